# Optimizing an MI355X kernel written in HIP

```python
import jax, jax.numpy as jnp
from jax import lax
import numpy as np

D_MODEL = 1024
BATCH = 2
SEQ = 8192
DEPTH = 2

N_MEM = 256
POOL_WINDOWS = (2, 4, 8, 16)
POOL_GROUPS = 4
POOL_W = D_MODEL // 2
POOL_GW = POOL_W // POOL_GROUPS
LRU_W = D_MODEL
LRU_HEADS = 8
LRU_HD = LRU_W // LRU_HEADS
CONV_W = 4
LRU_C = 8.0
FOX_HEADS = 8
FOX_HD = 64
FOX_W = FOX_HEADS * FOX_HD
Q_BLOCK = 128
X_HEADS = 4
X_HD = D_MODEL // X_HEADS
D_FF = ((8 * D_MODEL // 3 + 127) // 128) * 128
N_BRANCH = 3
EPS = 1e-6
IN_SIZES = (POOL_W, LRU_W, LRU_W, FOX_W, FOX_W, FOX_W, FOX_HEADS, N_BRANCH * D_MODEL)
IN_W = sum(IN_SIZES)

kernel_name = "hybrid_pool_rglru_fox_macaron_block"


def rmsnorm(x, g):
    xf = x.astype(jnp.float32)
    y = xf * lax.rsqrt(jnp.mean(xf * xf, axis=-1, keepdims=True) + EPS)
    return (y * g.astype(jnp.float32)).astype(x.dtype)


def swiglu(h, w_in, w_out):
    a, b = jnp.split(h @ w_in, 2, axis=-1)
    return (jax.nn.silu(a) * b) @ w_out


def pool_mixer(xa, w_grp, scale):
    B, S, _ = xa.shape
    xf = xa.astype(jnp.float32)
    cs = jnp.pad(jnp.cumsum(xf, axis=1), ((0, 0), (1, 0), (0, 0)))
    pos = jnp.arange(1, S + 1, dtype=jnp.float32)
    outs = []
    for g, w in enumerate(POOL_WINDOWS):
        c = cs[:, :, g * POOL_GW:(g + 1) * POOL_GW]
        lo = jnp.pad(c[:, :S + 1 - w], ((0, 0), (w - 1, 0), (0, 0)))
        cnt = jnp.minimum(pos, float(w))[None, :, None]
        outs.append((c[:, 1:] - lo) / cnt)
    mean = jnp.concatenate(outs, axis=-1)
    d = (mean - xf).astype(xa.dtype).reshape(B, S, POOL_GROUPS, POOL_GW)
    y = jnp.einsum('bsgc,gcd->bsgd', d, w_grp).reshape(B, S, POOL_W)
    return y * scale


def causal_depthwise_conv(x, w, b):
    S = x.shape[1]
    xp = jnp.pad(x, ((0, 0), (CONV_W - 1, 0), (0, 0)))
    y = b
    for k in range(CONV_W):
        y = y + xp[:, k:k + S] * w[k]
    return y


def rglru(xb, w_a, b_a, w_x, b_x, lam):
    B, S, _ = xb.shape
    xh = xb.reshape(B, S, LRU_HEADS, LRU_HD)
    r = jax.nn.sigmoid(jnp.einsum('bshc,hcd->bshd', xh, w_a).reshape(B, S, LRU_W) + b_a)
    i = jax.nn.sigmoid(jnp.einsum('bshc,hcd->bshd', xh, w_x).reshape(B, S, LRU_W) + b_x)
    log_a = -LRU_C * r.astype(jnp.float32) * jax.nn.softplus(-lam.astype(jnp.float32))
    a = jnp.exp(log_a)
    mult = jnp.sqrt(-jnp.expm1(2.0 * log_a))
    u = mult * (i * xb).astype(jnp.float32)

    def combine(l, rr):
        a1, b1 = l
        a2, b2 = rr
        return a1 * a2, a2 * b1 + b2

    _, h = lax.associative_scan(combine, (a, u), axis=1)
    return h.astype(xb.dtype)


def forgetting_attention(q, k, v, logf):
    B, S, _ = q.shape
    nb = S // Q_BLOCK
    q = q.reshape(B, S, FOX_HEADS, FOX_HD).transpose(0, 2, 1, 3)
    k = k.reshape(B, S, FOX_HEADS, FOX_HD).transpose(0, 2, 1, 3)
    v = v.reshape(B, S, FOX_HEADS, FOX_HD).transpose(0, 2, 1, 3)
    c = jnp.cumsum(logf.astype(jnp.float32), axis=1).transpose(0, 2, 1)
    qb = q.reshape(B, FOX_HEADS, nb, Q_BLOCK, FOX_HD).transpose(2, 0, 1, 3, 4)
    cb = c.reshape(B, FOX_HEADS, nb, Q_BLOCK).transpose(2, 0, 1, 3)
    starts = jnp.arange(nb, dtype=jnp.int32) * Q_BLOCK
    kpos = jnp.arange(S, dtype=jnp.int32)
    scale = FOX_HD ** -0.5

    def block(args):
        qi, ci, start = args
        s = jnp.einsum('bhqd,bhkd->bhqk', qi, k).astype(jnp.float32) * scale
        s = s + ci[..., None] - c[:, :, None, :]
        qpos = start + jnp.arange(Q_BLOCK, dtype=jnp.int32)
        s = jnp.where(kpos[None, :] <= qpos[:, None], s, -jnp.inf)
        p = jax.nn.softmax(s, axis=-1).astype(v.dtype)
        return jnp.einsum('bhqk,bhkd->bhqd', p, v)

    o = lax.map(block, (qb, cb, starts))
    return o.transpose(1, 0, 3, 2, 4).reshape(B, S, FOX_W)


def memory_cross_attention(h, m, w_q, w_kv, w_o):
    B, S, _ = h.shape
    q = (h @ w_q).reshape(B, S, X_HEADS, X_HD)
    k, v = jnp.split(m @ w_kv, 2, axis=-1)
    k = k.reshape(B, -1, X_HEADS, X_HD)
    v = v.reshape(B, -1, X_HEADS, X_HD)
    s = jnp.einsum('bshd,bmhd->bhsm', q, k).astype(jnp.float32) * (X_HD ** -0.5)
    p = jax.nn.softmax(s, axis=-1).astype(v.dtype)
    o = jnp.einsum('bhsm,bmhd->bshd', p, v).reshape(B, S, D_MODEL)
    return o @ w_o


def setup_inputs(seed: int = 0) -> dict:
    key = jax.random.key(seed)
    ks = iter(jax.random.split(key, 64))
    f32 = jnp.float32

    def dense(shape, fan_in):
        return jax.random.normal(next(ks), shape, f32) * (fan_in ** -0.5)

    def gain(shape):
        return 1.0 + 0.02 * jax.random.normal(next(ks), shape, f32)

    def bias(shape, s=0.01):
        return s * jax.random.normal(next(ks), shape, f32)

    L, D = DEPTH, D_MODEL
    a0 = jax.random.uniform(next(ks), (L, LRU_W), f32, 0.9, 0.999)
    s0 = a0 ** (1.0 / LRU_C)
    lru_lambda = jnp.log(s0) - jnp.log1p(-s0)
    return {
        "x": jax.random.normal(next(ks), (BATCH, SEQ, D), f32),
        "mem": jax.random.normal(next(ks), (BATCH, N_MEM, D), f32),
        "g_ffn1": gain((L, D)),
        "w_ffn1_in": dense((L, D, 2 * D_FF), D),
        "w_ffn1_out": dense((L, D_FF, D), D_FF),
        "g_mix": gain((L, D)),
        "w_in": dense((L, D, IN_W), D),
        "b_f": 2.0 + 0.5 * jax.random.normal(next(ks), (L, FOX_HEADS), f32),
        "b_gate": bias((L, N_BRANCH * D)),
        "w_pool": dense((L, POOL_GROUPS, POOL_GW, POOL_GW), POOL_GW),
        "pool_scale": gain((L, POOL_W)),
        "w_up_a": dense((L, POOL_W, D), POOL_W),
        "conv_w": dense((L, CONV_W, LRU_W), CONV_W),
        "conv_b": bias((L, LRU_W)),
        "w_rg_a": dense((L, LRU_HEADS, LRU_HD, LRU_HD), LRU_HD),
        "b_rg_a": bias((L, LRU_W)),
        "w_rg_x": dense((L, LRU_HEADS, LRU_HD, LRU_HD), LRU_HD),
        "b_rg_x": bias((L, LRU_W)),
        "lru_lambda": lru_lambda,
        "w_up_b": dense((L, LRU_W, D), LRU_W),
        "w_up_c": dense((L, FOX_W, D), FOX_W),
        "w_o": dense((L, D, D), D),
        "g_cross": gain((L, D)),
        "g_mem": gain((L, D)),
        "w_xq": dense((L, D, D), D),
        "w_xkv": dense((L, D, 2 * D), D),
        "w_xo": dense((L, D, D), D),
        "g_ffn2": gain((L, D)),
        "w_ffn2_in": dense((L, D, 2 * D_FF), D),
        "w_ffn2_out": dense((L, D_FF, D), D_FF),
        "g_final": gain((D,)),
    }


def reference(x, mem, g_ffn1, w_ffn1_in, w_ffn1_out, g_mix, w_in, b_f, b_gate, w_pool, pool_scale,
              w_up_a, conv_w, conv_b, w_rg_a, b_rg_a, w_rg_x, b_rg_x, lru_lambda, w_up_b, w_up_c, w_o,
              g_cross, g_mem, w_xq, w_xkv, w_xo, g_ffn2, w_ffn2_in, w_ffn2_out, g_final):
    B, S, D = x.shape
    offs = []
    acc = 0
    for n in IN_SIZES[:-1]:
        acc += n
        offs.append(acc)
    for l in range(DEPTH):
        x = x + 0.5 * swiglu(rmsnorm(x, g_ffn1[l]), w_ffn1_in[l], w_ffn1_out[l])
        u = rmsnorm(x, g_mix[l])
        xa, xb, gb, q, k, v, fl, gl = jnp.split(u @ w_in[l], offs, axis=-1)
        y_a = pool_mixer(xa, w_pool[l], pool_scale[l]) @ w_up_a[l]
        xb = causal_depthwise_conv(xb, conv_w[l], conv_b[l])
        h_b = rglru(xb, w_rg_a[l], b_rg_a[l], w_rg_x[l], b_rg_x[l], lru_lambda[l])
        y_b = (h_b * jax.nn.gelu(gb)) @ w_up_b[l]
        logf = jax.nn.log_sigmoid((fl + b_f[l]).astype(jnp.float32))
        y_c = forgetting_attention(q, k, v, logf) @ w_up_c[l]
        g = jax.nn.sigmoid(gl + b_gate[l]).reshape(B, S, N_BRANCH, D)
        merged = g[:, :, 0] * y_a + g[:, :, 1] * y_b + g[:, :, 2] * y_c
        x = x + merged @ w_o[l]
        x = x + memory_cross_attention(rmsnorm(x, g_cross[l]), rmsnorm(mem, g_mem[l]),
                                       w_xq[l], w_xkv[l], w_xo[l])
        x = x + 0.5 * swiglu(rmsnorm(x, g_ffn2[l]), w_ffn2_in[l], w_ffn2_out[l])
    return rmsnorm(x, g_final)
```

```cpp
#include <hip/hip_runtime.h>
#include <hip/hip_cooperative_groups.h>
#include <cstdio>
#include <cstdint>
namespace cg = cooperative_groups;
namespace pg8 {
#define PG8_LAS __attribute__((address_space(3)))
typedef unsigned short bf16_t;
typedef short bf16x8 __attribute__((ext_vector_type(8)));
typedef float f32x4 __attribute__((ext_vector_type(4)));
typedef unsigned u32x4 __attribute__((ext_vector_type(4)));
constexpr int BM = 256, BK = 64, HALF = 128, HTB = HALF * BK * 2  , STAGE_BYTES = 8 * HTB, NXCD = 8, WGM = 8;

__host__ __device__ __forceinline__ int lds_byte(int r, int c) { const int st = (r >> 4) * 2 + (c >> 5), rr = r & 15, cc = c & 31, ob = rr * 64 + cc * 2; return st * 1024 + (ob ^ (((ob >> 9) & 1) << 5)); }
__host__ __device__ __forceinline__ void stage_rc(int b, int& R, int& C) { const int st = b / 1024, sb = b % 1024, swz = sb ^ (((sb >> 9) & 1) << 5); R = (st >> 1) * 16 + swz / 64; C = (st & 1) * 32 + (swz % 64) / 2; }
__host__ __device__ __forceinline__ int perm32(int rho) { const int n = rho >> 4, i = rho & 15; return 8 * (i >> 2) + 4 * n + (i & 3); }

struct Unit { int pm, pn; };
struct Gemm { const bf16_t* A; const bf16_t* Bt; int M, N, K, lda, ldb, a_pn_off; };

struct StaticOrder {
    int nM, nN, nwg, G, c;
    __host__ __device__ __forceinline__ void init(int M, int N, int G_, int c_) { nM = M / BM; nN = N / BM; nwg = nM * nN; G = G_; c = c_; }
    __host__ __device__ __forceinline__ bool next(int i, Unit& u) const {
        const long L = (long)i * G + c; if (L >= nwg) return false;
        int wgid = (int)L; { const int q = nwg / NXCD, r = nwg % NXCD, xcd = wgid % NXCD, off = wgid / NXCD; wgid = (xcd < r ? xcd * (q + 1) : r * (q + 1) + (xcd - r) * q) + off; }
        const int nig = WGM * nN, gid = wgid / nig, fm = gid * WGM, gsz = (nM - fm) < WGM ? (nM - fm) : WGM;
        u.pm = fm + ((wgid % nig) % gsz); u.pn = (wgid % nig) / gsz; return true;
    }
    __device__ __forceinline__ void a_ready(const Unit&) const {}
    __device__ __forceinline__ void done(const Unit&) const {}
};

__device__ __forceinline__ unsigned cvt_pk_bf16(float lo, float hi) { unsigned r; asm volatile("v_cvt_pk_bf16_f32 %0, %1, %2" : "=v"(r) : "v"(lo), "v"(hi)); return r; }
__device__ __forceinline__ float bperm(float v, int srclane) { return __int_as_float(__builtin_amdgcn_ds_bpermute(srclane << 2, __float_as_int(v))); }
typedef float f32x2 __attribute__((ext_vector_type(2)));
typedef unsigned u32x2 __attribute__((ext_vector_type(2)));
__device__ __forceinline__ float fsig(float v) { return __builtin_amdgcn_rcpf(1.f + __expf(-v)); }
__device__ __forceinline__ float fsilu(float v) { return v * fsig(v); }
__device__ __forceinline__ float fgelu_tanh(float v) { return v * fsig(1.5957691216057308f * (v + 0.044715f * v * v * v)); }
__device__ __forceinline__ float bf_lo(unsigned w) { return __uint_as_float(w << 16); }
__device__ __forceinline__ float bf_hi(unsigned w) { return __uint_as_float(w & 0xffff0000u); }
__device__ __forceinline__ float rstd_of(const float* ss, int row) { const f32x4* p = (const f32x4*)(ss + (size_t)row * 16); const f32x4 a = p[0], b = p[1], c = p[2], d = p[3];
    const float s = ((a[0] + a[1]) + (a[2] + a[3])) + ((b[0] + b[1]) + (b[2] + b[3])) + (((c[0] + c[1]) + (c[2] + c[3])) + ((d[0] + d[1]) + (d[2] + d[3]))); return rsqrtf(s * (1.0f / 1024.0f) + 1e-6f); }
__device__ __forceinline__ u32x4 pack8(const f32x4 v0, const f32x4 v1) { u32x4 w; w.x = cvt_pk_bf16(v0[0], v0[1]); w.y = cvt_pk_bf16(v0[2], v0[3]); w.z = cvt_pk_bf16(v1[0], v1[1]); w.w = cvt_pk_bf16(v1[2], v1[3]); return w; }

struct OneUnit { int pm, pn;
    __device__ __forceinline__ bool next(int i, Unit& u) const { if (i) return false; u.pm = pm; u.pn = pn; return true; }
    __device__ __forceinline__ void a_ready(const Unit&) const {}
    __device__ __forceinline__ void done(const Unit&) const {} };

struct EpiSwiglu { static constexpr bool PERM = true, AFTER_DRAIN = false; bf16_t* H; const float* ss; int ldh;
    __device__ __forceinline__ void operator()(const f32x4 (&acc)[2][2][4][2], const Unit& u, int wr, int wc, int fr, int fq) const {
        const int row0 = u.pm * BM + wr * 64 + fr, col0 = u.pn * HALF + wc * 32 + 8 * fq;
#pragma unroll
        for (int ai = 0; ai < 2; ++ai)
#pragma unroll
            for (int m = 0; m < 4; ++m) { const int row = row0 + ai * HALF + m * 16; const float rs = rstd_of(ss, row);
                f32x4 o0, o1;
#pragma unroll
                for (int i = 0; i < 4; ++i) { o0[i] = fsilu(acc[ai][0][m][0][i] * rs) * (acc[ai][1][m][0][i] * rs); o1[i] = fsilu(acc[ai][0][m][1][i] * rs) * (acc[ai][1][m][1][i] * rs); }
                *(u32x4*)(H + (size_t)row * ldh + col0) = pack8(o0, o1); __builtin_amdgcn_sched_barrier(0); }
    }
};
struct EpiResid { static constexpr bool PERM = false, AFTER_DRAIN = false; float* x; bf16_t* xb; float* ss; float scale;
    __device__ __forceinline__ void operator()(const f32x4 (&acc)[2][2][4][2], const Unit& u, int wr, int wc, int fr, int fq) const {
        float scl = scale; asm volatile("" : "+v"(scl)); const int row0 = u.pm * BM + wr * 64 + fr, col0 = u.pn * BM + wc * 32 + 4 * fq;
#pragma unroll
        for (int ai = 0; ai < 2; ++ai)
#pragma unroll
            for (int m = 0; m < 4; ++m) { const int row = row0 + ai * HALF + m * 16; float q = 0.f;
#pragma unroll
                for (int bj = 0; bj < 2; ++bj)
#pragma unroll
                    for (int n = 0; n < 2; ++n) { const size_t off = (size_t)row * 1024 + col0 + bj * HALF + n * 16;
                        f32x4 v = *(const f32x4*)(x + off) + acc[ai][bj][m][n] * scl; *(f32x4*)(x + off) = v;
                        u32x2 w; w.x = cvt_pk_bf16(v[0], v[1]); w.y = cvt_pk_bf16(v[2], v[3]); *(u32x2*)(xb + off) = w;
                        q += (v[0] * v[0] + v[1] * v[1]) + (v[2] * v[2] + v[3] * v[3]); }
                q += bperm(q, (fr + 16 * fq) ^ 16); q += bperm(q, (fr + 16 * fq) ^ 32);
                if (fq == 0) ss[(size_t)row * 16 + u.pn * 4 + wc] = q; }
    }
};
struct EpiRs { static constexpr bool PERM = true, AFTER_DRAIN = false; bf16_t* O; int ldc; const float* ss; float sc;
    __device__ __forceinline__ void operator()(const f32x4 (&acc)[2][2][4][2], const Unit& u, int wr, int wc, int fr, int fq) const {
        const int row0 = u.pm * BM + wr * 64 + fr, col0 = u.pn * BM + wc * 32 + 8 * fq;
#pragma unroll
        for (int ai = 0; ai < 2; ++ai)
#pragma unroll
            for (int m = 0; m < 4; ++m) { const int row = row0 + ai * HALF + m * 16; const float rs = (ss ? rstd_of(ss, row) : 1.f) * sc;
#pragma unroll
                for (int bj = 0; bj < 2; ++bj) *(u32x4*)(O + (size_t)row * ldc + col0 + bj * HALF) = pack8(acc[ai][bj][m][0] * rs, acc[ai][bj][m][1] * rs); }
    }
};
struct EpiWin { static constexpr bool PERM = true, AFTER_DRAIN = false; bf16_t *xa, *xl, *gg, *q, *k, *v; const float* ss; float qscale;
    __device__ __forceinline__ void operator()(const f32x4 (&acc)[2][2][4][2], const Unit& u, int wr, int wc, int fr, int fq) const {
        const int pn = u.pn; bf16_t* dst; int ld, ct; float sc = 1.f; bool act = false;
        if (pn < 2) { dst = xa; ld = 512; ct = pn; } else if (pn < 6) { dst = xl; ld = 1024; ct = pn - 2; } else if (pn < 10) { dst = gg; ld = 1024; ct = pn - 6; act = true; }
        else if (pn < 12) { dst = q; ld = 512; ct = pn - 10; sc = qscale; } else if (pn < 14) { dst = k; ld = 512; ct = pn - 12; } else { dst = v; ld = 512; ct = pn - 14; }
        const int row0 = u.pm * BM + wr * 64 + fr, col0 = ct * BM + wc * 32 + 8 * fq;
#pragma unroll
        for (int ai = 0; ai < 2; ++ai)
#pragma unroll
            for (int m = 0; m < 4; ++m) { const int row = row0 + ai * HALF + m * 16; const float rs = rstd_of(ss, row) * sc;
#pragma unroll
                for (int bj = 0; bj < 2; ++bj) { f32x4 v0 = acc[ai][bj][m][0] * rs, v1 = acc[ai][bj][m][1] * rs;
                    if (act) {
#pragma unroll
                        for (int i = 0; i < 4; ++i) { v0[i] = fgelu_tanh(v0[i]); v1[i] = fgelu_tanh(v1[i]); } }
                    *(u32x4*)(dst + (size_t)row * ld + col0 + bj * HALF) = pack8(v0, v1); __builtin_amdgcn_sched_barrier(0); } }
    }
};
struct EpiGate { static constexpr bool PERM = true, AFTER_DRAIN = false; bf16_t* stash; const float* bg; const float* ss;
    __device__ __forceinline__ void operator()(const f32x4 (&acc)[2][2][4][2], const Unit& u, int wr, int wc, int fr, int fq) const {
        const int row0 = u.pm * BM + wr * 64 + fr, col0 = u.pn * BM + wc * 32 + 8 * fq; int tid_o = threadIdx.x; asm volatile("" : "+v"(tid_o)); const int tid = tid_o;
        f32x4 bv[2][2];
#pragma unroll
        for (int bj = 0; bj < 2; ++bj)
#pragma unroll
            for (int n = 0; n < 2; ++n) bv[bj][n] = *(const f32x4*)(bg + col0 + bj * HALF + 4 * n);
#pragma unroll
        for (int ai = 0; ai < 2; ++ai)
#pragma unroll
            for (int m = 0; m < 4; ++m) { const int row = row0 + ai * HALF + m * 16; const float rs = rstd_of(ss, row);
#pragma unroll
                for (int bj = 0; bj < 2; ++bj) { f32x4 v0 = acc[ai][bj][m][0] * rs + bv[bj][0], v1 = acc[ai][bj][m][1] * rs + bv[bj][1];
#pragma unroll
                    for (int i = 0; i < 4; ++i) { v0[i] = fsig(v0[i]); v1[i] = fsig(v1[i]); }
                    *(u32x4*)(stash + ((size_t)((ai * 4 + m) * 2 + bj) * 512 + tid) * 8) = pack8(v0, v1); __builtin_amdgcn_sched_barrier(0); } }
    }
};
struct EpiMerge { static constexpr bool PERM = true, AFTER_DRAIN = false; const bf16_t* stash; bf16_t* mg; int first;
    __device__ __forceinline__ void operator()(const f32x4 (&acc)[2][2][4][2], const Unit& u, int wr, int wc, int fr, int fq) const {
        const int row0 = u.pm * BM + wr * 64 + fr, col0 = u.pn * BM + wc * 32 + 8 * fq; int tid_o = threadIdx.x; asm volatile("" : "+v"(tid_o)); const int tid = tid_o;
#pragma unroll
        for (int ai = 0; ai < 2; ++ai)
#pragma unroll
            for (int m = 0; m < 4; ++m) { const int row = row0 + ai * HALF + m * 16;
#pragma unroll
                for (int bj = 0; bj < 2; ++bj) { const u32x4 gw = *(const u32x4*)(stash + ((size_t)((ai * 4 + m) * 2 + bj) * 512 + tid) * 8);
                    bf16_t* p = mg + (size_t)row * 1024 + col0 + bj * HALF;
                    f32x4 v0 = acc[ai][bj][m][0], v1 = acc[ai][bj][m][1];
                    v0[0] *= bf_lo(gw.x); v0[1] *= bf_hi(gw.x); v0[2] *= bf_lo(gw.y); v0[3] *= bf_hi(gw.y); v1[0] *= bf_lo(gw.z); v1[1] *= bf_hi(gw.z); v1[2] *= bf_lo(gw.w); v1[3] *= bf_hi(gw.w);
                    if (!first) { const u32x4 ow = *(const u32x4*)p;
                        v0[0] += bf_lo(ow.x); v0[1] += bf_hi(ow.x); v0[2] += bf_lo(ow.y); v0[3] += bf_hi(ow.y); v1[0] += bf_lo(ow.z); v1[1] += bf_hi(ow.z); v1[2] += bf_lo(ow.w); v1[3] += bf_hi(ow.w); }
                    *(u32x4*)p = pack8(v0, v1); __builtin_amdgcn_sched_barrier(0); } }
    }
};
struct EpiKV { static constexpr bool PERM = true, AFTER_DRAIN = false; bf16_t* kx; bf16_t* vt;
    __device__ __forceinline__ void operator()(const f32x4 (&acc)[2][2][4][2], const Unit& u, int wr, int wc, int fr, int fq) const {
        if (u.pn < 4) { const int row0 = u.pm * BM + wr * 64 + fr, col0 = u.pn * BM + wc * 32 + 8 * fq;
#pragma unroll
            for (int ai = 0; ai < 2; ++ai)
#pragma unroll
                for (int m = 0; m < 4; ++m)
#pragma unroll
                    for (int bj = 0; bj < 2; ++bj) *(u32x4*)(kx + (size_t)(row0 + ai * HALF + m * 16) * 1024 + col0 + bj * HALF) = pack8(acc[ai][bj][m][0], acc[ai][bj][m][1]);
        } else { const int h = u.pn - 4, b = u.pm; bf16_t* base = vt + (size_t)(b * 4 + h) * 65536;
#pragma unroll
            for (int ai = 0; ai < 2; ++ai)
#pragma unroll
                for (int m = 0; m < 4; ++m) { const int mr = ai * HALF + wr * 64 + m * 16 + fr;
#pragma unroll
                    for (int bj = 0; bj < 2; ++bj) { bf16_t* p = base + (size_t)(bj * HALF + wc * 32 + 8 * fq) * 256 + mr; asm volatile("" : "+v"(p));
#pragma unroll
                        for (int n = 0; n < 2; ++n)
#pragma unroll
                            for (int i = 0; i < 4; ++i) p[(4 * n + i) * 256] = (bf16_t)(cvt_pk_bf16(acc[ai][bj][m][n][i], 0.f) & 0xffffu);
                        __builtin_amdgcn_sched_barrier(0); } }
        }
    }
};
struct EpiSoftmaxP { static constexpr bool PERM = true, AFTER_DRAIN = true; bf16_t* P;
    __device__ __forceinline__ void fused(f32x4 (&acc)[2][2][4][2], const Unit& u, int wr, int wc, int fr, int fq, PG8_LAS unsigned char* lds, int wid, int lane) const {
        PG8_LAS f32x2* X = (PG8_LAS f32x2*)lds;
        float mloc[2][4];
#pragma unroll
        for (int ai = 0; ai < 2; ++ai)
#pragma unroll
            for (int m = 0; m < 4; ++m) { float mx = -__builtin_inff();
#pragma unroll
                for (int bj = 0; bj < 2; ++bj)
#pragma unroll
                    for (int n = 0; n < 2; ++n) { const f32x4 v = acc[ai][bj][m][n]; mx = fmaxf(mx, fmaxf(fmaxf(v[0], v[1]), fmaxf(v[2], v[3]))); }
                mx = fmaxf(mx, bperm(mx, (fr + 16 * fq) ^ 16)); mx = fmaxf(mx, bperm(mx, (fr + 16 * fq) ^ 32)); float s = 0.f;
#pragma unroll
                for (int bj = 0; bj < 2; ++bj)
#pragma unroll
                    for (int n = 0; n < 2; ++n) { f32x4 v = acc[ai][bj][m][n];
#pragma unroll
                        for (int i = 0; i < 4; ++i) { v[i] = __builtin_amdgcn_exp2f(v[i] - mx); s += v[i]; }
                        acc[ai][bj][m][n] = v; }
                s += bperm(s, (fr + 16 * fq) ^ 16); s += bperm(s, (fr + 16 * fq) ^ 32); mloc[ai][m] = mx;
                if (fq == 0) X[(ai * HALF + wr * 64 + m * 16 + fr) * 4 + wc] = (f32x2){mx, s}; __builtin_amdgcn_sched_barrier(0); }
        asm volatile("s_waitcnt lgkmcnt(0)" ::: "memory"); __builtin_amdgcn_s_barrier(); asm volatile("" ::: "memory");
#pragma unroll
        for (int ai = 0; ai < 2; ++ai)
#pragma unroll
            for (int m = 0; m < 4; ++m) { const int rl = ai * HALF + wr * 64 + m * 16 + fr;
                const f32x2 a = X[rl * 4 + 0], b = X[rl * 4 + 1], c = X[rl * 4 + 2], d = X[rl * 4 + 3];
                const float M = fmaxf(fmaxf(a.x, b.x), fmaxf(c.x, d.x));
                const float L = a.y * __builtin_amdgcn_exp2f(a.x - M) + b.y * __builtin_amdgcn_exp2f(b.x - M) + c.y * __builtin_amdgcn_exp2f(c.x - M) + d.y * __builtin_amdgcn_exp2f(d.x - M);
                const float f = __builtin_amdgcn_exp2f(mloc[ai][m] - M) / L;
#pragma unroll
                for (int bj = 0; bj < 2; ++bj) *(u32x4*)(P + (size_t)rl * 256 + bj * HALF + wc * 32 + 8 * fq) = pack8(acc[ai][bj][m][0] * f, acc[ai][bj][m][1] * f); __builtin_amdgcn_sched_barrier(0); }
        asm volatile("s_waitcnt vmcnt(0) lgkmcnt(0)" ::: "memory"); __builtin_amdgcn_s_barrier(); asm volatile("" ::: "memory");
    }
};

template <class Epi, class Sched, bool ALIGN_EPI = false, bool SP2 = false>
__device__ __forceinline__ void gemm_phase(PG8_LAS unsigned char* lds, const Gemm g, const Sched& S, const Epi& E) {
    int tid_o = threadIdx.x; asm volatile("" : "+v"(tid_o));
    const int tid = tid_o, wid = __builtin_amdgcn_readfirstlane(tid >> 6), lane = tid & 63, wr = wid >> 2, wc = wid & 3, fr = lane & 15, fq = lane >> 4;
    const int K = g.K, nt = K / BK;
    unsigned voffA[2], voffB[2];
#pragma unroll
    for (int i = 0; i < 2; ++i) { int R, C; stage_rc(tid * 16 + i * 8192, R, C); const int Rb = Epi::PERM ? ((R & ~31) + perm32(R & 31)) : R;
        voffA[i] = (unsigned)(R * g.lda + C) * 2u; voffB[i] = (unsigned)(Rb * g.ldb + C) * 2u; }
    const size_t kstep = (size_t)(BK * 2);
    const size_t hstepA = (size_t)HALF * g.lda * 2, hstepB = (size_t)HALF * g.ldb * 2;
    const size_t tstepA = 2 * hstepA, tstepB = 2 * hstepB;
    const unsigned ldsw = (unsigned)wid * 1024u;
    const int aoff = lds_byte(wr * 64 + fr, fq * 8), boff = lds_byte(wc * 32 + fr, fq * 8);
#define PG8_SA(b, h) (((b) * 2 + (h)) * HTB)
#define PG8_SB(b, h) ((4 + (b) * 2 + (h)) * HTB)
#define PG8_STAGE(bufoff, gbase, voff) do { _Pragma("unroll") for (int _i = 0; _i < 2; ++_i) \
        __builtin_amdgcn_global_load_lds((const unsigned*)((const char*)(gbase) + (voff)[_i]), (PG8_LAS unsigned*)(lds + (bufoff) + ldsw + _i * 8192), 16, 0, 0); } while (0)
#define PG8_LDA(dst, b, h) do { _Pragma("unroll") for (int m = 0; m < 4; ++m) _Pragma("unroll") for (int k = 0; k < 2; ++k) dst[m][k] = *(const PG8_LAS bf16x8*)(lds + PG8_SA(b, h) + aoff + m * 2048 + k * 1024); } while (0)
#define PG8_LDB(dst, b, h) do { _Pragma("unroll") for (int n = 0; n < 2; ++n) _Pragma("unroll") for (int k = 0; k < 2; ++k) dst[n][k] = *(const PG8_LAS bf16x8*)(lds + PG8_SB(b, h) + boff + n * 2048 + k * 1024); } while (0)
#define PG8_MMA(ai, bj, At, Bt) do { __builtin_amdgcn_s_setprio(1); _Pragma("unroll") for (int m = 0; m < 4; ++m) _Pragma("unroll") for (int n = 0; n < 2; ++n) _Pragma("unroll") for (int k = 0; k < 2; ++k) \
        acc[ai][bj][m][n] = __builtin_amdgcn_mfma_f32_16x16x32_bf16(Bt[n][k], At[m][k], acc[ai][bj][m][n], 0, 0, 0); __builtin_amdgcn_s_setprio(0); } while (0)
#define PG8_WAIT_V(n) asm volatile("s_waitcnt vmcnt(" #n ")" ::: "memory")
#define PG8_WAIT_L(n) asm volatile("s_waitcnt lgkmcnt(" #n ")" ::: "memory")
#define PG8_BAR __builtin_amdgcn_s_barrier()
#define PG8_SCHED __builtin_amdgcn_sched_barrier(0)
    Unit cur, nxt; int ui = 0;
    if (!S.next(0, cur)) return;
    f32x4 acc[2][2][4][2];
#pragma unroll
    for (int a = 0; a < 2; ++a)
#pragma unroll
        for (int b = 0; b < 2; ++b)
#pragma unroll
            for (int m = 0; m < 4; ++m)
#pragma unroll
                for (int n = 0; n < 2; ++n) acc[a][b][m][n] = (f32x4){0.f, 0.f, 0.f, 0.f};
    bf16x8 At[4][2], B0[2][2], B1[2][2];
    const char* cA = (const char*)g.A + (size_t)cur.pm * tstepA + (size_t)cur.pn * g.a_pn_off * 2; const char* cB = (const char*)g.Bt + (size_t)cur.pn * tstepB;
    S.a_ready(cur);
    if constexpr (SP2) {
        PG8_STAGE(PG8_SB(0, 0), cB, voffB); PG8_STAGE(PG8_SB(0, 1), cB + hstepB, voffB); PG8_STAGE(PG8_SA(0, 0), cA, voffA); PG8_STAGE(PG8_SA(0, 1), cA + hstepA, voffA);
        if (wr == 1) PG8_BAR;
        PG8_WAIT_V(2); PG8_BAR;
        PG8_STAGE(PG8_SB(1, 0), cB + kstep, voffB); PG8_STAGE(PG8_SA(1, 0), cA + kstep, voffA); PG8_STAGE(PG8_SB(1, 1), cB + hstepB + kstep, voffB);
        PG8_WAIT_V(6); PG8_BAR;
    } else {
        PG8_STAGE(PG8_SB(0, 0), cB, voffB); PG8_STAGE(PG8_SA(0, 0), cA, voffA); PG8_STAGE(PG8_SB(0, 1), cB + hstepB, voffB); PG8_STAGE(PG8_SA(0, 1), cA + hstepA, voffA);
        if (wr == 1) PG8_BAR;
        PG8_WAIT_V(4); PG8_BAR;
        PG8_STAGE(PG8_SB(1, 0), cB + kstep, voffB); PG8_STAGE(PG8_SA(1, 0), cA + kstep, voffA); PG8_STAGE(PG8_SB(1, 1), cB + hstepB + kstep, voffB);
        PG8_WAIT_V(6); PG8_BAR;
    }
    for (;;) {
        const bool has_next = S.next(ui + 1, nxt);
        const char* nA = has_next ? (const char*)g.A + (size_t)nxt.pm * tstepA + (size_t)nxt.pn * g.a_pn_off * 2 : cA; const char* nB = has_next ? (const char*)g.Bt + (size_t)nxt.pn * tstepB : cB;
        for (int t = 0; t < nt; t += 2) {
            const bool last = (t == nt - 2);
            const char* a1 = cA + (size_t)(t + 1) * kstep;
            const char* a2 = last ? nA : cA + (size_t)(t + 2) * kstep; const char* b2 = last ? nB : cB + (size_t)(t + 2) * kstep;
            const char* a3 = a2 + kstep; const char* b3 = b2 + kstep;
            if (last && has_next) S.a_ready(nxt);
            if constexpr (SP2) {
            PG8_LDB(B0, 0, 0); PG8_LDB(B1, 0, 1); PG8_SCHED; PG8_LDA(At, 0, 0); PG8_STAGE(PG8_SA(1, 1), a1 + hstepA, voffA);
            PG8_WAIT_V(8); PG8_WAIT_L(0); PG8_BAR; PG8_MMA(0, 0, At, B0); PG8_MMA(0, 1, At, B1); PG8_BAR; PG8_SCHED;
            PG8_LDA(At, 0, 1); PG8_STAGE(PG8_SB(0, 0), b2, voffB); PG8_STAGE(PG8_SB(0, 1), b2 + hstepB, voffB); PG8_STAGE(PG8_SA(0, 0), a2, voffA);
            PG8_WAIT_V(8); PG8_WAIT_L(0); PG8_BAR; PG8_MMA(1, 0, At, B0); PG8_MMA(1, 1, At, B1); PG8_BAR; PG8_SCHED;
            PG8_LDB(B0, 1, 0); PG8_LDB(B1, 1, 1); PG8_SCHED; PG8_LDA(At, 1, 0); PG8_STAGE(PG8_SA(0, 1), a2 + hstepA, voffA);
            PG8_WAIT_V(8); PG8_WAIT_L(0); PG8_BAR; PG8_MMA(0, 0, At, B0); PG8_MMA(0, 1, At, B1); PG8_BAR; PG8_SCHED;
            PG8_LDA(At, 1, 1); PG8_STAGE(PG8_SB(1, 0), b3, voffB); PG8_STAGE(PG8_SB(1, 1), b3 + hstepB, voffB); PG8_STAGE(PG8_SA(1, 0), a3, voffA);
            PG8_WAIT_V(8); PG8_WAIT_L(0); PG8_BAR; PG8_MMA(1, 0, At, B0); PG8_MMA(1, 1, At, B1); PG8_BAR; PG8_SCHED;
            } else {
            PG8_LDB(B0, 0, 0); PG8_SCHED; PG8_LDA(At, 0, 0); PG8_STAGE(PG8_SA(1, 1), a1 + hstepA, voffA);
            PG8_WAIT_L(8); PG8_BAR; PG8_WAIT_L(0); PG8_MMA(0, 0, At, B0); PG8_BAR; PG8_SCHED;
            PG8_LDB(B1, 0, 1); PG8_STAGE(PG8_SB(0, 0), b2, voffB);
            PG8_BAR; PG8_WAIT_L(0); PG8_MMA(0, 1, At, B1); PG8_BAR;
            PG8_LDA(At, 0, 1); PG8_STAGE(PG8_SA(0, 0), a2, voffA);
            PG8_BAR; PG8_WAIT_L(0); PG8_MMA(1, 0, At, B0); PG8_BAR; PG8_SCHED;
            PG8_STAGE(PG8_SB(0, 1), b2 + hstepB, voffB);
            PG8_WAIT_V(6); PG8_BAR; PG8_MMA(1, 1, At, B1); PG8_BAR;
            PG8_LDB(B0, 1, 0); PG8_SCHED; PG8_LDA(At, 1, 0); PG8_STAGE(PG8_SA(0, 1), a2 + hstepA, voffA);
            PG8_WAIT_L(8); PG8_BAR; PG8_WAIT_L(0); PG8_MMA(0, 0, At, B0); PG8_BAR; PG8_SCHED;
            PG8_LDB(B1, 1, 1); PG8_STAGE(PG8_SB(1, 0), b3, voffB);
            PG8_BAR; PG8_WAIT_L(0); PG8_MMA(0, 1, At, B1); PG8_BAR;
            PG8_LDA(At, 1, 1); PG8_STAGE(PG8_SA(1, 0), a3, voffA);
            PG8_BAR; PG8_WAIT_L(0); PG8_MMA(1, 0, At, B0); PG8_BAR; PG8_SCHED;
            PG8_STAGE(PG8_SB(1, 1), b3 + hstepB, voffB);
            PG8_WAIT_V(6); PG8_BAR; PG8_MMA(1, 1, At, B1); PG8_BAR;
            }
        }
        if constexpr (ALIGN_EPI) { if (wr == 0) PG8_BAR; }
        if constexpr (!Epi::AFTER_DRAIN) { E(acc, cur, wr, wc, fr, fq); S.done(cur); }
        if (!has_next) break;
#pragma unroll
        for (int a = 0; a < 2; ++a)
#pragma unroll
            for (int b = 0; b < 2; ++b)
#pragma unroll
                for (int m = 0; m < 4; ++m)
#pragma unroll
                    for (int n = 0; n < 2; ++n) acc[a][b][m][n] = (f32x4){0.f, 0.f, 0.f, 0.f};
        cur = nxt; cA = nA; cB = nB; ++ui;
        if constexpr (ALIGN_EPI) { if (wr == 1) PG8_BAR; }
    }
    PG8_WAIT_V(0);
    if constexpr (!ALIGN_EPI) { if (wr == 0) PG8_BAR; }
    PG8_BAR;
    if constexpr (Epi::AFTER_DRAIN) { E.fused(acc, cur, wr, wc, fr, fq, lds, wid, lane); S.done(cur); }
#undef PG8_SA
#undef PG8_SB
#undef PG8_STAGE
#undef PG8_LDA
#undef PG8_LDB
#undef PG8_MMA
#undef PG8_WAIT_V
#undef PG8_WAIT_L
#undef PG8_BAR
#undef PG8_SCHED
}
}
#include <hip/hip_bf16.h>
#include <cmath>
#define GAS __attribute__((address_space(1)))
#define LAS __attribute__((address_space(3)))
typedef unsigned short bf16;
typedef unsigned v4u __attribute__((ext_vector_type(4)));
typedef float f32x4 __attribute__((ext_vector_type(4)));
typedef short bf16x8 __attribute__((ext_vector_type(8)));
typedef float f32x16 __attribute__((ext_vector_type(16)));

constexpr int NWAVES = 8, NTHR = 512;
constexpr int BATCH = 2, SEQ = 8192, D = 1024, M = BATCH * SEQ, DFF = 2816, DEPTH = 2;
constexpr int INW = 7176;
constexpr size_t MiB = 1u << 20;
constexpr size_t WS_SS = 0, CTL_ZERO_BYTES = 1 * MiB;
constexpr size_t WS_WFL = 1 * MiB;
constexpr size_t WS_WAT = 1 * MiB + 256 * 1024, WS_WXT = 1 * MiB + 512 * 1024;
constexpr size_t WS_SUMM = 2 * MiB;
constexpr size_t WS_LOGF = 3 * MiB, WS_CTIL = 3 * MiB + 512 * 1024;
constexpr size_t WS_MEMN = 4 * MiB, WS_KX = 5 * MiB, WS_VT = 6 * MiB;
constexpr size_t WS_W1IN = 8 * MiB, WS_W1OUT = 19 * MiB, WS_WIN = 25 * MiB, WS_WG = 33 * MiB, WS_UA = 39 * MiB, WS_UB = 40 * MiB, WS_UC = 42 * MiB,
                 WS_WO = 43 * MiB, WS_WXQ = 45 * MiB, WS_WXKV = 47 * MiB, WS_WXO = 51 * MiB, WS_W2IN = 53 * MiB, WS_W2OUT = 64 * MiB;
constexpr size_t WS_XB = 70 * MiB;
constexpr size_t WS_Q = 102 * MiB, WS_GG = 118 * MiB, WS_XA = 150 * MiB, WS_XL = 166 * MiB, WS_K = 198 * MiB, WS_V = 214 * MiB;
constexpr size_t WS_H = 102 * MiB;
constexpr size_t WS_YC = 150 * MiB;
constexpr size_t WS_STASH = 166 * MiB, WS_MG = 198 * MiB, WS_QX = 150 * MiB, WS_PBUF = 198 * MiB;
constexpr size_t WS_YA = 230 * MiB, WS_SSP = 246 * MiB, WS_END = 255 * MiB;
constexpr int LDS_BYTES = 147456;

__device__ __forceinline__ unsigned f2bf(float f) { unsigned u = __builtin_bit_cast(unsigned, f); return (u + 0x7fffu + ((u >> 16) & 1u)) >> 16; }
__device__ __forceinline__ unsigned pk2(float lo, float hi) { return f2bf(lo) | (f2bf(hi) << 16); }
__device__ __forceinline__ float bf2f(unsigned short v) { return __uint_as_float((unsigned)v << 16); }
__device__ __forceinline__ float bperm(float v, int srclane) { return __int_as_float(__builtin_amdgcn_ds_bpermute(srclane << 2, __float_as_int(v))); }
__device__ __forceinline__ float wave_sum(float v, int lane) {
#pragma unroll
    for (int o = 1; o < 64; o <<= 1) v += bperm(v, lane ^ o);
    return v;
}
__device__ __forceinline__ float flog1p(float e) { return e < 0.01f ? e * (1.f - e * (0.5f - e * 0.33333334f)) : __logf(1.f + e); }
#define LDS_WAIT() asm volatile("s_waitcnt lgkmcnt(0)" ::: "memory")

__device__ __forceinline__ void tr_item(const float* W, int ldn, int col0, int k0, const float* g, bf16* WT, int ldk, int drow0, LAS float* scr, int lane) {
#pragma unroll 8
    for (int i = 0; i < 32; ++i) { const int kk = 2 * i + (lane >> 5); float v = W[(size_t)(k0 + kk) * ldn + col0 + (lane & 31)]; if (g) v *= g[k0 + kk]; scr[kk * 33 + (lane & 31)] = v; }
    LDS_WAIT(); asm volatile("" ::: "memory");
    const int c = lane & 7;
#pragma unroll
    for (int j = 0; j < 4; ++j) { const int n = (lane >> 3) + 8 * j; const LAS float* s = scr + (8 * c) * 33 + n;
        v4u o; o.x = pk2(s[0 * 33], s[1 * 33]); o.y = pk2(s[2 * 33], s[3 * 33]); o.z = pk2(s[4 * 33], s[5 * 33]); o.w = pk2(s[6 * 33], s[7 * 33]);
        *(v4u*)(WT + (size_t)(drow0 + n) * ldk + k0 + 8 * c) = o; }
    LDS_WAIT(); asm volatile("" ::: "memory");
}

#define RLX_AGENT __ATOMIC_RELAXED, __HIP_MEMORY_SCOPE_AGENT
#define XB_TMO      128
#define XB_XCNT(j)  (256  + 64 * (j))
#define XB_XSUB(j)  (1280 + 64 * (j))
#define XB_XGEN(j)  (2304 + 64 * (j))
#define XB_TOP      3328
#define XB_TOPGEN   3392
#define XCD_BAR_WORDS 3456
#define XB_SPIN_CAP (1u << 18)

__device__ __forceinline__ unsigned xb_ld(unsigned* p)              { return __hip_atomic_load(p, __ATOMIC_RELAXED, __HIP_MEMORY_SCOPE_AGENT); }
__device__ __forceinline__ unsigned xb_add(unsigned* p, unsigned v) { return __hip_atomic_fetch_add(p, v, __ATOMIC_RELAXED, __HIP_MEMORY_SCOPE_AGENT); }
__device__ __forceinline__ unsigned xb_xcc_id() { return (unsigned)__builtin_amdgcn_s_getreg((3 << 11) | 20) & 0xFu; }
#define XB_SPIN(cond, bar) do { unsigned _sp = 0; while (cond) { __builtin_amdgcn_s_sleep(1); \
    if ((++_sp & 255u) == 0u) { if (xb_ld(&(bar)[XB_TMO])) break; if (_sp > XB_SPIN_CAP) { atomicAdd(&(bar)[XB_TMO], 1u); break; } } } } while (0)

struct XcdBarrier {
    unsigned* bar; unsigned x;
    volatile LAS unsigned* st;
};

__device__ __forceinline__ XcdBarrier xcd_barrier_post(unsigned* bar, volatile LAS unsigned* st) {
    XcdBarrier b; b.bar = bar; b.x = xb_xcc_id(); b.st = st;
    if (threadIdx.x == 0) (void)xb_add(&bar[XB_XCNT(b.x)], 1u);
    return b;
}
__device__ __forceinline__ void xcd_barrier_complete(unsigned* bar, unsigned x, unsigned& nloc, unsigned& nx) {
    const unsigned G = gridDim.x * gridDim.y * gridDim.z;
    unsigned sum, cnt, mine, sp = 0u;
    for (;;) {
        sum = 0u; cnt = 0u; mine = 0u;
#pragma unroll
        for (unsigned j = 0; j < 16; ++j) { const unsigned c = xb_ld(&bar[XB_XCNT(j)]); sum += c; cnt += (c > 0u) ? 1u : 0u; mine = (j == x) ? c : mine; }
        if (sum == G) break;
        __builtin_amdgcn_s_sleep(1);
        if ((++sp & 255u) == 0u) { if (xb_ld(&bar[XB_TMO])) break; if (sp > XB_SPIN_CAP) { atomicAdd(&bar[XB_TMO], 1u); break; } }
    }
    nloc = mine > 0u ? mine : 1u; nx = cnt > 0u ? cnt : 1u;
}

__device__ __forceinline__ void xcd_barrier(const XcdBarrier& b) {
    asm volatile("s_waitcnt vmcnt(0)" ::: "memory");
    __syncthreads();
    if (threadIdx.x == 0) {
        unsigned* bar = b.bar;
        __builtin_amdgcn_s_waitcnt(0);
        unsigned nloc = b.st[0], nx = b.st[1];
        if (nloc == 0u) { xcd_barrier_complete(bar, b.x, nloc, nx); b.st[0] = nloc; b.st[1] = nx; }
        const unsigned old = xb_add(&bar[XB_XSUB(b.x)], 1u);
        const unsigned gen = old / nloc;
        if (old + 1u == (gen + 1u) * nloc) {
            __builtin_amdgcn_fence(__ATOMIC_RELEASE, "agent");
            asm volatile("s_waitcnt vmcnt(0)" ::: "memory");
            const unsigned og = xb_add(&bar[XB_TOP], 1u);
            const unsigned tg = og / nx;
            if (og + 1u == (tg + 1u) * nx) xb_add(&bar[XB_TOPGEN], 1u);
            else XB_SPIN(xb_ld(&bar[XB_TOPGEN]) == tg, bar);
            __builtin_amdgcn_fence(__ATOMIC_ACQUIRE, "agent");
            xb_add(&bar[XB_XGEN(b.x)], 1u);
            asm volatile("s_waitcnt vmcnt(0)" ::: "memory");
        } else {
            XB_SPIN(xb_ld(&bar[XB_XGEN(b.x)]) == gen, bar);
            __builtin_amdgcn_fence(__ATOMIC_ACQUIRE, "agent");
            asm volatile("s_waitcnt vmcnt(0)" ::: "memory");
        }
    }
    __syncthreads();
}

struct Args { const float* in[31]; float* out; unsigned char* ws; int pad[2]; };
typedef LAS unsigned long long* PtrTab;
__device__ __forceinline__ const float* tab_in(PtrTab tb, int k) { const unsigned long long v = tb[k]; const unsigned lo = __builtin_amdgcn_readfirstlane((unsigned)v), hi = __builtin_amdgcn_readfirstlane((unsigned)(v >> 32));
    return (const float*)(const GAS float*)(((unsigned long long)hi << 32) | lo); }
constexpr int TAB_OFF = 147456 - 512;
constexpr size_t WS_BAR = 768 * 1024;

__device__ __forceinline__ void phase_prologue(PtrTab TB, unsigned char* ws, float* xout, int l, LAS unsigned char* lds, int gw, int NGW, int lane, int wave) {
    LAS float* scr = (LAS float*)(lds + wave * 16384);
#define g1 (tab_in(TB, 2) + l * D)
#define w1i (tab_in(TB, 3) + (size_t)l * D * 2 * DFF)
#define w1o (tab_in(TB, 4) + (size_t)l * DFF * D)
#define gm (tab_in(TB, 5) + l * D)
#define win (tab_in(TB, 6) + (size_t)l * D * INW)
#define wpool (tab_in(TB, 9) + (size_t)l * 4 * 128 * 128)
#define psc (tab_in(TB, 10) + l * 512)
#define wua (tab_in(TB, 11) + (size_t)l * 512 * D)
#define wra (tab_in(TB, 14) + (size_t)l * 8 * 128 * 128)
#define wrx (tab_in(TB, 16) + (size_t)l * 8 * 128 * 128)
#define wub (tab_in(TB, 19) + (size_t)l * D * D)
#define wuc (tab_in(TB, 20) + (size_t)l * 512 * D)
#define wo (tab_in(TB, 21) + (size_t)l * D * D)
#define gc (tab_in(TB, 22) + l * D)
#define gmem (tab_in(TB, 23) + l * D)
#define wxq (tab_in(TB, 24) + (size_t)l * D * D)
#define wxkv (tab_in(TB, 25) + (size_t)l * D * 2 * D)
#define wxo (tab_in(TB, 26) + (size_t)l * D * D)
#define g2 (tab_in(TB, 27) + l * D)
#define w2i (tab_in(TB, 28) + (size_t)l * D * 2 * DFF)
#define w2o (tab_in(TB, 29) + (size_t)l * DFF * D)
    constexpr int I_FI = 16 * 176, I_FO = 44 * 32, I_WIN = 16 * 128, I_WG = 16 * 96, I_UB = 16 * 32, I_UC = 8 * 32, I_RG = 64, I_SQ = 16 * 32, I_KV = 16 * 64;
    constexpr int S0 = 0, S1 = S0 + I_FI, S2 = S1 + I_FO, S3 = S2 + I_WIN, S4 = S3 + I_WG, S5 = S4 + I_UB, S6 = S5 + I_UC, S7 = S6 + I_RG, S8 = S7 + I_RG, S9 = S8 + I_SQ, S10 = S9 + I_SQ,
                  S11 = S10 + I_KV, S12 = S11 + I_SQ, S13 = S12 + I_FI, S14 = S13 + I_FO;
    for (int it = gw; it < S14; it += NGW) {
        if (it < S1 || (it >= S12 && it < S13)) {
            const bool second = it >= S12; const int r = second ? it - S12 : it; const int kb = r / 176, nb = r % 176; const int n = nb * 32;
            const int half = n >= DFF ? 1 : 0, nn = n - half * DFF; const int drow = (nn >> 7) * 256 + half * 128 + (nn & 127);
            tr_item(second ? w2i : w1i, 2 * DFF, n, kb * 64, second ? g2 : g1, (bf16*)(ws + (second ? WS_W2IN : WS_W1IN)), D, drow, scr, lane);
        } else if (it < S2 || it >= S13) {
            const bool second = it >= S13; const int r = second ? it - S13 : it - S1; const int kb = r / 32, nb = r % 32;
            tr_item(second ? w2o : w1o, D, nb * 32, kb * 64, nullptr, (bf16*)(ws + (second ? WS_W2OUT : WS_W1OUT)), DFF, nb * 32, scr, lane);
        } else if (it < S3) { const int r = it - S2, kb = r / 128, nb = r % 128; tr_item(win, INW, nb * 32, kb * 64, gm, (bf16*)(ws + WS_WIN), D, nb * 32, scr, lane);
        } else if (it < S4) { const int r = it - S3, kb = r / 96, nb = r % 96; tr_item(win, INW, 4104 + nb * 32, kb * 64, gm, (bf16*)(ws + WS_WG), D, nb * 32, scr, lane);
        } else if (it < S5) { const int r = it - S4, kb = r / 32, nb = r % 32; tr_item(wub, D, nb * 32, kb * 64, nullptr, (bf16*)(ws + WS_UB), D, nb * 32, scr, lane);
        } else if (it < S6) { const int r = it - S5, kb = r / 32, nb = r % 32; tr_item(wuc, D, nb * 32, kb * 64, nullptr, (bf16*)(ws + WS_UC), 512, nb * 32, scr, lane);
        } else if (it < S8) { const bool xg = it >= S7; const int r = xg ? it - S7 : it - S6; const int hh = r >> 3, kb = (r >> 2) & 1, nb = r & 3;
            tr_item((xg ? wrx : wra) + hh * 16384, 128, nb * 32, kb * 64, nullptr, (bf16*)(ws + (xg ? WS_WXT : WS_WAT)) + hh * 16384, 128, nb * 32, scr, lane);
        } else if (it < S9) { const int r = it - S8, kb = r / 32, nb = r % 32; tr_item(wo, D, nb * 32, kb * 64, nullptr, (bf16*)(ws + WS_WO), D, nb * 32, scr, lane);
        } else if (it < S10) { const int r = it - S9, kb = r / 32, nb = r % 32; tr_item(wxq, D, nb * 32, kb * 64, gc, (bf16*)(ws + WS_WXQ), D, nb * 32, scr, lane);
        } else if (it < S11) { const int r = it - S10, kb = r / 64, nb = r % 64; tr_item(wxkv, 2 * D, nb * 32, kb * 64, nullptr, (bf16*)(ws + WS_WXKV), D, nb * 32, scr, lane);
        } else { const int r = it - S11, kb = r / 32, nb = r % 32; tr_item(wxo, D, nb * 32, kb * 64, nullptr, (bf16*)(ws + WS_WXO), D, nb * 32, scr, lane); }
    }
    { bf16* UaT = (bf16*)(ws + WS_UA);
      for (int it = gw; it < 512 * 16; it += NGW) { const int k = it >> 4, n = (it & 15) * 64 + lane, g = k >> 7, c = k & 127;
          const float* wp = wpool + ((size_t)g * 128 + c) * 128; const float* sc = psc + g * 128; const float* ua = wua + (size_t)(g * 128) * D + n; float acc = 0.f;
#pragma unroll 8
          for (int j = 0; j < 128; ++j) acc += wp[j] * sc[j] * ua[(size_t)j * D];
          UaT[(size_t)n * 512 + k] = (bf16)f2bf(acc); } }
    { float* wfl = (float*)(ws + WS_WFL);
      for (int it = gw * 64 + lane; it < 8 * 1024; it += NGW * 64) { const int h = it >> 10, k = it & 1023; wfl[it] = gm[k] * win[(size_t)k * INW + 4096 + h]; } }
    { const float* mem = tab_in(TB, 1); bf16* mn = (bf16*)(ws + WS_MEMN);
      for (int r = gw; r < 512; r += NGW) { const f32x4* xr = (const f32x4*)(mem + (size_t)r * D) + lane; f32x4 v[4]; float s = 0.f;
#pragma unroll
          for (int j = 0; j < 4; ++j) { v[j] = xr[64 * j]; s += (v[j].x * v[j].x + v[j].y * v[j].y) + (v[j].z * v[j].z + v[j].w * v[j].w); }
          const float rs = rsqrtf(wave_sum(s, lane) * (1.f / D) + 1e-6f); unsigned long long* o8 = (unsigned long long*)(mn + (size_t)r * D) + lane;
#pragma unroll
          for (int j = 0; j < 4; ++j) { const f32x4 gv = *((const f32x4*)gmem + lane + 64 * j);
              o8[64 * j] = (unsigned long long)pk2(v[j].x * rs * gv.x, v[j].y * rs * gv.y) | ((unsigned long long)pk2(v[j].z * rs * gv.z, v[j].w * rs * gv.w) << 32); } } }
    if (l == 0) {
        const float* x = tab_in(TB, 0); float* xo = xout; bf16* xb = (bf16*)(ws + WS_XB); float* ss = (float*)(ws + WS_SSP);
        for (int r = gw; r < M; r += NGW) { const f32x4* xr = (const f32x4*)(x + (size_t)r * D) + lane; f32x4* orow = (f32x4*)(xo + (size_t)r * D) + lane; f32x4 v[4]; float s = 0.f;
#pragma unroll
            for (int j = 0; j < 4; ++j) { v[j] = xr[64 * j]; orow[64 * j] = v[j]; s += (v[j].x * v[j].x + v[j].y * v[j].y) + (v[j].z * v[j].z + v[j].w * v[j].w); }
            s = wave_sum(s, lane); if (lane < 16) ss[(size_t)r * 16 + lane] = lane == 0 ? s : 0.f; unsigned long long* o8 = (unsigned long long*)(xb + (size_t)r * D) + lane;
#pragma unroll
            for (int j = 0; j < 4; ++j) o8[64 * j] = (unsigned long long)pk2(v[j].x, v[j].y) | ((unsigned long long)pk2(v[j].z, v[j].w) << 32); }
    }
}
#undef g1
#undef w1i
#undef w1o
#undef gm
#undef win
#undef wpool
#undef psc
#undef wua
#undef wra
#undef wrx
#undef wub
#undef wuc
#undef wo
#undef gc
#undef gmem
#undef wxq
#undef wxkv
#undef wxo
#undef g2
#undef w2i
#undef w2o
__device__ __forceinline__ void phase_fl(const bf16* xb, const float* wfl, const float* bfv, const float* ss, float* logf, int gw, int NGW, int lane) {
    for (int r = gw; r < M; r += NGW) {
        float acc[8];
#pragma unroll
        for (int h = 0; h < 8; ++h) acc[h] = 0.f;
#pragma unroll
        for (int j = 0; j < 2; ++j) { const int k0 = 8 * lane + 512 * j; const v4u xv = *(const v4u*)(xb + (size_t)r * D + k0);
            float xf[8]; xf[0] = __uint_as_float(xv.x << 16); xf[1] = __uint_as_float(xv.x & 0xffff0000u); xf[2] = __uint_as_float(xv.y << 16); xf[3] = __uint_as_float(xv.y & 0xffff0000u);
            xf[4] = __uint_as_float(xv.z << 16); xf[5] = __uint_as_float(xv.z & 0xffff0000u); xf[6] = __uint_as_float(xv.w << 16); xf[7] = __uint_as_float(xv.w & 0xffff0000u);
#pragma unroll
            for (int h = 0; h < 8; ++h) { const f32x4 w0 = *(const f32x4*)(wfl + h * 1024 + k0), w1 = *(const f32x4*)(wfl + h * 1024 + k0 + 4);
                acc[h] += (xf[0] * w0.x + xf[1] * w0.y) + (xf[2] * w0.z + xf[3] * w0.w) + (xf[4] * w1.x + xf[5] * w1.y) + (xf[6] * w1.z + xf[7] * w1.w); } }
        const float rs = pg8::rstd_of(ss, r);
#pragma unroll
        for (int h = 0; h < 8; ++h) { const float z = wave_sum(acc[h], lane) * rs + bfv[h]; const float ls = -(fmaxf(-z, 0.f) + flog1p(__expf(-fabsf(z)))); if (lane == h) logf[(size_t)r * 8 + h] = ls; }
    }
}
__device__ __forceinline__ void cumsum_bh(const float* logf, float* ctil, int bh, int lane) {
    const int b = bh >> 3, h = bh & 7; const float* src = logf + ((size_t)b * SEQ + 128 * lane) * 8 + h; float s = 0.f;
#pragma unroll 16
    for (int i = 0; i < 128; ++i) s += src[(size_t)i * 8];
    float incl = s;
#pragma unroll
    for (int o = 1; o < 64; o <<= 1) { const float t = bperm(incl, lane - o); if (lane >= o) incl += t; }
    float run = incl - s; float* dst = ctil + (size_t)bh * SEQ + 128 * lane;
#pragma unroll 16
    for (int i = 0; i < 128; ++i) { run += src[(size_t)i * 8]; dst[i] = run * 1.4426950408889634f; }
}
__device__ __forceinline__ void phase_pool(const bf16* xa, bf16* ya, int gtid, int nthr) {
    for (int idx = gtid; idx < M * 64; idx += nthr) { const int m = idx >> 6, cgi = idx & 63, t = m & (SEQ - 1), w = 2 << (cgi >> 4), cnt = (t + 1 < w) ? t + 1 : w;
        float s[8], cur[8];
#pragma unroll
        for (int i = 0; i < 8; ++i) s[i] = 0.f;
        for (int j = 0; j < cnt; ++j) { const v4u xv = *(const v4u*)(xa + (size_t)(m - j) * 512 + 8 * cgi);
            float xf[8]; xf[0] = __uint_as_float(xv.x << 16); xf[1] = __uint_as_float(xv.x & 0xffff0000u); xf[2] = __uint_as_float(xv.y << 16); xf[3] = __uint_as_float(xv.y & 0xffff0000u);
            xf[4] = __uint_as_float(xv.z << 16); xf[5] = __uint_as_float(xv.z & 0xffff0000u); xf[6] = __uint_as_float(xv.w << 16); xf[7] = __uint_as_float(xv.w & 0xffff0000u);
#pragma unroll
            for (int i = 0; i < 8; ++i) { s[i] += xf[i]; if (j == 0) cur[i] = xf[i]; } }
        const float ic = 1.f / (float)cnt; v4u o;
        o.x = pk2(s[0] * ic - cur[0], s[1] * ic - cur[1]); o.y = pk2(s[2] * ic - cur[2], s[3] * ic - cur[3]); o.z = pk2(s[4] * ic - cur[4], s[5] * ic - cur[5]); o.w = pk2(s[6] * ic - cur[6], s[7] * ic - cur[7]);
        *(v4u*)(ya + (size_t)m * 512 + 8 * cgi) = o; }
}
__device__ __forceinline__ int crow16(int r, int hi) { return (r & 3) + 8 * (r >> 2) + 4 * hi; }
template <bool FINAL>
__device__ __forceinline__ void lru_item(LAS unsigned char* lds, int b, int hp, int ck, const bf16* xl, bf16* gg, const float* cw, const float* cb, const bf16* WaT, const bf16* WxT,
                                         const float* ba, const float* bx, const float* lam, float* summ) {
    int tid_o = threadIdx.x; asm volatile("" : "+v"(tid_o)); const int tid = tid_o, lane = tid & 63, wid = tid >> 6, r32 = lane & 31, hi = lane >> 5;
    const int t0 = ck * 128; const size_t m0 = (size_t)b * SEQ + t0; const int ch0 = hp * 256;
    constexpr int XP = 264;
    LAS bf16* xc = (LAS bf16*)lds; LAS float* h0s = (LAS float*)(lds + 128 * XP * 2);
    {
        const int cgi = tid & 31, tq = tid >> 5, c = ch0 + 8 * cgi;
        float w[4][8], bb[8];
#pragma unroll
        for (int k = 0; k < 4; ++k) { const f32x4 a = *(const f32x4*)(cw + k * 1024 + c), d = *(const f32x4*)(cw + k * 1024 + c + 4); w[k][0] = a.x; w[k][1] = a.y; w[k][2] = a.z; w[k][3] = a.w; w[k][4] = d.x; w[k][5] = d.y; w[k][6] = d.z; w[k][7] = d.w; }
        { const f32x4 a = *(const f32x4*)(cb + c), d = *(const f32x4*)(cb + c + 4); bb[0] = a.x; bb[1] = a.y; bb[2] = a.z; bb[3] = a.w; bb[4] = d.x; bb[5] = d.y; bb[6] = d.z; bb[7] = d.w; }
        v4u rw[11];
#pragma unroll
        for (int i = 0; i < 11; ++i) { const int tl = tq * 8 - 3 + i; rw[i] = (t0 + tl >= 0) ? *(const v4u*)(xl + (size_t)((long)m0 + tl) * 1024 + c) : (v4u){0u, 0u, 0u, 0u}; }
#pragma unroll
        for (int o = 0; o < 8; ++o) { float y[8];
#pragma unroll
            for (int j = 0; j < 8; ++j) y[j] = bb[j];
#pragma unroll
            for (int k = 0; k < 4; ++k) { const v4u xv = rw[o + k];
                y[0] += w[k][0] * __uint_as_float(xv.x << 16); y[1] += w[k][1] * __uint_as_float(xv.x & 0xffff0000u); y[2] += w[k][2] * __uint_as_float(xv.y << 16); y[3] += w[k][3] * __uint_as_float(xv.y & 0xffff0000u);
                y[4] += w[k][4] * __uint_as_float(xv.z << 16); y[5] += w[k][5] * __uint_as_float(xv.z & 0xffff0000u); y[6] += w[k][6] * __uint_as_float(xv.w << 16); y[7] += w[k][7] * __uint_as_float(xv.w & 0xffff0000u); }
            v4u ov; ov.x = pk2(y[0], y[1]); ov.y = pk2(y[2], y[3]); ov.z = pk2(y[4], y[5]); ov.w = pk2(y[6], y[7]);
            *(LAS v4u*)(xc + (tq * 8 + o) * XP + 8 * cgi) = ov; }
    }
    if (FINAL && tid < 256) {
        const float* sp = summ + ((size_t)b * 64 * 1024 + ch0 + tid) * 2; float h = 0.f;
#pragma unroll 8
        for (int c2 = 0; c2 < ck; ++c2) { const float2 v = *(const float2*)(sp + (size_t)c2 * 2048); h = v.x * h + v.y; }
        h0s[tid] = h;
    }
    __syncthreads();
    const int hh = wid >> 2, s = wid & 3, chl = 128 * hh + 32 * s + r32, ch = ch0 + chl, head = 2 * hp + hh;
    const float bav = ba[ch], bxv = bx[ch]; const float nl = -lam[ch]; const float sp8 = 8.f * (fmaxf(nl, 0.f) + flog1p(__expf(-fabsf(nl))));
    bf16x8 fa[8], fx[8];
#pragma unroll
    for (int ks = 0; ks < 8; ++ks) { fa[ks] = *(const bf16x8*)(WaT + (size_t)head * 16384 + (32 * s + r32) * 128 + 16 * ks + 8 * hi); fx[ks] = *(const bf16x8*)(WxT + (size_t)head * 16384 + (32 * s + r32) * 128 + 16 * ks + 8 * hi); }
    float hrun = FINAL ? h0s[chl] : 0.f, Arun = 1.f;
    for (int mb = 0; mb < 4; ++mb) {
        f32x16 accA = {0.f, 0.f, 0.f, 0.f, 0.f, 0.f, 0.f, 0.f, 0.f, 0.f, 0.f, 0.f, 0.f, 0.f, 0.f, 0.f}, accX = accA;
#pragma unroll
        for (int ks = 0; ks < 8; ++ks) { const bf16x8 af = *(const LAS bf16x8*)(xc + (32 * mb + r32) * XP + 128 * hh + 16 * ks + 8 * hi);
            accA = __builtin_amdgcn_mfma_f32_32x32x16_bf16(af, fa[ks], accA, 0, 0, 0); accX = __builtin_amdgcn_mfma_f32_32x32x16_bf16(af, fx[ks], accX, 0, 0, 0); }
        float a[16], u[16];
#pragma unroll
        for (int r = 0; r < 16; ++r) { const int tok = 32 * mb + crow16(r, hi); const float xcv = bf2f(xc[tok * XP + chl]);
            const float rg = pg8::fsig(accA[r] + bav), la = -rg * sp8, av = __expf(la), mult = sqrtf(fmaxf(1.f - __expf(2.f * la), 0.f)), ig = pg8::fsig(accX[r] + bxv);
            a[r] = av; u[r] = mult * ig * xcv; }
        float As[4], Hs[4], Ap[4], Hp[4], hin[4];
#pragma unroll
        for (int g = 0; g < 4; ++g) { float Aq = 1.f, Hq = 0.f;
#pragma unroll
            for (int i = 0; i < 4; ++i) { Hq = a[4 * g + i] * Hq + u[4 * g + i]; Aq *= a[4 * g + i]; }
            As[g] = Aq; Hs[g] = Hq; Ap[g] = bperm(Aq, lane ^ 32); Hp[g] = bperm(Hq, lane ^ 32); }
#pragma unroll
        for (int g = 0; g < 4; ++g) { const float A0 = hi ? Ap[g] : As[g], H0 = hi ? Hp[g] : Hs[g], A1 = hi ? As[g] : Ap[g], H1 = hi ? Hs[g] : Hp[g];
            const float hA = hrun, hB = A0 * hA + H0; hrun = A1 * hB + H1; Arun *= A0 * A1; hin[g] = hi ? hB : hA; }
        if (FINAL) {
#pragma unroll
            for (int g = 0; g < 4; ++g) { float hc = hin[g];
#pragma unroll
                for (int i = 0; i < 4; ++i) { const int r = 4 * g + i; hc = a[r] * hc + u[r]; bf16* p = gg + (m0 + 32 * mb + crow16(r, hi)) * 1024 + ch; *p = (bf16)f2bf(hc * bf2f(*p)); } }
        }
    }
    if (!FINAL && hi == 0) { float* sp = summ + (((size_t)b * 64 + ck) * 1024 + ch) * 2; sp[0] = Arun; sp[1] = hrun; }
    __syncthreads();
}
__device__ __forceinline__ void phase_final(float* x, const float* g, int gw, int NGW, int lane) {
    for (int r = gw; r < M; r += NGW) { f32x4* xr = (f32x4*)(x + (size_t)r * D) + lane; f32x4 v[4]; float s = 0.f;
#pragma unroll
        for (int j = 0; j < 4; ++j) { v[j] = xr[64 * j]; s += (v[j].x * v[j].x + v[j].y * v[j].y) + (v[j].z * v[j].z + v[j].w * v[j].w); }
        const float rs = rsqrtf(wave_sum(s, lane) * (1.f / D) + 1e-6f);
#pragma unroll
        for (int j = 0; j < 4; ++j) { const f32x4 gv = *((const f32x4*)g + lane + 64 * j); xr[64 * j] = (f32x4){v[j].x * rs * gv.x, v[j].y * rs * gv.y, v[j].z * rs * gv.z, v[j].w * rs * gv.w}; } }
}
constexpr float FOX_C2 = 0.125f * 1.4426950408889634f;
constexpr int FOX_KP = 72;
constexpr int FOX_BUF = 2 * 64 * FOX_KP * 2 + 256;
__device__ __forceinline__ void fox_unit(LAS unsigned char* lds, int b, int h, int qb, const bf16* Q, const bf16* K, const bf16* V, bf16* O, const float* ct) {
    int tid_o = threadIdx.x; asm volatile("" : "+v"(tid_o)); const int tid = tid_o, lane = tid & 63, wid = tid >> 6, r32 = lane & 31, hi = lane >> 5;
    const size_t rowbase = (size_t)b * SEQ; const int q0 = qb * 256, NT = 4 * qb + 4;
    const bf16* Qw = Q + (rowbase + q0 + wid * 32 + r32) * 512 + h * 64;
    bf16x8 qr[4];
#pragma unroll
    for (int d0 = 0; d0 < 4; ++d0) qr[d0] = *(const bf16x8*)(Qw + 16 * d0 + 8 * hi);
    const int skey = tid >> 3, sd = (tid & 7) * 8;
    const bf16* kp = K + (rowbase + skey) * 512 + h * 64 + sd; const bf16* vp = V + (rowbase + skey) * 512 + h * 64 + sd;
    v4u kreg = *(const v4u*)kp, vreg = *(const v4u*)vp; float creg = (tid < 64) ? ct[tid] : 0.f;
    __syncthreads();
    { LAS bf16* Ks = (LAS bf16*)lds; LAS bf16* Vt = Ks + 64 * FOX_KP; LAS float* Cs = (LAS float*)(lds + 2 * 64 * FOX_KP * 2);
      *(LAS v4u*)(Ks + skey * FOX_KP + sd) = kreg;
      Vt[(sd + 0) * FOX_KP + skey] = (bf16)(vreg.x & 0xffffu); Vt[(sd + 1) * FOX_KP + skey] = (bf16)(vreg.x >> 16); Vt[(sd + 2) * FOX_KP + skey] = (bf16)(vreg.y & 0xffffu); Vt[(sd + 3) * FOX_KP + skey] = (bf16)(vreg.y >> 16);
      Vt[(sd + 4) * FOX_KP + skey] = (bf16)(vreg.z & 0xffffu); Vt[(sd + 5) * FOX_KP + skey] = (bf16)(vreg.z >> 16); Vt[(sd + 6) * FOX_KP + skey] = (bf16)(vreg.w & 0xffffu); Vt[(sd + 7) * FOX_KP + skey] = (bf16)(vreg.w >> 16);
      if (tid < 64) Cs[tid] = creg; }
    if (NT > 1) { kreg = *(const v4u*)(kp + (size_t)64 * 512); vreg = *(const v4u*)(vp + (size_t)64 * 512); if (tid < 64) creg = ct[64 + tid]; }
    float m = -1e30f, l = 0.f; f32x16 o0, o1;
#pragma unroll
    for (int r = 0; r < 16; ++r) { o0[r] = 0.f; o1[r] = 0.f; }
    for (int t = 0; t < NT; ++t) {
        __syncthreads();
        if (t + 1 < NT) { LAS unsigned char* bufn = lds + ((t + 1) & 1) * FOX_BUF; LAS bf16* Ks = (LAS bf16*)bufn; LAS bf16* Vt = Ks + 64 * FOX_KP; LAS float* Cs = (LAS float*)(bufn + 2 * 64 * FOX_KP * 2);
            *(LAS v4u*)(Ks + skey * FOX_KP + sd) = kreg;
            Vt[(sd + 0) * FOX_KP + skey] = (bf16)(vreg.x & 0xffffu); Vt[(sd + 1) * FOX_KP + skey] = (bf16)(vreg.x >> 16); Vt[(sd + 2) * FOX_KP + skey] = (bf16)(vreg.y & 0xffffu); Vt[(sd + 3) * FOX_KP + skey] = (bf16)(vreg.y >> 16);
            Vt[(sd + 4) * FOX_KP + skey] = (bf16)(vreg.z & 0xffffu); Vt[(sd + 5) * FOX_KP + skey] = (bf16)(vreg.z >> 16); Vt[(sd + 6) * FOX_KP + skey] = (bf16)(vreg.w & 0xffffu); Vt[(sd + 7) * FOX_KP + skey] = (bf16)(vreg.w >> 16);
            if (tid < 64) Cs[tid] = creg;
            if (t + 2 < NT) { kreg = *(const v4u*)(kp + (size_t)(t + 2) * 64 * 512); vreg = *(const v4u*)(vp + (size_t)(t + 2) * 64 * 512); if (tid < 64) creg = ct[64 * (t + 2) + tid]; } }
        const int jb = t - (NT - 4);
        if (jb >= 0 && 64 * jb > 32 * wid + 31) continue;
        LAS unsigned char* buf = lds + (t & 1) * FOX_BUF; const LAS bf16* Ks = (const LAS bf16*)buf; const LAS bf16* Vt = Ks + 64 * FOX_KP; const LAS float* Cs = (const LAS float*)(buf + 2 * 64 * FOX_KP * 2);
        f32x16 p0, p1;
#pragma unroll
        for (int g = 0; g < 4; ++g) { const f32x4 a = *(const LAS f32x4*)(Cs + 8 * g + 4 * hi), c = *(const LAS f32x4*)(Cs + 32 + 8 * g + 4 * hi);
            p0[4 * g + 0] = -a[0]; p0[4 * g + 1] = -a[1]; p0[4 * g + 2] = -a[2]; p0[4 * g + 3] = -a[3]; p1[4 * g + 0] = -c[0]; p1[4 * g + 1] = -c[1]; p1[4 * g + 2] = -c[2]; p1[4 * g + 3] = -c[3]; }
#pragma unroll
        for (int d0 = 0; d0 < 4; ++d0) { const bf16x8 a0 = *(const LAS bf16x8*)(Ks + r32 * FOX_KP + 16 * d0 + 8 * hi), a1 = *(const LAS bf16x8*)(Ks + (32 + r32) * FOX_KP + 16 * d0 + 8 * hi);
            p0 = __builtin_amdgcn_mfma_f32_32x32x16_bf16(a0, qr[d0], p0, 0, 0, 0); p1 = __builtin_amdgcn_mfma_f32_32x32x16_bf16(a1, qr[d0], p1, 0, 0, 0); }
        if (jb >= 0) { const int qrel = 32 * wid + r32, kb = 64 * jb + 4 * hi;
#pragma unroll
            for (int r = 0; r < 16; ++r) { const int kv = kb + (r & 3) + 8 * (r >> 2); if (kv > qrel) p0[r] = -__builtin_inff(); if (kv + 32 > qrel) p1[r] = -__builtin_inff(); } }
        float mx = fmaxf(p0[0], p1[0]);
#pragma unroll
        for (int r = 1; r < 16; ++r) mx = fmaxf(mx, fmaxf(p0[r], p1[r]));
        mx = fmaxf(mx, bperm(mx, lane ^ 32));
        const float mn = fmaxf(m, mx), alpha = __builtin_amdgcn_exp2f(m - mn); m = mn;
        float sum = 0.f;
#pragma unroll
        for (int r = 0; r < 16; ++r) { p0[r] = __builtin_amdgcn_exp2f(p0[r] - mn); p1[r] = __builtin_amdgcn_exp2f(p1[r] - mn); sum += p0[r] + p1[r]; }
        l = l * alpha + sum;
#pragma unroll
        for (int r = 0; r < 16; ++r) { o0[r] *= alpha; o1[r] *= alpha; }
        bf16x8 pb[4];
        { v4u w;
          w.x = pg8::cvt_pk_bf16(p0[0], p0[1]); w.y = pg8::cvt_pk_bf16(p0[2], p0[3]); w.z = pg8::cvt_pk_bf16(p0[4], p0[5]); w.w = pg8::cvt_pk_bf16(p0[6], p0[7]); pb[0] = __builtin_bit_cast(bf16x8, w);
          w.x = pg8::cvt_pk_bf16(p0[8], p0[9]); w.y = pg8::cvt_pk_bf16(p0[10], p0[11]); w.z = pg8::cvt_pk_bf16(p0[12], p0[13]); w.w = pg8::cvt_pk_bf16(p0[14], p0[15]); pb[1] = __builtin_bit_cast(bf16x8, w);
          w.x = pg8::cvt_pk_bf16(p1[0], p1[1]); w.y = pg8::cvt_pk_bf16(p1[2], p1[3]); w.z = pg8::cvt_pk_bf16(p1[4], p1[5]); w.w = pg8::cvt_pk_bf16(p1[6], p1[7]); pb[2] = __builtin_bit_cast(bf16x8, w);
          w.x = pg8::cvt_pk_bf16(p1[8], p1[9]); w.y = pg8::cvt_pk_bf16(p1[10], p1[11]); w.z = pg8::cvt_pk_bf16(p1[12], p1[13]); w.w = pg8::cvt_pk_bf16(p1[14], p1[15]); pb[3] = __builtin_bit_cast(bf16x8, w); }
#pragma unroll
        for (int mm = 0; mm < 4; ++mm) {
            typedef unsigned u32x2v __attribute__((ext_vector_type(2)));
            const u32x2v a0l = *(const LAS u32x2v*)(Vt + r32 * FOX_KP + 16 * mm + 4 * hi), a0h = *(const LAS u32x2v*)(Vt + r32 * FOX_KP + 16 * mm + 8 + 4 * hi);
            const u32x2v a1l = *(const LAS u32x2v*)(Vt + (32 + r32) * FOX_KP + 16 * mm + 4 * hi), a1h = *(const LAS u32x2v*)(Vt + (32 + r32) * FOX_KP + 16 * mm + 8 + 4 * hi);
            const v4u A0 = {a0l.x, a0l.y, a0h.x, a0h.y}, A1 = {a1l.x, a1l.y, a1h.x, a1h.y};
            o0 = __builtin_amdgcn_mfma_f32_32x32x16_bf16(__builtin_bit_cast(bf16x8, A0), pb[mm], o0, 0, 0, 0);
            o1 = __builtin_amdgcn_mfma_f32_32x32x16_bf16(__builtin_bit_cast(bf16x8, A1), pb[mm], o1, 0, 0, 0); }
    }
    l += bperm(l, lane ^ 32); const float inv = 1.f / l;
    bf16* Ow = O + (rowbase + q0 + wid * 32 + r32) * 512 + h * 64;
#pragma unroll
    for (int g = 0; g < 4; ++g) { typedef unsigned u32x2v __attribute__((ext_vector_type(2)));
        u32x2v w0, w1; w0.x = pg8::cvt_pk_bf16(o0[4 * g] * inv, o0[4 * g + 1] * inv); w0.y = pg8::cvt_pk_bf16(o0[4 * g + 2] * inv, o0[4 * g + 3] * inv);
        w1.x = pg8::cvt_pk_bf16(o1[4 * g] * inv, o1[4 * g + 1] * inv); w1.y = pg8::cvt_pk_bf16(o1[4 * g + 2] * inv, o1[4 * g + 3] * inv);
        *(u32x2v*)(Ow + 8 * g + 4 * hi) = w0; *(u32x2v*)(Ow + 32 + 8 * g + 4 * hi) = w1; }
    __syncthreads();
}
__global__ void __launch_bounds__(NTHR, 2) hybrid_fwd(Args args) {
    extern __shared__ __attribute__((aligned(16))) unsigned char lds_raw[];
    cg::grid_group grid = cg::this_grid();
    LAS unsigned char* lds = (LAS unsigned char*)lds_raw;
    int tid = threadIdx.x, lane = tid & 63, wave = __builtin_amdgcn_readfirstlane(tid >> 6);
    int G = gridDim.x, bx = blockIdx.x;
    int vcu = (G % 8 == 0) ? (bx % 8) * (G / 8) + bx / 8 : bx;
    int gw = vcu * NWAVES + wave; int NGW = G * NWAVES;
    PtrTab TB = (PtrTab)(lds + TAB_OFF);
    if (tid == 0) {
#pragma unroll
        for (int i = 0; i < 31; ++i) TB[i] = (unsigned long long)args.in[i];
    }
    if (tid == 1) { TB[40] = 0ull; }
    __syncthreads();
    (void)xcd_barrier_post((unsigned*)(args.ws + WS_BAR), (volatile LAS unsigned*)(lds + TAB_OFF + 320));
    grid.sync();
    unsigned char* ws = args.ws;
    float* X = args.out;
    float* SS = (float*)(ws + WS_SSP);
    bf16* XB = (bf16*)(ws + WS_XB);
    bf16* HB = (bf16*)(ws + WS_H);
    constexpr float C2X = 0.0625f * 1.4426950408889634f;
#define GSYNC() do { asm volatile("s_waitcnt vmcnt(0) lgkmcnt(0)" ::: "memory"); { XcdBarrier xb_; xb_.bar = (unsigned*)(ws + WS_BAR); xb_.x = xb_xcc_id(); xb_.st = (volatile LAS unsigned*)(lds + TAB_OFF + 320); xcd_barrier(xb_); } tid = threadIdx.x; asm volatile("" : "+v"(tid)); lane = tid & 63; wave = __builtin_amdgcn_readfirstlane(tid >> 6); G = gridDim.x; bx = blockIdx.x; asm volatile("" : "+s"(G), "+s"(bx)); vcu = (G % 8 == 0) ? (bx % 8) * (G / 8) + bx / 8 : bx; gw = vcu * NWAVES + wave; NGW = G * NWAVES; { unsigned long long wsi_ = (unsigned long long)ws; asm volatile("" : "+s"(wsi_)); ws = (unsigned char*)(GAS unsigned char*)wsi_; } } while (0)

    for (int l = 0; l < DEPTH; ++l) {
        float* ss0 = SS + (size_t)(4 * l + 0) * M * 16; float* ss1 = SS + (size_t)(4 * l + 1) * M * 16; float* ss2 = SS + (size_t)(4 * l + 2) * M * 16; float* ss3 = SS + (size_t)(4 * l + 3) * M * 16; float* ss4 = SS + (size_t)(4 * l + 4) * M * 16;
        phase_prologue(TB, ws, X, l, lds, gw, NGW, lane, wave);
        GSYNC();
        { pg8::Gemm g{XB, (const bf16*)(ws + WS_W1IN), M, 2 * DFF, D, D, D, 0}; pg8::StaticOrder S; S.init(M, 2 * DFF, G, bx);
          pg8::EpiSwiglu E{HB, ss0, DFF};
          pg8::gemm_phase<pg8::EpiSwiglu, pg8::StaticOrder, true, true>(lds, g, S, E); }
        if (bx >= G / 2) { pg8::Gemm g{(const bf16*)(ws + WS_MEMN), (const bf16*)(ws + WS_WXKV), 512, 2 * D, D, D, D, 0}; pg8::StaticOrder S; S.init(512, 2 * D, G, bx - G / 2);
          pg8::EpiKV E{(bf16*)(ws + WS_KX), (bf16*)(ws + WS_VT)};
          pg8::gemm_phase<pg8::EpiKV, pg8::StaticOrder, true, true>(lds, g, S, E); }
        GSYNC();
        { pg8::Gemm g{HB, (const bf16*)(ws + WS_W1OUT), M, D, DFF, DFF, DFF, 0}; pg8::StaticOrder S; S.init(M, D, G, bx);
          pg8::EpiResid E{X, XB, ss1, 0.5f};
          pg8::gemm_phase<pg8::EpiResid, pg8::StaticOrder, true, true>(lds, g, S, E); }
        GSYNC();
        { pg8::Gemm g{XB, (const bf16*)(ws + WS_WIN), M, 4096, D, D, D, 0}; pg8::StaticOrder S; S.init(M, 4096, G, bx);
          pg8::EpiWin E{(bf16*)(ws + WS_XA), (bf16*)(ws + WS_XL), (bf16*)(ws + WS_GG), (bf16*)(ws + WS_Q), (bf16*)(ws + WS_K), (bf16*)(ws + WS_V), ss1, FOX_C2};
          pg8::gemm_phase<pg8::EpiWin, pg8::StaticOrder, true, true>(lds, g, S, E); }
        phase_fl(XB, (const float*)(ws + WS_WFL), tab_in(TB, 7) + l * 8, ss1, (float*)(ws + WS_LOGF), gw, NGW, lane);
        GSYNC();
        if (wave == 0 && vcu < 16) cumsum_bh((const float*)(ws + WS_LOGF), (float*)(ws + WS_CTIL), vcu, lane);
        __syncthreads();
        for (int it = vcu; it < 512; it += G)
            lru_item<false>(lds, it >> 8, (it >> 6) & 3, it & 63, (const bf16*)(ws + WS_XL), (bf16*)(ws + WS_GG), tab_in(TB, 12) + (size_t)l * 4 * D, tab_in(TB, 13) + l * D, (const bf16*)(ws + WS_WAT), (const bf16*)(ws + WS_WXT),
                            tab_in(TB, 15) + l * D, tab_in(TB, 17) + l * D, tab_in(TB, 18) + l * D, (float*)(ws + WS_SUMM));
        phase_pool((const bf16*)(ws + WS_XA), (bf16*)(ws + WS_YA), vcu * NTHR + tid, G * NTHR);
        GSYNC();
        for (int it = vcu; it < 512; it += G)
            lru_item<true>(lds, it >> 8, (it >> 6) & 3, it & 63, (const bf16*)(ws + WS_XL), (bf16*)(ws + WS_GG), tab_in(TB, 12) + (size_t)l * 4 * D, tab_in(TB, 13) + l * D, (const bf16*)(ws + WS_WAT), (const bf16*)(ws + WS_WXT),
                           tab_in(TB, 15) + l * D, tab_in(TB, 17) + l * D, tab_in(TB, 18) + l * D, (float*)(ws + WS_SUMM));
        for (int p = vcu; p < 256; p += G) { const int bh = p >> 4, s = p & 15;
            fox_unit(lds, bh >> 3, bh & 7, s, (const bf16*)(ws + WS_Q), (const bf16*)(ws + WS_K), (const bf16*)(ws + WS_V), (bf16*)(ws + WS_YC), (const float*)(ws + WS_CTIL) + (size_t)bh * SEQ);
            fox_unit(lds, bh >> 3, bh & 7, 31 - s, (const bf16*)(ws + WS_Q), (const bf16*)(ws + WS_K), (const bf16*)(ws + WS_V), (bf16*)(ws + WS_YC), (const float*)(ws + WS_CTIL) + (size_t)bh * SEQ); }
        GSYNC();
        { pg8::StaticOrder S; S.init(M, D, G, bx); pg8::Unit u;
          bf16* stash = (bf16*)(ws + WS_STASH) + (size_t)bx * 65536; bf16* mg = (bf16*)(ws + WS_MG);
          for (int i = 0; S.next(i, u); ++i) { const pg8::OneUnit O1{u.pm, u.pn};
#pragma unroll 1
              for (int br = 0; br < 3; ++br) {
                  { pg8::Gemm g{XB, (const bf16*)(ws + WS_WG) + (size_t)br * D * D, M, D, D, D, D, 0}; pg8::EpiGate E{stash, tab_in(TB, 8) + (size_t)l * 3 * D + br * D, ss1};
                    pg8::gemm_phase<pg8::EpiGate, pg8::OneUnit, true, true>(lds, g, O1, E); }
                  asm volatile("s_waitcnt vmcnt(0)" ::: "memory"); __builtin_amdgcn_fence(__ATOMIC_ACQUIRE, "agent"); __syncthreads();
                  const bf16* Ab = br == 0 ? (const bf16*)(ws + WS_YA) : br == 1 ? (const bf16*)(ws + WS_GG) : (const bf16*)(ws + WS_YC);
                  const bf16* Ub = br == 0 ? (const bf16*)(ws + WS_UA) : br == 1 ? (const bf16*)(ws + WS_UB) : (const bf16*)(ws + WS_UC);
                  const int Kb = br == 1 ? 1024 : 512;
                  { pg8::Gemm g{Ab, Ub, M, D, Kb, Kb, Kb, 0}; pg8::EpiMerge E{stash, mg, br == 0 ? 1 : 0};
                    pg8::gemm_phase<pg8::EpiMerge, pg8::OneUnit, true, true>(lds, g, O1, E); }
                  asm volatile("s_waitcnt vmcnt(0)" ::: "memory"); __builtin_amdgcn_fence(__ATOMIC_ACQUIRE, "agent"); __syncthreads();
              } } }
        GSYNC();
        { pg8::Gemm g{(const bf16*)(ws + WS_MG), (const bf16*)(ws + WS_WO), M, D, D, D, D, 0}; pg8::StaticOrder S; S.init(M, D, G, bx);
          pg8::EpiResid E{X, XB, ss2, 1.0f};
          pg8::gemm_phase<pg8::EpiResid, pg8::StaticOrder, true, true>(lds, g, S, E); }
        GSYNC();
        { pg8::Gemm g{XB, (const bf16*)(ws + WS_WXQ), M, D, D, D, D, 0}; pg8::StaticOrder S; S.init(M, D, G, bx);
          pg8::EpiRs E{(bf16*)(ws + WS_QX), D, ss2, C2X};
          pg8::gemm_phase<pg8::EpiRs, pg8::StaticOrder, true, true>(lds, g, S, E); }
        GSYNC();
        { bf16* pb = (bf16*)(ws + WS_PBUF) + (size_t)bx * 65536; const pg8::OneUnit O1{0, 0};
          for (int uid = vcu; uid < 256; uid += G) { const int rt = uid >> 2, h = uid & 3, b = rt >> 5;
              int KX = 256; asm volatile("" : "+s"(KX));
              bf16* qo = (bf16*)(ws + WS_QX) + (size_t)rt * 256 * D + h * 256;
              { pg8::Gemm g{qo, (const bf16*)(ws + WS_KX) + (size_t)b * 256 * D + h * 256, 256, 256, KX, D, D, 0}; pg8::EpiSoftmaxP E{pb};
                pg8::gemm_phase<pg8::EpiSoftmaxP, pg8::OneUnit, false, true>(lds, g, O1, E); }
              asm volatile("s_waitcnt vmcnt(0)" ::: "memory"); __builtin_amdgcn_fence(__ATOMIC_ACQUIRE, "agent"); __syncthreads();
              { pg8::Gemm g{pb, (const bf16*)(ws + WS_VT) + (size_t)(b * 4 + h) * 65536, 256, 256, KX, 256, 256, 0}; pg8::EpiRs E{qo, D, nullptr, 1.0f};
                pg8::gemm_phase<pg8::EpiRs, pg8::OneUnit, true, true>(lds, g, O1, E); }
              asm volatile("s_waitcnt vmcnt(0)" ::: "memory"); __syncthreads();
          } }
        GSYNC();
        { pg8::Gemm g{(const bf16*)(ws + WS_QX), (const bf16*)(ws + WS_WXO), M, D, D, D, D, 0}; pg8::StaticOrder S; S.init(M, D, G, bx);
          pg8::EpiResid E{X, XB, ss3, 1.0f};
          pg8::gemm_phase<pg8::EpiResid, pg8::StaticOrder, true, true>(lds, g, S, E); }
        GSYNC();
        { pg8::Gemm g{XB, (const bf16*)(ws + WS_W2IN), M, 2 * DFF, D, D, D, 0}; pg8::StaticOrder S; S.init(M, 2 * DFF, G, bx);
          pg8::EpiSwiglu E{HB, ss3, DFF};
          pg8::gemm_phase<pg8::EpiSwiglu, pg8::StaticOrder, true, true>(lds, g, S, E); }
        GSYNC();
        { pg8::Gemm g{HB, (const bf16*)(ws + WS_W2OUT), M, D, DFF, DFF, DFF, 0}; pg8::StaticOrder S; S.init(M, D, G, bx);
          pg8::EpiResid E{X, XB, ss4, 0.5f};
          pg8::gemm_phase<pg8::EpiResid, pg8::StaticOrder, true, true>(lds, g, S, E); }
        GSYNC();
    }
    phase_final(X, tab_in(TB, 30), gw, NGW, lane);
#undef GSYNC
}

extern "C" void kernel_launch(void* const* d_in, const int* in_sizes, int n_in, void* d_out, int out_size, void* d_ws, size_t ws_size, hipStream_t stream) {
    static int grid = 0;
    if (grid == 0) {
        if (n_in != 31 || out_size != M * D || ws_size < WS_END) { fprintf(stderr, "kernel_launch: unexpected problem (n_in %d, out %d, ws %zu)\n", n_in, out_size, ws_size); grid = -1; return; }
        int dev = 0, cus = 0, per_cu = 0;
        (void)hipGetDevice(&dev); (void)hipDeviceGetAttribute(&cus, hipDeviceAttributeMultiprocessorCount, dev);
        if (hipFuncSetAttribute((const void*)hybrid_fwd, hipFuncAttributeMaxDynamicSharedMemorySize, LDS_BYTES) != hipSuccess) { fprintf(stderr, "kernel_launch: hipFuncSetAttribute failed\n"); grid = -1; return; }
        if (hipOccupancyMaxActiveBlocksPerMultiprocessor(&per_cu, (const void*)hybrid_fwd, NTHR, LDS_BYTES) != hipSuccess || per_cu < 1) per_cu = 1;
        (void)hipGetLastError();
        grid = cus * (per_cu > 1 ? 1 : per_cu);
        if (grid > 256) grid = 256;
    }
    if (grid < 0) return;
    (void)hipMemsetAsync((char*)d_ws + WS_SS, 0, CTL_ZERO_BYTES, stream);
    Args a{};
    for (int i = 0; i < 31; ++i) a.in[i] = (const float*)d_in[i];
    a.out = (float*)d_out; a.ws = (unsigned char*)d_ws;
    void* kargs[] = {&a};
    hipError_t e = hipLaunchCooperativeKernel((const void*)hybrid_fwd, dim3(grid), dim3(NTHR), kargs, LDS_BYTES, stream);
    if (e != hipSuccess) fprintf(stderr, "cooperative launch failed: %s (grid %d)\n", hipGetErrorString(e), grid);
}
```

```cpp
#include <hip/hip_runtime.h>
#include <hip/hip_cooperative_groups.h>
#include <cstdio>
#include <cstdint>
namespace cg = cooperative_groups;
namespace pg8 {
#define PG8_LAS __attribute__((address_space(3)))
typedef unsigned short bf16_t;
typedef short bf16x8 __attribute__((ext_vector_type(8)));
typedef float f32x4 __attribute__((ext_vector_type(4)));
typedef unsigned u32x4 __attribute__((ext_vector_type(4)));
constexpr int BM = 256, BK = 64, HALF = 128, HTB = HALF * BK * 2  , STAGE_BYTES = 8 * HTB, NXCD = 8, WGM = 8;

__host__ __device__ __forceinline__ int lds_byte(int r, int c) { const int st = (r >> 4) * 2 + (c >> 5), rr = r & 15, cc = c & 31, ob = rr * 64 + cc * 2; return st * 1024 + (ob ^ (((ob >> 9) & 1) << 5)); }
__host__ __device__ __forceinline__ void stage_rc(int b, int& R, int& C) { const int st = b / 1024, sb = b % 1024, swz = sb ^ (((sb >> 9) & 1) << 5); R = (st >> 1) * 16 + swz / 64; C = (st & 1) * 32 + (swz % 64) / 2; }
__host__ __device__ __forceinline__ int perm32(int rho) { const int n = rho >> 4, i = rho & 15; return 8 * (i >> 2) + 4 * n + (i & 3); }

struct Unit { int pm, pn; };
struct Gemm { const bf16_t* A; const bf16_t* Bt; int M, N, K, lda, ldb, a_pn_off; };

struct StaticOrder {
    int nM, nN, nwg, G, c;
    __host__ __device__ __forceinline__ void init(int M, int N, int G_, int c_) { nM = M / BM; nN = N / BM; nwg = nM * nN; G = G_; c = c_; }
    __host__ __device__ __forceinline__ bool next(int i, Unit& u) const {
        const long L = (long)i * G + c; if (L >= nwg) return false;
        int wgid = (int)L; { const int q = nwg / NXCD, r = nwg % NXCD, xcd = wgid % NXCD, off = wgid / NXCD; wgid = (xcd < r ? xcd * (q + 1) : r * (q + 1) + (xcd - r) * q) + off; }
        const int nig = WGM * nN, gid = wgid / nig, fm = gid * WGM, gsz = (nM - fm) < WGM ? (nM - fm) : WGM;
        u.pm = fm + ((wgid % nig) % gsz); u.pn = (wgid % nig) / gsz; return true;
    }
    __device__ __forceinline__ void a_ready(const Unit&) const {}
    __device__ __forceinline__ void done(const Unit&) const {}
};

__device__ __forceinline__ unsigned cvt_pk_bf16(float lo, float hi) { unsigned r; asm volatile("v_cvt_pk_bf16_f32 %0, %1, %2" : "=v"(r) : "v"(lo), "v"(hi)); return r; }
__device__ __forceinline__ float bperm(float v, int srclane) { return __int_as_float(__builtin_amdgcn_ds_bpermute(srclane << 2, __float_as_int(v))); }
typedef float f32x2 __attribute__((ext_vector_type(2)));
typedef unsigned u32x2 __attribute__((ext_vector_type(2)));
__device__ __forceinline__ float fsig(float v) { return __builtin_amdgcn_rcpf(1.f + __expf(-v)); }
__device__ __forceinline__ float fsilu(float v) { return v * fsig(v); }
__device__ __forceinline__ float fgelu_tanh(float v) { return v * fsig(1.5957691216057308f * (v + 0.044715f * v * v * v)); }
__device__ __forceinline__ float bf_lo(unsigned w) { return __uint_as_float(w << 16); }
__device__ __forceinline__ float bf_hi(unsigned w) { return __uint_as_float(w & 0xffff0000u); }
__device__ __forceinline__ float rstd_of(const float* ss, int row) { const f32x4* p = (const f32x4*)(ss + (size_t)row * 16); const f32x4 a = p[0], b = p[1], c = p[2], d = p[3];
    const float s = ((a[0] + a[1]) + (a[2] + a[3])) + ((b[0] + b[1]) + (b[2] + b[3])) + (((c[0] + c[1]) + (c[2] + c[3])) + ((d[0] + d[1]) + (d[2] + d[3]))); return rsqrtf(s * (1.0f / 1024.0f) + 1e-6f); }
__device__ __forceinline__ u32x4 pack8(const f32x4 v0, const f32x4 v1) { u32x4 w; w.x = cvt_pk_bf16(v0[0], v0[1]); w.y = cvt_pk_bf16(v0[2], v0[3]); w.z = cvt_pk_bf16(v1[0], v1[1]); w.w = cvt_pk_bf16(v1[2], v1[3]); return w; }

struct OneUnit { int pm, pn;
    __device__ __forceinline__ bool next(int i, Unit& u) const { if (i) return false; u.pm = pm; u.pn = pn; return true; }
    __device__ __forceinline__ void a_ready(const Unit&) const {}
    __device__ __forceinline__ void done(const Unit&) const {} };

struct EpiSwiglu { static constexpr bool PERM = true, AFTER_DRAIN = false; bf16_t* H; const float* ss; int ldh;
    __device__ __forceinline__ void operator()(const f32x4 (&acc)[2][2][4][2], const Unit& u, int wr, int wc, int fr, int fq) const {
        const int row0 = u.pm * BM + wr * 64 + fr, col0 = u.pn * HALF + wc * 32 + 8 * fq;
#pragma unroll
        for (int ai = 0; ai < 2; ++ai)
#pragma unroll
            for (int m = 0; m < 4; ++m) { const int row = row0 + ai * HALF + m * 16; const float rs = rstd_of(ss, row);
                f32x4 o0, o1;
#pragma unroll
                for (int i = 0; i < 4; ++i) { o0[i] = fsilu(acc[ai][0][m][0][i] * rs) * (acc[ai][1][m][0][i] * rs); o1[i] = fsilu(acc[ai][0][m][1][i] * rs) * (acc[ai][1][m][1][i] * rs); }
                *(u32x4*)(H + (size_t)row * ldh + col0) = pack8(o0, o1); __builtin_amdgcn_sched_barrier(0); }
    }
};
struct EpiResid { static constexpr bool PERM = false, AFTER_DRAIN = false; float* x; bf16_t* xb; float* ss; float scale;
    __device__ __forceinline__ void operator()(const f32x4 (&acc)[2][2][4][2], const Unit& u, int wr, int wc, int fr, int fq) const {
        float scl = scale; asm volatile("" : "+v"(scl)); const int row0 = u.pm * BM + wr * 64 + fr, col0 = u.pn * BM + wc * 32 + 4 * fq;
#pragma unroll
        for (int ai = 0; ai < 2; ++ai)
#pragma unroll
            for (int m = 0; m < 4; ++m) { const int row = row0 + ai * HALF + m * 16; float q = 0.f;
#pragma unroll
                for (int bj = 0; bj < 2; ++bj)
#pragma unroll
                    for (int n = 0; n < 2; ++n) { const size_t off = (size_t)row * 1024 + col0 + bj * HALF + n * 16;
                        f32x4 v = *(const f32x4*)(x + off) + acc[ai][bj][m][n] * scl; *(f32x4*)(x + off) = v;
                        u32x2 w; w.x = cvt_pk_bf16(v[0], v[1]); w.y = cvt_pk_bf16(v[2], v[3]); *(u32x2*)(xb + off) = w;
                        q += (v[0] * v[0] + v[1] * v[1]) + (v[2] * v[2] + v[3] * v[3]); }
                q += bperm(q, (fr + 16 * fq) ^ 16); q += bperm(q, (fr + 16 * fq) ^ 32);
                if (fq == 0) ss[(size_t)row * 16 + u.pn * 4 + wc] = q; }
    }
};
struct EpiRs { static constexpr bool PERM = true, AFTER_DRAIN = false; bf16_t* O; int ldc; const float* ss; float sc;
    __device__ __forceinline__ void operator()(const f32x4 (&acc)[2][2][4][2], const Unit& u, int wr, int wc, int fr, int fq) const {
        const int row0 = u.pm * BM + wr * 64 + fr, col0 = u.pn * BM + wc * 32 + 8 * fq;
#pragma unroll
        for (int ai = 0; ai < 2; ++ai)
#pragma unroll
            for (int m = 0; m < 4; ++m) { const int row = row0 + ai * HALF + m * 16; const float rs = (ss ? rstd_of(ss, row) : 1.f) * sc;
#pragma unroll
                for (int bj = 0; bj < 2; ++bj) *(u32x4*)(O + (size_t)row * ldc + col0 + bj * HALF) = pack8(acc[ai][bj][m][0] * rs, acc[ai][bj][m][1] * rs); }
    }
};
struct EpiWin { static constexpr bool PERM = true, AFTER_DRAIN = false; bf16_t *xa, *xl, *gg, *q, *k, *v; const float* ss; float qscale;
    __device__ __forceinline__ void operator()(const f32x4 (&acc)[2][2][4][2], const Unit& u, int wr, int wc, int fr, int fq) const {
        const int pn = u.pn; bf16_t* dst; int ld, ct; float sc = 1.f; bool act = false;
        if (pn < 2) { dst = xa; ld = 512; ct = pn; } else if (pn < 6) { dst = xl; ld = 1024; ct = pn - 2; } else if (pn < 10) { dst = gg; ld = 1024; ct = pn - 6; act = true; }
        else if (pn < 12) { dst = q; ld = 512; ct = pn - 10; sc = qscale; } else if (pn < 14) { dst = k; ld = 512; ct = pn - 12; } else { dst = v; ld = 512; ct = pn - 14; }
        const int row0 = u.pm * BM + wr * 64 + fr, col0 = ct * BM + wc * 32 + 8 * fq;
#pragma unroll
        for (int ai = 0; ai < 2; ++ai)
#pragma unroll
            for (int m = 0; m < 4; ++m) { const int row = row0 + ai * HALF + m * 16; const float rs = rstd_of(ss, row) * sc;
#pragma unroll
                for (int bj = 0; bj < 2; ++bj) { f32x4 v0 = acc[ai][bj][m][0] * rs, v1 = acc[ai][bj][m][1] * rs;
                    if (act) {
#pragma unroll
                        for (int i = 0; i < 4; ++i) { v0[i] = fgelu_tanh(v0[i]); v1[i] = fgelu_tanh(v1[i]); } }
                    *(u32x4*)(dst + (size_t)row * ld + col0 + bj * HALF) = pack8(v0, v1); __builtin_amdgcn_sched_barrier(0); } }
    }
};
struct EpiGate { static constexpr bool PERM = true, AFTER_DRAIN = false; bf16_t* stash; const float* bg; const float* ss;
    __device__ __forceinline__ void operator()(const f32x4 (&acc)[2][2][4][2], const Unit& u, int wr, int wc, int fr, int fq) const {
        const int row0 = u.pm * BM + wr * 64 + fr, col0 = u.pn * BM + wc * 32 + 8 * fq; int tid_o = threadIdx.x; asm volatile("" : "+v"(tid_o)); const int tid = tid_o;
        f32x4 bv[2][2];
#pragma unroll
        for (int bj = 0; bj < 2; ++bj)
#pragma unroll
            for (int n = 0; n < 2; ++n) bv[bj][n] = *(const f32x4*)(bg + col0 + bj * HALF + 4 * n);
#pragma unroll
        for (int ai = 0; ai < 2; ++ai)
#pragma unroll
            for (int m = 0; m < 4; ++m) { const int row = row0 + ai * HALF + m * 16; const float rs = rstd_of(ss, row);
#pragma unroll
                for (int bj = 0; bj < 2; ++bj) { f32x4 v0 = acc[ai][bj][m][0] * rs + bv[bj][0], v1 = acc[ai][bj][m][1] * rs + bv[bj][1];
#pragma unroll
                    for (int i = 0; i < 4; ++i) { v0[i] = fsig(v0[i]); v1[i] = fsig(v1[i]); }
                    *(u32x4*)(stash + ((size_t)((ai * 4 + m) * 2 + bj) * 512 + tid) * 8) = pack8(v0, v1); __builtin_amdgcn_sched_barrier(0); } }
    }
};
struct EpiMerge { static constexpr bool PERM = true, AFTER_DRAIN = false; const bf16_t* stash; bf16_t* mg; int first;
    __device__ __forceinline__ void operator()(const f32x4 (&acc)[2][2][4][2], const Unit& u, int wr, int wc, int fr, int fq) const {
        const int row0 = u.pm * BM + wr * 64 + fr, col0 = u.pn * BM + wc * 32 + 8 * fq; int tid_o = threadIdx.x; asm volatile("" : "+v"(tid_o)); const int tid = tid_o;
#pragma unroll
        for (int ai = 0; ai < 2; ++ai)
#pragma unroll
            for (int m = 0; m < 4; ++m) { const int row = row0 + ai * HALF + m * 16;
#pragma unroll
                for (int bj = 0; bj < 2; ++bj) { const u32x4 gw = *(const u32x4*)(stash + ((size_t)((ai * 4 + m) * 2 + bj) * 512 + tid) * 8);
                    bf16_t* p = mg + (size_t)row * 1024 + col0 + bj * HALF;
                    f32x4 v0 = acc[ai][bj][m][0], v1 = acc[ai][bj][m][1];
                    v0[0] *= bf_lo(gw.x); v0[1] *= bf_hi(gw.x); v0[2] *= bf_lo(gw.y); v0[3] *= bf_hi(gw.y); v1[0] *= bf_lo(gw.z); v1[1] *= bf_hi(gw.z); v1[2] *= bf_lo(gw.w); v1[3] *= bf_hi(gw.w);
                    if (!first) { const u32x4 ow = *(const u32x4*)p;
                        v0[0] += bf_lo(ow.x); v0[1] += bf_hi(ow.x); v0[2] += bf_lo(ow.y); v0[3] += bf_hi(ow.y); v1[0] += bf_lo(ow.z); v1[1] += bf_hi(ow.z); v1[2] += bf_lo(ow.w); v1[3] += bf_hi(ow.w); }
                    *(u32x4*)p = pack8(v0, v1); __builtin_amdgcn_sched_barrier(0); } }
    }
};
struct EpiKV { static constexpr bool PERM = true, AFTER_DRAIN = false; bf16_t* kx; bf16_t* vt;
    __device__ __forceinline__ void operator()(const f32x4 (&acc)[2][2][4][2], const Unit& u, int wr, int wc, int fr, int fq) const {
        if (u.pn < 4) { const int row0 = u.pm * BM + wr * 64 + fr, col0 = u.pn * BM + wc * 32 + 8 * fq;
#pragma unroll
            for (int ai = 0; ai < 2; ++ai)
#pragma unroll
                for (int m = 0; m < 4; ++m)
#pragma unroll
                    for (int bj = 0; bj < 2; ++bj) *(u32x4*)(kx + (size_t)(row0 + ai * HALF + m * 16) * 1024 + col0 + bj * HALF) = pack8(acc[ai][bj][m][0], acc[ai][bj][m][1]);
        } else { const int h = u.pn - 4, b = u.pm; bf16_t* base = vt + (size_t)(b * 4 + h) * 65536;
#pragma unroll
            for (int ai = 0; ai < 2; ++ai)
#pragma unroll
                for (int m = 0; m < 4; ++m) { const int mr = ai * HALF + wr * 64 + m * 16 + fr;
#pragma unroll
                    for (int bj = 0; bj < 2; ++bj) { bf16_t* p = base + (size_t)(bj * HALF + wc * 32 + 8 * fq) * 256 + mr; asm volatile("" : "+v"(p));
#pragma unroll
                        for (int n = 0; n < 2; ++n)
#pragma unroll
                            for (int i = 0; i < 4; ++i) p[(4 * n + i) * 256] = (bf16_t)(cvt_pk_bf16(acc[ai][bj][m][n][i], 0.f) & 0xffffu);
                        __builtin_amdgcn_sched_barrier(0); } }
        }
    }
};
struct EpiSoftmaxP { static constexpr bool PERM = true, AFTER_DRAIN = true; bf16_t* P;
    __device__ __forceinline__ void fused(f32x4 (&acc)[2][2][4][2], const Unit& u, int wr, int wc, int fr, int fq, PG8_LAS unsigned char* lds, int wid, int lane) const {
        PG8_LAS f32x2* X = (PG8_LAS f32x2*)lds;
        float mloc[2][4];
#pragma unroll
        for (int ai = 0; ai < 2; ++ai)
#pragma unroll
            for (int m = 0; m < 4; ++m) { float mx = -__builtin_inff();
#pragma unroll
                for (int bj = 0; bj < 2; ++bj)
#pragma unroll
                    for (int n = 0; n < 2; ++n) { const f32x4 v = acc[ai][bj][m][n]; mx = fmaxf(mx, fmaxf(fmaxf(v[0], v[1]), fmaxf(v[2], v[3]))); }
                mx = fmaxf(mx, bperm(mx, (fr + 16 * fq) ^ 16)); mx = fmaxf(mx, bperm(mx, (fr + 16 * fq) ^ 32)); float s = 0.f;
#pragma unroll
                for (int bj = 0; bj < 2; ++bj)
#pragma unroll
                    for (int n = 0; n < 2; ++n) { f32x4 v = acc[ai][bj][m][n];
#pragma unroll
                        for (int i = 0; i < 4; ++i) { v[i] = __builtin_amdgcn_exp2f(v[i] - mx); s += v[i]; }
                        acc[ai][bj][m][n] = v; }
                s += bperm(s, (fr + 16 * fq) ^ 16); s += bperm(s, (fr + 16 * fq) ^ 32); mloc[ai][m] = mx;
                if (fq == 0) X[(ai * HALF + wr * 64 + m * 16 + fr) * 4 + wc] = (f32x2){mx, s}; __builtin_amdgcn_sched_barrier(0); }
        asm volatile("s_waitcnt lgkmcnt(0)" ::: "memory"); __builtin_amdgcn_s_barrier(); asm volatile("" ::: "memory");
#pragma unroll
        for (int ai = 0; ai < 2; ++ai)
#pragma unroll
            for (int m = 0; m < 4; ++m) { const int rl = ai * HALF + wr * 64 + m * 16 + fr;
                const f32x2 a = X[rl * 4 + 0], b = X[rl * 4 + 1], c = X[rl * 4 + 2], d = X[rl * 4 + 3];
                const float M = fmaxf(fmaxf(a.x, b.x), fmaxf(c.x, d.x));
                const float L = a.y * __builtin_amdgcn_exp2f(a.x - M) + b.y * __builtin_amdgcn_exp2f(b.x - M) + c.y * __builtin_amdgcn_exp2f(c.x - M) + d.y * __builtin_amdgcn_exp2f(d.x - M);
                const float f = __builtin_amdgcn_exp2f(mloc[ai][m] - M) / L;
#pragma unroll
                for (int bj = 0; bj < 2; ++bj) *(u32x4*)(P + (size_t)rl * 256 + bj * HALF + wc * 32 + 8 * fq) = pack8(acc[ai][bj][m][0] * f, acc[ai][bj][m][1] * f); __builtin_amdgcn_sched_barrier(0); }
        asm volatile("s_waitcnt vmcnt(0) lgkmcnt(0)" ::: "memory"); __builtin_amdgcn_s_barrier(); asm volatile("" ::: "memory");
    }
};

template <class Epi, class Sched, bool ALIGN_EPI = false, bool SP2 = false>
__device__ __forceinline__ void gemm_phase(PG8_LAS unsigned char* lds, const Gemm g, const Sched& S, const Epi& E) {
    int tid_o = threadIdx.x; asm volatile("" : "+v"(tid_o));
    const int tid = tid_o, wid = __builtin_amdgcn_readfirstlane(tid >> 6), lane = tid & 63, wr = wid >> 2, wc = wid & 3, fr = lane & 15, fq = lane >> 4;
    const int K = g.K, nt = K / BK;
    unsigned voffA[2], voffB[2];
#pragma unroll
    for (int i = 0; i < 2; ++i) { int R, C; stage_rc(tid * 16 + i * 8192, R, C); const int Rb = Epi::PERM ? ((R & ~31) + perm32(R & 31)) : R;
        voffA[i] = (unsigned)(R * g.lda + C) * 2u; voffB[i] = (unsigned)(Rb * g.ldb + C) * 2u; }
    const size_t kstep = (size_t)(BK * 2);
    const size_t hstepA = (size_t)HALF * g.lda * 2, hstepB = (size_t)HALF * g.ldb * 2;
    const size_t tstepA = 2 * hstepA, tstepB = 2 * hstepB;
    const unsigned ldsw = (unsigned)wid * 1024u;
    const int aoff = lds_byte(wr * 64 + fr, fq * 8), boff = lds_byte(wc * 32 + fr, fq * 8);
#define PG8_SA(b, h) (((b) * 2 + (h)) * HTB)
#define PG8_SB(b, h) ((4 + (b) * 2 + (h)) * HTB)
#define PG8_STAGE(bufoff, gbase, voff) do { _Pragma("unroll") for (int _i = 0; _i < 2; ++_i) \
        __builtin_amdgcn_global_load_lds((const unsigned*)((const char*)(gbase) + (voff)[_i]), (PG8_LAS unsigned*)(lds + (bufoff) + ldsw + _i * 8192), 16, 0, 0); } while (0)
#define PG8_LDA(dst, b, h) do { _Pragma("unroll") for (int m = 0; m < 4; ++m) _Pragma("unroll") for (int k = 0; k < 2; ++k) dst[m][k] = *(const PG8_LAS bf16x8*)(lds + PG8_SA(b, h) + aoff + m * 2048 + k * 1024); } while (0)
#define PG8_LDB(dst, b, h) do { _Pragma("unroll") for (int n = 0; n < 2; ++n) _Pragma("unroll") for (int k = 0; k < 2; ++k) dst[n][k] = *(const PG8_LAS bf16x8*)(lds + PG8_SB(b, h) + boff + n * 2048 + k * 1024); } while (0)
#define PG8_MMA(ai, bj, At, Bt) do { __builtin_amdgcn_s_setprio(1); _Pragma("unroll") for (int m = 0; m < 4; ++m) _Pragma("unroll") for (int n = 0; n < 2; ++n) _Pragma("unroll") for (int k = 0; k < 2; ++k) \
        acc[ai][bj][m][n] = __builtin_amdgcn_mfma_f32_16x16x32_bf16(Bt[n][k], At[m][k], acc[ai][bj][m][n], 0, 0, 0); __builtin_amdgcn_s_setprio(0); } while (0)
#define PG8_WAIT_V(n) asm volatile("s_waitcnt vmcnt(" #n ")" ::: "memory")
#define PG8_WAIT_L(n) asm volatile("s_waitcnt lgkmcnt(" #n ")" ::: "memory")
#define PG8_BAR __builtin_amdgcn_s_barrier()
#define PG8_SCHED __builtin_amdgcn_sched_barrier(0)
    Unit cur, nxt; int ui = 0;
    if (!S.next(0, cur)) return;
    f32x4 acc[2][2][4][2];
#pragma unroll
    for (int a = 0; a < 2; ++a)
#pragma unroll
        for (int b = 0; b < 2; ++b)
#pragma unroll
            for (int m = 0; m < 4; ++m)
#pragma unroll
                for (int n = 0; n < 2; ++n) acc[a][b][m][n] = (f32x4){0.f, 0.f, 0.f, 0.f};
    bf16x8 At[4][2], B0[2][2], B1[2][2];
    const char* cA = (const char*)g.A + (size_t)cur.pm * tstepA + (size_t)cur.pn * g.a_pn_off * 2; const char* cB = (const char*)g.Bt + (size_t)cur.pn * tstepB;
    S.a_ready(cur);
    if constexpr (SP2) {
        PG8_STAGE(PG8_SB(0, 0), cB, voffB); PG8_STAGE(PG8_SB(0, 1), cB + hstepB, voffB); PG8_STAGE(PG8_SA(0, 0), cA, voffA); PG8_STAGE(PG8_SA(0, 1), cA + hstepA, voffA);
        if (wr == 1) PG8_BAR;
        PG8_WAIT_V(2); PG8_BAR;
        PG8_STAGE(PG8_SB(1, 0), cB + kstep, voffB); PG8_STAGE(PG8_SA(1, 0), cA + kstep, voffA); PG8_STAGE(PG8_SB(1, 1), cB + hstepB + kstep, voffB);
        PG8_WAIT_V(6); PG8_BAR;
    } else {
        PG8_STAGE(PG8_SB(0, 0), cB, voffB); PG8_STAGE(PG8_SA(0, 0), cA, voffA); PG8_STAGE(PG8_SB(0, 1), cB + hstepB, voffB); PG8_STAGE(PG8_SA(0, 1), cA + hstepA, voffA);
        if (wr == 1) PG8_BAR;
        PG8_WAIT_V(4); PG8_BAR;
        PG8_STAGE(PG8_SB(1, 0), cB + kstep, voffB); PG8_STAGE(PG8_SA(1, 0), cA + kstep, voffA); PG8_STAGE(PG8_SB(1, 1), cB + hstepB + kstep, voffB);
        PG8_WAIT_V(6); PG8_BAR;
    }
    for (;;) {
        const bool has_next = S.next(ui + 1, nxt);
        const char* nA = has_next ? (const char*)g.A + (size_t)nxt.pm * tstepA + (size_t)nxt.pn * g.a_pn_off * 2 : cA; const char* nB = has_next ? (const char*)g.Bt + (size_t)nxt.pn * tstepB : cB;
        for (int t = 0; t < nt; t += 2) {
            const bool last = (t == nt - 2);
            const char* a1 = cA + (size_t)(t + 1) * kstep;
            const char* a2 = last ? nA : cA + (size_t)(t + 2) * kstep; const char* b2 = last ? nB : cB + (size_t)(t + 2) * kstep;
            const char* a3 = a2 + kstep; const char* b3 = b2 + kstep;
            if (last && has_next) S.a_ready(nxt);
            if constexpr (SP2) {
            PG8_LDB(B0, 0, 0); PG8_LDB(B1, 0, 1); PG8_SCHED; PG8_LDA(At, 0, 0); PG8_STAGE(PG8_SA(1, 1), a1 + hstepA, voffA);
            PG8_WAIT_V(8); PG8_WAIT_L(0); PG8_BAR; PG8_MMA(0, 0, At, B0); PG8_MMA(0, 1, At, B1); PG8_BAR; PG8_SCHED;
            PG8_LDA(At, 0, 1); PG8_STAGE(PG8_SB(0, 0), b2, voffB); PG8_STAGE(PG8_SB(0, 1), b2 + hstepB, voffB); PG8_STAGE(PG8_SA(0, 0), a2, voffA);
            PG8_WAIT_V(8); PG8_WAIT_L(0); PG8_BAR; PG8_MMA(1, 0, At, B0); PG8_MMA(1, 1, At, B1); PG8_BAR; PG8_SCHED;
            PG8_LDB(B0, 1, 0); PG8_LDB(B1, 1, 1); PG8_SCHED; PG8_LDA(At, 1, 0); PG8_STAGE(PG8_SA(0, 1), a2 + hstepA, voffA);
            PG8_WAIT_V(8); PG8_WAIT_L(0); PG8_BAR; PG8_MMA(0, 0, At, B0); PG8_MMA(0, 1, At, B1); PG8_BAR; PG8_SCHED;
            PG8_LDA(At, 1, 1); PG8_STAGE(PG8_SB(1, 0), b3, voffB); PG8_STAGE(PG8_SB(1, 1), b3 + hstepB, voffB); PG8_STAGE(PG8_SA(1, 0), a3, voffA);
            PG8_WAIT_V(8); PG8_WAIT_L(0); PG8_BAR; PG8_MMA(1, 0, At, B0); PG8_MMA(1, 1, At, B1); PG8_BAR; PG8_SCHED;
            } else {
            PG8_LDB(B0, 0, 0); PG8_SCHED; PG8_LDA(At, 0, 0); PG8_STAGE(PG8_SA(1, 1), a1 + hstepA, voffA);
            PG8_WAIT_L(8); PG8_BAR; PG8_WAIT_L(0); PG8_MMA(0, 0, At, B0); PG8_BAR; PG8_SCHED;
            PG8_LDB(B1, 0, 1); PG8_STAGE(PG8_SB(0, 0), b2, voffB);
            PG8_BAR; PG8_WAIT_L(0); PG8_MMA(0, 1, At, B1); PG8_BAR;
            PG8_LDA(At, 0, 1); PG8_STAGE(PG8_SA(0, 0), a2, voffA);
            PG8_BAR; PG8_WAIT_L(0); PG8_MMA(1, 0, At, B0); PG8_BAR; PG8_SCHED;
            PG8_STAGE(PG8_SB(0, 1), b2 + hstepB, voffB);
            PG8_WAIT_V(6); PG8_BAR; PG8_MMA(1, 1, At, B1); PG8_BAR;
            PG8_LDB(B0, 1, 0); PG8_SCHED; PG8_LDA(At, 1, 0); PG8_STAGE(PG8_SA(0, 1), a2 + hstepA, voffA);
            PG8_WAIT_L(8); PG8_BAR; PG8_WAIT_L(0); PG8_MMA(0, 0, At, B0); PG8_BAR; PG8_SCHED;
            PG8_LDB(B1, 1, 1); PG8_STAGE(PG8_SB(1, 0), b3, voffB);
            PG8_BAR; PG8_WAIT_L(0); PG8_MMA(0, 1, At, B1); PG8_BAR;
            PG8_LDA(At, 1, 1); PG8_STAGE(PG8_SA(1, 0), a3, voffA);
            PG8_BAR; PG8_WAIT_L(0); PG8_MMA(1, 0, At, B0); PG8_BAR; PG8_SCHED;
            PG8_STAGE(PG8_SB(1, 1), b3 + hstepB, voffB);
            PG8_WAIT_V(6); PG8_BAR; PG8_MMA(1, 1, At, B1); PG8_BAR;
            }
        }
        if constexpr (ALIGN_EPI) { if (wr == 0) PG8_BAR; }
        if constexpr (!Epi::AFTER_DRAIN) { E(acc, cur, wr, wc, fr, fq); S.done(cur); }
        if (!has_next) break;
#pragma unroll
        for (int a = 0; a < 2; ++a)
#pragma unroll
            for (int b = 0; b < 2; ++b)
#pragma unroll
                for (int m = 0; m < 4; ++m)
#pragma unroll
                    for (int n = 0; n < 2; ++n) acc[a][b][m][n] = (f32x4){0.f, 0.f, 0.f, 0.f};
        cur = nxt; cA = nA; cB = nB; ++ui;
        if constexpr (ALIGN_EPI) { if (wr == 1) PG8_BAR; }
    }
    PG8_WAIT_V(0);
    if constexpr (!ALIGN_EPI) { if (wr == 0) PG8_BAR; }
    PG8_BAR;
    if constexpr (Epi::AFTER_DRAIN) { E.fused(acc, cur, wr, wc, fr, fq, lds, wid, lane); S.done(cur); }
#undef PG8_SA
#undef PG8_SB
#undef PG8_STAGE
#undef PG8_LDA
#undef PG8_LDB
#undef PG8_MMA
#undef PG8_WAIT_V
#undef PG8_WAIT_L
#undef PG8_BAR
#undef PG8_SCHED
}
}
#include <hip/hip_bf16.h>
#include <cmath>
#define GAS __attribute__((address_space(1)))
#define LAS __attribute__((address_space(3)))
typedef unsigned short bf16;
typedef unsigned v4u __attribute__((ext_vector_type(4)));
typedef float f32x4 __attribute__((ext_vector_type(4)));
typedef short bf16x8 __attribute__((ext_vector_type(8)));
typedef float f32x16 __attribute__((ext_vector_type(16)));

constexpr int NWAVES = 8, NTHR = 512;
constexpr int BATCH = 2, SEQ = 8192, D = 1024, M = BATCH * SEQ, DFF = 2816, DEPTH = 2;
constexpr int INW = 7176;
constexpr size_t MiB = 1u << 20;
constexpr size_t WS_SS = 0, CTL_ZERO_BYTES = 1 * MiB;
constexpr size_t WS_WFL = 1 * MiB;
constexpr size_t WS_WAT = 1 * MiB + 256 * 1024, WS_WXT = 1 * MiB + 512 * 1024;
constexpr size_t WS_SUMM = 2 * MiB;
constexpr size_t WS_LOGF = 3 * MiB, WS_CTIL = 3 * MiB + 512 * 1024;
constexpr size_t WS_KPART = 7 * MiB;
constexpr size_t WS_MEMN = 4 * MiB, WS_KX = 5 * MiB, WS_VT = 6 * MiB;
constexpr size_t WS_W1IN = 8 * MiB, WS_W1OUT = 19 * MiB, WS_WIN = 25 * MiB, WS_WG = 33 * MiB, WS_UA = 39 * MiB, WS_UB = 40 * MiB, WS_UC = 42 * MiB,
                 WS_WO = 43 * MiB, WS_WXQ = 45 * MiB, WS_WXKV = 47 * MiB, WS_WXO = 51 * MiB, WS_W2IN = 53 * MiB, WS_W2OUT = 64 * MiB;
constexpr size_t WS_XB = 70 * MiB;
constexpr size_t WS_Q = 102 * MiB, WS_GG = 118 * MiB, WS_XA = 150 * MiB, WS_XL = 166 * MiB, WS_K = 198 * MiB, WS_V = 214 * MiB;
constexpr size_t WS_H = 102 * MiB;
constexpr size_t WS_YC = 150 * MiB;
constexpr size_t WS_STASH = 166 * MiB, WS_MG = 198 * MiB, WS_QX = 150 * MiB, WS_PBUF = 198 * MiB;
constexpr size_t WS_YA = 230 * MiB, WS_SSP = 246 * MiB, WS_END = 255 * MiB;
constexpr int LDS_BYTES = 147456;

__device__ __forceinline__ unsigned f2bf(float f) { unsigned u = __builtin_bit_cast(unsigned, f); return (u + 0x7fffu + ((u >> 16) & 1u)) >> 16; }
__device__ __forceinline__ unsigned pk2(float lo, float hi) { return f2bf(lo) | (f2bf(hi) << 16); }
__device__ __forceinline__ float bf2f(unsigned short v) { return __uint_as_float((unsigned)v << 16); }
__device__ __forceinline__ float bperm(float v, int srclane) { return __int_as_float(__builtin_amdgcn_ds_bpermute(srclane << 2, __float_as_int(v))); }
__device__ __forceinline__ float wave_sum(float v, int lane) {
#pragma unroll
    for (int o = 1; o < 64; o <<= 1) v += bperm(v, lane ^ o);
    return v;
}
__device__ __forceinline__ float flog1p(float e) { return e < 0.01f ? e * (1.f - e * (0.5f - e * 0.33333334f)) : __logf(1.f + e); }
#define LDS_WAIT() asm volatile("s_waitcnt lgkmcnt(0)" ::: "memory")

__device__ __forceinline__ void tr_item(const float* W, int ldn, int col0, int k0, const float* g, bf16* WT, int ldk, int drow0, LAS float* scr, int lane) {
#pragma unroll
    for (int i = 0; i < 32; ++i) { const int kk = 2 * i + (lane >> 5); float v = W[(size_t)(k0 + kk) * ldn + col0 + (lane & 31)]; if (g) v *= g[k0 + kk]; scr[kk * 33 + (lane & 31)] = v; }
    LDS_WAIT(); asm volatile("" ::: "memory");
    const int c = lane & 7;
#pragma unroll
    for (int j = 0; j < 4; ++j) { const int n = (lane >> 3) + 8 * j; const LAS float* s = scr + (8 * c) * 33 + n;
        v4u o; o.x = pk2(s[0 * 33], s[1 * 33]); o.y = pk2(s[2 * 33], s[3 * 33]); o.z = pk2(s[4 * 33], s[5 * 33]); o.w = pk2(s[6 * 33], s[7 * 33]);
        *(v4u*)(WT + (size_t)(drow0 + n) * ldk + k0 + 8 * c) = o; }
    LDS_WAIT(); asm volatile("" ::: "memory");
}

#define RLX_AGENT __ATOMIC_RELAXED, __HIP_MEMORY_SCOPE_AGENT
#define XB_TMO      128
#define XB_XCNT(j)  (256  + 64 * (j))
#define XB_XSUB(j)  (1280 + 64 * (j))
#define XB_XGEN(j)  (2304 + 64 * (j))
#define XB_TOP      3328
#define XB_TOPGEN   3392
#define XCD_BAR_WORDS 3456
#define XB_SPIN_CAP (1u << 18)

__device__ __forceinline__ unsigned xb_ld(unsigned* p)              { return __hip_atomic_load(p, __ATOMIC_RELAXED, __HIP_MEMORY_SCOPE_AGENT); }
__device__ __forceinline__ unsigned xb_add(unsigned* p, unsigned v) { return __hip_atomic_fetch_add(p, v, __ATOMIC_RELAXED, __HIP_MEMORY_SCOPE_AGENT); }
__device__ __forceinline__ unsigned xb_xcc_id() { return (unsigned)__builtin_amdgcn_s_getreg((3 << 11) | 20) & 0xFu; }
#define XB_SPIN(cond, bar) do { unsigned _sp = 0; while (cond) { __builtin_amdgcn_s_sleep(1); \
    if ((++_sp & 255u) == 0u) { if (xb_ld(&(bar)[XB_TMO])) break; if (_sp > XB_SPIN_CAP) { atomicAdd(&(bar)[XB_TMO], 1u); break; } } } } while (0)

struct XcdBarrier {
    unsigned* bar; unsigned x;
    volatile LAS unsigned* st;
};

__device__ __forceinline__ XcdBarrier xcd_barrier_post(unsigned* bar, volatile LAS unsigned* st) {
    XcdBarrier b; b.bar = bar; b.x = xb_xcc_id(); b.st = st;
    if (threadIdx.x == 0) (void)xb_add(&bar[XB_XCNT(b.x)], 1u);
    return b;
}
__device__ __forceinline__ void xcd_barrier_complete(unsigned* bar, unsigned x, unsigned& nloc, unsigned& nx) {
    const unsigned G = gridDim.x * gridDim.y * gridDim.z;
    unsigned sum, cnt, mine, sp = 0u;
    for (;;) {
        sum = 0u; cnt = 0u; mine = 0u;
#pragma unroll
        for (unsigned j = 0; j < 16; ++j) { const unsigned c = xb_ld(&bar[XB_XCNT(j)]); sum += c; cnt += (c > 0u) ? 1u : 0u; mine = (j == x) ? c : mine; }
        if (sum == G) break;
        __builtin_amdgcn_s_sleep(1);
        if ((++sp & 255u) == 0u) { if (xb_ld(&bar[XB_TMO])) break; if (sp > XB_SPIN_CAP) { atomicAdd(&bar[XB_TMO], 1u); break; } }
    }
    nloc = mine > 0u ? mine : 1u; nx = cnt > 0u ? cnt : 1u;
}

__device__ __forceinline__ void xcd_barrier(const XcdBarrier& b) {
    asm volatile("s_waitcnt vmcnt(0)" ::: "memory");
    __syncthreads();
    if (threadIdx.x == 0) {
        unsigned* bar = b.bar;
        __builtin_amdgcn_s_waitcnt(0);
        unsigned nloc = b.st[0], nx = b.st[1];
        if (nloc == 0u) { xcd_barrier_complete(bar, b.x, nloc, nx); b.st[0] = nloc; b.st[1] = nx; }
        const unsigned old = xb_add(&bar[XB_XSUB(b.x)], 1u);
        const unsigned gen = old / nloc;
        if (old + 1u == (gen + 1u) * nloc) {
            __builtin_amdgcn_fence(__ATOMIC_RELEASE, "agent");
            asm volatile("s_waitcnt vmcnt(0)" ::: "memory");
            const unsigned og = xb_add(&bar[XB_TOP], 1u);
            const unsigned tg = og / nx;
            if (og + 1u == (tg + 1u) * nx) xb_add(&bar[XB_TOPGEN], 1u);
            else XB_SPIN(xb_ld(&bar[XB_TOPGEN]) == tg, bar);
            __builtin_amdgcn_fence(__ATOMIC_ACQUIRE, "agent");
            xb_add(&bar[XB_XGEN(b.x)], 1u);
            asm volatile("s_waitcnt vmcnt(0)" ::: "memory");
        } else {
            XB_SPIN(xb_ld(&bar[XB_XGEN(b.x)]) == gen, bar);
            __builtin_amdgcn_fence(__ATOMIC_ACQUIRE, "agent");
            asm volatile("s_waitcnt vmcnt(0)" ::: "memory");
        }
    }
    __syncthreads();
}

struct Args { const float* in[31]; float* out; unsigned char* ws; int pad[2]; };
typedef LAS unsigned long long* PtrTab;
__device__ __forceinline__ const float* tab_in(PtrTab tb, int k) { const unsigned long long v = tb[k]; const unsigned lo = __builtin_amdgcn_readfirstlane((unsigned)v), hi = __builtin_amdgcn_readfirstlane((unsigned)(v >> 32));
    return (const float*)(const GAS float*)(((unsigned long long)hi << 32) | lo); }
constexpr int TAB_OFF = 147456 - 512;
constexpr size_t WS_BAR = 768 * 1024;

__device__ __forceinline__ void phase_prologue(PtrTab TB, unsigned char* ws, float* xout, int l, LAS unsigned char* lds, int gw, int NGW, int lane, int wave) {
    LAS float* scr = (LAS float*)(lds + wave * 16384);
#define g1 (tab_in(TB, 2) + l * D)
#define w1i (tab_in(TB, 3) + (size_t)l * D * 2 * DFF)
#define w1o (tab_in(TB, 4) + (size_t)l * DFF * D)
#define gm (tab_in(TB, 5) + l * D)
#define win (tab_in(TB, 6) + (size_t)l * D * INW)
#define wpool (tab_in(TB, 9) + (size_t)l * 4 * 128 * 128)
#define psc (tab_in(TB, 10) + l * 512)
#define wua (tab_in(TB, 11) + (size_t)l * 512 * D)
#define wra (tab_in(TB, 14) + (size_t)l * 8 * 128 * 128)
#define wrx (tab_in(TB, 16) + (size_t)l * 8 * 128 * 128)
#define wub (tab_in(TB, 19) + (size_t)l * D * D)
#define wuc (tab_in(TB, 20) + (size_t)l * 512 * D)
#define wo (tab_in(TB, 21) + (size_t)l * D * D)
#define gc (tab_in(TB, 22) + l * D)
#define gmem (tab_in(TB, 23) + l * D)
#define wxq (tab_in(TB, 24) + (size_t)l * D * D)
#define wxkv (tab_in(TB, 25) + (size_t)l * D * 2 * D)
#define wxo (tab_in(TB, 26) + (size_t)l * D * D)
#define g2 (tab_in(TB, 27) + l * D)
#define w2i (tab_in(TB, 28) + (size_t)l * D * 2 * DFF)
#define w2o (tab_in(TB, 29) + (size_t)l * DFF * D)
    constexpr int I_FI = 16 * 176, I_FO = 44 * 32, I_WIN = 16 * 128, I_WG = 16 * 96, I_UB = 16 * 32, I_UC = 8 * 32, I_RG = 64, I_SQ = 16 * 32, I_KV = 16 * 64;
    constexpr int S0 = 0, S1 = S0 + I_FI, S2 = S1 + I_FO, S3 = S2 + I_WIN, S4 = S3 + I_WG, S5 = S4 + I_UB, S6 = S5 + I_UC, S7 = S6 + I_RG, S8 = S7 + I_RG, S9 = S8 + I_SQ, S10 = S9 + I_SQ,
                  S11 = S10 + I_KV, S12 = S11 + I_SQ, S13 = S12 + I_FI, S14 = S13 + I_FO;
    for (int it = gw; it < S14; it += NGW) {
        if (it < S1 || (it >= S12 && it < S13)) {
            const bool second = it >= S12; const int r = second ? it - S12 : it; const int kb = r / 176, nb = r % 176; const int n = nb * 32;
            const int half = n >= DFF ? 1 : 0, nn = n - half * DFF; const int drow = (nn >> 7) * 256 + half * 128 + (nn & 127);
            tr_item(second ? w2i : w1i, 2 * DFF, n, kb * 64, second ? g2 : g1, (bf16*)(ws + (second ? WS_W2IN : WS_W1IN)), D, drow, scr, lane);
        } else if (it < S2 || it >= S13) {
            const bool second = it >= S13; const int r = second ? it - S13 : it - S1; const int kb = r / 32, nb = r % 32;
            tr_item(second ? w2o : w1o, D, nb * 32, kb * 64, nullptr, (bf16*)(ws + (second ? WS_W2OUT : WS_W1OUT)), DFF, nb * 32, scr, lane);
        } else if (it < S3) { const int r = it - S2, kb = r / 128, nb = r % 128; tr_item(win, INW, nb * 32, kb * 64, gm, (bf16*)(ws + WS_WIN), D, nb * 32, scr, lane);
        } else if (it < S4) { const int r = it - S3, kb = r / 96, nb = r % 96; tr_item(win, INW, 4104 + nb * 32, kb * 64, gm, (bf16*)(ws + WS_WG), D, nb * 32, scr, lane);
        } else if (it < S5) { const int r = it - S4, kb = r / 32, nb = r % 32; tr_item(wub, D, nb * 32, kb * 64, nullptr, (bf16*)(ws + WS_UB), D, nb * 32, scr, lane);
        } else if (it < S6) { const int r = it - S5, kb = r / 32, nb = r % 32; tr_item(wuc, D, nb * 32, kb * 64, nullptr, (bf16*)(ws + WS_UC), 512, nb * 32, scr, lane);
        } else if (it < S8) { const bool xg = it >= S7; const int r = xg ? it - S7 : it - S6; const int hh = r >> 3, kb = (r >> 2) & 1, nb = r & 3;
            tr_item((xg ? wrx : wra) + hh * 16384, 128, nb * 32, kb * 64, nullptr, (bf16*)(ws + (xg ? WS_WXT : WS_WAT)) + hh * 16384, 128, nb * 32, scr, lane);
        } else if (it < S9) { const int r = it - S8, kb = r / 32, nb = r % 32; tr_item(wo, D, nb * 32, kb * 64, nullptr, (bf16*)(ws + WS_WO), D, nb * 32, scr, lane);
        } else if (it < S10) { const int r = it - S9, kb = r / 32, nb = r % 32; tr_item(wxq, D, nb * 32, kb * 64, gc, (bf16*)(ws + WS_WXQ), D, nb * 32, scr, lane);
        } else if (it < S11) { const int r = it - S10, kb = r / 64, nb = r % 64; tr_item(wxkv, 2 * D, nb * 32, kb * 64, nullptr, (bf16*)(ws + WS_WXKV), D, nb * 32, scr, lane);
        } else { const int r = it - S11, kb = r / 32, nb = r % 32; tr_item(wxo, D, nb * 32, kb * 64, nullptr, (bf16*)(ws + WS_WXO), D, nb * 32, scr, lane); }
    }
    { bf16* UaT = (bf16*)(ws + WS_UA);
      for (int it = gw; it < 512 * 16; it += NGW) { const int k = it >> 4, n = (it & 15) * 64 + lane, g = k >> 7, c = k & 127;
          const float* wp = wpool + ((size_t)g * 128 + c) * 128; const float* sc = psc + g * 128; const float* ua = wua + (size_t)(g * 128) * D + n; float acc = 0.f;
#pragma unroll 32
          for (int j = 0; j < 128; ++j) acc += wp[j] * sc[j] * ua[(size_t)j * D];
          UaT[(size_t)n * 512 + k] = (bf16)f2bf(acc); } }
    { float* wfl = (float*)(ws + WS_WFL);
      for (int it = gw * 64 + lane; it < 8 * 1024; it += NGW * 64) { const int h = it >> 10, k = it & 1023; wfl[it] = gm[k] * win[(size_t)k * INW + 4096 + h]; } }
    { const float* mem = tab_in(TB, 1); bf16* mn = (bf16*)(ws + WS_MEMN);
      for (int r = gw; r < 512; r += NGW) { const f32x4* xr = (const f32x4*)(mem + (size_t)r * D) + lane; f32x4 v[4]; float s = 0.f;
#pragma unroll
          for (int j = 0; j < 4; ++j) { v[j] = xr[64 * j]; s += (v[j].x * v[j].x + v[j].y * v[j].y) + (v[j].z * v[j].z + v[j].w * v[j].w); }
          const float rs = rsqrtf(wave_sum(s, lane) * (1.f / D) + 1e-6f); unsigned long long* o8 = (unsigned long long*)(mn + (size_t)r * D) + lane;
#pragma unroll
          for (int j = 0; j < 4; ++j) { const f32x4 gv = *((const f32x4*)gmem + lane + 64 * j);
              o8[64 * j] = (unsigned long long)pk2(v[j].x * rs * gv.x, v[j].y * rs * gv.y) | ((unsigned long long)pk2(v[j].z * rs * gv.z, v[j].w * rs * gv.w) << 32); } } }
    if (l == 0) {
        const float* x = tab_in(TB, 0); float* xo = xout; bf16* xb = (bf16*)(ws + WS_XB); float* ss = (float*)(ws + WS_SSP);
        for (int r = gw; r < M; r += NGW) { const f32x4* xr = (const f32x4*)(x + (size_t)r * D) + lane; f32x4* orow = (f32x4*)(xo + (size_t)r * D) + lane; f32x4 v[4]; float s = 0.f;
#pragma unroll
            for (int j = 0; j < 4; ++j) { v[j] = xr[64 * j]; orow[64 * j] = v[j]; s += (v[j].x * v[j].x + v[j].y * v[j].y) + (v[j].z * v[j].z + v[j].w * v[j].w); }
            s = wave_sum(s, lane); if (lane < 16) ss[(size_t)r * 16 + lane] = lane == 0 ? s : 0.f; unsigned long long* o8 = (unsigned long long*)(xb + (size_t)r * D) + lane;
#pragma unroll
            for (int j = 0; j < 4; ++j) o8[64 * j] = (unsigned long long)pk2(v[j].x, v[j].y) | ((unsigned long long)pk2(v[j].z, v[j].w) << 32); }
    }
}
#undef g1
#undef w1i
#undef w1o
#undef gm
#undef win
#undef wpool
#undef psc
#undef wua
#undef wra
#undef wrx
#undef wub
#undef wuc
#undef wo
#undef gc
#undef gmem
#undef wxq
#undef wxkv
#undef wxo
#undef g2
#undef w2i
#undef w2o
__device__ __forceinline__ void phase_fl(const bf16* xb, const float* wfl, const float* bfv, const float* ss, float* logf, int gw, int NGW, int lane) {
    for (int r = gw; r < M; r += NGW) {
        float acc[8];
#pragma unroll
        for (int h = 0; h < 8; ++h) acc[h] = 0.f;
#pragma unroll
        for (int j = 0; j < 2; ++j) { const int k0 = 8 * lane + 512 * j; const v4u xv = *(const v4u*)(xb + (size_t)r * D + k0);
            float xf[8]; xf[0] = __uint_as_float(xv.x << 16); xf[1] = __uint_as_float(xv.x & 0xffff0000u); xf[2] = __uint_as_float(xv.y << 16); xf[3] = __uint_as_float(xv.y & 0xffff0000u);
            xf[4] = __uint_as_float(xv.z << 16); xf[5] = __uint_as_float(xv.z & 0xffff0000u); xf[6] = __uint_as_float(xv.w << 16); xf[7] = __uint_as_float(xv.w & 0xffff0000u);
#pragma unroll
            for (int h = 0; h < 8; ++h) { const f32x4 w0 = *(const f32x4*)(wfl + h * 1024 + k0), w1 = *(const f32x4*)(wfl + h * 1024 + k0 + 4);
                acc[h] += (xf[0] * w0.x + xf[1] * w0.y) + (xf[2] * w0.z + xf[3] * w0.w) + (xf[4] * w1.x + xf[5] * w1.y) + (xf[6] * w1.z + xf[7] * w1.w); } }
        const float rs = pg8::rstd_of(ss, r);
#pragma unroll
        for (int h = 0; h < 8; ++h) { const float z = wave_sum(acc[h], lane) * rs + bfv[h]; const float ls = -(fmaxf(-z, 0.f) + flog1p(__expf(-fabsf(z)))); if (lane == h) logf[(size_t)r * 8 + h] = ls; }
    }
}
__device__ __forceinline__ void cumsum_bh(const float* logf, float* ctil, int bh, int lane) {
    const int b = bh >> 3, h = bh & 7; const float* src = logf + ((size_t)b * SEQ + 128 * lane) * 8 + h; float s = 0.f;
#pragma unroll 16
    for (int i = 0; i < 128; ++i) s += src[(size_t)i * 8];
    float incl = s;
#pragma unroll
    for (int o = 1; o < 64; o <<= 1) { const float t = bperm(incl, lane - o); if (lane >= o) incl += t; }
    float run = incl - s; float* dst = ctil + (size_t)bh * SEQ + 128 * lane;
#pragma unroll 16
    for (int i = 0; i < 128; ++i) { run += src[(size_t)i * 8]; dst[i] = run * 1.4426950408889634f; }
}
__device__ __forceinline__ void phase_pool(const bf16* xa, bf16* ya, int gtid, int nthr) {
    for (int idx = gtid; idx < M * 64; idx += nthr) { const int m = idx >> 6, cgi = idx & 63, t = m & (SEQ - 1), w = 2 << (cgi >> 4), cnt = (t + 1 < w) ? t + 1 : w;
        float s[8], cur[8];
#pragma unroll
        for (int i = 0; i < 8; ++i) s[i] = 0.f;
        for (int j = 0; j < cnt; ++j) { const v4u xv = *(const v4u*)(xa + (size_t)(m - j) * 512 + 8 * cgi);
            float xf[8]; xf[0] = __uint_as_float(xv.x << 16); xf[1] = __uint_as_float(xv.x & 0xffff0000u); xf[2] = __uint_as_float(xv.y << 16); xf[3] = __uint_as_float(xv.y & 0xffff0000u);
            xf[4] = __uint_as_float(xv.z << 16); xf[5] = __uint_as_float(xv.z & 0xffff0000u); xf[6] = __uint_as_float(xv.w << 16); xf[7] = __uint_as_float(xv.w & 0xffff0000u);
#pragma unroll
            for (int i = 0; i < 8; ++i) { s[i] += xf[i]; if (j == 0) cur[i] = xf[i]; } }
        const float ic = 1.f / (float)cnt; v4u o;
        o.x = pk2(s[0] * ic - cur[0], s[1] * ic - cur[1]); o.y = pk2(s[2] * ic - cur[2], s[3] * ic - cur[3]); o.z = pk2(s[4] * ic - cur[4], s[5] * ic - cur[5]); o.w = pk2(s[6] * ic - cur[6], s[7] * ic - cur[7]);
        *(v4u*)(ya + (size_t)m * 512 + 8 * cgi) = o; }
}
__device__ __forceinline__ int crow16(int r, int hi) { return (r & 3) + 8 * (r >> 2) + 4 * hi; }
template <bool FINAL>
__device__ __forceinline__ void lru_item(LAS unsigned char* lds, int b, int hp, int ck, const bf16* xl, bf16* gg, const float* cw, const float* cb, const bf16* WaT, const bf16* WxT,
                                         const float* ba, const float* bx, const float* lam, float* summ) {
    int tid_o = threadIdx.x; asm volatile("" : "+v"(tid_o)); const int tid = tid_o, lane = tid & 63, wid = tid >> 6, r32 = lane & 31, hi = lane >> 5;
    const int t0 = ck * 128; const size_t m0 = (size_t)b * SEQ + t0; const int ch0 = hp * 256;
    constexpr int XP = 264;
    LAS bf16* xc = (LAS bf16*)lds; LAS float* h0s = (LAS float*)(lds + 128 * XP * 2);
    {
        const int cgi = tid & 31, tq = tid >> 5, c = ch0 + 8 * cgi;
        float w[4][8], bb[8];
#pragma unroll
        for (int k = 0; k < 4; ++k) { const f32x4 a = *(const f32x4*)(cw + k * 1024 + c), d = *(const f32x4*)(cw + k * 1024 + c + 4); w[k][0] = a.x; w[k][1] = a.y; w[k][2] = a.z; w[k][3] = a.w; w[k][4] = d.x; w[k][5] = d.y; w[k][6] = d.z; w[k][7] = d.w; }
        { const f32x4 a = *(const f32x4*)(cb + c), d = *(const f32x4*)(cb + c + 4); bb[0] = a.x; bb[1] = a.y; bb[2] = a.z; bb[3] = a.w; bb[4] = d.x; bb[5] = d.y; bb[6] = d.z; bb[7] = d.w; }
        v4u rw[11];
#pragma unroll
        for (int i = 0; i < 11; ++i) { const int tl = tq * 8 - 3 + i; rw[i] = (t0 + tl >= 0) ? *(const v4u*)(xl + (size_t)((long)m0 + tl) * 1024 + c) : (v4u){0u, 0u, 0u, 0u}; }
#pragma unroll
        for (int o = 0; o < 8; ++o) { float y[8];
#pragma unroll
            for (int j = 0; j < 8; ++j) y[j] = bb[j];
#pragma unroll
            for (int k = 0; k < 4; ++k) { const v4u xv = rw[o + k];
                y[0] += w[k][0] * __uint_as_float(xv.x << 16); y[1] += w[k][1] * __uint_as_float(xv.x & 0xffff0000u); y[2] += w[k][2] * __uint_as_float(xv.y << 16); y[3] += w[k][3] * __uint_as_float(xv.y & 0xffff0000u);
                y[4] += w[k][4] * __uint_as_float(xv.z << 16); y[5] += w[k][5] * __uint_as_float(xv.z & 0xffff0000u); y[6] += w[k][6] * __uint_as_float(xv.w << 16); y[7] += w[k][7] * __uint_as_float(xv.w & 0xffff0000u); }
            v4u ov; ov.x = pk2(y[0], y[1]); ov.y = pk2(y[2], y[3]); ov.z = pk2(y[4], y[5]); ov.w = pk2(y[6], y[7]);
            *(LAS v4u*)(xc + (tq * 8 + o) * XP + 8 * cgi) = ov; }
    }
    if (FINAL && tid < 256) {
        const float* sp = summ + ((size_t)b * 64 * 1024 + ch0 + tid) * 2; float h = 0.f;
#pragma unroll 8
        for (int c2 = 0; c2 < ck; ++c2) { const float2 v = *(const float2*)(sp + (size_t)c2 * 2048); h = v.x * h + v.y; }
        h0s[tid] = h;
    }
    __syncthreads();
    const int hh = wid >> 2, s = wid & 3, chl = 128 * hh + 32 * s + r32, ch = ch0 + chl, head = 2 * hp + hh;
    const float bav = ba[ch], bxv = bx[ch]; const float nl = -lam[ch]; const float sp8 = 8.f * (fmaxf(nl, 0.f) + flog1p(__expf(-fabsf(nl))));
    bf16x8 fa[8], fx[8];
#pragma unroll
    for (int ks = 0; ks < 8; ++ks) { fa[ks] = *(const bf16x8*)(WaT + (size_t)head * 16384 + (32 * s + r32) * 128 + 16 * ks + 8 * hi); fx[ks] = *(const bf16x8*)(WxT + (size_t)head * 16384 + (32 * s + r32) * 128 + 16 * ks + 8 * hi); }
    float hrun = FINAL ? h0s[chl] : 0.f, Arun = 1.f;
    for (int mb = 0; mb < 4; ++mb) {
        f32x16 accA = {0.f, 0.f, 0.f, 0.f, 0.f, 0.f, 0.f, 0.f, 0.f, 0.f, 0.f, 0.f, 0.f, 0.f, 0.f, 0.f}, accX = accA;
#pragma unroll
        for (int ks = 0; ks < 8; ++ks) { const bf16x8 af = *(const LAS bf16x8*)(xc + (32 * mb + r32) * XP + 128 * hh + 16 * ks + 8 * hi);
            accA = __builtin_amdgcn_mfma_f32_32x32x16_bf16(af, fa[ks], accA, 0, 0, 0); accX = __builtin_amdgcn_mfma_f32_32x32x16_bf16(af, fx[ks], accX, 0, 0, 0); }
        float a[16], u[16];
#pragma unroll
        for (int r = 0; r < 16; ++r) { const int tok = 32 * mb + crow16(r, hi); const float xcv = bf2f(xc[tok * XP + chl]);
            const float rg = pg8::fsig(accA[r] + bav), la = -rg * sp8, av = __expf(la), mult = sqrtf(fmaxf(1.f - __expf(2.f * la), 0.f)), ig = pg8::fsig(accX[r] + bxv);
            a[r] = av; u[r] = mult * ig * xcv; }
        float As[4], Hs[4], Ap[4], Hp[4], hin[4];
#pragma unroll
        for (int g = 0; g < 4; ++g) { float Aq = 1.f, Hq = 0.f;
#pragma unroll
            for (int i = 0; i < 4; ++i) { Hq = a[4 * g + i] * Hq + u[4 * g + i]; Aq *= a[4 * g + i]; }
            As[g] = Aq; Hs[g] = Hq; Ap[g] = bperm(Aq, lane ^ 32); Hp[g] = bperm(Hq, lane ^ 32); }
#pragma unroll
        for (int g = 0; g < 4; ++g) { const float A0 = hi ? Ap[g] : As[g], H0 = hi ? Hp[g] : Hs[g], A1 = hi ? As[g] : Ap[g], H1 = hi ? Hs[g] : Hp[g];
            const float hA = hrun, hB = A0 * hA + H0; hrun = A1 * hB + H1; Arun *= A0 * A1; hin[g] = hi ? hB : hA; }
        if (FINAL) {
#pragma unroll
            for (int g = 0; g < 4; ++g) { float hc = hin[g];
#pragma unroll
                for (int i = 0; i < 4; ++i) { const int r = 4 * g + i; hc = a[r] * hc + u[r]; bf16* p = gg + (m0 + 32 * mb + crow16(r, hi)) * 1024 + ch; *p = (bf16)f2bf(hc * bf2f(*p)); } }
        }
    }
    if (!FINAL && hi == 0) { float* sp = summ + (((size_t)b * 64 + ck) * 1024 + ch) * 2; sp[0] = Arun; sp[1] = hrun; }
    __syncthreads();
}
__device__ __forceinline__ void phase_final(float* x, const float* g, int gw, int NGW, int lane) {
    for (int r = gw; r < M; r += NGW) { f32x4* xr = (f32x4*)(x + (size_t)r * D) + lane; f32x4 v[4]; float s = 0.f;
#pragma unroll
        for (int j = 0; j < 4; ++j) { v[j] = xr[64 * j]; s += (v[j].x * v[j].x + v[j].y * v[j].y) + (v[j].z * v[j].z + v[j].w * v[j].w); }
        const float rs = rsqrtf(wave_sum(s, lane) * (1.f / D) + 1e-6f);
#pragma unroll
        for (int j = 0; j < 4; ++j) { const f32x4 gv = *((const f32x4*)g + lane + 64 * j); xr[64 * j] = (f32x4){v[j].x * rs * gv.x, v[j].y * rs * gv.y, v[j].z * rs * gv.z, v[j].w * rs * gv.w}; } }
}
__device__ __forceinline__ void phase_kmax(const bf16* K, float* kpart, int gw, int NGW, int lane) {
    float m0 = 0.f, m1 = 0.f;
    for (int r = gw; r < M; r += NGW) { const v4u w = *(const v4u*)(K + (size_t)r * 512 + 8 * lane);
        const float a0 = __uint_as_float(w.x << 16), a1 = __uint_as_float(w.x & 0xffff0000u), a2 = __uint_as_float(w.y << 16), a3 = __uint_as_float(w.y & 0xffff0000u);
        const float a4 = __uint_as_float(w.z << 16), a5 = __uint_as_float(w.z & 0xffff0000u), a6 = __uint_as_float(w.w << 16), a7 = __uint_as_float(w.w & 0xffff0000u);
        float s = (a0 * a0 + a1 * a1) + (a2 * a2 + a3 * a3) + (a4 * a4 + a5 * a5) + (a6 * a6 + a7 * a7);
        s += bperm(s, lane ^ 1); s += bperm(s, lane ^ 2); s += bperm(s, lane ^ 4);
        if (r < SEQ) m0 = fmaxf(m0, s); else m1 = fmaxf(m1, s); }
    if ((lane & 7) == 0) { kpart[((size_t)gw * 2 + 0) * 8 + (lane >> 3)] = m0; kpart[((size_t)gw * 2 + 1) * 8 + (lane >> 3)] = m1; }
}
constexpr float FOX_C2 = 0.125f * 1.4426950408889634f;
constexpr float FOX_SKIP = 64.f;
constexpr int FOX_KP = 72;
constexpr int FOX_BUF = 2 * 64 * FOX_KP * 2 + 256;
__device__ __forceinline__ void fox_unit(LAS unsigned char* lds, int b, int h, int qb, const bf16* Q, const bf16* K, const bf16* V, bf16* O, const float* ct, const float* kpart, int nparts) {
    int tid_o = threadIdx.x; asm volatile("" : "+v"(tid_o)); const int tid = tid_o, lane = tid & 63, wid = tid >> 6, r32 = lane & 31, hi = lane >> 5;
    const size_t rowbase = (size_t)b * SEQ; const int q0 = qb * 256, NT = 4 * qb + 4;
    const bf16* Qw = Q + (rowbase + q0 + wid * 32 + r32) * 512 + h * 64;
    bf16x8 qr[4];
#pragma unroll
    for (int d0 = 0; d0 < 4; ++d0) qr[d0] = *(const bf16x8*)(Qw + 16 * d0 + 8 * hi);
    LAS float* red = (LAS float*)(lds + 2 * FOX_BUF); LAS int* tsl = (LAS int*)(lds + 2 * FOX_BUF + 128);
    { float qn = 0.f;
#pragma unroll
      for (int d0 = 0; d0 < 4; ++d0) { const v4u w = __builtin_bit_cast(v4u, qr[d0]);
          const float a0 = __uint_as_float(w.x << 16), a1 = __uint_as_float(w.x & 0xffff0000u), a2 = __uint_as_float(w.y << 16), a3 = __uint_as_float(w.y & 0xffff0000u);
          const float a4 = __uint_as_float(w.z << 16), a5 = __uint_as_float(w.z & 0xffff0000u), a6 = __uint_as_float(w.w << 16), a7 = __uint_as_float(w.w & 0xffff0000u);
          qn += (a0 * a0 + a1 * a1) + (a2 * a2 + a3 * a3) + (a4 * a4 + a5 * a5) + (a6 * a6 + a7 * a7); }
      qn += bperm(qn, lane ^ 32);
#pragma unroll
      for (int o = 1; o < 32; o <<= 1) qn = fmaxf(qn, bperm(qn, lane ^ o));
      __syncthreads();
      float km = 0.f;
      for (int i = tid; i < nparts; i += NTHR) km = fmaxf(km, kpart[((size_t)i * 2 + b) * 8 + h]);
#pragma unroll
      for (int o = 1; o < 64; o <<= 1) km = fmaxf(km, bperm(km, lane ^ o));
      if (lane == 0) { red[wid] = qn; red[8 + wid] = km; } if (tid == 0) tsl[0] = 4 * qb;
      __syncthreads();
      float q2 = red[0], k2 = red[8];
#pragma unroll
      for (int w = 1; w < 8; ++w) { q2 = fmaxf(q2, red[w]); k2 = fmaxf(k2, red[8 + w]); }
      const float thr = 2.f * sqrtf(q2) * sqrtf(k2) * 1.0001f + FOX_SKIP;
      const float c0 = ct[q0];
      if (tid < 4 * qb && ct[64 * tid + 63] - c0 <= thr) atomicMin((int*)tsl, tid);
      __syncthreads(); }
    const int T0 = tsl[0];
    const int skey = tid >> 3, sd = (tid & 7) * 8;
    const bf16* kp = K + (rowbase + skey) * 512 + h * 64 + sd; const bf16* vp = V + (rowbase + skey) * 512 + h * 64 + sd;
    v4u kreg = *(const v4u*)(kp + (size_t)T0 * 64 * 512), vreg = *(const v4u*)(vp + (size_t)T0 * 64 * 512); float creg = (tid < 64) ? ct[64 * T0 + tid] : 0.f;
    __syncthreads();
    { LAS unsigned char* buf0 = lds + (T0 & 1) * FOX_BUF; LAS bf16* Ks = (LAS bf16*)buf0; LAS bf16* Vt = Ks + 64 * FOX_KP; LAS float* Cs = (LAS float*)(buf0 + 2 * 64 * FOX_KP * 2);
      *(LAS v4u*)(Ks + skey * FOX_KP + sd) = kreg;
      Vt[(sd + 0) * FOX_KP + skey] = (bf16)(vreg.x & 0xffffu); Vt[(sd + 1) * FOX_KP + skey] = (bf16)(vreg.x >> 16); Vt[(sd + 2) * FOX_KP + skey] = (bf16)(vreg.y & 0xffffu); Vt[(sd + 3) * FOX_KP + skey] = (bf16)(vreg.y >> 16);
      Vt[(sd + 4) * FOX_KP + skey] = (bf16)(vreg.z & 0xffffu); Vt[(sd + 5) * FOX_KP + skey] = (bf16)(vreg.z >> 16); Vt[(sd + 6) * FOX_KP + skey] = (bf16)(vreg.w & 0xffffu); Vt[(sd + 7) * FOX_KP + skey] = (bf16)(vreg.w >> 16);
      if (tid < 64) Cs[tid] = creg; }
    if (T0 + 1 < NT) { kreg = *(const v4u*)(kp + (size_t)(T0 + 1) * 64 * 512); vreg = *(const v4u*)(vp + (size_t)(T0 + 1) * 64 * 512); if (tid < 64) creg = ct[64 * (T0 + 1) + tid]; }
    float m = -1e30f, l = 0.f; f32x16 o0, o1;
#pragma unroll
    for (int r = 0; r < 16; ++r) { o0[r] = 0.f; o1[r] = 0.f; }
    for (int t = T0; t < NT; ++t) {
        __syncthreads();
        if (t + 1 < NT) { LAS unsigned char* bufn = lds + ((t + 1) & 1) * FOX_BUF; LAS bf16* Ks = (LAS bf16*)bufn; LAS bf16* Vt = Ks + 64 * FOX_KP; LAS float* Cs = (LAS float*)(bufn + 2 * 64 * FOX_KP * 2);
            *(LAS v4u*)(Ks + skey * FOX_KP + sd) = kreg;
            Vt[(sd + 0) * FOX_KP + skey] = (bf16)(vreg.x & 0xffffu); Vt[(sd + 1) * FOX_KP + skey] = (bf16)(vreg.x >> 16); Vt[(sd + 2) * FOX_KP + skey] = (bf16)(vreg.y & 0xffffu); Vt[(sd + 3) * FOX_KP + skey] = (bf16)(vreg.y >> 16);
            Vt[(sd + 4) * FOX_KP + skey] = (bf16)(vreg.z & 0xffffu); Vt[(sd + 5) * FOX_KP + skey] = (bf16)(vreg.z >> 16); Vt[(sd + 6) * FOX_KP + skey] = (bf16)(vreg.w & 0xffffu); Vt[(sd + 7) * FOX_KP + skey] = (bf16)(vreg.w >> 16);
            if (tid < 64) Cs[tid] = creg;
            if (t + 2 < NT) { kreg = *(const v4u*)(kp + (size_t)(t + 2) * 64 * 512); vreg = *(const v4u*)(vp + (size_t)(t + 2) * 64 * 512); if (tid < 64) creg = ct[64 * (t + 2) + tid]; } }
        const int jb = t - (NT - 4);
        if (jb >= 0 && 64 * jb > 32 * wid + 31) continue;
        LAS unsigned char* buf = lds + (t & 1) * FOX_BUF; const LAS bf16* Ks = (const LAS bf16*)buf; const LAS bf16* Vt = Ks + 64 * FOX_KP; const LAS float* Cs = (const LAS float*)(buf + 2 * 64 * FOX_KP * 2);
        f32x16 p0, p1;
#pragma unroll
        for (int g = 0; g < 4; ++g) { const f32x4 a = *(const LAS f32x4*)(Cs + 8 * g + 4 * hi), c = *(const LAS f32x4*)(Cs + 32 + 8 * g + 4 * hi);
            p0[4 * g + 0] = -a[0]; p0[4 * g + 1] = -a[1]; p0[4 * g + 2] = -a[2]; p0[4 * g + 3] = -a[3]; p1[4 * g + 0] = -c[0]; p1[4 * g + 1] = -c[1]; p1[4 * g + 2] = -c[2]; p1[4 * g + 3] = -c[3]; }
#pragma unroll
        for (int d0 = 0; d0 < 4; ++d0) { const bf16x8 a0 = *(const LAS bf16x8*)(Ks + r32 * FOX_KP + 16 * d0 + 8 * hi), a1 = *(const LAS bf16x8*)(Ks + (32 + r32) * FOX_KP + 16 * d0 + 8 * hi);
            p0 = __builtin_amdgcn_mfma_f32_32x32x16_bf16(a0, qr[d0], p0, 0, 0, 0); p1 = __builtin_amdgcn_mfma_f32_32x32x16_bf16(a1, qr[d0], p1, 0, 0, 0); }
        if (jb >= 0) { const int qrel = 32 * wid + r32, kb = 64 * jb + 4 * hi;
#pragma unroll
            for (int r = 0; r < 16; ++r) { const int kv = kb + (r & 3) + 8 * (r >> 2); if (kv > qrel) p0[r] = -__builtin_inff(); if (kv + 32 > qrel) p1[r] = -__builtin_inff(); } }
        float mx = fmaxf(p0[0], p1[0]);
#pragma unroll
        for (int r = 1; r < 16; ++r) mx = fmaxf(mx, fmaxf(p0[r], p1[r]));
        mx = fmaxf(mx, bperm(mx, lane ^ 32));
        const float mn = fmaxf(m, mx), alpha = __builtin_amdgcn_exp2f(m - mn); m = mn;
        float sum = 0.f;
#pragma unroll
        for (int r = 0; r < 16; ++r) { p0[r] = __builtin_amdgcn_exp2f(p0[r] - mn); p1[r] = __builtin_amdgcn_exp2f(p1[r] - mn); sum += p0[r] + p1[r]; }
        l = l * alpha + sum;
#pragma unroll
        for (int r = 0; r < 16; ++r) { o0[r] *= alpha; o1[r] *= alpha; }
        bf16x8 pb[4];
        { v4u w;
          w.x = pg8::cvt_pk_bf16(p0[0], p0[1]); w.y = pg8::cvt_pk_bf16(p0[2], p0[3]); w.z = pg8::cvt_pk_bf16(p0[4], p0[5]); w.w = pg8::cvt_pk_bf16(p0[6], p0[7]); pb[0] = __builtin_bit_cast(bf16x8, w);
          w.x = pg8::cvt_pk_bf16(p0[8], p0[9]); w.y = pg8::cvt_pk_bf16(p0[10], p0[11]); w.z = pg8::cvt_pk_bf16(p0[12], p0[13]); w.w = pg8::cvt_pk_bf16(p0[14], p0[15]); pb[1] = __builtin_bit_cast(bf16x8, w);
          w.x = pg8::cvt_pk_bf16(p1[0], p1[1]); w.y = pg8::cvt_pk_bf16(p1[2], p1[3]); w.z = pg8::cvt_pk_bf16(p1[4], p1[5]); w.w = pg8::cvt_pk_bf16(p1[6], p1[7]); pb[2] = __builtin_bit_cast(bf16x8, w);
          w.x = pg8::cvt_pk_bf16(p1[8], p1[9]); w.y = pg8::cvt_pk_bf16(p1[10], p1[11]); w.z = pg8::cvt_pk_bf16(p1[12], p1[13]); w.w = pg8::cvt_pk_bf16(p1[14], p1[15]); pb[3] = __builtin_bit_cast(bf16x8, w); }
#pragma unroll
        for (int mm = 0; mm < 4; ++mm) {
            typedef unsigned u32x2v __attribute__((ext_vector_type(2)));
            const u32x2v a0l = *(const LAS u32x2v*)(Vt + r32 * FOX_KP + 16 * mm + 4 * hi), a0h = *(const LAS u32x2v*)(Vt + r32 * FOX_KP + 16 * mm + 8 + 4 * hi);
            const u32x2v a1l = *(const LAS u32x2v*)(Vt + (32 + r32) * FOX_KP + 16 * mm + 4 * hi), a1h = *(const LAS u32x2v*)(Vt + (32 + r32) * FOX_KP + 16 * mm + 8 + 4 * hi);
            const v4u A0 = {a0l.x, a0l.y, a0h.x, a0h.y}, A1 = {a1l.x, a1l.y, a1h.x, a1h.y};
            o0 = __builtin_amdgcn_mfma_f32_32x32x16_bf16(__builtin_bit_cast(bf16x8, A0), pb[mm], o0, 0, 0, 0);
            o1 = __builtin_amdgcn_mfma_f32_32x32x16_bf16(__builtin_bit_cast(bf16x8, A1), pb[mm], o1, 0, 0, 0); }
    }
    l += bperm(l, lane ^ 32); const float inv = 1.f / l;
    bf16* Ow = O + (rowbase + q0 + wid * 32 + r32) * 512 + h * 64;
#pragma unroll
    for (int g = 0; g < 4; ++g) { typedef unsigned u32x2v __attribute__((ext_vector_type(2)));
        u32x2v w0, w1; w0.x = pg8::cvt_pk_bf16(o0[4 * g] * inv, o0[4 * g + 1] * inv); w0.y = pg8::cvt_pk_bf16(o0[4 * g + 2] * inv, o0[4 * g + 3] * inv);
        w1.x = pg8::cvt_pk_bf16(o1[4 * g] * inv, o1[4 * g + 1] * inv); w1.y = pg8::cvt_pk_bf16(o1[4 * g + 2] * inv, o1[4 * g + 3] * inv);
        *(u32x2v*)(Ow + 8 * g + 4 * hi) = w0; *(u32x2v*)(Ow + 32 + 8 * g + 4 * hi) = w1; }
    __syncthreads();
}
__global__ void __launch_bounds__(NTHR, 2) hybrid_fwd(Args args) {
    extern __shared__ __attribute__((aligned(16))) unsigned char lds_raw[];
    cg::grid_group grid = cg::this_grid();
    LAS unsigned char* lds = (LAS unsigned char*)lds_raw;
    int tid = threadIdx.x, lane = tid & 63, wave = __builtin_amdgcn_readfirstlane(tid >> 6);
    int G = gridDim.x, bx = blockIdx.x;
    int vcu = (G % 8 == 0) ? (bx % 8) * (G / 8) + bx / 8 : bx;
    int gw = vcu * NWAVES + wave; int NGW = G * NWAVES;
    PtrTab TB = (PtrTab)(lds + TAB_OFF);
    if (tid == 0) {
#pragma unroll
        for (int i = 0; i < 31; ++i) TB[i] = (unsigned long long)args.in[i];
    }
    if (tid == 1) { TB[40] = 0ull; }
    __syncthreads();
    (void)xcd_barrier_post((unsigned*)(args.ws + WS_BAR), (volatile LAS unsigned*)(lds + TAB_OFF + 320));
    grid.sync();
    unsigned char* ws = args.ws;
    float* X = args.out;
    float* SS = (float*)(ws + WS_SSP);
    bf16* XB = (bf16*)(ws + WS_XB);
    bf16* HB = (bf16*)(ws + WS_H);
    constexpr float C2X = 0.0625f * 1.4426950408889634f;
#define GSYNC() do { asm volatile("s_waitcnt vmcnt(0) lgkmcnt(0)" ::: "memory"); { XcdBarrier xb_; xb_.bar = (unsigned*)(ws + WS_BAR); xb_.x = xb_xcc_id(); xb_.st = (volatile LAS unsigned*)(lds + TAB_OFF + 320); xcd_barrier(xb_); } tid = threadIdx.x; asm volatile("" : "+v"(tid)); lane = tid & 63; wave = __builtin_amdgcn_readfirstlane(tid >> 6); G = gridDim.x; bx = blockIdx.x; asm volatile("" : "+s"(G), "+s"(bx)); vcu = (G % 8 == 0) ? (bx % 8) * (G / 8) + bx / 8 : bx; gw = vcu * NWAVES + wave; NGW = G * NWAVES; { unsigned long long wsi_ = (unsigned long long)ws; asm volatile("" : "+s"(wsi_)); ws = (unsigned char*)(GAS unsigned char*)wsi_; } } while (0)

    for (int l = 0; l < DEPTH; ++l) {
        float* ss0 = SS + (size_t)(4 * l + 0) * M * 16; float* ss1 = SS + (size_t)(4 * l + 1) * M * 16; float* ss2 = SS + (size_t)(4 * l + 2) * M * 16; float* ss3 = SS + (size_t)(4 * l + 3) * M * 16; float* ss4 = SS + (size_t)(4 * l + 4) * M * 16;
        phase_prologue(TB, ws, X, l, lds, gw, NGW, lane, wave);
        GSYNC();
        { pg8::Gemm g{XB, (const bf16*)(ws + WS_W1IN), M, 2 * DFF, D, D, D, 0}; pg8::StaticOrder S; S.init(M, 2 * DFF, G, bx);
          pg8::EpiSwiglu E{HB, ss0, DFF};
          pg8::gemm_phase<pg8::EpiSwiglu, pg8::StaticOrder, true, true>(lds, g, S, E); }
        if (bx >= G / 2) { pg8::Gemm g{(const bf16*)(ws + WS_MEMN), (const bf16*)(ws + WS_WXKV), 512, 2 * D, D, D, D, 0}; pg8::StaticOrder S; S.init(512, 2 * D, G, bx - G / 2);
          pg8::EpiKV E{(bf16*)(ws + WS_KX), (bf16*)(ws + WS_VT)};
          pg8::gemm_phase<pg8::EpiKV, pg8::StaticOrder, true, true>(lds, g, S, E); }
        GSYNC();
        { pg8::Gemm g{HB, (const bf16*)(ws + WS_W1OUT), M, D, DFF, DFF, DFF, 0}; pg8::StaticOrder S; S.init(M, D, G, bx);
          pg8::EpiResid E{X, XB, ss1, 0.5f};
          pg8::gemm_phase<pg8::EpiResid, pg8::StaticOrder, true, true>(lds, g, S, E); }
        GSYNC();
        { pg8::Gemm g{XB, (const bf16*)(ws + WS_WIN), M, 4096, D, D, D, 0}; pg8::StaticOrder S; S.init(M, 4096, G, bx);
          pg8::EpiWin E{(bf16*)(ws + WS_XA), (bf16*)(ws + WS_XL), (bf16*)(ws + WS_GG), (bf16*)(ws + WS_Q), (bf16*)(ws + WS_K), (bf16*)(ws + WS_V), ss1, FOX_C2};
          pg8::gemm_phase<pg8::EpiWin, pg8::StaticOrder, true, true>(lds, g, S, E); }
        phase_fl(XB, (const float*)(ws + WS_WFL), tab_in(TB, 7) + l * 8, ss1, (float*)(ws + WS_LOGF), gw, NGW, lane);
        GSYNC();
        if (wave == 0 && vcu < 16) cumsum_bh((const float*)(ws + WS_LOGF), (float*)(ws + WS_CTIL), vcu, lane);
        __syncthreads();
        for (int it = vcu; it < 512; it += G)
            lru_item<false>(lds, it >> 8, (it >> 6) & 3, it & 63, (const bf16*)(ws + WS_XL), (bf16*)(ws + WS_GG), tab_in(TB, 12) + (size_t)l * 4 * D, tab_in(TB, 13) + l * D, (const bf16*)(ws + WS_WAT), (const bf16*)(ws + WS_WXT),
                            tab_in(TB, 15) + l * D, tab_in(TB, 17) + l * D, tab_in(TB, 18) + l * D, (float*)(ws + WS_SUMM));
        phase_pool((const bf16*)(ws + WS_XA), (bf16*)(ws + WS_YA), vcu * NTHR + tid, G * NTHR);
        phase_kmax((const bf16*)(ws + WS_K), (float*)(ws + WS_KPART), gw, NGW, lane);
        GSYNC();
        for (int it = vcu; it < 512; it += G)
            lru_item<true>(lds, it >> 8, (it >> 6) & 3, it & 63, (const bf16*)(ws + WS_XL), (bf16*)(ws + WS_GG), tab_in(TB, 12) + (size_t)l * 4 * D, tab_in(TB, 13) + l * D, (const bf16*)(ws + WS_WAT), (const bf16*)(ws + WS_WXT),
                           tab_in(TB, 15) + l * D, tab_in(TB, 17) + l * D, tab_in(TB, 18) + l * D, (float*)(ws + WS_SUMM));
        for (int p = vcu; p < 256; p += G) { const int bh = p >> 4, s = p & 15;
            fox_unit(lds, bh >> 3, bh & 7, s, (const bf16*)(ws + WS_Q), (const bf16*)(ws + WS_K), (const bf16*)(ws + WS_V), (bf16*)(ws + WS_YC), (const float*)(ws + WS_CTIL) + (size_t)bh * SEQ, (const float*)(ws + WS_KPART), NGW);
            fox_unit(lds, bh >> 3, bh & 7, 31 - s, (const bf16*)(ws + WS_Q), (const bf16*)(ws + WS_K), (const bf16*)(ws + WS_V), (bf16*)(ws + WS_YC), (const float*)(ws + WS_CTIL) + (size_t)bh * SEQ, (const float*)(ws + WS_KPART), NGW); }
        GSYNC();
        { pg8::StaticOrder S; S.init(M, D, G, bx); pg8::Unit u;
          bf16* stash = (bf16*)(ws + WS_STASH) + (size_t)bx * 65536; bf16* mg = (bf16*)(ws + WS_MG);
          for (int i = 0; S.next(i, u); ++i) { const pg8::OneUnit O1{u.pm, u.pn};
#pragma unroll 1
              for (int br = 0; br < 3; ++br) {
                  { pg8::Gemm g{XB, (const bf16*)(ws + WS_WG) + (size_t)br * D * D, M, D, D, D, D, 0}; pg8::EpiGate E{stash, tab_in(TB, 8) + (size_t)l * 3 * D + br * D, ss1};
                    pg8::gemm_phase<pg8::EpiGate, pg8::OneUnit, true, true>(lds, g, O1, E); }
                  asm volatile("s_waitcnt vmcnt(0)" ::: "memory"); __builtin_amdgcn_fence(__ATOMIC_ACQUIRE, "agent"); __syncthreads();
                  const bf16* Ab = br == 0 ? (const bf16*)(ws + WS_YA) : br == 1 ? (const bf16*)(ws + WS_GG) : (const bf16*)(ws + WS_YC);
                  const bf16* Ub = br == 0 ? (const bf16*)(ws + WS_UA) : br == 1 ? (const bf16*)(ws + WS_UB) : (const bf16*)(ws + WS_UC);
                  const int Kb = br == 1 ? 1024 : 512;
                  { pg8::Gemm g{Ab, Ub, M, D, Kb, Kb, Kb, 0}; pg8::EpiMerge E{stash, mg, br == 0 ? 1 : 0};
                    pg8::gemm_phase<pg8::EpiMerge, pg8::OneUnit, true, true>(lds, g, O1, E); }
                  asm volatile("s_waitcnt vmcnt(0)" ::: "memory"); __builtin_amdgcn_fence(__ATOMIC_ACQUIRE, "agent"); __syncthreads();
              } } }
        GSYNC();
        { pg8::Gemm g{(const bf16*)(ws + WS_MG), (const bf16*)(ws + WS_WO), M, D, D, D, D, 0}; pg8::StaticOrder S; S.init(M, D, G, bx);
          pg8::EpiResid E{X, XB, ss2, 1.0f};
          pg8::gemm_phase<pg8::EpiResid, pg8::StaticOrder, true, true>(lds, g, S, E); }
        GSYNC();
        { pg8::Gemm g{XB, (const bf16*)(ws + WS_WXQ), M, D, D, D, D, 0}; pg8::StaticOrder S; S.init(M, D, G, bx);
          pg8::EpiRs E{(bf16*)(ws + WS_QX), D, ss2, C2X};
          pg8::gemm_phase<pg8::EpiRs, pg8::StaticOrder, true, true>(lds, g, S, E); }
        GSYNC();
        { bf16* pb = (bf16*)(ws + WS_PBUF) + (size_t)bx * 65536; const pg8::OneUnit O1{0, 0};
          for (int uid = vcu; uid < 256; uid += G) { const int rt = uid >> 2, h = uid & 3, b = rt >> 5;
              int KX = 256; asm volatile("" : "+s"(KX));
              bf16* qo = (bf16*)(ws + WS_QX) + (size_t)rt * 256 * D + h * 256;
              { pg8::Gemm g{qo, (const bf16*)(ws + WS_KX) + (size_t)b * 256 * D + h * 256, 256, 256, KX, D, D, 0}; pg8::EpiSoftmaxP E{pb};
                pg8::gemm_phase<pg8::EpiSoftmaxP, pg8::OneUnit, false, true>(lds, g, O1, E); }
              asm volatile("s_waitcnt vmcnt(0)" ::: "memory"); __builtin_amdgcn_fence(__ATOMIC_ACQUIRE, "agent"); __syncthreads();
              { pg8::Gemm g{pb, (const bf16*)(ws + WS_VT) + (size_t)(b * 4 + h) * 65536, 256, 256, KX, 256, 256, 0}; pg8::EpiRs E{qo, D, nullptr, 1.0f};
                pg8::gemm_phase<pg8::EpiRs, pg8::OneUnit, true, true>(lds, g, O1, E); }
              asm volatile("s_waitcnt vmcnt(0)" ::: "memory"); __syncthreads();
          } }
        GSYNC();
        { pg8::Gemm g{(const bf16*)(ws + WS_QX), (const bf16*)(ws + WS_WXO), M, D, D, D, D, 0}; pg8::StaticOrder S; S.init(M, D, G, bx);
          pg8::EpiResid E{X, XB, ss3, 1.0f};
          pg8::gemm_phase<pg8::EpiResid, pg8::StaticOrder, true, true>(lds, g, S, E); }
        GSYNC();
        { pg8::Gemm g{XB, (const bf16*)(ws + WS_W2IN), M, 2 * DFF, D, D, D, 0}; pg8::StaticOrder S; S.init(M, 2 * DFF, G, bx);
          pg8::EpiSwiglu E{HB, ss3, DFF};
          pg8::gemm_phase<pg8::EpiSwiglu, pg8::StaticOrder, true, true>(lds, g, S, E); }
        GSYNC();
        { pg8::Gemm g{HB, (const bf16*)(ws + WS_W2OUT), M, D, DFF, DFF, DFF, 0}; pg8::StaticOrder S; S.init(M, D, G, bx);
          pg8::EpiResid E{X, XB, ss4, 0.5f};
          pg8::gemm_phase<pg8::EpiResid, pg8::StaticOrder, true, true>(lds, g, S, E); }
        GSYNC();
    }
    phase_final(X, tab_in(TB, 30), gw, NGW, lane);
#undef GSYNC
}

extern "C" void kernel_launch(void* const* d_in, const int* in_sizes, int n_in, void* d_out, int out_size, void* d_ws, size_t ws_size, hipStream_t stream) {
    static int grid = 0;
    if (grid == 0) {
        if (n_in != 31 || out_size != M * D || ws_size < WS_END) { fprintf(stderr, "kernel_launch: unexpected problem (n_in %d, out %d, ws %zu)\n", n_in, out_size, ws_size); grid = -1; return; }
        int dev = 0, cus = 0, per_cu = 0;
        (void)hipGetDevice(&dev); (void)hipDeviceGetAttribute(&cus, hipDeviceAttributeMultiprocessorCount, dev);
        if (hipFuncSetAttribute((const void*)hybrid_fwd, hipFuncAttributeMaxDynamicSharedMemorySize, LDS_BYTES) != hipSuccess) { fprintf(stderr, "kernel_launch: hipFuncSetAttribute failed\n"); grid = -1; return; }
        if (hipOccupancyMaxActiveBlocksPerMultiprocessor(&per_cu, (const void*)hybrid_fwd, NTHR, LDS_BYTES) != hipSuccess || per_cu < 1) per_cu = 1;
        (void)hipGetLastError();
        grid = cus * (per_cu > 1 ? 1 : per_cu);
        if (grid > 256) grid = 256;
    }
    if (grid < 0) return;
    (void)hipMemsetAsync((char*)d_ws + WS_SS, 0, CTL_ZERO_BYTES, stream);
    Args a{};
    for (int i = 0; i < 31; ++i) a.in[i] = (const float*)d_in[i];
    a.out = (float*)d_out; a.ws = (unsigned char*)d_ws;
    void* kargs[] = {&a};
    hipError_t e = hipLaunchCooperativeKernel((const void*)hybrid_fwd, dim3(grid), dim3(NTHR), kargs, LDS_BYTES, stream);
    if (e != hipSuccess) fprintf(stderr, "cooperative launch failed: %s (grid %d)\n", hipGetErrorString(e), grid);
}
```

```cpp
#include <hip/hip_runtime.h>
#include <hip/hip_cooperative_groups.h>
#include <cstdio>
#include <cstdint>
namespace cg = cooperative_groups;
namespace pg8 {
#define PG8_LAS __attribute__((address_space(3)))
typedef unsigned short bf16_t;
typedef short bf16x8 __attribute__((ext_vector_type(8)));
typedef float f32x4 __attribute__((ext_vector_type(4)));
typedef unsigned u32x4 __attribute__((ext_vector_type(4)));
constexpr int BM = 256, BK = 64, HALF = 128, HTB = HALF * BK * 2  , STAGE_BYTES = 8 * HTB, NXCD = 8, WGM = 8;

__host__ __device__ __forceinline__ int lds_byte(int r, int c) { const int st = (r >> 4) * 2 + (c >> 5), rr = r & 15, cc = c & 31, ob = rr * 64 + cc * 2; return st * 1024 + (ob ^ (((ob >> 9) & 1) << 5)); }
__host__ __device__ __forceinline__ void stage_rc(int b, int& R, int& C) { const int st = b / 1024, sb = b % 1024, swz = sb ^ (((sb >> 9) & 1) << 5); R = (st >> 1) * 16 + swz / 64; C = (st & 1) * 32 + (swz % 64) / 2; }
__host__ __device__ __forceinline__ int perm32(int rho) { const int n = rho >> 4, i = rho & 15; return 8 * (i >> 2) + 4 * n + (i & 3); }

struct Unit { int pm, pn; };
struct Gemm { const bf16_t* A; const bf16_t* Bt; int M, N, K, lda, ldb, a_pn_off; };

struct StaticOrder {
    int nM, nN, nwg, G, c;
    __host__ __device__ __forceinline__ void init(int M, int N, int G_, int c_) { nM = M / BM; nN = N / BM; nwg = nM * nN; G = G_; c = c_; }
    __host__ __device__ __forceinline__ bool next(int i, Unit& u) const {
        const long L = (long)i * G + c; if (L >= nwg) return false;
        int wgid = (int)L; { const int q = nwg / NXCD, r = nwg % NXCD, xcd = wgid % NXCD, off = wgid / NXCD; wgid = (xcd < r ? xcd * (q + 1) : r * (q + 1) + (xcd - r) * q) + off; }
        const int nig = WGM * nN, gid = wgid / nig, fm = gid * WGM, gsz = (nM - fm) < WGM ? (nM - fm) : WGM;
        u.pm = fm + ((wgid % nig) % gsz); u.pn = (wgid % nig) / gsz; return true;
    }
    __device__ __forceinline__ void a_ready(const Unit&) const {}
    __device__ __forceinline__ void done(const Unit&) const {}
};

__device__ __forceinline__ unsigned cvt_pk_bf16(float lo, float hi) { unsigned r; asm volatile("v_cvt_pk_bf16_f32 %0, %1, %2" : "=v"(r) : "v"(lo), "v"(hi)); return r; }
__device__ __forceinline__ float bperm(float v, int srclane) { return __int_as_float(__builtin_amdgcn_ds_bpermute(srclane << 2, __float_as_int(v))); }
typedef float f32x2 __attribute__((ext_vector_type(2)));
typedef unsigned u32x2 __attribute__((ext_vector_type(2)));
__device__ __forceinline__ float fsig(float v) { return __builtin_amdgcn_rcpf(1.f + __expf(-v)); }
__device__ __forceinline__ float fsilu(float v) { return v * fsig(v); }
__device__ __forceinline__ float fgelu_tanh(float v) { return v * fsig(1.5957691216057308f * (v + 0.044715f * v * v * v)); }
__device__ __forceinline__ float bf_lo(unsigned w) { return __uint_as_float(w << 16); }
__device__ __forceinline__ float bf_hi(unsigned w) { return __uint_as_float(w & 0xffff0000u); }
__device__ __forceinline__ float rstd_of(const float* ss, int row) { const f32x4* p = (const f32x4*)(ss + (size_t)row * 16); const f32x4 a = p[0], b = p[1], c = p[2], d = p[3];
    const float s = ((a[0] + a[1]) + (a[2] + a[3])) + ((b[0] + b[1]) + (b[2] + b[3])) + (((c[0] + c[1]) + (c[2] + c[3])) + ((d[0] + d[1]) + (d[2] + d[3]))); return rsqrtf(s * (1.0f / 1024.0f) + 1e-6f); }
__device__ __forceinline__ u32x4 pack8(const f32x4 v0, const f32x4 v1) { u32x4 w; w.x = cvt_pk_bf16(v0[0], v0[1]); w.y = cvt_pk_bf16(v0[2], v0[3]); w.z = cvt_pk_bf16(v1[0], v1[1]); w.w = cvt_pk_bf16(v1[2], v1[3]); return w; }

struct OneUnit { int pm, pn;
    __device__ __forceinline__ bool next(int i, Unit& u) const { if (i) return false; u.pm = pm; u.pn = pn; return true; }
    __device__ __forceinline__ void a_ready(const Unit&) const {}
    __device__ __forceinline__ void done(const Unit&) const {} };

struct EpiSwiglu { static constexpr bool PERM = true, AFTER_DRAIN = false; bf16_t* H; const float* ss; int ldh;
    __device__ __forceinline__ void operator()(const f32x4 (&acc)[2][2][4][2], const Unit& u, int wr, int wc, int fr, int fq) const {
        const int row0 = u.pm * BM + wr * 64 + fr, col0 = u.pn * HALF + wc * 32 + 8 * fq;
#pragma unroll
        for (int ai = 0; ai < 2; ++ai)
#pragma unroll
            for (int m = 0; m < 4; ++m) { const int row = row0 + ai * HALF + m * 16; const float rs = rstd_of(ss, row);
                f32x4 o0, o1;
#pragma unroll
                for (int i = 0; i < 4; ++i) { o0[i] = fsilu(acc[ai][0][m][0][i] * rs) * (acc[ai][1][m][0][i] * rs); o1[i] = fsilu(acc[ai][0][m][1][i] * rs) * (acc[ai][1][m][1][i] * rs); }
                *(u32x4*)(H + (size_t)row * ldh + col0) = pack8(o0, o1); __builtin_amdgcn_sched_barrier(0); }
    }
};
struct EpiResid { static constexpr bool PERM = false, AFTER_DRAIN = false; float* x; bf16_t* xb; float* ss; float scale;
    __device__ __forceinline__ void operator()(const f32x4 (&acc)[2][2][4][2], const Unit& u, int wr, int wc, int fr, int fq) const {
        float scl = scale; asm volatile("" : "+v"(scl)); const int row0 = u.pm * BM + wr * 64 + fr, col0 = u.pn * BM + wc * 32 + 4 * fq;
#pragma unroll
        for (int ai = 0; ai < 2; ++ai)
#pragma unroll
            for (int m = 0; m < 4; ++m) { const int row = row0 + ai * HALF + m * 16; float q = 0.f;
#pragma unroll
                for (int bj = 0; bj < 2; ++bj)
#pragma unroll
                    for (int n = 0; n < 2; ++n) { const size_t off = (size_t)row * 1024 + col0 + bj * HALF + n * 16;
                        f32x4 v = *(const f32x4*)(x + off) + acc[ai][bj][m][n] * scl; *(f32x4*)(x + off) = v;
                        u32x2 w; w.x = cvt_pk_bf16(v[0], v[1]); w.y = cvt_pk_bf16(v[2], v[3]); *(u32x2*)(xb + off) = w;
                        q += (v[0] * v[0] + v[1] * v[1]) + (v[2] * v[2] + v[3] * v[3]); }
                q += bperm(q, (fr + 16 * fq) ^ 16); q += bperm(q, (fr + 16 * fq) ^ 32);
                if (fq == 0) ss[(size_t)row * 16 + u.pn * 4 + wc] = q; }
    }
};
struct EpiRs { static constexpr bool PERM = true, AFTER_DRAIN = false; bf16_t* O; int ldc; const float* ss; float sc;
    __device__ __forceinline__ void operator()(const f32x4 (&acc)[2][2][4][2], const Unit& u, int wr, int wc, int fr, int fq) const {
        const int row0 = u.pm * BM + wr * 64 + fr, col0 = u.pn * BM + wc * 32 + 8 * fq;
#pragma unroll
        for (int ai = 0; ai < 2; ++ai)
#pragma unroll
            for (int m = 0; m < 4; ++m) { const int row = row0 + ai * HALF + m * 16; const float rs = (ss ? rstd_of(ss, row) : 1.f) * sc;
#pragma unroll
                for (int bj = 0; bj < 2; ++bj) *(u32x4*)(O + (size_t)row * ldc + col0 + bj * HALF) = pack8(acc[ai][bj][m][0] * rs, acc[ai][bj][m][1] * rs); }
    }
};
struct EpiWin { static constexpr bool PERM = true, AFTER_DRAIN = false; bf16_t *xa, *xl, *gg, *q, *k, *v; const float* ss; float qscale;
    __device__ __forceinline__ void operator()(const f32x4 (&acc)[2][2][4][2], const Unit& u, int wr, int wc, int fr, int fq) const {
        const int pn = u.pn; bf16_t* dst; int ld, ct; float sc = 1.f; bool act = false;
        if (pn < 2) { dst = xa; ld = 512; ct = pn; } else if (pn < 6) { dst = xl; ld = 1024; ct = pn - 2; } else if (pn < 10) { dst = gg; ld = 1024; ct = pn - 6; act = true; }
        else if (pn < 12) { dst = q; ld = 512; ct = pn - 10; sc = qscale; } else if (pn < 14) { dst = k; ld = 512; ct = pn - 12; } else { dst = v; ld = 512; ct = pn - 14; }
        const int row0 = u.pm * BM + wr * 64 + fr, col0 = ct * BM + wc * 32 + 8 * fq;
#pragma unroll
        for (int ai = 0; ai < 2; ++ai)
#pragma unroll
            for (int m = 0; m < 4; ++m) { const int row = row0 + ai * HALF + m * 16; const float rs = rstd_of(ss, row) * sc;
#pragma unroll
                for (int bj = 0; bj < 2; ++bj) { f32x4 v0 = acc[ai][bj][m][0] * rs, v1 = acc[ai][bj][m][1] * rs;
                    if (act) {
#pragma unroll
                        for (int i = 0; i < 4; ++i) { v0[i] = fgelu_tanh(v0[i]); v1[i] = fgelu_tanh(v1[i]); } }
                    *(u32x4*)(dst + (size_t)row * ld + col0 + bj * HALF) = pack8(v0, v1); __builtin_amdgcn_sched_barrier(0); } }
    }
};
struct EpiGate { static constexpr bool PERM = true, AFTER_DRAIN = false; bf16_t* stash; const float* bg; const float* ss;
    __device__ __forceinline__ void operator()(const f32x4 (&acc)[2][2][4][2], const Unit& u, int wr, int wc, int fr, int fq) const {
        const int row0 = u.pm * BM + wr * 64 + fr, col0 = u.pn * BM + wc * 32 + 8 * fq; int tid_o = threadIdx.x; asm volatile("" : "+v"(tid_o)); const int tid = tid_o;
        f32x4 bv[2][2];
#pragma unroll
        for (int bj = 0; bj < 2; ++bj)
#pragma unroll
            for (int n = 0; n < 2; ++n) bv[bj][n] = *(const f32x4*)(bg + col0 + bj * HALF + 4 * n);
#pragma unroll
        for (int ai = 0; ai < 2; ++ai)
#pragma unroll
            for (int m = 0; m < 4; ++m) { const int row = row0 + ai * HALF + m * 16; const float rs = rstd_of(ss, row);
#pragma unroll
                for (int bj = 0; bj < 2; ++bj) { f32x4 v0 = acc[ai][bj][m][0] * rs + bv[bj][0], v1 = acc[ai][bj][m][1] * rs + bv[bj][1];
#pragma unroll
                    for (int i = 0; i < 4; ++i) { v0[i] = fsig(v0[i]); v1[i] = fsig(v1[i]); }
                    *(u32x4*)(stash + ((size_t)((ai * 4 + m) * 2 + bj) * 512 + tid) * 8) = pack8(v0, v1); __builtin_amdgcn_sched_barrier(0); } }
    }
};
struct EpiMerge { static constexpr bool PERM = true, AFTER_DRAIN = false; const bf16_t* stash; bf16_t* mg; int first;
    __device__ __forceinline__ void operator()(const f32x4 (&acc)[2][2][4][2], const Unit& u, int wr, int wc, int fr, int fq) const {
        const int row0 = u.pm * BM + wr * 64 + fr, col0 = u.pn * BM + wc * 32 + 8 * fq; int tid_o = threadIdx.x; asm volatile("" : "+v"(tid_o)); const int tid = tid_o;
#pragma unroll
        for (int ai = 0; ai < 2; ++ai)
#pragma unroll
            for (int m = 0; m < 4; ++m) { const int row = row0 + ai * HALF + m * 16;
#pragma unroll
                for (int bj = 0; bj < 2; ++bj) { const u32x4 gw = *(const u32x4*)(stash + ((size_t)((ai * 4 + m) * 2 + bj) * 512 + tid) * 8);
                    bf16_t* p = mg + (size_t)row * 1024 + col0 + bj * HALF;
                    f32x4 v0 = acc[ai][bj][m][0], v1 = acc[ai][bj][m][1];
                    v0[0] *= bf_lo(gw.x); v0[1] *= bf_hi(gw.x); v0[2] *= bf_lo(gw.y); v0[3] *= bf_hi(gw.y); v1[0] *= bf_lo(gw.z); v1[1] *= bf_hi(gw.z); v1[2] *= bf_lo(gw.w); v1[3] *= bf_hi(gw.w);
                    if (!first) { const u32x4 ow = *(const u32x4*)p;
                        v0[0] += bf_lo(ow.x); v0[1] += bf_hi(ow.x); v0[2] += bf_lo(ow.y); v0[3] += bf_hi(ow.y); v1[0] += bf_lo(ow.z); v1[1] += bf_hi(ow.z); v1[2] += bf_lo(ow.w); v1[3] += bf_hi(ow.w); }
                    *(u32x4*)p = pack8(v0, v1); __builtin_amdgcn_sched_barrier(0); } }
    }
};
struct EpiKV { static constexpr bool PERM = true, AFTER_DRAIN = false; bf16_t* kx; bf16_t* vt;
    __device__ __forceinline__ void operator()(const f32x4 (&acc)[2][2][4][2], const Unit& u, int wr, int wc, int fr, int fq) const {
        if (u.pn < 4) { const int row0 = u.pm * BM + wr * 64 + fr, col0 = u.pn * BM + wc * 32 + 8 * fq;
#pragma unroll
            for (int ai = 0; ai < 2; ++ai)
#pragma unroll
                for (int m = 0; m < 4; ++m)
#pragma unroll
                    for (int bj = 0; bj < 2; ++bj) *(u32x4*)(kx + (size_t)(row0 + ai * HALF + m * 16) * 1024 + col0 + bj * HALF) = pack8(acc[ai][bj][m][0], acc[ai][bj][m][1]);
        } else { const int h = u.pn - 4, b = u.pm; bf16_t* base = vt + (size_t)(b * 4 + h) * 65536;
#pragma unroll
            for (int ai = 0; ai < 2; ++ai)
#pragma unroll
                for (int m = 0; m < 4; ++m) { const int mr = ai * HALF + wr * 64 + m * 16 + fr;
#pragma unroll
                    for (int bj = 0; bj < 2; ++bj) { bf16_t* p = base + (size_t)(bj * HALF + wc * 32 + 8 * fq) * 256 + mr; asm volatile("" : "+v"(p));
#pragma unroll
                        for (int n = 0; n < 2; ++n)
#pragma unroll
                            for (int i = 0; i < 4; ++i) p[(4 * n + i) * 256] = (bf16_t)(cvt_pk_bf16(acc[ai][bj][m][n][i], 0.f) & 0xffffu);
                        __builtin_amdgcn_sched_barrier(0); } }
        }
    }
};
struct EpiSoftmaxP { static constexpr bool PERM = true, AFTER_DRAIN = true; bf16_t* P;
    __device__ __forceinline__ void fused(f32x4 (&acc)[2][2][4][2], const Unit& u, int wr, int wc, int fr, int fq, PG8_LAS unsigned char* lds, int wid, int lane) const {
        PG8_LAS f32x2* X = (PG8_LAS f32x2*)lds;
        float mloc[2][4];
#pragma unroll
        for (int ai = 0; ai < 2; ++ai)
#pragma unroll
            for (int m = 0; m < 4; ++m) { float mx = -__builtin_inff();
#pragma unroll
                for (int bj = 0; bj < 2; ++bj)
#pragma unroll
                    for (int n = 0; n < 2; ++n) { const f32x4 v = acc[ai][bj][m][n]; mx = fmaxf(mx, fmaxf(fmaxf(v[0], v[1]), fmaxf(v[2], v[3]))); }
                mx = fmaxf(mx, bperm(mx, (fr + 16 * fq) ^ 16)); mx = fmaxf(mx, bperm(mx, (fr + 16 * fq) ^ 32)); float s = 0.f;
#pragma unroll
                for (int bj = 0; bj < 2; ++bj)
#pragma unroll
                    for (int n = 0; n < 2; ++n) { f32x4 v = acc[ai][bj][m][n];
#pragma unroll
                        for (int i = 0; i < 4; ++i) { v[i] = __builtin_amdgcn_exp2f(v[i] - mx); s += v[i]; }
                        acc[ai][bj][m][n] = v; }
                s += bperm(s, (fr + 16 * fq) ^ 16); s += bperm(s, (fr + 16 * fq) ^ 32); mloc[ai][m] = mx;
                if (fq == 0) X[(ai * HALF + wr * 64 + m * 16 + fr) * 4 + wc] = (f32x2){mx, s}; __builtin_amdgcn_sched_barrier(0); }
        asm volatile("s_waitcnt lgkmcnt(0)" ::: "memory"); __builtin_amdgcn_s_barrier(); asm volatile("" ::: "memory");
#pragma unroll
        for (int ai = 0; ai < 2; ++ai)
#pragma unroll
            for (int m = 0; m < 4; ++m) { const int rl = ai * HALF + wr * 64 + m * 16 + fr;
                const f32x2 a = X[rl * 4 + 0], b = X[rl * 4 + 1], c = X[rl * 4 + 2], d = X[rl * 4 + 3];
                const float M = fmaxf(fmaxf(a.x, b.x), fmaxf(c.x, d.x));
                const float L = a.y * __builtin_amdgcn_exp2f(a.x - M) + b.y * __builtin_amdgcn_exp2f(b.x - M) + c.y * __builtin_amdgcn_exp2f(c.x - M) + d.y * __builtin_amdgcn_exp2f(d.x - M);
                const float f = __builtin_amdgcn_exp2f(mloc[ai][m] - M) / L;
#pragma unroll
                for (int bj = 0; bj < 2; ++bj) *(u32x4*)(P + (size_t)rl * 256 + bj * HALF + wc * 32 + 8 * fq) = pack8(acc[ai][bj][m][0] * f, acc[ai][bj][m][1] * f); __builtin_amdgcn_sched_barrier(0); }
        asm volatile("s_waitcnt vmcnt(0) lgkmcnt(0)" ::: "memory"); __builtin_amdgcn_s_barrier(); asm volatile("" ::: "memory");
    }
};

template <class Epi, class Sched, bool ALIGN_EPI = false, bool SP2 = false>
__device__ __forceinline__ void gemm_phase(PG8_LAS unsigned char* lds, const Gemm g, const Sched& S, const Epi& E) {
    int tid_o = threadIdx.x; asm volatile("" : "+v"(tid_o));
    const int tid = tid_o, wid = __builtin_amdgcn_readfirstlane(tid >> 6), lane = tid & 63, wr = wid >> 2, wc = wid & 3, fr = lane & 15, fq = lane >> 4;
    const int K = g.K, nt = K / BK;
    unsigned voffA[2], voffB[2];
#pragma unroll
    for (int i = 0; i < 2; ++i) { int R, C; stage_rc(tid * 16 + i * 8192, R, C); const int Rb = Epi::PERM ? ((R & ~31) + perm32(R & 31)) : R;
        voffA[i] = (unsigned)(R * g.lda + C) * 2u; voffB[i] = (unsigned)(Rb * g.ldb + C) * 2u; }
    const size_t kstep = (size_t)(BK * 2);
    const size_t hstepA = (size_t)HALF * g.lda * 2, hstepB = (size_t)HALF * g.ldb * 2;
    const size_t tstepA = 2 * hstepA, tstepB = 2 * hstepB;
    const unsigned ldsw = (unsigned)wid * 1024u;
    const int aoff = lds_byte(wr * 64 + fr, fq * 8), boff = lds_byte(wc * 32 + fr, fq * 8);
#define PG8_SA(b, h) (((b) * 2 + (h)) * HTB)
#define PG8_SB(b, h) ((4 + (b) * 2 + (h)) * HTB)
#define PG8_STAGE(bufoff, gbase, voff) do { _Pragma("unroll") for (int _i = 0; _i < 2; ++_i) \
        __builtin_amdgcn_global_load_lds((const unsigned*)((const char*)(gbase) + (voff)[_i]), (PG8_LAS unsigned*)(lds + (bufoff) + ldsw + _i * 8192), 16, 0, 0); } while (0)
#define PG8_LDA(dst, b, h) do { _Pragma("unroll") for (int m = 0; m < 4; ++m) _Pragma("unroll") for (int k = 0; k < 2; ++k) dst[m][k] = *(const PG8_LAS bf16x8*)(lds + PG8_SA(b, h) + aoff + m * 2048 + k * 1024); } while (0)
#define PG8_LDB(dst, b, h) do { _Pragma("unroll") for (int n = 0; n < 2; ++n) _Pragma("unroll") for (int k = 0; k < 2; ++k) dst[n][k] = *(const PG8_LAS bf16x8*)(lds + PG8_SB(b, h) + boff + n * 2048 + k * 1024); } while (0)
#define PG8_MMA(ai, bj, At, Bt) do { __builtin_amdgcn_s_setprio(1); _Pragma("unroll") for (int m = 0; m < 4; ++m) _Pragma("unroll") for (int n = 0; n < 2; ++n) _Pragma("unroll") for (int k = 0; k < 2; ++k) \
        acc[ai][bj][m][n] = __builtin_amdgcn_mfma_f32_16x16x32_bf16(Bt[n][k], At[m][k], acc[ai][bj][m][n], 0, 0, 0); __builtin_amdgcn_s_setprio(0); } while (0)
#define PG8_WAIT_V(n) asm volatile("s_waitcnt vmcnt(" #n ")" ::: "memory")
#define PG8_WAIT_L(n) asm volatile("s_waitcnt lgkmcnt(" #n ")" ::: "memory")
#define PG8_BAR __builtin_amdgcn_s_barrier()
#define PG8_SCHED __builtin_amdgcn_sched_barrier(0)
    Unit cur, nxt; int ui = 0;
    if (!S.next(0, cur)) return;
    f32x4 acc[2][2][4][2];
#pragma unroll
    for (int a = 0; a < 2; ++a)
#pragma unroll
        for (int b = 0; b < 2; ++b)
#pragma unroll
            for (int m = 0; m < 4; ++m)
#pragma unroll
                for (int n = 0; n < 2; ++n) acc[a][b][m][n] = (f32x4){0.f, 0.f, 0.f, 0.f};
    bf16x8 At[4][2], B0[2][2], B1[2][2];
    const char* cA = (const char*)g.A + (size_t)cur.pm * tstepA + (size_t)cur.pn * g.a_pn_off * 2; const char* cB = (const char*)g.Bt + (size_t)cur.pn * tstepB;
    S.a_ready(cur);
    if constexpr (SP2) {
        PG8_STAGE(PG8_SB(0, 0), cB, voffB); PG8_STAGE(PG8_SB(0, 1), cB + hstepB, voffB); PG8_STAGE(PG8_SA(0, 0), cA, voffA); PG8_STAGE(PG8_SA(0, 1), cA + hstepA, voffA);
        if (wr == 1) PG8_BAR;
        PG8_WAIT_V(2); PG8_BAR;
        PG8_STAGE(PG8_SB(1, 0), cB + kstep, voffB); PG8_STAGE(PG8_SA(1, 0), cA + kstep, voffA); PG8_STAGE(PG8_SB(1, 1), cB + hstepB + kstep, voffB);
        PG8_WAIT_V(6); PG8_BAR;
    } else {
        PG8_STAGE(PG8_SB(0, 0), cB, voffB); PG8_STAGE(PG8_SA(0, 0), cA, voffA); PG8_STAGE(PG8_SB(0, 1), cB + hstepB, voffB); PG8_STAGE(PG8_SA(0, 1), cA + hstepA, voffA);
        if (wr == 1) PG8_BAR;
        PG8_WAIT_V(4); PG8_BAR;
        PG8_STAGE(PG8_SB(1, 0), cB + kstep, voffB); PG8_STAGE(PG8_SA(1, 0), cA + kstep, voffA); PG8_STAGE(PG8_SB(1, 1), cB + hstepB + kstep, voffB);
        PG8_WAIT_V(6); PG8_BAR;
    }
    for (;;) {
        const bool has_next = S.next(ui + 1, nxt);
        const char* nA = has_next ? (const char*)g.A + (size_t)nxt.pm * tstepA + (size_t)nxt.pn * g.a_pn_off * 2 : cA; const char* nB = has_next ? (const char*)g.Bt + (size_t)nxt.pn * tstepB : cB;
        for (int t = 0; t < nt; t += 2) {
            const bool last = (t == nt - 2);
            const char* a1 = cA + (size_t)(t + 1) * kstep;
            const char* a2 = last ? nA : cA + (size_t)(t + 2) * kstep; const char* b2 = last ? nB : cB + (size_t)(t + 2) * kstep;
            const char* a3 = a2 + kstep; const char* b3 = b2 + kstep;
            if (last && has_next) S.a_ready(nxt);
            if constexpr (SP2) {
            PG8_LDB(B0, 0, 0); PG8_LDB(B1, 0, 1); PG8_SCHED; PG8_LDA(At, 0, 0); PG8_STAGE(PG8_SA(1, 1), a1 + hstepA, voffA);
            PG8_WAIT_V(8); PG8_WAIT_L(0); PG8_BAR; PG8_MMA(0, 0, At, B0); PG8_MMA(0, 1, At, B1); PG8_BAR; PG8_SCHED;
            PG8_LDA(At, 0, 1); PG8_STAGE(PG8_SB(0, 0), b2, voffB); PG8_STAGE(PG8_SB(0, 1), b2 + hstepB, voffB); PG8_STAGE(PG8_SA(0, 0), a2, voffA);
            PG8_WAIT_V(8); PG8_WAIT_L(0); PG8_BAR; PG8_MMA(1, 0, At, B0); PG8_MMA(1, 1, At, B1); PG8_BAR; PG8_SCHED;
            PG8_LDB(B0, 1, 0); PG8_LDB(B1, 1, 1); PG8_SCHED; PG8_LDA(At, 1, 0); PG8_STAGE(PG8_SA(0, 1), a2 + hstepA, voffA);
            PG8_WAIT_V(8); PG8_WAIT_L(0); PG8_BAR; PG8_MMA(0, 0, At, B0); PG8_MMA(0, 1, At, B1); PG8_BAR; PG8_SCHED;
            PG8_LDA(At, 1, 1); PG8_STAGE(PG8_SB(1, 0), b3, voffB); PG8_STAGE(PG8_SB(1, 1), b3 + hstepB, voffB); PG8_STAGE(PG8_SA(1, 0), a3, voffA);
            PG8_WAIT_V(8); PG8_WAIT_L(0); PG8_BAR; PG8_MMA(1, 0, At, B0); PG8_MMA(1, 1, At, B1); PG8_BAR; PG8_SCHED;
            } else {
            PG8_LDB(B0, 0, 0); PG8_SCHED; PG8_LDA(At, 0, 0); PG8_STAGE(PG8_SA(1, 1), a1 + hstepA, voffA);
            PG8_WAIT_L(8); PG8_BAR; PG8_WAIT_L(0); PG8_MMA(0, 0, At, B0); PG8_BAR; PG8_SCHED;
            PG8_LDB(B1, 0, 1); PG8_STAGE(PG8_SB(0, 0), b2, voffB);
            PG8_BAR; PG8_WAIT_L(0); PG8_MMA(0, 1, At, B1); PG8_BAR;
            PG8_LDA(At, 0, 1); PG8_STAGE(PG8_SA(0, 0), a2, voffA);
            PG8_BAR; PG8_WAIT_L(0); PG8_MMA(1, 0, At, B0); PG8_BAR; PG8_SCHED;
            PG8_STAGE(PG8_SB(0, 1), b2 + hstepB, voffB);
            PG8_WAIT_V(6); PG8_BAR; PG8_MMA(1, 1, At, B1); PG8_BAR;
            PG8_LDB(B0, 1, 0); PG8_SCHED; PG8_LDA(At, 1, 0); PG8_STAGE(PG8_SA(0, 1), a2 + hstepA, voffA);
            PG8_WAIT_L(8); PG8_BAR; PG8_WAIT_L(0); PG8_MMA(0, 0, At, B0); PG8_BAR; PG8_SCHED;
            PG8_LDB(B1, 1, 1); PG8_STAGE(PG8_SB(1, 0), b3, voffB);
            PG8_BAR; PG8_WAIT_L(0); PG8_MMA(0, 1, At, B1); PG8_BAR;
            PG8_LDA(At, 1, 1); PG8_STAGE(PG8_SA(1, 0), a3, voffA);
            PG8_BAR; PG8_WAIT_L(0); PG8_MMA(1, 0, At, B0); PG8_BAR; PG8_SCHED;
            PG8_STAGE(PG8_SB(1, 1), b3 + hstepB, voffB);
            PG8_WAIT_V(6); PG8_BAR; PG8_MMA(1, 1, At, B1); PG8_BAR;
            }
        }
        if constexpr (ALIGN_EPI) { if (wr == 0) PG8_BAR; }
        if constexpr (!Epi::AFTER_DRAIN) { E(acc, cur, wr, wc, fr, fq); S.done(cur); }
        if (!has_next) break;
#pragma unroll
        for (int a = 0; a < 2; ++a)
#pragma unroll
            for (int b = 0; b < 2; ++b)
#pragma unroll
                for (int m = 0; m < 4; ++m)
#pragma unroll
                    for (int n = 0; n < 2; ++n) acc[a][b][m][n] = (f32x4){0.f, 0.f, 0.f, 0.f};
        cur = nxt; cA = nA; cB = nB; ++ui;
        if constexpr (ALIGN_EPI) { if (wr == 1) PG8_BAR; }
    }
    PG8_WAIT_V(0);
    if constexpr (!ALIGN_EPI) { if (wr == 0) PG8_BAR; }
    PG8_BAR;
    if constexpr (Epi::AFTER_DRAIN) { E.fused(acc, cur, wr, wc, fr, fq, lds, wid, lane); S.done(cur); }
#undef PG8_SA
#undef PG8_SB
#undef PG8_STAGE
#undef PG8_LDA
#undef PG8_LDB
#undef PG8_MMA
#undef PG8_WAIT_V
#undef PG8_WAIT_L
#undef PG8_BAR
#undef PG8_SCHED
}
}
#include <hip/hip_bf16.h>
#include <cmath>
#define GAS __attribute__((address_space(1)))
#define LAS __attribute__((address_space(3)))
typedef unsigned short bf16;
typedef unsigned v4u __attribute__((ext_vector_type(4)));
typedef float f32x4 __attribute__((ext_vector_type(4)));
typedef short bf16x8 __attribute__((ext_vector_type(8)));
typedef float f32x16 __attribute__((ext_vector_type(16)));

constexpr int NWAVES = 8, NTHR = 512;
constexpr int BATCH = 2, SEQ = 8192, D = 1024, M = BATCH * SEQ, DFF = 2816, DEPTH = 2;
constexpr int INW = 7176;
constexpr size_t MiB = 1u << 20;
constexpr size_t WS_SS = 0, CTL_ZERO_BYTES = 1 * MiB;
constexpr size_t WS_WFL = 1 * MiB;
constexpr size_t WS_WAT = 1 * MiB + 256 * 1024, WS_WXT = 1 * MiB + 512 * 1024;
constexpr size_t WS_SUMM = 2 * MiB;
constexpr size_t WS_LOGF = 3 * MiB, WS_CTIL = 3 * MiB + 512 * 1024;
constexpr size_t WS_KPART = 7 * MiB;
constexpr size_t WS_MEMN = 4 * MiB, WS_KX = 5 * MiB, WS_VT = 6 * MiB;
constexpr size_t WS_W1IN = 8 * MiB, WS_W1OUT = 19 * MiB, WS_WIN = 25 * MiB, WS_WG = 33 * MiB, WS_UA = 39 * MiB, WS_UB = 40 * MiB, WS_UC = 42 * MiB,
                 WS_WO = 43 * MiB, WS_WXQ = 45 * MiB, WS_WXKV = 47 * MiB, WS_WXO = 51 * MiB, WS_W2IN = 53 * MiB, WS_W2OUT = 64 * MiB;
constexpr size_t WS_XB = 70 * MiB;
constexpr size_t WS_Q = 102 * MiB, WS_GG = 118 * MiB, WS_XA = 150 * MiB, WS_XL = 166 * MiB, WS_K = 198 * MiB, WS_V = 214 * MiB;
constexpr size_t WS_H = 102 * MiB;
constexpr size_t WS_YC = 150 * MiB;
constexpr size_t WS_STASH = 166 * MiB, WS_MG = 198 * MiB, WS_QX = 150 * MiB, WS_PBUF = 198 * MiB;
constexpr size_t WS_YA = 230 * MiB, WS_SSP = 246 * MiB, WS_END = 255 * MiB;
constexpr int LDS_BYTES = 147456;

__device__ __forceinline__ unsigned f2bf(float f) { unsigned u = __builtin_bit_cast(unsigned, f); return (u + 0x7fffu + ((u >> 16) & 1u)) >> 16; }
__device__ __forceinline__ unsigned pk2(float lo, float hi) { return f2bf(lo) | (f2bf(hi) << 16); }
__device__ __forceinline__ float bf2f(unsigned short v) { return __uint_as_float((unsigned)v << 16); }
__device__ __forceinline__ float bperm(float v, int srclane) { return __int_as_float(__builtin_amdgcn_ds_bpermute(srclane << 2, __float_as_int(v))); }
__device__ __forceinline__ float wave_sum(float v, int lane) {
#pragma unroll
    for (int o = 1; o < 64; o <<= 1) v += bperm(v, lane ^ o);
    return v;
}
__device__ __forceinline__ float flog1p(float e) { return e < 0.01f ? e * (1.f - e * (0.5f - e * 0.33333334f)) : __logf(1.f + e); }
#define LDS_WAIT() asm volatile("s_waitcnt lgkmcnt(0)" ::: "memory")

__device__ __forceinline__ void tr_item(const float* W, int ldn, int col0, int k0, const float* g, bf16* WT, int ldk, int drow0, LAS float* scr, int lane) {
    const int n4 = (lane & 15) * 4, kr = lane >> 4;
#pragma unroll
    for (int i = 0; i < 16; ++i) { const int kk = 4 * i + kr; f32x4 v = *(const f32x4*)(W + (size_t)(k0 + kk) * ldn + col0 + n4); if (g) v = v * g[k0 + kk];
        LAS float* d = scr + kk * 65 + n4; d[0] = v.x; d[1] = v.y; d[2] = v.z; d[3] = v.w; }
    LDS_WAIT(); asm volatile("" ::: "memory");
    const int c = lane & 7;
#pragma unroll
    for (int j = 0; j < 8; ++j) { const int n = (lane >> 3) + 8 * j; const LAS float* s = scr + (8 * c) * 65 + n;
        v4u o; o.x = pk2(s[0 * 65], s[1 * 65]); o.y = pk2(s[2 * 65], s[3 * 65]); o.z = pk2(s[4 * 65], s[5 * 65]); o.w = pk2(s[6 * 65], s[7 * 65]);
        *(v4u*)(WT + (size_t)(drow0 + n) * ldk + k0 + 8 * c) = o; }
    LDS_WAIT(); asm volatile("" ::: "memory");
}

#define RLX_AGENT __ATOMIC_RELAXED, __HIP_MEMORY_SCOPE_AGENT
#define XB_TMO      128
#define XB_XCNT(j)  (256  + 64 * (j))
#define XB_XSUB(j)  (1280 + 64 * (j))
#define XB_XGEN(j)  (2304 + 64 * (j))
#define XB_TOP      3328
#define XB_TOPGEN   3392
#define XCD_BAR_WORDS 3456
#define XB_SPIN_CAP (1u << 18)

__device__ __forceinline__ unsigned xb_ld(unsigned* p)              { return __hip_atomic_load(p, __ATOMIC_RELAXED, __HIP_MEMORY_SCOPE_AGENT); }
__device__ __forceinline__ unsigned xb_add(unsigned* p, unsigned v) { return __hip_atomic_fetch_add(p, v, __ATOMIC_RELAXED, __HIP_MEMORY_SCOPE_AGENT); }
__device__ __forceinline__ unsigned xb_xcc_id() { return (unsigned)__builtin_amdgcn_s_getreg((3 << 11) | 20) & 0xFu; }
#define XB_SPIN(cond, bar) do { unsigned _sp = 0; while (cond) { __builtin_amdgcn_s_sleep(1); \
    if ((++_sp & 255u) == 0u) { if (xb_ld(&(bar)[XB_TMO])) break; if (_sp > XB_SPIN_CAP) { atomicAdd(&(bar)[XB_TMO], 1u); break; } } } } while (0)

struct XcdBarrier {
    unsigned* bar; unsigned x;
    volatile LAS unsigned* st;
};

__device__ __forceinline__ XcdBarrier xcd_barrier_post(unsigned* bar, volatile LAS unsigned* st) {
    XcdBarrier b; b.bar = bar; b.x = xb_xcc_id(); b.st = st;
    if (threadIdx.x == 0) (void)xb_add(&bar[XB_XCNT(b.x)], 1u);
    return b;
}
__device__ __forceinline__ void xcd_barrier_complete(unsigned* bar, unsigned x, unsigned& nloc, unsigned& nx) {
    const unsigned G = gridDim.x * gridDim.y * gridDim.z;
    unsigned sum, cnt, mine, sp = 0u;
    for (;;) {
        sum = 0u; cnt = 0u; mine = 0u;
#pragma unroll
        for (unsigned j = 0; j < 16; ++j) { const unsigned c = xb_ld(&bar[XB_XCNT(j)]); sum += c; cnt += (c > 0u) ? 1u : 0u; mine = (j == x) ? c : mine; }
        if (sum == G) break;
        __builtin_amdgcn_s_sleep(1);
        if ((++sp & 255u) == 0u) { if (xb_ld(&bar[XB_TMO])) break; if (sp > XB_SPIN_CAP) { atomicAdd(&bar[XB_TMO], 1u); break; } }
    }
    nloc = mine > 0u ? mine : 1u; nx = cnt > 0u ? cnt : 1u;
}

__device__ __forceinline__ void xcd_barrier(const XcdBarrier& b) {
    asm volatile("s_waitcnt vmcnt(0)" ::: "memory");
    __syncthreads();
    if (threadIdx.x == 0) {
        unsigned* bar = b.bar;
        __builtin_amdgcn_s_waitcnt(0);
        unsigned nloc = b.st[0], nx = b.st[1];
        if (nloc == 0u) { xcd_barrier_complete(bar, b.x, nloc, nx); b.st[0] = nloc; b.st[1] = nx; }
        const unsigned old = xb_add(&bar[XB_XSUB(b.x)], 1u);
        const unsigned gen = old / nloc;
        if (old + 1u == (gen + 1u) * nloc) {
            __builtin_amdgcn_fence(__ATOMIC_RELEASE, "agent");
            asm volatile("s_waitcnt vmcnt(0)" ::: "memory");
            const unsigned og = xb_add(&bar[XB_TOP], 1u);
            const unsigned tg = og / nx;
            if (og + 1u == (tg + 1u) * nx) xb_add(&bar[XB_TOPGEN], 1u);
            else XB_SPIN(xb_ld(&bar[XB_TOPGEN]) == tg, bar);
            __builtin_amdgcn_fence(__ATOMIC_ACQUIRE, "agent");
            xb_add(&bar[XB_XGEN(b.x)], 1u);
            asm volatile("s_waitcnt vmcnt(0)" ::: "memory");
        } else {
            XB_SPIN(xb_ld(&bar[XB_XGEN(b.x)]) == gen, bar);
            __builtin_amdgcn_fence(__ATOMIC_ACQUIRE, "agent");
            asm volatile("s_waitcnt vmcnt(0)" ::: "memory");
        }
    }
    __syncthreads();
}

struct Args { const float* in[31]; float* out; unsigned char* ws; int pad[2]; };
typedef LAS unsigned long long* PtrTab;
__device__ __forceinline__ const float* tab_in(PtrTab tb, int k) { const unsigned long long v = tb[k]; const unsigned lo = __builtin_amdgcn_readfirstlane((unsigned)v), hi = __builtin_amdgcn_readfirstlane((unsigned)(v >> 32));
    return (const float*)(const GAS float*)(((unsigned long long)hi << 32) | lo); }
constexpr int TAB_OFF = 147456 - 512;
constexpr size_t WS_BAR = 768 * 1024;

__device__ __forceinline__ void phase_prologue(PtrTab TB, unsigned char* ws, float* xout, int l, LAS unsigned char* lds, int gw, int NGW, int lane, int wave) {
    LAS float* scr = (LAS float*)(lds + wave * 16640);
#define g1 (tab_in(TB, 2) + l * D)
#define w1i (tab_in(TB, 3) + (size_t)l * D * 2 * DFF)
#define w1o (tab_in(TB, 4) + (size_t)l * DFF * D)
#define gm (tab_in(TB, 5) + l * D)
#define win (tab_in(TB, 6) + (size_t)l * D * INW)
#define wpool (tab_in(TB, 9) + (size_t)l * 4 * 128 * 128)
#define psc (tab_in(TB, 10) + l * 512)
#define wua (tab_in(TB, 11) + (size_t)l * 512 * D)
#define wra (tab_in(TB, 14) + (size_t)l * 8 * 128 * 128)
#define wrx (tab_in(TB, 16) + (size_t)l * 8 * 128 * 128)
#define wub (tab_in(TB, 19) + (size_t)l * D * D)
#define wuc (tab_in(TB, 20) + (size_t)l * 512 * D)
#define wo (tab_in(TB, 21) + (size_t)l * D * D)
#define gc (tab_in(TB, 22) + l * D)
#define gmem (tab_in(TB, 23) + l * D)
#define wxq (tab_in(TB, 24) + (size_t)l * D * D)
#define wxkv (tab_in(TB, 25) + (size_t)l * D * 2 * D)
#define wxo (tab_in(TB, 26) + (size_t)l * D * D)
#define g2 (tab_in(TB, 27) + l * D)
#define w2i (tab_in(TB, 28) + (size_t)l * D * 2 * DFF)
#define w2o (tab_in(TB, 29) + (size_t)l * DFF * D)
    constexpr int I_FI = 16 * 88, I_FO = 44 * 16, I_WIN = 16 * 64, I_WG = 16 * 48, I_UB = 16 * 16, I_UC = 8 * 16, I_RG = 32, I_SQ = 16 * 16, I_KV = 16 * 32;
    constexpr int S0 = 0, S1 = S0 + I_FI, S2 = S1 + I_FO, S3 = S2 + I_WIN, S4 = S3 + I_WG, S5 = S4 + I_UB, S6 = S5 + I_UC, S7 = S6 + I_RG, S8 = S7 + I_RG, S9 = S8 + I_SQ, S10 = S9 + I_SQ,
                  S11 = S10 + I_KV, S12 = S11 + I_SQ, S13 = S12 + I_FI, S14 = S13 + I_FO;
    for (int it = gw; it < S14; it += NGW) {
        if (it < S1 || (it >= S12 && it < S13)) {
            const bool second = it >= S12; const int r = second ? it - S12 : it; const int kb = r / 88, nb = r % 88; const int n = nb * 64;
            const int half = n >= DFF ? 1 : 0, nn = n - half * DFF; const int drow = (nn >> 7) * 256 + half * 128 + (nn & 127);
            tr_item(second ? w2i : w1i, 2 * DFF, n, kb * 64, second ? g2 : g1, (bf16*)(ws + (second ? WS_W2IN : WS_W1IN)), D, drow, scr, lane);
        } else if (it < S2 || it >= S13) {
            const bool second = it >= S13; const int r = second ? it - S13 : it - S1; const int kb = r / 16, nb = r % 16;
            tr_item(second ? w2o : w1o, D, nb * 64, kb * 64, nullptr, (bf16*)(ws + (second ? WS_W2OUT : WS_W1OUT)), DFF, nb * 64, scr, lane);
        } else if (it < S3) { const int r = it - S2, kb = r / 64, nb = r % 64; tr_item(win, INW, nb * 64, kb * 64, gm, (bf16*)(ws + WS_WIN), D, nb * 64, scr, lane);
        } else if (it < S4) { const int r = it - S3, kb = r / 48, nb = r % 48; tr_item(win, INW, 4104 + nb * 64, kb * 64, gm, (bf16*)(ws + WS_WG), D, nb * 64, scr, lane);
        } else if (it < S5) { const int r = it - S4, kb = r / 16, nb = r % 16; tr_item(wub, D, nb * 64, kb * 64, nullptr, (bf16*)(ws + WS_UB), D, nb * 64, scr, lane);
        } else if (it < S6) { const int r = it - S5, kb = r / 16, nb = r % 16; tr_item(wuc, D, nb * 64, kb * 64, nullptr, (bf16*)(ws + WS_UC), 512, nb * 64, scr, lane);
        } else if (it < S8) { const bool xg = it >= S7; const int r = xg ? it - S7 : it - S6; const int hh = r >> 2, kb = (r >> 1) & 1, nb = r & 1;
            tr_item((xg ? wrx : wra) + hh * 16384, 128, nb * 64, kb * 64, nullptr, (bf16*)(ws + (xg ? WS_WXT : WS_WAT)) + hh * 16384, 128, nb * 64, scr, lane);
        } else if (it < S9) { const int r = it - S8, kb = r / 16, nb = r % 16; tr_item(wo, D, nb * 64, kb * 64, nullptr, (bf16*)(ws + WS_WO), D, nb * 64, scr, lane);
        } else if (it < S10) { const int r = it - S9, kb = r / 16, nb = r % 16; tr_item(wxq, D, nb * 64, kb * 64, gc, (bf16*)(ws + WS_WXQ), D, nb * 64, scr, lane);
        } else if (it < S11) { const int r = it - S10, kb = r / 32, nb = r % 32; tr_item(wxkv, 2 * D, nb * 64, kb * 64, nullptr, (bf16*)(ws + WS_WXKV), D, nb * 64, scr, lane);
        } else { const int r = it - S11, kb = r / 16, nb = r % 16; tr_item(wxo, D, nb * 64, kb * 64, nullptr, (bf16*)(ws + WS_WXO), D, nb * 64, scr, lane); }
    }
    { bf16* UaT = (bf16*)(ws + WS_UA);
      for (int it = gw; it < 4 * 16 * 16; it += NGW) { const int g = it >> 8, nblk = (it >> 4) & 15, c0 = (it & 15) * 8, n = nblk * 64 + lane;
          const float* wp = wpool + ((size_t)g * 128 + c0) * 128; const float* sc = psc + g * 128; const float* ua = wua + (size_t)(g * 128) * D + n; float acc[8];
#pragma unroll
          for (int c = 0; c < 8; ++c) acc[c] = 0.f;
#pragma unroll 16
          for (int j = 0; j < 128; ++j) { const float u = ua[(size_t)j * D] * sc[j];
#pragma unroll
              for (int c = 0; c < 8; ++c) acc[c] += wp[c * 128 + j] * u; }
          v4u o; o.x = pk2(acc[0], acc[1]); o.y = pk2(acc[2], acc[3]); o.z = pk2(acc[4], acc[5]); o.w = pk2(acc[6], acc[7]);
          *(v4u*)(UaT + (size_t)n * 512 + g * 128 + c0) = o; } }
    { float* wfl = (float*)(ws + WS_WFL);
      for (int it = gw * 64 + lane; it < 8 * 1024; it += NGW * 64) { const int h = it >> 10, k = it & 1023; wfl[it] = gm[k] * win[(size_t)k * INW + 4096 + h]; } }
    { const float* mem = tab_in(TB, 1); bf16* mn = (bf16*)(ws + WS_MEMN);
      for (int r = gw; r < 512; r += NGW) { const f32x4* xr = (const f32x4*)(mem + (size_t)r * D) + lane; f32x4 v[4]; float s = 0.f;
#pragma unroll
          for (int j = 0; j < 4; ++j) { v[j] = xr[64 * j]; s += (v[j].x * v[j].x + v[j].y * v[j].y) + (v[j].z * v[j].z + v[j].w * v[j].w); }
          const float rs = rsqrtf(wave_sum(s, lane) * (1.f / D) + 1e-6f); unsigned long long* o8 = (unsigned long long*)(mn + (size_t)r * D) + lane;
#pragma unroll
          for (int j = 0; j < 4; ++j) { const f32x4 gv = *((const f32x4*)gmem + lane + 64 * j);
              o8[64 * j] = (unsigned long long)pk2(v[j].x * rs * gv.x, v[j].y * rs * gv.y) | ((unsigned long long)pk2(v[j].z * rs * gv.z, v[j].w * rs * gv.w) << 32); } } }
    if (l == 0) {
        const float* x = tab_in(TB, 0); float* xo = xout; bf16* xb = (bf16*)(ws + WS_XB); float* ss = (float*)(ws + WS_SSP);
        for (int r = gw; r < M; r += NGW) { const f32x4* xr = (const f32x4*)(x + (size_t)r * D) + lane; f32x4* orow = (f32x4*)(xo + (size_t)r * D) + lane; f32x4 v[4]; float s = 0.f;
#pragma unroll
            for (int j = 0; j < 4; ++j) { v[j] = xr[64 * j]; orow[64 * j] = v[j]; s += (v[j].x * v[j].x + v[j].y * v[j].y) + (v[j].z * v[j].z + v[j].w * v[j].w); }
            s = wave_sum(s, lane); if (lane < 16) ss[(size_t)r * 16 + lane] = lane == 0 ? s : 0.f; unsigned long long* o8 = (unsigned long long*)(xb + (size_t)r * D) + lane;
#pragma unroll
            for (int j = 0; j < 4; ++j) o8[64 * j] = (unsigned long long)pk2(v[j].x, v[j].y) | ((unsigned long long)pk2(v[j].z, v[j].w) << 32); }
    }
}
#undef g1
#undef w1i
#undef w1o
#undef gm
#undef win
#undef wpool
#undef psc
#undef wua
#undef wra
#undef wrx
#undef wub
#undef wuc
#undef wo
#undef gc
#undef gmem
#undef wxq
#undef wxkv
#undef wxo
#undef g2
#undef w2i
#undef w2o
__device__ __forceinline__ void phase_fl(const bf16* xb, const float* wfl, const float* bfv, const float* ss, float* logf, int gw, int NGW, int lane) {
    for (int r = gw; r < M; r += NGW) {
        float acc[8];
#pragma unroll
        for (int h = 0; h < 8; ++h) acc[h] = 0.f;
#pragma unroll
        for (int j = 0; j < 2; ++j) { const int k0 = 8 * lane + 512 * j; const v4u xv = *(const v4u*)(xb + (size_t)r * D + k0);
            float xf[8]; xf[0] = __uint_as_float(xv.x << 16); xf[1] = __uint_as_float(xv.x & 0xffff0000u); xf[2] = __uint_as_float(xv.y << 16); xf[3] = __uint_as_float(xv.y & 0xffff0000u);
            xf[4] = __uint_as_float(xv.z << 16); xf[5] = __uint_as_float(xv.z & 0xffff0000u); xf[6] = __uint_as_float(xv.w << 16); xf[7] = __uint_as_float(xv.w & 0xffff0000u);
#pragma unroll
            for (int h = 0; h < 8; ++h) { const f32x4 w0 = *(const f32x4*)(wfl + h * 1024 + k0), w1 = *(const f32x4*)(wfl + h * 1024 + k0 + 4);
                acc[h] += (xf[0] * w0.x + xf[1] * w0.y) + (xf[2] * w0.z + xf[3] * w0.w) + (xf[4] * w1.x + xf[5] * w1.y) + (xf[6] * w1.z + xf[7] * w1.w); } }
        const float rs = pg8::rstd_of(ss, r);
#pragma unroll
        for (int h = 0; h < 8; ++h) { const float z = wave_sum(acc[h], lane) * rs + bfv[h]; const float ls = -(fmaxf(-z, 0.f) + flog1p(__expf(-fabsf(z)))); if (lane == h) logf[(size_t)r * 8 + h] = ls; }
    }
}
__device__ __forceinline__ void cumsum_bh(const float* logf, float* ctil, int bh, LAS float* red) {
    int tid_o = threadIdx.x; asm volatile("" : "+v"(tid_o)); const int tid = tid_o, lane = tid & 63, wid = tid >> 6;
    const int b = bh >> 3, h = bh & 7; const float* src = logf + ((size_t)b * SEQ + 16 * tid) * 8 + h; float v[16]; float s = 0.f;
#pragma unroll
    for (int i = 0; i < 16; ++i) { v[i] = src[(size_t)i * 8]; s += v[i]; }
    float incl = s;
#pragma unroll
    for (int o = 1; o < 64; o <<= 1) { const float t = bperm(incl, lane - o); if (lane >= o) incl += t; }
    if (lane == 63) red[wid] = incl;
    __syncthreads();
    float base = 0.f;
#pragma unroll
    for (int w = 0; w < 8; ++w) if (w < wid) base += red[w];
    float run = base + incl - s; float* dst = ctil + (size_t)bh * SEQ + 16 * tid;
#pragma unroll
    for (int i = 0; i < 16; ++i) { run += v[i]; dst[i] = run * 1.4426950408889634f; }
    __syncthreads();
}
__device__ __forceinline__ void unpk8(const v4u xv, float (&xf)[8]) { xf[0] = __uint_as_float(xv.x << 16); xf[1] = __uint_as_float(xv.x & 0xffff0000u); xf[2] = __uint_as_float(xv.y << 16); xf[3] = __uint_as_float(xv.y & 0xffff0000u);
    xf[4] = __uint_as_float(xv.z << 16); xf[5] = __uint_as_float(xv.z & 0xffff0000u); xf[6] = __uint_as_float(xv.w << 16); xf[7] = __uint_as_float(xv.w & 0xffff0000u); }
template <int W> __device__ __forceinline__ void pool_item(const bf16* xa, bf16* ya, int m0, int cgi) {
    const int t0 = m0 & (SEQ - 1); v4u rw[W + 7];
#pragma unroll
    for (int a = 0; a < W + 7; ++a) { const int tl = a - (W - 1); rw[a] = (t0 + tl >= 0) ? *(const v4u*)(xa + (size_t)(m0 + tl) * 512 + 8 * cgi) : (v4u){0u, 0u, 0u, 0u}; }
    float s[8];
#pragma unroll
    for (int i = 0; i < 8; ++i) s[i] = 0.f;
#pragma unroll
    for (int a = 0; a < W - 1; ++a) { float xf[8]; unpk8(rw[a], xf);
#pragma unroll
        for (int i = 0; i < 8; ++i) s[i] += xf[i]; }
#pragma unroll
    for (int o = 0; o < 8; ++o) { float cur[8]; unpk8(rw[o + W - 1], cur);
#pragma unroll
        for (int i = 0; i < 8; ++i) s[i] += cur[i];
        const int t = t0 + o, cnt = (t + 1 < W) ? t + 1 : W; const float ic = 1.f / (float)cnt; v4u ov;
        ov.x = pk2(s[0] * ic - cur[0], s[1] * ic - cur[1]); ov.y = pk2(s[2] * ic - cur[2], s[3] * ic - cur[3]); ov.z = pk2(s[4] * ic - cur[4], s[5] * ic - cur[5]); ov.w = pk2(s[6] * ic - cur[6], s[7] * ic - cur[7]);
        *(v4u*)(ya + (size_t)(m0 + o) * 512 + 8 * cgi) = ov;
        float old[8]; unpk8(rw[o], old);
#pragma unroll
        for (int i = 0; i < 8; ++i) s[i] -= old[i]; }
}
__device__ __forceinline__ void phase_pool(const bf16* xa, bf16* ya, int gtid, int nthr) {
    for (int idx = gtid; idx < (M / 8) * 64; idx += nthr) { const int c16 = idx & 15, rl = (idx >> 4) & 3, g = (idx >> 6) & 3, rh = idx >> 8; const int m0 = (rh * 4 + rl) * 8, cgi = g * 16 + c16;
        if (g == 0) pool_item<2>(xa, ya, m0, cgi); else if (g == 1) pool_item<4>(xa, ya, m0, cgi); else if (g == 2) pool_item<8>(xa, ya, m0, cgi); else pool_item<16>(xa, ya, m0, cgi); }
}
__device__ __forceinline__ int crow16(int r, int hi) { return (r & 3) + 8 * (r >> 2) + 4 * hi; }
template <bool FINAL>
__device__ __forceinline__ void lru_item(LAS unsigned char* lds, int b, int hp, int ck, const bf16* xl, bf16* gg, const float* cw, const float* cb, const bf16* WaT, const bf16* WxT,
                                         const float* ba, const float* bx, const float* lam, float* summ) {
    int tid_o = threadIdx.x; asm volatile("" : "+v"(tid_o)); const int tid = tid_o, lane = tid & 63, wid = tid >> 6, r32 = lane & 31, hi = lane >> 5;
    const int t0 = ck * 128; const size_t m0 = (size_t)b * SEQ + t0; const int ch0 = hp * 256;
    constexpr int XP = 264;
    LAS bf16* xc = (LAS bf16*)lds; LAS float* h0s = (LAS float*)(lds + 128 * XP * 2);
    {
        const int cgi = tid & 31, tq = tid >> 5, c = ch0 + 8 * cgi;
        float w[4][8], bb[8];
#pragma unroll
        for (int k = 0; k < 4; ++k) { const f32x4 a = *(const f32x4*)(cw + k * 1024 + c), d = *(const f32x4*)(cw + k * 1024 + c + 4); w[k][0] = a.x; w[k][1] = a.y; w[k][2] = a.z; w[k][3] = a.w; w[k][4] = d.x; w[k][5] = d.y; w[k][6] = d.z; w[k][7] = d.w; }
        { const f32x4 a = *(const f32x4*)(cb + c), d = *(const f32x4*)(cb + c + 4); bb[0] = a.x; bb[1] = a.y; bb[2] = a.z; bb[3] = a.w; bb[4] = d.x; bb[5] = d.y; bb[6] = d.z; bb[7] = d.w; }
        v4u rw[11];
#pragma unroll
        for (int i = 0; i < 11; ++i) { const int tl = tq * 8 - 3 + i; rw[i] = (t0 + tl >= 0) ? *(const v4u*)(xl + (size_t)((long)m0 + tl) * 1024 + c) : (v4u){0u, 0u, 0u, 0u}; }
#pragma unroll
        for (int o = 0; o < 8; ++o) { float y[8];
#pragma unroll
            for (int j = 0; j < 8; ++j) y[j] = bb[j];
#pragma unroll
            for (int k = 0; k < 4; ++k) { const v4u xv = rw[o + k];
                y[0] += w[k][0] * __uint_as_float(xv.x << 16); y[1] += w[k][1] * __uint_as_float(xv.x & 0xffff0000u); y[2] += w[k][2] * __uint_as_float(xv.y << 16); y[3] += w[k][3] * __uint_as_float(xv.y & 0xffff0000u);
                y[4] += w[k][4] * __uint_as_float(xv.z << 16); y[5] += w[k][5] * __uint_as_float(xv.z & 0xffff0000u); y[6] += w[k][6] * __uint_as_float(xv.w << 16); y[7] += w[k][7] * __uint_as_float(xv.w & 0xffff0000u); }
            v4u ov; ov.x = pk2(y[0], y[1]); ov.y = pk2(y[2], y[3]); ov.z = pk2(y[4], y[5]); ov.w = pk2(y[6], y[7]);
            *(LAS v4u*)(xc + (tq * 8 + o) * XP + 8 * cgi) = ov; }
    }
    if (FINAL && tid < 256) {
        const float* sp = summ + ((size_t)b * 64 * 1024 + ch0 + tid) * 2; float h = 0.f;
#pragma unroll 8
        for (int c2 = 0; c2 < ck; ++c2) { const float2 v = *(const float2*)(sp + (size_t)c2 * 2048); h = v.x * h + v.y; }
        h0s[tid] = h;
    }
    __syncthreads();
    const int hh = wid >> 2, s = wid & 3, chl = 128 * hh + 32 * s + r32, ch = ch0 + chl, head = 2 * hp + hh;
    const float bav = ba[ch], bxv = bx[ch]; const float nl = -lam[ch]; const float sp8 = 8.f * (fmaxf(nl, 0.f) + flog1p(__expf(-fabsf(nl))));
    bf16x8 fa[8], fx[8];
#pragma unroll
    for (int ks = 0; ks < 8; ++ks) { fa[ks] = *(const bf16x8*)(WaT + (size_t)head * 16384 + (32 * s + r32) * 128 + 16 * ks + 8 * hi); fx[ks] = *(const bf16x8*)(WxT + (size_t)head * 16384 + (32 * s + r32) * 128 + 16 * ks + 8 * hi); }
    float hrun = FINAL ? h0s[chl] : 0.f, Arun = 1.f;
    for (int mb = 0; mb < 4; ++mb) {
        f32x16 accA = {0.f, 0.f, 0.f, 0.f, 0.f, 0.f, 0.f, 0.f, 0.f, 0.f, 0.f, 0.f, 0.f, 0.f, 0.f, 0.f}, accX = accA;
#pragma unroll
        for (int ks = 0; ks < 8; ++ks) { const bf16x8 af = *(const LAS bf16x8*)(xc + (32 * mb + r32) * XP + 128 * hh + 16 * ks + 8 * hi);
            accA = __builtin_amdgcn_mfma_f32_32x32x16_bf16(af, fa[ks], accA, 0, 0, 0); accX = __builtin_amdgcn_mfma_f32_32x32x16_bf16(af, fx[ks], accX, 0, 0, 0); }
        float a[16], u[16];
#pragma unroll
        for (int r = 0; r < 16; ++r) { const int tok = 32 * mb + crow16(r, hi); const float xcv = bf2f(xc[tok * XP + chl]);
            const float rg = pg8::fsig(accA[r] + bav), la = -rg * sp8, av = __expf(la), mult = sqrtf(fmaxf(1.f - __expf(2.f * la), 0.f)), ig = pg8::fsig(accX[r] + bxv);
            a[r] = av; u[r] = mult * ig * xcv; }
        float As[4], Hs[4], Ap[4], Hp[4], hin[4];
#pragma unroll
        for (int g = 0; g < 4; ++g) { float Aq = 1.f, Hq = 0.f;
#pragma unroll
            for (int i = 0; i < 4; ++i) { Hq = a[4 * g + i] * Hq + u[4 * g + i]; Aq *= a[4 * g + i]; }
            As[g] = Aq; Hs[g] = Hq; Ap[g] = bperm(Aq, lane ^ 32); Hp[g] = bperm(Hq, lane ^ 32); }
#pragma unroll
        for (int g = 0; g < 4; ++g) { const float A0 = hi ? Ap[g] : As[g], H0 = hi ? Hp[g] : Hs[g], A1 = hi ? As[g] : Ap[g], H1 = hi ? Hs[g] : Hp[g];
            const float hA = hrun, hB = A0 * hA + H0; hrun = A1 * hB + H1; Arun *= A0 * A1; hin[g] = hi ? hB : hA; }
        if (FINAL) {
#pragma unroll
            for (int g = 0; g < 4; ++g) { float hc = hin[g];
#pragma unroll
                for (int i = 0; i < 4; ++i) { const int r = 4 * g + i; hc = a[r] * hc + u[r]; bf16* p = gg + (m0 + 32 * mb + crow16(r, hi)) * 1024 + ch; *p = (bf16)f2bf(hc * bf2f(*p)); } }
        }
    }
    if (!FINAL && hi == 0) { float* sp = summ + (((size_t)b * 64 + ck) * 1024 + ch) * 2; sp[0] = Arun; sp[1] = hrun; }
    __syncthreads();
}
__device__ __forceinline__ void phase_final(float* x, const float* g, int gw, int NGW, int lane) {
    for (int r = gw; r < M; r += NGW) { f32x4* xr = (f32x4*)(x + (size_t)r * D) + lane; f32x4 v[4]; float s = 0.f;
#pragma unroll
        for (int j = 0; j < 4; ++j) { v[j] = xr[64 * j]; s += (v[j].x * v[j].x + v[j].y * v[j].y) + (v[j].z * v[j].z + v[j].w * v[j].w); }
        const float rs = rsqrtf(wave_sum(s, lane) * (1.f / D) + 1e-6f);
#pragma unroll
        for (int j = 0; j < 4; ++j) { const f32x4 gv = *((const f32x4*)g + lane + 64 * j); xr[64 * j] = (f32x4){v[j].x * rs * gv.x, v[j].y * rs * gv.y, v[j].z * rs * gv.z, v[j].w * rs * gv.w}; } }
}
__device__ __forceinline__ void phase_kmax(const bf16* K, float* kpart, int gw, int NGW, int lane) {
    float m0 = 0.f, m1 = 0.f;
#pragma unroll 8
    for (int r = gw; r < M; r += NGW) { const v4u w = *(const v4u*)(K + (size_t)r * 512 + 8 * lane);
        const float a0 = __uint_as_float(w.x << 16), a1 = __uint_as_float(w.x & 0xffff0000u), a2 = __uint_as_float(w.y << 16), a3 = __uint_as_float(w.y & 0xffff0000u);
        const float a4 = __uint_as_float(w.z << 16), a5 = __uint_as_float(w.z & 0xffff0000u), a6 = __uint_as_float(w.w << 16), a7 = __uint_as_float(w.w & 0xffff0000u);
        float s = (a0 * a0 + a1 * a1) + (a2 * a2 + a3 * a3) + (a4 * a4 + a5 * a5) + (a6 * a6 + a7 * a7);
        s += bperm(s, lane ^ 1); s += bperm(s, lane ^ 2); s += bperm(s, lane ^ 4);
        if (r < SEQ) m0 = fmaxf(m0, s); else m1 = fmaxf(m1, s); }
    if ((lane & 7) == 0) { kpart[((size_t)gw * 2 + 0) * 8 + (lane >> 3)] = m0; kpart[((size_t)gw * 2 + 1) * 8 + (lane >> 3)] = m1; }
}
constexpr float FOX_C2 = 0.125f * 1.4426950408889634f;
constexpr float FOX_SKIP = 64.f;
constexpr int FOX_KP = 72;
constexpr int FOX_BUF = 2 * 64 * FOX_KP * 2 + 256;
__device__ __forceinline__ void fox_unit(LAS unsigned char* lds, int b, int h, int qb, const bf16* Q, const bf16* K, const bf16* V, bf16* O, const float* ct, const float* kpart, int nparts) {
    int tid_o = threadIdx.x; asm volatile("" : "+v"(tid_o)); const int tid = tid_o, lane = tid & 63, wid = tid >> 6, r32 = lane & 31, hi = lane >> 5;
    const size_t rowbase = (size_t)b * SEQ; const int q0 = qb * 256, NT = 4 * qb + 4;
    const bf16* Qw = Q + (rowbase + q0 + wid * 32 + r32) * 512 + h * 64;
    bf16x8 qr[4];
#pragma unroll
    for (int d0 = 0; d0 < 4; ++d0) qr[d0] = *(const bf16x8*)(Qw + 16 * d0 + 8 * hi);
    LAS float* red = (LAS float*)(lds + 2 * FOX_BUF); LAS int* tsl = (LAS int*)(lds + 2 * FOX_BUF + 128);
    { float qn = 0.f;
#pragma unroll
      for (int d0 = 0; d0 < 4; ++d0) { const v4u w = __builtin_bit_cast(v4u, qr[d0]);
          const float a0 = __uint_as_float(w.x << 16), a1 = __uint_as_float(w.x & 0xffff0000u), a2 = __uint_as_float(w.y << 16), a3 = __uint_as_float(w.y & 0xffff0000u);
          const float a4 = __uint_as_float(w.z << 16), a5 = __uint_as_float(w.z & 0xffff0000u), a6 = __uint_as_float(w.w << 16), a7 = __uint_as_float(w.w & 0xffff0000u);
          qn += (a0 * a0 + a1 * a1) + (a2 * a2 + a3 * a3) + (a4 * a4 + a5 * a5) + (a6 * a6 + a7 * a7); }
      qn += bperm(qn, lane ^ 32);
#pragma unroll
      for (int o = 1; o < 32; o <<= 1) qn = fmaxf(qn, bperm(qn, lane ^ o));
      __syncthreads();
      float km = 0.f;
      for (int i = tid; i < nparts; i += NTHR) km = fmaxf(km, kpart[((size_t)i * 2 + b) * 8 + h]);
#pragma unroll
      for (int o = 1; o < 64; o <<= 1) km = fmaxf(km, bperm(km, lane ^ o));
      if (lane == 0) { red[wid] = qn; red[8 + wid] = km; } if (tid == 0) tsl[0] = 4 * qb;
      __syncthreads();
      float q2 = red[0], k2 = red[8];
#pragma unroll
      for (int w = 1; w < 8; ++w) { q2 = fmaxf(q2, red[w]); k2 = fmaxf(k2, red[8 + w]); }
      const float thr = 2.f * sqrtf(q2) * sqrtf(k2) * 1.0001f + FOX_SKIP;
      const float c0 = ct[q0];
      if (tid < 4 * qb && ct[64 * tid + 63] - c0 <= thr) atomicMin((int*)tsl, tid);
      __syncthreads(); }
    const int T0 = tsl[0];
    const int skey = tid >> 3, sd = (tid & 7) * 8;
    const bf16* kp = K + (rowbase + skey) * 512 + h * 64 + sd; const bf16* vp = V + (rowbase + skey) * 512 + h * 64 + sd;
    v4u kreg = *(const v4u*)(kp + (size_t)T0 * 64 * 512), vreg = *(const v4u*)(vp + (size_t)T0 * 64 * 512); float creg = (tid < 64) ? ct[64 * T0 + tid] : 0.f;
    __syncthreads();
    { LAS unsigned char* buf0 = lds + (T0 & 1) * FOX_BUF; LAS bf16* Ks = (LAS bf16*)buf0; LAS bf16* Vt = Ks + 64 * FOX_KP; LAS float* Cs = (LAS float*)(buf0 + 2 * 64 * FOX_KP * 2);
      *(LAS v4u*)(Ks + skey * FOX_KP + sd) = kreg;
      Vt[(sd + 0) * FOX_KP + skey] = (bf16)(vreg.x & 0xffffu); Vt[(sd + 1) * FOX_KP + skey] = (bf16)(vreg.x >> 16); Vt[(sd + 2) * FOX_KP + skey] = (bf16)(vreg.y & 0xffffu); Vt[(sd + 3) * FOX_KP + skey] = (bf16)(vreg.y >> 16);
      Vt[(sd + 4) * FOX_KP + skey] = (bf16)(vreg.z & 0xffffu); Vt[(sd + 5) * FOX_KP + skey] = (bf16)(vreg.z >> 16); Vt[(sd + 6) * FOX_KP + skey] = (bf16)(vreg.w & 0xffffu); Vt[(sd + 7) * FOX_KP + skey] = (bf16)(vreg.w >> 16);
      if (tid < 64) Cs[tid] = creg; }
    if (T0 + 1 < NT) { kreg = *(const v4u*)(kp + (size_t)(T0 + 1) * 64 * 512); vreg = *(const v4u*)(vp + (size_t)(T0 + 1) * 64 * 512); if (tid < 64) creg = ct[64 * (T0 + 1) + tid]; }
    float m = -1e30f, l = 0.f; f32x16 o0, o1;
#pragma unroll
    for (int r = 0; r < 16; ++r) { o0[r] = 0.f; o1[r] = 0.f; }
    for (int t = T0; t < NT; ++t) {
        __syncthreads();
        if (t + 1 < NT) { LAS unsigned char* bufn = lds + ((t + 1) & 1) * FOX_BUF; LAS bf16* Ks = (LAS bf16*)bufn; LAS bf16* Vt = Ks + 64 * FOX_KP; LAS float* Cs = (LAS float*)(bufn + 2 * 64 * FOX_KP * 2);
            *(LAS v4u*)(Ks + skey * FOX_KP + sd) = kreg;
            Vt[(sd + 0) * FOX_KP + skey] = (bf16)(vreg.x & 0xffffu); Vt[(sd + 1) * FOX_KP + skey] = (bf16)(vreg.x >> 16); Vt[(sd + 2) * FOX_KP + skey] = (bf16)(vreg.y & 0xffffu); Vt[(sd + 3) * FOX_KP + skey] = (bf16)(vreg.y >> 16);
            Vt[(sd + 4) * FOX_KP + skey] = (bf16)(vreg.z & 0xffffu); Vt[(sd + 5) * FOX_KP + skey] = (bf16)(vreg.z >> 16); Vt[(sd + 6) * FOX_KP + skey] = (bf16)(vreg.w & 0xffffu); Vt[(sd + 7) * FOX_KP + skey] = (bf16)(vreg.w >> 16);
            if (tid < 64) Cs[tid] = creg;
            if (t + 2 < NT) { kreg = *(const v4u*)(kp + (size_t)(t + 2) * 64 * 512); vreg = *(const v4u*)(vp + (size_t)(t + 2) * 64 * 512); if (tid < 64) creg = ct[64 * (t + 2) + tid]; } }
        const int jb = t - (NT - 4);
        if (jb >= 0 && 64 * jb > 32 * wid + 31) continue;
        LAS unsigned char* buf = lds + (t & 1) * FOX_BUF; const LAS bf16* Ks = (const LAS bf16*)buf; const LAS bf16* Vt = Ks + 64 * FOX_KP; const LAS float* Cs = (const LAS float*)(buf + 2 * 64 * FOX_KP * 2);
        f32x16 p0, p1;
#pragma unroll
        for (int g = 0; g < 4; ++g) { const f32x4 a = *(const LAS f32x4*)(Cs + 8 * g + 4 * hi), c = *(const LAS f32x4*)(Cs + 32 + 8 * g + 4 * hi);
            p0[4 * g + 0] = -a[0]; p0[4 * g + 1] = -a[1]; p0[4 * g + 2] = -a[2]; p0[4 * g + 3] = -a[3]; p1[4 * g + 0] = -c[0]; p1[4 * g + 1] = -c[1]; p1[4 * g + 2] = -c[2]; p1[4 * g + 3] = -c[3]; }
#pragma unroll
        for (int d0 = 0; d0 < 4; ++d0) { const bf16x8 a0 = *(const LAS bf16x8*)(Ks + r32 * FOX_KP + 16 * d0 + 8 * hi), a1 = *(const LAS bf16x8*)(Ks + (32 + r32) * FOX_KP + 16 * d0 + 8 * hi);
            p0 = __builtin_amdgcn_mfma_f32_32x32x16_bf16(a0, qr[d0], p0, 0, 0, 0); p1 = __builtin_amdgcn_mfma_f32_32x32x16_bf16(a1, qr[d0], p1, 0, 0, 0); }
        if (jb >= 0) { const int qrel = 32 * wid + r32, kb = 64 * jb + 4 * hi;
#pragma unroll
            for (int r = 0; r < 16; ++r) { const int kv = kb + (r & 3) + 8 * (r >> 2); if (kv > qrel) p0[r] = -__builtin_inff(); if (kv + 32 > qrel) p1[r] = -__builtin_inff(); } }
        float mx = fmaxf(p0[0], p1[0]);
#pragma unroll
        for (int r = 1; r < 16; ++r) mx = fmaxf(mx, fmaxf(p0[r], p1[r]));
        mx = fmaxf(mx, bperm(mx, lane ^ 32));
        const float mn = fmaxf(m, mx), alpha = __builtin_amdgcn_exp2f(m - mn); m = mn;
        float sum = 0.f;
#pragma unroll
        for (int r = 0; r < 16; ++r) { p0[r] = __builtin_amdgcn_exp2f(p0[r] - mn); p1[r] = __builtin_amdgcn_exp2f(p1[r] - mn); sum += p0[r] + p1[r]; }
        l = l * alpha + sum;
#pragma unroll
        for (int r = 0; r < 16; ++r) { o0[r] *= alpha; o1[r] *= alpha; }
        bf16x8 pb[4];
        { v4u w;
          w.x = pg8::cvt_pk_bf16(p0[0], p0[1]); w.y = pg8::cvt_pk_bf16(p0[2], p0[3]); w.z = pg8::cvt_pk_bf16(p0[4], p0[5]); w.w = pg8::cvt_pk_bf16(p0[6], p0[7]); pb[0] = __builtin_bit_cast(bf16x8, w);
          w.x = pg8::cvt_pk_bf16(p0[8], p0[9]); w.y = pg8::cvt_pk_bf16(p0[10], p0[11]); w.z = pg8::cvt_pk_bf16(p0[12], p0[13]); w.w = pg8::cvt_pk_bf16(p0[14], p0[15]); pb[1] = __builtin_bit_cast(bf16x8, w);
          w.x = pg8::cvt_pk_bf16(p1[0], p1[1]); w.y = pg8::cvt_pk_bf16(p1[2], p1[3]); w.z = pg8::cvt_pk_bf16(p1[4], p1[5]); w.w = pg8::cvt_pk_bf16(p1[6], p1[7]); pb[2] = __builtin_bit_cast(bf16x8, w);
          w.x = pg8::cvt_pk_bf16(p1[8], p1[9]); w.y = pg8::cvt_pk_bf16(p1[10], p1[11]); w.z = pg8::cvt_pk_bf16(p1[12], p1[13]); w.w = pg8::cvt_pk_bf16(p1[14], p1[15]); pb[3] = __builtin_bit_cast(bf16x8, w); }
#pragma unroll
        for (int mm = 0; mm < 4; ++mm) {
            typedef unsigned u32x2v __attribute__((ext_vector_type(2)));
            const u32x2v a0l = *(const LAS u32x2v*)(Vt + r32 * FOX_KP + 16 * mm + 4 * hi), a0h = *(const LAS u32x2v*)(Vt + r32 * FOX_KP + 16 * mm + 8 + 4 * hi);
            const u32x2v a1l = *(const LAS u32x2v*)(Vt + (32 + r32) * FOX_KP + 16 * mm + 4 * hi), a1h = *(const LAS u32x2v*)(Vt + (32 + r32) * FOX_KP + 16 * mm + 8 + 4 * hi);
            const v4u A0 = {a0l.x, a0l.y, a0h.x, a0h.y}, A1 = {a1l.x, a1l.y, a1h.x, a1h.y};
            o0 = __builtin_amdgcn_mfma_f32_32x32x16_bf16(__builtin_bit_cast(bf16x8, A0), pb[mm], o0, 0, 0, 0);
            o1 = __builtin_amdgcn_mfma_f32_32x32x16_bf16(__builtin_bit_cast(bf16x8, A1), pb[mm], o1, 0, 0, 0); }
    }
    l += bperm(l, lane ^ 32); const float inv = 1.f / l;
    bf16* Ow = O + (rowbase + q0 + wid * 32 + r32) * 512 + h * 64;
#pragma unroll
    for (int g = 0; g < 4; ++g) { typedef unsigned u32x2v __attribute__((ext_vector_type(2)));
        u32x2v w0, w1; w0.x = pg8::cvt_pk_bf16(o0[4 * g] * inv, o0[4 * g + 1] * inv); w0.y = pg8::cvt_pk_bf16(o0[4 * g + 2] * inv, o0[4 * g + 3] * inv);
        w1.x = pg8::cvt_pk_bf16(o1[4 * g] * inv, o1[4 * g + 1] * inv); w1.y = pg8::cvt_pk_bf16(o1[4 * g + 2] * inv, o1[4 * g + 3] * inv);
        *(u32x2v*)(Ow + 8 * g + 4 * hi) = w0; *(u32x2v*)(Ow + 32 + 8 * g + 4 * hi) = w1; }
    __syncthreads();
}
__global__ void __launch_bounds__(NTHR, 2) hybrid_fwd(Args args) {
    extern __shared__ __attribute__((aligned(16))) unsigned char lds_raw[];
    cg::grid_group grid = cg::this_grid();
    LAS unsigned char* lds = (LAS unsigned char*)lds_raw;
    int tid = threadIdx.x, lane = tid & 63, wave = __builtin_amdgcn_readfirstlane(tid >> 6);
    int G = gridDim.x, bx = blockIdx.x;
    int vcu = (G % 8 == 0) ? (bx % 8) * (G / 8) + bx / 8 : bx;
    int gw = vcu * NWAVES + wave; int NGW = G * NWAVES;
    PtrTab TB = (PtrTab)(lds + TAB_OFF);
    if (tid == 0) {
#pragma unroll
        for (int i = 0; i < 31; ++i) TB[i] = (unsigned long long)args.in[i];
    }
    if (tid == 1) { TB[40] = 0ull; }
    __syncthreads();
    (void)xcd_barrier_post((unsigned*)(args.ws + WS_BAR), (volatile LAS unsigned*)(lds + TAB_OFF + 320));
    grid.sync();
    unsigned char* ws = args.ws;
    float* X = args.out;
    float* SS = (float*)(ws + WS_SSP);
    bf16* XB = (bf16*)(ws + WS_XB);
    bf16* HB = (bf16*)(ws + WS_H);
    constexpr float C2X = 0.0625f * 1.4426950408889634f;
#define GSYNC() do { asm volatile("s_waitcnt vmcnt(0) lgkmcnt(0)" ::: "memory"); { XcdBarrier xb_; xb_.bar = (unsigned*)(ws + WS_BAR); xb_.x = xb_xcc_id(); xb_.st = (volatile LAS unsigned*)(lds + TAB_OFF + 320); xcd_barrier(xb_); } tid = threadIdx.x; asm volatile("" : "+v"(tid)); lane = tid & 63; wave = __builtin_amdgcn_readfirstlane(tid >> 6); G = gridDim.x; bx = blockIdx.x; asm volatile("" : "+s"(G), "+s"(bx)); vcu = (G % 8 == 0) ? (bx % 8) * (G / 8) + bx / 8 : bx; gw = vcu * NWAVES + wave; NGW = G * NWAVES; { unsigned long long wsi_ = (unsigned long long)ws; asm volatile("" : "+s"(wsi_)); ws = (unsigned char*)(GAS unsigned char*)wsi_; } } while (0)

    for (int l = 0; l < DEPTH; ++l) {
        float* ss0 = SS + (size_t)(4 * l + 0) * M * 16; float* ss1 = SS + (size_t)(4 * l + 1) * M * 16; float* ss2 = SS + (size_t)(4 * l + 2) * M * 16; float* ss3 = SS + (size_t)(4 * l + 3) * M * 16; float* ss4 = SS + (size_t)(4 * l + 4) * M * 16;
        phase_prologue(TB, ws, X, l, lds, gw, NGW, lane, wave);
        GSYNC();
        { pg8::Gemm g{XB, (const bf16*)(ws + WS_W1IN), M, 2 * DFF, D, D, D, 0}; pg8::StaticOrder S; S.init(M, 2 * DFF, G, bx);
          pg8::EpiSwiglu E{HB, ss0, DFF};
          pg8::gemm_phase<pg8::EpiSwiglu, pg8::StaticOrder, true, true>(lds, g, S, E); }
        if (bx >= G / 2) { pg8::Gemm g{(const bf16*)(ws + WS_MEMN), (const bf16*)(ws + WS_WXKV), 512, 2 * D, D, D, D, 0}; pg8::StaticOrder S; S.init(512, 2 * D, G, bx - G / 2);
          pg8::EpiKV E{(bf16*)(ws + WS_KX), (bf16*)(ws + WS_VT)};
          pg8::gemm_phase<pg8::EpiKV, pg8::StaticOrder, true, true>(lds, g, S, E); }
        GSYNC();
        { pg8::Gemm g{HB, (const bf16*)(ws + WS_W1OUT), M, D, DFF, DFF, DFF, 0}; pg8::StaticOrder S; S.init(M, D, G, bx);
          pg8::EpiResid E{X, XB, ss1, 0.5f};
          pg8::gemm_phase<pg8::EpiResid, pg8::StaticOrder, true, true>(lds, g, S, E); }
        GSYNC();
        { pg8::Gemm g{XB, (const bf16*)(ws + WS_WIN), M, 4096, D, D, D, 0}; pg8::StaticOrder S; S.init(M, 4096, G, bx);
          pg8::EpiWin E{(bf16*)(ws + WS_XA), (bf16*)(ws + WS_XL), (bf16*)(ws + WS_GG), (bf16*)(ws + WS_Q), (bf16*)(ws + WS_K), (bf16*)(ws + WS_V), ss1, FOX_C2};
          pg8::gemm_phase<pg8::EpiWin, pg8::StaticOrder, true, true>(lds, g, S, E); }
        phase_fl(XB, (const float*)(ws + WS_WFL), tab_in(TB, 7) + l * 8, ss1, (float*)(ws + WS_LOGF), gw, NGW, lane);
        GSYNC();
        if (vcu < 16) cumsum_bh((const float*)(ws + WS_LOGF), (float*)(ws + WS_CTIL), vcu, (LAS float*)lds);
        for (int it = vcu; it < 512; it += G)
            lru_item<false>(lds, it >> 8, (it >> 6) & 3, it & 63, (const bf16*)(ws + WS_XL), (bf16*)(ws + WS_GG), tab_in(TB, 12) + (size_t)l * 4 * D, tab_in(TB, 13) + l * D, (const bf16*)(ws + WS_WAT), (const bf16*)(ws + WS_WXT),
                            tab_in(TB, 15) + l * D, tab_in(TB, 17) + l * D, tab_in(TB, 18) + l * D, (float*)(ws + WS_SUMM));
        phase_pool((const bf16*)(ws + WS_XA), (bf16*)(ws + WS_YA), vcu * NTHR + tid, G * NTHR);
        phase_kmax((const bf16*)(ws + WS_K), (float*)(ws + WS_KPART), gw, NGW, lane);
        GSYNC();
        for (int it = vcu; it < 512; it += G)
            lru_item<true>(lds, it >> 8, (it >> 6) & 3, it & 63, (const bf16*)(ws + WS_XL), (bf16*)(ws + WS_GG), tab_in(TB, 12) + (size_t)l * 4 * D, tab_in(TB, 13) + l * D, (const bf16*)(ws + WS_WAT), (const bf16*)(ws + WS_WXT),
                           tab_in(TB, 15) + l * D, tab_in(TB, 17) + l * D, tab_in(TB, 18) + l * D, (float*)(ws + WS_SUMM));
        for (int p = vcu; p < 256; p += G) { const int bh = p >> 4, s = p & 15;
            fox_unit(lds, bh >> 3, bh & 7, s, (const bf16*)(ws + WS_Q), (const bf16*)(ws + WS_K), (const bf16*)(ws + WS_V), (bf16*)(ws + WS_YC), (const float*)(ws + WS_CTIL) + (size_t)bh * SEQ, (const float*)(ws + WS_KPART), NGW);
            fox_unit(lds, bh >> 3, bh & 7, 31 - s, (const bf16*)(ws + WS_Q), (const bf16*)(ws + WS_K), (const bf16*)(ws + WS_V), (bf16*)(ws + WS_YC), (const float*)(ws + WS_CTIL) + (size_t)bh * SEQ, (const float*)(ws + WS_KPART), NGW); }
        GSYNC();
        { pg8::StaticOrder S; S.init(M, D, G, bx); pg8::Unit u;
          bf16* stash = (bf16*)(ws + WS_STASH) + (size_t)bx * 65536; bf16* mg = (bf16*)(ws + WS_MG);
          for (int i = 0; S.next(i, u); ++i) { const pg8::OneUnit O1{u.pm, u.pn};
#pragma unroll 1
              for (int br = 0; br < 3; ++br) {
                  { pg8::Gemm g{XB, (const bf16*)(ws + WS_WG) + (size_t)br * D * D, M, D, D, D, D, 0}; pg8::EpiGate E{stash, tab_in(TB, 8) + (size_t)l * 3 * D + br * D, ss1};
                    pg8::gemm_phase<pg8::EpiGate, pg8::OneUnit, true, true>(lds, g, O1, E); }
                  asm volatile("s_waitcnt vmcnt(0)" ::: "memory"); __builtin_amdgcn_fence(__ATOMIC_ACQUIRE, "agent"); __syncthreads();
                  const bf16* Ab = br == 0 ? (const bf16*)(ws + WS_YA) : br == 1 ? (const bf16*)(ws + WS_GG) : (const bf16*)(ws + WS_YC);
                  const bf16* Ub = br == 0 ? (const bf16*)(ws + WS_UA) : br == 1 ? (const bf16*)(ws + WS_UB) : (const bf16*)(ws + WS_UC);
                  const int Kb = br == 1 ? 1024 : 512;
                  { pg8::Gemm g{Ab, Ub, M, D, Kb, Kb, Kb, 0}; pg8::EpiMerge E{stash, mg, br == 0 ? 1 : 0};
                    pg8::gemm_phase<pg8::EpiMerge, pg8::OneUnit, true, true>(lds, g, O1, E); }
                  asm volatile("s_waitcnt vmcnt(0)" ::: "memory"); __builtin_amdgcn_fence(__ATOMIC_ACQUIRE, "agent"); __syncthreads();
              } } }
        GSYNC();
        { pg8::Gemm g{(const bf16*)(ws + WS_MG), (const bf16*)(ws + WS_WO), M, D, D, D, D, 0}; pg8::StaticOrder S; S.init(M, D, G, bx);
          pg8::EpiResid E{X, XB, ss2, 1.0f};
          pg8::gemm_phase<pg8::EpiResid, pg8::StaticOrder, true, true>(lds, g, S, E); }
        GSYNC();
        { pg8::Gemm g{XB, (const bf16*)(ws + WS_WXQ), M, D, D, D, D, 0}; pg8::StaticOrder S; S.init(M, D, G, bx);
          pg8::EpiRs E{(bf16*)(ws + WS_QX), D, ss2, C2X};
          pg8::gemm_phase<pg8::EpiRs, pg8::StaticOrder, true, true>(lds, g, S, E); }
        GSYNC();
        { bf16* pb = (bf16*)(ws + WS_PBUF) + (size_t)bx * 65536; const pg8::OneUnit O1{0, 0};
          for (int uid = vcu; uid < 256; uid += G) { const int rt = uid >> 2, h = uid & 3, b = rt >> 5;
              int KX = 256; asm volatile("" : "+s"(KX));
              bf16* qo = (bf16*)(ws + WS_QX) + (size_t)rt * 256 * D + h * 256;
              { pg8::Gemm g{qo, (const bf16*)(ws + WS_KX) + (size_t)b * 256 * D + h * 256, 256, 256, KX, D, D, 0}; pg8::EpiSoftmaxP E{pb};
                pg8::gemm_phase<pg8::EpiSoftmaxP, pg8::OneUnit, false, true>(lds, g, O1, E); }
              asm volatile("s_waitcnt vmcnt(0)" ::: "memory"); __builtin_amdgcn_fence(__ATOMIC_ACQUIRE, "agent"); __syncthreads();
              { pg8::Gemm g{pb, (const bf16*)(ws + WS_VT) + (size_t)(b * 4 + h) * 65536, 256, 256, KX, 256, 256, 0}; pg8::EpiRs E{qo, D, nullptr, 1.0f};
                pg8::gemm_phase<pg8::EpiRs, pg8::OneUnit, true, true>(lds, g, O1, E); }
              asm volatile("s_waitcnt vmcnt(0)" ::: "memory"); __syncthreads();
          } }
        GSYNC();
        { pg8::Gemm g{(const bf16*)(ws + WS_QX), (const bf16*)(ws + WS_WXO), M, D, D, D, D, 0}; pg8::StaticOrder S; S.init(M, D, G, bx);
          pg8::EpiResid E{X, XB, ss3, 1.0f};
          pg8::gemm_phase<pg8::EpiResid, pg8::StaticOrder, true, true>(lds, g, S, E); }
        GSYNC();
        { pg8::Gemm g{XB, (const bf16*)(ws + WS_W2IN), M, 2 * DFF, D, D, D, 0}; pg8::StaticOrder S; S.init(M, 2 * DFF, G, bx);
          pg8::EpiSwiglu E{HB, ss3, DFF};
          pg8::gemm_phase<pg8::EpiSwiglu, pg8::StaticOrder, true, true>(lds, g, S, E); }
        GSYNC();
        { pg8::Gemm g{HB, (const bf16*)(ws + WS_W2OUT), M, D, DFF, DFF, DFF, 0}; pg8::StaticOrder S; S.init(M, D, G, bx);
          pg8::EpiResid E{X, XB, ss4, 0.5f};
          pg8::gemm_phase<pg8::EpiResid, pg8::StaticOrder, true, true>(lds, g, S, E); }
        GSYNC();
    }
    phase_final(X, tab_in(TB, 30), gw, NGW, lane);
#undef GSYNC
}

extern "C" void kernel_launch(void* const* d_in, const int* in_sizes, int n_in, void* d_out, int out_size, void* d_ws, size_t ws_size, hipStream_t stream) {
    static int grid = 0;
    if (grid == 0) {
        if (n_in != 31 || out_size != M * D || ws_size < WS_END) { fprintf(stderr, "kernel_launch: unexpected problem (n_in %d, out %d, ws %zu)\n", n_in, out_size, ws_size); grid = -1; return; }
        int dev = 0, cus = 0, per_cu = 0;
        (void)hipGetDevice(&dev); (void)hipDeviceGetAttribute(&cus, hipDeviceAttributeMultiprocessorCount, dev);
        if (hipFuncSetAttribute((const void*)hybrid_fwd, hipFuncAttributeMaxDynamicSharedMemorySize, LDS_BYTES) != hipSuccess) { fprintf(stderr, "kernel_launch: hipFuncSetAttribute failed\n"); grid = -1; return; }
        if (hipOccupancyMaxActiveBlocksPerMultiprocessor(&per_cu, (const void*)hybrid_fwd, NTHR, LDS_BYTES) != hipSuccess || per_cu < 1) per_cu = 1;
        (void)hipGetLastError();
        grid = cus * (per_cu > 1 ? 1 : per_cu);
        if (grid > 256) grid = 256;
    }
    if (grid < 0) return;
    (void)hipMemsetAsync((char*)d_ws + WS_SS, 0, CTL_ZERO_BYTES, stream);
    Args a{};
    for (int i = 0; i < 31; ++i) a.in[i] = (const float*)d_in[i];
    a.out = (float*)d_out; a.ws = (unsigned char*)d_ws;
    void* kargs[] = {&a};
    hipError_t e = hipLaunchCooperativeKernel((const void*)hybrid_fwd, dim3(grid), dim3(NTHR), kargs, LDS_BYTES, stream);
    if (e != hipSuccess) fprintf(stderr, "cooperative launch failed: %s (grid %d)\n", hipGetErrorString(e), grid);
}
```

```cpp
#include <hip/hip_runtime.h>
#include <hip/hip_cooperative_groups.h>
#include <cstdio>
#include <cstdint>
namespace cg = cooperative_groups;
namespace pg8 {
#define PG8_LAS __attribute__((address_space(3)))
typedef unsigned short bf16_t;
typedef short bf16x8 __attribute__((ext_vector_type(8)));
typedef float f32x4 __attribute__((ext_vector_type(4)));
typedef unsigned u32x4 __attribute__((ext_vector_type(4)));
constexpr int BM = 256, BK = 64, HALF = 128, HTB = HALF * BK * 2  , STAGE_BYTES = 8 * HTB, NXCD = 8, WGM = 8;

__host__ __device__ __forceinline__ int lds_byte(int r, int c) { const int st = (r >> 4) * 2 + (c >> 5), rr = r & 15, cc = c & 31, ob = rr * 64 + cc * 2; return st * 1024 + (ob ^ (((ob >> 9) & 1) << 5)); }
__host__ __device__ __forceinline__ void stage_rc(int b, int& R, int& C) { const int st = b / 1024, sb = b % 1024, swz = sb ^ (((sb >> 9) & 1) << 5); R = (st >> 1) * 16 + swz / 64; C = (st & 1) * 32 + (swz % 64) / 2; }
__host__ __device__ __forceinline__ int perm32(int rho) { const int n = rho >> 4, i = rho & 15; return 8 * (i >> 2) + 4 * n + (i & 3); }

struct Unit { int pm, pn; };
struct Gemm { const bf16_t* A; const bf16_t* Bt; int M, N, K, lda, ldb, a_pn_off; };

struct StaticOrder {
    int nM, nN, nwg, G, c;
    __host__ __device__ __forceinline__ void init(int M, int N, int G_, int c_) { nM = M / BM; nN = N / BM; nwg = nM * nN; G = G_; c = c_; }
    __host__ __device__ __forceinline__ bool next(int i, Unit& u) const {
        const long L = (long)i * G + c; if (L >= nwg) return false;
        int wgid = (int)L; { const int q = nwg / NXCD, r = nwg % NXCD, xcd = wgid % NXCD, off = wgid / NXCD; wgid = (xcd < r ? xcd * (q + 1) : r * (q + 1) + (xcd - r) * q) + off; }
        const int nig = WGM * nN, gid = wgid / nig, fm = gid * WGM, gsz = (nM - fm) < WGM ? (nM - fm) : WGM;
        u.pm = fm + ((wgid % nig) % gsz); u.pn = (wgid % nig) / gsz; return true;
    }
    __device__ __forceinline__ void a_ready(const Unit&) const {}
    __device__ __forceinline__ void done(const Unit&) const {}
};

__device__ __forceinline__ unsigned cvt_pk_bf16(float lo, float hi) { unsigned r; asm volatile("v_cvt_pk_bf16_f32 %0, %1, %2" : "=v"(r) : "v"(lo), "v"(hi)); return r; }
__device__ __forceinline__ float bperm(float v, int srclane) { return __int_as_float(__builtin_amdgcn_ds_bpermute(srclane << 2, __float_as_int(v))); }
typedef float f32x2 __attribute__((ext_vector_type(2)));
typedef unsigned u32x2 __attribute__((ext_vector_type(2)));
__device__ __forceinline__ float fsig(float v) { return __builtin_amdgcn_rcpf(1.f + __expf(-v)); }
__device__ __forceinline__ float fsilu(float v) { return v * fsig(v); }
__device__ __forceinline__ float fgelu_tanh(float v) { return v * fsig(1.5957691216057308f * (v + 0.044715f * v * v * v)); }
__device__ __forceinline__ float bf_lo(unsigned w) { return __uint_as_float(w << 16); }
__device__ __forceinline__ float bf_hi(unsigned w) { return __uint_as_float(w & 0xffff0000u); }
__device__ __forceinline__ float rstd_of(const float* ss, int row) { const f32x4 a = *(const f32x4*)(ss + (size_t)row * 4); return rsqrtf(((a[0] + a[1]) + (a[2] + a[3])) * (1.0f / 1024.0f) + 1e-6f); }
__device__ __forceinline__ u32x4 pack8(const f32x4 v0, const f32x4 v1) { u32x4 w; w.x = cvt_pk_bf16(v0[0], v0[1]); w.y = cvt_pk_bf16(v0[2], v0[3]); w.z = cvt_pk_bf16(v1[0], v1[1]); w.w = cvt_pk_bf16(v1[2], v1[3]); return w; }

__device__ __forceinline__ void rstd8(const float* ss, int row0, float sc, float (&rs)[2][4]) {
    f32x4 pa[2][4];
#pragma unroll
    for (int ai = 0; ai < 2; ++ai)
#pragma unroll
        for (int m = 0; m < 4; ++m) pa[ai][m] = *(const f32x4*)(ss + (size_t)(row0 + ai * HALF + m * 16) * 4);
#pragma unroll
    for (int ai = 0; ai < 2; ++ai)
#pragma unroll
        for (int m = 0; m < 4; ++m) { const f32x4 a = pa[ai][m]; rs[ai][m] = rsqrtf(((a[0] + a[1]) + (a[2] + a[3])) * (1.0f / 1024.0f) + 1e-6f) * sc; }
    __builtin_amdgcn_sched_barrier(0);
}

struct OneUnit { int pm, pn;
    __device__ __forceinline__ bool next(int i, Unit& u) const { if (i) return false; u.pm = pm; u.pn = pn; return true; }
    __device__ __forceinline__ void a_ready(const Unit&) const {}
    __device__ __forceinline__ void done(const Unit&) const {} };

struct EpiSwiglu { static constexpr bool PERM = true, AFTER_DRAIN = false; bf16_t* H; const float* ss; int ldh;
    __device__ __forceinline__ void operator()(const f32x4 (&acc)[2][2][4][2], const Unit& u, int wr, int wc, int fr, int fq) const {
        const int row0 = u.pm * BM + wr * 64 + fr, col0 = u.pn * HALF + wc * 32 + 8 * fq; float rsv[2][4]; rstd8(ss, row0, 1.f, rsv);
#pragma unroll
        for (int ai = 0; ai < 2; ++ai)
#pragma unroll
            for (int m = 0; m < 4; ++m) { const int row = row0 + ai * HALF + m * 16; const float rs = rsv[ai][m];
                f32x4 o0, o1;
#pragma unroll
                for (int i = 0; i < 4; ++i) { o0[i] = fsilu(acc[ai][0][m][0][i] * rs) * (acc[ai][1][m][0][i] * rs); o1[i] = fsilu(acc[ai][0][m][1][i] * rs) * (acc[ai][1][m][1][i] * rs); }
                *(u32x4*)(H + (size_t)row * ldh + col0) = pack8(o0, o1); __builtin_amdgcn_sched_barrier(0); }
    }
};
struct EpiResid { static constexpr bool PERM = false, AFTER_DRAIN = true; float* x; bf16_t* xb; float* ss; float scale;
    __device__ __forceinline__ void fused(f32x4 (&acc)[2][2][4][2], const Unit& u, int wr, int wc, int fr, int fq, PG8_LAS unsigned char* lds, int wid, int lane) const {
        float scl = scale; asm volatile("" : "+v"(scl)); const int row0 = u.pm * BM + wr * 64 + fr, col0 = u.pn * BM + wc * 32 + 4 * fq;
        PG8_LAS float* P = (PG8_LAS float*)lds;
#pragma unroll
        for (int ai = 0; ai < 2; ++ai)
#pragma unroll
            for (int m = 0; m < 4; ++m) { const int row = row0 + ai * HALF + m * 16; float q = 0.f;
#pragma unroll
                for (int bj = 0; bj < 2; ++bj)
#pragma unroll
                    for (int n = 0; n < 2; ++n) { const size_t off = (size_t)row * 1024 + col0 + bj * HALF + n * 16;
                        f32x4 v = *(const f32x4*)(x + off) + acc[ai][bj][m][n] * scl; *(f32x4*)(x + off) = v;
                        u32x2 w; w.x = cvt_pk_bf16(v[0], v[1]); w.y = cvt_pk_bf16(v[2], v[3]); *(u32x2*)(xb + off) = w;
                        q += (v[0] * v[0] + v[1] * v[1]) + (v[2] * v[2] + v[3] * v[3]); }
                q += bperm(q, (fr + 16 * fq) ^ 16); q += bperm(q, (fr + 16 * fq) ^ 32);
                if (fq == 0) P[(ai * HALF + wr * 64 + m * 16 + fr) * 4 + wc] = q; }
        asm volatile("s_waitcnt lgkmcnt(0)" ::: "memory"); __builtin_amdgcn_s_barrier(); asm volatile("" ::: "memory");
        const int tl = wid * 64 + lane;
        if (tl < 256) { const f32x4 a = *(const PG8_LAS f32x4*)(P + tl * 4); ss[(size_t)(u.pm * BM + tl) * 4 + u.pn] = (a[0] + a[1]) + (a[2] + a[3]); }
        asm volatile("s_waitcnt lgkmcnt(0)" ::: "memory"); __builtin_amdgcn_s_barrier(); asm volatile("" ::: "memory");
    }
};
struct EpiRs { static constexpr bool PERM = true, AFTER_DRAIN = false; bf16_t* O; int ldc; const float* ss; float sc;
    __device__ __forceinline__ void operator()(const f32x4 (&acc)[2][2][4][2], const Unit& u, int wr, int wc, int fr, int fq) const {
        const int row0 = u.pm * BM + wr * 64 + fr, col0 = u.pn * BM + wc * 32 + 8 * fq; float rsv[2][4];
        if (ss) rstd8(ss, row0, sc, rsv); else {
#pragma unroll
            for (int a = 0; a < 2; ++a)
#pragma unroll
                for (int b = 0; b < 4; ++b) rsv[a][b] = sc; }
#pragma unroll
        for (int ai = 0; ai < 2; ++ai)
#pragma unroll
            for (int m = 0; m < 4; ++m) { const int row = row0 + ai * HALF + m * 16; const float rs = rsv[ai][m];
#pragma unroll
                for (int bj = 0; bj < 2; ++bj) *(u32x4*)(O + (size_t)row * ldc + col0 + bj * HALF) = pack8(acc[ai][bj][m][0] * rs, acc[ai][bj][m][1] * rs); }
    }
};
struct EpiWin { static constexpr bool PERM = true, AFTER_DRAIN = false; bf16_t *xa, *xl, *gg, *q, *k, *v; const float* ss; float qscale;
    __device__ __forceinline__ void operator()(const f32x4 (&acc)[2][2][4][2], const Unit& u, int wr, int wc, int fr, int fq) const {
        const int pn = u.pn; bf16_t* dst; int ld, ct; float sc = 1.f; bool act = false;
        if (pn < 2) { dst = xa; ld = 512; ct = pn; } else if (pn < 6) { dst = xl; ld = 1024; ct = pn - 2; } else if (pn < 10) { dst = gg; ld = 1024; ct = pn - 6; act = true; }
        else if (pn < 12) { dst = q; ld = 512; ct = pn - 10; sc = qscale; } else if (pn < 14) { dst = k; ld = 512; ct = pn - 12; } else { dst = v; ld = 512; ct = pn - 14; }
        const int row0 = u.pm * BM + wr * 64 + fr, col0 = ct * BM + wc * 32 + 8 * fq; float rsv[2][4]; rstd8(ss, row0, sc, rsv);
#pragma unroll
        for (int ai = 0; ai < 2; ++ai)
#pragma unroll
            for (int m = 0; m < 4; ++m) { const int row = row0 + ai * HALF + m * 16; const float rs = rsv[ai][m];
#pragma unroll
                for (int bj = 0; bj < 2; ++bj) { f32x4 v0 = acc[ai][bj][m][0] * rs, v1 = acc[ai][bj][m][1] * rs;
                    if (act) {
#pragma unroll
                        for (int i = 0; i < 4; ++i) { v0[i] = fgelu_tanh(v0[i]); v1[i] = fgelu_tanh(v1[i]); } }
                    *(u32x4*)(dst + (size_t)row * ld + col0 + bj * HALF) = pack8(v0, v1); __builtin_amdgcn_sched_barrier(0); } }
    }
};
struct EpiGate { static constexpr bool PERM = true, AFTER_DRAIN = false; bf16_t* stash; const float* bg; const float* ss;
    __device__ __forceinline__ void operator()(const f32x4 (&acc)[2][2][4][2], const Unit& u, int wr, int wc, int fr, int fq) const {
        const int row0 = u.pm * BM + wr * 64 + fr, col0 = u.pn * BM + wc * 32 + 8 * fq; int tid_o = threadIdx.x; asm volatile("" : "+v"(tid_o)); const int tid = tid_o;
        f32x4 bv[2][2];
#pragma unroll
        for (int bj = 0; bj < 2; ++bj)
#pragma unroll
            for (int n = 0; n < 2; ++n) bv[bj][n] = *(const f32x4*)(bg + col0 + bj * HALF + 4 * n);
        float rsv[2][4]; rstd8(ss, row0, 1.f, rsv);
#pragma unroll
        for (int ai = 0; ai < 2; ++ai)
#pragma unroll
            for (int m = 0; m < 4; ++m) { const float rs = rsv[ai][m];
#pragma unroll
                for (int bj = 0; bj < 2; ++bj) { f32x4 v0 = acc[ai][bj][m][0] * rs + bv[bj][0], v1 = acc[ai][bj][m][1] * rs + bv[bj][1];
#pragma unroll
                    for (int i = 0; i < 4; ++i) { v0[i] = fsig(v0[i]); v1[i] = fsig(v1[i]); }
                    *(u32x4*)(stash + ((size_t)((ai * 4 + m) * 2 + bj) * 512 + tid) * 8) = pack8(v0, v1); __builtin_amdgcn_sched_barrier(0); } }
    }
};
struct EpiMerge { static constexpr bool PERM = true, AFTER_DRAIN = false; const bf16_t* stash; bf16_t* mg; int first;
    __device__ __forceinline__ void operator()(const f32x4 (&acc)[2][2][4][2], const Unit& u, int wr, int wc, int fr, int fq) const {
        const int row0 = u.pm * BM + wr * 64 + fr, col0 = u.pn * BM + wc * 32 + 8 * fq; int tid_o = threadIdx.x; asm volatile("" : "+v"(tid_o)); const int tid = tid_o;
#pragma unroll
        for (int ai = 0; ai < 2; ++ai) { u32x4 gw[4][2], ow[4][2];
#pragma unroll
            for (int m = 0; m < 4; ++m)
#pragma unroll
                for (int bj = 0; bj < 2; ++bj) { gw[m][bj] = *(const u32x4*)(stash + ((size_t)((ai * 4 + m) * 2 + bj) * 512 + tid) * 8);
                    ow[m][bj] = first ? (u32x4){0u, 0u, 0u, 0u} : *(const u32x4*)(mg + (size_t)(row0 + ai * HALF + m * 16) * 1024 + col0 + bj * HALF); }
            __builtin_amdgcn_sched_barrier(0);
#pragma unroll
            for (int m = 0; m < 4; ++m)
#pragma unroll
                for (int bj = 0; bj < 2; ++bj) { const u32x4 g = gw[m][bj], o = ow[m][bj]; f32x4 v0 = acc[ai][bj][m][0], v1 = acc[ai][bj][m][1];
                    v0[0] = v0[0] * bf_lo(g.x) + bf_lo(o.x); v0[1] = v0[1] * bf_hi(g.x) + bf_hi(o.x); v0[2] = v0[2] * bf_lo(g.y) + bf_lo(o.y); v0[3] = v0[3] * bf_hi(g.y) + bf_hi(o.y);
                    v1[0] = v1[0] * bf_lo(g.z) + bf_lo(o.z); v1[1] = v1[1] * bf_hi(g.z) + bf_hi(o.z); v1[2] = v1[2] * bf_lo(g.w) + bf_lo(o.w); v1[3] = v1[3] * bf_hi(g.w) + bf_hi(o.w);
                    *(u32x4*)(mg + (size_t)(row0 + ai * HALF + m * 16) * 1024 + col0 + bj * HALF) = pack8(v0, v1); }
            __builtin_amdgcn_sched_barrier(0); }
    }
};
struct EpiKV { static constexpr bool PERM = true, AFTER_DRAIN = false; bf16_t* kx; bf16_t* vt;
    __device__ __forceinline__ void operator()(const f32x4 (&acc)[2][2][4][2], const Unit& u, int wr, int wc, int fr, int fq) const {
        if (u.pn < 4) { const int row0 = u.pm * BM + wr * 64 + fr, col0 = u.pn * BM + wc * 32 + 8 * fq;
#pragma unroll
            for (int ai = 0; ai < 2; ++ai)
#pragma unroll
                for (int m = 0; m < 4; ++m)
#pragma unroll
                    for (int bj = 0; bj < 2; ++bj) *(u32x4*)(kx + (size_t)(row0 + ai * HALF + m * 16) * 1024 + col0 + bj * HALF) = pack8(acc[ai][bj][m][0], acc[ai][bj][m][1]);
        } else { const int h = u.pn - 4, b = u.pm; bf16_t* base = vt + (size_t)(b * 4 + h) * 65536;
#pragma unroll
            for (int ai = 0; ai < 2; ++ai)
#pragma unroll
                for (int m = 0; m < 4; ++m) { const int mr = ai * HALF + wr * 64 + m * 16 + fr;
#pragma unroll
                    for (int bj = 0; bj < 2; ++bj) { bf16_t* p = base + (size_t)(bj * HALF + wc * 32 + 8 * fq) * 256 + mr; asm volatile("" : "+v"(p));
#pragma unroll
                        for (int n = 0; n < 2; ++n)
#pragma unroll
                            for (int i = 0; i < 4; ++i) p[(4 * n + i) * 256] = (bf16_t)(cvt_pk_bf16(acc[ai][bj][m][n][i], 0.f) & 0xffffu);
                        __builtin_amdgcn_sched_barrier(0); } }
        }
    }
};
struct EpiSoftmaxP { static constexpr bool PERM = true, AFTER_DRAIN = true; bf16_t* P;
    __device__ __forceinline__ void fused(f32x4 (&acc)[2][2][4][2], const Unit& u, int wr, int wc, int fr, int fq, PG8_LAS unsigned char* lds, int wid, int lane) const {
        PG8_LAS f32x2* X = (PG8_LAS f32x2*)lds;
        float mloc[2][4];
#pragma unroll
        for (int ai = 0; ai < 2; ++ai)
#pragma unroll
            for (int m = 0; m < 4; ++m) { float mx = -__builtin_inff();
#pragma unroll
                for (int bj = 0; bj < 2; ++bj)
#pragma unroll
                    for (int n = 0; n < 2; ++n) { const f32x4 v = acc[ai][bj][m][n]; mx = fmaxf(mx, fmaxf(fmaxf(v[0], v[1]), fmaxf(v[2], v[3]))); }
                mx = fmaxf(mx, bperm(mx, (fr + 16 * fq) ^ 16)); mx = fmaxf(mx, bperm(mx, (fr + 16 * fq) ^ 32)); float s = 0.f;
#pragma unroll
                for (int bj = 0; bj < 2; ++bj)
#pragma unroll
                    for (int n = 0; n < 2; ++n) { f32x4 v = acc[ai][bj][m][n];
#pragma unroll
                        for (int i = 0; i < 4; ++i) { v[i] = __builtin_amdgcn_exp2f(v[i] - mx); s += v[i]; }
                        acc[ai][bj][m][n] = v; }
                s += bperm(s, (fr + 16 * fq) ^ 16); s += bperm(s, (fr + 16 * fq) ^ 32); mloc[ai][m] = mx;
                if (fq == 0) X[(ai * HALF + wr * 64 + m * 16 + fr) * 4 + wc] = (f32x2){mx, s}; __builtin_amdgcn_sched_barrier(0); }
        asm volatile("s_waitcnt lgkmcnt(0)" ::: "memory"); __builtin_amdgcn_s_barrier(); asm volatile("" ::: "memory");
#pragma unroll
        for (int ai = 0; ai < 2; ++ai)
#pragma unroll
            for (int m = 0; m < 4; ++m) { const int rl = ai * HALF + wr * 64 + m * 16 + fr;
                const f32x2 a = X[rl * 4 + 0], b = X[rl * 4 + 1], c = X[rl * 4 + 2], d = X[rl * 4 + 3];
                const float M = fmaxf(fmaxf(a.x, b.x), fmaxf(c.x, d.x));
                const float L = a.y * __builtin_amdgcn_exp2f(a.x - M) + b.y * __builtin_amdgcn_exp2f(b.x - M) + c.y * __builtin_amdgcn_exp2f(c.x - M) + d.y * __builtin_amdgcn_exp2f(d.x - M);
                const float f = __builtin_amdgcn_exp2f(mloc[ai][m] - M) / L;
#pragma unroll
                for (int bj = 0; bj < 2; ++bj) *(u32x4*)(P + (size_t)rl * 256 + bj * HALF + wc * 32 + 8 * fq) = pack8(acc[ai][bj][m][0] * f, acc[ai][bj][m][1] * f); __builtin_amdgcn_sched_barrier(0); }
        asm volatile("s_waitcnt vmcnt(0) lgkmcnt(0)" ::: "memory"); __builtin_amdgcn_s_barrier(); asm volatile("" ::: "memory");
    }
};

template <class Epi, class Sched, bool ALIGN_EPI = false, bool SP2 = false>
__device__ __forceinline__ void gemm_phase(PG8_LAS unsigned char* lds, const Gemm g, const Sched& S, const Epi& E) {
    int tid_o = threadIdx.x; asm volatile("" : "+v"(tid_o));
    const int tid = tid_o, wid = __builtin_amdgcn_readfirstlane(tid >> 6), lane = tid & 63, wr = wid >> 2, wc = wid & 3, fr = lane & 15, fq = lane >> 4;
    const int K = g.K, nt = K / BK;
    unsigned voffA[2], voffB[2];
#pragma unroll
    for (int i = 0; i < 2; ++i) { int R, C; stage_rc(tid * 16 + i * 8192, R, C); const int Rb = Epi::PERM ? ((R & ~31) + perm32(R & 31)) : R;
        voffA[i] = (unsigned)(R * g.lda + C) * 2u; voffB[i] = (unsigned)(Rb * g.ldb + C) * 2u; }
    const size_t kstep = (size_t)(BK * 2);
    const size_t hstepA = (size_t)HALF * g.lda * 2, hstepB = (size_t)HALF * g.ldb * 2;
    const size_t tstepA = 2 * hstepA, tstepB = 2 * hstepB;
    const unsigned ldsw = (unsigned)wid * 1024u;
    const int aoff = lds_byte(wr * 64 + fr, fq * 8), boff = lds_byte(wc * 32 + fr, fq * 8);
#define PG8_SA(b, h) (((b) * 2 + (h)) * HTB)
#define PG8_SB(b, h) ((4 + (b) * 2 + (h)) * HTB)
#define PG8_STAGE(bufoff, gbase, voff) do { _Pragma("unroll") for (int _i = 0; _i < 2; ++_i) \
        __builtin_amdgcn_global_load_lds((const unsigned*)((const char*)(gbase) + (voff)[_i]), (PG8_LAS unsigned*)(lds + (bufoff) + ldsw + _i * 8192), 16, 0, 0); } while (0)
#define PG8_LDA(dst, b, h) do { _Pragma("unroll") for (int m = 0; m < 4; ++m) _Pragma("unroll") for (int k = 0; k < 2; ++k) dst[m][k] = *(const PG8_LAS bf16x8*)(lds + PG8_SA(b, h) + aoff + m * 2048 + k * 1024); } while (0)
#define PG8_LDB(dst, b, h) do { _Pragma("unroll") for (int n = 0; n < 2; ++n) _Pragma("unroll") for (int k = 0; k < 2; ++k) dst[n][k] = *(const PG8_LAS bf16x8*)(lds + PG8_SB(b, h) + boff + n * 2048 + k * 1024); } while (0)
#define PG8_MMA(ai, bj, At, Bt) do { __builtin_amdgcn_s_setprio(1); _Pragma("unroll") for (int m = 0; m < 4; ++m) _Pragma("unroll") for (int n = 0; n < 2; ++n) _Pragma("unroll") for (int k = 0; k < 2; ++k) \
        acc[ai][bj][m][n] = __builtin_amdgcn_mfma_f32_16x16x32_bf16(Bt[n][k], At[m][k], acc[ai][bj][m][n], 0, 0, 0); __builtin_amdgcn_s_setprio(0); } while (0)
#define PG8_WAIT_V(n) asm volatile("s_waitcnt vmcnt(" #n ")" ::: "memory")
#define PG8_WAIT_L(n) asm volatile("s_waitcnt lgkmcnt(" #n ")" ::: "memory")
#define PG8_BAR __builtin_amdgcn_s_barrier()
#define PG8_SCHED __builtin_amdgcn_sched_barrier(0)
    Unit cur, nxt; int ui = 0;
    if (!S.next(0, cur)) return;
    f32x4 acc[2][2][4][2];
#pragma unroll
    for (int a = 0; a < 2; ++a)
#pragma unroll
        for (int b = 0; b < 2; ++b)
#pragma unroll
            for (int m = 0; m < 4; ++m)
#pragma unroll
                for (int n = 0; n < 2; ++n) acc[a][b][m][n] = (f32x4){0.f, 0.f, 0.f, 0.f};
    bf16x8 At[4][2], B0[2][2], B1[2][2];
    const char* cA = (const char*)g.A + (size_t)cur.pm * tstepA + (size_t)cur.pn * g.a_pn_off * 2; const char* cB = (const char*)g.Bt + (size_t)cur.pn * tstepB;
    S.a_ready(cur);
    if constexpr (SP2) {
        PG8_STAGE(PG8_SB(0, 0), cB, voffB); PG8_STAGE(PG8_SB(0, 1), cB + hstepB, voffB); PG8_STAGE(PG8_SA(0, 0), cA, voffA); PG8_STAGE(PG8_SA(0, 1), cA + hstepA, voffA);
        if (wr == 1) PG8_BAR;
        PG8_WAIT_V(2); PG8_BAR;
        PG8_STAGE(PG8_SB(1, 0), cB + kstep, voffB); PG8_STAGE(PG8_SA(1, 0), cA + kstep, voffA); PG8_STAGE(PG8_SB(1, 1), cB + hstepB + kstep, voffB);
        PG8_WAIT_V(6); PG8_BAR;
    } else {
        PG8_STAGE(PG8_SB(0, 0), cB, voffB); PG8_STAGE(PG8_SA(0, 0), cA, voffA); PG8_STAGE(PG8_SB(0, 1), cB + hstepB, voffB); PG8_STAGE(PG8_SA(0, 1), cA + hstepA, voffA);
        if (wr == 1) PG8_BAR;
        PG8_WAIT_V(4); PG8_BAR;
        PG8_STAGE(PG8_SB(1, 0), cB + kstep, voffB); PG8_STAGE(PG8_SA(1, 0), cA + kstep, voffA); PG8_STAGE(PG8_SB(1, 1), cB + hstepB + kstep, voffB);
        PG8_WAIT_V(6); PG8_BAR;
    }
    for (;;) {
        const bool has_next = S.next(ui + 1, nxt);
        const char* nA = has_next ? (const char*)g.A + (size_t)nxt.pm * tstepA + (size_t)nxt.pn * g.a_pn_off * 2 : cA; const char* nB = has_next ? (const char*)g.Bt + (size_t)nxt.pn * tstepB : cB;
        for (int t = 0; t < nt; t += 2) {
            const bool last = (t == nt - 2);
            const char* a1 = cA + (size_t)(t + 1) * kstep;
            const char* a2 = last ? nA : cA + (size_t)(t + 2) * kstep; const char* b2 = last ? nB : cB + (size_t)(t + 2) * kstep;
            const char* a3 = a2 + kstep; const char* b3 = b2 + kstep;
            if (last && has_next) S.a_ready(nxt);
            if constexpr (SP2) {
            PG8_LDB(B0, 0, 0); PG8_LDB(B1, 0, 1); PG8_SCHED; PG8_LDA(At, 0, 0); PG8_STAGE(PG8_SA(1, 1), a1 + hstepA, voffA);
            PG8_WAIT_V(8); PG8_WAIT_L(0); PG8_BAR; PG8_MMA(0, 0, At, B0); PG8_MMA(0, 1, At, B1); PG8_BAR; PG8_SCHED;
            PG8_LDA(At, 0, 1); PG8_STAGE(PG8_SB(0, 0), b2, voffB); PG8_STAGE(PG8_SB(0, 1), b2 + hstepB, voffB); PG8_STAGE(PG8_SA(0, 0), a2, voffA);
            PG8_WAIT_V(8); PG8_WAIT_L(0); PG8_BAR; PG8_MMA(1, 0, At, B0); PG8_MMA(1, 1, At, B1); PG8_BAR; PG8_SCHED;
            PG8_LDB(B0, 1, 0); PG8_LDB(B1, 1, 1); PG8_SCHED; PG8_LDA(At, 1, 0); PG8_STAGE(PG8_SA(0, 1), a2 + hstepA, voffA);
            PG8_WAIT_V(8); PG8_WAIT_L(0); PG8_BAR; PG8_MMA(0, 0, At, B0); PG8_MMA(0, 1, At, B1); PG8_BAR; PG8_SCHED;
            PG8_LDA(At, 1, 1); PG8_STAGE(PG8_SB(1, 0), b3, voffB); PG8_STAGE(PG8_SB(1, 1), b3 + hstepB, voffB); PG8_STAGE(PG8_SA(1, 0), a3, voffA);
            PG8_WAIT_V(8); PG8_WAIT_L(0); PG8_BAR; PG8_MMA(1, 0, At, B0); PG8_MMA(1, 1, At, B1); PG8_BAR; PG8_SCHED;
            } else {
            PG8_LDB(B0, 0, 0); PG8_SCHED; PG8_LDA(At, 0, 0); PG8_STAGE(PG8_SA(1, 1), a1 + hstepA, voffA);
            PG8_WAIT_L(8); PG8_BAR; PG8_WAIT_L(0); PG8_MMA(0, 0, At, B0); PG8_BAR; PG8_SCHED;
            PG8_LDB(B1, 0, 1); PG8_STAGE(PG8_SB(0, 0), b2, voffB);
            PG8_BAR; PG8_WAIT_L(0); PG8_MMA(0, 1, At, B1); PG8_BAR;
            PG8_LDA(At, 0, 1); PG8_STAGE(PG8_SA(0, 0), a2, voffA);
            PG8_BAR; PG8_WAIT_L(0); PG8_MMA(1, 0, At, B0); PG8_BAR; PG8_SCHED;
            PG8_STAGE(PG8_SB(0, 1), b2 + hstepB, voffB);
            PG8_WAIT_V(6); PG8_BAR; PG8_MMA(1, 1, At, B1); PG8_BAR;
            PG8_LDB(B0, 1, 0); PG8_SCHED; PG8_LDA(At, 1, 0); PG8_STAGE(PG8_SA(0, 1), a2 + hstepA, voffA);
            PG8_WAIT_L(8); PG8_BAR; PG8_WAIT_L(0); PG8_MMA(0, 0, At, B0); PG8_BAR; PG8_SCHED;
            PG8_LDB(B1, 1, 1); PG8_STAGE(PG8_SB(1, 0), b3, voffB);
            PG8_BAR; PG8_WAIT_L(0); PG8_MMA(0, 1, At, B1); PG8_BAR;
            PG8_LDA(At, 1, 1); PG8_STAGE(PG8_SA(1, 0), a3, voffA);
            PG8_BAR; PG8_WAIT_L(0); PG8_MMA(1, 0, At, B0); PG8_BAR; PG8_SCHED;
            PG8_STAGE(PG8_SB(1, 1), b3 + hstepB, voffB);
            PG8_WAIT_V(6); PG8_BAR; PG8_MMA(1, 1, At, B1); PG8_BAR;
            }
        }
        if constexpr (ALIGN_EPI) { if (wr == 0) PG8_BAR; }
        if constexpr (!Epi::AFTER_DRAIN) { E(acc, cur, wr, wc, fr, fq); S.done(cur); }
        if (!has_next) break;
#pragma unroll
        for (int a = 0; a < 2; ++a)
#pragma unroll
            for (int b = 0; b < 2; ++b)
#pragma unroll
                for (int m = 0; m < 4; ++m)
#pragma unroll
                    for (int n = 0; n < 2; ++n) acc[a][b][m][n] = (f32x4){0.f, 0.f, 0.f, 0.f};
        cur = nxt; cA = nA; cB = nB; ++ui;
        if constexpr (ALIGN_EPI) { if (wr == 1) PG8_BAR; }
    }
    PG8_WAIT_V(0);
    if constexpr (!ALIGN_EPI) { if (wr == 0) PG8_BAR; }
    PG8_BAR;
    if constexpr (Epi::AFTER_DRAIN) { E.fused(acc, cur, wr, wc, fr, fq, lds, wid, lane); S.done(cur); }
#undef PG8_SA
#undef PG8_SB
#undef PG8_STAGE
#undef PG8_LDA
#undef PG8_LDB
#undef PG8_MMA
#undef PG8_WAIT_V
#undef PG8_WAIT_L
#undef PG8_BAR
#undef PG8_SCHED
}
}
#include <hip/hip_bf16.h>
#include <cmath>
#define GAS __attribute__((address_space(1)))
#define LAS __attribute__((address_space(3)))
typedef unsigned short bf16;
typedef unsigned v4u __attribute__((ext_vector_type(4)));
typedef float f32x4 __attribute__((ext_vector_type(4)));
typedef short bf16x8 __attribute__((ext_vector_type(8)));
typedef float f32x16 __attribute__((ext_vector_type(16)));

constexpr int NWAVES = 8, NTHR = 512;
constexpr int BATCH = 2, SEQ = 8192, D = 1024, M = BATCH * SEQ, DFF = 2816, DEPTH = 2;
constexpr int INW = 7176;
constexpr size_t MiB = 1u << 20;
constexpr size_t WS_SS = 0, CTL_ZERO_BYTES = 1 * MiB;
constexpr size_t WS_WFL = 1 * MiB;
constexpr size_t WS_WAT = 1 * MiB + 256 * 1024, WS_WXT = 1 * MiB + 512 * 1024;
constexpr size_t WS_SUMM = 2 * MiB;
constexpr size_t WS_LOGF = 3 * MiB, WS_CTIL = 3 * MiB + 512 * 1024;
constexpr size_t WS_KPART = 7 * MiB;
constexpr size_t WS_MEMN = 4 * MiB, WS_KX = 5 * MiB, WS_VT = 6 * MiB;
constexpr size_t WS_W1IN = 8 * MiB, WS_W1OUT = 19 * MiB, WS_WIN = 25 * MiB, WS_WG = 33 * MiB, WS_UA = 39 * MiB, WS_UB = 40 * MiB, WS_UC = 42 * MiB,
                 WS_WO = 43 * MiB, WS_WXQ = 45 * MiB, WS_WXKV = 47 * MiB, WS_WXO = 51 * MiB, WS_W2IN = 53 * MiB, WS_W2OUT = 64 * MiB;
constexpr size_t WS_XB = 70 * MiB;
constexpr size_t WS_Q = 102 * MiB, WS_GG = 118 * MiB, WS_XA = 150 * MiB, WS_XL = 166 * MiB, WS_K = 198 * MiB, WS_V = 214 * MiB;
constexpr size_t WS_H = 102 * MiB;
constexpr size_t WS_YC = 150 * MiB;
constexpr size_t WS_STASH = 166 * MiB, WS_MG = 198 * MiB, WS_QX = 150 * MiB, WS_PBUF = 198 * MiB;
constexpr size_t WS_YA = 230 * MiB, WS_SSP = 246 * MiB, WS_END = 255 * MiB;
constexpr int LDS_BYTES = 147456;

__device__ __forceinline__ unsigned f2bf(float f) { unsigned u = __builtin_bit_cast(unsigned, f); return (u + 0x7fffu + ((u >> 16) & 1u)) >> 16; }
__device__ __forceinline__ unsigned pk2(float lo, float hi) { return f2bf(lo) | (f2bf(hi) << 16); }
__device__ __forceinline__ float bf2f(unsigned short v) { return __uint_as_float((unsigned)v << 16); }
__device__ __forceinline__ float bperm(float v, int srclane) { return __int_as_float(__builtin_amdgcn_ds_bpermute(srclane << 2, __float_as_int(v))); }
__device__ __forceinline__ float wave_sum(float v, int lane) {
#pragma unroll
    for (int o = 1; o < 64; o <<= 1) v += bperm(v, lane ^ o);
    return v;
}
__device__ __forceinline__ float flog1p(float e) { return e < 0.01f ? e * (1.f - e * (0.5f - e * 0.33333334f)) : __logf(1.f + e); }
#define LDS_WAIT() asm volatile("s_waitcnt lgkmcnt(0)" ::: "memory")

__device__ __forceinline__ void tr_item(const float* W, int ldn, int col0, int k0, const float* g, bf16* WT, int ldk, int drow0, LAS float* scr, int lane) {
    const int n4 = (lane & 15) * 4, kr = lane >> 4;
#pragma unroll
    for (int i = 0; i < 16; ++i) { const int kk = 4 * i + kr; f32x4 v = *(const f32x4*)(W + (size_t)(k0 + kk) * ldn + col0 + n4); if (g) v = v * g[k0 + kk];
        LAS float* d = scr + kk * 65 + n4; d[0] = v.x; d[1] = v.y; d[2] = v.z; d[3] = v.w; }
    LDS_WAIT(); asm volatile("" ::: "memory");
    const int c = lane & 7;
#pragma unroll
    for (int j = 0; j < 8; ++j) { const int n = (lane >> 3) + 8 * j; const LAS float* s = scr + (8 * c) * 65 + n;
        v4u o; o.x = pk2(s[0 * 65], s[1 * 65]); o.y = pk2(s[2 * 65], s[3 * 65]); o.z = pk2(s[4 * 65], s[5 * 65]); o.w = pk2(s[6 * 65], s[7 * 65]);
        *(v4u*)(WT + (size_t)(drow0 + n) * ldk + k0 + 8 * c) = o; }
    LDS_WAIT(); asm volatile("" ::: "memory");
}

#define RLX_AGENT __ATOMIC_RELAXED, __HIP_MEMORY_SCOPE_AGENT
#define XB_TMO      128
#define XB_XCNT(j)  (256  + 64 * (j))
#define XB_XSUB(j)  (1280 + 64 * (j))
#define XB_XGEN(j)  (2304 + 64 * (j))
#define XB_TOP      3328
#define XB_TOPGEN   3392
#define XCD_BAR_WORDS 3456
#define XB_SPIN_CAP (1u << 18)

__device__ __forceinline__ unsigned xb_ld(unsigned* p)              { return __hip_atomic_load(p, __ATOMIC_RELAXED, __HIP_MEMORY_SCOPE_AGENT); }
__device__ __forceinline__ unsigned xb_add(unsigned* p, unsigned v) { return __hip_atomic_fetch_add(p, v, __ATOMIC_RELAXED, __HIP_MEMORY_SCOPE_AGENT); }
__device__ __forceinline__ unsigned xb_xcc_id() { return (unsigned)__builtin_amdgcn_s_getreg((3 << 11) | 20) & 0xFu; }
#define XB_SPIN(cond, bar) do { unsigned _sp = 0; while (cond) { __builtin_amdgcn_s_sleep(1); \
    if ((++_sp & 255u) == 0u) { if (xb_ld(&(bar)[XB_TMO])) break; if (_sp > XB_SPIN_CAP) { atomicAdd(&(bar)[XB_TMO], 1u); break; } } } } while (0)

struct XcdBarrier {
    unsigned* bar; unsigned x;
    volatile LAS unsigned* st;
};

__device__ __forceinline__ XcdBarrier xcd_barrier_post(unsigned* bar, volatile LAS unsigned* st) {
    XcdBarrier b; b.bar = bar; b.x = xb_xcc_id(); b.st = st;
    if (threadIdx.x == 0) (void)xb_add(&bar[XB_XCNT(b.x)], 1u);
    return b;
}
__device__ __forceinline__ void xcd_barrier_complete(unsigned* bar, unsigned x, unsigned& nloc, unsigned& nx) {
    const unsigned G = gridDim.x * gridDim.y * gridDim.z;
    unsigned sum, cnt, mine, sp = 0u;
    for (;;) {
        sum = 0u; cnt = 0u; mine = 0u;
#pragma unroll
        for (unsigned j = 0; j < 16; ++j) { const unsigned c = xb_ld(&bar[XB_XCNT(j)]); sum += c; cnt += (c > 0u) ? 1u : 0u; mine = (j == x) ? c : mine; }
        if (sum == G) break;
        __builtin_amdgcn_s_sleep(1);
        if ((++sp & 255u) == 0u) { if (xb_ld(&bar[XB_TMO])) break; if (sp > XB_SPIN_CAP) { atomicAdd(&bar[XB_TMO], 1u); break; } }
    }
    nloc = mine > 0u ? mine : 1u; nx = cnt > 0u ? cnt : 1u;
}

__device__ __forceinline__ void xcd_barrier(const XcdBarrier& b) {
    asm volatile("s_waitcnt vmcnt(0)" ::: "memory");
    __syncthreads();
    if (threadIdx.x == 0) {
        unsigned* bar = b.bar;
        __builtin_amdgcn_s_waitcnt(0);
        unsigned nloc = b.st[0], nx = b.st[1];
        if (nloc == 0u) { xcd_barrier_complete(bar, b.x, nloc, nx); b.st[0] = nloc; b.st[1] = nx; }
        const unsigned old = xb_add(&bar[XB_XSUB(b.x)], 1u);
        const unsigned gen = old / nloc;
        if (old + 1u == (gen + 1u) * nloc) {
            __builtin_amdgcn_fence(__ATOMIC_RELEASE, "agent");
            asm volatile("s_waitcnt vmcnt(0)" ::: "memory");
            const unsigned og = xb_add(&bar[XB_TOP], 1u);
            const unsigned tg = og / nx;
            if (og + 1u == (tg + 1u) * nx) xb_add(&bar[XB_TOPGEN], 1u);
            else XB_SPIN(xb_ld(&bar[XB_TOPGEN]) == tg, bar);
            __builtin_amdgcn_fence(__ATOMIC_ACQUIRE, "agent");
            xb_add(&bar[XB_XGEN(b.x)], 1u);
            asm volatile("s_waitcnt vmcnt(0)" ::: "memory");
        } else {
            XB_SPIN(xb_ld(&bar[XB_XGEN(b.x)]) == gen, bar);
            __builtin_amdgcn_fence(__ATOMIC_ACQUIRE, "agent");
            asm volatile("s_waitcnt vmcnt(0)" ::: "memory");
        }
    }
    __syncthreads();
}

struct Args { const float* in[31]; float* out; unsigned char* ws; int pad[2]; };
typedef LAS unsigned long long* PtrTab;
__device__ __forceinline__ const float* tab_in(PtrTab tb, int k) { const unsigned long long v = tb[k]; const unsigned lo = __builtin_amdgcn_readfirstlane((unsigned)v), hi = __builtin_amdgcn_readfirstlane((unsigned)(v >> 32));
    return (const float*)(const GAS float*)(((unsigned long long)hi << 32) | lo); }
constexpr int TAB_OFF = 147456 - 512;
constexpr size_t WS_BAR = 768 * 1024;

__device__ __forceinline__ void phase_prologue(PtrTab TB, unsigned char* ws, float* xout, int l, LAS unsigned char* lds, int gw, int NGW, int lane, int wave) {
    LAS float* scr = (LAS float*)(lds + wave * 16640);
#define g1 (tab_in(TB, 2) + l * D)
#define w1i (tab_in(TB, 3) + (size_t)l * D * 2 * DFF)
#define w1o (tab_in(TB, 4) + (size_t)l * DFF * D)
#define gm (tab_in(TB, 5) + l * D)
#define win (tab_in(TB, 6) + (size_t)l * D * INW)
#define wpool (tab_in(TB, 9) + (size_t)l * 4 * 128 * 128)
#define psc (tab_in(TB, 10) + l * 512)
#define wua (tab_in(TB, 11) + (size_t)l * 512 * D)
#define wra (tab_in(TB, 14) + (size_t)l * 8 * 128 * 128)
#define wrx (tab_in(TB, 16) + (size_t)l * 8 * 128 * 128)
#define wub (tab_in(TB, 19) + (size_t)l * D * D)
#define wuc (tab_in(TB, 20) + (size_t)l * 512 * D)
#define wo (tab_in(TB, 21) + (size_t)l * D * D)
#define gc (tab_in(TB, 22) + l * D)
#define gmem (tab_in(TB, 23) + l * D)
#define wxq (tab_in(TB, 24) + (size_t)l * D * D)
#define wxkv (tab_in(TB, 25) + (size_t)l * D * 2 * D)
#define wxo (tab_in(TB, 26) + (size_t)l * D * D)
#define g2 (tab_in(TB, 27) + l * D)
#define w2i (tab_in(TB, 28) + (size_t)l * D * 2 * DFF)
#define w2o (tab_in(TB, 29) + (size_t)l * DFF * D)
    constexpr int I_FI = 16 * 88, I_FO = 44 * 16, I_WIN = 16 * 64, I_WG = 16 * 48, I_UB = 16 * 16, I_UC = 8 * 16, I_RG = 32, I_SQ = 16 * 16, I_KV = 16 * 32;
    constexpr int S0 = 0, S1 = S0 + I_FI, S2 = S1 + I_FO, S3 = S2 + I_WIN, S4 = S3 + I_WG, S5 = S4 + I_UB, S6 = S5 + I_UC, S7 = S6 + I_RG, S8 = S7 + I_RG, S9 = S8 + I_SQ, S10 = S9 + I_SQ,
                  S11 = S10 + I_KV, S12 = S11 + I_SQ, S13 = S12 + I_FI, S14 = S13 + I_FO;
    for (int it = gw; it < S14; it += NGW) {
        if (it < S1 || (it >= S12 && it < S13)) {
            const bool second = it >= S12; const int r = second ? it - S12 : it; const int kb = r / 88, nb = r % 88; const int n = nb * 64;
            const int half = n >= DFF ? 1 : 0, nn = n - half * DFF; const int drow = (nn >> 7) * 256 + half * 128 + (nn & 127);
            tr_item(second ? w2i : w1i, 2 * DFF, n, kb * 64, second ? g2 : g1, (bf16*)(ws + (second ? WS_W2IN : WS_W1IN)), D, drow, scr, lane);
        } else if (it < S2 || it >= S13) {
            const bool second = it >= S13; const int r = second ? it - S13 : it - S1; const int kb = r / 16, nb = r % 16;
            tr_item(second ? w2o : w1o, D, nb * 64, kb * 64, nullptr, (bf16*)(ws + (second ? WS_W2OUT : WS_W1OUT)), DFF, nb * 64, scr, lane);
        } else if (it < S3) { const int r = it - S2, kb = r / 64, nb = r % 64; tr_item(win, INW, nb * 64, kb * 64, gm, (bf16*)(ws + WS_WIN), D, nb * 64, scr, lane);
        } else if (it < S4) { const int r = it - S3, kb = r / 48, nb = r % 48; tr_item(win, INW, 4104 + nb * 64, kb * 64, gm, (bf16*)(ws + WS_WG), D, nb * 64, scr, lane);
        } else if (it < S5) { const int r = it - S4, kb = r / 16, nb = r % 16; tr_item(wub, D, nb * 64, kb * 64, nullptr, (bf16*)(ws + WS_UB), D, nb * 64, scr, lane);
        } else if (it < S6) { const int r = it - S5, kb = r / 16, nb = r % 16; tr_item(wuc, D, nb * 64, kb * 64, nullptr, (bf16*)(ws + WS_UC), 512, nb * 64, scr, lane);
        } else if (it < S8) { const bool xg = it >= S7; const int r = xg ? it - S7 : it - S6; const int hh = r >> 2, kb = (r >> 1) & 1, nb = r & 1;
            tr_item((xg ? wrx : wra) + hh * 16384, 128, nb * 64, kb * 64, nullptr, (bf16*)(ws + (xg ? WS_WXT : WS_WAT)) + hh * 16384, 128, nb * 64, scr, lane);
        } else if (it < S9) { const int r = it - S8, kb = r / 16, nb = r % 16; tr_item(wo, D, nb * 64, kb * 64, nullptr, (bf16*)(ws + WS_WO), D, nb * 64, scr, lane);
        } else if (it < S10) { const int r = it - S9, kb = r / 16, nb = r % 16; tr_item(wxq, D, nb * 64, kb * 64, gc, (bf16*)(ws + WS_WXQ), D, nb * 64, scr, lane);
        } else if (it < S11) { const int r = it - S10, kb = r / 32, nb = r % 32; tr_item(wxkv, 2 * D, nb * 64, kb * 64, nullptr, (bf16*)(ws + WS_WXKV), D, nb * 64, scr, lane);
        } else { const int r = it - S11, kb = r / 16, nb = r % 16; tr_item(wxo, D, nb * 64, kb * 64, nullptr, (bf16*)(ws + WS_WXO), D, nb * 64, scr, lane); }
    }
    { bf16* UaT = (bf16*)(ws + WS_UA);
      for (int it = gw; it < 4 * 16 * 16; it += NGW) { const int g = it >> 8, nblk = (it >> 4) & 15, c0 = (it & 15) * 8, n = nblk * 64 + lane;
          const float* wp = wpool + ((size_t)g * 128 + c0) * 128; const float* sc = psc + g * 128; const float* ua = wua + (size_t)(g * 128) * D + n; float acc[8];
#pragma unroll
          for (int c = 0; c < 8; ++c) acc[c] = 0.f;
#pragma unroll 16
          for (int j = 0; j < 128; ++j) { const float u = ua[(size_t)j * D] * sc[j];
#pragma unroll
              for (int c = 0; c < 8; ++c) acc[c] += wp[c * 128 + j] * u; }
          v4u o; o.x = pk2(acc[0], acc[1]); o.y = pk2(acc[2], acc[3]); o.z = pk2(acc[4], acc[5]); o.w = pk2(acc[6], acc[7]);
          *(v4u*)(UaT + (size_t)n * 512 + g * 128 + c0) = o; } }
    { float* wfl = (float*)(ws + WS_WFL);
      for (int it = gw * 64 + lane; it < 8 * 1024; it += NGW * 64) { const int h = it >> 10, k = it & 1023; wfl[it] = gm[k] * win[(size_t)k * INW + 4096 + h]; } }
    { const float* mem = tab_in(TB, 1); bf16* mn = (bf16*)(ws + WS_MEMN);
      for (int r = gw; r < 512; r += NGW) { const f32x4* xr = (const f32x4*)(mem + (size_t)r * D) + lane; f32x4 v[4]; float s = 0.f;
#pragma unroll
          for (int j = 0; j < 4; ++j) { v[j] = xr[64 * j]; s += (v[j].x * v[j].x + v[j].y * v[j].y) + (v[j].z * v[j].z + v[j].w * v[j].w); }
          const float rs = rsqrtf(wave_sum(s, lane) * (1.f / D) + 1e-6f); unsigned long long* o8 = (unsigned long long*)(mn + (size_t)r * D) + lane;
#pragma unroll
          for (int j = 0; j < 4; ++j) { const f32x4 gv = *((const f32x4*)gmem + lane + 64 * j);
              o8[64 * j] = (unsigned long long)pk2(v[j].x * rs * gv.x, v[j].y * rs * gv.y) | ((unsigned long long)pk2(v[j].z * rs * gv.z, v[j].w * rs * gv.w) << 32); } } }
    if (l == 0) {
        const float* x = tab_in(TB, 0); float* xo = xout; bf16* xb = (bf16*)(ws + WS_XB); float* ss = (float*)(ws + WS_SSP);
        for (int r = gw; r < M; r += NGW) { const f32x4* xr = (const f32x4*)(x + (size_t)r * D) + lane; f32x4* orow = (f32x4*)(xo + (size_t)r * D) + lane; f32x4 v[4]; float s = 0.f;
#pragma unroll
            for (int j = 0; j < 4; ++j) { v[j] = xr[64 * j]; orow[64 * j] = v[j]; s += (v[j].x * v[j].x + v[j].y * v[j].y) + (v[j].z * v[j].z + v[j].w * v[j].w); }
            s = wave_sum(s, lane); if (lane < 4) ss[(size_t)r * 4 + lane] = lane == 0 ? s : 0.f; unsigned long long* o8 = (unsigned long long*)(xb + (size_t)r * D) + lane;
#pragma unroll
            for (int j = 0; j < 4; ++j) o8[64 * j] = (unsigned long long)pk2(v[j].x, v[j].y) | ((unsigned long long)pk2(v[j].z, v[j].w) << 32); }
    }
}
#undef g1
#undef w1i
#undef w1o
#undef gm
#undef win
#undef wpool
#undef psc
#undef wua
#undef wra
#undef wrx
#undef wub
#undef wuc
#undef wo
#undef gc
#undef gmem
#undef wxq
#undef wxkv
#undef wxo
#undef g2
#undef w2i
#undef w2o
__device__ __forceinline__ void phase_fl(const bf16* xb, const float* wfl, const float* bfv, const float* ss, float* logf, int gw, int NGW, int lane) {
    for (int r = gw; r < M; r += NGW) {
        float acc[8];
#pragma unroll
        for (int h = 0; h < 8; ++h) acc[h] = 0.f;
#pragma unroll
        for (int j = 0; j < 2; ++j) { const int k0 = 8 * lane + 512 * j; const v4u xv = *(const v4u*)(xb + (size_t)r * D + k0);
            float xf[8]; xf[0] = __uint_as_float(xv.x << 16); xf[1] = __uint_as_float(xv.x & 0xffff0000u); xf[2] = __uint_as_float(xv.y << 16); xf[3] = __uint_as_float(xv.y & 0xffff0000u);
            xf[4] = __uint_as_float(xv.z << 16); xf[5] = __uint_as_float(xv.z & 0xffff0000u); xf[6] = __uint_as_float(xv.w << 16); xf[7] = __uint_as_float(xv.w & 0xffff0000u);
#pragma unroll
            for (int h = 0; h < 8; ++h) { const f32x4 w0 = *(const f32x4*)(wfl + h * 1024 + k0), w1 = *(const f32x4*)(wfl + h * 1024 + k0 + 4);
                acc[h] += (xf[0] * w0.x + xf[1] * w0.y) + (xf[2] * w0.z + xf[3] * w0.w) + (xf[4] * w1.x + xf[5] * w1.y) + (xf[6] * w1.z + xf[7] * w1.w); } }
        const float rs = pg8::rstd_of(ss, r);
#pragma unroll
        for (int h = 0; h < 8; ++h) { const float z = wave_sum(acc[h], lane) * rs + bfv[h]; const float ls = -(fmaxf(-z, 0.f) + flog1p(__expf(-fabsf(z)))); if (lane == h) logf[(size_t)r * 8 + h] = ls; }
    }
}
__device__ __forceinline__ void cumsum_bh(const float* logf, float* ctil, int bh, LAS float* red) {
    int tid_o = threadIdx.x; asm volatile("" : "+v"(tid_o)); const int tid = tid_o, lane = tid & 63, wid = tid >> 6;
    const int b = bh >> 3, h = bh & 7; const float* src = logf + ((size_t)b * SEQ + 16 * tid) * 8 + h; float v[16]; float s = 0.f;
#pragma unroll
    for (int i = 0; i < 16; ++i) { v[i] = src[(size_t)i * 8]; s += v[i]; }
    float incl = s;
#pragma unroll
    for (int o = 1; o < 64; o <<= 1) { const float t = bperm(incl, lane - o); if (lane >= o) incl += t; }
    if (lane == 63) red[wid] = incl;
    __syncthreads();
    float base = 0.f;
#pragma unroll
    for (int w = 0; w < 8; ++w) if (w < wid) base += red[w];
    float run = base + incl - s; float* dst = ctil + (size_t)bh * SEQ + 16 * tid;
#pragma unroll
    for (int i = 0; i < 16; ++i) { run += v[i]; dst[i] = run * 1.4426950408889634f; }
    __syncthreads();
}
__device__ __forceinline__ void unpk8(const v4u xv, float (&xf)[8]) { xf[0] = __uint_as_float(xv.x << 16); xf[1] = __uint_as_float(xv.x & 0xffff0000u); xf[2] = __uint_as_float(xv.y << 16); xf[3] = __uint_as_float(xv.y & 0xffff0000u);
    xf[4] = __uint_as_float(xv.z << 16); xf[5] = __uint_as_float(xv.z & 0xffff0000u); xf[6] = __uint_as_float(xv.w << 16); xf[7] = __uint_as_float(xv.w & 0xffff0000u); }
template <int W> __device__ __forceinline__ void pool_item(const bf16* xa, bf16* ya, int m0, int cgi) {
    const int t0 = m0 & (SEQ - 1); v4u rw[W + 7];
#pragma unroll
    for (int a = 0; a < W + 7; ++a) { const int tl = a - (W - 1); rw[a] = (t0 + tl >= 0) ? *(const v4u*)(xa + (size_t)(m0 + tl) * 512 + 8 * cgi) : (v4u){0u, 0u, 0u, 0u}; }
    float s[8];
#pragma unroll
    for (int i = 0; i < 8; ++i) s[i] = 0.f;
#pragma unroll
    for (int a = 0; a < W - 1; ++a) { float xf[8]; unpk8(rw[a], xf);
#pragma unroll
        for (int i = 0; i < 8; ++i) s[i] += xf[i]; }
#pragma unroll
    for (int o = 0; o < 8; ++o) { float cur[8]; unpk8(rw[o + W - 1], cur);
#pragma unroll
        for (int i = 0; i < 8; ++i) s[i] += cur[i];
        const int t = t0 + o, cnt = (t + 1 < W) ? t + 1 : W; const float ic = 1.f / (float)cnt; v4u ov;
        ov.x = pk2(s[0] * ic - cur[0], s[1] * ic - cur[1]); ov.y = pk2(s[2] * ic - cur[2], s[3] * ic - cur[3]); ov.z = pk2(s[4] * ic - cur[4], s[5] * ic - cur[5]); ov.w = pk2(s[6] * ic - cur[6], s[7] * ic - cur[7]);
        *(v4u*)(ya + (size_t)(m0 + o) * 512 + 8 * cgi) = ov;
        float old[8]; unpk8(rw[o], old);
#pragma unroll
        for (int i = 0; i < 8; ++i) s[i] -= old[i]; }
}
__device__ __forceinline__ void phase_pool(const bf16* xa, bf16* ya, int gtid, int nthr) {
    for (int idx = gtid; idx < (M / 8) * 64; idx += nthr) { const int c16 = idx & 15, rl = (idx >> 4) & 3, g = (idx >> 6) & 3, rh = idx >> 8; const int m0 = (rh * 4 + rl) * 8, cgi = g * 16 + c16;
        if (g == 0) pool_item<2>(xa, ya, m0, cgi); else if (g == 1) pool_item<4>(xa, ya, m0, cgi); else if (g == 2) pool_item<8>(xa, ya, m0, cgi); else pool_item<16>(xa, ya, m0, cgi); }
}
__device__ __forceinline__ int crow16(int r, int hi) { return (r & 3) + 8 * (r >> 2) + 4 * hi; }
template <bool FINAL>
__device__ __forceinline__ void lru_item(LAS unsigned char* lds, int b, int hp, int ck, const bf16* xl, bf16* gg, const float* cw, const float* cb, const bf16* WaT, const bf16* WxT,
                                         const float* ba, const float* bx, const float* lam, float* summ) {
    int tid_o = threadIdx.x; asm volatile("" : "+v"(tid_o)); const int tid = tid_o, lane = tid & 63, wid = tid >> 6, r32 = lane & 31, hi = lane >> 5;
    const int t0 = ck * 128; const size_t m0 = (size_t)b * SEQ + t0; const int ch0 = hp * 256;
    constexpr int XP = 264;
    LAS bf16* xc = (LAS bf16*)lds; LAS float* h0s = (LAS float*)(lds + 128 * XP * 2);
    {
        const int cgi = tid & 31, tq = tid >> 5, c = ch0 + 8 * cgi;
        float w[4][8], bb[8];
#pragma unroll
        for (int k = 0; k < 4; ++k) { const f32x4 a = *(const f32x4*)(cw + k * 1024 + c), d = *(const f32x4*)(cw + k * 1024 + c + 4); w[k][0] = a.x; w[k][1] = a.y; w[k][2] = a.z; w[k][3] = a.w; w[k][4] = d.x; w[k][5] = d.y; w[k][6] = d.z; w[k][7] = d.w; }
        { const f32x4 a = *(const f32x4*)(cb + c), d = *(const f32x4*)(cb + c + 4); bb[0] = a.x; bb[1] = a.y; bb[2] = a.z; bb[3] = a.w; bb[4] = d.x; bb[5] = d.y; bb[6] = d.z; bb[7] = d.w; }
        v4u rw[11];
#pragma unroll
        for (int i = 0; i < 11; ++i) { const int tl = tq * 8 - 3 + i; rw[i] = (t0 + tl >= 0) ? *(const v4u*)(xl + (size_t)((long)m0 + tl) * 1024 + c) : (v4u){0u, 0u, 0u, 0u}; }
#pragma unroll
        for (int o = 0; o < 8; ++o) { float y[8];
#pragma unroll
            for (int j = 0; j < 8; ++j) y[j] = bb[j];
#pragma unroll
            for (int k = 0; k < 4; ++k) { const v4u xv = rw[o + k];
                y[0] += w[k][0] * __uint_as_float(xv.x << 16); y[1] += w[k][1] * __uint_as_float(xv.x & 0xffff0000u); y[2] += w[k][2] * __uint_as_float(xv.y << 16); y[3] += w[k][3] * __uint_as_float(xv.y & 0xffff0000u);
                y[4] += w[k][4] * __uint_as_float(xv.z << 16); y[5] += w[k][5] * __uint_as_float(xv.z & 0xffff0000u); y[6] += w[k][6] * __uint_as_float(xv.w << 16); y[7] += w[k][7] * __uint_as_float(xv.w & 0xffff0000u); }
            v4u ov; ov.x = pk2(y[0], y[1]); ov.y = pk2(y[2], y[3]); ov.z = pk2(y[4], y[5]); ov.w = pk2(y[6], y[7]);
            *(LAS v4u*)(xc + (tq * 8 + o) * XP + 8 * cgi) = ov; }
    }
    if (FINAL && tid < 256) {
        const float* sp = summ + ((size_t)b * 64 * 1024 + ch0 + tid) * 2; float h = 0.f;
#pragma unroll 8
        for (int c2 = 0; c2 < ck; ++c2) { const float2 v = *(const float2*)(sp + (size_t)c2 * 2048); h = v.x * h + v.y; }
        h0s[tid] = h;
    }
    __syncthreads();
    const int hh = wid >> 2, s = wid & 3, chl = 128 * hh + 32 * s + r32, ch = ch0 + chl, head = 2 * hp + hh;
    const float bav = ba[ch], bxv = bx[ch]; const float nl = -lam[ch]; const float sp8 = 8.f * (fmaxf(nl, 0.f) + flog1p(__expf(-fabsf(nl))));
    bf16x8 fa[8], fx[8];
#pragma unroll
    for (int ks = 0; ks < 8; ++ks) { fa[ks] = *(const bf16x8*)(WaT + (size_t)head * 16384 + (32 * s + r32) * 128 + 16 * ks + 8 * hi); fx[ks] = *(const bf16x8*)(WxT + (size_t)head * 16384 + (32 * s + r32) * 128 + 16 * ks + 8 * hi); }
    float hrun = FINAL ? h0s[chl] : 0.f, Arun = 1.f;
    for (int mb = 0; mb < 4; ++mb) {
        f32x16 accA = {0.f, 0.f, 0.f, 0.f, 0.f, 0.f, 0.f, 0.f, 0.f, 0.f, 0.f, 0.f, 0.f, 0.f, 0.f, 0.f}, accX = accA;
#pragma unroll
        for (int ks = 0; ks < 8; ++ks) { const bf16x8 af = *(const LAS bf16x8*)(xc + (32 * mb + r32) * XP + 128 * hh + 16 * ks + 8 * hi);
            accA = __builtin_amdgcn_mfma_f32_32x32x16_bf16(af, fa[ks], accA, 0, 0, 0); accX = __builtin_amdgcn_mfma_f32_32x32x16_bf16(af, fx[ks], accX, 0, 0, 0); }
        float a[16], u[16];
#pragma unroll
        for (int r = 0; r < 16; ++r) { const int tok = 32 * mb + crow16(r, hi); const float xcv = bf2f(xc[tok * XP + chl]);
            const float rg = pg8::fsig(accA[r] + bav), la = -rg * sp8, av = __expf(la), mult = sqrtf(fmaxf(1.f - av * av, 0.f)), ig = pg8::fsig(accX[r] + bxv);
            a[r] = av; u[r] = mult * ig * xcv; }
        float As[4], Hs[4], Ap[4], Hp[4], hin[4];
#pragma unroll
        for (int g = 0; g < 4; ++g) { float Aq = 1.f, Hq = 0.f;
#pragma unroll
            for (int i = 0; i < 4; ++i) { Hq = a[4 * g + i] * Hq + u[4 * g + i]; Aq *= a[4 * g + i]; }
            As[g] = Aq; Hs[g] = Hq; Ap[g] = bperm(Aq, lane ^ 32); Hp[g] = bperm(Hq, lane ^ 32); }
#pragma unroll
        for (int g = 0; g < 4; ++g) { const float A0 = hi ? Ap[g] : As[g], H0 = hi ? Hp[g] : Hs[g], A1 = hi ? As[g] : Ap[g], H1 = hi ? Hs[g] : Hp[g];
            const float hA = hrun, hB = A0 * hA + H0; hrun = A1 * hB + H1; Arun *= A0 * A1; hin[g] = hi ? hB : hA; }
        if (FINAL) {
#pragma unroll
            for (int g = 0; g < 4; ++g) { float hc = hin[g];
#pragma unroll
                for (int i = 0; i < 4; ++i) { const int r = 4 * g + i; hc = a[r] * hc + u[r]; bf16* p = gg + (m0 + 32 * mb + crow16(r, hi)) * 1024 + ch; *p = (bf16)f2bf(hc * bf2f(*p)); } }
        }
    }
    if (!FINAL && hi == 0) { float* sp = summ + (((size_t)b * 64 + ck) * 1024 + ch) * 2; sp[0] = Arun; sp[1] = hrun; }
    __syncthreads();
}
__device__ __forceinline__ void phase_final(float* x, const float* g, int gw, int NGW, int lane) {
    for (int r = gw; r < M; r += NGW) { f32x4* xr = (f32x4*)(x + (size_t)r * D) + lane; f32x4 v[4]; float s = 0.f;
#pragma unroll
        for (int j = 0; j < 4; ++j) { v[j] = xr[64 * j]; s += (v[j].x * v[j].x + v[j].y * v[j].y) + (v[j].z * v[j].z + v[j].w * v[j].w); }
        const float rs = rsqrtf(wave_sum(s, lane) * (1.f / D) + 1e-6f);
#pragma unroll
        for (int j = 0; j < 4; ++j) { const f32x4 gv = *((const f32x4*)g + lane + 64 * j); xr[64 * j] = (f32x4){v[j].x * rs * gv.x, v[j].y * rs * gv.y, v[j].z * rs * gv.z, v[j].w * rs * gv.w}; } }
}
__device__ __forceinline__ void phase_kmax(const bf16* K, float* kpart, int gw, int NGW, int lane) {
    float m0 = 0.f, m1 = 0.f;
#pragma unroll 8
    for (int r = gw; r < M; r += NGW) { const v4u w = *(const v4u*)(K + (size_t)r * 512 + 8 * lane);
        const float a0 = __uint_as_float(w.x << 16), a1 = __uint_as_float(w.x & 0xffff0000u), a2 = __uint_as_float(w.y << 16), a3 = __uint_as_float(w.y & 0xffff0000u);
        const float a4 = __uint_as_float(w.z << 16), a5 = __uint_as_float(w.z & 0xffff0000u), a6 = __uint_as_float(w.w << 16), a7 = __uint_as_float(w.w & 0xffff0000u);
        float s = (a0 * a0 + a1 * a1) + (a2 * a2 + a3 * a3) + (a4 * a4 + a5 * a5) + (a6 * a6 + a7 * a7);
        s += bperm(s, lane ^ 1); s += bperm(s, lane ^ 2); s += bperm(s, lane ^ 4);
        if (r < SEQ) m0 = fmaxf(m0, s); else m1 = fmaxf(m1, s); }
    if ((lane & 7) == 0) { kpart[((size_t)gw * 2 + 0) * 8 + (lane >> 3)] = m0; kpart[((size_t)gw * 2 + 1) * 8 + (lane >> 3)] = m1; }
}
constexpr float FOX_C2 = 0.125f * 1.4426950408889634f;
constexpr float FOX_SKIP = 64.f;
constexpr int FOX_KP = 72;
constexpr int FOX_BUF = 2 * 64 * FOX_KP * 2 + 256;
__device__ __forceinline__ void fox_unit(LAS unsigned char* lds, int b, int h, int qb, const bf16* Q, const bf16* K, const bf16* V, bf16* O, const float* ct, const float* kpart, int nparts) {
    int tid_o = threadIdx.x; asm volatile("" : "+v"(tid_o)); const int tid = tid_o, lane = tid & 63, wid = tid >> 6, r32 = lane & 31, hi = lane >> 5;
    const size_t rowbase = (size_t)b * SEQ; const int q0 = qb * 256, NT = 4 * qb + 4;
    const bf16* Qw = Q + (rowbase + q0 + wid * 32 + r32) * 512 + h * 64;
    bf16x8 qr[4];
#pragma unroll
    for (int d0 = 0; d0 < 4; ++d0) qr[d0] = *(const bf16x8*)(Qw + 16 * d0 + 8 * hi);
    LAS float* red = (LAS float*)(lds + 2 * FOX_BUF); LAS int* tsl = (LAS int*)(lds + 2 * FOX_BUF + 128);
    { float qn = 0.f;
#pragma unroll
      for (int d0 = 0; d0 < 4; ++d0) { const v4u w = __builtin_bit_cast(v4u, qr[d0]);
          const float a0 = __uint_as_float(w.x << 16), a1 = __uint_as_float(w.x & 0xffff0000u), a2 = __uint_as_float(w.y << 16), a3 = __uint_as_float(w.y & 0xffff0000u);
          const float a4 = __uint_as_float(w.z << 16), a5 = __uint_as_float(w.z & 0xffff0000u), a6 = __uint_as_float(w.w << 16), a7 = __uint_as_float(w.w & 0xffff0000u);
          qn += (a0 * a0 + a1 * a1) + (a2 * a2 + a3 * a3) + (a4 * a4 + a5 * a5) + (a6 * a6 + a7 * a7); }
      qn += bperm(qn, lane ^ 32);
#pragma unroll
      for (int o = 1; o < 32; o <<= 1) qn = fmaxf(qn, bperm(qn, lane ^ o));
      __syncthreads();
      float km = 0.f;
      for (int i = tid; i < nparts; i += NTHR) km = fmaxf(km, kpart[((size_t)i * 2 + b) * 8 + h]);
#pragma unroll
      for (int o = 1; o < 64; o <<= 1) km = fmaxf(km, bperm(km, lane ^ o));
      if (lane == 0) { red[wid] = qn; red[8 + wid] = km; } if (tid == 0) tsl[0] = 4 * qb;
      __syncthreads();
      float q2 = red[0], k2 = red[8];
#pragma unroll
      for (int w = 1; w < 8; ++w) { q2 = fmaxf(q2, red[w]); k2 = fmaxf(k2, red[8 + w]); }
      const float thr = 2.f * sqrtf(q2) * sqrtf(k2) * 1.0001f + FOX_SKIP;
      const float c0 = ct[q0];
      if (tid < 4 * qb && ct[64 * tid + 63] - c0 <= thr) atomicMin((int*)tsl, tid);
      __syncthreads(); }
    const int T0 = tsl[0];
    const int skey = tid >> 3, sd = (tid & 7) * 8;
    const bf16* kp = K + (rowbase + skey) * 512 + h * 64 + sd; const bf16* vp = V + (rowbase + skey) * 512 + h * 64 + sd;
    v4u kreg = *(const v4u*)(kp + (size_t)T0 * 64 * 512), vreg = *(const v4u*)(vp + (size_t)T0 * 64 * 512); float creg = (tid < 64) ? ct[64 * T0 + tid] : 0.f;
    __syncthreads();
    { LAS unsigned char* buf0 = lds + (T0 & 1) * FOX_BUF; LAS bf16* Ks = (LAS bf16*)buf0; LAS bf16* Vt = Ks + 64 * FOX_KP; LAS float* Cs = (LAS float*)(buf0 + 2 * 64 * FOX_KP * 2);
      *(LAS v4u*)(Ks + skey * FOX_KP + sd) = kreg;
      Vt[(sd + 0) * FOX_KP + skey] = (bf16)(vreg.x & 0xffffu); Vt[(sd + 1) * FOX_KP + skey] = (bf16)(vreg.x >> 16); Vt[(sd + 2) * FOX_KP + skey] = (bf16)(vreg.y & 0xffffu); Vt[(sd + 3) * FOX_KP + skey] = (bf16)(vreg.y >> 16);
      Vt[(sd + 4) * FOX_KP + skey] = (bf16)(vreg.z & 0xffffu); Vt[(sd + 5) * FOX_KP + skey] = (bf16)(vreg.z >> 16); Vt[(sd + 6) * FOX_KP + skey] = (bf16)(vreg.w & 0xffffu); Vt[(sd + 7) * FOX_KP + skey] = (bf16)(vreg.w >> 16);
      if (tid < 64) Cs[tid] = creg; }
    if (T0 + 1 < NT) { kreg = *(const v4u*)(kp + (size_t)(T0 + 1) * 64 * 512); vreg = *(const v4u*)(vp + (size_t)(T0 + 1) * 64 * 512); if (tid < 64) creg = ct[64 * (T0 + 1) + tid]; }
    float m = -1e30f, l = 0.f; f32x16 o0, o1;
#pragma unroll
    for (int r = 0; r < 16; ++r) { o0[r] = 0.f; o1[r] = 0.f; }
    for (int t = T0; t < NT; ++t) {
        __syncthreads();
        if (t + 1 < NT) { LAS unsigned char* bufn = lds + ((t + 1) & 1) * FOX_BUF; LAS bf16* Ks = (LAS bf16*)bufn; LAS bf16* Vt = Ks + 64 * FOX_KP; LAS float* Cs = (LAS float*)(bufn + 2 * 64 * FOX_KP * 2);
            *(LAS v4u*)(Ks + skey * FOX_KP + sd) = kreg;
            Vt[(sd + 0) * FOX_KP + skey] = (bf16)(vreg.x & 0xffffu); Vt[(sd + 1) * FOX_KP + skey] = (bf16)(vreg.x >> 16); Vt[(sd + 2) * FOX_KP + skey] = (bf16)(vreg.y & 0xffffu); Vt[(sd + 3) * FOX_KP + skey] = (bf16)(vreg.y >> 16);
            Vt[(sd + 4) * FOX_KP + skey] = (bf16)(vreg.z & 0xffffu); Vt[(sd + 5) * FOX_KP + skey] = (bf16)(vreg.z >> 16); Vt[(sd + 6) * FOX_KP + skey] = (bf16)(vreg.w & 0xffffu); Vt[(sd + 7) * FOX_KP + skey] = (bf16)(vreg.w >> 16);
            if (tid < 64) Cs[tid] = creg;
            if (t + 2 < NT) { kreg = *(const v4u*)(kp + (size_t)(t + 2) * 64 * 512); vreg = *(const v4u*)(vp + (size_t)(t + 2) * 64 * 512); if (tid < 64) creg = ct[64 * (t + 2) + tid]; } }
        const int jb = t - (NT - 4);
        if (jb >= 0 && 64 * jb > 32 * wid + 31) continue;
        LAS unsigned char* buf = lds + (t & 1) * FOX_BUF; const LAS bf16* Ks = (const LAS bf16*)buf; const LAS bf16* Vt = Ks + 64 * FOX_KP; const LAS float* Cs = (const LAS float*)(buf + 2 * 64 * FOX_KP * 2);
        f32x16 p0, p1;
#pragma unroll
        for (int g = 0; g < 4; ++g) { const f32x4 a = *(const LAS f32x4*)(Cs + 8 * g + 4 * hi), c = *(const LAS f32x4*)(Cs + 32 + 8 * g + 4 * hi);
            p0[4 * g + 0] = -a[0]; p0[4 * g + 1] = -a[1]; p0[4 * g + 2] = -a[2]; p0[4 * g + 3] = -a[3]; p1[4 * g + 0] = -c[0]; p1[4 * g + 1] = -c[1]; p1[4 * g + 2] = -c[2]; p1[4 * g + 3] = -c[3]; }
#pragma unroll
        for (int d0 = 0; d0 < 4; ++d0) { const bf16x8 a0 = *(const LAS bf16x8*)(Ks + r32 * FOX_KP + 16 * d0 + 8 * hi), a1 = *(const LAS bf16x8*)(Ks + (32 + r32) * FOX_KP + 16 * d0 + 8 * hi);
            p0 = __builtin_amdgcn_mfma_f32_32x32x16_bf16(a0, qr[d0], p0, 0, 0, 0); p1 = __builtin_amdgcn_mfma_f32_32x32x16_bf16(a1, qr[d0], p1, 0, 0, 0); }
        if (jb >= 0) { const int qrel = 32 * wid + r32, kb = 64 * jb + 4 * hi;
#pragma unroll
            for (int r = 0; r < 16; ++r) { const int kv = kb + (r & 3) + 8 * (r >> 2); if (kv > qrel) p0[r] = -__builtin_inff(); if (kv + 32 > qrel) p1[r] = -__builtin_inff(); } }
        float mx = fmaxf(p0[0], p1[0]);
#pragma unroll
        for (int r = 1; r < 16; ++r) mx = fmaxf(mx, fmaxf(p0[r], p1[r]));
        mx = fmaxf(mx, bperm(mx, lane ^ 32));
        const float mn = fmaxf(m, mx), alpha = __builtin_amdgcn_exp2f(m - mn); m = mn;
        float sum = 0.f;
#pragma unroll
        for (int r = 0; r < 16; ++r) { p0[r] = __builtin_amdgcn_exp2f(p0[r] - mn); p1[r] = __builtin_amdgcn_exp2f(p1[r] - mn); sum += p0[r] + p1[r]; }
        l = l * alpha + sum;
#pragma unroll
        for (int r = 0; r < 16; ++r) { o0[r] *= alpha; o1[r] *= alpha; }
        bf16x8 pb[4];
        { v4u w;
          w.x = pg8::cvt_pk_bf16(p0[0], p0[1]); w.y = pg8::cvt_pk_bf16(p0[2], p0[3]); w.z = pg8::cvt_pk_bf16(p0[4], p0[5]); w.w = pg8::cvt_pk_bf16(p0[6], p0[7]); pb[0] = __builtin_bit_cast(bf16x8, w);
          w.x = pg8::cvt_pk_bf16(p0[8], p0[9]); w.y = pg8::cvt_pk_bf16(p0[10], p0[11]); w.z = pg8::cvt_pk_bf16(p0[12], p0[13]); w.w = pg8::cvt_pk_bf16(p0[14], p0[15]); pb[1] = __builtin_bit_cast(bf16x8, w);
          w.x = pg8::cvt_pk_bf16(p1[0], p1[1]); w.y = pg8::cvt_pk_bf16(p1[2], p1[3]); w.z = pg8::cvt_pk_bf16(p1[4], p1[5]); w.w = pg8::cvt_pk_bf16(p1[6], p1[7]); pb[2] = __builtin_bit_cast(bf16x8, w);
          w.x = pg8::cvt_pk_bf16(p1[8], p1[9]); w.y = pg8::cvt_pk_bf16(p1[10], p1[11]); w.z = pg8::cvt_pk_bf16(p1[12], p1[13]); w.w = pg8::cvt_pk_bf16(p1[14], p1[15]); pb[3] = __builtin_bit_cast(bf16x8, w); }
#pragma unroll
        for (int mm = 0; mm < 4; ++mm) {
            typedef unsigned u32x2v __attribute__((ext_vector_type(2)));
            const u32x2v a0l = *(const LAS u32x2v*)(Vt + r32 * FOX_KP + 16 * mm + 4 * hi), a0h = *(const LAS u32x2v*)(Vt + r32 * FOX_KP + 16 * mm + 8 + 4 * hi);
            const u32x2v a1l = *(const LAS u32x2v*)(Vt + (32 + r32) * FOX_KP + 16 * mm + 4 * hi), a1h = *(const LAS u32x2v*)(Vt + (32 + r32) * FOX_KP + 16 * mm + 8 + 4 * hi);
            const v4u A0 = {a0l.x, a0l.y, a0h.x, a0h.y}, A1 = {a1l.x, a1l.y, a1h.x, a1h.y};
            o0 = __builtin_amdgcn_mfma_f32_32x32x16_bf16(__builtin_bit_cast(bf16x8, A0), pb[mm], o0, 0, 0, 0);
            o1 = __builtin_amdgcn_mfma_f32_32x32x16_bf16(__builtin_bit_cast(bf16x8, A1), pb[mm], o1, 0, 0, 0); }
    }
    l += bperm(l, lane ^ 32); const float inv = 1.f / l;
    bf16* Ow = O + (rowbase + q0 + wid * 32 + r32) * 512 + h * 64;
#pragma unroll
    for (int g = 0; g < 4; ++g) { typedef unsigned u32x2v __attribute__((ext_vector_type(2)));
        u32x2v w0, w1; w0.x = pg8::cvt_pk_bf16(o0[4 * g] * inv, o0[4 * g + 1] * inv); w0.y = pg8::cvt_pk_bf16(o0[4 * g + 2] * inv, o0[4 * g + 3] * inv);
        w1.x = pg8::cvt_pk_bf16(o1[4 * g] * inv, o1[4 * g + 1] * inv); w1.y = pg8::cvt_pk_bf16(o1[4 * g + 2] * inv, o1[4 * g + 3] * inv);
        *(u32x2v*)(Ow + 8 * g + 4 * hi) = w0; *(u32x2v*)(Ow + 32 + 8 * g + 4 * hi) = w1; }
    __syncthreads();
}
__global__ void __launch_bounds__(NTHR, 2) hybrid_fwd(Args args) {
    extern __shared__ __attribute__((aligned(16))) unsigned char lds_raw[];
    cg::grid_group grid = cg::this_grid();
    LAS unsigned char* lds = (LAS unsigned char*)lds_raw;
    int tid = threadIdx.x, lane = tid & 63, wave = __builtin_amdgcn_readfirstlane(tid >> 6);
    int G = gridDim.x, bx = blockIdx.x;
    int vcu = (G % 8 == 0) ? (bx % 8) * (G / 8) + bx / 8 : bx;
    int gw = vcu * NWAVES + wave; int NGW = G * NWAVES;
    PtrTab TB = (PtrTab)(lds + TAB_OFF);
    if (tid == 0) {
#pragma unroll
        for (int i = 0; i < 31; ++i) TB[i] = (unsigned long long)args.in[i];
    }
    if (tid == 1) { TB[40] = 0ull; }
    __syncthreads();
    (void)xcd_barrier_post((unsigned*)(args.ws + WS_BAR), (volatile LAS unsigned*)(lds + TAB_OFF + 320));
    grid.sync();
    unsigned char* ws = args.ws;
    float* X = args.out;
    float* SS = (float*)(ws + WS_SSP);
    bf16* XB = (bf16*)(ws + WS_XB);
    bf16* HB = (bf16*)(ws + WS_H);
    constexpr float C2X = 0.0625f * 1.4426950408889634f;
#define GSYNC() do { asm volatile("s_waitcnt vmcnt(0) lgkmcnt(0)" ::: "memory"); { XcdBarrier xb_; xb_.bar = (unsigned*)(ws + WS_BAR); xb_.x = xb_xcc_id(); xb_.st = (volatile LAS unsigned*)(lds + TAB_OFF + 320); xcd_barrier(xb_); } tid = threadIdx.x; asm volatile("" : "+v"(tid)); lane = tid & 63; wave = __builtin_amdgcn_readfirstlane(tid >> 6); G = gridDim.x; bx = blockIdx.x; asm volatile("" : "+s"(G), "+s"(bx)); vcu = (G % 8 == 0) ? (bx % 8) * (G / 8) + bx / 8 : bx; gw = vcu * NWAVES + wave; NGW = G * NWAVES; { unsigned long long wsi_ = (unsigned long long)ws; asm volatile("" : "+s"(wsi_)); ws = (unsigned char*)(GAS unsigned char*)wsi_; } } while (0)

    for (int l = 0; l < DEPTH; ++l) {
        float* ss0 = SS + (size_t)(4 * l + 0) * M * 4; float* ss1 = SS + (size_t)(4 * l + 1) * M * 4; float* ss2 = SS + (size_t)(4 * l + 2) * M * 4; float* ss3 = SS + (size_t)(4 * l + 3) * M * 4; float* ss4 = SS + (size_t)(4 * l + 4) * M * 4;
        phase_prologue(TB, ws, X, l, lds, gw, NGW, lane, wave);
        GSYNC();
        { pg8::Gemm g{XB, (const bf16*)(ws + WS_W1IN), M, 2 * DFF, D, D, D, 0}; pg8::StaticOrder S; S.init(M, 2 * DFF, G, bx);
          pg8::EpiSwiglu E{HB, ss0, DFF};
          pg8::gemm_phase<pg8::EpiSwiglu, pg8::StaticOrder, true, true>(lds, g, S, E); }
        if (bx >= G / 2) { pg8::Gemm g{(const bf16*)(ws + WS_MEMN), (const bf16*)(ws + WS_WXKV), 512, 2 * D, D, D, D, 0}; pg8::StaticOrder S; S.init(512, 2 * D, G, bx - G / 2);
          pg8::EpiKV E{(bf16*)(ws + WS_KX), (bf16*)(ws + WS_VT)};
          pg8::gemm_phase<pg8::EpiKV, pg8::StaticOrder, true, true>(lds, g, S, E); }
        GSYNC();
        { pg8::Gemm g{HB, (const bf16*)(ws + WS_W1OUT), M, D, DFF, DFF, DFF, 0}; pg8::StaticOrder S; S.init(M, D, G, bx); pg8::Unit u_;
          pg8::EpiResid E{X, XB, ss1, 0.5f};
          for (int i_ = 0; S.next(i_, u_); ++i_) { const pg8::OneUnit O1{u_.pm, u_.pn}; pg8::gemm_phase<pg8::EpiResid, pg8::OneUnit, false, true>(lds, g, O1, E); } }
        GSYNC();
        { pg8::Gemm g{XB, (const bf16*)(ws + WS_WIN), M, 4096, D, D, D, 0}; pg8::StaticOrder S; S.init(M, 4096, G, bx);
          pg8::EpiWin E{(bf16*)(ws + WS_XA), (bf16*)(ws + WS_XL), (bf16*)(ws + WS_GG), (bf16*)(ws + WS_Q), (bf16*)(ws + WS_K), (bf16*)(ws + WS_V), ss1, FOX_C2};
          pg8::gemm_phase<pg8::EpiWin, pg8::StaticOrder, true, true>(lds, g, S, E); }
        phase_fl(XB, (const float*)(ws + WS_WFL), tab_in(TB, 7) + l * 8, ss1, (float*)(ws + WS_LOGF), gw, NGW, lane);
        GSYNC();
        if (vcu < 16) cumsum_bh((const float*)(ws + WS_LOGF), (float*)(ws + WS_CTIL), vcu, (LAS float*)lds);
        for (int it = vcu; it < 512; it += G)
            lru_item<false>(lds, it >> 8, (it >> 6) & 3, it & 63, (const bf16*)(ws + WS_XL), (bf16*)(ws + WS_GG), tab_in(TB, 12) + (size_t)l * 4 * D, tab_in(TB, 13) + l * D, (const bf16*)(ws + WS_WAT), (const bf16*)(ws + WS_WXT),
                            tab_in(TB, 15) + l * D, tab_in(TB, 17) + l * D, tab_in(TB, 18) + l * D, (float*)(ws + WS_SUMM));
        phase_pool((const bf16*)(ws + WS_XA), (bf16*)(ws + WS_YA), vcu * NTHR + tid, G * NTHR);
        phase_kmax((const bf16*)(ws + WS_K), (float*)(ws + WS_KPART), gw, NGW, lane);
        GSYNC();
        for (int it = vcu; it < 512; it += G)
            lru_item<true>(lds, it >> 8, (it >> 6) & 3, it & 63, (const bf16*)(ws + WS_XL), (bf16*)(ws + WS_GG), tab_in(TB, 12) + (size_t)l * 4 * D, tab_in(TB, 13) + l * D, (const bf16*)(ws + WS_WAT), (const bf16*)(ws + WS_WXT),
                           tab_in(TB, 15) + l * D, tab_in(TB, 17) + l * D, tab_in(TB, 18) + l * D, (float*)(ws + WS_SUMM));
        for (int p = vcu; p < 256; p += G) { const int bh = p >> 4, s = p & 15;
            fox_unit(lds, bh >> 3, bh & 7, s, (const bf16*)(ws + WS_Q), (const bf16*)(ws + WS_K), (const bf16*)(ws + WS_V), (bf16*)(ws + WS_YC), (const float*)(ws + WS_CTIL) + (size_t)bh * SEQ, (const float*)(ws + WS_KPART), NGW);
            fox_unit(lds, bh >> 3, bh & 7, 31 - s, (const bf16*)(ws + WS_Q), (const bf16*)(ws + WS_K), (const bf16*)(ws + WS_V), (bf16*)(ws + WS_YC), (const float*)(ws + WS_CTIL) + (size_t)bh * SEQ, (const float*)(ws + WS_KPART), NGW); }
        GSYNC();
        { pg8::StaticOrder S; S.init(M, D, G, bx); pg8::Unit u;
          bf16* stash = (bf16*)(ws + WS_STASH) + (size_t)bx * 65536; bf16* mg = (bf16*)(ws + WS_MG);
          for (int i = 0; S.next(i, u); ++i) { const pg8::OneUnit O1{u.pm, u.pn};
#pragma unroll 1
              for (int br = 0; br < 3; ++br) {
                  { pg8::Gemm g{XB, (const bf16*)(ws + WS_WG) + (size_t)br * D * D, M, D, D, D, D, 0}; pg8::EpiGate E{stash, tab_in(TB, 8) + (size_t)l * 3 * D + br * D, ss1};
                    pg8::gemm_phase<pg8::EpiGate, pg8::OneUnit, true, true>(lds, g, O1, E); }
                  asm volatile("s_waitcnt vmcnt(0)" ::: "memory"); __builtin_amdgcn_fence(__ATOMIC_ACQUIRE, "agent"); __syncthreads();
                  const bf16* Ab = br == 0 ? (const bf16*)(ws + WS_YA) : br == 1 ? (const bf16*)(ws + WS_GG) : (const bf16*)(ws + WS_YC);
                  const bf16* Ub = br == 0 ? (const bf16*)(ws + WS_UA) : br == 1 ? (const bf16*)(ws + WS_UB) : (const bf16*)(ws + WS_UC);
                  const int Kb = br == 1 ? 1024 : 512;
                  { pg8::Gemm g{Ab, Ub, M, D, Kb, Kb, Kb, 0}; pg8::EpiMerge E{stash, mg, br == 0 ? 1 : 0};
                    pg8::gemm_phase<pg8::EpiMerge, pg8::OneUnit, true, true>(lds, g, O1, E); }
                  asm volatile("s_waitcnt vmcnt(0)" ::: "memory"); __builtin_amdgcn_fence(__ATOMIC_ACQUIRE, "agent"); __syncthreads();
              } } }
        GSYNC();
        { pg8::Gemm g{(const bf16*)(ws + WS_MG), (const bf16*)(ws + WS_WO), M, D, D, D, D, 0}; pg8::StaticOrder S; S.init(M, D, G, bx); pg8::Unit u_;
          pg8::EpiResid E{X, XB, ss2, 1.0f};
          for (int i_ = 0; S.next(i_, u_); ++i_) { const pg8::OneUnit O1{u_.pm, u_.pn}; pg8::gemm_phase<pg8::EpiResid, pg8::OneUnit, false, true>(lds, g, O1, E); } }
        GSYNC();
        { bf16* pb = (bf16*)(ws + WS_PBUF) + (size_t)bx * 65536; const pg8::OneUnit O1{0, 0};
          for (int uid = vcu; uid < 256; uid += G) { const int rt = uid >> 2, h = uid & 3, b = rt >> 5;
              int KX = 256; asm volatile("" : "+s"(KX));
              bf16* qo = (bf16*)(ws + WS_QX) + (size_t)rt * 256 * D + h * 256; bf16* qs = (bf16*)(ws + WS_Q) + (size_t)bx * 65536;
              { pg8::Gemm g{XB + (size_t)rt * 256 * D, (const bf16*)(ws + WS_WXQ) + (size_t)h * 256 * D, 256, 256, D, D, D, 0}; pg8::EpiRs E{qs, 256, ss2 + (size_t)rt * 256 * 4, C2X};
                pg8::gemm_phase<pg8::EpiRs, pg8::OneUnit, true, true>(lds, g, O1, E); }
              asm volatile("s_waitcnt vmcnt(0)" ::: "memory"); __builtin_amdgcn_fence(__ATOMIC_ACQUIRE, "agent"); __syncthreads();
              { pg8::Gemm g{qs, (const bf16*)(ws + WS_KX) + (size_t)b * 256 * D + h * 256, 256, 256, KX, 256, D, 0}; pg8::EpiSoftmaxP E{pb};
                pg8::gemm_phase<pg8::EpiSoftmaxP, pg8::OneUnit, false, true>(lds, g, O1, E); }
              asm volatile("s_waitcnt vmcnt(0)" ::: "memory"); __builtin_amdgcn_fence(__ATOMIC_ACQUIRE, "agent"); __syncthreads();
              { pg8::Gemm g{pb, (const bf16*)(ws + WS_VT) + (size_t)(b * 4 + h) * 65536, 256, 256, KX, 256, 256, 0}; pg8::EpiRs E{qo, D, nullptr, 1.0f};
                pg8::gemm_phase<pg8::EpiRs, pg8::OneUnit, true, true>(lds, g, O1, E); }
              asm volatile("s_waitcnt vmcnt(0)" ::: "memory"); __syncthreads();
          } }
        GSYNC();
        { pg8::Gemm g{(const bf16*)(ws + WS_QX), (const bf16*)(ws + WS_WXO), M, D, D, D, D, 0}; pg8::StaticOrder S; S.init(M, D, G, bx); pg8::Unit u_;
          pg8::EpiResid E{X, XB, ss3, 1.0f};
          for (int i_ = 0; S.next(i_, u_); ++i_) { const pg8::OneUnit O1{u_.pm, u_.pn}; pg8::gemm_phase<pg8::EpiResid, pg8::OneUnit, false, true>(lds, g, O1, E); } }
        GSYNC();
        { pg8::Gemm g{XB, (const bf16*)(ws + WS_W2IN), M, 2 * DFF, D, D, D, 0}; pg8::StaticOrder S; S.init(M, 2 * DFF, G, bx);
          pg8::EpiSwiglu E{HB, ss3, DFF};
          pg8::gemm_phase<pg8::EpiSwiglu, pg8::StaticOrder, true, true>(lds, g, S, E); }
        GSYNC();
        { pg8::Gemm g{HB, (const bf16*)(ws + WS_W2OUT), M, D, DFF, DFF, DFF, 0}; pg8::StaticOrder S; S.init(M, D, G, bx); pg8::Unit u_;
          pg8::EpiResid E{X, XB, ss4, 0.5f};
          for (int i_ = 0; S.next(i_, u_); ++i_) { const pg8::OneUnit O1{u_.pm, u_.pn}; pg8::gemm_phase<pg8::EpiResid, pg8::OneUnit, false, true>(lds, g, O1, E); } }
        GSYNC();
    }
    phase_final(X, tab_in(TB, 30), gw, NGW, lane);
#undef GSYNC
}

extern "C" void kernel_launch(void* const* d_in, const int* in_sizes, int n_in, void* d_out, int out_size, void* d_ws, size_t ws_size, hipStream_t stream) {
    static int grid = 0;
    if (grid == 0) {
        if (n_in != 31 || out_size != M * D || ws_size < WS_END) { fprintf(stderr, "kernel_launch: unexpected problem (n_in %d, out %d, ws %zu)\n", n_in, out_size, ws_size); grid = -1; return; }
        int dev = 0, cus = 0, per_cu = 0;
        (void)hipGetDevice(&dev); (void)hipDeviceGetAttribute(&cus, hipDeviceAttributeMultiprocessorCount, dev);
        if (hipFuncSetAttribute((const void*)hybrid_fwd, hipFuncAttributeMaxDynamicSharedMemorySize, LDS_BYTES) != hipSuccess) { fprintf(stderr, "kernel_launch: hipFuncSetAttribute failed\n"); grid = -1; return; }
        if (hipOccupancyMaxActiveBlocksPerMultiprocessor(&per_cu, (const void*)hybrid_fwd, NTHR, LDS_BYTES) != hipSuccess || per_cu < 1) per_cu = 1;
        (void)hipGetLastError();
        grid = cus * (per_cu > 1 ? 1 : per_cu);
        if (grid > 256) grid = 256;
    }
    if (grid < 0) return;
    (void)hipMemsetAsync((char*)d_ws + WS_SS, 0, CTL_ZERO_BYTES, stream);
    Args a{};
    for (int i = 0; i < 31; ++i) a.in[i] = (const float*)d_in[i];
    a.out = (float*)d_out; a.ws = (unsigned char*)d_ws;
    void* kargs[] = {&a};
    hipError_t e = hipLaunchCooperativeKernel((const void*)hybrid_fwd, dim3(grid), dim3(NTHR), kargs, LDS_BYTES, stream);
    if (e != hipSuccess) fprintf(stderr, "cooperative launch failed: %s (grid %d)\n", hipGetErrorString(e), grid);
}
```

```cpp
#include <hip/hip_runtime.h>
#include <hip/hip_cooperative_groups.h>
#include <cstdio>
#include <cstdint>
namespace cg = cooperative_groups;
namespace pg8 {
#define PG8_LAS __attribute__((address_space(3)))
typedef unsigned short bf16_t;
typedef short bf16x8 __attribute__((ext_vector_type(8)));
typedef float f32x4 __attribute__((ext_vector_type(4)));
typedef unsigned u32x4 __attribute__((ext_vector_type(4)));
constexpr int BM = 256, BK = 64, HALF = 128, HTB = HALF * BK * 2  , STAGE_BYTES = 8 * HTB, NXCD = 8, WGM = 8;

__host__ __device__ __forceinline__ int lds_byte(int r, int c) { const int st = (r >> 4) * 2 + (c >> 5), rr = r & 15, cc = c & 31, ob = rr * 64 + cc * 2; return st * 1024 + (ob ^ (((ob >> 9) & 1) << 5)); }
__host__ __device__ __forceinline__ void stage_rc(int b, int& R, int& C) { const int st = b / 1024, sb = b % 1024, swz = sb ^ (((sb >> 9) & 1) << 5); R = (st >> 1) * 16 + swz / 64; C = (st & 1) * 32 + (swz % 64) / 2; }
__host__ __device__ __forceinline__ int perm32(int rho) { const int n = rho >> 4, i = rho & 15; return 8 * (i >> 2) + 4 * n + (i & 3); }

struct Unit { int pm, pn; };
struct Gemm { const bf16_t* A; const bf16_t* Bt; int M, N, K, lda, ldb, a_pn_off; };

struct StaticOrder {
    int nM, nN, nwg, G, c;
    __host__ __device__ __forceinline__ void init(int M, int N, int G_, int c_) { nM = M / BM; nN = N / BM; nwg = nM * nN; G = G_; c = c_; }
    __host__ __device__ __forceinline__ bool next(int i, Unit& u) const {
        const long L = (long)i * G + c; if (L >= nwg) return false;
        int wgid = (int)L; { const int q = nwg / NXCD, r = nwg % NXCD, xcd = wgid % NXCD, off = wgid / NXCD; wgid = (xcd < r ? xcd * (q + 1) : r * (q + 1) + (xcd - r) * q) + off; }
        const int nig = WGM * nN, gid = wgid / nig, fm = gid * WGM, gsz = (nM - fm) < WGM ? (nM - fm) : WGM;
        u.pm = fm + ((wgid % nig) % gsz); u.pn = (wgid % nig) / gsz; return true;
    }
    __device__ __forceinline__ void a_ready(const Unit&) const {}
    __device__ __forceinline__ void done(const Unit&) const {}
};

__device__ __forceinline__ unsigned cvt_pk_bf16(float lo, float hi) { unsigned r; asm volatile("v_cvt_pk_bf16_f32 %0, %1, %2" : "=v"(r) : "v"(lo), "v"(hi)); return r; }
__device__ __forceinline__ float bperm(float v, int srclane) { return __int_as_float(__builtin_amdgcn_ds_bpermute(srclane << 2, __float_as_int(v))); }
typedef float f32x2 __attribute__((ext_vector_type(2)));
typedef unsigned u32x2 __attribute__((ext_vector_type(2)));
__device__ __forceinline__ float fsig(float v) { return __builtin_amdgcn_rcpf(1.f + __expf(-v)); }
__device__ __forceinline__ float fsilu(float v) { return v * fsig(v); }
__device__ __forceinline__ float fgelu_tanh(float v) { return v * fsig(1.5957691216057308f * (v + 0.044715f * v * v * v)); }
__device__ __forceinline__ float bf_lo(unsigned w) { return __uint_as_float(w << 16); }
__device__ __forceinline__ float bf_hi(unsigned w) { return __uint_as_float(w & 0xffff0000u); }
__device__ __forceinline__ float rstd_of(const float* ss, int row) { const f32x4 a = *(const f32x4*)(ss + (size_t)row * 4); return rsqrtf(((a[0] + a[1]) + (a[2] + a[3])) * (1.0f / 1024.0f) + 1e-6f); }
__device__ __forceinline__ u32x4 pack8(const f32x4 v0, const f32x4 v1) { u32x4 w; w.x = cvt_pk_bf16(v0[0], v0[1]); w.y = cvt_pk_bf16(v0[2], v0[3]); w.z = cvt_pk_bf16(v1[0], v1[1]); w.w = cvt_pk_bf16(v1[2], v1[3]); return w; }

__device__ __forceinline__ void rstd8(const float* ss, int row0, float sc, float (&rs)[2][4]) {
    f32x4 pa[2][4];
#pragma unroll
    for (int ai = 0; ai < 2; ++ai)
#pragma unroll
        for (int m = 0; m < 4; ++m) pa[ai][m] = *(const f32x4*)(ss + (size_t)(row0 + ai * HALF + m * 16) * 4);
#pragma unroll
    for (int ai = 0; ai < 2; ++ai)
#pragma unroll
        for (int m = 0; m < 4; ++m) { const f32x4 a = pa[ai][m]; rs[ai][m] = rsqrtf(((a[0] + a[1]) + (a[2] + a[3])) * (1.0f / 1024.0f) + 1e-6f) * sc; }
    __builtin_amdgcn_sched_barrier(0);
}

__device__ __forceinline__ u32x4 ld16_sc1(const void* p) { u32x4 v; asm volatile("global_load_dwordx4 %0, %1, off sc1" : "=v"(v) : "v"(p) : "memory"); return v; }
#define PG8_LDWAIT(v) asm volatile("s_waitcnt vmcnt(0)" : "+v"(v))

struct OneUnit { int pm, pn;
    __device__ __forceinline__ bool next(int i, Unit& u) const { if (i) return false; u.pm = pm; u.pn = pn; return true; }
    __device__ __forceinline__ void a_ready(const Unit&) const {}
    __device__ __forceinline__ void done(const Unit&) const {} };

struct EpiSwiglu { static constexpr bool PERM = true, AFTER_DRAIN = false; bf16_t* H; const float* ss; int ldh;
    __device__ __forceinline__ void operator()(const f32x4 (&acc)[2][2][4][2], const Unit& u, int wr, int wc, int fr, int fq) const {
        const int row0 = u.pm * BM + wr * 64 + fr, col0 = u.pn * HALF + wc * 32 + 8 * fq; float rsv[2][4]; rstd8(ss, row0, 1.f, rsv);
#pragma unroll
        for (int ai = 0; ai < 2; ++ai)
#pragma unroll
            for (int m = 0; m < 4; ++m) { const int row = row0 + ai * HALF + m * 16; const float rs = rsv[ai][m];
                f32x4 o0, o1;
#pragma unroll
                for (int i = 0; i < 4; ++i) { o0[i] = fsilu(acc[ai][0][m][0][i] * rs) * (acc[ai][1][m][0][i] * rs); o1[i] = fsilu(acc[ai][0][m][1][i] * rs) * (acc[ai][1][m][1][i] * rs); }
                *(u32x4*)(H + (size_t)row * ldh + col0) = pack8(o0, o1); __builtin_amdgcn_sched_barrier(0); }
    }
};
struct EpiResid { static constexpr bool PERM = false, AFTER_DRAIN = true; float* x; bf16_t* xb; float* ss; float scale;
    __device__ __forceinline__ void fused(f32x4 (&acc)[2][2][4][2], const Unit& u, int wr, int wc, int fr, int fq, PG8_LAS unsigned char* lds, int wid, int lane) const {
        float scl = scale; asm volatile("" : "+v"(scl)); const int row0 = u.pm * BM + wr * 64 + fr, col0 = u.pn * BM + wc * 32 + 4 * fq;
        PG8_LAS float* P = (PG8_LAS float*)lds;
#pragma unroll
        for (int ai = 0; ai < 2; ++ai)
#pragma unroll
            for (int m = 0; m < 4; ++m) { const int row = row0 + ai * HALF + m * 16; float q = 0.f;
#pragma unroll
                for (int bj = 0; bj < 2; ++bj)
#pragma unroll
                    for (int n = 0; n < 2; ++n) { const size_t off = (size_t)row * 1024 + col0 + bj * HALF + n * 16;
                        f32x4 v = *(const f32x4*)(x + off) + acc[ai][bj][m][n] * scl; *(f32x4*)(x + off) = v;
                        u32x2 w; w.x = cvt_pk_bf16(v[0], v[1]); w.y = cvt_pk_bf16(v[2], v[3]); *(u32x2*)(xb + off) = w;
                        q += (v[0] * v[0] + v[1] * v[1]) + (v[2] * v[2] + v[3] * v[3]); }
                q += bperm(q, (fr + 16 * fq) ^ 16); q += bperm(q, (fr + 16 * fq) ^ 32);
                if (fq == 0) P[(ai * HALF + wr * 64 + m * 16 + fr) * 4 + wc] = q; }
        asm volatile("s_waitcnt lgkmcnt(0)" ::: "memory"); __builtin_amdgcn_s_barrier(); asm volatile("" ::: "memory");
        const int tl = wid * 64 + lane;
        if (tl < 256) { const f32x4 a = *(const PG8_LAS f32x4*)(P + tl * 4); ss[(size_t)(u.pm * BM + tl) * 4 + u.pn] = (a[0] + a[1]) + (a[2] + a[3]); }
        asm volatile("s_waitcnt lgkmcnt(0)" ::: "memory"); __builtin_amdgcn_s_barrier(); asm volatile("" ::: "memory");
    }
};
struct EpiRs { static constexpr bool PERM = true, AFTER_DRAIN = false; bf16_t* O; int ldc; const float* ss; float sc;
    __device__ __forceinline__ void operator()(const f32x4 (&acc)[2][2][4][2], const Unit& u, int wr, int wc, int fr, int fq) const {
        const int row0 = u.pm * BM + wr * 64 + fr, col0 = u.pn * BM + wc * 32 + 8 * fq; float rsv[2][4];
        if (ss) rstd8(ss, row0, sc, rsv); else {
#pragma unroll
            for (int a = 0; a < 2; ++a)
#pragma unroll
                for (int b = 0; b < 4; ++b) rsv[a][b] = sc; }
#pragma unroll
        for (int ai = 0; ai < 2; ++ai)
#pragma unroll
            for (int m = 0; m < 4; ++m) { const int row = row0 + ai * HALF + m * 16; const float rs = rsv[ai][m];
#pragma unroll
                for (int bj = 0; bj < 2; ++bj) *(u32x4*)(O + (size_t)row * ldc + col0 + bj * HALF) = pack8(acc[ai][bj][m][0] * rs, acc[ai][bj][m][1] * rs); }
    }
};
struct EpiWin { static constexpr bool PERM = true, AFTER_DRAIN = false; bf16_t *xa, *xl, *gg, *q, *k, *v; const float* ss; float qscale;
    __device__ __forceinline__ void operator()(const f32x4 (&acc)[2][2][4][2], const Unit& u, int wr, int wc, int fr, int fq) const {
        const int pn = u.pn; bf16_t* dst; int ld, ct; float sc = 1.f; bool act = false;
        if (pn < 2) { dst = xa; ld = 512; ct = pn; } else if (pn < 6) { dst = xl; ld = 1024; ct = pn - 2; } else if (pn < 10) { dst = gg; ld = 1024; ct = pn - 6; act = true; }
        else if (pn < 12) { dst = q; ld = 512; ct = pn - 10; sc = qscale; } else if (pn < 14) { dst = k; ld = 512; ct = pn - 12; } else { dst = v; ld = 512; ct = pn - 14; }
        const int row0 = u.pm * BM + wr * 64 + fr, col0 = ct * BM + wc * 32 + 8 * fq; float rsv[2][4]; rstd8(ss, row0, sc, rsv);
#pragma unroll
        for (int ai = 0; ai < 2; ++ai)
#pragma unroll
            for (int m = 0; m < 4; ++m) { const int row = row0 + ai * HALF + m * 16; const float rs = rsv[ai][m];
#pragma unroll
                for (int bj = 0; bj < 2; ++bj) { f32x4 v0 = acc[ai][bj][m][0] * rs, v1 = acc[ai][bj][m][1] * rs;
                    if (act) {
#pragma unroll
                        for (int i = 0; i < 4; ++i) { v0[i] = fgelu_tanh(v0[i]); v1[i] = fgelu_tanh(v1[i]); } }
                    *(u32x4*)(dst + (size_t)row * ld + col0 + bj * HALF) = pack8(v0, v1); __builtin_amdgcn_sched_barrier(0); } }
    }
};
struct EpiGate { static constexpr bool PERM = true, AFTER_DRAIN = false; bf16_t* stash; const float* bg; const float* ss;
    __device__ __forceinline__ void operator()(const f32x4 (&acc)[2][2][4][2], const Unit& u, int wr, int wc, int fr, int fq) const {
        const int row0 = u.pm * BM + wr * 64 + fr, col0 = u.pn * BM + wc * 32 + 8 * fq; int tid_o = threadIdx.x; asm volatile("" : "+v"(tid_o)); const int tid = tid_o;
        f32x4 bv[2][2];
#pragma unroll
        for (int bj = 0; bj < 2; ++bj)
#pragma unroll
            for (int n = 0; n < 2; ++n) bv[bj][n] = *(const f32x4*)(bg + col0 + bj * HALF + 4 * n);
        float rsv[2][4]; rstd8(ss, row0, 1.f, rsv);
#pragma unroll
        for (int ai = 0; ai < 2; ++ai)
#pragma unroll
            for (int m = 0; m < 4; ++m) { const float rs = rsv[ai][m];
#pragma unroll
                for (int bj = 0; bj < 2; ++bj) { f32x4 v0 = acc[ai][bj][m][0] * rs + bv[bj][0], v1 = acc[ai][bj][m][1] * rs + bv[bj][1];
#pragma unroll
                    for (int i = 0; i < 4; ++i) { v0[i] = fsig(v0[i]); v1[i] = fsig(v1[i]); }
                    *(u32x4*)(stash + ((size_t)((ai * 4 + m) * 2 + bj) * 512 + tid) * 8) = pack8(v0, v1); __builtin_amdgcn_sched_barrier(0); } }
    }
};
struct EpiMerge { static constexpr bool PERM = true, AFTER_DRAIN = false; const bf16_t* stash; bf16_t* mg; int first;
    __device__ __forceinline__ void operator()(const f32x4 (&acc)[2][2][4][2], const Unit& u, int wr, int wc, int fr, int fq) const {
        const int row0 = u.pm * BM + wr * 64 + fr, col0 = u.pn * BM + wc * 32 + 8 * fq; int tid_o = threadIdx.x; asm volatile("" : "+v"(tid_o)); const int tid = tid_o;
#pragma unroll
        for (int ai = 0; ai < 2; ++ai) { u32x4 gw[4][2], ow[4][2];
#pragma unroll
            for (int m = 0; m < 4; ++m)
#pragma unroll
                for (int bj = 0; bj < 2; ++bj) { gw[m][bj] = ld16_sc1(stash + ((size_t)((ai * 4 + m) * 2 + bj) * 512 + tid) * 8);
                    ow[m][bj] = first ? (u32x4){0u, 0u, 0u, 0u} : ld16_sc1(mg + (size_t)(row0 + ai * HALF + m * 16) * 1024 + col0 + bj * HALF); }
#pragma unroll
            for (int m = 0; m < 4; ++m)
#pragma unroll
                for (int bj = 0; bj < 2; ++bj) { PG8_LDWAIT(gw[m][bj]); if (!first) PG8_LDWAIT(ow[m][bj]); }
            __builtin_amdgcn_sched_barrier(0);
#pragma unroll
            for (int m = 0; m < 4; ++m)
#pragma unroll
                for (int bj = 0; bj < 2; ++bj) { const u32x4 g = gw[m][bj], o = ow[m][bj]; f32x4 v0 = acc[ai][bj][m][0], v1 = acc[ai][bj][m][1];
                    v0[0] = v0[0] * bf_lo(g.x) + bf_lo(o.x); v0[1] = v0[1] * bf_hi(g.x) + bf_hi(o.x); v0[2] = v0[2] * bf_lo(g.y) + bf_lo(o.y); v0[3] = v0[3] * bf_hi(g.y) + bf_hi(o.y);
                    v1[0] = v1[0] * bf_lo(g.z) + bf_lo(o.z); v1[1] = v1[1] * bf_hi(g.z) + bf_hi(o.z); v1[2] = v1[2] * bf_lo(g.w) + bf_lo(o.w); v1[3] = v1[3] * bf_hi(g.w) + bf_hi(o.w);
                    *(u32x4*)(mg + (size_t)(row0 + ai * HALF + m * 16) * 1024 + col0 + bj * HALF) = pack8(v0, v1); }
            __builtin_amdgcn_sched_barrier(0); }
    }
};
struct EpiKV { static constexpr bool PERM = true, AFTER_DRAIN = false; bf16_t* kx; bf16_t* vt;
    __device__ __forceinline__ void operator()(const f32x4 (&acc)[2][2][4][2], const Unit& u, int wr, int wc, int fr, int fq) const {
        if (u.pn < 4) { const int row0 = u.pm * BM + wr * 64 + fr, col0 = u.pn * BM + wc * 32 + 8 * fq;
#pragma unroll
            for (int ai = 0; ai < 2; ++ai)
#pragma unroll
                for (int m = 0; m < 4; ++m)
#pragma unroll
                    for (int bj = 0; bj < 2; ++bj) *(u32x4*)(kx + (size_t)(row0 + ai * HALF + m * 16) * 1024 + col0 + bj * HALF) = pack8(acc[ai][bj][m][0], acc[ai][bj][m][1]);
        } else { const int h = u.pn - 4, b = u.pm; bf16_t* base = vt + (size_t)(b * 4 + h) * 65536;
#pragma unroll
            for (int ai = 0; ai < 2; ++ai)
#pragma unroll
                for (int m = 0; m < 4; ++m) { const int mr = ai * HALF + wr * 64 + m * 16 + fr;
#pragma unroll
                    for (int bj = 0; bj < 2; ++bj) { bf16_t* p = base + (size_t)(bj * HALF + wc * 32 + 8 * fq) * 256 + mr; asm volatile("" : "+v"(p));
#pragma unroll
                        for (int n = 0; n < 2; ++n)
#pragma unroll
                            for (int i = 0; i < 4; ++i) p[(4 * n + i) * 256] = (bf16_t)(cvt_pk_bf16(acc[ai][bj][m][n][i], 0.f) & 0xffffu);
                        __builtin_amdgcn_sched_barrier(0); } }
        }
    }
};
struct EpiSoftmaxP { static constexpr bool PERM = true, AFTER_DRAIN = true; bf16_t* P;
    __device__ __forceinline__ void fused(f32x4 (&acc)[2][2][4][2], const Unit& u, int wr, int wc, int fr, int fq, PG8_LAS unsigned char* lds, int wid, int lane) const {
        PG8_LAS f32x2* X = (PG8_LAS f32x2*)lds;
        float mloc[2][4];
#pragma unroll
        for (int ai = 0; ai < 2; ++ai)
#pragma unroll
            for (int m = 0; m < 4; ++m) { float mx = -__builtin_inff();
#pragma unroll
                for (int bj = 0; bj < 2; ++bj)
#pragma unroll
                    for (int n = 0; n < 2; ++n) { const f32x4 v = acc[ai][bj][m][n]; mx = fmaxf(mx, fmaxf(fmaxf(v[0], v[1]), fmaxf(v[2], v[3]))); }
                mx = fmaxf(mx, bperm(mx, (fr + 16 * fq) ^ 16)); mx = fmaxf(mx, bperm(mx, (fr + 16 * fq) ^ 32)); float s = 0.f;
#pragma unroll
                for (int bj = 0; bj < 2; ++bj)
#pragma unroll
                    for (int n = 0; n < 2; ++n) { f32x4 v = acc[ai][bj][m][n];
#pragma unroll
                        for (int i = 0; i < 4; ++i) { v[i] = __builtin_amdgcn_exp2f(v[i] - mx); s += v[i]; }
                        acc[ai][bj][m][n] = v; }
                s += bperm(s, (fr + 16 * fq) ^ 16); s += bperm(s, (fr + 16 * fq) ^ 32); mloc[ai][m] = mx;
                if (fq == 0) X[(ai * HALF + wr * 64 + m * 16 + fr) * 4 + wc] = (f32x2){mx, s}; __builtin_amdgcn_sched_barrier(0); }
        asm volatile("s_waitcnt lgkmcnt(0)" ::: "memory"); __builtin_amdgcn_s_barrier(); asm volatile("" ::: "memory");
#pragma unroll
        for (int ai = 0; ai < 2; ++ai)
#pragma unroll
            for (int m = 0; m < 4; ++m) { const int rl = ai * HALF + wr * 64 + m * 16 + fr;
                const f32x2 a = X[rl * 4 + 0], b = X[rl * 4 + 1], c = X[rl * 4 + 2], d = X[rl * 4 + 3];
                const float M = fmaxf(fmaxf(a.x, b.x), fmaxf(c.x, d.x));
                const float L = a.y * __builtin_amdgcn_exp2f(a.x - M) + b.y * __builtin_amdgcn_exp2f(b.x - M) + c.y * __builtin_amdgcn_exp2f(c.x - M) + d.y * __builtin_amdgcn_exp2f(d.x - M);
                const float f = __builtin_amdgcn_exp2f(mloc[ai][m] - M) / L;
#pragma unroll
                for (int bj = 0; bj < 2; ++bj) *(u32x4*)(P + (size_t)rl * 256 + bj * HALF + wc * 32 + 8 * fq) = pack8(acc[ai][bj][m][0] * f, acc[ai][bj][m][1] * f); __builtin_amdgcn_sched_barrier(0); }
        asm volatile("s_waitcnt vmcnt(0) lgkmcnt(0)" ::: "memory"); __builtin_amdgcn_s_barrier(); asm volatile("" ::: "memory");
    }
};

template <class Epi, class Sched, bool ALIGN_EPI = false, bool SP2 = false>
__device__ __forceinline__ void gemm_phase(PG8_LAS unsigned char* lds, const Gemm g, const Sched& S, const Epi& E) {
    int tid_o = threadIdx.x; asm volatile("" : "+v"(tid_o));
    const int tid = tid_o, wid = __builtin_amdgcn_readfirstlane(tid >> 6), lane = tid & 63, wr = wid >> 2, wc = wid & 3, fr = lane & 15, fq = lane >> 4;
    const int K = g.K, nt = K / BK;
    unsigned voffA[2], voffB[2];
#pragma unroll
    for (int i = 0; i < 2; ++i) { int R, C; stage_rc(tid * 16 + i * 8192, R, C); const int Rb = Epi::PERM ? ((R & ~31) + perm32(R & 31)) : R;
        voffA[i] = (unsigned)(R * g.lda + C) * 2u; voffB[i] = (unsigned)(Rb * g.ldb + C) * 2u; }
    const size_t kstep = (size_t)(BK * 2);
    const size_t hstepA = (size_t)HALF * g.lda * 2, hstepB = (size_t)HALF * g.ldb * 2;
    const size_t tstepA = 2 * hstepA, tstepB = 2 * hstepB;
    const unsigned ldsw = (unsigned)wid * 1024u;
    const int aoff = lds_byte(wr * 64 + fr, fq * 8), boff = lds_byte(wc * 32 + fr, fq * 8);
#define PG8_SA(b, h) (((b) * 2 + (h)) * HTB)
#define PG8_SB(b, h) ((4 + (b) * 2 + (h)) * HTB)
#define PG8_STAGE(bufoff, gbase, voff) do { _Pragma("unroll") for (int _i = 0; _i < 2; ++_i) \
        __builtin_amdgcn_global_load_lds((const unsigned*)((const char*)(gbase) + (voff)[_i]), (PG8_LAS unsigned*)(lds + (bufoff) + ldsw + _i * 8192), 16, 0, 0); } while (0)
#define PG8_LDA(dst, b, h) do { _Pragma("unroll") for (int m = 0; m < 4; ++m) _Pragma("unroll") for (int k = 0; k < 2; ++k) dst[m][k] = *(const PG8_LAS bf16x8*)(lds + PG8_SA(b, h) + aoff + m * 2048 + k * 1024); } while (0)
#define PG8_LDB(dst, b, h) do { _Pragma("unroll") for (int n = 0; n < 2; ++n) _Pragma("unroll") for (int k = 0; k < 2; ++k) dst[n][k] = *(const PG8_LAS bf16x8*)(lds + PG8_SB(b, h) + boff + n * 2048 + k * 1024); } while (0)
#define PG8_MMA(ai, bj, At, Bt) do { __builtin_amdgcn_s_setprio(1); _Pragma("unroll") for (int m = 0; m < 4; ++m) _Pragma("unroll") for (int n = 0; n < 2; ++n) _Pragma("unroll") for (int k = 0; k < 2; ++k) \
        acc[ai][bj][m][n] = __builtin_amdgcn_mfma_f32_16x16x32_bf16(Bt[n][k], At[m][k], acc[ai][bj][m][n], 0, 0, 0); __builtin_amdgcn_s_setprio(0); } while (0)
#define PG8_WAIT_V(n) asm volatile("s_waitcnt vmcnt(" #n ")" ::: "memory")
#define PG8_WAIT_L(n) asm volatile("s_waitcnt lgkmcnt(" #n ")" ::: "memory")
#define PG8_BAR __builtin_amdgcn_s_barrier()
#define PG8_SCHED __builtin_amdgcn_sched_barrier(0)
    Unit cur, nxt; int ui = 0;
    if (!S.next(0, cur)) return;
    f32x4 acc[2][2][4][2];
#pragma unroll
    for (int a = 0; a < 2; ++a)
#pragma unroll
        for (int b = 0; b < 2; ++b)
#pragma unroll
            for (int m = 0; m < 4; ++m)
#pragma unroll
                for (int n = 0; n < 2; ++n) acc[a][b][m][n] = (f32x4){0.f, 0.f, 0.f, 0.f};
    bf16x8 At[4][2], B0[2][2], B1[2][2];
    const char* cA = (const char*)g.A + (size_t)cur.pm * tstepA + (size_t)cur.pn * g.a_pn_off * 2; const char* cB = (const char*)g.Bt + (size_t)cur.pn * tstepB;
    S.a_ready(cur);
    if constexpr (SP2) {
        PG8_STAGE(PG8_SB(0, 0), cB, voffB); PG8_STAGE(PG8_SB(0, 1), cB + hstepB, voffB); PG8_STAGE(PG8_SA(0, 0), cA, voffA); PG8_STAGE(PG8_SA(0, 1), cA + hstepA, voffA);
        if (wr == 1) PG8_BAR;
        PG8_WAIT_V(2); PG8_BAR;
        PG8_STAGE(PG8_SB(1, 0), cB + kstep, voffB); PG8_STAGE(PG8_SA(1, 0), cA + kstep, voffA); PG8_STAGE(PG8_SB(1, 1), cB + hstepB + kstep, voffB);
        PG8_WAIT_V(6); PG8_BAR;
    } else {
        PG8_STAGE(PG8_SB(0, 0), cB, voffB); PG8_STAGE(PG8_SA(0, 0), cA, voffA); PG8_STAGE(PG8_SB(0, 1), cB + hstepB, voffB); PG8_STAGE(PG8_SA(0, 1), cA + hstepA, voffA);
        if (wr == 1) PG8_BAR;
        PG8_WAIT_V(4); PG8_BAR;
        PG8_STAGE(PG8_SB(1, 0), cB + kstep, voffB); PG8_STAGE(PG8_SA(1, 0), cA + kstep, voffA); PG8_STAGE(PG8_SB(1, 1), cB + hstepB + kstep, voffB);
        PG8_WAIT_V(6); PG8_BAR;
    }
    for (;;) {
        const bool has_next = S.next(ui + 1, nxt);
        const char* nA = has_next ? (const char*)g.A + (size_t)nxt.pm * tstepA + (size_t)nxt.pn * g.a_pn_off * 2 : cA; const char* nB = has_next ? (const char*)g.Bt + (size_t)nxt.pn * tstepB : cB;
        for (int t = 0; t < nt; t += 2) {
            const bool last = (t == nt - 2);
            const char* a1 = cA + (size_t)(t + 1) * kstep;
            const char* a2 = last ? nA : cA + (size_t)(t + 2) * kstep; const char* b2 = last ? nB : cB + (size_t)(t + 2) * kstep;
            const char* a3 = a2 + kstep; const char* b3 = b2 + kstep;
            if (last && has_next) S.a_ready(nxt);
            if constexpr (SP2) {
            PG8_LDB(B0, 0, 0); PG8_LDB(B1, 0, 1); PG8_SCHED; PG8_LDA(At, 0, 0); PG8_STAGE(PG8_SA(1, 1), a1 + hstepA, voffA);
            PG8_WAIT_V(8); PG8_WAIT_L(0); PG8_BAR; PG8_MMA(0, 0, At, B0); PG8_MMA(0, 1, At, B1); PG8_BAR; PG8_SCHED;
            PG8_LDA(At, 0, 1); PG8_STAGE(PG8_SB(0, 0), b2, voffB); PG8_STAGE(PG8_SB(0, 1), b2 + hstepB, voffB); PG8_STAGE(PG8_SA(0, 0), a2, voffA);
            PG8_WAIT_V(8); PG8_WAIT_L(0); PG8_BAR; PG8_MMA(1, 0, At, B0); PG8_MMA(1, 1, At, B1); PG8_BAR; PG8_SCHED;
            PG8_LDB(B0, 1, 0); PG8_LDB(B1, 1, 1); PG8_SCHED; PG8_LDA(At, 1, 0); PG8_STAGE(PG8_SA(0, 1), a2 + hstepA, voffA);
            PG8_WAIT_V(8); PG8_WAIT_L(0); PG8_BAR; PG8_MMA(0, 0, At, B0); PG8_MMA(0, 1, At, B1); PG8_BAR; PG8_SCHED;
            PG8_LDA(At, 1, 1); PG8_STAGE(PG8_SB(1, 0), b3, voffB); PG8_STAGE(PG8_SB(1, 1), b3 + hstepB, voffB); PG8_STAGE(PG8_SA(1, 0), a3, voffA);
            PG8_WAIT_V(8); PG8_WAIT_L(0); PG8_BAR; PG8_MMA(1, 0, At, B0); PG8_MMA(1, 1, At, B1); PG8_BAR; PG8_SCHED;
            } else {
            PG8_LDB(B0, 0, 0); PG8_SCHED; PG8_LDA(At, 0, 0); PG8_STAGE(PG8_SA(1, 1), a1 + hstepA, voffA);
            PG8_WAIT_L(8); PG8_BAR; PG8_WAIT_L(0); PG8_MMA(0, 0, At, B0); PG8_BAR; PG8_SCHED;
            PG8_LDB(B1, 0, 1); PG8_STAGE(PG8_SB(0, 0), b2, voffB);
            PG8_BAR; PG8_WAIT_L(0); PG8_MMA(0, 1, At, B1); PG8_BAR;
            PG8_LDA(At, 0, 1); PG8_STAGE(PG8_SA(0, 0), a2, voffA);
            PG8_BAR; PG8_WAIT_L(0); PG8_MMA(1, 0, At, B0); PG8_BAR; PG8_SCHED;
            PG8_STAGE(PG8_SB(0, 1), b2 + hstepB, voffB);
            PG8_WAIT_V(6); PG8_BAR; PG8_MMA(1, 1, At, B1); PG8_BAR;
            PG8_LDB(B0, 1, 0); PG8_SCHED; PG8_LDA(At, 1, 0); PG8_STAGE(PG8_SA(0, 1), a2 + hstepA, voffA);
            PG8_WAIT_L(8); PG8_BAR; PG8_WAIT_L(0); PG8_MMA(0, 0, At, B0); PG8_BAR; PG8_SCHED;
            PG8_LDB(B1, 1, 1); PG8_STAGE(PG8_SB(1, 0), b3, voffB);
            PG8_BAR; PG8_WAIT_L(0); PG8_MMA(0, 1, At, B1); PG8_BAR;
            PG8_LDA(At, 1, 1); PG8_STAGE(PG8_SA(1, 0), a3, voffA);
            PG8_BAR; PG8_WAIT_L(0); PG8_MMA(1, 0, At, B0); PG8_BAR; PG8_SCHED;
            PG8_STAGE(PG8_SB(1, 1), b3 + hstepB, voffB);
            PG8_WAIT_V(6); PG8_BAR; PG8_MMA(1, 1, At, B1); PG8_BAR;
            }
        }
        if constexpr (ALIGN_EPI) { if (wr == 0) PG8_BAR; }
        if constexpr (!Epi::AFTER_DRAIN) { E(acc, cur, wr, wc, fr, fq); S.done(cur); }
        if (!has_next) break;
#pragma unroll
        for (int a = 0; a < 2; ++a)
#pragma unroll
            for (int b = 0; b < 2; ++b)
#pragma unroll
                for (int m = 0; m < 4; ++m)
#pragma unroll
                    for (int n = 0; n < 2; ++n) acc[a][b][m][n] = (f32x4){0.f, 0.f, 0.f, 0.f};
        cur = nxt; cA = nA; cB = nB; ++ui;
        if constexpr (ALIGN_EPI) { if (wr == 1) PG8_BAR; }
    }
    PG8_WAIT_V(0);
    if constexpr (!ALIGN_EPI) { if (wr == 0) PG8_BAR; }
    PG8_BAR;
    if constexpr (Epi::AFTER_DRAIN) { E.fused(acc, cur, wr, wc, fr, fq, lds, wid, lane); S.done(cur); }
#undef PG8_SA
#undef PG8_SB
#undef PG8_STAGE
#undef PG8_LDA
#undef PG8_LDB
#undef PG8_MMA
#undef PG8_WAIT_V
#undef PG8_WAIT_L
#undef PG8_BAR
#undef PG8_SCHED
}
}
#include <hip/hip_bf16.h>
#include <cmath>
#define GAS __attribute__((address_space(1)))
#define LAS __attribute__((address_space(3)))
typedef unsigned short bf16;
typedef unsigned v4u __attribute__((ext_vector_type(4)));
typedef float f32x4 __attribute__((ext_vector_type(4)));
typedef short bf16x8 __attribute__((ext_vector_type(8)));
typedef float f32x16 __attribute__((ext_vector_type(16)));

constexpr int NWAVES = 8, NTHR = 512;
constexpr int BATCH = 2, SEQ = 8192, D = 1024, M = BATCH * SEQ, DFF = 2816, DEPTH = 2;
constexpr int INW = 7176;
constexpr size_t MiB = 1u << 20;
constexpr size_t WS_SS = 0, CTL_ZERO_BYTES = 1 * MiB;
constexpr size_t WS_WFL = 1 * MiB;
constexpr size_t WS_WAT = 1 * MiB + 256 * 1024, WS_WXT = 1 * MiB + 512 * 1024;
constexpr size_t WS_SUMM = 2 * MiB;
constexpr size_t WS_LOGF = 3 * MiB, WS_CTIL = 3 * MiB + 512 * 1024;
constexpr size_t WS_KPART = 7 * MiB;
constexpr size_t WS_MEMN = 4 * MiB, WS_KX = 5 * MiB, WS_VT = 6 * MiB;
constexpr size_t WS_W1IN = 8 * MiB, WS_W1OUT = 19 * MiB, WS_WIN = 25 * MiB, WS_WG = 33 * MiB, WS_UA = 39 * MiB, WS_UB = 40 * MiB, WS_UC = 42 * MiB,
                 WS_WO = 43 * MiB, WS_WXQ = 45 * MiB, WS_WXKV = 47 * MiB, WS_WXO = 51 * MiB, WS_W2IN = 53 * MiB, WS_W2OUT = 64 * MiB;
constexpr size_t WS_XB = 70 * MiB;
constexpr size_t WS_Q = 102 * MiB, WS_GG = 118 * MiB, WS_XA = 150 * MiB, WS_XL = 166 * MiB, WS_K = 198 * MiB, WS_V = 214 * MiB;
constexpr size_t WS_H = 102 * MiB;
constexpr size_t WS_YC = 150 * MiB;
constexpr size_t WS_STASH = 166 * MiB, WS_MG = 198 * MiB, WS_QX = 150 * MiB, WS_PBUF = 198 * MiB;
constexpr size_t WS_YA = 230 * MiB, WS_SSP = 246 * MiB, WS_END = 255 * MiB;
constexpr int LDS_BYTES = 147456;

__device__ __forceinline__ unsigned f2bf(float f) { unsigned u = __builtin_bit_cast(unsigned, f); return (u + 0x7fffu + ((u >> 16) & 1u)) >> 16; }
__device__ __forceinline__ unsigned pk2(float lo, float hi) { return f2bf(lo) | (f2bf(hi) << 16); }
__device__ __forceinline__ float bf2f(unsigned short v) { return __uint_as_float((unsigned)v << 16); }
__device__ __forceinline__ float bperm(float v, int srclane) { return __int_as_float(__builtin_amdgcn_ds_bpermute(srclane << 2, __float_as_int(v))); }
__device__ __forceinline__ float wave_sum(float v, int lane) {
#pragma unroll
    for (int o = 1; o < 64; o <<= 1) v += bperm(v, lane ^ o);
    return v;
}
__device__ __forceinline__ float flog1p(float e) { return e < 0.01f ? e * (1.f - e * (0.5f - e * 0.33333334f)) : __logf(1.f + e); }
#define LDS_WAIT() asm volatile("s_waitcnt lgkmcnt(0)" ::: "memory")

__device__ __forceinline__ void tr_item(const float* W, int ldn, int col0, int k0, const float* g, bf16* WT, int ldk, int drow0, LAS float* scr, int lane) {
    const int n4 = (lane & 15) * 4, kr = lane >> 4;
#pragma unroll
    for (int i = 0; i < 16; ++i) { const int kk = 4 * i + kr; f32x4 v = *(const f32x4*)(W + (size_t)(k0 + kk) * ldn + col0 + n4); if (g) v = v * g[k0 + kk];
        LAS float* d = scr + kk * 65 + n4; d[0] = v.x; d[1] = v.y; d[2] = v.z; d[3] = v.w; }
    LDS_WAIT(); asm volatile("" ::: "memory");
    const int c = lane & 7;
#pragma unroll
    for (int j = 0; j < 8; ++j) { const int n = (lane >> 3) + 8 * j; const LAS float* s = scr + (8 * c) * 65 + n;
        v4u o; o.x = pk2(s[0 * 65], s[1 * 65]); o.y = pk2(s[2 * 65], s[3 * 65]); o.z = pk2(s[4 * 65], s[5 * 65]); o.w = pk2(s[6 * 65], s[7 * 65]);
        *(v4u*)(WT + (size_t)(drow0 + n) * ldk + k0 + 8 * c) = o; }
    LDS_WAIT(); asm volatile("" ::: "memory");
}

#define RLX_AGENT __ATOMIC_RELAXED, __HIP_MEMORY_SCOPE_AGENT
#define XB_TMO      128
#define XB_XCNT(j)  (256  + 64 * (j))
#define XB_XSUB(j)  (1280 + 64 * (j))
#define XB_XGEN(j)  (2304 + 64 * (j))
#define XB_TOP      3328
#define XB_TOPGEN   3392
#define XCD_BAR_WORDS 3456
#define XB_SPIN_CAP (1u << 18)

__device__ __forceinline__ unsigned xb_ld(unsigned* p)              { return __hip_atomic_load(p, __ATOMIC_RELAXED, __HIP_MEMORY_SCOPE_AGENT); }
__device__ __forceinline__ unsigned xb_add(unsigned* p, unsigned v) { return __hip_atomic_fetch_add(p, v, __ATOMIC_RELAXED, __HIP_MEMORY_SCOPE_AGENT); }
__device__ __forceinline__ unsigned xb_xcc_id() { return (unsigned)__builtin_amdgcn_s_getreg((3 << 11) | 20) & 0xFu; }
#define XB_SPIN(cond, bar) do { unsigned _sp = 0; while (cond) { __builtin_amdgcn_s_sleep(1); \
    if ((++_sp & 255u) == 0u) { if (xb_ld(&(bar)[XB_TMO])) break; if (_sp > XB_SPIN_CAP) { atomicAdd(&(bar)[XB_TMO], 1u); break; } } } } while (0)

struct XcdBarrier {
    unsigned* bar; unsigned x;
    volatile LAS unsigned* st;
};

__device__ __forceinline__ XcdBarrier xcd_barrier_post(unsigned* bar, volatile LAS unsigned* st) {
    XcdBarrier b; b.bar = bar; b.x = xb_xcc_id(); b.st = st;
    if (threadIdx.x == 0) (void)xb_add(&bar[XB_XCNT(b.x)], 1u);
    return b;
}
__device__ __forceinline__ void xcd_barrier_complete(unsigned* bar, unsigned x, unsigned& nloc, unsigned& nx) {
    const unsigned G = gridDim.x * gridDim.y * gridDim.z;
    unsigned sum, cnt, mine, sp = 0u;
    for (;;) {
        sum = 0u; cnt = 0u; mine = 0u;
#pragma unroll
        for (unsigned j = 0; j < 16; ++j) { const unsigned c = xb_ld(&bar[XB_XCNT(j)]); sum += c; cnt += (c > 0u) ? 1u : 0u; mine = (j == x) ? c : mine; }
        if (sum == G) break;
        __builtin_amdgcn_s_sleep(1);
        if ((++sp & 255u) == 0u) { if (xb_ld(&bar[XB_TMO])) break; if (sp > XB_SPIN_CAP) { atomicAdd(&bar[XB_TMO], 1u); break; } }
    }
    nloc = mine > 0u ? mine : 1u; nx = cnt > 0u ? cnt : 1u;
}

__device__ __forceinline__ void xcd_barrier(const XcdBarrier& b) {
    asm volatile("s_waitcnt vmcnt(0)" ::: "memory");
    __syncthreads();
    if (threadIdx.x == 0) {
        unsigned* bar = b.bar;
        __builtin_amdgcn_s_waitcnt(0);
        unsigned nloc = b.st[0], nx = b.st[1];
        if (nloc == 0u) { xcd_barrier_complete(bar, b.x, nloc, nx); b.st[0] = nloc; b.st[1] = nx; }
        const unsigned old = xb_add(&bar[XB_XSUB(b.x)], 1u);
        const unsigned gen = old / nloc;
        if (old + 1u == (gen + 1u) * nloc) {
            __builtin_amdgcn_fence(__ATOMIC_RELEASE, "agent");
            asm volatile("s_waitcnt vmcnt(0)" ::: "memory");
            const unsigned og = xb_add(&bar[XB_TOP], 1u);
            const unsigned tg = og / nx;
            if (og + 1u == (tg + 1u) * nx) xb_add(&bar[XB_TOPGEN], 1u);
            else XB_SPIN(xb_ld(&bar[XB_TOPGEN]) == tg, bar);
            __builtin_amdgcn_fence(__ATOMIC_ACQUIRE, "agent");
            xb_add(&bar[XB_XGEN(b.x)], 1u);
            asm volatile("s_waitcnt vmcnt(0)" ::: "memory");
        } else {
            XB_SPIN(xb_ld(&bar[XB_XGEN(b.x)]) == gen, bar);
            __builtin_amdgcn_fence(__ATOMIC_ACQUIRE, "agent");
            asm volatile("s_waitcnt vmcnt(0)" ::: "memory");
        }
    }
    __syncthreads();
}

struct Args { const float* in[31]; float* out; unsigned char* ws; int pad[2]; };
typedef LAS unsigned long long* PtrTab;
__device__ __forceinline__ const float* tab_in(PtrTab tb, int k) { const unsigned long long v = tb[k]; const unsigned lo = __builtin_amdgcn_readfirstlane((unsigned)v), hi = __builtin_amdgcn_readfirstlane((unsigned)(v >> 32));
    return (const float*)(const GAS float*)(((unsigned long long)hi << 32) | lo); }
constexpr int TAB_OFF = 147456 - 512;
constexpr size_t WS_BAR = 768 * 1024;

__device__ __forceinline__ void phase_prologue(PtrTab TB, unsigned char* ws, float* xout, int l, LAS unsigned char* lds, int gw, int NGW, int lane, int wave) {
    LAS float* scr = (LAS float*)(lds + wave * 16640);
#define g1 (tab_in(TB, 2) + l * D)
#define w1i (tab_in(TB, 3) + (size_t)l * D * 2 * DFF)
#define w1o (tab_in(TB, 4) + (size_t)l * DFF * D)
#define gm (tab_in(TB, 5) + l * D)
#define win (tab_in(TB, 6) + (size_t)l * D * INW)
#define wpool (tab_in(TB, 9) + (size_t)l * 4 * 128 * 128)
#define psc (tab_in(TB, 10) + l * 512)
#define wua (tab_in(TB, 11) + (size_t)l * 512 * D)
#define wra (tab_in(TB, 14) + (size_t)l * 8 * 128 * 128)
#define wrx (tab_in(TB, 16) + (size_t)l * 8 * 128 * 128)
#define wub (tab_in(TB, 19) + (size_t)l * D * D)
#define wuc (tab_in(TB, 20) + (size_t)l * 512 * D)
#define wo (tab_in(TB, 21) + (size_t)l * D * D)
#define gc (tab_in(TB, 22) + l * D)
#define gmem (tab_in(TB, 23) + l * D)
#define wxq (tab_in(TB, 24) + (size_t)l * D * D)
#define wxkv (tab_in(TB, 25) + (size_t)l * D * 2 * D)
#define wxo (tab_in(TB, 26) + (size_t)l * D * D)
#define g2 (tab_in(TB, 27) + l * D)
#define w2i (tab_in(TB, 28) + (size_t)l * D * 2 * DFF)
#define w2o (tab_in(TB, 29) + (size_t)l * DFF * D)
    constexpr int I_FI = 16 * 88, I_FO = 44 * 16, I_WIN = 16 * 64, I_WG = 16 * 48, I_UB = 16 * 16, I_UC = 8 * 16, I_RG = 32, I_SQ = 16 * 16, I_KV = 16 * 32;
    constexpr int S0 = 0, S1 = S0 + I_FI, S2 = S1 + I_FO, S3 = S2 + I_WIN, S4 = S3 + I_WG, S5 = S4 + I_UB, S6 = S5 + I_UC, S7 = S6 + I_RG, S8 = S7 + I_RG, S9 = S8 + I_SQ, S10 = S9 + I_SQ,
                  S11 = S10 + I_KV, S12 = S11 + I_SQ, S13 = S12 + I_FI, S14 = S13 + I_FO;
    for (int it = gw; it < S14; it += NGW) {
        if (it < S1 || (it >= S12 && it < S13)) {
            const bool second = it >= S12; const int r = second ? it - S12 : it; const int kb = r / 88, nb = r % 88; const int n = nb * 64;
            const int half = n >= DFF ? 1 : 0, nn = n - half * DFF; const int drow = (nn >> 7) * 256 + half * 128 + (nn & 127);
            tr_item(second ? w2i : w1i, 2 * DFF, n, kb * 64, second ? g2 : g1, (bf16*)(ws + (second ? WS_W2IN : WS_W1IN)), D, drow, scr, lane);
        } else if (it < S2 || it >= S13) {
            const bool second = it >= S13; const int r = second ? it - S13 : it - S1; const int kb = r / 16, nb = r % 16;
            tr_item(second ? w2o : w1o, D, nb * 64, kb * 64, nullptr, (bf16*)(ws + (second ? WS_W2OUT : WS_W1OUT)), DFF, nb * 64, scr, lane);
        } else if (it < S3) { const int r = it - S2, kb = r / 64, nb = r % 64; tr_item(win, INW, nb * 64, kb * 64, gm, (bf16*)(ws + WS_WIN), D, nb * 64, scr, lane);
        } else if (it < S4) { const int r = it - S3, kb = r / 48, nb = r % 48; tr_item(win, INW, 4104 + nb * 64, kb * 64, gm, (bf16*)(ws + WS_WG), D, nb * 64, scr, lane);
        } else if (it < S5) { const int r = it - S4, kb = r / 16, nb = r % 16; tr_item(wub, D, nb * 64, kb * 64, nullptr, (bf16*)(ws + WS_UB), D, nb * 64, scr, lane);
        } else if (it < S6) { const int r = it - S5, kb = r / 16, nb = r % 16; tr_item(wuc, D, nb * 64, kb * 64, nullptr, (bf16*)(ws + WS_UC), 512, nb * 64, scr, lane);
        } else if (it < S8) { const bool xg = it >= S7; const int r = xg ? it - S7 : it - S6; const int hh = r >> 2, kb = (r >> 1) & 1, nb = r & 1;
            tr_item((xg ? wrx : wra) + hh * 16384, 128, nb * 64, kb * 64, nullptr, (bf16*)(ws + (xg ? WS_WXT : WS_WAT)) + hh * 16384, 128, nb * 64, scr, lane);
        } else if (it < S9) { const int r = it - S8, kb = r / 16, nb = r % 16; tr_item(wo, D, nb * 64, kb * 64, nullptr, (bf16*)(ws + WS_WO), D, nb * 64, scr, lane);
        } else if (it < S10) { const int r = it - S9, kb = r / 16, nb = r % 16; tr_item(wxq, D, nb * 64, kb * 64, gc, (bf16*)(ws + WS_WXQ), D, nb * 64, scr, lane);
        } else if (it < S11) { const int r = it - S10, kb = r / 32, nb = r % 32; tr_item(wxkv, 2 * D, nb * 64, kb * 64, nullptr, (bf16*)(ws + WS_WXKV), D, nb * 64, scr, lane);
        } else { const int r = it - S11, kb = r / 16, nb = r % 16; tr_item(wxo, D, nb * 64, kb * 64, nullptr, (bf16*)(ws + WS_WXO), D, nb * 64, scr, lane); }
    }
    { bf16* UaT = (bf16*)(ws + WS_UA);
      for (int it = gw; it < 4 * 16 * 16; it += NGW) { const int g = it >> 8, nblk = (it >> 4) & 15, c0 = (it & 15) * 8, n = nblk * 64 + lane;
          const float* wp = wpool + ((size_t)g * 128 + c0) * 128; const float* sc = psc + g * 128; const float* ua = wua + (size_t)(g * 128) * D + n; float acc[8];
#pragma unroll
          for (int c = 0; c < 8; ++c) acc[c] = 0.f;
#pragma unroll 16
          for (int j = 0; j < 128; ++j) { const float u = ua[(size_t)j * D] * sc[j];
#pragma unroll
              for (int c = 0; c < 8; ++c) acc[c] += wp[c * 128 + j] * u; }
          v4u o; o.x = pk2(acc[0], acc[1]); o.y = pk2(acc[2], acc[3]); o.z = pk2(acc[4], acc[5]); o.w = pk2(acc[6], acc[7]);
          *(v4u*)(UaT + (size_t)n * 512 + g * 128 + c0) = o; } }
    { float* wfl = (float*)(ws + WS_WFL);
      for (int it = gw * 64 + lane; it < 8 * 1024; it += NGW * 64) { const int h = it >> 10, k = it & 1023; wfl[it] = gm[k] * win[(size_t)k * INW + 4096 + h]; } }
    { const float* mem = tab_in(TB, 1); bf16* mn = (bf16*)(ws + WS_MEMN);
      for (int r = gw; r < 512; r += NGW) { const f32x4* xr = (const f32x4*)(mem + (size_t)r * D) + lane; f32x4 v[4]; float s = 0.f;
#pragma unroll
          for (int j = 0; j < 4; ++j) { v[j] = xr[64 * j]; s += (v[j].x * v[j].x + v[j].y * v[j].y) + (v[j].z * v[j].z + v[j].w * v[j].w); }
          const float rs = rsqrtf(wave_sum(s, lane) * (1.f / D) + 1e-6f); unsigned long long* o8 = (unsigned long long*)(mn + (size_t)r * D) + lane;
#pragma unroll
          for (int j = 0; j < 4; ++j) { const f32x4 gv = *((const f32x4*)gmem + lane + 64 * j);
              o8[64 * j] = (unsigned long long)pk2(v[j].x * rs * gv.x, v[j].y * rs * gv.y) | ((unsigned long long)pk2(v[j].z * rs * gv.z, v[j].w * rs * gv.w) << 32); } } }
    if (l == 0) {
        const float* x = tab_in(TB, 0); float* xo = xout; bf16* xb = (bf16*)(ws + WS_XB); float* ss = (float*)(ws + WS_SSP);
        for (int r = gw; r < M; r += NGW) { const f32x4* xr = (const f32x4*)(x + (size_t)r * D) + lane; f32x4* orow = (f32x4*)(xo + (size_t)r * D) + lane; f32x4 v[4]; float s = 0.f;
#pragma unroll
            for (int j = 0; j < 4; ++j) { v[j] = xr[64 * j]; orow[64 * j] = v[j]; s += (v[j].x * v[j].x + v[j].y * v[j].y) + (v[j].z * v[j].z + v[j].w * v[j].w); }
            s = wave_sum(s, lane); if (lane < 4) ss[(size_t)r * 4 + lane] = lane == 0 ? s : 0.f; unsigned long long* o8 = (unsigned long long*)(xb + (size_t)r * D) + lane;
#pragma unroll
            for (int j = 0; j < 4; ++j) o8[64 * j] = (unsigned long long)pk2(v[j].x, v[j].y) | ((unsigned long long)pk2(v[j].z, v[j].w) << 32); }
    }
}
#undef g1
#undef w1i
#undef w1o
#undef gm
#undef win
#undef wpool
#undef psc
#undef wua
#undef wra
#undef wrx
#undef wub
#undef wuc
#undef wo
#undef gc
#undef gmem
#undef wxq
#undef wxkv
#undef wxo
#undef g2
#undef w2i
#undef w2o
__device__ __forceinline__ void phase_fl(const bf16* xb, const float* wfl, const float* bfv, const float* ss, float* logf, int gw, int NGW, int lane) {
    for (int r = gw; r < M; r += NGW) {
        float acc[8];
#pragma unroll
        for (int h = 0; h < 8; ++h) acc[h] = 0.f;
#pragma unroll
        for (int j = 0; j < 2; ++j) { const int k0 = 8 * lane + 512 * j; const v4u xv = *(const v4u*)(xb + (size_t)r * D + k0);
            float xf[8]; xf[0] = __uint_as_float(xv.x << 16); xf[1] = __uint_as_float(xv.x & 0xffff0000u); xf[2] = __uint_as_float(xv.y << 16); xf[3] = __uint_as_float(xv.y & 0xffff0000u);
            xf[4] = __uint_as_float(xv.z << 16); xf[5] = __uint_as_float(xv.z & 0xffff0000u); xf[6] = __uint_as_float(xv.w << 16); xf[7] = __uint_as_float(xv.w & 0xffff0000u);
#pragma unroll
            for (int h = 0; h < 8; ++h) { const f32x4 w0 = *(const f32x4*)(wfl + h * 1024 + k0), w1 = *(const f32x4*)(wfl + h * 1024 + k0 + 4);
                acc[h] += (xf[0] * w0.x + xf[1] * w0.y) + (xf[2] * w0.z + xf[3] * w0.w) + (xf[4] * w1.x + xf[5] * w1.y) + (xf[6] * w1.z + xf[7] * w1.w); } }
        const float rs = pg8::rstd_of(ss, r);
        float v4[4], v2[2], v1;
        { const bool up = (lane & 32) != 0;
#pragma unroll
          for (int i = 0; i < 4; ++i) { const float mine = up ? acc[4 + i] : acc[i], other = up ? acc[i] : acc[4 + i]; v4[i] = mine + bperm(other, lane ^ 32); } }
        { const bool up = (lane & 16) != 0;
#pragma unroll
          for (int i = 0; i < 2; ++i) { const float mine = up ? v4[2 + i] : v4[i], other = up ? v4[i] : v4[2 + i]; v2[i] = mine + bperm(other, lane ^ 16); } }
        { const bool up = (lane & 8) != 0; const float mine = up ? v2[1] : v2[0], other = up ? v2[0] : v2[1]; v1 = mine + bperm(other, lane ^ 8); }
        v1 += bperm(v1, lane ^ 4); v1 += bperm(v1, lane ^ 2); v1 += bperm(v1, lane ^ 1);
        { const int h = ((lane >> 5) & 1) * 4 + ((lane >> 4) & 1) * 2 + ((lane >> 3) & 1); const float z = v1 * rs + bfv[h]; const float ls = -(fmaxf(-z, 0.f) + flog1p(__expf(-fabsf(z)))); if ((lane & 7) == 0) logf[(size_t)r * 8 + h] = ls; }
    }
}
__device__ __forceinline__ void cumsum_bh(const float* logf, float* ctil, int bh, LAS float* red) {
    int tid_o = threadIdx.x; asm volatile("" : "+v"(tid_o)); const int tid = tid_o, lane = tid & 63, wid = tid >> 6;
    const int b = bh >> 3, h = bh & 7; const float* src = logf + ((size_t)b * SEQ + 16 * tid) * 8 + h; float v[16]; float s = 0.f;
#pragma unroll
    for (int i = 0; i < 16; ++i) { v[i] = src[(size_t)i * 8]; s += v[i]; }
    float incl = s;
#pragma unroll
    for (int o = 1; o < 64; o <<= 1) { const float t = bperm(incl, lane - o); if (lane >= o) incl += t; }
    if (lane == 63) red[wid] = incl;
    __syncthreads();
    float base = 0.f;
#pragma unroll
    for (int w = 0; w < 8; ++w) if (w < wid) base += red[w];
    float run = base + incl - s; float* dst = ctil + (size_t)bh * SEQ + 16 * tid;
#pragma unroll
    for (int i = 0; i < 16; ++i) { run += v[i]; dst[i] = run * 1.4426950408889634f; }
    __syncthreads();
}
__device__ __forceinline__ void unpk8(const v4u xv, float (&xf)[8]) { xf[0] = __uint_as_float(xv.x << 16); xf[1] = __uint_as_float(xv.x & 0xffff0000u); xf[2] = __uint_as_float(xv.y << 16); xf[3] = __uint_as_float(xv.y & 0xffff0000u);
    xf[4] = __uint_as_float(xv.z << 16); xf[5] = __uint_as_float(xv.z & 0xffff0000u); xf[6] = __uint_as_float(xv.w << 16); xf[7] = __uint_as_float(xv.w & 0xffff0000u); }
template <int W> __device__ __forceinline__ void pool_item(const bf16* xa, bf16* ya, int m0, int cgi) {
    const int t0 = m0 & (SEQ - 1); v4u rw[W + 7];
#pragma unroll
    for (int a = 0; a < W + 7; ++a) { const int tl = a - (W - 1); rw[a] = (t0 + tl >= 0) ? *(const v4u*)(xa + (size_t)(m0 + tl) * 512 + 8 * cgi) : (v4u){0u, 0u, 0u, 0u}; }
    float s[8];
#pragma unroll
    for (int i = 0; i < 8; ++i) s[i] = 0.f;
#pragma unroll
    for (int a = 0; a < W - 1; ++a) { float xf[8]; unpk8(rw[a], xf);
#pragma unroll
        for (int i = 0; i < 8; ++i) s[i] += xf[i]; }
#pragma unroll
    for (int o = 0; o < 8; ++o) { float cur[8]; unpk8(rw[o + W - 1], cur);
#pragma unroll
        for (int i = 0; i < 8; ++i) s[i] += cur[i];
        const int t = t0 + o, cnt = (t + 1 < W) ? t + 1 : W; const float ic = 1.f / (float)cnt; v4u ov;
        ov.x = pk2(s[0] * ic - cur[0], s[1] * ic - cur[1]); ov.y = pk2(s[2] * ic - cur[2], s[3] * ic - cur[3]); ov.z = pk2(s[4] * ic - cur[4], s[5] * ic - cur[5]); ov.w = pk2(s[6] * ic - cur[6], s[7] * ic - cur[7]);
        *(v4u*)(ya + (size_t)(m0 + o) * 512 + 8 * cgi) = ov;
        float old[8]; unpk8(rw[o], old);
#pragma unroll
        for (int i = 0; i < 8; ++i) s[i] -= old[i]; }
}
__device__ __forceinline__ void phase_pool(const bf16* xa, bf16* ya, int gtid, int nthr) {
    for (int idx = gtid; idx < (M / 8) * 64; idx += nthr) { const int c16 = idx & 15, rl = (idx >> 4) & 3, g = (idx >> 6) & 3, rh = idx >> 8; const int m0 = (rh * 4 + rl) * 8, cgi = g * 16 + c16;
        if (g == 0) pool_item<2>(xa, ya, m0, cgi); else if (g == 1) pool_item<4>(xa, ya, m0, cgi); else if (g == 2) pool_item<8>(xa, ya, m0, cgi); else pool_item<16>(xa, ya, m0, cgi); }
}
__device__ __forceinline__ int crow16(int r, int hi) { return (r & 3) + 8 * (r >> 2) + 4 * hi; }
template <bool FINAL>
__device__ __forceinline__ void lru_item(LAS unsigned char* lds, int b, int hp, int ck, const bf16* xl, bf16* gg, const float* cw, const float* cb, const bf16* WaT, const bf16* WxT,
                                         const float* ba, const float* bx, const float* lam, float* summ) {
    int tid_o = threadIdx.x; asm volatile("" : "+v"(tid_o)); const int tid = tid_o, lane = tid & 63, wid = tid >> 6, r32 = lane & 31, hi = lane >> 5;
    const int t0 = ck * 128; const size_t m0 = (size_t)b * SEQ + t0; const int ch0 = hp * 256;
    constexpr int XP = 264;
    LAS bf16* xc = (LAS bf16*)lds; LAS float* h0s = (LAS float*)(lds + 128 * XP * 2);
    {
        const int cgi = tid & 31, tq = tid >> 5, c = ch0 + 8 * cgi;
        float w[4][8], bb[8];
#pragma unroll
        for (int k = 0; k < 4; ++k) { const f32x4 a = *(const f32x4*)(cw + k * 1024 + c), d = *(const f32x4*)(cw + k * 1024 + c + 4); w[k][0] = a.x; w[k][1] = a.y; w[k][2] = a.z; w[k][3] = a.w; w[k][4] = d.x; w[k][5] = d.y; w[k][6] = d.z; w[k][7] = d.w; }
        { const f32x4 a = *(const f32x4*)(cb + c), d = *(const f32x4*)(cb + c + 4); bb[0] = a.x; bb[1] = a.y; bb[2] = a.z; bb[3] = a.w; bb[4] = d.x; bb[5] = d.y; bb[6] = d.z; bb[7] = d.w; }
        v4u rw[11];
#pragma unroll
        for (int i = 0; i < 11; ++i) { const int tl = tq * 8 - 3 + i; rw[i] = (t0 + tl >= 0) ? *(const v4u*)(xl + (size_t)((long)m0 + tl) * 1024 + c) : (v4u){0u, 0u, 0u, 0u}; }
#pragma unroll
        for (int o = 0; o < 8; ++o) { float y[8];
#pragma unroll
            for (int j = 0; j < 8; ++j) y[j] = bb[j];
#pragma unroll
            for (int k = 0; k < 4; ++k) { const v4u xv = rw[o + k];
                y[0] += w[k][0] * __uint_as_float(xv.x << 16); y[1] += w[k][1] * __uint_as_float(xv.x & 0xffff0000u); y[2] += w[k][2] * __uint_as_float(xv.y << 16); y[3] += w[k][3] * __uint_as_float(xv.y & 0xffff0000u);
                y[4] += w[k][4] * __uint_as_float(xv.z << 16); y[5] += w[k][5] * __uint_as_float(xv.z & 0xffff0000u); y[6] += w[k][6] * __uint_as_float(xv.w << 16); y[7] += w[k][7] * __uint_as_float(xv.w & 0xffff0000u); }
            v4u ov; ov.x = pk2(y[0], y[1]); ov.y = pk2(y[2], y[3]); ov.z = pk2(y[4], y[5]); ov.w = pk2(y[6], y[7]);
            *(LAS v4u*)(xc + (tq * 8 + o) * XP + 8 * cgi) = ov; }
    }
    if (FINAL && tid < 256) {
        const float* sp = summ + ((size_t)b * 64 * 1024 + ch0 + tid) * 2; float h = 0.f;
        for (int c0 = 0; c0 < ck; c0 += 16) { float2 v[16];
#pragma unroll
            for (int j = 0; j < 16; ++j) v[j] = (c0 + j < ck) ? *(const float2*)(sp + (size_t)(c0 + j) * 2048) : make_float2(1.f, 0.f);
#pragma unroll
            for (int j = 0; j < 16; ++j) h = v[j].x * h + v[j].y; }
        h0s[tid] = h;
    }
    __syncthreads();
    const int hh = wid >> 2, s = wid & 3, chl = 128 * hh + 32 * s + r32, ch = ch0 + chl, head = 2 * hp + hh;
    const float bav = ba[ch], bxv = bx[ch]; const float nl = -lam[ch]; const float sp8 = 8.f * (fmaxf(nl, 0.f) + flog1p(__expf(-fabsf(nl))));
    bf16x8 fa[8], fx[8];
#pragma unroll
    for (int ks = 0; ks < 8; ++ks) { fa[ks] = *(const bf16x8*)(WaT + (size_t)head * 16384 + (32 * s + r32) * 128 + 16 * ks + 8 * hi); fx[ks] = *(const bf16x8*)(WxT + (size_t)head * 16384 + (32 * s + r32) * 128 + 16 * ks + 8 * hi); }
    float hrun = FINAL ? h0s[chl] : 0.f, Arun = 1.f;
    for (int mb = 0; mb < 4; ++mb) {
        unsigned short gv[16];
        if (FINAL) {
#pragma unroll
            for (int r = 0; r < 16; ++r) gv[r] = gg[(m0 + 32 * mb + crow16(r, hi)) * 1024 + ch]; }
        f32x16 accA = {0.f, 0.f, 0.f, 0.f, 0.f, 0.f, 0.f, 0.f, 0.f, 0.f, 0.f, 0.f, 0.f, 0.f, 0.f, 0.f}, accX = accA;
#pragma unroll
        for (int ks = 0; ks < 8; ++ks) { const bf16x8 af = *(const LAS bf16x8*)(xc + (32 * mb + r32) * XP + 128 * hh + 16 * ks + 8 * hi);
            accA = __builtin_amdgcn_mfma_f32_32x32x16_bf16(af, fa[ks], accA, 0, 0, 0); accX = __builtin_amdgcn_mfma_f32_32x32x16_bf16(af, fx[ks], accX, 0, 0, 0); }
        float a[16], u[16];
#pragma unroll
        for (int r = 0; r < 16; ++r) { const int tok = 32 * mb + crow16(r, hi); const float xcv = bf2f(xc[tok * XP + chl]);
            const float rg = pg8::fsig(accA[r] + bav), la = -rg * sp8, av = __expf(la), mult = sqrtf(fmaxf(1.f - av * av, 0.f)), ig = pg8::fsig(accX[r] + bxv);
            a[r] = av; u[r] = mult * ig * xcv; }
        float As[4], Hs[4], Ap[4], Hp[4], hin[4];
#pragma unroll
        for (int g = 0; g < 4; ++g) { float Aq = 1.f, Hq = 0.f;
#pragma unroll
            for (int i = 0; i < 4; ++i) { Hq = a[4 * g + i] * Hq + u[4 * g + i]; Aq *= a[4 * g + i]; }
            As[g] = Aq; Hs[g] = Hq; Ap[g] = bperm(Aq, lane ^ 32); Hp[g] = bperm(Hq, lane ^ 32); }
#pragma unroll
        for (int g = 0; g < 4; ++g) { const float A0 = hi ? Ap[g] : As[g], H0 = hi ? Hp[g] : Hs[g], A1 = hi ? As[g] : Ap[g], H1 = hi ? Hs[g] : Hp[g];
            const float hA = hrun, hB = A0 * hA + H0; hrun = A1 * hB + H1; Arun *= A0 * A1; hin[g] = hi ? hB : hA; }
        if (FINAL) {
#pragma unroll
            for (int g = 0; g < 4; ++g) { float hc = hin[g];
#pragma unroll
                for (int i = 0; i < 4; ++i) { const int r = 4 * g + i; hc = a[r] * hc + u[r]; gv[r] = (unsigned short)f2bf(hc * bf2f(gv[r])); } }
#pragma unroll
            for (int r = 0; r < 16; ++r) gg[(m0 + 32 * mb + crow16(r, hi)) * 1024 + ch] = gv[r];
        }
    }
    if (!FINAL && hi == 0) { float* sp = summ + (((size_t)b * 64 + ck) * 1024 + ch) * 2; sp[0] = Arun; sp[1] = hrun; }
    __syncthreads();
}
__device__ __forceinline__ void phase_final(float* x, const float* g, int gw, int NGW, int lane) {
    for (int r = gw; r < M; r += NGW) { f32x4* xr = (f32x4*)(x + (size_t)r * D) + lane; f32x4 v[4]; float s = 0.f;
#pragma unroll
        for (int j = 0; j < 4; ++j) { v[j] = xr[64 * j]; s += (v[j].x * v[j].x + v[j].y * v[j].y) + (v[j].z * v[j].z + v[j].w * v[j].w); }
        const float rs = rsqrtf(wave_sum(s, lane) * (1.f / D) + 1e-6f);
#pragma unroll
        for (int j = 0; j < 4; ++j) { const f32x4 gv = *((const f32x4*)g + lane + 64 * j); xr[64 * j] = (f32x4){v[j].x * rs * gv.x, v[j].y * rs * gv.y, v[j].z * rs * gv.z, v[j].w * rs * gv.w}; } }
}
__device__ __forceinline__ void phase_kmax(const bf16* K, float* kpart, int gw, int NGW, int lane) {
    float m0 = 0.f, m1 = 0.f;
#pragma unroll 8
    for (int r = gw; r < M; r += NGW) { const v4u w = *(const v4u*)(K + (size_t)r * 512 + 8 * lane);
        const float a0 = __uint_as_float(w.x << 16), a1 = __uint_as_float(w.x & 0xffff0000u), a2 = __uint_as_float(w.y << 16), a3 = __uint_as_float(w.y & 0xffff0000u);
        const float a4 = __uint_as_float(w.z << 16), a5 = __uint_as_float(w.z & 0xffff0000u), a6 = __uint_as_float(w.w << 16), a7 = __uint_as_float(w.w & 0xffff0000u);
        float s = (a0 * a0 + a1 * a1) + (a2 * a2 + a3 * a3) + (a4 * a4 + a5 * a5) + (a6 * a6 + a7 * a7);
        s += bperm(s, lane ^ 1); s += bperm(s, lane ^ 2); s += bperm(s, lane ^ 4);
        if (r < SEQ) m0 = fmaxf(m0, s); else m1 = fmaxf(m1, s); }
    if ((lane & 7) == 0) { kpart[((size_t)gw * 2 + 0) * 8 + (lane >> 3)] = m0; kpart[((size_t)gw * 2 + 1) * 8 + (lane >> 3)] = m1; }
}
constexpr float FOX_C2 = 0.125f * 1.4426950408889634f;
constexpr float FOX_SKIP = 64.f;
constexpr int FOX_KP = 72;
constexpr int FOX_BUF = 2 * 64 * FOX_KP * 2 + 256;
__device__ __forceinline__ void fox_unit(LAS unsigned char* lds, int b, int h, int qb, const bf16* Q, const bf16* K, const bf16* V, bf16* O, const float* ct, const float* kpart, int nparts) {
    int tid_o = threadIdx.x; asm volatile("" : "+v"(tid_o)); const int tid = tid_o, lane = tid & 63, wid = tid >> 6, r32 = lane & 31, hi = lane >> 5;
    const size_t rowbase = (size_t)b * SEQ; const int q0 = qb * 256, NT = 4 * qb + 4;
    const bf16* Qw = Q + (rowbase + q0 + wid * 32 + r32) * 512 + h * 64;
    bf16x8 qr[4];
#pragma unroll
    for (int d0 = 0; d0 < 4; ++d0) qr[d0] = *(const bf16x8*)(Qw + 16 * d0 + 8 * hi);
    LAS float* red = (LAS float*)(lds + 2 * FOX_BUF); LAS int* tsl = (LAS int*)(lds + 2 * FOX_BUF + 128);
    { float qn = 0.f;
#pragma unroll
      for (int d0 = 0; d0 < 4; ++d0) { const v4u w = __builtin_bit_cast(v4u, qr[d0]);
          const float a0 = __uint_as_float(w.x << 16), a1 = __uint_as_float(w.x & 0xffff0000u), a2 = __uint_as_float(w.y << 16), a3 = __uint_as_float(w.y & 0xffff0000u);
          const float a4 = __uint_as_float(w.z << 16), a5 = __uint_as_float(w.z & 0xffff0000u), a6 = __uint_as_float(w.w << 16), a7 = __uint_as_float(w.w & 0xffff0000u);
          qn += (a0 * a0 + a1 * a1) + (a2 * a2 + a3 * a3) + (a4 * a4 + a5 * a5) + (a6 * a6 + a7 * a7); }
      qn += bperm(qn, lane ^ 32);
#pragma unroll
      for (int o = 1; o < 32; o <<= 1) qn = fmaxf(qn, bperm(qn, lane ^ o));
      __syncthreads();
      float km = 0.f;
      for (int i = tid; i < nparts; i += NTHR) km = fmaxf(km, kpart[((size_t)i * 2 + b) * 8 + h]);
#pragma unroll
      for (int o = 1; o < 64; o <<= 1) km = fmaxf(km, bperm(km, lane ^ o));
      if (lane == 0) { red[wid] = qn; red[8 + wid] = km; } if (tid == 0) tsl[0] = 4 * qb;
      __syncthreads();
      float q2 = red[0], k2 = red[8];
#pragma unroll
      for (int w = 1; w < 8; ++w) { q2 = fmaxf(q2, red[w]); k2 = fmaxf(k2, red[8 + w]); }
      const float thr = 2.f * sqrtf(q2) * sqrtf(k2) * 1.0001f + FOX_SKIP;
      const float c0 = ct[q0];
      if (tid < 4 * qb && ct[64 * tid + 63] - c0 <= thr) atomicMin((int*)tsl, tid);
      __syncthreads(); }
    const int T0 = tsl[0];
    const int skey = tid >> 3, sd = (tid & 7) * 8;
    const bf16* kp = K + (rowbase + skey) * 512 + h * 64 + sd; const bf16* vp = V + (rowbase + skey) * 512 + h * 64 + sd;
    v4u kreg = *(const v4u*)(kp + (size_t)T0 * 64 * 512), vreg = *(const v4u*)(vp + (size_t)T0 * 64 * 512); float creg = (tid < 64) ? ct[64 * T0 + tid] : 0.f;
    __syncthreads();
    { LAS unsigned char* buf0 = lds + (T0 & 1) * FOX_BUF; LAS bf16* Ks = (LAS bf16*)buf0; LAS bf16* Vt = Ks + 64 * FOX_KP; LAS float* Cs = (LAS float*)(buf0 + 2 * 64 * FOX_KP * 2);
      *(LAS v4u*)(Ks + skey * FOX_KP + sd) = kreg;
      Vt[(sd + 0) * FOX_KP + skey] = (bf16)(vreg.x & 0xffffu); Vt[(sd + 1) * FOX_KP + skey] = (bf16)(vreg.x >> 16); Vt[(sd + 2) * FOX_KP + skey] = (bf16)(vreg.y & 0xffffu); Vt[(sd + 3) * FOX_KP + skey] = (bf16)(vreg.y >> 16);
      Vt[(sd + 4) * FOX_KP + skey] = (bf16)(vreg.z & 0xffffu); Vt[(sd + 5) * FOX_KP + skey] = (bf16)(vreg.z >> 16); Vt[(sd + 6) * FOX_KP + skey] = (bf16)(vreg.w & 0xffffu); Vt[(sd + 7) * FOX_KP + skey] = (bf16)(vreg.w >> 16);
      if (tid < 64) Cs[tid] = creg; }
    if (T0 + 1 < NT) { kreg = *(const v4u*)(kp + (size_t)(T0 + 1) * 64 * 512); vreg = *(const v4u*)(vp + (size_t)(T0 + 1) * 64 * 512); if (tid < 64) creg = ct[64 * (T0 + 1) + tid]; }
    float m = -1e30f, l = 0.f; f32x16 o0, o1;
#pragma unroll
    for (int r = 0; r < 16; ++r) { o0[r] = 0.f; o1[r] = 0.f; }
    for (int t = T0; t < NT; ++t) {
        __syncthreads();
        if (t + 1 < NT) { LAS unsigned char* bufn = lds + ((t + 1) & 1) * FOX_BUF; LAS bf16* Ks = (LAS bf16*)bufn; LAS bf16* Vt = Ks + 64 * FOX_KP; LAS float* Cs = (LAS float*)(bufn + 2 * 64 * FOX_KP * 2);
            *(LAS v4u*)(Ks + skey * FOX_KP + sd) = kreg;
            Vt[(sd + 0) * FOX_KP + skey] = (bf16)(vreg.x & 0xffffu); Vt[(sd + 1) * FOX_KP + skey] = (bf16)(vreg.x >> 16); Vt[(sd + 2) * FOX_KP + skey] = (bf16)(vreg.y & 0xffffu); Vt[(sd + 3) * FOX_KP + skey] = (bf16)(vreg.y >> 16);
            Vt[(sd + 4) * FOX_KP + skey] = (bf16)(vreg.z & 0xffffu); Vt[(sd + 5) * FOX_KP + skey] = (bf16)(vreg.z >> 16); Vt[(sd + 6) * FOX_KP + skey] = (bf16)(vreg.w & 0xffffu); Vt[(sd + 7) * FOX_KP + skey] = (bf16)(vreg.w >> 16);
            if (tid < 64) Cs[tid] = creg;
            if (t + 2 < NT) { kreg = *(const v4u*)(kp + (size_t)(t + 2) * 64 * 512); vreg = *(const v4u*)(vp + (size_t)(t + 2) * 64 * 512); if (tid < 64) creg = ct[64 * (t + 2) + tid]; } }
        const int jb = t - (NT - 4);
        if (jb >= 0 && 64 * jb > 32 * wid + 31) continue;
        LAS unsigned char* buf = lds + (t & 1) * FOX_BUF; const LAS bf16* Ks = (const LAS bf16*)buf; const LAS bf16* Vt = Ks + 64 * FOX_KP; const LAS float* Cs = (const LAS float*)(buf + 2 * 64 * FOX_KP * 2);
        f32x16 p0, p1;
#pragma unroll
        for (int g = 0; g < 4; ++g) { const f32x4 a = *(const LAS f32x4*)(Cs + 8 * g + 4 * hi), c = *(const LAS f32x4*)(Cs + 32 + 8 * g + 4 * hi);
            p0[4 * g + 0] = -a[0]; p0[4 * g + 1] = -a[1]; p0[4 * g + 2] = -a[2]; p0[4 * g + 3] = -a[3]; p1[4 * g + 0] = -c[0]; p1[4 * g + 1] = -c[1]; p1[4 * g + 2] = -c[2]; p1[4 * g + 3] = -c[3]; }
#pragma unroll
        for (int d0 = 0; d0 < 4; ++d0) { const bf16x8 a0 = *(const LAS bf16x8*)(Ks + r32 * FOX_KP + 16 * d0 + 8 * hi), a1 = *(const LAS bf16x8*)(Ks + (32 + r32) * FOX_KP + 16 * d0 + 8 * hi);
            p0 = __builtin_amdgcn_mfma_f32_32x32x16_bf16(a0, qr[d0], p0, 0, 0, 0); p1 = __builtin_amdgcn_mfma_f32_32x32x16_bf16(a1, qr[d0], p1, 0, 0, 0); }
        if (jb >= 0) { const int qrel = 32 * wid + r32, kb = 64 * jb + 4 * hi;
#pragma unroll
            for (int r = 0; r < 16; ++r) { const int kv = kb + (r & 3) + 8 * (r >> 2); if (kv > qrel) p0[r] = -__builtin_inff(); if (kv + 32 > qrel) p1[r] = -__builtin_inff(); } }
        float mx = fmaxf(p0[0], p1[0]);
#pragma unroll
        for (int r = 1; r < 16; ++r) mx = fmaxf(mx, fmaxf(p0[r], p1[r]));
        mx = fmaxf(mx, bperm(mx, lane ^ 32));
        const float mn = fmaxf(m, mx), alpha = __builtin_amdgcn_exp2f(m - mn); m = mn;
        float sum = 0.f;
#pragma unroll
        for (int r = 0; r < 16; ++r) { p0[r] = __builtin_amdgcn_exp2f(p0[r] - mn); p1[r] = __builtin_amdgcn_exp2f(p1[r] - mn); sum += p0[r] + p1[r]; }
        l = l * alpha + sum;
#pragma unroll
        for (int r = 0; r < 16; ++r) { o0[r] *= alpha; o1[r] *= alpha; }
        bf16x8 pb[4];
        { v4u w;
          w.x = pg8::cvt_pk_bf16(p0[0], p0[1]); w.y = pg8::cvt_pk_bf16(p0[2], p0[3]); w.z = pg8::cvt_pk_bf16(p0[4], p0[5]); w.w = pg8::cvt_pk_bf16(p0[6], p0[7]); pb[0] = __builtin_bit_cast(bf16x8, w);
          w.x = pg8::cvt_pk_bf16(p0[8], p0[9]); w.y = pg8::cvt_pk_bf16(p0[10], p0[11]); w.z = pg8::cvt_pk_bf16(p0[12], p0[13]); w.w = pg8::cvt_pk_bf16(p0[14], p0[15]); pb[1] = __builtin_bit_cast(bf16x8, w);
          w.x = pg8::cvt_pk_bf16(p1[0], p1[1]); w.y = pg8::cvt_pk_bf16(p1[2], p1[3]); w.z = pg8::cvt_pk_bf16(p1[4], p1[5]); w.w = pg8::cvt_pk_bf16(p1[6], p1[7]); pb[2] = __builtin_bit_cast(bf16x8, w);
          w.x = pg8::cvt_pk_bf16(p1[8], p1[9]); w.y = pg8::cvt_pk_bf16(p1[10], p1[11]); w.z = pg8::cvt_pk_bf16(p1[12], p1[13]); w.w = pg8::cvt_pk_bf16(p1[14], p1[15]); pb[3] = __builtin_bit_cast(bf16x8, w); }
#pragma unroll
        for (int mm = 0; mm < 4; ++mm) {
            typedef unsigned u32x2v __attribute__((ext_vector_type(2)));
            const u32x2v a0l = *(const LAS u32x2v*)(Vt + r32 * FOX_KP + 16 * mm + 4 * hi), a0h = *(const LAS u32x2v*)(Vt + r32 * FOX_KP + 16 * mm + 8 + 4 * hi);
            const u32x2v a1l = *(const LAS u32x2v*)(Vt + (32 + r32) * FOX_KP + 16 * mm + 4 * hi), a1h = *(const LAS u32x2v*)(Vt + (32 + r32) * FOX_KP + 16 * mm + 8 + 4 * hi);
            const v4u A0 = {a0l.x, a0l.y, a0h.x, a0h.y}, A1 = {a1l.x, a1l.y, a1h.x, a1h.y};
            o0 = __builtin_amdgcn_mfma_f32_32x32x16_bf16(__builtin_bit_cast(bf16x8, A0), pb[mm], o0, 0, 0, 0);
            o1 = __builtin_amdgcn_mfma_f32_32x32x16_bf16(__builtin_bit_cast(bf16x8, A1), pb[mm], o1, 0, 0, 0); }
    }
    l += bperm(l, lane ^ 32); const float inv = 1.f / l;
    bf16* Ow = O + (rowbase + q0 + wid * 32 + r32) * 512 + h * 64;
#pragma unroll
    for (int g = 0; g < 4; ++g) { typedef unsigned u32x2v __attribute__((ext_vector_type(2)));
        u32x2v w0, w1; w0.x = pg8::cvt_pk_bf16(o0[4 * g] * inv, o0[4 * g + 1] * inv); w0.y = pg8::cvt_pk_bf16(o0[4 * g + 2] * inv, o0[4 * g + 3] * inv);
        w1.x = pg8::cvt_pk_bf16(o1[4 * g] * inv, o1[4 * g + 1] * inv); w1.y = pg8::cvt_pk_bf16(o1[4 * g + 2] * inv, o1[4 * g + 3] * inv);
        *(u32x2v*)(Ow + 8 * g + 4 * hi) = w0; *(u32x2v*)(Ow + 32 + 8 * g + 4 * hi) = w1; }
    __syncthreads();
}
__global__ void __launch_bounds__(NTHR, 2) hybrid_fwd(Args args) {
    extern __shared__ __attribute__((aligned(16))) unsigned char lds_raw[];
    cg::grid_group grid = cg::this_grid();
    LAS unsigned char* lds = (LAS unsigned char*)lds_raw;
    int tid = threadIdx.x, lane = tid & 63, wave = __builtin_amdgcn_readfirstlane(tid >> 6);
    int G = gridDim.x, bx = blockIdx.x;
    int vcu = (G % 8 == 0) ? (bx % 8) * (G / 8) + bx / 8 : bx;
    int gw = vcu * NWAVES + wave; int NGW = G * NWAVES;
    PtrTab TB = (PtrTab)(lds + TAB_OFF);
    if (tid == 0) {
#pragma unroll
        for (int i = 0; i < 31; ++i) TB[i] = (unsigned long long)args.in[i];
    }
    if (tid == 1) { TB[40] = 0ull; }
    __syncthreads();
    (void)xcd_barrier_post((unsigned*)(args.ws + WS_BAR), (volatile LAS unsigned*)(lds + TAB_OFF + 320));
    grid.sync();
    unsigned char* ws = args.ws;
    float* X = args.out;
    float* SS = (float*)(ws + WS_SSP);
    bf16* XB = (bf16*)(ws + WS_XB);
    bf16* HB = (bf16*)(ws + WS_H);
    constexpr float C2X = 0.0625f * 1.4426950408889634f;
#define GSYNC() do { asm volatile("s_waitcnt vmcnt(0) lgkmcnt(0)" ::: "memory"); { XcdBarrier xb_; xb_.bar = (unsigned*)(ws + WS_BAR); xb_.x = xb_xcc_id(); xb_.st = (volatile LAS unsigned*)(lds + TAB_OFF + 320); xcd_barrier(xb_); } tid = threadIdx.x; asm volatile("" : "+v"(tid)); lane = tid & 63; wave = __builtin_amdgcn_readfirstlane(tid >> 6); G = gridDim.x; bx = blockIdx.x; asm volatile("" : "+s"(G), "+s"(bx)); vcu = (G % 8 == 0) ? (bx % 8) * (G / 8) + bx / 8 : bx; gw = vcu * NWAVES + wave; NGW = G * NWAVES; { unsigned long long wsi_ = (unsigned long long)ws; asm volatile("" : "+s"(wsi_)); ws = (unsigned char*)(GAS unsigned char*)wsi_; } } while (0)

    for (int l = 0; l < DEPTH; ++l) {
        float* ss0 = SS + (size_t)(4 * l + 0) * M * 4; float* ss1 = SS + (size_t)(4 * l + 1) * M * 4; float* ss2 = SS + (size_t)(4 * l + 2) * M * 4; float* ss3 = SS + (size_t)(4 * l + 3) * M * 4; float* ss4 = SS + (size_t)(4 * l + 4) * M * 4;
        phase_prologue(TB, ws, X, l, lds, gw, NGW, lane, wave);
        GSYNC();
        { pg8::Gemm g{XB, (const bf16*)(ws + WS_W1IN), M, 2 * DFF, D, D, D, 0}; pg8::StaticOrder S; S.init(M, 2 * DFF, G, bx);
          pg8::EpiSwiglu E{HB, ss0, DFF};
          pg8::gemm_phase<pg8::EpiSwiglu, pg8::StaticOrder, true, true>(lds, g, S, E); }
        if (bx >= G / 2) { pg8::Gemm g{(const bf16*)(ws + WS_MEMN), (const bf16*)(ws + WS_WXKV), 512, 2 * D, D, D, D, 0}; pg8::StaticOrder S; S.init(512, 2 * D, G, bx - G / 2);
          pg8::EpiKV E{(bf16*)(ws + WS_KX), (bf16*)(ws + WS_VT)};
          pg8::gemm_phase<pg8::EpiKV, pg8::StaticOrder, true, true>(lds, g, S, E); }
        GSYNC();
        { pg8::Gemm g{HB, (const bf16*)(ws + WS_W1OUT), M, D, DFF, DFF, DFF, 0}; pg8::StaticOrder S; S.init(M, D, G, bx); pg8::Unit u_;
          pg8::EpiResid E{X, XB, ss1, 0.5f};
          for (int i_ = 0; S.next(i_, u_); ++i_) { const pg8::OneUnit O1{u_.pm, u_.pn}; pg8::gemm_phase<pg8::EpiResid, pg8::OneUnit, false, true>(lds, g, O1, E); } }
        GSYNC();
        { pg8::Gemm g{XB, (const bf16*)(ws + WS_WIN), M, 4096, D, D, D, 0}; pg8::StaticOrder S; S.init(M, 4096, G, bx);
          pg8::EpiWin E{(bf16*)(ws + WS_XA), (bf16*)(ws + WS_XL), (bf16*)(ws + WS_GG), (bf16*)(ws + WS_Q), (bf16*)(ws + WS_K), (bf16*)(ws + WS_V), ss1, FOX_C2};
          pg8::gemm_phase<pg8::EpiWin, pg8::StaticOrder, true, true>(lds, g, S, E); }
        phase_fl(XB, (const float*)(ws + WS_WFL), tab_in(TB, 7) + l * 8, ss1, (float*)(ws + WS_LOGF), gw, NGW, lane);
        GSYNC();
        if (vcu < 16) cumsum_bh((const float*)(ws + WS_LOGF), (float*)(ws + WS_CTIL), vcu, (LAS float*)lds);
        for (int it = vcu; it < 512; it += G)
            lru_item<false>(lds, it >> 8, (it >> 6) & 3, it & 63, (const bf16*)(ws + WS_XL), (bf16*)(ws + WS_GG), tab_in(TB, 12) + (size_t)l * 4 * D, tab_in(TB, 13) + l * D, (const bf16*)(ws + WS_WAT), (const bf16*)(ws + WS_WXT),
                            tab_in(TB, 15) + l * D, tab_in(TB, 17) + l * D, tab_in(TB, 18) + l * D, (float*)(ws + WS_SUMM));
        phase_pool((const bf16*)(ws + WS_XA), (bf16*)(ws + WS_YA), vcu * NTHR + tid, G * NTHR);
        phase_kmax((const bf16*)(ws + WS_K), (float*)(ws + WS_KPART), gw, NGW, lane);
        GSYNC();
        for (int it = vcu; it < 512; it += G)
            lru_item<true>(lds, it >> 8, (it >> 6) & 3, it & 63, (const bf16*)(ws + WS_XL), (bf16*)(ws + WS_GG), tab_in(TB, 12) + (size_t)l * 4 * D, tab_in(TB, 13) + l * D, (const bf16*)(ws + WS_WAT), (const bf16*)(ws + WS_WXT),
                           tab_in(TB, 15) + l * D, tab_in(TB, 17) + l * D, tab_in(TB, 18) + l * D, (float*)(ws + WS_SUMM));
        for (int p = vcu; p < 256; p += G) { const int bh = p >> 4, s = p & 15;
            fox_unit(lds, bh >> 3, bh & 7, s, (const bf16*)(ws + WS_Q), (const bf16*)(ws + WS_K), (const bf16*)(ws + WS_V), (bf16*)(ws + WS_YC), (const float*)(ws + WS_CTIL) + (size_t)bh * SEQ, (const float*)(ws + WS_KPART), NGW);
            fox_unit(lds, bh >> 3, bh & 7, 31 - s, (const bf16*)(ws + WS_Q), (const bf16*)(ws + WS_K), (const bf16*)(ws + WS_V), (bf16*)(ws + WS_YC), (const float*)(ws + WS_CTIL) + (size_t)bh * SEQ, (const float*)(ws + WS_KPART), NGW); }
        GSYNC();
        { pg8::StaticOrder S; S.init(M, D, G, bx); pg8::Unit u;
          bf16* stash = (bf16*)(ws + WS_STASH) + (size_t)bx * 65536; bf16* mg = (bf16*)(ws + WS_MG);
          for (int i = 0; S.next(i, u); ++i) { const pg8::OneUnit O1{u.pm, u.pn};
#pragma unroll 1
              for (int br = 0; br < 3; ++br) {
                  { pg8::Gemm g{XB, (const bf16*)(ws + WS_WG) + (size_t)br * D * D, M, D, D, D, D, 0}; pg8::EpiGate E{stash, tab_in(TB, 8) + (size_t)l * 3 * D + br * D, ss1};
                    pg8::gemm_phase<pg8::EpiGate, pg8::OneUnit, true, true>(lds, g, O1, E); }
                  asm volatile("s_waitcnt vmcnt(0)" ::: "memory"); __syncthreads();
                  const bf16* Ab = br == 0 ? (const bf16*)(ws + WS_YA) : br == 1 ? (const bf16*)(ws + WS_GG) : (const bf16*)(ws + WS_YC);
                  const bf16* Ub = br == 0 ? (const bf16*)(ws + WS_UA) : br == 1 ? (const bf16*)(ws + WS_UB) : (const bf16*)(ws + WS_UC);
                  const int Kb = br == 1 ? 1024 : 512;
                  { pg8::Gemm g{Ab, Ub, M, D, Kb, Kb, Kb, 0}; pg8::EpiMerge E{stash, mg, br == 0 ? 1 : 0};
                    pg8::gemm_phase<pg8::EpiMerge, pg8::OneUnit, true, true>(lds, g, O1, E); }
                  asm volatile("s_waitcnt vmcnt(0)" ::: "memory"); __syncthreads();
              } } }
        GSYNC();
        { pg8::Gemm g{(const bf16*)(ws + WS_MG), (const bf16*)(ws + WS_WO), M, D, D, D, D, 0}; pg8::StaticOrder S; S.init(M, D, G, bx); pg8::Unit u_;
          pg8::EpiResid E{X, XB, ss2, 1.0f};
          for (int i_ = 0; S.next(i_, u_); ++i_) { const pg8::OneUnit O1{u_.pm, u_.pn}; pg8::gemm_phase<pg8::EpiResid, pg8::OneUnit, false, true>(lds, g, O1, E); } }
        GSYNC();
        { bf16* pb = (bf16*)(ws + WS_PBUF) + (size_t)bx * 65536; const pg8::OneUnit O1{0, 0};
          for (int uid = vcu; uid < 256; uid += G) { const int rt = uid >> 2, h = uid & 3, b = rt >> 5;
              int KX = 256; asm volatile("" : "+s"(KX));
              bf16* qo = (bf16*)(ws + WS_QX) + (size_t)rt * 256 * D + h * 256; bf16* qs = (bf16*)(ws + WS_Q) + (size_t)bx * 65536;
              { pg8::Gemm g{XB + (size_t)rt * 256 * D, (const bf16*)(ws + WS_WXQ) + (size_t)h * 256 * D, 256, 256, D, D, D, 0}; pg8::EpiRs E{qs, 256, ss2 + (size_t)rt * 256 * 4, C2X};
                pg8::gemm_phase<pg8::EpiRs, pg8::OneUnit, true, true>(lds, g, O1, E); }
              asm volatile("s_waitcnt vmcnt(0)" ::: "memory"); __syncthreads();
              { pg8::Gemm g{qs, (const bf16*)(ws + WS_KX) + (size_t)b * 256 * D + h * 256, 256, 256, KX, 256, D, 0}; pg8::EpiSoftmaxP E{pb};
                pg8::gemm_phase<pg8::EpiSoftmaxP, pg8::OneUnit, false, true>(lds, g, O1, E); }
              asm volatile("s_waitcnt vmcnt(0)" ::: "memory"); __syncthreads();
              { pg8::Gemm g{pb, (const bf16*)(ws + WS_VT) + (size_t)(b * 4 + h) * 65536, 256, 256, KX, 256, 256, 0}; pg8::EpiRs E{qo, D, nullptr, 1.0f};
                pg8::gemm_phase<pg8::EpiRs, pg8::OneUnit, true, true>(lds, g, O1, E); }
              asm volatile("s_waitcnt vmcnt(0)" ::: "memory"); if (uid + G < 256) __builtin_amdgcn_fence(__ATOMIC_ACQUIRE, "agent"); __syncthreads();
          } }
        GSYNC();
        { pg8::Gemm g{(const bf16*)(ws + WS_QX), (const bf16*)(ws + WS_WXO), M, D, D, D, D, 0}; pg8::StaticOrder S; S.init(M, D, G, bx); pg8::Unit u_;
          pg8::EpiResid E{X, XB, ss3, 1.0f};
          for (int i_ = 0; S.next(i_, u_); ++i_) { const pg8::OneUnit O1{u_.pm, u_.pn}; pg8::gemm_phase<pg8::EpiResid, pg8::OneUnit, false, true>(lds, g, O1, E); } }
        GSYNC();
        { pg8::Gemm g{XB, (const bf16*)(ws + WS_W2IN), M, 2 * DFF, D, D, D, 0}; pg8::StaticOrder S; S.init(M, 2 * DFF, G, bx);
          pg8::EpiSwiglu E{HB, ss3, DFF};
          pg8::gemm_phase<pg8::EpiSwiglu, pg8::StaticOrder, true, true>(lds, g, S, E); }
        GSYNC();
        { pg8::Gemm g{HB, (const bf16*)(ws + WS_W2OUT), M, D, DFF, DFF, DFF, 0}; pg8::StaticOrder S; S.init(M, D, G, bx); pg8::Unit u_;
          pg8::EpiResid E{X, XB, ss4, 0.5f};
          for (int i_ = 0; S.next(i_, u_); ++i_) { const pg8::OneUnit O1{u_.pm, u_.pn}; pg8::gemm_phase<pg8::EpiResid, pg8::OneUnit, false, true>(lds, g, O1, E); } }
        GSYNC();
    }
    phase_final(X, tab_in(TB, 30), gw, NGW, lane);
#undef GSYNC
}

extern "C" void kernel_launch(void* const* d_in, const int* in_sizes, int n_in, void* d_out, int out_size, void* d_ws, size_t ws_size, hipStream_t stream) {
    static int grid = 0;
    if (grid == 0) {
        if (n_in != 31 || out_size != M * D || ws_size < WS_END) { fprintf(stderr, "kernel_launch: unexpected problem (n_in %d, out %d, ws %zu)\n", n_in, out_size, ws_size); grid = -1; return; }
        int dev = 0, cus = 0, per_cu = 0;
        (void)hipGetDevice(&dev); (void)hipDeviceGetAttribute(&cus, hipDeviceAttributeMultiprocessorCount, dev);
        if (hipFuncSetAttribute((const void*)hybrid_fwd, hipFuncAttributeMaxDynamicSharedMemorySize, LDS_BYTES) != hipSuccess) { fprintf(stderr, "kernel_launch: hipFuncSetAttribute failed\n"); grid = -1; return; }
        if (hipOccupancyMaxActiveBlocksPerMultiprocessor(&per_cu, (const void*)hybrid_fwd, NTHR, LDS_BYTES) != hipSuccess || per_cu < 1) per_cu = 1;
        (void)hipGetLastError();
        grid = cus * (per_cu > 1 ? 1 : per_cu);
        if (grid > 256) grid = 256;
    }
    if (grid < 0) return;
    (void)hipMemsetAsync((char*)d_ws + WS_SS, 0, CTL_ZERO_BYTES, stream);
    Args a{};
    for (int i = 0; i < 31; ++i) a.in[i] = (const float*)d_in[i];
    a.out = (float*)d_out; a.ws = (unsigned char*)d_ws;
    void* kargs[] = {&a};
    hipError_t e = hipLaunchCooperativeKernel((const void*)hybrid_fwd, dim3(grid), dim3(NTHR), kargs, LDS_BYTES, stream);
    if (e != hipSuccess) fprintf(stderr, "cooperative launch failed: %s (grid %d)\n", hipGetErrorString(e), grid);
}
```

```cpp
#include <hip/hip_runtime.h>
#include <hip/hip_cooperative_groups.h>
#include <cstdio>
#include <cstdint>
namespace cg = cooperative_groups;
namespace pg8 {
#define PG8_LAS __attribute__((address_space(3)))
typedef unsigned short bf16_t;
typedef short bf16x8 __attribute__((ext_vector_type(8)));
typedef float f32x4 __attribute__((ext_vector_type(4)));
typedef unsigned u32x4 __attribute__((ext_vector_type(4)));
constexpr int BM = 256, BK = 64, HALF = 128, HTB = HALF * BK * 2  , STAGE_BYTES = 8 * HTB, NXCD = 8, WGM = 8;

__host__ __device__ __forceinline__ int lds_byte(int r, int c) { const int st = (r >> 4) * 2 + (c >> 5), rr = r & 15, cc = c & 31, ob = rr * 64 + cc * 2; return st * 1024 + (ob ^ (((ob >> 9) & 1) << 5)); }
__host__ __device__ __forceinline__ void stage_rc(int b, int& R, int& C) { const int st = b / 1024, sb = b % 1024, swz = sb ^ (((sb >> 9) & 1) << 5); R = (st >> 1) * 16 + swz / 64; C = (st & 1) * 32 + (swz % 64) / 2; }
__host__ __device__ __forceinline__ int perm32(int rho) { const int n = rho >> 4, i = rho & 15; return 8 * (i >> 2) + 4 * n + (i & 3); }

struct Unit { int pm, pn; };
struct Gemm { const bf16_t* A; const bf16_t* Bt; int M, N, K, lda, ldb, a_pn_off; };

struct StaticOrder {
    int nM, nN, nwg, G, c;
    __host__ __device__ __forceinline__ void init(int M, int N, int G_, int c_) { nM = M / BM; nN = N / BM; nwg = nM * nN; G = G_; c = c_; }
    __host__ __device__ __forceinline__ bool next(int i, Unit& u) const {
        const long L = (long)i * G + c; if (L >= nwg) return false;
        int wgid = (int)L; { const int q = nwg / NXCD, r = nwg % NXCD, xcd = wgid % NXCD, off = wgid / NXCD; wgid = (xcd < r ? xcd * (q + 1) : r * (q + 1) + (xcd - r) * q) + off; }
        const int nig = WGM * nN, gid = wgid / nig, fm = gid * WGM, gsz = (nM - fm) < WGM ? (nM - fm) : WGM;
        u.pm = fm + ((wgid % nig) % gsz); u.pn = (wgid % nig) / gsz; return true;
    }
    __device__ __forceinline__ void a_ready(const Unit&) const {}
    __device__ __forceinline__ void done(const Unit&) const {}
};

__device__ __forceinline__ unsigned cvt_pk_bf16(float lo, float hi) { unsigned r; asm volatile("v_cvt_pk_bf16_f32 %0, %1, %2" : "=v"(r) : "v"(lo), "v"(hi)); return r; }
__device__ __forceinline__ float bperm(float v, int srclane) { return __int_as_float(__builtin_amdgcn_ds_bpermute(srclane << 2, __float_as_int(v))); }
typedef float f32x2 __attribute__((ext_vector_type(2)));
typedef unsigned u32x2 __attribute__((ext_vector_type(2)));
__device__ __forceinline__ float fsig(float v) { return __builtin_amdgcn_rcpf(1.f + __expf(-v)); }
__device__ __forceinline__ float fsilu(float v) { return v * fsig(v); }
__device__ __forceinline__ float fgelu_tanh(float v) { return v * fsig(1.5957691216057308f * (v + 0.044715f * v * v * v)); }
__device__ __forceinline__ float bf_lo(unsigned w) { return __uint_as_float(w << 16); }
__device__ __forceinline__ float bf_hi(unsigned w) { return __uint_as_float(w & 0xffff0000u); }
__device__ __forceinline__ float rstd_of(const float* ss, int row) { const f32x4 a = *(const f32x4*)(ss + (size_t)row * 4); return rsqrtf(((a[0] + a[1]) + (a[2] + a[3])) * (1.0f / 1024.0f) + 1e-6f); }
__device__ __forceinline__ u32x4 pack8(const f32x4 v0, const f32x4 v1) { u32x4 w; w.x = cvt_pk_bf16(v0[0], v0[1]); w.y = cvt_pk_bf16(v0[2], v0[3]); w.z = cvt_pk_bf16(v1[0], v1[1]); w.w = cvt_pk_bf16(v1[2], v1[3]); return w; }

__device__ __forceinline__ void rstd8(const float* ss, int row0, float sc, float (&rs)[2][4]) {
    f32x4 pa[2][4];
#pragma unroll
    for (int ai = 0; ai < 2; ++ai)
#pragma unroll
        for (int m = 0; m < 4; ++m) pa[ai][m] = *(const f32x4*)(ss + (size_t)(row0 + ai * HALF + m * 16) * 4);
#pragma unroll
    for (int ai = 0; ai < 2; ++ai)
#pragma unroll
        for (int m = 0; m < 4; ++m) { const f32x4 a = pa[ai][m]; rs[ai][m] = rsqrtf(((a[0] + a[1]) + (a[2] + a[3])) * (1.0f / 1024.0f) + 1e-6f) * sc; }
    __builtin_amdgcn_sched_barrier(0);
}

__device__ __forceinline__ u32x4 ld16_sc1(const void* p) { u32x4 v; asm volatile("global_load_dwordx4 %0, %1, off sc1" : "=v"(v) : "v"(p) : "memory"); return v; }
#define PG8_LDWAIT(v) asm volatile("s_waitcnt vmcnt(0)" : "+v"(v))

struct OneUnit { int pm, pn;
    __device__ __forceinline__ bool next(int i, Unit& u) const { if (i) return false; u.pm = pm; u.pn = pn; return true; }
    __device__ __forceinline__ void a_ready(const Unit&) const {}
    __device__ __forceinline__ void done(const Unit&) const {} };

struct EpiSwiglu { static constexpr bool PERM = true, AFTER_DRAIN = false; bf16_t* H; const float* ss; int ldh;
    __device__ __forceinline__ void operator()(const f32x4 (&acc)[2][2][4][2], const Unit& u, int wr, int wc, int fr, int fq) const {
        const int row0 = u.pm * BM + wr * 64 + fr, col0 = u.pn * HALF + wc * 32 + 8 * fq; float rsv[2][4]; rstd8(ss, row0, 1.f, rsv);
#pragma unroll
        for (int ai = 0; ai < 2; ++ai)
#pragma unroll
            for (int m = 0; m < 4; ++m) { const int row = row0 + ai * HALF + m * 16; const float rs = rsv[ai][m];
                f32x4 o0, o1;
#pragma unroll
                for (int i = 0; i < 4; ++i) { o0[i] = fsilu(acc[ai][0][m][0][i] * rs) * (acc[ai][1][m][0][i] * rs); o1[i] = fsilu(acc[ai][0][m][1][i] * rs) * (acc[ai][1][m][1][i] * rs); }
                *(u32x4*)(H + (size_t)row * ldh + col0) = pack8(o0, o1); __builtin_amdgcn_sched_barrier(0); }
    }
};
struct EpiResid { static constexpr bool PERM = false, AFTER_DRAIN = true; float* x; bf16_t* xb; float* ss; float scale;
    __device__ __forceinline__ void fused(f32x4 (&acc)[2][2][4][2], const Unit& u, int wr, int wc, int fr, int fq, PG8_LAS unsigned char* lds, int wid, int lane) const {
        float scl = scale; asm volatile("" : "+v"(scl)); const int row0 = u.pm * BM + wr * 64 + fr, col0 = u.pn * BM + wc * 32 + 4 * fq;
        PG8_LAS float* P = (PG8_LAS float*)lds;
#pragma unroll
        for (int ai = 0; ai < 2; ++ai)
#pragma unroll
            for (int m = 0; m < 4; ++m) { const int row = row0 + ai * HALF + m * 16; float q = 0.f;
#pragma unroll
                for (int bj = 0; bj < 2; ++bj)
#pragma unroll
                    for (int n = 0; n < 2; ++n) { const size_t off = (size_t)row * 1024 + col0 + bj * HALF + n * 16;
                        f32x4 v = *(const f32x4*)(x + off) + acc[ai][bj][m][n] * scl; *(f32x4*)(x + off) = v;
                        u32x2 w; w.x = cvt_pk_bf16(v[0], v[1]); w.y = cvt_pk_bf16(v[2], v[3]); *(u32x2*)(xb + off) = w;
                        q += (v[0] * v[0] + v[1] * v[1]) + (v[2] * v[2] + v[3] * v[3]); }
                q += bperm(q, (fr + 16 * fq) ^ 16); q += bperm(q, (fr + 16 * fq) ^ 32);
                if (fq == 0) P[(ai * HALF + wr * 64 + m * 16 + fr) * 4 + wc] = q; }
        asm volatile("s_waitcnt lgkmcnt(0)" ::: "memory"); __builtin_amdgcn_s_barrier(); asm volatile("" ::: "memory");
        const int tl = wid * 64 + lane;
        if (tl < 256) { const f32x4 a = *(const PG8_LAS f32x4*)(P + tl * 4); ss[(size_t)(u.pm * BM + tl) * 4 + u.pn] = (a[0] + a[1]) + (a[2] + a[3]); }
        asm volatile("s_waitcnt lgkmcnt(0)" ::: "memory"); __builtin_amdgcn_s_barrier(); asm volatile("" ::: "memory");
    }
};
struct EpiRs { static constexpr bool PERM = true, AFTER_DRAIN = false; bf16_t* O; int ldc; const float* ss; float sc;
    __device__ __forceinline__ void operator()(const f32x4 (&acc)[2][2][4][2], const Unit& u, int wr, int wc, int fr, int fq) const {
        const int row0 = u.pm * BM + wr * 64 + fr, col0 = u.pn * BM + wc * 32 + 8 * fq; float rsv[2][4];
        if (ss) rstd8(ss, row0, sc, rsv); else {
#pragma unroll
            for (int a = 0; a < 2; ++a)
#pragma unroll
                for (int b = 0; b < 4; ++b) rsv[a][b] = sc; }
#pragma unroll
        for (int ai = 0; ai < 2; ++ai)
#pragma unroll
            for (int m = 0; m < 4; ++m) { const int row = row0 + ai * HALF + m * 16; const float rs = rsv[ai][m];
#pragma unroll
                for (int bj = 0; bj < 2; ++bj) *(u32x4*)(O + (size_t)row * ldc + col0 + bj * HALF) = pack8(acc[ai][bj][m][0] * rs, acc[ai][bj][m][1] * rs); }
    }
};
struct EpiWin { static constexpr bool PERM = true, AFTER_DRAIN = false; bf16_t *xa, *xl, *gg, *q, *k, *v; const float* ss; float qscale;
    __device__ __forceinline__ void operator()(const f32x4 (&acc)[2][2][4][2], const Unit& u, int wr, int wc, int fr, int fq) const {
        const int pn = u.pn; bf16_t* dst; int ld, ct; float sc = 1.f; bool act = false;
        if (pn < 2) { dst = xa; ld = 512; ct = pn; } else if (pn < 6) { dst = xl; ld = 1024; ct = pn - 2; } else if (pn < 10) { dst = gg; ld = 1024; ct = pn - 6; act = true; }
        else if (pn < 12) { dst = q; ld = 512; ct = pn - 10; sc = qscale; } else if (pn < 14) { dst = k; ld = 512; ct = pn - 12; } else { dst = v; ld = 512; ct = pn - 14; }
        const int row0 = u.pm * BM + wr * 64 + fr, col0 = ct * BM + wc * 32 + 8 * fq; float rsv[2][4]; rstd8(ss, row0, sc, rsv);
#pragma unroll
        for (int ai = 0; ai < 2; ++ai)
#pragma unroll
            for (int m = 0; m < 4; ++m) { const int row = row0 + ai * HALF + m * 16; const float rs = rsv[ai][m];
#pragma unroll
                for (int bj = 0; bj < 2; ++bj) { f32x4 v0 = acc[ai][bj][m][0] * rs, v1 = acc[ai][bj][m][1] * rs;
                    if (act) {
#pragma unroll
                        for (int i = 0; i < 4; ++i) { v0[i] = fgelu_tanh(v0[i]); v1[i] = fgelu_tanh(v1[i]); } }
                    *(u32x4*)(dst + (size_t)row * ld + col0 + bj * HALF) = pack8(v0, v1); __builtin_amdgcn_sched_barrier(0); } }
    }
};
struct EpiGate { static constexpr bool PERM = true, AFTER_DRAIN = false; bf16_t* stash; const float* bg; const float* ss;
    __device__ __forceinline__ void operator()(const f32x4 (&acc)[2][2][4][2], const Unit& u, int wr, int wc, int fr, int fq) const {
        const int row0 = u.pm * BM + wr * 64 + fr, col0 = u.pn * BM + wc * 32 + 8 * fq; int tid_o = threadIdx.x; asm volatile("" : "+v"(tid_o)); const int tid = tid_o;
        f32x4 bv[2][2];
#pragma unroll
        for (int bj = 0; bj < 2; ++bj)
#pragma unroll
            for (int n = 0; n < 2; ++n) bv[bj][n] = *(const f32x4*)(bg + col0 + bj * HALF + 4 * n);
        float rsv[2][4]; rstd8(ss, row0, 1.f, rsv);
#pragma unroll
        for (int ai = 0; ai < 2; ++ai)
#pragma unroll
            for (int m = 0; m < 4; ++m) { const float rs = rsv[ai][m];
#pragma unroll
                for (int bj = 0; bj < 2; ++bj) { f32x4 v0 = acc[ai][bj][m][0] * rs + bv[bj][0], v1 = acc[ai][bj][m][1] * rs + bv[bj][1];
#pragma unroll
                    for (int i = 0; i < 4; ++i) { v0[i] = fsig(v0[i]); v1[i] = fsig(v1[i]); }
                    *(u32x4*)(stash + ((size_t)((ai * 4 + m) * 2 + bj) * 512 + tid) * 8) = pack8(v0, v1); __builtin_amdgcn_sched_barrier(0); } }
    }
};
struct EpiMerge { static constexpr bool PERM = true, AFTER_DRAIN = false; const bf16_t* stash; bf16_t* mg; int first;
    __device__ __forceinline__ void operator()(const f32x4 (&acc)[2][2][4][2], const Unit& u, int wr, int wc, int fr, int fq) const {
        const int row0 = u.pm * BM + wr * 64 + fr, col0 = u.pn * BM + wc * 32 + 8 * fq; int tid_o = threadIdx.x; asm volatile("" : "+v"(tid_o)); const int tid = tid_o;
#pragma unroll
        for (int ai = 0; ai < 2; ++ai) { u32x4 gw[4][2], ow[4][2];
#pragma unroll
            for (int m = 0; m < 4; ++m)
#pragma unroll
                for (int bj = 0; bj < 2; ++bj) { gw[m][bj] = ld16_sc1(stash + ((size_t)((ai * 4 + m) * 2 + bj) * 512 + tid) * 8);
                    ow[m][bj] = first ? (u32x4){0u, 0u, 0u, 0u} : ld16_sc1(mg + (size_t)(row0 + ai * HALF + m * 16) * 1024 + col0 + bj * HALF); }
#pragma unroll
            for (int m = 0; m < 4; ++m)
#pragma unroll
                for (int bj = 0; bj < 2; ++bj) { PG8_LDWAIT(gw[m][bj]); if (!first) PG8_LDWAIT(ow[m][bj]); }
            __builtin_amdgcn_sched_barrier(0);
#pragma unroll
            for (int m = 0; m < 4; ++m)
#pragma unroll
                for (int bj = 0; bj < 2; ++bj) { const u32x4 g = gw[m][bj], o = ow[m][bj]; f32x4 v0 = acc[ai][bj][m][0], v1 = acc[ai][bj][m][1];
                    v0[0] = v0[0] * bf_lo(g.x) + bf_lo(o.x); v0[1] = v0[1] * bf_hi(g.x) + bf_hi(o.x); v0[2] = v0[2] * bf_lo(g.y) + bf_lo(o.y); v0[3] = v0[3] * bf_hi(g.y) + bf_hi(o.y);
                    v1[0] = v1[0] * bf_lo(g.z) + bf_lo(o.z); v1[1] = v1[1] * bf_hi(g.z) + bf_hi(o.z); v1[2] = v1[2] * bf_lo(g.w) + bf_lo(o.w); v1[3] = v1[3] * bf_hi(g.w) + bf_hi(o.w);
                    *(u32x4*)(mg + (size_t)(row0 + ai * HALF + m * 16) * 1024 + col0 + bj * HALF) = pack8(v0, v1); }
            __builtin_amdgcn_sched_barrier(0); }
    }
};
struct EpiKV { static constexpr bool PERM = true, AFTER_DRAIN = false; bf16_t* kx; bf16_t* vt;
    __device__ __forceinline__ void operator()(const f32x4 (&acc)[2][2][4][2], const Unit& u, int wr, int wc, int fr, int fq) const {
        if (u.pn < 4) { const int row0 = u.pm * BM + wr * 64 + fr, col0 = u.pn * BM + wc * 32 + 8 * fq;
#pragma unroll
            for (int ai = 0; ai < 2; ++ai)
#pragma unroll
                for (int m = 0; m < 4; ++m)
#pragma unroll
                    for (int bj = 0; bj < 2; ++bj) *(u32x4*)(kx + (size_t)(row0 + ai * HALF + m * 16) * 1024 + col0 + bj * HALF) = pack8(acc[ai][bj][m][0], acc[ai][bj][m][1]);
        } else { const int h = u.pn - 4, b = u.pm; bf16_t* base = vt + (size_t)(b * 4 + h) * 65536;
#pragma unroll
            for (int ai = 0; ai < 2; ++ai)
#pragma unroll
                for (int m = 0; m < 4; ++m) { const int mr = ai * HALF + wr * 64 + m * 16 + fr;
#pragma unroll
                    for (int bj = 0; bj < 2; ++bj) { bf16_t* p = base + (size_t)(bj * HALF + wc * 32 + 8 * fq) * 256 + mr; asm volatile("" : "+v"(p));
#pragma unroll
                        for (int n = 0; n < 2; ++n)
#pragma unroll
                            for (int i = 0; i < 4; ++i) p[(4 * n + i) * 256] = (bf16_t)(cvt_pk_bf16(acc[ai][bj][m][n][i], 0.f) & 0xffffu);
                        __builtin_amdgcn_sched_barrier(0); } }
        }
    }
};
struct EpiSoftmaxP { static constexpr bool PERM = true, AFTER_DRAIN = true; bf16_t* P;
    __device__ __forceinline__ void fused(f32x4 (&acc)[2][2][4][2], const Unit& u, int wr, int wc, int fr, int fq, PG8_LAS unsigned char* lds, int wid, int lane) const {
        PG8_LAS f32x2* X = (PG8_LAS f32x2*)lds;
        float mloc[2][4];
#pragma unroll
        for (int ai = 0; ai < 2; ++ai)
#pragma unroll
            for (int m = 0; m < 4; ++m) { float mx = -__builtin_inff();
#pragma unroll
                for (int bj = 0; bj < 2; ++bj)
#pragma unroll
                    for (int n = 0; n < 2; ++n) { const f32x4 v = acc[ai][bj][m][n]; mx = fmaxf(mx, fmaxf(fmaxf(v[0], v[1]), fmaxf(v[2], v[3]))); }
                mx = fmaxf(mx, bperm(mx, (fr + 16 * fq) ^ 16)); mx = fmaxf(mx, bperm(mx, (fr + 16 * fq) ^ 32)); float s = 0.f;
#pragma unroll
                for (int bj = 0; bj < 2; ++bj)
#pragma unroll
                    for (int n = 0; n < 2; ++n) { f32x4 v = acc[ai][bj][m][n];
#pragma unroll
                        for (int i = 0; i < 4; ++i) { v[i] = __builtin_amdgcn_exp2f(v[i] - mx); s += v[i]; }
                        acc[ai][bj][m][n] = v; }
                s += bperm(s, (fr + 16 * fq) ^ 16); s += bperm(s, (fr + 16 * fq) ^ 32); mloc[ai][m] = mx;
                if (fq == 0) X[(ai * HALF + wr * 64 + m * 16 + fr) * 4 + wc] = (f32x2){mx, s}; __builtin_amdgcn_sched_barrier(0); }
        asm volatile("s_waitcnt lgkmcnt(0)" ::: "memory"); __builtin_amdgcn_s_barrier(); asm volatile("" ::: "memory");
#pragma unroll
        for (int ai = 0; ai < 2; ++ai)
#pragma unroll
            for (int m = 0; m < 4; ++m) { const int rl = ai * HALF + wr * 64 + m * 16 + fr;
                const f32x2 a = X[rl * 4 + 0], b = X[rl * 4 + 1], c = X[rl * 4 + 2], d = X[rl * 4 + 3];
                const float M = fmaxf(fmaxf(a.x, b.x), fmaxf(c.x, d.x));
                const float L = a.y * __builtin_amdgcn_exp2f(a.x - M) + b.y * __builtin_amdgcn_exp2f(b.x - M) + c.y * __builtin_amdgcn_exp2f(c.x - M) + d.y * __builtin_amdgcn_exp2f(d.x - M);
                const float f = __builtin_amdgcn_exp2f(mloc[ai][m] - M) / L;
#pragma unroll
                for (int bj = 0; bj < 2; ++bj) *(u32x4*)(P + (size_t)rl * 256 + bj * HALF + wc * 32 + 8 * fq) = pack8(acc[ai][bj][m][0] * f, acc[ai][bj][m][1] * f); __builtin_amdgcn_sched_barrier(0); }
        asm volatile("s_waitcnt vmcnt(0) lgkmcnt(0)" ::: "memory"); __builtin_amdgcn_s_barrier(); asm volatile("" ::: "memory");
    }
};

template <class Epi, class Sched, bool ALIGN_EPI = false, bool SP2 = false>
__device__ __forceinline__ void gemm_phase(PG8_LAS unsigned char* lds, const Gemm g, const Sched& S, const Epi& E) {
    int tid_o = threadIdx.x; asm volatile("" : "+v"(tid_o));
    const int tid = tid_o, wid = __builtin_amdgcn_readfirstlane(tid >> 6), lane = tid & 63, wr = wid >> 2, wc = wid & 3, fr = lane & 15, fq = lane >> 4;
    const int K = g.K, nt = K / BK;
    unsigned voffA[2], voffB[2];
#pragma unroll
    for (int i = 0; i < 2; ++i) { int R, C; stage_rc(tid * 16 + i * 8192, R, C); const int Rb = Epi::PERM ? ((R & ~31) + perm32(R & 31)) : R;
        voffA[i] = (unsigned)(R * g.lda + C) * 2u; voffB[i] = (unsigned)(Rb * g.ldb + C) * 2u; }
    const size_t kstep = (size_t)(BK * 2);
    const size_t hstepA = (size_t)HALF * g.lda * 2, hstepB = (size_t)HALF * g.ldb * 2;
    const size_t tstepA = 2 * hstepA, tstepB = 2 * hstepB;
    const unsigned ldsw = (unsigned)wid * 1024u;
    const int aoff = lds_byte(wr * 64 + fr, fq * 8), boff = lds_byte(wc * 32 + fr, fq * 8);
#define PG8_SA(b, h) (((b) * 2 + (h)) * HTB)
#define PG8_SB(b, h) ((4 + (b) * 2 + (h)) * HTB)
#define PG8_STAGE(bufoff, gbase, voff) do { _Pragma("unroll") for (int _i = 0; _i < 2; ++_i) \
        __builtin_amdgcn_global_load_lds((const unsigned*)((const char*)(gbase) + (voff)[_i]), (PG8_LAS unsigned*)(lds + (bufoff) + ldsw + _i * 8192), 16, 0, 0); } while (0)
#define PG8_LDA(dst, b, h) do { _Pragma("unroll") for (int m = 0; m < 4; ++m) _Pragma("unroll") for (int k = 0; k < 2; ++k) dst[m][k] = *(const PG8_LAS bf16x8*)(lds + PG8_SA(b, h) + aoff + m * 2048 + k * 1024); } while (0)
#define PG8_LDB(dst, b, h) do { _Pragma("unroll") for (int n = 0; n < 2; ++n) _Pragma("unroll") for (int k = 0; k < 2; ++k) dst[n][k] = *(const PG8_LAS bf16x8*)(lds + PG8_SB(b, h) + boff + n * 2048 + k * 1024); } while (0)
#define PG8_MMA(ai, bj, At, Bt) do { __builtin_amdgcn_s_setprio(1); _Pragma("unroll") for (int m = 0; m < 4; ++m) _Pragma("unroll") for (int n = 0; n < 2; ++n) _Pragma("unroll") for (int k = 0; k < 2; ++k) \
        acc[ai][bj][m][n] = __builtin_amdgcn_mfma_f32_16x16x32_bf16(Bt[n][k], At[m][k], acc[ai][bj][m][n], 0, 0, 0); __builtin_amdgcn_s_setprio(0); } while (0)
#define PG8_WAIT_V(n) asm volatile("s_waitcnt vmcnt(" #n ")" ::: "memory")
#define PG8_WAIT_L(n) asm volatile("s_waitcnt lgkmcnt(" #n ")" ::: "memory")
#define PG8_BAR __builtin_amdgcn_s_barrier()
#define PG8_SCHED __builtin_amdgcn_sched_barrier(0)
    Unit cur, nxt; int ui = 0;
    if (!S.next(0, cur)) return;
    f32x4 acc[2][2][4][2];
#pragma unroll
    for (int a = 0; a < 2; ++a)
#pragma unroll
        for (int b = 0; b < 2; ++b)
#pragma unroll
            for (int m = 0; m < 4; ++m)
#pragma unroll
                for (int n = 0; n < 2; ++n) acc[a][b][m][n] = (f32x4){0.f, 0.f, 0.f, 0.f};
    bf16x8 At[4][2], B0[2][2], B1[2][2];
    const char* cA = (const char*)g.A + (size_t)cur.pm * tstepA + (size_t)cur.pn * g.a_pn_off * 2; const char* cB = (const char*)g.Bt + (size_t)cur.pn * tstepB;
    S.a_ready(cur);
    if constexpr (SP2) {
        PG8_STAGE(PG8_SB(0, 0), cB, voffB); PG8_STAGE(PG8_SB(0, 1), cB + hstepB, voffB); PG8_STAGE(PG8_SA(0, 0), cA, voffA); PG8_STAGE(PG8_SA(0, 1), cA + hstepA, voffA);
        if (wr == 1) PG8_BAR;
        PG8_WAIT_V(2); PG8_BAR;
        PG8_STAGE(PG8_SB(1, 0), cB + kstep, voffB); PG8_STAGE(PG8_SA(1, 0), cA + kstep, voffA); PG8_STAGE(PG8_SB(1, 1), cB + hstepB + kstep, voffB);
        PG8_WAIT_V(6); PG8_BAR;
    } else {
        PG8_STAGE(PG8_SB(0, 0), cB, voffB); PG8_STAGE(PG8_SA(0, 0), cA, voffA); PG8_STAGE(PG8_SB(0, 1), cB + hstepB, voffB); PG8_STAGE(PG8_SA(0, 1), cA + hstepA, voffA);
        if (wr == 1) PG8_BAR;
        PG8_WAIT_V(4); PG8_BAR;
        PG8_STAGE(PG8_SB(1, 0), cB + kstep, voffB); PG8_STAGE(PG8_SA(1, 0), cA + kstep, voffA); PG8_STAGE(PG8_SB(1, 1), cB + hstepB + kstep, voffB);
        PG8_WAIT_V(6); PG8_BAR;
    }
    for (;;) {
        const bool has_next = S.next(ui + 1, nxt);
        const char* nA = has_next ? (const char*)g.A + (size_t)nxt.pm * tstepA + (size_t)nxt.pn * g.a_pn_off * 2 : cA; const char* nB = has_next ? (const char*)g.Bt + (size_t)nxt.pn * tstepB : cB;
        for (int t = 0; t < nt; t += 2) {
            const bool last = (t == nt - 2);
            const char* a1 = cA + (size_t)(t + 1) * kstep;
            const char* a2 = last ? nA : cA + (size_t)(t + 2) * kstep; const char* b2 = last ? nB : cB + (size_t)(t + 2) * kstep;
            const char* a3 = a2 + kstep; const char* b3 = b2 + kstep;
            if (last && has_next) S.a_ready(nxt);
            if constexpr (SP2) {
            PG8_LDB(B0, 0, 0); PG8_LDB(B1, 0, 1); PG8_SCHED; PG8_LDA(At, 0, 0); PG8_STAGE(PG8_SA(1, 1), a1 + hstepA, voffA);
            PG8_WAIT_V(8); PG8_WAIT_L(0); PG8_BAR; PG8_MMA(0, 0, At, B0); PG8_MMA(0, 1, At, B1); PG8_BAR; PG8_SCHED;
            PG8_LDA(At, 0, 1); PG8_STAGE(PG8_SB(0, 0), b2, voffB); PG8_STAGE(PG8_SB(0, 1), b2 + hstepB, voffB); PG8_STAGE(PG8_SA(0, 0), a2, voffA);
            PG8_WAIT_V(8); PG8_WAIT_L(0); PG8_BAR; PG8_MMA(1, 0, At, B0); PG8_MMA(1, 1, At, B1); PG8_BAR; PG8_SCHED;
            PG8_LDB(B0, 1, 0); PG8_LDB(B1, 1, 1); PG8_SCHED; PG8_LDA(At, 1, 0); PG8_STAGE(PG8_SA(0, 1), a2 + hstepA, voffA);
            PG8_WAIT_V(8); PG8_WAIT_L(0); PG8_BAR; PG8_MMA(0, 0, At, B0); PG8_MMA(0, 1, At, B1); PG8_BAR; PG8_SCHED;
            PG8_LDA(At, 1, 1); PG8_STAGE(PG8_SB(1, 0), b3, voffB); PG8_STAGE(PG8_SB(1, 1), b3 + hstepB, voffB); PG8_STAGE(PG8_SA(1, 0), a3, voffA);
            PG8_WAIT_V(8); PG8_WAIT_L(0); PG8_BAR; PG8_MMA(1, 0, At, B0); PG8_MMA(1, 1, At, B1); PG8_BAR; PG8_SCHED;
            } else {
            PG8_LDB(B0, 0, 0); PG8_SCHED; PG8_LDA(At, 0, 0); PG8_STAGE(PG8_SA(1, 1), a1 + hstepA, voffA);
            PG8_WAIT_L(8); PG8_BAR; PG8_WAIT_L(0); PG8_MMA(0, 0, At, B0); PG8_BAR; PG8_SCHED;
            PG8_LDB(B1, 0, 1); PG8_STAGE(PG8_SB(0, 0), b2, voffB);
            PG8_BAR; PG8_WAIT_L(0); PG8_MMA(0, 1, At, B1); PG8_BAR;
            PG8_LDA(At, 0, 1); PG8_STAGE(PG8_SA(0, 0), a2, voffA);
            PG8_BAR; PG8_WAIT_L(0); PG8_MMA(1, 0, At, B0); PG8_BAR; PG8_SCHED;
            PG8_STAGE(PG8_SB(0, 1), b2 + hstepB, voffB);
            PG8_WAIT_V(6); PG8_BAR; PG8_MMA(1, 1, At, B1); PG8_BAR;
            PG8_LDB(B0, 1, 0); PG8_SCHED; PG8_LDA(At, 1, 0); PG8_STAGE(PG8_SA(0, 1), a2 + hstepA, voffA);
            PG8_WAIT_L(8); PG8_BAR; PG8_WAIT_L(0); PG8_MMA(0, 0, At, B0); PG8_BAR; PG8_SCHED;
            PG8_LDB(B1, 1, 1); PG8_STAGE(PG8_SB(1, 0), b3, voffB);
            PG8_BAR; PG8_WAIT_L(0); PG8_MMA(0, 1, At, B1); PG8_BAR;
            PG8_LDA(At, 1, 1); PG8_STAGE(PG8_SA(1, 0), a3, voffA);
            PG8_BAR; PG8_WAIT_L(0); PG8_MMA(1, 0, At, B0); PG8_BAR; PG8_SCHED;
            PG8_STAGE(PG8_SB(1, 1), b3 + hstepB, voffB);
            PG8_WAIT_V(6); PG8_BAR; PG8_MMA(1, 1, At, B1); PG8_BAR;
            }
        }
        if constexpr (ALIGN_EPI) { if (wr == 0) PG8_BAR; }
        if constexpr (!Epi::AFTER_DRAIN) { E(acc, cur, wr, wc, fr, fq); S.done(cur); }
        if (!has_next) break;
#pragma unroll
        for (int a = 0; a < 2; ++a)
#pragma unroll
            for (int b = 0; b < 2; ++b)
#pragma unroll
                for (int m = 0; m < 4; ++m)
#pragma unroll
                    for (int n = 0; n < 2; ++n) acc[a][b][m][n] = (f32x4){0.f, 0.f, 0.f, 0.f};
        cur = nxt; cA = nA; cB = nB; ++ui;
        if constexpr (ALIGN_EPI) { if (wr == 1) PG8_BAR; }
    }
    PG8_WAIT_V(0);
    if constexpr (!ALIGN_EPI) { if (wr == 0) PG8_BAR; }
    PG8_BAR;
    if constexpr (Epi::AFTER_DRAIN) { E.fused(acc, cur, wr, wc, fr, fq, lds, wid, lane); S.done(cur); }
#undef PG8_SA
#undef PG8_SB
#undef PG8_STAGE
#undef PG8_LDA
#undef PG8_LDB
#undef PG8_MMA
#undef PG8_WAIT_V
#undef PG8_WAIT_L
#undef PG8_BAR
#undef PG8_SCHED
}
}
#include <hip/hip_bf16.h>
#include <cmath>
#define GAS __attribute__((address_space(1)))
#define LAS __attribute__((address_space(3)))
typedef unsigned short bf16;
typedef unsigned v4u __attribute__((ext_vector_type(4)));
typedef float f32x4 __attribute__((ext_vector_type(4)));
typedef short bf16x8 __attribute__((ext_vector_type(8)));
typedef float f32x16 __attribute__((ext_vector_type(16)));

constexpr int NWAVES = 8, NTHR = 512;
constexpr int BATCH = 2, SEQ = 8192, D = 1024, M = BATCH * SEQ, DFF = 2816, DEPTH = 2;
constexpr int INW = 7176;
constexpr size_t MiB = 1u << 20;
constexpr size_t WS_SS = 0, CTL_ZERO_BYTES = 1 * MiB;
constexpr size_t WS_WFL = 1 * MiB;
constexpr size_t WS_WAT = 1 * MiB + 256 * 1024, WS_WXT = 1 * MiB + 512 * 1024;
constexpr size_t WS_SUMM = 2 * MiB;
constexpr size_t WS_LOGF = 3 * MiB, WS_CTIL = 3 * MiB + 512 * 1024;
constexpr size_t WS_KPART = 7 * MiB;
constexpr size_t WS_MEMN = 4 * MiB, WS_KX = 5 * MiB, WS_VT = 6 * MiB;
constexpr size_t WS_W1IN = 8 * MiB, WS_W1OUT = 19 * MiB, WS_WIN = 25 * MiB, WS_WG = 33 * MiB, WS_UA = 39 * MiB, WS_UB = 40 * MiB, WS_UC = 42 * MiB,
                 WS_WO = 43 * MiB, WS_WXQ = 45 * MiB, WS_WXKV = 47 * MiB, WS_WXO = 51 * MiB, WS_W2IN = 53 * MiB, WS_W2OUT = 64 * MiB;
constexpr size_t WS_XB = 70 * MiB;
constexpr size_t WS_Q = 102 * MiB, WS_GG = 118 * MiB, WS_XA = 150 * MiB, WS_XL = 166 * MiB, WS_K = 198 * MiB, WS_V = 214 * MiB;
constexpr size_t WS_H = 102 * MiB;
constexpr size_t WS_YC = 150 * MiB;
constexpr size_t WS_STASH = 166 * MiB, WS_MG = 198 * MiB, WS_QX = 150 * MiB, WS_PBUF = 198 * MiB;
constexpr size_t WS_YA = 230 * MiB, WS_SSP = 246 * MiB, WS_END = 255 * MiB;
constexpr int LDS_BYTES = 147456;

__device__ __forceinline__ unsigned f2bf(float f) { unsigned u = __builtin_bit_cast(unsigned, f); return (u + 0x7fffu + ((u >> 16) & 1u)) >> 16; }
__device__ __forceinline__ unsigned pk2(float lo, float hi) { return f2bf(lo) | (f2bf(hi) << 16); }
__device__ __forceinline__ float bf2f(unsigned short v) { return __uint_as_float((unsigned)v << 16); }
__device__ __forceinline__ float bperm(float v, int srclane) { return __int_as_float(__builtin_amdgcn_ds_bpermute(srclane << 2, __float_as_int(v))); }
__device__ __forceinline__ float wave_sum(float v, int lane) {
#pragma unroll
    for (int o = 1; o < 64; o <<= 1) v += bperm(v, lane ^ o);
    return v;
}
__device__ __forceinline__ float flog1p(float e) { return e < 0.01f ? e * (1.f - e * (0.5f - e * 0.33333334f)) : __logf(1.f + e); }
#define LDS_WAIT() asm volatile("s_waitcnt lgkmcnt(0)" ::: "memory")

__device__ __forceinline__ void tr_item(const float* W, int ldn, int col0, int k0, const float* g, bf16* WT, int ldk, int drow0, LAS float* scr, int lane) {
    const int n4 = (lane & 15) * 4, kr = lane >> 4;
#pragma unroll
    for (int i = 0; i < 16; ++i) { const int kk = 4 * i + kr; f32x4 v = *(const f32x4*)(W + (size_t)(k0 + kk) * ldn + col0 + n4); if (g) v = v * g[k0 + kk];
        LAS float* d = scr + kk * 65 + n4; d[0] = v.x; d[1] = v.y; d[2] = v.z; d[3] = v.w; }
    LDS_WAIT(); asm volatile("" ::: "memory");
    const int c = lane & 7;
#pragma unroll
    for (int j = 0; j < 8; ++j) { const int n = (lane >> 3) + 8 * j; const LAS float* s = scr + (8 * c) * 65 + n;
        v4u o; o.x = pk2(s[0 * 65], s[1 * 65]); o.y = pk2(s[2 * 65], s[3 * 65]); o.z = pk2(s[4 * 65], s[5 * 65]); o.w = pk2(s[6 * 65], s[7 * 65]);
        *(v4u*)(WT + (size_t)(drow0 + n) * ldk + k0 + 8 * c) = o; }
    LDS_WAIT(); asm volatile("" ::: "memory");
}

#define RLX_AGENT __ATOMIC_RELAXED, __HIP_MEMORY_SCOPE_AGENT
#define XB_TMO      128
#define XB_XCNT(j)  (256  + 64 * (j))
#define XB_XSUB(j)  (1280 + 64 * (j))
#define XB_XGEN(j)  (2304 + 64 * (j))
#define XB_TOP      3328
#define XB_TOPGEN   3392
#define XCD_BAR_WORDS 3456
#define XB_SPIN_CAP (1u << 18)

__device__ __forceinline__ unsigned xb_ld(unsigned* p)              { return __hip_atomic_load(p, __ATOMIC_RELAXED, __HIP_MEMORY_SCOPE_AGENT); }
__device__ __forceinline__ unsigned xb_add(unsigned* p, unsigned v) { return __hip_atomic_fetch_add(p, v, __ATOMIC_RELAXED, __HIP_MEMORY_SCOPE_AGENT); }
__device__ __forceinline__ unsigned xb_xcc_id() { return (unsigned)__builtin_amdgcn_s_getreg((3 << 11) | 20) & 0xFu; }
#define XB_SPIN(cond, bar) do { unsigned _sp = 0; while (cond) { __builtin_amdgcn_s_sleep(1); \
    if ((++_sp & 255u) == 0u) { if (xb_ld(&(bar)[XB_TMO])) break; if (_sp > XB_SPIN_CAP) { atomicAdd(&(bar)[XB_TMO], 1u); break; } } } } while (0)

struct XcdBarrier {
    unsigned* bar; unsigned x;
    volatile LAS unsigned* st;
};

__device__ __forceinline__ XcdBarrier xcd_barrier_post(unsigned* bar, volatile LAS unsigned* st) {
    XcdBarrier b; b.bar = bar; b.x = xb_xcc_id(); b.st = st;
    if (threadIdx.x == 0) (void)xb_add(&bar[XB_XCNT(b.x)], 1u);
    return b;
}
__device__ __forceinline__ void xcd_barrier_complete(unsigned* bar, unsigned x, unsigned& nloc, unsigned& nx) {
    const unsigned G = gridDim.x * gridDim.y * gridDim.z;
    unsigned sum, cnt, mine, sp = 0u;
    for (;;) {
        sum = 0u; cnt = 0u; mine = 0u;
#pragma unroll
        for (unsigned j = 0; j < 16; ++j) { const unsigned c = xb_ld(&bar[XB_XCNT(j)]); sum += c; cnt += (c > 0u) ? 1u : 0u; mine = (j == x) ? c : mine; }
        if (sum == G) break;
        __builtin_amdgcn_s_sleep(1);
        if ((++sp & 255u) == 0u) { if (xb_ld(&bar[XB_TMO])) break; if (sp > XB_SPIN_CAP) { atomicAdd(&bar[XB_TMO], 1u); break; } }
    }
    nloc = mine > 0u ? mine : 1u; nx = cnt > 0u ? cnt : 1u;
}

__device__ __forceinline__ void xcd_barrier(const XcdBarrier& b) {
    asm volatile("s_waitcnt vmcnt(0)" ::: "memory");
    __syncthreads();
    if (threadIdx.x == 0) {
        unsigned* bar = b.bar;
        __builtin_amdgcn_s_waitcnt(0);
        unsigned nloc = b.st[0], nx = b.st[1];
        if (nloc == 0u) { xcd_barrier_complete(bar, b.x, nloc, nx); b.st[0] = nloc; b.st[1] = nx; }
        const unsigned old = xb_add(&bar[XB_XSUB(b.x)], 1u);
        const unsigned gen = old / nloc;
        if (old + 1u == (gen + 1u) * nloc) {
            __builtin_amdgcn_fence(__ATOMIC_RELEASE, "agent");
            asm volatile("s_waitcnt vmcnt(0)" ::: "memory");
            const unsigned og = xb_add(&bar[XB_TOP], 1u);
            const unsigned tg = og / nx;
            if (og + 1u == (tg + 1u) * nx) xb_add(&bar[XB_TOPGEN], 1u);
            else XB_SPIN(xb_ld(&bar[XB_TOPGEN]) == tg, bar);
            __builtin_amdgcn_fence(__ATOMIC_ACQUIRE, "agent");
            xb_add(&bar[XB_XGEN(b.x)], 1u);
            asm volatile("s_waitcnt vmcnt(0)" ::: "memory");
        } else {
            XB_SPIN(xb_ld(&bar[XB_XGEN(b.x)]) == gen, bar);
            __builtin_amdgcn_fence(__ATOMIC_ACQUIRE, "agent");
            asm volatile("s_waitcnt vmcnt(0)" ::: "memory");
        }
    }
    __syncthreads();
}

struct Args { const float* in[31]; float* out; unsigned char* ws; int pad[2]; };
typedef LAS unsigned long long* PtrTab;
__device__ __forceinline__ const float* tab_in(PtrTab tb, int k) { const unsigned long long v = tb[k]; const unsigned lo = __builtin_amdgcn_readfirstlane((unsigned)v), hi = __builtin_amdgcn_readfirstlane((unsigned)(v >> 32));
    return (const float*)(const GAS float*)(((unsigned long long)hi << 32) | lo); }
constexpr int TAB_OFF = 147456 - 512;
constexpr size_t WS_BAR = 768 * 1024; constexpr size_t WS_QCTR = 832 * 1024;

__device__ __forceinline__ void phase_prologue(PtrTab TB, unsigned char* ws, float* xout, int l, LAS unsigned char* lds, int gw, int NGW, int lane, int wave) {
    LAS float* scr = (LAS float*)(lds + wave * 16640);
#define g1 (tab_in(TB, 2) + l * D)
#define w1i (tab_in(TB, 3) + (size_t)l * D * 2 * DFF)
#define w1o (tab_in(TB, 4) + (size_t)l * DFF * D)
#define gm (tab_in(TB, 5) + l * D)
#define win (tab_in(TB, 6) + (size_t)l * D * INW)
#define wpool (tab_in(TB, 9) + (size_t)l * 4 * 128 * 128)
#define psc (tab_in(TB, 10) + l * 512)
#define wua (tab_in(TB, 11) + (size_t)l * 512 * D)
#define wra (tab_in(TB, 14) + (size_t)l * 8 * 128 * 128)
#define wrx (tab_in(TB, 16) + (size_t)l * 8 * 128 * 128)
#define wub (tab_in(TB, 19) + (size_t)l * D * D)
#define wuc (tab_in(TB, 20) + (size_t)l * 512 * D)
#define wo (tab_in(TB, 21) + (size_t)l * D * D)
#define gc (tab_in(TB, 22) + l * D)
#define gmem (tab_in(TB, 23) + l * D)
#define wxq (tab_in(TB, 24) + (size_t)l * D * D)
#define wxkv (tab_in(TB, 25) + (size_t)l * D * 2 * D)
#define wxo (tab_in(TB, 26) + (size_t)l * D * D)
#define g2 (tab_in(TB, 27) + l * D)
#define w2i (tab_in(TB, 28) + (size_t)l * D * 2 * DFF)
#define w2o (tab_in(TB, 29) + (size_t)l * DFF * D)
    constexpr int I_FI = 16 * 88, I_FO = 44 * 16, I_WIN = 16 * 64, I_WG = 16 * 48, I_UB = 16 * 16, I_UC = 8 * 16, I_RG = 32, I_SQ = 16 * 16, I_KV = 16 * 32;
    constexpr int S0 = 0, S1 = S0 + I_FI, S2 = S1 + I_FO, S3 = S2 + I_WIN, S4 = S3 + I_WG, S5 = S4 + I_UB, S6 = S5 + I_UC, S7 = S6 + I_RG, S8 = S7 + I_RG, S9 = S8 + I_SQ, S10 = S9 + I_SQ,
                  S11 = S10 + I_KV, S12 = S11 + I_SQ, S13 = S12 + I_FI, S14 = S13 + I_FO;
    for (int it = gw; it < S14; it += NGW) {
        if (it < S1 || (it >= S12 && it < S13)) {
            const bool second = it >= S12; const int r = second ? it - S12 : it; const int kb = r / 88, nb = r % 88; const int n = nb * 64;
            const int half = n >= DFF ? 1 : 0, nn = n - half * DFF; const int drow = (nn >> 7) * 256 + half * 128 + (nn & 127);
            tr_item(second ? w2i : w1i, 2 * DFF, n, kb * 64, second ? g2 : g1, (bf16*)(ws + (second ? WS_W2IN : WS_W1IN)), D, drow, scr, lane);
        } else if (it < S2 || it >= S13) {
            const bool second = it >= S13; const int r = second ? it - S13 : it - S1; const int kb = r / 16, nb = r % 16;
            tr_item(second ? w2o : w1o, D, nb * 64, kb * 64, nullptr, (bf16*)(ws + (second ? WS_W2OUT : WS_W1OUT)), DFF, nb * 64, scr, lane);
        } else if (it < S3) { const int r = it - S2, kb = r / 64, nb = r % 64; tr_item(win, INW, nb * 64, kb * 64, gm, (bf16*)(ws + WS_WIN), D, nb * 64, scr, lane);
        } else if (it < S4) { const int r = it - S3, kb = r / 48, nb = r % 48; tr_item(win, INW, 4104 + nb * 64, kb * 64, gm, (bf16*)(ws + WS_WG), D, nb * 64, scr, lane);
        } else if (it < S5) { const int r = it - S4, kb = r / 16, nb = r % 16; tr_item(wub, D, nb * 64, kb * 64, nullptr, (bf16*)(ws + WS_UB), D, nb * 64, scr, lane);
        } else if (it < S6) { const int r = it - S5, kb = r / 16, nb = r % 16; tr_item(wuc, D, nb * 64, kb * 64, nullptr, (bf16*)(ws + WS_UC), 512, nb * 64, scr, lane);
        } else if (it < S8) { const bool xg = it >= S7; const int r = xg ? it - S7 : it - S6; const int hh = r >> 2, kb = (r >> 1) & 1, nb = r & 1;
            tr_item((xg ? wrx : wra) + hh * 16384, 128, nb * 64, kb * 64, nullptr, (bf16*)(ws + (xg ? WS_WXT : WS_WAT)) + hh * 16384, 128, nb * 64, scr, lane);
        } else if (it < S9) { const int r = it - S8, kb = r / 16, nb = r % 16; tr_item(wo, D, nb * 64, kb * 64, nullptr, (bf16*)(ws + WS_WO), D, nb * 64, scr, lane);
        } else if (it < S10) { const int r = it - S9, kb = r / 16, nb = r % 16; tr_item(wxq, D, nb * 64, kb * 64, gc, (bf16*)(ws + WS_WXQ), D, nb * 64, scr, lane);
        } else if (it < S11) { const int r = it - S10, kb = r / 32, nb = r % 32; tr_item(wxkv, 2 * D, nb * 64, kb * 64, nullptr, (bf16*)(ws + WS_WXKV), D, nb * 64, scr, lane);
        } else { const int r = it - S11, kb = r / 16, nb = r % 16; tr_item(wxo, D, nb * 64, kb * 64, nullptr, (bf16*)(ws + WS_WXO), D, nb * 64, scr, lane); }
    }
    { bf16* UaT = (bf16*)(ws + WS_UA);
      for (int it = gw; it < 4 * 16 * 16; it += NGW) { const int g = it >> 8, nblk = (it >> 4) & 15, c0 = (it & 15) * 8, n = nblk * 64 + lane;
          const float* wp = wpool + ((size_t)g * 128 + c0) * 128; const float* sc = psc + g * 128; const float* ua = wua + (size_t)(g * 128) * D + n; float acc[8];
#pragma unroll
          for (int c = 0; c < 8; ++c) acc[c] = 0.f;
#pragma unroll 16
          for (int j = 0; j < 128; ++j) { const float u = ua[(size_t)j * D] * sc[j];
#pragma unroll
              for (int c = 0; c < 8; ++c) acc[c] += wp[c * 128 + j] * u; }
          v4u o; o.x = pk2(acc[0], acc[1]); o.y = pk2(acc[2], acc[3]); o.z = pk2(acc[4], acc[5]); o.w = pk2(acc[6], acc[7]);
          *(v4u*)(UaT + (size_t)n * 512 + g * 128 + c0) = o; } }
    { float* wfl = (float*)(ws + WS_WFL);
      for (int it = gw * 64 + lane; it < 8 * 1024; it += NGW * 64) { const int h = it >> 10, k = it & 1023; wfl[it] = gm[k] * win[(size_t)k * INW + 4096 + h]; } }
    { const float* mem = tab_in(TB, 1); bf16* mn = (bf16*)(ws + WS_MEMN);
      for (int r = gw; r < 512; r += NGW) { const f32x4* xr = (const f32x4*)(mem + (size_t)r * D) + lane; f32x4 v[4]; float s = 0.f;
#pragma unroll
          for (int j = 0; j < 4; ++j) { v[j] = xr[64 * j]; s += (v[j].x * v[j].x + v[j].y * v[j].y) + (v[j].z * v[j].z + v[j].w * v[j].w); }
          const float rs = rsqrtf(wave_sum(s, lane) * (1.f / D) + 1e-6f); unsigned long long* o8 = (unsigned long long*)(mn + (size_t)r * D) + lane;
#pragma unroll
          for (int j = 0; j < 4; ++j) { const f32x4 gv = *((const f32x4*)gmem + lane + 64 * j);
              o8[64 * j] = (unsigned long long)pk2(v[j].x * rs * gv.x, v[j].y * rs * gv.y) | ((unsigned long long)pk2(v[j].z * rs * gv.z, v[j].w * rs * gv.w) << 32); } } }
    if (l == 0) {
        const float* x = tab_in(TB, 0); float* xo = xout; bf16* xb = (bf16*)(ws + WS_XB); float* ss = (float*)(ws + WS_SSP);
        for (int r = gw; r < M; r += NGW) { const f32x4* xr = (const f32x4*)(x + (size_t)r * D) + lane; f32x4* orow = (f32x4*)(xo + (size_t)r * D) + lane; f32x4 v[4]; float s = 0.f;
#pragma unroll
            for (int j = 0; j < 4; ++j) { v[j] = xr[64 * j]; orow[64 * j] = v[j]; s += (v[j].x * v[j].x + v[j].y * v[j].y) + (v[j].z * v[j].z + v[j].w * v[j].w); }
            s = wave_sum(s, lane); if (lane < 4) ss[(size_t)r * 4 + lane] = lane == 0 ? s : 0.f; unsigned long long* o8 = (unsigned long long*)(xb + (size_t)r * D) + lane;
#pragma unroll
            for (int j = 0; j < 4; ++j) o8[64 * j] = (unsigned long long)pk2(v[j].x, v[j].y) | ((unsigned long long)pk2(v[j].z, v[j].w) << 32); }
    }
}
#undef g1
#undef w1i
#undef w1o
#undef gm
#undef win
#undef wpool
#undef psc
#undef wua
#undef wra
#undef wrx
#undef wub
#undef wuc
#undef wo
#undef gc
#undef gmem
#undef wxq
#undef wxkv
#undef wxo
#undef g2
#undef w2i
#undef w2o
__device__ __forceinline__ void phase_fl(const bf16* xb, const float* wfl, const float* bfv, const float* ss, float* logf, int gw, int NGW, int lane) {
    for (int r = gw; r < M; r += NGW) {
        float acc[8];
#pragma unroll
        for (int h = 0; h < 8; ++h) acc[h] = 0.f;
#pragma unroll
        for (int j = 0; j < 2; ++j) { const int k0 = 8 * lane + 512 * j; const v4u xv = *(const v4u*)(xb + (size_t)r * D + k0);
            float xf[8]; xf[0] = __uint_as_float(xv.x << 16); xf[1] = __uint_as_float(xv.x & 0xffff0000u); xf[2] = __uint_as_float(xv.y << 16); xf[3] = __uint_as_float(xv.y & 0xffff0000u);
            xf[4] = __uint_as_float(xv.z << 16); xf[5] = __uint_as_float(xv.z & 0xffff0000u); xf[6] = __uint_as_float(xv.w << 16); xf[7] = __uint_as_float(xv.w & 0xffff0000u);
#pragma unroll
            for (int h = 0; h < 8; ++h) { const f32x4 w0 = *(const f32x4*)(wfl + h * 1024 + k0), w1 = *(const f32x4*)(wfl + h * 1024 + k0 + 4);
                acc[h] += (xf[0] * w0.x + xf[1] * w0.y) + (xf[2] * w0.z + xf[3] * w0.w) + (xf[4] * w1.x + xf[5] * w1.y) + (xf[6] * w1.z + xf[7] * w1.w); } }
        const float rs = pg8::rstd_of(ss, r);
        float v4[4], v2[2], v1;
        { const bool up = (lane & 32) != 0;
#pragma unroll
          for (int i = 0; i < 4; ++i) { const float mine = up ? acc[4 + i] : acc[i], other = up ? acc[i] : acc[4 + i]; v4[i] = mine + bperm(other, lane ^ 32); } }
        { const bool up = (lane & 16) != 0;
#pragma unroll
          for (int i = 0; i < 2; ++i) { const float mine = up ? v4[2 + i] : v4[i], other = up ? v4[i] : v4[2 + i]; v2[i] = mine + bperm(other, lane ^ 16); } }
        { const bool up = (lane & 8) != 0; const float mine = up ? v2[1] : v2[0], other = up ? v2[0] : v2[1]; v1 = mine + bperm(other, lane ^ 8); }
        v1 += bperm(v1, lane ^ 4); v1 += bperm(v1, lane ^ 2); v1 += bperm(v1, lane ^ 1);
        { const int h = ((lane >> 5) & 1) * 4 + ((lane >> 4) & 1) * 2 + ((lane >> 3) & 1); const float z = v1 * rs + bfv[h]; const float ls = -(fmaxf(-z, 0.f) + flog1p(__expf(-fabsf(z)))); if ((lane & 7) == 0) logf[(size_t)r * 8 + h] = ls; }
    }
}
__device__ __forceinline__ void cumsum_bh(const float* logf, float* ctil, int bh, LAS float* red) {
    int tid_o = threadIdx.x; asm volatile("" : "+v"(tid_o)); const int tid = tid_o, lane = tid & 63, wid = tid >> 6;
    const int b = bh >> 3, h = bh & 7; const float* src = logf + ((size_t)b * SEQ + 16 * tid) * 8 + h; float v[16]; float s = 0.f;
#pragma unroll
    for (int i = 0; i < 16; ++i) { v[i] = src[(size_t)i * 8]; s += v[i]; }
    float incl = s;
#pragma unroll
    for (int o = 1; o < 64; o <<= 1) { const float t = bperm(incl, lane - o); if (lane >= o) incl += t; }
    if (lane == 63) red[wid] = incl;
    __syncthreads();
    float base = 0.f;
#pragma unroll
    for (int w = 0; w < 8; ++w) if (w < wid) base += red[w];
    float run = base + incl - s; float* dst = ctil + (size_t)bh * SEQ + 16 * tid;
#pragma unroll
    for (int i = 0; i < 16; ++i) { run += v[i]; dst[i] = run * 1.4426950408889634f; }
    __syncthreads();
}
__device__ __forceinline__ void unpk8(const v4u xv, float (&xf)[8]) { xf[0] = __uint_as_float(xv.x << 16); xf[1] = __uint_as_float(xv.x & 0xffff0000u); xf[2] = __uint_as_float(xv.y << 16); xf[3] = __uint_as_float(xv.y & 0xffff0000u);
    xf[4] = __uint_as_float(xv.z << 16); xf[5] = __uint_as_float(xv.z & 0xffff0000u); xf[6] = __uint_as_float(xv.w << 16); xf[7] = __uint_as_float(xv.w & 0xffff0000u); }
template <int W> __device__ __forceinline__ void pool_item(const bf16* xa, bf16* ya, int m0, int cgi) {
    const int t0 = m0 & (SEQ - 1); v4u rw[W + 7];
#pragma unroll
    for (int a = 0; a < W + 7; ++a) { const int tl = a - (W - 1); rw[a] = (t0 + tl >= 0) ? *(const v4u*)(xa + (size_t)(m0 + tl) * 512 + 8 * cgi) : (v4u){0u, 0u, 0u, 0u}; }
    float s[8];
#pragma unroll
    for (int i = 0; i < 8; ++i) s[i] = 0.f;
#pragma unroll
    for (int a = 0; a < W - 1; ++a) { float xf[8]; unpk8(rw[a], xf);
#pragma unroll
        for (int i = 0; i < 8; ++i) s[i] += xf[i]; }
#pragma unroll
    for (int o = 0; o < 8; ++o) { float cur[8]; unpk8(rw[o + W - 1], cur);
#pragma unroll
        for (int i = 0; i < 8; ++i) s[i] += cur[i];
        const int t = t0 + o, cnt = (t + 1 < W) ? t + 1 : W; const float ic = 1.f / (float)cnt; v4u ov;
        ov.x = pk2(s[0] * ic - cur[0], s[1] * ic - cur[1]); ov.y = pk2(s[2] * ic - cur[2], s[3] * ic - cur[3]); ov.z = pk2(s[4] * ic - cur[4], s[5] * ic - cur[5]); ov.w = pk2(s[6] * ic - cur[6], s[7] * ic - cur[7]);
        *(v4u*)(ya + (size_t)(m0 + o) * 512 + 8 * cgi) = ov;
        float old[8]; unpk8(rw[o], old);
#pragma unroll
        for (int i = 0; i < 8; ++i) s[i] -= old[i]; }
}
__device__ __forceinline__ void phase_pool(const bf16* xa, bf16* ya, int gtid, int nthr) {
    for (int idx = gtid; idx < (M / 8) * 64; idx += nthr) { const int c16 = idx & 15, rl = (idx >> 4) & 3, g = (idx >> 6) & 3, rh = idx >> 8; const int m0 = (rh * 4 + rl) * 8, cgi = g * 16 + c16;
        if (g == 0) pool_item<2>(xa, ya, m0, cgi); else if (g == 1) pool_item<4>(xa, ya, m0, cgi); else if (g == 2) pool_item<8>(xa, ya, m0, cgi); else pool_item<16>(xa, ya, m0, cgi); }
}
__device__ __forceinline__ int crow16(int r, int hi) { return (r & 3) + 8 * (r >> 2) + 4 * hi; }
template <bool FINAL>
__device__ __forceinline__ void lru_item(LAS unsigned char* lds, int b, int hp, int ck, const bf16* xl, bf16* gg, const float* cw, const float* cb, const bf16* WaT, const bf16* WxT,
                                         const float* ba, const float* bx, const float* lam, float* summ) {
    int tid_o = threadIdx.x; asm volatile("" : "+v"(tid_o)); const int tid = tid_o, lane = tid & 63, wid = tid >> 6, r32 = lane & 31, hi = lane >> 5;
    const int t0 = ck * 128; const size_t m0 = (size_t)b * SEQ + t0; const int ch0 = hp * 256;
    constexpr int XP = 264;
    LAS bf16* xc = (LAS bf16*)lds; LAS float* h0s = (LAS float*)(lds + 128 * XP * 2);
    {
        const int cgi = tid & 31, tq = tid >> 5, c = ch0 + 8 * cgi;
        float w[4][8], bb[8];
#pragma unroll
        for (int k = 0; k < 4; ++k) { const f32x4 a = *(const f32x4*)(cw + k * 1024 + c), d = *(const f32x4*)(cw + k * 1024 + c + 4); w[k][0] = a.x; w[k][1] = a.y; w[k][2] = a.z; w[k][3] = a.w; w[k][4] = d.x; w[k][5] = d.y; w[k][6] = d.z; w[k][7] = d.w; }
        { const f32x4 a = *(const f32x4*)(cb + c), d = *(const f32x4*)(cb + c + 4); bb[0] = a.x; bb[1] = a.y; bb[2] = a.z; bb[3] = a.w; bb[4] = d.x; bb[5] = d.y; bb[6] = d.z; bb[7] = d.w; }
        v4u rw[11];
#pragma unroll
        for (int i = 0; i < 11; ++i) { const int tl = tq * 8 - 3 + i; rw[i] = (t0 + tl >= 0) ? *(const v4u*)(xl + (size_t)((long)m0 + tl) * 1024 + c) : (v4u){0u, 0u, 0u, 0u}; }
#pragma unroll
        for (int o = 0; o < 8; ++o) { float y[8];
#pragma unroll
            for (int j = 0; j < 8; ++j) y[j] = bb[j];
#pragma unroll
            for (int k = 0; k < 4; ++k) { const v4u xv = rw[o + k];
                y[0] += w[k][0] * __uint_as_float(xv.x << 16); y[1] += w[k][1] * __uint_as_float(xv.x & 0xffff0000u); y[2] += w[k][2] * __uint_as_float(xv.y << 16); y[3] += w[k][3] * __uint_as_float(xv.y & 0xffff0000u);
                y[4] += w[k][4] * __uint_as_float(xv.z << 16); y[5] += w[k][5] * __uint_as_float(xv.z & 0xffff0000u); y[6] += w[k][6] * __uint_as_float(xv.w << 16); y[7] += w[k][7] * __uint_as_float(xv.w & 0xffff0000u); }
            v4u ov; ov.x = pk2(y[0], y[1]); ov.y = pk2(y[2], y[3]); ov.z = pk2(y[4], y[5]); ov.w = pk2(y[6], y[7]);
            *(LAS v4u*)(xc + (tq * 8 + o) * XP + 8 * cgi) = ov; }
    }
    if (FINAL && tid < 256) {
        const float* sp = summ + ((size_t)b * 64 * 1024 + ch0 + tid) * 2; float h = 0.f;
        for (int c0 = 0; c0 < ck; c0 += 16) { float2 v[16];
#pragma unroll
            for (int j = 0; j < 16; ++j) v[j] = (c0 + j < ck) ? *(const float2*)(sp + (size_t)(c0 + j) * 2048) : make_float2(1.f, 0.f);
#pragma unroll
            for (int j = 0; j < 16; ++j) h = v[j].x * h + v[j].y; }
        h0s[tid] = h;
    }
    __syncthreads();
    const int hh = wid >> 2, s = wid & 3, chl = 128 * hh + 32 * s + r32, ch = ch0 + chl, head = 2 * hp + hh;
    const float bav = ba[ch], bxv = bx[ch]; const float nl = -lam[ch]; const float sp8 = 8.f * (fmaxf(nl, 0.f) + flog1p(__expf(-fabsf(nl))));
    bf16x8 fa[8], fx[8];
#pragma unroll
    for (int ks = 0; ks < 8; ++ks) { fa[ks] = *(const bf16x8*)(WaT + (size_t)head * 16384 + (32 * s + r32) * 128 + 16 * ks + 8 * hi); fx[ks] = *(const bf16x8*)(WxT + (size_t)head * 16384 + (32 * s + r32) * 128 + 16 * ks + 8 * hi); }
    float hrun = FINAL ? h0s[chl] : 0.f, Arun = 1.f;
    for (int mb = 0; mb < 4; ++mb) {
        unsigned short gv[16];
        if (FINAL) {
#pragma unroll
            for (int r = 0; r < 16; ++r) gv[r] = gg[(m0 + 32 * mb + crow16(r, hi)) * 1024 + ch]; }
        f32x16 accA = {0.f, 0.f, 0.f, 0.f, 0.f, 0.f, 0.f, 0.f, 0.f, 0.f, 0.f, 0.f, 0.f, 0.f, 0.f, 0.f}, accX = accA;
#pragma unroll
        for (int ks = 0; ks < 8; ++ks) { const bf16x8 af = *(const LAS bf16x8*)(xc + (32 * mb + r32) * XP + 128 * hh + 16 * ks + 8 * hi);
            accA = __builtin_amdgcn_mfma_f32_32x32x16_bf16(af, fa[ks], accA, 0, 0, 0); accX = __builtin_amdgcn_mfma_f32_32x32x16_bf16(af, fx[ks], accX, 0, 0, 0); }
        float a[16], u[16];
#pragma unroll
        for (int r = 0; r < 16; ++r) { const int tok = 32 * mb + crow16(r, hi); const float xcv = bf2f(xc[tok * XP + chl]);
            const float rg = pg8::fsig(accA[r] + bav), la = -rg * sp8, av = __expf(la), mult = sqrtf(fmaxf(1.f - av * av, 0.f)), ig = pg8::fsig(accX[r] + bxv);
            a[r] = av; u[r] = mult * ig * xcv; }
        float As[4], Hs[4], Ap[4], Hp[4], hin[4];
#pragma unroll
        for (int g = 0; g < 4; ++g) { float Aq = 1.f, Hq = 0.f;
#pragma unroll
            for (int i = 0; i < 4; ++i) { Hq = a[4 * g + i] * Hq + u[4 * g + i]; Aq *= a[4 * g + i]; }
            As[g] = Aq; Hs[g] = Hq; Ap[g] = bperm(Aq, lane ^ 32); Hp[g] = bperm(Hq, lane ^ 32); }
#pragma unroll
        for (int g = 0; g < 4; ++g) { const float A0 = hi ? Ap[g] : As[g], H0 = hi ? Hp[g] : Hs[g], A1 = hi ? As[g] : Ap[g], H1 = hi ? Hs[g] : Hp[g];
            const float hA = hrun, hB = A0 * hA + H0; hrun = A1 * hB + H1; Arun *= A0 * A1; hin[g] = hi ? hB : hA; }
        if (FINAL) {
#pragma unroll
            for (int g = 0; g < 4; ++g) { float hc = hin[g];
#pragma unroll
                for (int i = 0; i < 4; ++i) { const int r = 4 * g + i; hc = a[r] * hc + u[r]; gv[r] = (unsigned short)f2bf(hc * bf2f(gv[r])); } }
#pragma unroll
            for (int r = 0; r < 16; ++r) gg[(m0 + 32 * mb + crow16(r, hi)) * 1024 + ch] = gv[r];
        }
    }
    if (!FINAL && hi == 0) { float* sp = summ + (((size_t)b * 64 + ck) * 1024 + ch) * 2; sp[0] = Arun; sp[1] = hrun; }
    __syncthreads();
}
__device__ __forceinline__ void phase_final(float* x, const float* g, int gw, int NGW, int lane) {
    for (int r = gw; r < M; r += NGW) { f32x4* xr = (f32x4*)(x + (size_t)r * D) + lane; f32x4 v[4]; float s = 0.f;
#pragma unroll
        for (int j = 0; j < 4; ++j) { v[j] = xr[64 * j]; s += (v[j].x * v[j].x + v[j].y * v[j].y) + (v[j].z * v[j].z + v[j].w * v[j].w); }
        const float rs = rsqrtf(wave_sum(s, lane) * (1.f / D) + 1e-6f);
#pragma unroll
        for (int j = 0; j < 4; ++j) { const f32x4 gv = *((const f32x4*)g + lane + 64 * j); xr[64 * j] = (f32x4){v[j].x * rs * gv.x, v[j].y * rs * gv.y, v[j].z * rs * gv.z, v[j].w * rs * gv.w}; } }
}
__device__ __forceinline__ void phase_kmax(const bf16* K, float* kpart, int gw, int NGW, int lane) {
    float m0 = 0.f, m1 = 0.f;
#pragma unroll 8
    for (int r = gw; r < M; r += NGW) { const v4u w = *(const v4u*)(K + (size_t)r * 512 + 8 * lane);
        const float a0 = __uint_as_float(w.x << 16), a1 = __uint_as_float(w.x & 0xffff0000u), a2 = __uint_as_float(w.y << 16), a3 = __uint_as_float(w.y & 0xffff0000u);
        const float a4 = __uint_as_float(w.z << 16), a5 = __uint_as_float(w.z & 0xffff0000u), a6 = __uint_as_float(w.w << 16), a7 = __uint_as_float(w.w & 0xffff0000u);
        float s = (a0 * a0 + a1 * a1) + (a2 * a2 + a3 * a3) + (a4 * a4 + a5 * a5) + (a6 * a6 + a7 * a7);
        s += bperm(s, lane ^ 1); s += bperm(s, lane ^ 2); s += bperm(s, lane ^ 4);
        if (r < SEQ) m0 = fmaxf(m0, s); else m1 = fmaxf(m1, s); }
    if ((lane & 7) == 0) { kpart[((size_t)gw * 2 + 0) * 8 + (lane >> 3)] = m0; kpart[((size_t)gw * 2 + 1) * 8 + (lane >> 3)] = m1; }
}
constexpr float FOX_C2 = 0.125f * 1.4426950408889634f;
constexpr float FOX_SKIP = 64.f;
constexpr int FOX_KP = 72;
constexpr int FOX_BUF = 2 * 64 * FOX_KP * 2 + 256;
__device__ __forceinline__ void fox_unit(LAS unsigned char* lds, int b, int h, int qb, const bf16* Q, const bf16* K, const bf16* V, bf16* O, const float* ct, const float* kpart, int nparts) {
    int tid_o = threadIdx.x; asm volatile("" : "+v"(tid_o)); const int tid = tid_o, lane = tid & 63, wid = tid >> 6, r32 = lane & 31, hi = lane >> 5;
    const size_t rowbase = (size_t)b * SEQ; const int q0 = qb * 256, NT = 4 * qb + 4;
    const bf16* Qw = Q + (rowbase + q0 + wid * 32 + r32) * 512 + h * 64;
    bf16x8 qr[4];
#pragma unroll
    for (int d0 = 0; d0 < 4; ++d0) qr[d0] = *(const bf16x8*)(Qw + 16 * d0 + 8 * hi);
    LAS float* red = (LAS float*)(lds + 2 * FOX_BUF); LAS int* tsl = (LAS int*)(lds + 2 * FOX_BUF + 128);
    { float qn = 0.f;
#pragma unroll
      for (int d0 = 0; d0 < 4; ++d0) { const v4u w = __builtin_bit_cast(v4u, qr[d0]);
          const float a0 = __uint_as_float(w.x << 16), a1 = __uint_as_float(w.x & 0xffff0000u), a2 = __uint_as_float(w.y << 16), a3 = __uint_as_float(w.y & 0xffff0000u);
          const float a4 = __uint_as_float(w.z << 16), a5 = __uint_as_float(w.z & 0xffff0000u), a6 = __uint_as_float(w.w << 16), a7 = __uint_as_float(w.w & 0xffff0000u);
          qn += (a0 * a0 + a1 * a1) + (a2 * a2 + a3 * a3) + (a4 * a4 + a5 * a5) + (a6 * a6 + a7 * a7); }
      qn += bperm(qn, lane ^ 32);
#pragma unroll
      for (int o = 1; o < 32; o <<= 1) qn = fmaxf(qn, bperm(qn, lane ^ o));
      __syncthreads();
      float km = 0.f;
      for (int i = tid; i < nparts; i += NTHR) km = fmaxf(km, kpart[((size_t)i * 2 + b) * 8 + h]);
#pragma unroll
      for (int o = 1; o < 64; o <<= 1) km = fmaxf(km, bperm(km, lane ^ o));
      if (lane == 0) { red[wid] = qn; red[8 + wid] = km; } if (tid == 0) tsl[0] = 4 * qb;
      __syncthreads();
      float q2 = red[0], k2 = red[8];
#pragma unroll
      for (int w = 1; w < 8; ++w) { q2 = fmaxf(q2, red[w]); k2 = fmaxf(k2, red[8 + w]); }
      const float thr = 2.f * sqrtf(q2) * sqrtf(k2) * 1.0001f + FOX_SKIP;
      const float c0 = ct[q0];
      if (tid < 4 * qb && ct[64 * tid + 63] - c0 <= thr) atomicMin((int*)tsl, tid);
      __syncthreads(); }
    const int T0 = tsl[0];
    const int skey = tid >> 3, sd = (tid & 7) * 8;
    const bf16* kp = K + (rowbase + skey) * 512 + h * 64 + sd; const bf16* vp = V + (rowbase + skey) * 512 + h * 64 + sd;
    v4u kreg = *(const v4u*)(kp + (size_t)T0 * 64 * 512), vreg = *(const v4u*)(vp + (size_t)T0 * 64 * 512); float creg = (tid < 64) ? ct[64 * T0 + tid] : 0.f;
    __syncthreads();
    { LAS unsigned char* buf0 = lds + (T0 & 1) * FOX_BUF; LAS bf16* Ks = (LAS bf16*)buf0; LAS bf16* Vt = Ks + 64 * FOX_KP; LAS float* Cs = (LAS float*)(buf0 + 2 * 64 * FOX_KP * 2);
      *(LAS v4u*)(Ks + skey * FOX_KP + sd) = kreg;
      Vt[(sd + 0) * FOX_KP + skey] = (bf16)(vreg.x & 0xffffu); Vt[(sd + 1) * FOX_KP + skey] = (bf16)(vreg.x >> 16); Vt[(sd + 2) * FOX_KP + skey] = (bf16)(vreg.y & 0xffffu); Vt[(sd + 3) * FOX_KP + skey] = (bf16)(vreg.y >> 16);
      Vt[(sd + 4) * FOX_KP + skey] = (bf16)(vreg.z & 0xffffu); Vt[(sd + 5) * FOX_KP + skey] = (bf16)(vreg.z >> 16); Vt[(sd + 6) * FOX_KP + skey] = (bf16)(vreg.w & 0xffffu); Vt[(sd + 7) * FOX_KP + skey] = (bf16)(vreg.w >> 16);
      if (tid < 64) Cs[tid] = creg; }
    if (T0 + 1 < NT) { kreg = *(const v4u*)(kp + (size_t)(T0 + 1) * 64 * 512); vreg = *(const v4u*)(vp + (size_t)(T0 + 1) * 64 * 512); if (tid < 64) creg = ct[64 * (T0 + 1) + tid]; }
    float m = -1e30f, l = 0.f; f32x16 o0, o1;
#pragma unroll
    for (int r = 0; r < 16; ++r) { o0[r] = 0.f; o1[r] = 0.f; }
    for (int t = T0; t < NT; ++t) {
        __syncthreads();
        if (t + 1 < NT) { LAS unsigned char* bufn = lds + ((t + 1) & 1) * FOX_BUF; LAS bf16* Ks = (LAS bf16*)bufn; LAS bf16* Vt = Ks + 64 * FOX_KP; LAS float* Cs = (LAS float*)(bufn + 2 * 64 * FOX_KP * 2);
            *(LAS v4u*)(Ks + skey * FOX_KP + sd) = kreg;
            Vt[(sd + 0) * FOX_KP + skey] = (bf16)(vreg.x & 0xffffu); Vt[(sd + 1) * FOX_KP + skey] = (bf16)(vreg.x >> 16); Vt[(sd + 2) * FOX_KP + skey] = (bf16)(vreg.y & 0xffffu); Vt[(sd + 3) * FOX_KP + skey] = (bf16)(vreg.y >> 16);
            Vt[(sd + 4) * FOX_KP + skey] = (bf16)(vreg.z & 0xffffu); Vt[(sd + 5) * FOX_KP + skey] = (bf16)(vreg.z >> 16); Vt[(sd + 6) * FOX_KP + skey] = (bf16)(vreg.w & 0xffffu); Vt[(sd + 7) * FOX_KP + skey] = (bf16)(vreg.w >> 16);
            if (tid < 64) Cs[tid] = creg;
            if (t + 2 < NT) { kreg = *(const v4u*)(kp + (size_t)(t + 2) * 64 * 512); vreg = *(const v4u*)(vp + (size_t)(t + 2) * 64 * 512); if (tid < 64) creg = ct[64 * (t + 2) + tid]; } }
        const int jb = t - (NT - 4);
        if (jb >= 0 && 64 * jb > 32 * wid + 31) continue;
        LAS unsigned char* buf = lds + (t & 1) * FOX_BUF; const LAS bf16* Ks = (const LAS bf16*)buf; const LAS bf16* Vt = Ks + 64 * FOX_KP; const LAS float* Cs = (const LAS float*)(buf + 2 * 64 * FOX_KP * 2);
        f32x16 p0, p1;
#pragma unroll
        for (int g = 0; g < 4; ++g) { const f32x4 a = *(const LAS f32x4*)(Cs + 8 * g + 4 * hi), c = *(const LAS f32x4*)(Cs + 32 + 8 * g + 4 * hi);
            p0[4 * g + 0] = -a[0]; p0[4 * g + 1] = -a[1]; p0[4 * g + 2] = -a[2]; p0[4 * g + 3] = -a[3]; p1[4 * g + 0] = -c[0]; p1[4 * g + 1] = -c[1]; p1[4 * g + 2] = -c[2]; p1[4 * g + 3] = -c[3]; }
#pragma unroll
        for (int d0 = 0; d0 < 4; ++d0) { const bf16x8 a0 = *(const LAS bf16x8*)(Ks + r32 * FOX_KP + 16 * d0 + 8 * hi), a1 = *(const LAS bf16x8*)(Ks + (32 + r32) * FOX_KP + 16 * d0 + 8 * hi);
            p0 = __builtin_amdgcn_mfma_f32_32x32x16_bf16(a0, qr[d0], p0, 0, 0, 0); p1 = __builtin_amdgcn_mfma_f32_32x32x16_bf16(a1, qr[d0], p1, 0, 0, 0); }
        if (jb >= 0) { const int qrel = 32 * wid + r32, kb = 64 * jb + 4 * hi;
#pragma unroll
            for (int r = 0; r < 16; ++r) { const int kv = kb + (r & 3) + 8 * (r >> 2); if (kv > qrel) p0[r] = -__builtin_inff(); if (kv + 32 > qrel) p1[r] = -__builtin_inff(); } }
        float mx = fmaxf(p0[0], p1[0]);
#pragma unroll
        for (int r = 1; r < 16; ++r) mx = fmaxf(mx, fmaxf(p0[r], p1[r]));
        mx = fmaxf(mx, bperm(mx, lane ^ 32));
        const float mn = fmaxf(m, mx), alpha = __builtin_amdgcn_exp2f(m - mn); m = mn;
        float sum = 0.f;
#pragma unroll
        for (int r = 0; r < 16; ++r) { p0[r] = __builtin_amdgcn_exp2f(p0[r] - mn); p1[r] = __builtin_amdgcn_exp2f(p1[r] - mn); sum += p0[r] + p1[r]; }
        l = l * alpha + sum;
#pragma unroll
        for (int r = 0; r < 16; ++r) { o0[r] *= alpha; o1[r] *= alpha; }
        bf16x8 pb[4];
        { v4u w;
          w.x = pg8::cvt_pk_bf16(p0[0], p0[1]); w.y = pg8::cvt_pk_bf16(p0[2], p0[3]); w.z = pg8::cvt_pk_bf16(p0[4], p0[5]); w.w = pg8::cvt_pk_bf16(p0[6], p0[7]); pb[0] = __builtin_bit_cast(bf16x8, w);
          w.x = pg8::cvt_pk_bf16(p0[8], p0[9]); w.y = pg8::cvt_pk_bf16(p0[10], p0[11]); w.z = pg8::cvt_pk_bf16(p0[12], p0[13]); w.w = pg8::cvt_pk_bf16(p0[14], p0[15]); pb[1] = __builtin_bit_cast(bf16x8, w);
          w.x = pg8::cvt_pk_bf16(p1[0], p1[1]); w.y = pg8::cvt_pk_bf16(p1[2], p1[3]); w.z = pg8::cvt_pk_bf16(p1[4], p1[5]); w.w = pg8::cvt_pk_bf16(p1[6], p1[7]); pb[2] = __builtin_bit_cast(bf16x8, w);
          w.x = pg8::cvt_pk_bf16(p1[8], p1[9]); w.y = pg8::cvt_pk_bf16(p1[10], p1[11]); w.z = pg8::cvt_pk_bf16(p1[12], p1[13]); w.w = pg8::cvt_pk_bf16(p1[14], p1[15]); pb[3] = __builtin_bit_cast(bf16x8, w); }
#pragma unroll
        for (int mm = 0; mm < 4; ++mm) {
            typedef unsigned u32x2v __attribute__((ext_vector_type(2)));
            const u32x2v a0l = *(const LAS u32x2v*)(Vt + r32 * FOX_KP + 16 * mm + 4 * hi), a0h = *(const LAS u32x2v*)(Vt + r32 * FOX_KP + 16 * mm + 8 + 4 * hi);
            const u32x2v a1l = *(const LAS u32x2v*)(Vt + (32 + r32) * FOX_KP + 16 * mm + 4 * hi), a1h = *(const LAS u32x2v*)(Vt + (32 + r32) * FOX_KP + 16 * mm + 8 + 4 * hi);
            const v4u A0 = {a0l.x, a0l.y, a0h.x, a0h.y}, A1 = {a1l.x, a1l.y, a1h.x, a1h.y};
            o0 = __builtin_amdgcn_mfma_f32_32x32x16_bf16(__builtin_bit_cast(bf16x8, A0), pb[mm], o0, 0, 0, 0);
            o1 = __builtin_amdgcn_mfma_f32_32x32x16_bf16(__builtin_bit_cast(bf16x8, A1), pb[mm], o1, 0, 0, 0); }
    }
    l += bperm(l, lane ^ 32); const float inv = 1.f / l;
    bf16* Ow = O + (rowbase + q0 + wid * 32 + r32) * 512 + h * 64;
#pragma unroll
    for (int g = 0; g < 4; ++g) { typedef unsigned u32x2v __attribute__((ext_vector_type(2)));
        u32x2v w0, w1; w0.x = pg8::cvt_pk_bf16(o0[4 * g] * inv, o0[4 * g + 1] * inv); w0.y = pg8::cvt_pk_bf16(o0[4 * g + 2] * inv, o0[4 * g + 3] * inv);
        w1.x = pg8::cvt_pk_bf16(o1[4 * g] * inv, o1[4 * g + 1] * inv); w1.y = pg8::cvt_pk_bf16(o1[4 * g + 2] * inv, o1[4 * g + 3] * inv);
        *(u32x2v*)(Ow + 8 * g + 4 * hi) = w0; *(u32x2v*)(Ow + 32 + 8 * g + 4 * hi) = w1; }
    __syncthreads();
}
__global__ void __launch_bounds__(NTHR, 2) hybrid_fwd(Args args) {
    extern __shared__ __attribute__((aligned(16))) unsigned char lds_raw[];
    cg::grid_group grid = cg::this_grid();
    LAS unsigned char* lds = (LAS unsigned char*)lds_raw;
    int tid = threadIdx.x, lane = tid & 63, wave = __builtin_amdgcn_readfirstlane(tid >> 6);
    int G = gridDim.x, bx = blockIdx.x;
    int vcu = (G % 8 == 0) ? (bx % 8) * (G / 8) + bx / 8 : bx;
    int gw = vcu * NWAVES + wave; int NGW = G * NWAVES;
    PtrTab TB = (PtrTab)(lds + TAB_OFF);
    if (tid == 0) {
#pragma unroll
        for (int i = 0; i < 31; ++i) TB[i] = (unsigned long long)args.in[i];
    }
    if (tid == 1) { TB[40] = 0ull; }
    __syncthreads();
    (void)xcd_barrier_post((unsigned*)(args.ws + WS_BAR), (volatile LAS unsigned*)(lds + TAB_OFF + 320));
    grid.sync();
    unsigned char* ws = args.ws;
    float* X = args.out;
    float* SS = (float*)(ws + WS_SSP);
    bf16* XB = (bf16*)(ws + WS_XB);
    bf16* HB = (bf16*)(ws + WS_H);
    constexpr float C2X = 0.0625f * 1.4426950408889634f;
#define GSYNC() do { asm volatile("s_waitcnt vmcnt(0) lgkmcnt(0)" ::: "memory"); { XcdBarrier xb_; xb_.bar = (unsigned*)(ws + WS_BAR); xb_.x = xb_xcc_id(); xb_.st = (volatile LAS unsigned*)(lds + TAB_OFF + 320); xcd_barrier(xb_); } tid = threadIdx.x; asm volatile("" : "+v"(tid)); lane = tid & 63; wave = __builtin_amdgcn_readfirstlane(tid >> 6); G = gridDim.x; bx = blockIdx.x; asm volatile("" : "+s"(G), "+s"(bx)); vcu = (G % 8 == 0) ? (bx % 8) * (G / 8) + bx / 8 : bx; gw = vcu * NWAVES + wave; NGW = G * NWAVES; { unsigned long long wsi_ = (unsigned long long)ws; asm volatile("" : "+s"(wsi_)); ws = (unsigned char*)(GAS unsigned char*)wsi_; } } while (0)

    for (int l = 0; l < DEPTH; ++l) {
        float* ss0 = SS + (size_t)(4 * l + 0) * M * 4; float* ss1 = SS + (size_t)(4 * l + 1) * M * 4; float* ss2 = SS + (size_t)(4 * l + 2) * M * 4; float* ss3 = SS + (size_t)(4 * l + 3) * M * 4; float* ss4 = SS + (size_t)(4 * l + 4) * M * 4;
        phase_prologue(TB, ws, X, l, lds, gw, NGW, lane, wave);
        GSYNC();
        { pg8::Gemm g{XB, (const bf16*)(ws + WS_W1IN), M, 2 * DFF, D, D, D, 0}; pg8::StaticOrder S; S.init(M, 2 * DFF, G, bx);
          pg8::EpiSwiglu E{HB, ss0, DFF};
          pg8::gemm_phase<pg8::EpiSwiglu, pg8::StaticOrder, true, true>(lds, g, S, E); }
        if (bx >= G / 2) { pg8::Gemm g{(const bf16*)(ws + WS_MEMN), (const bf16*)(ws + WS_WXKV), 512, 2 * D, D, D, D, 0}; pg8::StaticOrder S; S.init(512, 2 * D, G, bx - G / 2);
          pg8::EpiKV E{(bf16*)(ws + WS_KX), (bf16*)(ws + WS_VT)};
          pg8::gemm_phase<pg8::EpiKV, pg8::StaticOrder, true, true>(lds, g, S, E); }
        GSYNC();
        { pg8::Gemm g{HB, (const bf16*)(ws + WS_W1OUT), M, D, DFF, DFF, DFF, 0}; pg8::StaticOrder S; S.init(M, D, G, bx); pg8::Unit u_;
          pg8::EpiResid E{X, XB, ss1, 0.5f};
          for (int i_ = 0; S.next(i_, u_); ++i_) { const pg8::OneUnit O1{u_.pm, u_.pn}; pg8::gemm_phase<pg8::EpiResid, pg8::OneUnit, false, true>(lds, g, O1, E); } }
        GSYNC();
        { pg8::Gemm g{XB, (const bf16*)(ws + WS_WIN), M, 4096, D, D, D, 0}; pg8::StaticOrder S; S.init(M, 4096, G, bx);
          pg8::EpiWin E{(bf16*)(ws + WS_XA), (bf16*)(ws + WS_XL), (bf16*)(ws + WS_GG), (bf16*)(ws + WS_Q), (bf16*)(ws + WS_K), (bf16*)(ws + WS_V), ss1, FOX_C2};
          pg8::gemm_phase<pg8::EpiWin, pg8::StaticOrder, true, true>(lds, g, S, E); }
        phase_fl(XB, (const float*)(ws + WS_WFL), tab_in(TB, 7) + l * 8, ss1, (float*)(ws + WS_LOGF), gw, NGW, lane);
        GSYNC();
        if (vcu < 16) cumsum_bh((const float*)(ws + WS_LOGF), (float*)(ws + WS_CTIL), vcu, (LAS float*)lds);
        for (int it = vcu; it < 512; it += G)
            lru_item<false>(lds, it >> 8, (it >> 6) & 3, it & 63, (const bf16*)(ws + WS_XL), (bf16*)(ws + WS_GG), tab_in(TB, 12) + (size_t)l * 4 * D, tab_in(TB, 13) + l * D, (const bf16*)(ws + WS_WAT), (const bf16*)(ws + WS_WXT),
                            tab_in(TB, 15) + l * D, tab_in(TB, 17) + l * D, tab_in(TB, 18) + l * D, (float*)(ws + WS_SUMM));
        phase_pool((const bf16*)(ws + WS_XA), (bf16*)(ws + WS_YA), vcu * NTHR + tid, G * NTHR);
        phase_kmax((const bf16*)(ws + WS_K), (float*)(ws + WS_KPART), gw, NGW, lane);
        GSYNC();
        for (int it = vcu; it < 512; it += G)
            lru_item<true>(lds, it >> 8, (it >> 6) & 3, (it & 256) ? 63 - (it & 63) : (it & 63),
                            (const bf16*)(ws + WS_XL), (bf16*)(ws + WS_GG), tab_in(TB, 12) + (size_t)l * 4 * D, tab_in(TB, 13) + l * D, (const bf16*)(ws + WS_WAT), (const bf16*)(ws + WS_WXT),
                           tab_in(TB, 15) + l * D, tab_in(TB, 17) + l * D, tab_in(TB, 18) + l * D, (float*)(ws + WS_SUMM));
        for (int p = vcu; p < 256; p += G) {
            { const int bh = p & 15, qb = 31 - (p >> 4);
              fox_unit(lds, bh >> 3, bh & 7, qb, (const bf16*)(ws + WS_Q), (const bf16*)(ws + WS_K), (const bf16*)(ws + WS_V), (bf16*)(ws + WS_YC), (const float*)(ws + WS_CTIL) + (size_t)bh * SEQ, (const float*)(ws + WS_KPART), NGW); }
            { const int bh = 15 - (p & 15), qb = p >> 4;
              fox_unit(lds, bh >> 3, bh & 7, qb, (const bf16*)(ws + WS_Q), (const bf16*)(ws + WS_K), (const bf16*)(ws + WS_V), (bf16*)(ws + WS_YC), (const float*)(ws + WS_CTIL) + (size_t)bh * SEQ, (const float*)(ws + WS_KPART), NGW); } }
        GSYNC();
        { pg8::StaticOrder S; S.init(M, D, G, bx); pg8::Unit u;
          bf16* stash = (bf16*)(ws + WS_STASH) + (size_t)bx * 65536; bf16* mg = (bf16*)(ws + WS_MG);
          for (int i = 0; S.next(i, u); ++i) { const pg8::OneUnit O1{u.pm, u.pn};
#pragma unroll 1
              for (int br = 0; br < 3; ++br) {
                  { pg8::Gemm g{XB, (const bf16*)(ws + WS_WG) + (size_t)br * D * D, M, D, D, D, D, 0}; pg8::EpiGate E{stash, tab_in(TB, 8) + (size_t)l * 3 * D + br * D, ss1};
                    pg8::gemm_phase<pg8::EpiGate, pg8::OneUnit, true, true>(lds, g, O1, E); }
                  asm volatile("s_waitcnt vmcnt(0)" ::: "memory"); __syncthreads();
                  const bf16* Ab = br == 0 ? (const bf16*)(ws + WS_YA) : br == 1 ? (const bf16*)(ws + WS_GG) : (const bf16*)(ws + WS_YC);
                  const bf16* Ub = br == 0 ? (const bf16*)(ws + WS_UA) : br == 1 ? (const bf16*)(ws + WS_UB) : (const bf16*)(ws + WS_UC);
                  const int Kb = br == 1 ? 1024 : 512;
                  { pg8::Gemm g{Ab, Ub, M, D, Kb, Kb, Kb, 0}; pg8::EpiMerge E{stash, mg, br == 0 ? 1 : 0};
                    pg8::gemm_phase<pg8::EpiMerge, pg8::OneUnit, true, true>(lds, g, O1, E); }
                  asm volatile("s_waitcnt vmcnt(0)" ::: "memory"); __syncthreads();
              } } }
        GSYNC();
        { pg8::Gemm g{(const bf16*)(ws + WS_MG), (const bf16*)(ws + WS_WO), M, D, D, D, D, 0}; pg8::StaticOrder S; S.init(M, D, G, bx); pg8::Unit u_;
          pg8::EpiResid E{X, XB, ss2, 1.0f};
          for (int i_ = 0; S.next(i_, u_); ++i_) { const pg8::OneUnit O1{u_.pm, u_.pn}; pg8::gemm_phase<pg8::EpiResid, pg8::OneUnit, false, true>(lds, g, O1, E); } }
        GSYNC();
        { bf16* pb = (bf16*)(ws + WS_PBUF) + (size_t)bx * 65536; const pg8::OneUnit O1{0, 0};
          for (int uid = vcu; uid < 256; uid += G) { const int rt = uid >> 2, h = uid & 3, b = rt >> 5;
              int KX = 256; asm volatile("" : "+s"(KX));
              bf16* qo = (bf16*)(ws + WS_QX) + (size_t)rt * 256 * D + h * 256; bf16* qs = (bf16*)(ws + WS_Q) + (size_t)bx * 65536;
              { pg8::Gemm g{XB + (size_t)rt * 256 * D, (const bf16*)(ws + WS_WXQ) + (size_t)h * 256 * D, 256, 256, D, D, D, 0}; pg8::EpiRs E{qs, 256, ss2 + (size_t)rt * 256 * 4, C2X};
                pg8::gemm_phase<pg8::EpiRs, pg8::OneUnit, true, true>(lds, g, O1, E); }
              asm volatile("s_waitcnt vmcnt(0)" ::: "memory"); __syncthreads();
              { pg8::Gemm g{qs, (const bf16*)(ws + WS_KX) + (size_t)b * 256 * D + h * 256, 256, 256, KX, 256, D, 0}; pg8::EpiSoftmaxP E{pb};
                pg8::gemm_phase<pg8::EpiSoftmaxP, pg8::OneUnit, false, true>(lds, g, O1, E); }
              asm volatile("s_waitcnt vmcnt(0)" ::: "memory"); __syncthreads();
              { pg8::Gemm g{pb, (const bf16*)(ws + WS_VT) + (size_t)(b * 4 + h) * 65536, 256, 256, KX, 256, 256, 0}; pg8::EpiRs E{qo, D, nullptr, 1.0f};
                pg8::gemm_phase<pg8::EpiRs, pg8::OneUnit, true, true>(lds, g, O1, E); }
              asm volatile("s_waitcnt vmcnt(0)" ::: "memory"); if (uid + G < 256) __builtin_amdgcn_fence(__ATOMIC_ACQUIRE, "agent"); __syncthreads();
          } }
        GSYNC();
        { pg8::Gemm g{(const bf16*)(ws + WS_QX), (const bf16*)(ws + WS_WXO), M, D, D, D, D, 0}; pg8::StaticOrder S; S.init(M, D, G, bx); pg8::Unit u_;
          pg8::EpiResid E{X, XB, ss3, 1.0f};
          for (int i_ = 0; S.next(i_, u_); ++i_) { const pg8::OneUnit O1{u_.pm, u_.pn}; pg8::gemm_phase<pg8::EpiResid, pg8::OneUnit, false, true>(lds, g, O1, E); } }
        GSYNC();
        { pg8::Gemm g{XB, (const bf16*)(ws + WS_W2IN), M, 2 * DFF, D, D, D, 0}; pg8::StaticOrder S; S.init(M, 2 * DFF, G, bx);
          pg8::EpiSwiglu E{HB, ss3, DFF};
          pg8::gemm_phase<pg8::EpiSwiglu, pg8::StaticOrder, true, true>(lds, g, S, E); }
        GSYNC();
        { pg8::Gemm g{HB, (const bf16*)(ws + WS_W2OUT), M, D, DFF, DFF, DFF, 0}; pg8::StaticOrder S; S.init(M, D, G, bx); pg8::Unit u_;
          pg8::EpiResid E{X, XB, ss4, 0.5f};
          for (int i_ = 0; S.next(i_, u_); ++i_) { const pg8::OneUnit O1{u_.pm, u_.pn}; pg8::gemm_phase<pg8::EpiResid, pg8::OneUnit, false, true>(lds, g, O1, E); } }
        GSYNC();
    }
    phase_final(X, tab_in(TB, 30), gw, NGW, lane);
#undef GSYNC
}

extern "C" void kernel_launch(void* const* d_in, const int* in_sizes, int n_in, void* d_out, int out_size, void* d_ws, size_t ws_size, hipStream_t stream) {
    static int grid = 0;
    if (grid == 0) {
        if (n_in != 31 || out_size != M * D || ws_size < WS_END) { fprintf(stderr, "kernel_launch: unexpected problem (n_in %d, out %d, ws %zu)\n", n_in, out_size, ws_size); grid = -1; return; }
        int dev = 0, cus = 0, per_cu = 0;
        (void)hipGetDevice(&dev); (void)hipDeviceGetAttribute(&cus, hipDeviceAttributeMultiprocessorCount, dev);
        if (hipFuncSetAttribute((const void*)hybrid_fwd, hipFuncAttributeMaxDynamicSharedMemorySize, LDS_BYTES) != hipSuccess) { fprintf(stderr, "kernel_launch: hipFuncSetAttribute failed\n"); grid = -1; return; }
        if (hipOccupancyMaxActiveBlocksPerMultiprocessor(&per_cu, (const void*)hybrid_fwd, NTHR, LDS_BYTES) != hipSuccess || per_cu < 1) per_cu = 1;
        (void)hipGetLastError();
        grid = cus * (per_cu > 1 ? 1 : per_cu);
        if (grid > 256) grid = 256;
    }
    if (grid < 0) return;
    (void)hipMemsetAsync((char*)d_ws + WS_SS, 0, CTL_ZERO_BYTES, stream);
    Args a{};
    for (int i = 0; i < 31; ++i) a.in[i] = (const float*)d_in[i];
    a.out = (float*)d_out; a.ws = (unsigned char*)d_ws;
    void* kargs[] = {&a};
    hipError_t e = hipLaunchCooperativeKernel((const void*)hybrid_fwd, dim3(grid), dim3(NTHR), kargs, LDS_BYTES, stream);
    if (e != hipSuccess) fprintf(stderr, "cooperative launch failed: %s (grid %d)\n", hipGetErrorString(e), grid);
}
```

```cpp
#include <hip/hip_runtime.h>
#include <hip/hip_cooperative_groups.h>
#include <cstdio>
#include <cstdint>
namespace cg = cooperative_groups;
namespace pg8 {
#define PG8_LAS __attribute__((address_space(3)))
typedef unsigned short bf16_t;
typedef short bf16x8 __attribute__((ext_vector_type(8)));
typedef float f32x4 __attribute__((ext_vector_type(4)));
typedef unsigned u32x4 __attribute__((ext_vector_type(4)));
constexpr int BM = 256, BK = 64, HALF = 128, HTB = HALF * BK * 2  , STAGE_BYTES = 8 * HTB, NXCD = 8, WGM = 8;

__host__ __device__ __forceinline__ int lds_byte(int r, int c) { const int st = (r >> 4) * 2 + (c >> 5), rr = r & 15, cc = c & 31, ob = rr * 64 + cc * 2; return st * 1024 + (ob ^ (((ob >> 9) & 1) << 5)); }
__host__ __device__ __forceinline__ void stage_rc(int b, int& R, int& C) { const int st = b / 1024, sb = b % 1024, swz = sb ^ (((sb >> 9) & 1) << 5); R = (st >> 1) * 16 + swz / 64; C = (st & 1) * 32 + (swz % 64) / 2; }
__host__ __device__ __forceinline__ int perm32(int rho) { const int n = rho >> 4, i = rho & 15; return 8 * (i >> 2) + 4 * n + (i & 3); }

struct Unit { int pm, pn; };
struct Gemm { const bf16_t* A; const bf16_t* Bt; int M, N, K, lda, ldb, a_pn_off; };

struct StaticOrder {
    int nM, nN, nwg, G, c;
    __host__ __device__ __forceinline__ void init(int M, int N, int G_, int c_) { nM = M / BM; nN = N / BM; nwg = nM * nN; G = G_; c = c_; }
    __host__ __device__ __forceinline__ bool next(int i, Unit& u) const {
        const long L = (long)i * G + c; if (L >= nwg) return false;
        int wgid = (int)L; { const int q = nwg / NXCD, r = nwg % NXCD, xcd = wgid % NXCD, off = wgid / NXCD; wgid = (xcd < r ? xcd * (q + 1) : r * (q + 1) + (xcd - r) * q) + off; }
        const int nig = WGM * nN, gid = wgid / nig, fm = gid * WGM, gsz = (nM - fm) < WGM ? (nM - fm) : WGM;
        u.pm = fm + ((wgid % nig) % gsz); u.pn = (wgid % nig) / gsz; return true;
    }
    __device__ __forceinline__ void a_ready(const Unit&) const {}
    __device__ __forceinline__ void done(const Unit&) const {}
};

__device__ __forceinline__ unsigned cvt_pk_bf16(float lo, float hi) { unsigned r; asm volatile("v_cvt_pk_bf16_f32 %0, %1, %2" : "=v"(r) : "v"(lo), "v"(hi)); return r; }
__device__ __forceinline__ float bperm(float v, int srclane) { return __int_as_float(__builtin_amdgcn_ds_bpermute(srclane << 2, __float_as_int(v))); }
typedef float f32x2 __attribute__((ext_vector_type(2)));
typedef unsigned u32x2 __attribute__((ext_vector_type(2)));
__device__ __forceinline__ float fsig(float v) { return __builtin_amdgcn_rcpf(1.f + __expf(-v)); }
__device__ __forceinline__ float fsilu(float v) { return v * fsig(v); }
__device__ __forceinline__ float fgelu_tanh(float v) { return v * fsig(1.5957691216057308f * (v + 0.044715f * v * v * v)); }
__device__ __forceinline__ float bf_lo(unsigned w) { return __uint_as_float(w << 16); }
__device__ __forceinline__ float bf_hi(unsigned w) { return __uint_as_float(w & 0xffff0000u); }
__device__ __forceinline__ float rstd_of(const float* ss, int row) { const f32x4 a = *(const f32x4*)(ss + (size_t)row * 4); return rsqrtf(((a[0] + a[1]) + (a[2] + a[3])) * (1.0f / 1024.0f) + 1e-6f); }
__device__ __forceinline__ u32x4 pack8(const f32x4 v0, const f32x4 v1) { u32x4 w; w.x = cvt_pk_bf16(v0[0], v0[1]); w.y = cvt_pk_bf16(v0[2], v0[3]); w.z = cvt_pk_bf16(v1[0], v1[1]); w.w = cvt_pk_bf16(v1[2], v1[3]); return w; }

__device__ __forceinline__ void rstd8(const float* ss, int row0, float sc, float (&rs)[2][4]) {
    f32x4 pa[2][4];
#pragma unroll
    for (int ai = 0; ai < 2; ++ai)
#pragma unroll
        for (int m = 0; m < 4; ++m) pa[ai][m] = *(const f32x4*)(ss + (size_t)(row0 + ai * HALF + m * 16) * 4);
#pragma unroll
    for (int ai = 0; ai < 2; ++ai)
#pragma unroll
        for (int m = 0; m < 4; ++m) { const f32x4 a = pa[ai][m]; rs[ai][m] = rsqrtf(((a[0] + a[1]) + (a[2] + a[3])) * (1.0f / 1024.0f) + 1e-6f) * sc; }
    __builtin_amdgcn_sched_barrier(0);
}

__device__ __forceinline__ u32x4 ld16_sc1(const void* p) { u32x4 v; asm volatile("global_load_dwordx4 %0, %1, off sc1" : "=v"(v) : "v"(p) : "memory"); return v; }
#define PG8_LDWAIT(v) asm volatile("s_waitcnt vmcnt(0)" : "+v"(v))

struct OneUnit { int pm, pn;
    __device__ __forceinline__ bool next(int i, Unit& u) const { if (i) return false; u.pm = pm; u.pn = pn; return true; }
    __device__ __forceinline__ void a_ready(const Unit&) const {}
    __device__ __forceinline__ void done(const Unit&) const {} };

struct EpiSwiglu { static constexpr bool PERM = true, AFTER_DRAIN = false; bf16_t* H; const float* ss; int ldh;
    __device__ __forceinline__ void operator()(const f32x4 (&acc)[2][2][4][2], const Unit& u, int wr, int wc, int fr, int fq) const {
        const int row0 = u.pm * BM + wr * 64 + fr, col0 = u.pn * HALF + wc * 32 + 8 * fq; float rsv[2][4]; rstd8(ss, row0, 1.f, rsv);
#pragma unroll
        for (int ai = 0; ai < 2; ++ai)
#pragma unroll
            for (int m = 0; m < 4; ++m) { const int row = row0 + ai * HALF + m * 16; const float rs = rsv[ai][m];
                f32x4 o0, o1;
#pragma unroll
                for (int i = 0; i < 4; ++i) { o0[i] = fsilu(acc[ai][0][m][0][i] * rs) * (acc[ai][1][m][0][i] * rs); o1[i] = fsilu(acc[ai][0][m][1][i] * rs) * (acc[ai][1][m][1][i] * rs); }
                *(u32x4*)(H + (size_t)row * ldh + col0) = pack8(o0, o1); __builtin_amdgcn_sched_barrier(0); }
    }
};
struct EpiResid { static constexpr bool PERM = false, AFTER_DRAIN = true; float* x; bf16_t* xb; float* ss; float scale;
    __device__ __forceinline__ void fused(f32x4 (&acc)[2][2][4][2], const Unit& u, int wr, int wc, int fr, int fq, PG8_LAS unsigned char* lds, int wid, int lane) const {
        float scl = scale; asm volatile("" : "+v"(scl)); const int row0 = u.pm * BM + wr * 64 + fr, col0 = u.pn * BM + wc * 32 + 4 * fq;
        PG8_LAS float* P = (PG8_LAS float*)lds;
#pragma unroll
        for (int ai = 0; ai < 2; ++ai)
#pragma unroll
            for (int m = 0; m < 4; ++m) { const int row = row0 + ai * HALF + m * 16; float q = 0.f;
#pragma unroll
                for (int bj = 0; bj < 2; ++bj)
#pragma unroll
                    for (int n = 0; n < 2; ++n) { const size_t off = (size_t)row * 1024 + col0 + bj * HALF + n * 16;
                        f32x4 v = *(const f32x4*)(x + off) + acc[ai][bj][m][n] * scl; *(f32x4*)(x + off) = v;
                        u32x2 w; w.x = cvt_pk_bf16(v[0], v[1]); w.y = cvt_pk_bf16(v[2], v[3]); *(u32x2*)(xb + off) = w;
                        q += (v[0] * v[0] + v[1] * v[1]) + (v[2] * v[2] + v[3] * v[3]); }
                q += bperm(q, (fr + 16 * fq) ^ 16); q += bperm(q, (fr + 16 * fq) ^ 32);
                if (fq == 0) P[(ai * HALF + wr * 64 + m * 16 + fr) * 4 + wc] = q; }
        asm volatile("s_waitcnt lgkmcnt(0)" ::: "memory"); __builtin_amdgcn_s_barrier(); asm volatile("" ::: "memory");
        const int tl = wid * 64 + lane;
        if (tl < 256) { const f32x4 a = *(const PG8_LAS f32x4*)(P + tl * 4); ss[(size_t)(u.pm * BM + tl) * 4 + u.pn] = (a[0] + a[1]) + (a[2] + a[3]); }
        asm volatile("s_waitcnt lgkmcnt(0)" ::: "memory"); __builtin_amdgcn_s_barrier(); asm volatile("" ::: "memory");
    }
};
struct EpiRs { static constexpr bool PERM = true, AFTER_DRAIN = false; bf16_t* O; int ldc; const float* ss; float sc;
    __device__ __forceinline__ void operator()(const f32x4 (&acc)[2][2][4][2], const Unit& u, int wr, int wc, int fr, int fq) const {
        const int row0 = u.pm * BM + wr * 64 + fr, col0 = u.pn * BM + wc * 32 + 8 * fq; float rsv[2][4];
        if (ss) rstd8(ss, row0, sc, rsv); else {
#pragma unroll
            for (int a = 0; a < 2; ++a)
#pragma unroll
                for (int b = 0; b < 4; ++b) rsv[a][b] = sc; }
#pragma unroll
        for (int ai = 0; ai < 2; ++ai)
#pragma unroll
            for (int m = 0; m < 4; ++m) { const int row = row0 + ai * HALF + m * 16; const float rs = rsv[ai][m];
#pragma unroll
                for (int bj = 0; bj < 2; ++bj) *(u32x4*)(O + (size_t)row * ldc + col0 + bj * HALF) = pack8(acc[ai][bj][m][0] * rs, acc[ai][bj][m][1] * rs); }
    }
};
struct EpiWin { static constexpr bool PERM = true, AFTER_DRAIN = false; bf16_t *xa, *xl, *gg, *q, *k, *v; const float* ss; float qscale;
    __device__ __forceinline__ void operator()(const f32x4 (&acc)[2][2][4][2], const Unit& u, int wr, int wc, int fr, int fq) const {
        const int pn = u.pn; bf16_t* dst; int ld, ct; float sc = 1.f; bool act = false;
        if (pn < 2) { dst = xa; ld = 512; ct = pn; } else if (pn < 6) { dst = xl; ld = 1024; ct = pn - 2; } else if (pn < 10) { dst = gg; ld = 1024; ct = pn - 6; act = true; }
        else if (pn < 12) { dst = q; ld = 512; ct = pn - 10; sc = qscale; } else if (pn < 14) { dst = k; ld = 512; ct = pn - 12; } else { dst = v; ld = 512; ct = pn - 14; }
        const int row0 = u.pm * BM + wr * 64 + fr, col0 = ct * BM + wc * 32 + 8 * fq; float rsv[2][4]; rstd8(ss, row0, sc, rsv);
#pragma unroll
        for (int ai = 0; ai < 2; ++ai)
#pragma unroll
            for (int m = 0; m < 4; ++m) { const int row = row0 + ai * HALF + m * 16; const float rs = rsv[ai][m];
#pragma unroll
                for (int bj = 0; bj < 2; ++bj) { f32x4 v0 = acc[ai][bj][m][0] * rs, v1 = acc[ai][bj][m][1] * rs;
                    if (act) {
#pragma unroll
                        for (int i = 0; i < 4; ++i) { v0[i] = fgelu_tanh(v0[i]); v1[i] = fgelu_tanh(v1[i]); } }
                    *(u32x4*)(dst + (size_t)row * ld + col0 + bj * HALF) = pack8(v0, v1); __builtin_amdgcn_sched_barrier(0); } }
    }
};
struct EpiGate { static constexpr bool PERM = true, AFTER_DRAIN = false; bf16_t* stash; const float* bg; const float* ss;
    __device__ __forceinline__ void operator()(const f32x4 (&acc)[2][2][4][2], const Unit& u, int wr, int wc, int fr, int fq) const {
        const int row0 = u.pm * BM + wr * 64 + fr, col0 = u.pn * BM + wc * 32 + 8 * fq; int tid_o = threadIdx.x; asm volatile("" : "+v"(tid_o)); const int tid = tid_o;
        f32x4 bv[2][2];
#pragma unroll
        for (int bj = 0; bj < 2; ++bj)
#pragma unroll
            for (int n = 0; n < 2; ++n) bv[bj][n] = *(const f32x4*)(bg + col0 + bj * HALF + 4 * n);
        float rsv[2][4]; rstd8(ss, row0, 1.f, rsv);
#pragma unroll
        for (int ai = 0; ai < 2; ++ai)
#pragma unroll
            for (int m = 0; m < 4; ++m) { const float rs = rsv[ai][m];
#pragma unroll
                for (int bj = 0; bj < 2; ++bj) { f32x4 v0 = acc[ai][bj][m][0] * rs + bv[bj][0], v1 = acc[ai][bj][m][1] * rs + bv[bj][1];
#pragma unroll
                    for (int i = 0; i < 4; ++i) { v0[i] = fsig(v0[i]); v1[i] = fsig(v1[i]); }
                    *(u32x4*)(stash + ((size_t)((ai * 4 + m) * 2 + bj) * 512 + tid) * 8) = pack8(v0, v1); __builtin_amdgcn_sched_barrier(0); } }
    }
};
struct EpiMerge { static constexpr bool PERM = true, AFTER_DRAIN = false; const bf16_t* stash; bf16_t* mg; int first;
    __device__ __forceinline__ void operator()(const f32x4 (&acc)[2][2][4][2], const Unit& u, int wr, int wc, int fr, int fq) const {
        const int row0 = u.pm * BM + wr * 64 + fr, col0 = u.pn * BM + wc * 32 + 8 * fq; int tid_o = threadIdx.x; asm volatile("" : "+v"(tid_o)); const int tid = tid_o;
#pragma unroll
        for (int ai = 0; ai < 2; ++ai) { u32x4 gw[4][2], ow[4][2];
#pragma unroll
            for (int m = 0; m < 4; ++m)
#pragma unroll
                for (int bj = 0; bj < 2; ++bj) { gw[m][bj] = ld16_sc1(stash + ((size_t)((ai * 4 + m) * 2 + bj) * 512 + tid) * 8);
                    ow[m][bj] = first ? (u32x4){0u, 0u, 0u, 0u} : ld16_sc1(mg + (size_t)(row0 + ai * HALF + m * 16) * 1024 + col0 + bj * HALF); }
#pragma unroll
            for (int m = 0; m < 4; ++m)
#pragma unroll
                for (int bj = 0; bj < 2; ++bj) { PG8_LDWAIT(gw[m][bj]); if (!first) PG8_LDWAIT(ow[m][bj]); }
            __builtin_amdgcn_sched_barrier(0);
#pragma unroll
            for (int m = 0; m < 4; ++m)
#pragma unroll
                for (int bj = 0; bj < 2; ++bj) { const u32x4 g = gw[m][bj], o = ow[m][bj]; f32x4 v0 = acc[ai][bj][m][0], v1 = acc[ai][bj][m][1];
                    v0[0] = v0[0] * bf_lo(g.x) + bf_lo(o.x); v0[1] = v0[1] * bf_hi(g.x) + bf_hi(o.x); v0[2] = v0[2] * bf_lo(g.y) + bf_lo(o.y); v0[3] = v0[3] * bf_hi(g.y) + bf_hi(o.y);
                    v1[0] = v1[0] * bf_lo(g.z) + bf_lo(o.z); v1[1] = v1[1] * bf_hi(g.z) + bf_hi(o.z); v1[2] = v1[2] * bf_lo(g.w) + bf_lo(o.w); v1[3] = v1[3] * bf_hi(g.w) + bf_hi(o.w);
                    *(u32x4*)(mg + (size_t)(row0 + ai * HALF + m * 16) * 1024 + col0 + bj * HALF) = pack8(v0, v1); }
            __builtin_amdgcn_sched_barrier(0); }
    }
};
struct EpiKV { static constexpr bool PERM = true, AFTER_DRAIN = false; bf16_t* kx; bf16_t* vt;
    __device__ __forceinline__ void operator()(const f32x4 (&acc)[2][2][4][2], const Unit& u, int wr, int wc, int fr, int fq) const {
        if (u.pn < 4) { const int row0 = u.pm * BM + wr * 64 + fr, col0 = u.pn * BM + wc * 32 + 8 * fq;
#pragma unroll
            for (int ai = 0; ai < 2; ++ai)
#pragma unroll
                for (int m = 0; m < 4; ++m)
#pragma unroll
                    for (int bj = 0; bj < 2; ++bj) *(u32x4*)(kx + (size_t)(row0 + ai * HALF + m * 16) * 1024 + col0 + bj * HALF) = pack8(acc[ai][bj][m][0], acc[ai][bj][m][1]);
        } else { const int h = u.pn - 4, b = u.pm; bf16_t* base = vt + (size_t)(b * 4 + h) * 65536;
#pragma unroll
            for (int ai = 0; ai < 2; ++ai)
#pragma unroll
                for (int m = 0; m < 4; ++m) { const int mr = ai * HALF + wr * 64 + m * 16 + fr;
#pragma unroll
                    for (int bj = 0; bj < 2; ++bj) { bf16_t* p = base + (size_t)(bj * HALF + wc * 32 + 8 * fq) * 256 + mr; asm volatile("" : "+v"(p));
#pragma unroll
                        for (int n = 0; n < 2; ++n)
#pragma unroll
                            for (int i = 0; i < 4; ++i) p[(4 * n + i) * 256] = (bf16_t)(cvt_pk_bf16(acc[ai][bj][m][n][i], 0.f) & 0xffffu);
                        __builtin_amdgcn_sched_barrier(0); } }
        }
    }
};
struct EpiSoftmaxP { static constexpr bool PERM = true, AFTER_DRAIN = true; bf16_t* P;
    __device__ __forceinline__ void fused(f32x4 (&acc)[2][2][4][2], const Unit& u, int wr, int wc, int fr, int fq, PG8_LAS unsigned char* lds, int wid, int lane) const {
        PG8_LAS f32x2* X = (PG8_LAS f32x2*)lds;
        float mloc[2][4];
#pragma unroll
        for (int ai = 0; ai < 2; ++ai)
#pragma unroll
            for (int m = 0; m < 4; ++m) { float mx = -__builtin_inff();
#pragma unroll
                for (int bj = 0; bj < 2; ++bj)
#pragma unroll
                    for (int n = 0; n < 2; ++n) { const f32x4 v = acc[ai][bj][m][n]; mx = fmaxf(mx, fmaxf(fmaxf(v[0], v[1]), fmaxf(v[2], v[3]))); }
                mx = fmaxf(mx, bperm(mx, (fr + 16 * fq) ^ 16)); mx = fmaxf(mx, bperm(mx, (fr + 16 * fq) ^ 32)); float s = 0.f;
#pragma unroll
                for (int bj = 0; bj < 2; ++bj)
#pragma unroll
                    for (int n = 0; n < 2; ++n) { f32x4 v = acc[ai][bj][m][n];
#pragma unroll
                        for (int i = 0; i < 4; ++i) { v[i] = __builtin_amdgcn_exp2f(v[i] - mx); s += v[i]; }
                        acc[ai][bj][m][n] = v; }
                s += bperm(s, (fr + 16 * fq) ^ 16); s += bperm(s, (fr + 16 * fq) ^ 32); mloc[ai][m] = mx;
                if (fq == 0) X[(ai * HALF + wr * 64 + m * 16 + fr) * 4 + wc] = (f32x2){mx, s}; __builtin_amdgcn_sched_barrier(0); }
        asm volatile("s_waitcnt lgkmcnt(0)" ::: "memory"); __builtin_amdgcn_s_barrier(); asm volatile("" ::: "memory");
#pragma unroll
        for (int ai = 0; ai < 2; ++ai)
#pragma unroll
            for (int m = 0; m < 4; ++m) { const int rl = ai * HALF + wr * 64 + m * 16 + fr;
                const f32x2 a = X[rl * 4 + 0], b = X[rl * 4 + 1], c = X[rl * 4 + 2], d = X[rl * 4 + 3];
                const float M = fmaxf(fmaxf(a.x, b.x), fmaxf(c.x, d.x));
                const float L = a.y * __builtin_amdgcn_exp2f(a.x - M) + b.y * __builtin_amdgcn_exp2f(b.x - M) + c.y * __builtin_amdgcn_exp2f(c.x - M) + d.y * __builtin_amdgcn_exp2f(d.x - M);
                const float f = __builtin_amdgcn_exp2f(mloc[ai][m] - M) / L;
#pragma unroll
                for (int bj = 0; bj < 2; ++bj) *(u32x4*)(P + (size_t)rl * 256 + bj * HALF + wc * 32 + 8 * fq) = pack8(acc[ai][bj][m][0] * f, acc[ai][bj][m][1] * f); __builtin_amdgcn_sched_barrier(0); }
        asm volatile("s_waitcnt vmcnt(0) lgkmcnt(0)" ::: "memory"); __builtin_amdgcn_s_barrier(); asm volatile("" ::: "memory");
    }
};

template <class Epi, class Sched, bool ALIGN_EPI = false, bool SP2 = false>
__device__ __forceinline__ void gemm_phase(PG8_LAS unsigned char* lds, const Gemm g, const Sched& S, const Epi& E) {
    int tid_o = threadIdx.x; asm volatile("" : "+v"(tid_o));
    const int tid = tid_o, wid = __builtin_amdgcn_readfirstlane(tid >> 6), lane = tid & 63, wr = wid >> 2, wc = wid & 3, fr = lane & 15, fq = lane >> 4;
    const int K = g.K, nt = K / BK;
    unsigned voffA[2], voffB[2];
#pragma unroll
    for (int i = 0; i < 2; ++i) { int R, C; stage_rc(tid * 16 + i * 8192, R, C); const int Rb = Epi::PERM ? ((R & ~31) + perm32(R & 31)) : R;
        voffA[i] = (unsigned)(R * g.lda + C) * 2u; voffB[i] = (unsigned)(Rb * g.ldb + C) * 2u; }
    const size_t kstep = (size_t)(BK * 2);
    const size_t hstepA = (size_t)HALF * g.lda * 2, hstepB = (size_t)HALF * g.ldb * 2;
    const size_t tstepA = 2 * hstepA, tstepB = 2 * hstepB;
    const unsigned ldsw = (unsigned)wid * 1024u;
    const int aoff = lds_byte(wr * 64 + fr, fq * 8), boff = lds_byte(wc * 32 + fr, fq * 8);
#define PG8_SA(b, h) (((b) * 2 + (h)) * HTB)
#define PG8_SB(b, h) ((4 + (b) * 2 + (h)) * HTB)
#define PG8_STAGE(bufoff, gbase, voff) do { _Pragma("unroll") for (int _i = 0; _i < 2; ++_i) \
        __builtin_amdgcn_global_load_lds((const unsigned*)((const char*)(gbase) + (voff)[_i]), (PG8_LAS unsigned*)(lds + (bufoff) + ldsw + _i * 8192), 16, 0, 0); } while (0)
#define PG8_LDA(dst, b, h) do { _Pragma("unroll") for (int m = 0; m < 4; ++m) _Pragma("unroll") for (int k = 0; k < 2; ++k) dst[m][k] = *(const PG8_LAS bf16x8*)(lds + PG8_SA(b, h) + aoff + m * 2048 + k * 1024); } while (0)
#define PG8_LDB(dst, b, h) do { _Pragma("unroll") for (int n = 0; n < 2; ++n) _Pragma("unroll") for (int k = 0; k < 2; ++k) dst[n][k] = *(const PG8_LAS bf16x8*)(lds + PG8_SB(b, h) + boff + n * 2048 + k * 1024); } while (0)
#define PG8_MMA(ai, bj, At, Bt) do { __builtin_amdgcn_s_setprio(1); _Pragma("unroll") for (int m = 0; m < 4; ++m) _Pragma("unroll") for (int n = 0; n < 2; ++n) _Pragma("unroll") for (int k = 0; k < 2; ++k) \
        acc[ai][bj][m][n] = __builtin_amdgcn_mfma_f32_16x16x32_bf16(Bt[n][k], At[m][k], acc[ai][bj][m][n], 0, 0, 0); __builtin_amdgcn_s_setprio(0); } while (0)
#define PG8_WAIT_V(n) asm volatile("s_waitcnt vmcnt(" #n ")" ::: "memory")
#define PG8_WAIT_L(n) asm volatile("s_waitcnt lgkmcnt(" #n ")" ::: "memory")
#define PG8_BAR __builtin_amdgcn_s_barrier()
#define PG8_SCHED __builtin_amdgcn_sched_barrier(0)
    Unit cur, nxt; int ui = 0;
    if (!S.next(0, cur)) return;
    f32x4 acc[2][2][4][2];
#pragma unroll
    for (int a = 0; a < 2; ++a)
#pragma unroll
        for (int b = 0; b < 2; ++b)
#pragma unroll
            for (int m = 0; m < 4; ++m)
#pragma unroll
                for (int n = 0; n < 2; ++n) acc[a][b][m][n] = (f32x4){0.f, 0.f, 0.f, 0.f};
    bf16x8 At[4][2], B0[2][2], B1[2][2];
    const char* cA = (const char*)g.A + (size_t)cur.pm * tstepA + (size_t)cur.pn * g.a_pn_off * 2; const char* cB = (const char*)g.Bt + (size_t)cur.pn * tstepB;
    S.a_ready(cur);
    if constexpr (SP2) {
        PG8_STAGE(PG8_SB(0, 0), cB, voffB); PG8_STAGE(PG8_SB(0, 1), cB + hstepB, voffB); PG8_STAGE(PG8_SA(0, 0), cA, voffA); PG8_STAGE(PG8_SA(0, 1), cA + hstepA, voffA);
        if (wr == 1) PG8_BAR;
        PG8_WAIT_V(2); PG8_BAR;
        PG8_STAGE(PG8_SB(1, 0), cB + kstep, voffB); PG8_STAGE(PG8_SA(1, 0), cA + kstep, voffA); PG8_STAGE(PG8_SB(1, 1), cB + hstepB + kstep, voffB);
        PG8_WAIT_V(6); PG8_BAR;
    } else {
        PG8_STAGE(PG8_SB(0, 0), cB, voffB); PG8_STAGE(PG8_SA(0, 0), cA, voffA); PG8_STAGE(PG8_SB(0, 1), cB + hstepB, voffB); PG8_STAGE(PG8_SA(0, 1), cA + hstepA, voffA);
        if (wr == 1) PG8_BAR;
        PG8_WAIT_V(4); PG8_BAR;
        PG8_STAGE(PG8_SB(1, 0), cB + kstep, voffB); PG8_STAGE(PG8_SA(1, 0), cA + kstep, voffA); PG8_STAGE(PG8_SB(1, 1), cB + hstepB + kstep, voffB);
        PG8_WAIT_V(6); PG8_BAR;
    }
    for (;;) {
        const bool has_next = S.next(ui + 1, nxt);
        const char* nA = has_next ? (const char*)g.A + (size_t)nxt.pm * tstepA + (size_t)nxt.pn * g.a_pn_off * 2 : cA; const char* nB = has_next ? (const char*)g.Bt + (size_t)nxt.pn * tstepB : cB;
        for (int t = 0; t < nt; t += 2) {
            const bool last = (t == nt - 2);
            const char* a1 = cA + (size_t)(t + 1) * kstep;
            const char* a2 = last ? nA : cA + (size_t)(t + 2) * kstep; const char* b2 = last ? nB : cB + (size_t)(t + 2) * kstep;
            const char* a3 = a2 + kstep; const char* b3 = b2 + kstep;
            if (last && has_next) S.a_ready(nxt);
            if constexpr (SP2) {
            PG8_LDB(B0, 0, 0); PG8_LDB(B1, 0, 1); PG8_SCHED; PG8_LDA(At, 0, 0); PG8_STAGE(PG8_SA(1, 1), a1 + hstepA, voffA);
            PG8_WAIT_V(8); PG8_WAIT_L(0); PG8_BAR; PG8_MMA(0, 0, At, B0); PG8_MMA(0, 1, At, B1); PG8_BAR; PG8_SCHED;
            PG8_LDA(At, 0, 1); PG8_STAGE(PG8_SB(0, 0), b2, voffB); PG8_STAGE(PG8_SB(0, 1), b2 + hstepB, voffB); PG8_STAGE(PG8_SA(0, 0), a2, voffA);
            PG8_WAIT_V(8); PG8_WAIT_L(0); PG8_BAR; PG8_MMA(1, 0, At, B0); PG8_MMA(1, 1, At, B1); PG8_BAR; PG8_SCHED;
            PG8_LDB(B0, 1, 0); PG8_LDB(B1, 1, 1); PG8_SCHED; PG8_LDA(At, 1, 0); PG8_STAGE(PG8_SA(0, 1), a2 + hstepA, voffA);
            PG8_WAIT_V(8); PG8_WAIT_L(0); PG8_BAR; PG8_MMA(0, 0, At, B0); PG8_MMA(0, 1, At, B1); PG8_BAR; PG8_SCHED;
            PG8_LDA(At, 1, 1); PG8_STAGE(PG8_SB(1, 0), b3, voffB); PG8_STAGE(PG8_SB(1, 1), b3 + hstepB, voffB); PG8_STAGE(PG8_SA(1, 0), a3, voffA);
            PG8_WAIT_V(8); PG8_WAIT_L(0); PG8_BAR; PG8_MMA(1, 0, At, B0); PG8_MMA(1, 1, At, B1); PG8_BAR; PG8_SCHED;
            } else {
            PG8_LDB(B0, 0, 0); PG8_SCHED; PG8_LDA(At, 0, 0); PG8_STAGE(PG8_SA(1, 1), a1 + hstepA, voffA);
            PG8_WAIT_L(8); PG8_BAR; PG8_WAIT_L(0); PG8_MMA(0, 0, At, B0); PG8_BAR; PG8_SCHED;
            PG8_LDB(B1, 0, 1); PG8_STAGE(PG8_SB(0, 0), b2, voffB);
            PG8_BAR; PG8_WAIT_L(0); PG8_MMA(0, 1, At, B1); PG8_BAR;
            PG8_LDA(At, 0, 1); PG8_STAGE(PG8_SA(0, 0), a2, voffA);
            PG8_BAR; PG8_WAIT_L(0); PG8_MMA(1, 0, At, B0); PG8_BAR; PG8_SCHED;
            PG8_STAGE(PG8_SB(0, 1), b2 + hstepB, voffB);
            PG8_WAIT_V(6); PG8_BAR; PG8_MMA(1, 1, At, B1); PG8_BAR;
            PG8_LDB(B0, 1, 0); PG8_SCHED; PG8_LDA(At, 1, 0); PG8_STAGE(PG8_SA(0, 1), a2 + hstepA, voffA);
            PG8_WAIT_L(8); PG8_BAR; PG8_WAIT_L(0); PG8_MMA(0, 0, At, B0); PG8_BAR; PG8_SCHED;
            PG8_LDB(B1, 1, 1); PG8_STAGE(PG8_SB(1, 0), b3, voffB);
            PG8_BAR; PG8_WAIT_L(0); PG8_MMA(0, 1, At, B1); PG8_BAR;
            PG8_LDA(At, 1, 1); PG8_STAGE(PG8_SA(1, 0), a3, voffA);
            PG8_BAR; PG8_WAIT_L(0); PG8_MMA(1, 0, At, B0); PG8_BAR; PG8_SCHED;
            PG8_STAGE(PG8_SB(1, 1), b3 + hstepB, voffB);
            PG8_WAIT_V(6); PG8_BAR; PG8_MMA(1, 1, At, B1); PG8_BAR;
            }
        }
        if constexpr (ALIGN_EPI) { if (wr == 0) PG8_BAR; }
        if constexpr (!Epi::AFTER_DRAIN) { E(acc, cur, wr, wc, fr, fq); S.done(cur); }
        if (!has_next) break;
#pragma unroll
        for (int a = 0; a < 2; ++a)
#pragma unroll
            for (int b = 0; b < 2; ++b)
#pragma unroll
                for (int m = 0; m < 4; ++m)
#pragma unroll
                    for (int n = 0; n < 2; ++n) acc[a][b][m][n] = (f32x4){0.f, 0.f, 0.f, 0.f};
        cur = nxt; cA = nA; cB = nB; ++ui;
        if constexpr (ALIGN_EPI) { if (wr == 1) PG8_BAR; }
    }
    PG8_WAIT_V(0);
    if constexpr (!ALIGN_EPI) { if (wr == 0) PG8_BAR; }
    PG8_BAR;
    if constexpr (Epi::AFTER_DRAIN) { E.fused(acc, cur, wr, wc, fr, fq, lds, wid, lane); S.done(cur); }
#undef PG8_SA
#undef PG8_SB
#undef PG8_STAGE
#undef PG8_LDA
#undef PG8_LDB
#undef PG8_MMA
#undef PG8_WAIT_V
#undef PG8_WAIT_L
#undef PG8_BAR
#undef PG8_SCHED
}
}
#include <hip/hip_bf16.h>
#include <cmath>
#define GAS __attribute__((address_space(1)))
#define LAS __attribute__((address_space(3)))
typedef unsigned short bf16;
typedef unsigned v4u __attribute__((ext_vector_type(4)));
typedef float f32x4 __attribute__((ext_vector_type(4)));
typedef short bf16x8 __attribute__((ext_vector_type(8)));
typedef float f32x16 __attribute__((ext_vector_type(16)));

constexpr int NWAVES = 8, NTHR = 512;
constexpr int BATCH = 2, SEQ = 8192, D = 1024, M = BATCH * SEQ, DFF = 2816, DEPTH = 2;
constexpr int INW = 7176;
constexpr size_t MiB = 1u << 20;
constexpr size_t WS_SS = 0, CTL_ZERO_BYTES = 1 * MiB;
constexpr size_t WS_WFL = 1 * MiB;
constexpr size_t WS_WAT = 1 * MiB + 256 * 1024, WS_WXT = 1 * MiB + 512 * 1024;
constexpr size_t WS_SUMM = 2 * MiB;
constexpr size_t WS_LOGF = 3 * MiB, WS_CTIL = 3 * MiB + 512 * 1024;
constexpr size_t WS_KPART = 7 * MiB;
constexpr size_t WS_MEMN = 4 * MiB, WS_KX = 5 * MiB, WS_VT = 6 * MiB;
constexpr size_t WS_W1IN = 8 * MiB, WS_W1OUT = 19 * MiB, WS_WIN = 25 * MiB, WS_WG = 33 * MiB, WS_UA = 39 * MiB, WS_UB = 40 * MiB, WS_UC = 42 * MiB,
                 WS_WO = 43 * MiB, WS_WXQ = 45 * MiB, WS_WXKV = 47 * MiB, WS_WXO = 51 * MiB, WS_W2IN = 53 * MiB, WS_W2OUT = 64 * MiB;
constexpr size_t WS_XB = 70 * MiB;
constexpr size_t WS_Q = 102 * MiB, WS_GG = 118 * MiB, WS_XA = 150 * MiB, WS_XL = 166 * MiB, WS_K = 198 * MiB, WS_V = 214 * MiB;
constexpr size_t WS_H = 102 * MiB;
constexpr size_t WS_YC = 150 * MiB;
constexpr size_t WS_STASH = 166 * MiB, WS_MG = 198 * MiB, WS_QX = 150 * MiB, WS_PBUF = 198 * MiB;
constexpr size_t WS_YA = 230 * MiB, WS_SSP = 246 * MiB, WS_END = 255 * MiB;
constexpr int LDS_BYTES = 147456;

__device__ __forceinline__ unsigned f2bf(float f) { unsigned u = __builtin_bit_cast(unsigned, f); return (u + 0x7fffu + ((u >> 16) & 1u)) >> 16; }
__device__ __forceinline__ unsigned pk2(float lo, float hi) { return f2bf(lo) | (f2bf(hi) << 16); }
__device__ __forceinline__ float bf2f(unsigned short v) { return __uint_as_float((unsigned)v << 16); }
__device__ __forceinline__ float bperm(float v, int srclane) { return __int_as_float(__builtin_amdgcn_ds_bpermute(srclane << 2, __float_as_int(v))); }
__device__ __forceinline__ float wave_sum(float v, int lane) {
#pragma unroll
    for (int o = 1; o < 64; o <<= 1) v += bperm(v, lane ^ o);
    return v;
}
__device__ __forceinline__ float flog1p(float e) { return e < 0.01f ? e * (1.f - e * (0.5f - e * 0.33333334f)) : __logf(1.f + e); }
#define LDS_WAIT() asm volatile("s_waitcnt lgkmcnt(0)" ::: "memory")

__device__ __forceinline__ void tr_item(const float* W, int ldn, int col0, int k0, const float* g, bf16* WT, int ldk, int drow0, LAS float* scr, int lane) {
    const int n4 = (lane & 15) * 4, kr = lane >> 4;
#pragma unroll
    for (int i = 0; i < 16; ++i) { const int kk = 4 * i + kr; f32x4 v = *(const f32x4*)(W + (size_t)(k0 + kk) * ldn + col0 + n4); if (g) v = v * g[k0 + kk];
        LAS float* d = scr + kk * 65 + n4; d[0] = v.x; d[1] = v.y; d[2] = v.z; d[3] = v.w; }
    LDS_WAIT(); asm volatile("" ::: "memory");
    const int c = lane & 7;
#pragma unroll
    for (int j = 0; j < 8; ++j) { const int n = (lane >> 3) + 8 * j; const LAS float* s = scr + (8 * c) * 65 + n;
        v4u o; o.x = pk2(s[0 * 65], s[1 * 65]); o.y = pk2(s[2 * 65], s[3 * 65]); o.z = pk2(s[4 * 65], s[5 * 65]); o.w = pk2(s[6 * 65], s[7 * 65]);
        *(v4u*)(WT + (size_t)(drow0 + n) * ldk + k0 + 8 * c) = o; }
    LDS_WAIT(); asm volatile("" ::: "memory");
}

#define RLX_AGENT __ATOMIC_RELAXED, __HIP_MEMORY_SCOPE_AGENT
#define XB_TMO      128
#define XB_XCNT(j)  (256  + 64 * (j))
#define XB_XSUB(j)  (1280 + 64 * (j))
#define XB_XGEN(j)  (2304 + 64 * (j))
#define XB_TOP      3328
#define XB_TOPGEN   3392
#define XCD_BAR_WORDS 3456
#define XB_SPIN_CAP (1u << 18)

__device__ __forceinline__ unsigned xb_ld(unsigned* p)              { return __hip_atomic_load(p, __ATOMIC_RELAXED, __HIP_MEMORY_SCOPE_AGENT); }
__device__ __forceinline__ unsigned xb_add(unsigned* p, unsigned v) { return __hip_atomic_fetch_add(p, v, __ATOMIC_RELAXED, __HIP_MEMORY_SCOPE_AGENT); }
__device__ __forceinline__ unsigned xb_xcc_id() { return (unsigned)__builtin_amdgcn_s_getreg((3 << 11) | 20) & 0xFu; }
#define XB_SPIN(cond, bar) do { unsigned _sp = 0; while (cond) { __builtin_amdgcn_s_sleep(1); \
    if ((++_sp & 255u) == 0u) { if (xb_ld(&(bar)[XB_TMO])) break; if (_sp > XB_SPIN_CAP) { atomicAdd(&(bar)[XB_TMO], 1u); break; } } } } while (0)

struct XcdBarrier {
    unsigned* bar; unsigned x;
    volatile LAS unsigned* st;
};

__device__ __forceinline__ XcdBarrier xcd_barrier_post(unsigned* bar, volatile LAS unsigned* st) {
    XcdBarrier b; b.bar = bar; b.x = xb_xcc_id(); b.st = st;
    if (threadIdx.x == 0) (void)xb_add(&bar[XB_XCNT(b.x)], 1u);
    return b;
}
__device__ __forceinline__ void xcd_barrier_complete(unsigned* bar, unsigned x, unsigned& nloc, unsigned& nx) {
    const unsigned G = gridDim.x * gridDim.y * gridDim.z;
    unsigned sum, cnt, mine, sp = 0u;
    for (;;) {
        sum = 0u; cnt = 0u; mine = 0u;
#pragma unroll
        for (unsigned j = 0; j < 16; ++j) { const unsigned c = xb_ld(&bar[XB_XCNT(j)]); sum += c; cnt += (c > 0u) ? 1u : 0u; mine = (j == x) ? c : mine; }
        if (sum == G) break;
        __builtin_amdgcn_s_sleep(1);
        if ((++sp & 255u) == 0u) { if (xb_ld(&bar[XB_TMO])) break; if (sp > XB_SPIN_CAP) { atomicAdd(&bar[XB_TMO], 1u); break; } }
    }
    nloc = mine > 0u ? mine : 1u; nx = cnt > 0u ? cnt : 1u;
}

__device__ __forceinline__ void xcd_barrier(const XcdBarrier& b) {
    asm volatile("s_waitcnt vmcnt(0)" ::: "memory");
    __syncthreads();
    if (threadIdx.x == 0) {
        unsigned* bar = b.bar;
        __builtin_amdgcn_s_waitcnt(0);
        unsigned nloc = b.st[0], nx = b.st[1];
        if (nloc == 0u) { xcd_barrier_complete(bar, b.x, nloc, nx); b.st[0] = nloc; b.st[1] = nx; }
        const unsigned old = xb_add(&bar[XB_XSUB(b.x)], 1u);
        const unsigned gen = old / nloc;
        if (old + 1u == (gen + 1u) * nloc) {
            __builtin_amdgcn_fence(__ATOMIC_RELEASE, "agent");
            asm volatile("s_waitcnt vmcnt(0)" ::: "memory");
            const unsigned og = xb_add(&bar[XB_TOP], 1u);
            const unsigned tg = og / nx;
            if (og + 1u == (tg + 1u) * nx) xb_add(&bar[XB_TOPGEN], 1u);
            else XB_SPIN(xb_ld(&bar[XB_TOPGEN]) == tg, bar);
            __builtin_amdgcn_fence(__ATOMIC_ACQUIRE, "agent");
            xb_add(&bar[XB_XGEN(b.x)], 1u);
            asm volatile("s_waitcnt vmcnt(0)" ::: "memory");
        } else {
            XB_SPIN(xb_ld(&bar[XB_XGEN(b.x)]) == gen, bar);
            __builtin_amdgcn_fence(__ATOMIC_ACQUIRE, "agent");
            asm volatile("s_waitcnt vmcnt(0)" ::: "memory");
        }
    }
    __syncthreads();
}

struct Args { const float* in[31]; float* out; unsigned char* ws; int pad[2]; };
typedef LAS unsigned long long* PtrTab;
__device__ __forceinline__ const float* tab_in(PtrTab tb, int k) { const unsigned long long v = tb[k]; const unsigned lo = __builtin_amdgcn_readfirstlane((unsigned)v), hi = __builtin_amdgcn_readfirstlane((unsigned)(v >> 32));
    return (const float*)(const GAS float*)(((unsigned long long)hi << 32) | lo); }
constexpr int TAB_OFF = 147456 - 512;
constexpr size_t WS_BAR = 768 * 1024; constexpr size_t WS_QCTR = 832 * 1024;

__device__ __forceinline__ void phase_prologue(PtrTab TB, unsigned char* ws, float* xout, int l, LAS unsigned char* lds, int gw, int NGW, int lane, int wave) {
    LAS float* scr = (LAS float*)(lds + wave * 16640);
#define g1 (tab_in(TB, 2) + l * D)
#define w1i (tab_in(TB, 3) + (size_t)l * D * 2 * DFF)
#define w1o (tab_in(TB, 4) + (size_t)l * DFF * D)
#define gm (tab_in(TB, 5) + l * D)
#define win (tab_in(TB, 6) + (size_t)l * D * INW)
#define wpool (tab_in(TB, 9) + (size_t)l * 4 * 128 * 128)
#define psc (tab_in(TB, 10) + l * 512)
#define wua (tab_in(TB, 11) + (size_t)l * 512 * D)
#define wra (tab_in(TB, 14) + (size_t)l * 8 * 128 * 128)
#define wrx (tab_in(TB, 16) + (size_t)l * 8 * 128 * 128)
#define wub (tab_in(TB, 19) + (size_t)l * D * D)
#define wuc (tab_in(TB, 20) + (size_t)l * 512 * D)
#define wo (tab_in(TB, 21) + (size_t)l * D * D)
#define gc (tab_in(TB, 22) + l * D)
#define gmem (tab_in(TB, 23) + l * D)
#define wxq (tab_in(TB, 24) + (size_t)l * D * D)
#define wxkv (tab_in(TB, 25) + (size_t)l * D * 2 * D)
#define wxo (tab_in(TB, 26) + (size_t)l * D * D)
#define g2 (tab_in(TB, 27) + l * D)
#define w2i (tab_in(TB, 28) + (size_t)l * D * 2 * DFF)
#define w2o (tab_in(TB, 29) + (size_t)l * DFF * D)
    constexpr int I_FI = 16 * 88, I_FO = 44 * 16, I_WIN = 16 * 64, I_WG = 16 * 48, I_UB = 16 * 16, I_UC = 8 * 16, I_RG = 32, I_SQ = 16 * 16, I_KV = 16 * 32;
    constexpr int S0 = 0, S1 = S0 + I_FI, S2 = S1 + I_FO, S3 = S2 + I_WIN, S4 = S3 + I_WG, S5 = S4 + I_UB, S6 = S5 + I_UC, S7 = S6 + I_RG, S8 = S7 + I_RG, S9 = S8 + I_SQ, S10 = S9 + I_SQ,
                  S11 = S10 + I_KV, S12 = S11 + I_SQ, S13 = S12 + I_FI, S14 = S13 + I_FO;
    for (int it = gw; it < S14; it += NGW) {
        if (it < S1 || (it >= S12 && it < S13)) {
            const bool second = it >= S12; const int r = second ? it - S12 : it; const int kb = r / 88, nb = r % 88; const int n = nb * 64;
            const int half = n >= DFF ? 1 : 0, nn = n - half * DFF; const int drow = (nn >> 7) * 256 + half * 128 + (nn & 127);
            tr_item(second ? w2i : w1i, 2 * DFF, n, kb * 64, second ? g2 : g1, (bf16*)(ws + (second ? WS_W2IN : WS_W1IN)), D, drow, scr, lane);
        } else if (it < S2 || it >= S13) {
            const bool second = it >= S13; const int r = second ? it - S13 : it - S1; const int kb = r / 16, nb = r % 16;
            tr_item(second ? w2o : w1o, D, nb * 64, kb * 64, nullptr, (bf16*)(ws + (second ? WS_W2OUT : WS_W1OUT)), DFF, nb * 64, scr, lane);
        } else if (it < S3) { const int r = it - S2, kb = r / 64, nb = r % 64; tr_item(win, INW, nb * 64, kb * 64, gm, (bf16*)(ws + WS_WIN), D, nb * 64, scr, lane);
        } else if (it < S4) { const int r = it - S3, kb = r / 48, nb = r % 48; tr_item(win, INW, 4104 + nb * 64, kb * 64, gm, (bf16*)(ws + WS_WG), D, nb * 64, scr, lane);
        } else if (it < S5) { const int r = it - S4, kb = r / 16, nb = r % 16; tr_item(wub, D, nb * 64, kb * 64, nullptr, (bf16*)(ws + WS_UB), D, nb * 64, scr, lane);
        } else if (it < S6) { const int r = it - S5, kb = r / 16, nb = r % 16; tr_item(wuc, D, nb * 64, kb * 64, nullptr, (bf16*)(ws + WS_UC), 512, nb * 64, scr, lane);
        } else if (it < S8) { const bool xg = it >= S7; const int r = xg ? it - S7 : it - S6; const int hh = r >> 2, kb = (r >> 1) & 1, nb = r & 1;
            tr_item((xg ? wrx : wra) + hh * 16384, 128, nb * 64, kb * 64, nullptr, (bf16*)(ws + (xg ? WS_WXT : WS_WAT)) + hh * 16384, 128, nb * 64, scr, lane);
        } else if (it < S9) { const int r = it - S8, kb = r / 16, nb = r % 16; tr_item(wo, D, nb * 64, kb * 64, nullptr, (bf16*)(ws + WS_WO), D, nb * 64, scr, lane);
        } else if (it < S10) { const int r = it - S9, kb = r / 16, nb = r % 16; tr_item(wxq, D, nb * 64, kb * 64, gc, (bf16*)(ws + WS_WXQ), D, nb * 64, scr, lane);
        } else if (it < S11) { const int r = it - S10, kb = r / 32, nb = r % 32; tr_item(wxkv, 2 * D, nb * 64, kb * 64, nullptr, (bf16*)(ws + WS_WXKV), D, nb * 64, scr, lane);
        } else { const int r = it - S11, kb = r / 16, nb = r % 16; tr_item(wxo, D, nb * 64, kb * 64, nullptr, (bf16*)(ws + WS_WXO), D, nb * 64, scr, lane); }
    }
    { bf16* UaT = (bf16*)(ws + WS_UA);
      for (int it = gw; it < 4 * 16 * 16; it += NGW) { const int g = it >> 8, nblk = (it >> 4) & 15, c0 = (it & 15) * 8, n = nblk * 64 + lane;
          const float* wp = wpool + ((size_t)g * 128 + c0) * 128; const float* sc = psc + g * 128; const float* ua = wua + (size_t)(g * 128) * D + n; float acc[8];
#pragma unroll
          for (int c = 0; c < 8; ++c) acc[c] = 0.f;
#pragma unroll 16
          for (int j = 0; j < 128; ++j) { const float u = ua[(size_t)j * D] * sc[j];
#pragma unroll
              for (int c = 0; c < 8; ++c) acc[c] += wp[c * 128 + j] * u; }
          v4u o; o.x = pk2(acc[0], acc[1]); o.y = pk2(acc[2], acc[3]); o.z = pk2(acc[4], acc[5]); o.w = pk2(acc[6], acc[7]);
          *(v4u*)(UaT + (size_t)n * 512 + g * 128 + c0) = o; } }
    { float* wfl = (float*)(ws + WS_WFL);
      for (int it = gw * 64 + lane; it < 8 * 1024; it += NGW * 64) { const int h = it >> 10, k = it & 1023; wfl[it] = gm[k] * win[(size_t)k * INW + 4096 + h]; } }
    { const float* mem = tab_in(TB, 1); bf16* mn = (bf16*)(ws + WS_MEMN);
      for (int r = gw; r < 512; r += NGW) { const f32x4* xr = (const f32x4*)(mem + (size_t)r * D) + lane; f32x4 v[4]; float s = 0.f;
#pragma unroll
          for (int j = 0; j < 4; ++j) { v[j] = xr[64 * j]; s += (v[j].x * v[j].x + v[j].y * v[j].y) + (v[j].z * v[j].z + v[j].w * v[j].w); }
          const float rs = rsqrtf(wave_sum(s, lane) * (1.f / D) + 1e-6f); unsigned long long* o8 = (unsigned long long*)(mn + (size_t)r * D) + lane;
#pragma unroll
          for (int j = 0; j < 4; ++j) { const f32x4 gv = *((const f32x4*)gmem + lane + 64 * j);
              o8[64 * j] = (unsigned long long)pk2(v[j].x * rs * gv.x, v[j].y * rs * gv.y) | ((unsigned long long)pk2(v[j].z * rs * gv.z, v[j].w * rs * gv.w) << 32); } } }
    if (l == 0) {
        const float* x = tab_in(TB, 0); float* xo = xout; bf16* xb = (bf16*)(ws + WS_XB); float* ss = (float*)(ws + WS_SSP);
        for (int r = gw; r < M; r += NGW) { const f32x4* xr = (const f32x4*)(x + (size_t)r * D) + lane; f32x4* orow = (f32x4*)(xo + (size_t)r * D) + lane; f32x4 v[4]; float s = 0.f;
#pragma unroll
            for (int j = 0; j < 4; ++j) { v[j] = xr[64 * j]; orow[64 * j] = v[j]; s += (v[j].x * v[j].x + v[j].y * v[j].y) + (v[j].z * v[j].z + v[j].w * v[j].w); }
            s = wave_sum(s, lane); if (lane < 4) ss[(size_t)r * 4 + lane] = lane == 0 ? s : 0.f; unsigned long long* o8 = (unsigned long long*)(xb + (size_t)r * D) + lane;
#pragma unroll
            for (int j = 0; j < 4; ++j) o8[64 * j] = (unsigned long long)pk2(v[j].x, v[j].y) | ((unsigned long long)pk2(v[j].z, v[j].w) << 32); }
    }
}
#undef g1
#undef w1i
#undef w1o
#undef gm
#undef win
#undef wpool
#undef psc
#undef wua
#undef wra
#undef wrx
#undef wub
#undef wuc
#undef wo
#undef gc
#undef gmem
#undef wxq
#undef wxkv
#undef wxo
#undef g2
#undef w2i
#undef w2o
__device__ __forceinline__ void phase_fl(const bf16* xb, const float* wfl, const float* bfv, const float* ss, float* logf, int gw, int NGW, int lane) {
    for (int r0 = gw; r0 < M; r0 += 4 * NGW) {
        float acc[4][8]; v4u xv[4][2];
#pragma unroll
        for (int q = 0; q < 4; ++q) { const int r = r0 + q * NGW; const bool ok = r < M;
#pragma unroll
            for (int j = 0; j < 2; ++j) xv[q][j] = ok ? *(const v4u*)(xb + (size_t)r * D + 8 * lane + 512 * j) : (v4u){0u, 0u, 0u, 0u};
#pragma unroll
            for (int h = 0; h < 8; ++h) acc[q][h] = 0.f; }
#pragma unroll
        for (int j = 0; j < 2; ++j) { const int k0 = 8 * lane + 512 * j;
#pragma unroll
            for (int h = 0; h < 8; ++h) { const f32x4 w0 = *(const f32x4*)(wfl + h * 1024 + k0), w1 = *(const f32x4*)(wfl + h * 1024 + k0 + 4);
#pragma unroll
                for (int q = 0; q < 4; ++q) { const v4u x = xv[q][j];
                    acc[q][h] += (__uint_as_float(x.x << 16) * w0.x + __uint_as_float(x.x & 0xffff0000u) * w0.y) + (__uint_as_float(x.y << 16) * w0.z + __uint_as_float(x.y & 0xffff0000u) * w0.w)
                               + (__uint_as_float(x.z << 16) * w1.x + __uint_as_float(x.z & 0xffff0000u) * w1.y) + (__uint_as_float(x.w << 16) * w1.z + __uint_as_float(x.w & 0xffff0000u) * w1.w); } } }
        const int h = ((lane >> 5) & 1) * 4 + ((lane >> 4) & 1) * 2 + ((lane >> 3) & 1); const float bh_ = bfv[h];
#pragma unroll
        for (int q = 0; q < 4; ++q) { const int r = r0 + q * NGW;
            float v4[4], v2[2], v1;
            { const bool up = (lane & 32) != 0;
#pragma unroll
              for (int i = 0; i < 4; ++i) { const float mine = up ? acc[q][4 + i] : acc[q][i], other = up ? acc[q][i] : acc[q][4 + i]; v4[i] = mine + bperm(other, lane ^ 32); } }
            { const bool up = (lane & 16) != 0;
#pragma unroll
              for (int i = 0; i < 2; ++i) { const float mine = up ? v4[2 + i] : v4[i], other = up ? v4[i] : v4[2 + i]; v2[i] = mine + bperm(other, lane ^ 16); } }
            { const bool up = (lane & 8) != 0; const float mine = up ? v2[1] : v2[0], other = up ? v2[0] : v2[1]; v1 = mine + bperm(other, lane ^ 8); }
            v1 += bperm(v1, lane ^ 4); v1 += bperm(v1, lane ^ 2); v1 += bperm(v1, lane ^ 1);
            if (r < M) { const float z = v1 * pg8::rstd_of(ss, r) + bh_; const float ls = -(fmaxf(-z, 0.f) + flog1p(__expf(-fabsf(z)))); if ((lane & 7) == 0) logf[(size_t)r * 8 + h] = ls; } }
    }
}
__device__ __forceinline__ void cumsum_bh(const float* logf, float* ctil, int bh, LAS float* red) {
    int tid_o = threadIdx.x; asm volatile("" : "+v"(tid_o)); const int tid = tid_o, lane = tid & 63, wid = tid >> 6;
    const int b = bh >> 3, h = bh & 7; const float* src = logf + ((size_t)b * SEQ + 16 * tid) * 8 + h; float v[16]; float s = 0.f;
#pragma unroll
    for (int i = 0; i < 16; ++i) { v[i] = src[(size_t)i * 8]; s += v[i]; }
    float incl = s;
#pragma unroll
    for (int o = 1; o < 64; o <<= 1) { const float t = bperm(incl, lane - o); if (lane >= o) incl += t; }
    if (lane == 63) red[wid] = incl;
    __syncthreads();
    float base = 0.f;
#pragma unroll
    for (int w = 0; w < 8; ++w) if (w < wid) base += red[w];
    float run = base + incl - s; float* dst = ctil + (size_t)bh * SEQ + 16 * tid;
#pragma unroll
    for (int i = 0; i < 16; ++i) { run += v[i]; dst[i] = run * 1.4426950408889634f; }
    __syncthreads();
}
__device__ __forceinline__ void unpk8(const v4u xv, float (&xf)[8]) { xf[0] = __uint_as_float(xv.x << 16); xf[1] = __uint_as_float(xv.x & 0xffff0000u); xf[2] = __uint_as_float(xv.y << 16); xf[3] = __uint_as_float(xv.y & 0xffff0000u);
    xf[4] = __uint_as_float(xv.z << 16); xf[5] = __uint_as_float(xv.z & 0xffff0000u); xf[6] = __uint_as_float(xv.w << 16); xf[7] = __uint_as_float(xv.w & 0xffff0000u); }
template <int W> __device__ __forceinline__ void pool_item(const bf16* xa, bf16* ya, int m0, int cgi) {
    const int t0 = m0 & (SEQ - 1); v4u rw[W + 7];
#pragma unroll
    for (int a = 0; a < W + 7; ++a) { const int tl = a - (W - 1); rw[a] = (t0 + tl >= 0) ? *(const v4u*)(xa + (size_t)(m0 + tl) * 512 + 8 * cgi) : (v4u){0u, 0u, 0u, 0u}; }
    float s[8];
#pragma unroll
    for (int i = 0; i < 8; ++i) s[i] = 0.f;
#pragma unroll
    for (int a = 0; a < W - 1; ++a) { float xf[8]; unpk8(rw[a], xf);
#pragma unroll
        for (int i = 0; i < 8; ++i) s[i] += xf[i]; }
#pragma unroll
    for (int o = 0; o < 8; ++o) { float cur[8]; unpk8(rw[o + W - 1], cur);
#pragma unroll
        for (int i = 0; i < 8; ++i) s[i] += cur[i];
        const int t = t0 + o, cnt = (t + 1 < W) ? t + 1 : W; const float ic = 1.f / (float)cnt; v4u ov;
        ov.x = pk2(s[0] * ic - cur[0], s[1] * ic - cur[1]); ov.y = pk2(s[2] * ic - cur[2], s[3] * ic - cur[3]); ov.z = pk2(s[4] * ic - cur[4], s[5] * ic - cur[5]); ov.w = pk2(s[6] * ic - cur[6], s[7] * ic - cur[7]);
        *(v4u*)(ya + (size_t)(m0 + o) * 512 + 8 * cgi) = ov;
        float old[8]; unpk8(rw[o], old);
#pragma unroll
        for (int i = 0; i < 8; ++i) s[i] -= old[i]; }
}
__device__ __forceinline__ void phase_pool(const bf16* xa, bf16* ya, int gtid, int nthr) {
    for (int idx = gtid; idx < (M / 8) * 64; idx += nthr) { const int c16 = idx & 15, rl = (idx >> 4) & 3, g = (idx >> 6) & 3, rh = idx >> 8; const int m0 = (rh * 4 + rl) * 8, cgi = g * 16 + c16;
        if (g == 0) pool_item<2>(xa, ya, m0, cgi); else if (g == 1) pool_item<4>(xa, ya, m0, cgi); else if (g == 2) pool_item<8>(xa, ya, m0, cgi); else pool_item<16>(xa, ya, m0, cgi); }
}
__device__ __forceinline__ int crow16(int r, int hi) { return (r & 3) + 8 * (r >> 2) + 4 * hi; }
template <bool FINAL>
__device__ __forceinline__ void lru_item(LAS unsigned char* lds, int b, int hp, int ck, const bf16* xl, bf16* gg, const float* cw, const float* cb, const bf16* WaT, const bf16* WxT,
                                         const float* ba, const float* bx, const float* lam, float* summ) {
    int tid_o = threadIdx.x; asm volatile("" : "+v"(tid_o)); const int tid = tid_o, lane = tid & 63, wid = tid >> 6, r32 = lane & 31, hi = lane >> 5;
    const int t0 = ck * 128; const size_t m0 = (size_t)b * SEQ + t0; const int ch0 = hp * 256;
    constexpr int XP = 264;
    LAS bf16* xc = (LAS bf16*)lds; LAS float* h0s = (LAS float*)(lds + 128 * XP * 2);
    {
        const int cgi = tid & 31, tq = tid >> 5, c = ch0 + 8 * cgi;
        float w[4][8], bb[8];
#pragma unroll
        for (int k = 0; k < 4; ++k) { const f32x4 a = *(const f32x4*)(cw + k * 1024 + c), d = *(const f32x4*)(cw + k * 1024 + c + 4); w[k][0] = a.x; w[k][1] = a.y; w[k][2] = a.z; w[k][3] = a.w; w[k][4] = d.x; w[k][5] = d.y; w[k][6] = d.z; w[k][7] = d.w; }
        { const f32x4 a = *(const f32x4*)(cb + c), d = *(const f32x4*)(cb + c + 4); bb[0] = a.x; bb[1] = a.y; bb[2] = a.z; bb[3] = a.w; bb[4] = d.x; bb[5] = d.y; bb[6] = d.z; bb[7] = d.w; }
        v4u rw[11];
#pragma unroll
        for (int i = 0; i < 11; ++i) { const int tl = tq * 8 - 3 + i; rw[i] = (t0 + tl >= 0) ? *(const v4u*)(xl + (size_t)((long)m0 + tl) * 1024 + c) : (v4u){0u, 0u, 0u, 0u}; }
#pragma unroll
        for (int o = 0; o < 8; ++o) { float y[8];
#pragma unroll
            for (int j = 0; j < 8; ++j) y[j] = bb[j];
#pragma unroll
            for (int k = 0; k < 4; ++k) { const v4u xv = rw[o + k];
                y[0] += w[k][0] * __uint_as_float(xv.x << 16); y[1] += w[k][1] * __uint_as_float(xv.x & 0xffff0000u); y[2] += w[k][2] * __uint_as_float(xv.y << 16); y[3] += w[k][3] * __uint_as_float(xv.y & 0xffff0000u);
                y[4] += w[k][4] * __uint_as_float(xv.z << 16); y[5] += w[k][5] * __uint_as_float(xv.z & 0xffff0000u); y[6] += w[k][6] * __uint_as_float(xv.w << 16); y[7] += w[k][7] * __uint_as_float(xv.w & 0xffff0000u); }
            v4u ov; ov.x = pk2(y[0], y[1]); ov.y = pk2(y[2], y[3]); ov.z = pk2(y[4], y[5]); ov.w = pk2(y[6], y[7]);
            *(LAS v4u*)(xc + (tq * 8 + o) * XP + 8 * cgi) = ov; }
    }
    if (FINAL && tid < 256) {
        const float* sp = summ + ((size_t)b * 64 * 1024 + ch0 + tid) * 2; float h = 0.f;
        for (int c0 = 0; c0 < ck; c0 += 16) { float2 v[16];
#pragma unroll
            for (int j = 0; j < 16; ++j) v[j] = (c0 + j < ck) ? *(const float2*)(sp + (size_t)(c0 + j) * 2048) : make_float2(1.f, 0.f);
#pragma unroll
            for (int j = 0; j < 16; ++j) h = v[j].x * h + v[j].y; }
        h0s[tid] = h;
    }
    __syncthreads();
    const int hh = wid >> 2, s = wid & 3, chl = 128 * hh + 32 * s + r32, ch = ch0 + chl, head = 2 * hp + hh;
    const float bav = ba[ch], bxv = bx[ch]; const float nl = -lam[ch]; const float sp8 = 8.f * (fmaxf(nl, 0.f) + flog1p(__expf(-fabsf(nl))));
    bf16x8 fa[8], fx[8];
#pragma unroll
    for (int ks = 0; ks < 8; ++ks) { fa[ks] = *(const bf16x8*)(WaT + (size_t)head * 16384 + (32 * s + r32) * 128 + 16 * ks + 8 * hi); fx[ks] = *(const bf16x8*)(WxT + (size_t)head * 16384 + (32 * s + r32) * 128 + 16 * ks + 8 * hi); }
    float hrun = FINAL ? h0s[chl] : 0.f, Arun = 1.f;
    for (int mb = 0; mb < 4; ++mb) {
        unsigned short gv[16];
        if (FINAL) {
#pragma unroll
            for (int r = 0; r < 16; ++r) gv[r] = gg[(m0 + 32 * mb + crow16(r, hi)) * 1024 + ch]; }
        f32x16 accA = {0.f, 0.f, 0.f, 0.f, 0.f, 0.f, 0.f, 0.f, 0.f, 0.f, 0.f, 0.f, 0.f, 0.f, 0.f, 0.f}, accX = accA;
#pragma unroll
        for (int ks = 0; ks < 8; ++ks) { const bf16x8 af = *(const LAS bf16x8*)(xc + (32 * mb + r32) * XP + 128 * hh + 16 * ks + 8 * hi);
            accA = __builtin_amdgcn_mfma_f32_32x32x16_bf16(af, fa[ks], accA, 0, 0, 0); accX = __builtin_amdgcn_mfma_f32_32x32x16_bf16(af, fx[ks], accX, 0, 0, 0); }
        float a[16], u[16];
#pragma unroll
        for (int r = 0; r < 16; ++r) { const int tok = 32 * mb + crow16(r, hi); const float xcv = bf2f(xc[tok * XP + chl]);
            const float rg = pg8::fsig(accA[r] + bav), la = -rg * sp8, av = __expf(la), mult = sqrtf(fmaxf(1.f - av * av, 0.f)), ig = pg8::fsig(accX[r] + bxv);
            a[r] = av; u[r] = mult * ig * xcv; }
        float As[4], Hs[4], Ap[4], Hp[4], hin[4];
#pragma unroll
        for (int g = 0; g < 4; ++g) { float Aq = 1.f, Hq = 0.f;
#pragma unroll
            for (int i = 0; i < 4; ++i) { Hq = a[4 * g + i] * Hq + u[4 * g + i]; Aq *= a[4 * g + i]; }
            As[g] = Aq; Hs[g] = Hq; Ap[g] = bperm(Aq, lane ^ 32); Hp[g] = bperm(Hq, lane ^ 32); }
#pragma unroll
        for (int g = 0; g < 4; ++g) { const float A0 = hi ? Ap[g] : As[g], H0 = hi ? Hp[g] : Hs[g], A1 = hi ? As[g] : Ap[g], H1 = hi ? Hs[g] : Hp[g];
            const float hA = hrun, hB = A0 * hA + H0; hrun = A1 * hB + H1; Arun *= A0 * A1; hin[g] = hi ? hB : hA; }
        if (FINAL) {
#pragma unroll
            for (int g = 0; g < 4; ++g) { float hc = hin[g];
#pragma unroll
                for (int i = 0; i < 4; ++i) { const int r = 4 * g + i; hc = a[r] * hc + u[r]; gv[r] = (unsigned short)f2bf(hc * bf2f(gv[r])); } }
#pragma unroll
            for (int r = 0; r < 16; ++r) gg[(m0 + 32 * mb + crow16(r, hi)) * 1024 + ch] = gv[r];
        }
    }
    if (!FINAL && hi == 0) { float* sp = summ + (((size_t)b * 64 + ck) * 1024 + ch) * 2; sp[0] = Arun; sp[1] = hrun; }
    __syncthreads();
}
__device__ __forceinline__ void phase_final(float* x, const float* g, int gw, int NGW, int lane) {
    for (int r = gw; r < M; r += NGW) { f32x4* xr = (f32x4*)(x + (size_t)r * D) + lane; f32x4 v[4]; float s = 0.f;
#pragma unroll
        for (int j = 0; j < 4; ++j) { v[j] = xr[64 * j]; s += (v[j].x * v[j].x + v[j].y * v[j].y) + (v[j].z * v[j].z + v[j].w * v[j].w); }
        const float rs = rsqrtf(wave_sum(s, lane) * (1.f / D) + 1e-6f);
#pragma unroll
        for (int j = 0; j < 4; ++j) { const f32x4 gv = *((const f32x4*)g + lane + 64 * j); xr[64 * j] = (f32x4){v[j].x * rs * gv.x, v[j].y * rs * gv.y, v[j].z * rs * gv.z, v[j].w * rs * gv.w}; } }
}
__device__ __forceinline__ void phase_kmax(const bf16* K, float* kpart, int gw, int NGW, int lane) {
    float m0 = 0.f, m1 = 0.f;
#pragma unroll 8
    for (int r = gw; r < M; r += NGW) { const v4u w = *(const v4u*)(K + (size_t)r * 512 + 8 * lane);
        const float a0 = __uint_as_float(w.x << 16), a1 = __uint_as_float(w.x & 0xffff0000u), a2 = __uint_as_float(w.y << 16), a3 = __uint_as_float(w.y & 0xffff0000u);
        const float a4 = __uint_as_float(w.z << 16), a5 = __uint_as_float(w.z & 0xffff0000u), a6 = __uint_as_float(w.w << 16), a7 = __uint_as_float(w.w & 0xffff0000u);
        float s = (a0 * a0 + a1 * a1) + (a2 * a2 + a3 * a3) + (a4 * a4 + a5 * a5) + (a6 * a6 + a7 * a7);
        s += bperm(s, lane ^ 1); s += bperm(s, lane ^ 2); s += bperm(s, lane ^ 4);
        if (r < SEQ) m0 = fmaxf(m0, s); else m1 = fmaxf(m1, s); }
    if ((lane & 7) == 0) { kpart[((size_t)gw * 2 + 0) * 8 + (lane >> 3)] = m0; kpart[((size_t)gw * 2 + 1) * 8 + (lane >> 3)] = m1; }
}
constexpr float FOX_C2 = 0.125f * 1.4426950408889634f;
constexpr float FOX_SKIP = 64.f;
constexpr int FOX_KP = 72;
constexpr int FOX_BUF = 2 * 64 * FOX_KP * 2 + 256;
__device__ __forceinline__ void fox_unit(LAS unsigned char* lds, int b, int h, int qb, const bf16* Q, const bf16* K, const bf16* V, bf16* O, const float* ct, const float* kpart, int nparts) {
    int tid_o = threadIdx.x; asm volatile("" : "+v"(tid_o)); const int tid = tid_o, lane = tid & 63, wid = tid >> 6, r32 = lane & 31, hi = lane >> 5;
    const size_t rowbase = (size_t)b * SEQ; const int q0 = qb * 256, NT = 4 * qb + 4;
    const bf16* Qw = Q + (rowbase + q0 + wid * 32 + r32) * 512 + h * 64;
    bf16x8 qr[4];
#pragma unroll
    for (int d0 = 0; d0 < 4; ++d0) qr[d0] = *(const bf16x8*)(Qw + 16 * d0 + 8 * hi);
    LAS float* red = (LAS float*)(lds + 2 * FOX_BUF); LAS int* tsl = (LAS int*)(lds + 2 * FOX_BUF + 128);
    { float qn = 0.f;
#pragma unroll
      for (int d0 = 0; d0 < 4; ++d0) { const v4u w = __builtin_bit_cast(v4u, qr[d0]);
          const float a0 = __uint_as_float(w.x << 16), a1 = __uint_as_float(w.x & 0xffff0000u), a2 = __uint_as_float(w.y << 16), a3 = __uint_as_float(w.y & 0xffff0000u);
          const float a4 = __uint_as_float(w.z << 16), a5 = __uint_as_float(w.z & 0xffff0000u), a6 = __uint_as_float(w.w << 16), a7 = __uint_as_float(w.w & 0xffff0000u);
          qn += (a0 * a0 + a1 * a1) + (a2 * a2 + a3 * a3) + (a4 * a4 + a5 * a5) + (a6 * a6 + a7 * a7); }
      qn += bperm(qn, lane ^ 32);
#pragma unroll
      for (int o = 1; o < 32; o <<= 1) qn = fmaxf(qn, bperm(qn, lane ^ o));
      __syncthreads();
      float km = 0.f;
      for (int i = tid; i < nparts; i += NTHR) km = fmaxf(km, kpart[((size_t)i * 2 + b) * 8 + h]);
#pragma unroll
      for (int o = 1; o < 64; o <<= 1) km = fmaxf(km, bperm(km, lane ^ o));
      if (lane == 0) { red[wid] = qn; red[8 + wid] = km; } if (tid == 0) tsl[0] = 4 * qb;
      __syncthreads();
      float q2 = red[0], k2 = red[8];
#pragma unroll
      for (int w = 1; w < 8; ++w) { q2 = fmaxf(q2, red[w]); k2 = fmaxf(k2, red[8 + w]); }
      const float thr = 2.f * sqrtf(q2) * sqrtf(k2) * 1.0001f + FOX_SKIP;
      const float c0 = ct[q0];
      if (tid < 4 * qb && ct[64 * tid + 63] - c0 <= thr) atomicMin((int*)tsl, tid);
      __syncthreads(); }
    const int T0 = tsl[0];
    const int skey = tid >> 3, sd = (tid & 7) * 8;
    const bf16* kp = K + (rowbase + skey) * 512 + h * 64 + sd; const bf16* vp = V + (rowbase + skey) * 512 + h * 64 + sd;
    v4u kreg = *(const v4u*)(kp + (size_t)T0 * 64 * 512), vreg = *(const v4u*)(vp + (size_t)T0 * 64 * 512); float creg = (tid < 64) ? ct[64 * T0 + tid] : 0.f;
    __syncthreads();
    { LAS unsigned char* buf0 = lds + (T0 & 1) * FOX_BUF; LAS bf16* Ks = (LAS bf16*)buf0; LAS bf16* Vt = Ks + 64 * FOX_KP; LAS float* Cs = (LAS float*)(buf0 + 2 * 64 * FOX_KP * 2);
      *(LAS v4u*)(Ks + skey * FOX_KP + sd) = kreg;
      Vt[(sd + 0) * FOX_KP + skey] = (bf16)(vreg.x & 0xffffu); Vt[(sd + 1) * FOX_KP + skey] = (bf16)(vreg.x >> 16); Vt[(sd + 2) * FOX_KP + skey] = (bf16)(vreg.y & 0xffffu); Vt[(sd + 3) * FOX_KP + skey] = (bf16)(vreg.y >> 16);
      Vt[(sd + 4) * FOX_KP + skey] = (bf16)(vreg.z & 0xffffu); Vt[(sd + 5) * FOX_KP + skey] = (bf16)(vreg.z >> 16); Vt[(sd + 6) * FOX_KP + skey] = (bf16)(vreg.w & 0xffffu); Vt[(sd + 7) * FOX_KP + skey] = (bf16)(vreg.w >> 16);
      if (tid < 64) Cs[tid] = creg; }
    if (T0 + 1 < NT) { kreg = *(const v4u*)(kp + (size_t)(T0 + 1) * 64 * 512); vreg = *(const v4u*)(vp + (size_t)(T0 + 1) * 64 * 512); if (tid < 64) creg = ct[64 * (T0 + 1) + tid]; }
    float m = -1e30f, l = 0.f; f32x16 o0, o1;
#pragma unroll
    for (int r = 0; r < 16; ++r) { o0[r] = 0.f; o1[r] = 0.f; }
    for (int t = T0; t < NT; ++t) {
        __syncthreads();
        if (t + 1 < NT) { LAS unsigned char* bufn = lds + ((t + 1) & 1) * FOX_BUF; LAS bf16* Ks = (LAS bf16*)bufn; LAS bf16* Vt = Ks + 64 * FOX_KP; LAS float* Cs = (LAS float*)(bufn + 2 * 64 * FOX_KP * 2);
            *(LAS v4u*)(Ks + skey * FOX_KP + sd) = kreg;
            Vt[(sd + 0) * FOX_KP + skey] = (bf16)(vreg.x & 0xffffu); Vt[(sd + 1) * FOX_KP + skey] = (bf16)(vreg.x >> 16); Vt[(sd + 2) * FOX_KP + skey] = (bf16)(vreg.y & 0xffffu); Vt[(sd + 3) * FOX_KP + skey] = (bf16)(vreg.y >> 16);
            Vt[(sd + 4) * FOX_KP + skey] = (bf16)(vreg.z & 0xffffu); Vt[(sd + 5) * FOX_KP + skey] = (bf16)(vreg.z >> 16); Vt[(sd + 6) * FOX_KP + skey] = (bf16)(vreg.w & 0xffffu); Vt[(sd + 7) * FOX_KP + skey] = (bf16)(vreg.w >> 16);
            if (tid < 64) Cs[tid] = creg;
            if (t + 2 < NT) { kreg = *(const v4u*)(kp + (size_t)(t + 2) * 64 * 512); vreg = *(const v4u*)(vp + (size_t)(t + 2) * 64 * 512); if (tid < 64) creg = ct[64 * (t + 2) + tid]; } }
        const int jb = t - (NT - 4);
        if (jb >= 0 && 64 * jb > 32 * wid + 31) continue;
        LAS unsigned char* buf = lds + (t & 1) * FOX_BUF; const LAS bf16* Ks = (const LAS bf16*)buf; const LAS bf16* Vt = Ks + 64 * FOX_KP; const LAS float* Cs = (const LAS float*)(buf + 2 * 64 * FOX_KP * 2);
        f32x16 p0, p1;
#pragma unroll
        for (int g = 0; g < 4; ++g) { const f32x4 a = *(const LAS f32x4*)(Cs + 8 * g + 4 * hi), c = *(const LAS f32x4*)(Cs + 32 + 8 * g + 4 * hi);
            p0[4 * g + 0] = -a[0]; p0[4 * g + 1] = -a[1]; p0[4 * g + 2] = -a[2]; p0[4 * g + 3] = -a[3]; p1[4 * g + 0] = -c[0]; p1[4 * g + 1] = -c[1]; p1[4 * g + 2] = -c[2]; p1[4 * g + 3] = -c[3]; }
#pragma unroll
        for (int d0 = 0; d0 < 4; ++d0) { const bf16x8 a0 = *(const LAS bf16x8*)(Ks + r32 * FOX_KP + 16 * d0 + 8 * hi), a1 = *(const LAS bf16x8*)(Ks + (32 + r32) * FOX_KP + 16 * d0 + 8 * hi);
            p0 = __builtin_amdgcn_mfma_f32_32x32x16_bf16(a0, qr[d0], p0, 0, 0, 0); p1 = __builtin_amdgcn_mfma_f32_32x32x16_bf16(a1, qr[d0], p1, 0, 0, 0); }
        if (jb >= 0) { const int qrel = 32 * wid + r32, kb = 64 * jb + 4 * hi;
#pragma unroll
            for (int r = 0; r < 16; ++r) { const int kv = kb + (r & 3) + 8 * (r >> 2); if (kv > qrel) p0[r] = -__builtin_inff(); if (kv + 32 > qrel) p1[r] = -__builtin_inff(); } }
        float mx = fmaxf(p0[0], p1[0]);
#pragma unroll
        for (int r = 1; r < 16; ++r) mx = fmaxf(mx, fmaxf(p0[r], p1[r]));
        mx = fmaxf(mx, bperm(mx, lane ^ 32));
        const float mn = fmaxf(m, mx), alpha = __builtin_amdgcn_exp2f(m - mn); m = mn;
        float sum = 0.f;
#pragma unroll
        for (int r = 0; r < 16; ++r) { p0[r] = __builtin_amdgcn_exp2f(p0[r] - mn); p1[r] = __builtin_amdgcn_exp2f(p1[r] - mn); sum += p0[r] + p1[r]; }
        l = l * alpha + sum;
#pragma unroll
        for (int r = 0; r < 16; ++r) { o0[r] *= alpha; o1[r] *= alpha; }
        bf16x8 pb[4];
        { v4u w;
          w.x = pg8::cvt_pk_bf16(p0[0], p0[1]); w.y = pg8::cvt_pk_bf16(p0[2], p0[3]); w.z = pg8::cvt_pk_bf16(p0[4], p0[5]); w.w = pg8::cvt_pk_bf16(p0[6], p0[7]); pb[0] = __builtin_bit_cast(bf16x8, w);
          w.x = pg8::cvt_pk_bf16(p0[8], p0[9]); w.y = pg8::cvt_pk_bf16(p0[10], p0[11]); w.z = pg8::cvt_pk_bf16(p0[12], p0[13]); w.w = pg8::cvt_pk_bf16(p0[14], p0[15]); pb[1] = __builtin_bit_cast(bf16x8, w);
          w.x = pg8::cvt_pk_bf16(p1[0], p1[1]); w.y = pg8::cvt_pk_bf16(p1[2], p1[3]); w.z = pg8::cvt_pk_bf16(p1[4], p1[5]); w.w = pg8::cvt_pk_bf16(p1[6], p1[7]); pb[2] = __builtin_bit_cast(bf16x8, w);
          w.x = pg8::cvt_pk_bf16(p1[8], p1[9]); w.y = pg8::cvt_pk_bf16(p1[10], p1[11]); w.z = pg8::cvt_pk_bf16(p1[12], p1[13]); w.w = pg8::cvt_pk_bf16(p1[14], p1[15]); pb[3] = __builtin_bit_cast(bf16x8, w); }
#pragma unroll
        for (int mm = 0; mm < 4; ++mm) {
            typedef unsigned u32x2v __attribute__((ext_vector_type(2)));
            const u32x2v a0l = *(const LAS u32x2v*)(Vt + r32 * FOX_KP + 16 * mm + 4 * hi), a0h = *(const LAS u32x2v*)(Vt + r32 * FOX_KP + 16 * mm + 8 + 4 * hi);
            const u32x2v a1l = *(const LAS u32x2v*)(Vt + (32 + r32) * FOX_KP + 16 * mm + 4 * hi), a1h = *(const LAS u32x2v*)(Vt + (32 + r32) * FOX_KP + 16 * mm + 8 + 4 * hi);
            const v4u A0 = {a0l.x, a0l.y, a0h.x, a0h.y}, A1 = {a1l.x, a1l.y, a1h.x, a1h.y};
            o0 = __builtin_amdgcn_mfma_f32_32x32x16_bf16(__builtin_bit_cast(bf16x8, A0), pb[mm], o0, 0, 0, 0);
            o1 = __builtin_amdgcn_mfma_f32_32x32x16_bf16(__builtin_bit_cast(bf16x8, A1), pb[mm], o1, 0, 0, 0); }
    }
    l += bperm(l, lane ^ 32); const float inv = 1.f / l;
    bf16* Ow = O + (rowbase + q0 + wid * 32 + r32) * 512 + h * 64;
#pragma unroll
    for (int g = 0; g < 4; ++g) { typedef unsigned u32x2v __attribute__((ext_vector_type(2)));
        u32x2v w0, w1; w0.x = pg8::cvt_pk_bf16(o0[4 * g] * inv, o0[4 * g + 1] * inv); w0.y = pg8::cvt_pk_bf16(o0[4 * g + 2] * inv, o0[4 * g + 3] * inv);
        w1.x = pg8::cvt_pk_bf16(o1[4 * g] * inv, o1[4 * g + 1] * inv); w1.y = pg8::cvt_pk_bf16(o1[4 * g + 2] * inv, o1[4 * g + 3] * inv);
        *(u32x2v*)(Ow + 8 * g + 4 * hi) = w0; *(u32x2v*)(Ow + 32 + 8 * g + 4 * hi) = w1; }
    __syncthreads();
}
__global__ void __launch_bounds__(NTHR, 2) hybrid_fwd(Args args) {
    extern __shared__ __attribute__((aligned(16))) unsigned char lds_raw[];
    cg::grid_group grid = cg::this_grid();
    LAS unsigned char* lds = (LAS unsigned char*)lds_raw;
    int tid = threadIdx.x, lane = tid & 63, wave = __builtin_amdgcn_readfirstlane(tid >> 6);
    int G = gridDim.x, bx = blockIdx.x;
    int vcu = (G % 8 == 0) ? (bx % 8) * (G / 8) + bx / 8 : bx;
    int gw = vcu * NWAVES + wave; int NGW = G * NWAVES;
    PtrTab TB = (PtrTab)(lds + TAB_OFF);
    if (tid == 0) {
#pragma unroll
        for (int i = 0; i < 31; ++i) TB[i] = (unsigned long long)args.in[i];
    }
    if (tid == 1) { TB[40] = 0ull; }
    __syncthreads();
    (void)xcd_barrier_post((unsigned*)(args.ws + WS_BAR), (volatile LAS unsigned*)(lds + TAB_OFF + 320));
    grid.sync();
    unsigned char* ws = args.ws;
    float* X = args.out;
    float* SS = (float*)(ws + WS_SSP);
    bf16* XB = (bf16*)(ws + WS_XB);
    bf16* HB = (bf16*)(ws + WS_H);
    constexpr float C2X = 0.0625f * 1.4426950408889634f;
#define GSYNC() do { asm volatile("s_waitcnt vmcnt(0) lgkmcnt(0)" ::: "memory"); { XcdBarrier xb_; xb_.bar = (unsigned*)(ws + WS_BAR); xb_.x = xb_xcc_id(); xb_.st = (volatile LAS unsigned*)(lds + TAB_OFF + 320); xcd_barrier(xb_); } tid = threadIdx.x; asm volatile("" : "+v"(tid)); lane = tid & 63; wave = __builtin_amdgcn_readfirstlane(tid >> 6); G = gridDim.x; bx = blockIdx.x; asm volatile("" : "+s"(G), "+s"(bx)); vcu = (G % 8 == 0) ? (bx % 8) * (G / 8) + bx / 8 : bx; gw = vcu * NWAVES + wave; NGW = G * NWAVES; { unsigned long long wsi_ = (unsigned long long)ws; asm volatile("" : "+s"(wsi_)); ws = (unsigned char*)(GAS unsigned char*)wsi_; } } while (0)

    for (int l = 0; l < DEPTH; ++l) {
        float* ss0 = SS + (size_t)(4 * l + 0) * M * 4; float* ss1 = SS + (size_t)(4 * l + 1) * M * 4; float* ss2 = SS + (size_t)(4 * l + 2) * M * 4; float* ss3 = SS + (size_t)(4 * l + 3) * M * 4; float* ss4 = SS + (size_t)(4 * l + 4) * M * 4;
        phase_prologue(TB, ws, X, l, lds, gw, NGW, lane, wave);
        GSYNC();
        { pg8::Gemm g{XB, (const bf16*)(ws + WS_W1IN), M, 2 * DFF, D, D, D, 0}; pg8::StaticOrder S; S.init(M, 2 * DFF, G, bx);
          pg8::EpiSwiglu E{HB, ss0, DFF};
          pg8::gemm_phase<pg8::EpiSwiglu, pg8::StaticOrder, true, true>(lds, g, S, E); }
        if (bx >= G / 2) { pg8::Gemm g{(const bf16*)(ws + WS_MEMN), (const bf16*)(ws + WS_WXKV), 512, 2 * D, D, D, D, 0}; pg8::StaticOrder S; S.init(512, 2 * D, G, bx - G / 2);
          pg8::EpiKV E{(bf16*)(ws + WS_KX), (bf16*)(ws + WS_VT)};
          pg8::gemm_phase<pg8::EpiKV, pg8::StaticOrder, true, true>(lds, g, S, E); }
        GSYNC();
        { pg8::Gemm g{HB, (const bf16*)(ws + WS_W1OUT), M, D, DFF, DFF, DFF, 0}; pg8::StaticOrder S; S.init(M, D, G, bx); pg8::Unit u_;
          pg8::EpiResid E{X, XB, ss1, 0.5f};
          for (int i_ = 0; S.next(i_, u_); ++i_) { const pg8::OneUnit O1{u_.pm, u_.pn}; pg8::gemm_phase<pg8::EpiResid, pg8::OneUnit, false, true>(lds, g, O1, E); } }
        GSYNC();
        { pg8::Gemm g{XB, (const bf16*)(ws + WS_WIN), M, 4096, D, D, D, 0}; pg8::StaticOrder S; S.init(M, 4096, G, bx);
          pg8::EpiWin E{(bf16*)(ws + WS_XA), (bf16*)(ws + WS_XL), (bf16*)(ws + WS_GG), (bf16*)(ws + WS_Q), (bf16*)(ws + WS_K), (bf16*)(ws + WS_V), ss1, FOX_C2};
          pg8::gemm_phase<pg8::EpiWin, pg8::StaticOrder, true, true>(lds, g, S, E); }
        phase_fl(XB, (const float*)(ws + WS_WFL), tab_in(TB, 7) + l * 8, ss1, (float*)(ws + WS_LOGF), gw, NGW, lane);
        GSYNC();
        if (vcu < 16) cumsum_bh((const float*)(ws + WS_LOGF), (float*)(ws + WS_CTIL), vcu, (LAS float*)lds);
        for (int it = vcu; it < 512; it += G)
            lru_item<false>(lds, it >> 8, (it >> 6) & 3, it & 63, (const bf16*)(ws + WS_XL), (bf16*)(ws + WS_GG), tab_in(TB, 12) + (size_t)l * 4 * D, tab_in(TB, 13) + l * D, (const bf16*)(ws + WS_WAT), (const bf16*)(ws + WS_WXT),
                            tab_in(TB, 15) + l * D, tab_in(TB, 17) + l * D, tab_in(TB, 18) + l * D, (float*)(ws + WS_SUMM));
        phase_pool((const bf16*)(ws + WS_XA), (bf16*)(ws + WS_YA), vcu * NTHR + tid, G * NTHR);
        phase_kmax((const bf16*)(ws + WS_K), (float*)(ws + WS_KPART), gw, NGW, lane);
        GSYNC();
        for (int it = vcu; it < 512; it += G)
            lru_item<true>(lds, it >> 8, (it >> 6) & 3, (it & 256) ? 63 - (it & 63) : (it & 63),
                            (const bf16*)(ws + WS_XL), (bf16*)(ws + WS_GG), tab_in(TB, 12) + (size_t)l * 4 * D, tab_in(TB, 13) + l * D, (const bf16*)(ws + WS_WAT), (const bf16*)(ws + WS_WXT),
                           tab_in(TB, 15) + l * D, tab_in(TB, 17) + l * D, tab_in(TB, 18) + l * D, (float*)(ws + WS_SUMM));
        for (int p = vcu; p < 256; p += G) {
            { const int bh = p & 15, qb = 31 - (p >> 4);
              fox_unit(lds, bh >> 3, bh & 7, qb, (const bf16*)(ws + WS_Q), (const bf16*)(ws + WS_K), (const bf16*)(ws + WS_V), (bf16*)(ws + WS_YC), (const float*)(ws + WS_CTIL) + (size_t)bh * SEQ, (const float*)(ws + WS_KPART), NGW); }
            { const int bh = 15 - (p & 15), qb = p >> 4;
              fox_unit(lds, bh >> 3, bh & 7, qb, (const bf16*)(ws + WS_Q), (const bf16*)(ws + WS_K), (const bf16*)(ws + WS_V), (bf16*)(ws + WS_YC), (const float*)(ws + WS_CTIL) + (size_t)bh * SEQ, (const float*)(ws + WS_KPART), NGW); } }
        GSYNC();
        { pg8::StaticOrder S; S.init(M, D, G, bx); pg8::Unit u;
          bf16* stash = (bf16*)(ws + WS_STASH) + (size_t)bx * 65536; bf16* mg = (bf16*)(ws + WS_MG);
          for (int i = 0; S.next(i, u); ++i) { const pg8::OneUnit O1{u.pm, u.pn};
#pragma unroll 1
              for (int br = 0; br < 3; ++br) {
                  { pg8::Gemm g{XB, (const bf16*)(ws + WS_WG) + (size_t)br * D * D, M, D, D, D, D, 0}; pg8::EpiGate E{stash, tab_in(TB, 8) + (size_t)l * 3 * D + br * D, ss1};
                    pg8::gemm_phase<pg8::EpiGate, pg8::OneUnit, true, true>(lds, g, O1, E); }
                  asm volatile("s_waitcnt vmcnt(0)" ::: "memory"); __syncthreads();
                  const bf16* Ab = br == 0 ? (const bf16*)(ws + WS_YA) : br == 1 ? (const bf16*)(ws + WS_GG) : (const bf16*)(ws + WS_YC);
                  const bf16* Ub = br == 0 ? (const bf16*)(ws + WS_UA) : br == 1 ? (const bf16*)(ws + WS_UB) : (const bf16*)(ws + WS_UC);
                  const int Kb = br == 1 ? 1024 : 512;
                  { pg8::Gemm g{Ab, Ub, M, D, Kb, Kb, Kb, 0}; pg8::EpiMerge E{stash, mg, br == 0 ? 1 : 0};
                    pg8::gemm_phase<pg8::EpiMerge, pg8::OneUnit, true, true>(lds, g, O1, E); }
                  asm volatile("s_waitcnt vmcnt(0)" ::: "memory"); __syncthreads();
              } } }
        GSYNC();
        { pg8::Gemm g{(const bf16*)(ws + WS_MG), (const bf16*)(ws + WS_WO), M, D, D, D, D, 0}; pg8::StaticOrder S; S.init(M, D, G, bx); pg8::Unit u_;
          pg8::EpiResid E{X, XB, ss2, 1.0f};
          for (int i_ = 0; S.next(i_, u_); ++i_) { const pg8::OneUnit O1{u_.pm, u_.pn}; pg8::gemm_phase<pg8::EpiResid, pg8::OneUnit, false, true>(lds, g, O1, E); } }
        GSYNC();
        { bf16* pb = (bf16*)(ws + WS_PBUF) + (size_t)bx * 65536; const pg8::OneUnit O1{0, 0};
          for (int uid = vcu; uid < 256; uid += G) { const int rt = uid >> 2, h = uid & 3, b = rt >> 5;
              int KX = 256; asm volatile("" : "+s"(KX));
              bf16* qo = (bf16*)(ws + WS_QX) + (size_t)rt * 256 * D + h * 256; bf16* qs = (bf16*)(ws + WS_Q) + (size_t)bx * 65536;
              { pg8::Gemm g{XB + (size_t)rt * 256 * D, (const bf16*)(ws + WS_WXQ) + (size_t)h * 256 * D, 256, 256, D, D, D, 0}; pg8::EpiRs E{qs, 256, ss2 + (size_t)rt * 256 * 4, C2X};
                pg8::gemm_phase<pg8::EpiRs, pg8::OneUnit, true, true>(lds, g, O1, E); }
              asm volatile("s_waitcnt vmcnt(0)" ::: "memory"); __syncthreads();
              { pg8::Gemm g{qs, (const bf16*)(ws + WS_KX) + (size_t)b * 256 * D + h * 256, 256, 256, KX, 256, D, 0}; pg8::EpiSoftmaxP E{pb};
                pg8::gemm_phase<pg8::EpiSoftmaxP, pg8::OneUnit, false, true>(lds, g, O1, E); }
              asm volatile("s_waitcnt vmcnt(0)" ::: "memory"); __syncthreads();
              { pg8::Gemm g{pb, (const bf16*)(ws + WS_VT) + (size_t)(b * 4 + h) * 65536, 256, 256, KX, 256, 256, 0}; pg8::EpiRs E{qo, D, nullptr, 1.0f};
                pg8::gemm_phase<pg8::EpiRs, pg8::OneUnit, true, true>(lds, g, O1, E); }
              asm volatile("s_waitcnt vmcnt(0)" ::: "memory"); if (uid + G < 256) __builtin_amdgcn_fence(__ATOMIC_ACQUIRE, "agent"); __syncthreads();
          } }
        GSYNC();
        { pg8::Gemm g{(const bf16*)(ws + WS_QX), (const bf16*)(ws + WS_WXO), M, D, D, D, D, 0}; pg8::StaticOrder S; S.init(M, D, G, bx); pg8::Unit u_;
          pg8::EpiResid E{X, XB, ss3, 1.0f};
          for (int i_ = 0; S.next(i_, u_); ++i_) { const pg8::OneUnit O1{u_.pm, u_.pn}; pg8::gemm_phase<pg8::EpiResid, pg8::OneUnit, false, true>(lds, g, O1, E); } }
        GSYNC();
        { pg8::Gemm g{XB, (const bf16*)(ws + WS_W2IN), M, 2 * DFF, D, D, D, 0}; pg8::StaticOrder S; S.init(M, 2 * DFF, G, bx);
          pg8::EpiSwiglu E{HB, ss3, DFF};
          pg8::gemm_phase<pg8::EpiSwiglu, pg8::StaticOrder, true, true>(lds, g, S, E); }
        GSYNC();
        { pg8::Gemm g{HB, (const bf16*)(ws + WS_W2OUT), M, D, DFF, DFF, DFF, 0}; pg8::StaticOrder S; S.init(M, D, G, bx); pg8::Unit u_;
          pg8::EpiResid E{X, XB, ss4, 0.5f};
          for (int i_ = 0; S.next(i_, u_); ++i_) { const pg8::OneUnit O1{u_.pm, u_.pn}; pg8::gemm_phase<pg8::EpiResid, pg8::OneUnit, false, true>(lds, g, O1, E); } }
        GSYNC();
    }
    phase_final(X, tab_in(TB, 30), gw, NGW, lane);
#undef GSYNC
}

extern "C" void kernel_launch(void* const* d_in, const int* in_sizes, int n_in, void* d_out, int out_size, void* d_ws, size_t ws_size, hipStream_t stream) {
    static int grid = 0;
    if (grid == 0) {
        if (n_in != 31 || out_size != M * D || ws_size < WS_END) { fprintf(stderr, "kernel_launch: unexpected problem (n_in %d, out %d, ws %zu)\n", n_in, out_size, ws_size); grid = -1; return; }
        int dev = 0, cus = 0, per_cu = 0;
        (void)hipGetDevice(&dev); (void)hipDeviceGetAttribute(&cus, hipDeviceAttributeMultiprocessorCount, dev);
        if (hipFuncSetAttribute((const void*)hybrid_fwd, hipFuncAttributeMaxDynamicSharedMemorySize, LDS_BYTES) != hipSuccess) { fprintf(stderr, "kernel_launch: hipFuncSetAttribute failed\n"); grid = -1; return; }
        if (hipOccupancyMaxActiveBlocksPerMultiprocessor(&per_cu, (const void*)hybrid_fwd, NTHR, LDS_BYTES) != hipSuccess || per_cu < 1) per_cu = 1;
        (void)hipGetLastError();
        grid = cus * (per_cu > 1 ? 1 : per_cu);
        if (grid > 256) grid = 256;
    }
    if (grid < 0) return;
    (void)hipMemsetAsync((char*)d_ws + WS_SS, 0, CTL_ZERO_BYTES, stream);
    Args a{};
    for (int i = 0; i < 31; ++i) a.in[i] = (const float*)d_in[i];
    a.out = (float*)d_out; a.ws = (unsigned char*)d_ws;
    void* kargs[] = {&a};
    hipError_t e = hipLaunchCooperativeKernel((const void*)hybrid_fwd, dim3(grid), dim3(NTHR), kargs, LDS_BYTES, stream);
    if (e != hipSuccess) fprintf(stderr, "cooperative launch failed: %s (grid %d)\n", hipGetErrorString(e), grid);
}
```

```cpp
#include <hip/hip_runtime.h>
#include <hip/hip_cooperative_groups.h>
#include <cstdio>
#include <cstdint>
namespace cg = cooperative_groups;
namespace pg8 {
#define PG8_LAS __attribute__((address_space(3)))
typedef unsigned short bf16_t;
typedef short bf16x8 __attribute__((ext_vector_type(8)));
typedef float f32x4 __attribute__((ext_vector_type(4)));
typedef unsigned u32x4 __attribute__((ext_vector_type(4)));
constexpr int BM = 256, BK = 64, HALF = 128, HTB = HALF * BK * 2  , STAGE_BYTES = 8 * HTB, NXCD = 8, WGM = 8;

__host__ __device__ __forceinline__ int lds_byte(int r, int c) { const int st = (r >> 4) * 2 + (c >> 5), rr = r & 15, cc = c & 31, ob = rr * 64 + cc * 2; return st * 1024 + (ob ^ (((ob >> 9) & 1) << 5)); }
__host__ __device__ __forceinline__ void stage_rc(int b, int& R, int& C) { const int st = b / 1024, sb = b % 1024, swz = sb ^ (((sb >> 9) & 1) << 5); R = (st >> 1) * 16 + swz / 64; C = (st & 1) * 32 + (swz % 64) / 2; }
__host__ __device__ __forceinline__ int perm32(int rho) { const int n = rho >> 4, i = rho & 15; return 8 * (i >> 2) + 4 * n + (i & 3); }

struct Unit { int pm, pn; };
struct Gemm { const bf16_t* A; const bf16_t* Bt; int M, N, K, lda, ldb, a_pn_off; };

struct StaticOrder {
    int nM, nN, nwg, G, c;
    __host__ __device__ __forceinline__ void init(int M, int N, int G_, int c_) { nM = M / BM; nN = N / BM; nwg = nM * nN; G = G_; c = c_; }
    __host__ __device__ __forceinline__ bool next(int i, Unit& u) const {
        const long L = (long)i * G + c; if (L >= nwg) return false;
        int wgid = (int)L; { const int q = nwg / NXCD, r = nwg % NXCD, xcd = wgid % NXCD, off = wgid / NXCD; wgid = (xcd < r ? xcd * (q + 1) : r * (q + 1) + (xcd - r) * q) + off; }
        const int nig = WGM * nN, gid = wgid / nig, fm = gid * WGM, gsz = (nM - fm) < WGM ? (nM - fm) : WGM;
        u.pm = fm + ((wgid % nig) % gsz); u.pn = (wgid % nig) / gsz; return true;
    }
    __device__ __forceinline__ void a_ready(const Unit&) const {}
    __device__ __forceinline__ void done(const Unit&) const {}
};

__device__ __forceinline__ unsigned cvt_pk_bf16(float lo, float hi) { unsigned r; asm volatile("v_cvt_pk_bf16_f32 %0, %1, %2" : "=v"(r) : "v"(lo), "v"(hi)); return r; }
__device__ __forceinline__ float bperm(float v, int srclane) { return __int_as_float(__builtin_amdgcn_ds_bpermute(srclane << 2, __float_as_int(v))); }
typedef float f32x2 __attribute__((ext_vector_type(2)));
typedef unsigned u32x2 __attribute__((ext_vector_type(2)));
__device__ __forceinline__ float fsig(float v) { return __builtin_amdgcn_rcpf(1.f + __expf(-v)); }
__device__ __forceinline__ float fsilu(float v) { return v * fsig(v); }
__device__ __forceinline__ float fgelu_tanh(float v) { return v * fsig(1.5957691216057308f * (v + 0.044715f * v * v * v)); }
__device__ __forceinline__ float bf_lo(unsigned w) { return __uint_as_float(w << 16); }
__device__ __forceinline__ float bf_hi(unsigned w) { return __uint_as_float(w & 0xffff0000u); }
__device__ __forceinline__ float rstd_of(const float* ss, int row) { const f32x4 a = *(const f32x4*)(ss + (size_t)row * 4); return rsqrtf(((a[0] + a[1]) + (a[2] + a[3])) * (1.0f / 1024.0f) + 1e-6f); }
__device__ __forceinline__ u32x4 pack8(const f32x4 v0, const f32x4 v1) { u32x4 w; w.x = cvt_pk_bf16(v0[0], v0[1]); w.y = cvt_pk_bf16(v0[2], v0[3]); w.z = cvt_pk_bf16(v1[0], v1[1]); w.w = cvt_pk_bf16(v1[2], v1[3]); return w; }

__device__ __forceinline__ void rstd8(const float* ss, int row0, float sc, float (&rs)[2][4]) {
    f32x4 pa[2][4];
#pragma unroll
    for (int ai = 0; ai < 2; ++ai)
#pragma unroll
        for (int m = 0; m < 4; ++m) pa[ai][m] = *(const f32x4*)(ss + (size_t)(row0 + ai * HALF + m * 16) * 4);
#pragma unroll
    for (int ai = 0; ai < 2; ++ai)
#pragma unroll
        for (int m = 0; m < 4; ++m) { const f32x4 a = pa[ai][m]; rs[ai][m] = rsqrtf(((a[0] + a[1]) + (a[2] + a[3])) * (1.0f / 1024.0f) + 1e-6f) * sc; }
    __builtin_amdgcn_sched_barrier(0);
}

__device__ __forceinline__ u32x4 ld16_sc1(const void* p) { u32x4 v; asm volatile("global_load_dwordx4 %0, %1, off sc1" : "=v"(v) : "v"(p) : "memory"); return v; }
#define PG8_LDWAIT(v) asm volatile("s_waitcnt vmcnt(0)" : "+v"(v))

struct OneUnit { int pm, pn;
    __device__ __forceinline__ bool next(int i, Unit& u) const { if (i) return false; u.pm = pm; u.pn = pn; return true; }
    __device__ __forceinline__ void a_ready(const Unit&) const {}
    __device__ __forceinline__ void done(const Unit&) const {} };

struct EpiSwiglu { static constexpr bool PERM = true, AFTER_DRAIN = false; bf16_t* H; const float* ss; int ldh;
    __device__ __forceinline__ void operator()(const f32x4 (&acc)[2][2][4][2], const Unit& u, int wr, int wc, int fr, int fq) const {
        const int row0 = u.pm * BM + wr * 64 + fr, col0 = u.pn * HALF + wc * 32 + 8 * fq; float rsv[2][4]; rstd8(ss, row0, 1.f, rsv);
#pragma unroll
        for (int ai = 0; ai < 2; ++ai)
#pragma unroll
            for (int m = 0; m < 4; ++m) { const int row = row0 + ai * HALF + m * 16; const float rs = rsv[ai][m];
                f32x4 o0, o1;
#pragma unroll
                for (int i = 0; i < 4; ++i) { o0[i] = fsilu(acc[ai][0][m][0][i] * rs) * (acc[ai][1][m][0][i] * rs); o1[i] = fsilu(acc[ai][0][m][1][i] * rs) * (acc[ai][1][m][1][i] * rs); }
                *(u32x4*)(H + (size_t)row * ldh + col0) = pack8(o0, o1); __builtin_amdgcn_sched_barrier(0); }
    }
};
struct EpiResid { static constexpr bool PERM = false, AFTER_DRAIN = true; float* x; bf16_t* xb; float* ss; float scale;
    __device__ __forceinline__ void fused(f32x4 (&acc)[2][2][4][2], const Unit& u, int wr, int wc, int fr, int fq, PG8_LAS unsigned char* lds, int wid, int lane) const {
        float scl = scale; asm volatile("" : "+v"(scl)); const int row0 = u.pm * BM + wr * 64 + fr, col0 = u.pn * BM + wc * 32 + 4 * fq;
        PG8_LAS float* P = (PG8_LAS float*)lds;
#pragma unroll
        for (int ai = 0; ai < 2; ++ai) { f32x4 xv[4][2][2];
#pragma unroll
            for (int m = 0; m < 4; ++m)
#pragma unroll
                for (int bj = 0; bj < 2; ++bj)
#pragma unroll
                    for (int n = 0; n < 2; ++n) xv[m][bj][n] = *(const f32x4*)(x + (size_t)(row0 + ai * HALF + m * 16) * 1024 + col0 + bj * HALF + n * 16);
            __builtin_amdgcn_sched_barrier(0);
#pragma unroll
            for (int m = 0; m < 4; ++m) { const int row = row0 + ai * HALF + m * 16; float q = 0.f;
#pragma unroll
                for (int bj = 0; bj < 2; ++bj)
#pragma unroll
                    for (int n = 0; n < 2; ++n) { const size_t off = (size_t)row * 1024 + col0 + bj * HALF + n * 16;
                        f32x4 v = xv[m][bj][n] + acc[ai][bj][m][n] * scl; *(f32x4*)(x + off) = v;
                        u32x2 w; w.x = cvt_pk_bf16(v[0], v[1]); w.y = cvt_pk_bf16(v[2], v[3]); *(u32x2*)(xb + off) = w;
                        q += (v[0] * v[0] + v[1] * v[1]) + (v[2] * v[2] + v[3] * v[3]); }
                q += bperm(q, (fr + 16 * fq) ^ 16); q += bperm(q, (fr + 16 * fq) ^ 32);
                if (fq == 0) P[(ai * HALF + wr * 64 + m * 16 + fr) * 4 + wc] = q; }
            __builtin_amdgcn_sched_barrier(0); }
        asm volatile("s_waitcnt lgkmcnt(0)" ::: "memory"); __builtin_amdgcn_s_barrier(); asm volatile("" ::: "memory");
        const int tl = wid * 64 + lane;
        if (tl < 256) { const f32x4 a = *(const PG8_LAS f32x4*)(P + tl * 4); ss[(size_t)(u.pm * BM + tl) * 4 + u.pn] = (a[0] + a[1]) + (a[2] + a[3]); }
        asm volatile("s_waitcnt lgkmcnt(0)" ::: "memory"); __builtin_amdgcn_s_barrier(); asm volatile("" ::: "memory");
    }
};
struct EpiRs { static constexpr bool PERM = true, AFTER_DRAIN = false; bf16_t* O; int ldc; const float* ss; float sc;
    __device__ __forceinline__ void operator()(const f32x4 (&acc)[2][2][4][2], const Unit& u, int wr, int wc, int fr, int fq) const {
        const int row0 = u.pm * BM + wr * 64 + fr, col0 = u.pn * BM + wc * 32 + 8 * fq; float rsv[2][4];
        if (ss) rstd8(ss, row0, sc, rsv); else {
#pragma unroll
            for (int a = 0; a < 2; ++a)
#pragma unroll
                for (int b = 0; b < 4; ++b) rsv[a][b] = sc; }
#pragma unroll
        for (int ai = 0; ai < 2; ++ai)
#pragma unroll
            for (int m = 0; m < 4; ++m) { const int row = row0 + ai * HALF + m * 16; const float rs = rsv[ai][m];
#pragma unroll
                for (int bj = 0; bj < 2; ++bj) *(u32x4*)(O + (size_t)row * ldc + col0 + bj * HALF) = pack8(acc[ai][bj][m][0] * rs, acc[ai][bj][m][1] * rs); }
    }
};
struct EpiWin { static constexpr bool PERM = true, AFTER_DRAIN = false; bf16_t *xa, *xl, *gg, *q, *k, *v; const float* ss; float qscale;
    __device__ __forceinline__ void operator()(const f32x4 (&acc)[2][2][4][2], const Unit& u, int wr, int wc, int fr, int fq) const {
        const int pn = u.pn; bf16_t* dst; int ld, ct; float sc = 1.f; bool act = false;
        if (pn < 2) { dst = xa; ld = 512; ct = pn; } else if (pn < 6) { dst = xl; ld = 1024; ct = pn - 2; } else if (pn < 10) { dst = gg; ld = 1024; ct = pn - 6; act = true; }
        else if (pn < 12) { dst = q; ld = 512; ct = pn - 10; sc = qscale; } else if (pn < 14) { dst = k; ld = 512; ct = pn - 12; } else { dst = v; ld = 512; ct = pn - 14; }
        const int row0 = u.pm * BM + wr * 64 + fr, col0 = ct * BM + wc * 32 + 8 * fq; float rsv[2][4]; rstd8(ss, row0, sc, rsv);
#pragma unroll
        for (int ai = 0; ai < 2; ++ai)
#pragma unroll
            for (int m = 0; m < 4; ++m) { const int row = row0 + ai * HALF + m * 16; const float rs = rsv[ai][m];
#pragma unroll
                for (int bj = 0; bj < 2; ++bj) { f32x4 v0 = acc[ai][bj][m][0] * rs, v1 = acc[ai][bj][m][1] * rs;
                    if (act) {
#pragma unroll
                        for (int i = 0; i < 4; ++i) { v0[i] = fgelu_tanh(v0[i]); v1[i] = fgelu_tanh(v1[i]); } }
                    *(u32x4*)(dst + (size_t)row * ld + col0 + bj * HALF) = pack8(v0, v1); __builtin_amdgcn_sched_barrier(0); } }
    }
};
struct EpiGate { static constexpr bool PERM = true, AFTER_DRAIN = false; bf16_t* stash; const float* bg; const float* ss;
    __device__ __forceinline__ void operator()(const f32x4 (&acc)[2][2][4][2], const Unit& u, int wr, int wc, int fr, int fq) const {
        const int row0 = u.pm * BM + wr * 64 + fr, col0 = u.pn * BM + wc * 32 + 8 * fq; int tid_o = threadIdx.x; asm volatile("" : "+v"(tid_o)); const int tid = tid_o;
        f32x4 bv[2][2];
#pragma unroll
        for (int bj = 0; bj < 2; ++bj)
#pragma unroll
            for (int n = 0; n < 2; ++n) bv[bj][n] = *(const f32x4*)(bg + col0 + bj * HALF + 4 * n);
        float rsv[2][4]; rstd8(ss, row0, 1.f, rsv);
#pragma unroll
        for (int ai = 0; ai < 2; ++ai)
#pragma unroll
            for (int m = 0; m < 4; ++m) { const float rs = rsv[ai][m];
#pragma unroll
                for (int bj = 0; bj < 2; ++bj) { f32x4 v0 = acc[ai][bj][m][0] * rs + bv[bj][0], v1 = acc[ai][bj][m][1] * rs + bv[bj][1];
#pragma unroll
                    for (int i = 0; i < 4; ++i) { v0[i] = fsig(v0[i]); v1[i] = fsig(v1[i]); }
                    *(u32x4*)(stash + ((size_t)((ai * 4 + m) * 2 + bj) * 512 + tid) * 8) = pack8(v0, v1); __builtin_amdgcn_sched_barrier(0); } }
    }
};
struct EpiMerge { static constexpr bool PERM = true, AFTER_DRAIN = false; const bf16_t* stash; bf16_t* mg; int first;
    __device__ __forceinline__ void operator()(const f32x4 (&acc)[2][2][4][2], const Unit& u, int wr, int wc, int fr, int fq) const {
        const int row0 = u.pm * BM + wr * 64 + fr, col0 = u.pn * BM + wc * 32 + 8 * fq; int tid_o = threadIdx.x; asm volatile("" : "+v"(tid_o)); const int tid = tid_o;
#pragma unroll
        for (int ai = 0; ai < 2; ++ai) { u32x4 gw[4][2], ow[4][2];
#pragma unroll
            for (int m = 0; m < 4; ++m)
#pragma unroll
                for (int bj = 0; bj < 2; ++bj) { gw[m][bj] = ld16_sc1(stash + ((size_t)((ai * 4 + m) * 2 + bj) * 512 + tid) * 8);
                    ow[m][bj] = first ? (u32x4){0u, 0u, 0u, 0u} : ld16_sc1(mg + (size_t)(row0 + ai * HALF + m * 16) * 1024 + col0 + bj * HALF); }
#pragma unroll
            for (int m = 0; m < 4; ++m)
#pragma unroll
                for (int bj = 0; bj < 2; ++bj) { PG8_LDWAIT(gw[m][bj]); if (!first) PG8_LDWAIT(ow[m][bj]); }
            __builtin_amdgcn_sched_barrier(0);
#pragma unroll
            for (int m = 0; m < 4; ++m)
#pragma unroll
                for (int bj = 0; bj < 2; ++bj) { const u32x4 g = gw[m][bj], o = ow[m][bj]; f32x4 v0 = acc[ai][bj][m][0], v1 = acc[ai][bj][m][1];
                    v0[0] = v0[0] * bf_lo(g.x) + bf_lo(o.x); v0[1] = v0[1] * bf_hi(g.x) + bf_hi(o.x); v0[2] = v0[2] * bf_lo(g.y) + bf_lo(o.y); v0[3] = v0[3] * bf_hi(g.y) + bf_hi(o.y);
                    v1[0] = v1[0] * bf_lo(g.z) + bf_lo(o.z); v1[1] = v1[1] * bf_hi(g.z) + bf_hi(o.z); v1[2] = v1[2] * bf_lo(g.w) + bf_lo(o.w); v1[3] = v1[3] * bf_hi(g.w) + bf_hi(o.w);
                    *(u32x4*)(mg + (size_t)(row0 + ai * HALF + m * 16) * 1024 + col0 + bj * HALF) = pack8(v0, v1); }
            __builtin_amdgcn_sched_barrier(0); }
    }
};
struct EpiKV { static constexpr bool PERM = true, AFTER_DRAIN = false; bf16_t* kx; bf16_t* vt;
    __device__ __forceinline__ void operator()(const f32x4 (&acc)[2][2][4][2], const Unit& u, int wr, int wc, int fr, int fq) const {
        if (u.pn < 4) { const int row0 = u.pm * BM + wr * 64 + fr, col0 = u.pn * BM + wc * 32 + 8 * fq;
#pragma unroll
            for (int ai = 0; ai < 2; ++ai)
#pragma unroll
                for (int m = 0; m < 4; ++m)
#pragma unroll
                    for (int bj = 0; bj < 2; ++bj) *(u32x4*)(kx + (size_t)(row0 + ai * HALF + m * 16) * 1024 + col0 + bj * HALF) = pack8(acc[ai][bj][m][0], acc[ai][bj][m][1]);
        } else { const int h = u.pn - 4, b = u.pm; bf16_t* base = vt + (size_t)(b * 4 + h) * 65536;
#pragma unroll
            for (int ai = 0; ai < 2; ++ai)
#pragma unroll
                for (int m = 0; m < 4; ++m) { const int mr = ai * HALF + wr * 64 + m * 16 + fr;
#pragma unroll
                    for (int bj = 0; bj < 2; ++bj) { bf16_t* p = base + (size_t)(bj * HALF + wc * 32 + 8 * fq) * 256 + mr; asm volatile("" : "+v"(p));
#pragma unroll
                        for (int n = 0; n < 2; ++n)
#pragma unroll
                            for (int i = 0; i < 4; ++i) p[(4 * n + i) * 256] = (bf16_t)(cvt_pk_bf16(acc[ai][bj][m][n][i], 0.f) & 0xffffu);
                        __builtin_amdgcn_sched_barrier(0); } }
        }
    }
};
struct EpiSoftmaxP { static constexpr bool PERM = true, AFTER_DRAIN = true; bf16_t* P;
    __device__ __forceinline__ void fused(f32x4 (&acc)[2][2][4][2], const Unit& u, int wr, int wc, int fr, int fq, PG8_LAS unsigned char* lds, int wid, int lane) const {
        PG8_LAS f32x2* X = (PG8_LAS f32x2*)lds;
        float mloc[2][4];
#pragma unroll
        for (int ai = 0; ai < 2; ++ai)
#pragma unroll
            for (int m = 0; m < 4; ++m) { float mx = -__builtin_inff();
#pragma unroll
                for (int bj = 0; bj < 2; ++bj)
#pragma unroll
                    for (int n = 0; n < 2; ++n) { const f32x4 v = acc[ai][bj][m][n]; mx = fmaxf(mx, fmaxf(fmaxf(v[0], v[1]), fmaxf(v[2], v[3]))); }
                mx = fmaxf(mx, bperm(mx, (fr + 16 * fq) ^ 16)); mx = fmaxf(mx, bperm(mx, (fr + 16 * fq) ^ 32)); float s = 0.f;
#pragma unroll
                for (int bj = 0; bj < 2; ++bj)
#pragma unroll
                    for (int n = 0; n < 2; ++n) { f32x4 v = acc[ai][bj][m][n];
#pragma unroll
                        for (int i = 0; i < 4; ++i) { v[i] = __builtin_amdgcn_exp2f(v[i] - mx); s += v[i]; }
                        acc[ai][bj][m][n] = v; }
                s += bperm(s, (fr + 16 * fq) ^ 16); s += bperm(s, (fr + 16 * fq) ^ 32); mloc[ai][m] = mx;
                if (fq == 0) X[(ai * HALF + wr * 64 + m * 16 + fr) * 4 + wc] = (f32x2){mx, s}; __builtin_amdgcn_sched_barrier(0); }
        asm volatile("s_waitcnt lgkmcnt(0)" ::: "memory"); __builtin_amdgcn_s_barrier(); asm volatile("" ::: "memory");
#pragma unroll
        for (int ai = 0; ai < 2; ++ai)
#pragma unroll
            for (int m = 0; m < 4; ++m) { const int rl = ai * HALF + wr * 64 + m * 16 + fr;
                const f32x2 a = X[rl * 4 + 0], b = X[rl * 4 + 1], c = X[rl * 4 + 2], d = X[rl * 4 + 3];
                const float M = fmaxf(fmaxf(a.x, b.x), fmaxf(c.x, d.x));
                const float L = a.y * __builtin_amdgcn_exp2f(a.x - M) + b.y * __builtin_amdgcn_exp2f(b.x - M) + c.y * __builtin_amdgcn_exp2f(c.x - M) + d.y * __builtin_amdgcn_exp2f(d.x - M);
                const float f = __builtin_amdgcn_exp2f(mloc[ai][m] - M) / L;
#pragma unroll
                for (int bj = 0; bj < 2; ++bj) *(u32x4*)(P + (size_t)rl * 256 + bj * HALF + wc * 32 + 8 * fq) = pack8(acc[ai][bj][m][0] * f, acc[ai][bj][m][1] * f); __builtin_amdgcn_sched_barrier(0); }
        asm volatile("s_waitcnt vmcnt(0) lgkmcnt(0)" ::: "memory"); __builtin_amdgcn_s_barrier(); asm volatile("" ::: "memory");
    }
};

template <class Epi, class Sched, bool ALIGN_EPI = false, bool SP2 = false>
__device__ __forceinline__ void gemm_phase(PG8_LAS unsigned char* lds, const Gemm g, const Sched& S, const Epi& E) {
    int tid_o = threadIdx.x; asm volatile("" : "+v"(tid_o));
    const int tid = tid_o, wid = __builtin_amdgcn_readfirstlane(tid >> 6), lane = tid & 63, wr = wid >> 2, wc = wid & 3, fr = lane & 15, fq = lane >> 4;
    const int K = g.K, nt = K / BK;
    unsigned voffA[2], voffB[2];
#pragma unroll
    for (int i = 0; i < 2; ++i) { int R, C; stage_rc(tid * 16 + i * 8192, R, C); const int Rb = Epi::PERM ? ((R & ~31) + perm32(R & 31)) : R;
        voffA[i] = (unsigned)(R * g.lda + C) * 2u; voffB[i] = (unsigned)(Rb * g.ldb + C) * 2u; }
    const size_t kstep = (size_t)(BK * 2);
    const size_t hstepA = (size_t)HALF * g.lda * 2, hstepB = (size_t)HALF * g.ldb * 2;
    const size_t tstepA = 2 * hstepA, tstepB = 2 * hstepB;
    const unsigned ldsw = (unsigned)wid * 1024u;
    const int aoff = lds_byte(wr * 64 + fr, fq * 8), boff = lds_byte(wc * 32 + fr, fq * 8);
#define PG8_SA(b, h) (((b) * 2 + (h)) * HTB)
#define PG8_SB(b, h) ((4 + (b) * 2 + (h)) * HTB)
#define PG8_STAGE(bufoff, gbase, voff) do { _Pragma("unroll") for (int _i = 0; _i < 2; ++_i) \
        __builtin_amdgcn_global_load_lds((const unsigned*)((const char*)(gbase) + (voff)[_i]), (PG8_LAS unsigned*)(lds + (bufoff) + ldsw + _i * 8192), 16, 0, 0); } while (0)
#define PG8_LDA(dst, b, h) do { _Pragma("unroll") for (int m = 0; m < 4; ++m) _Pragma("unroll") for (int k = 0; k < 2; ++k) dst[m][k] = *(const PG8_LAS bf16x8*)(lds + PG8_SA(b, h) + aoff + m * 2048 + k * 1024); } while (0)
#define PG8_LDB(dst, b, h) do { _Pragma("unroll") for (int n = 0; n < 2; ++n) _Pragma("unroll") for (int k = 0; k < 2; ++k) dst[n][k] = *(const PG8_LAS bf16x8*)(lds + PG8_SB(b, h) + boff + n * 2048 + k * 1024); } while (0)
#define PG8_MMA(ai, bj, At, Bt) do { __builtin_amdgcn_s_setprio(1); _Pragma("unroll") for (int m = 0; m < 4; ++m) _Pragma("unroll") for (int n = 0; n < 2; ++n) _Pragma("unroll") for (int k = 0; k < 2; ++k) \
        acc[ai][bj][m][n] = __builtin_amdgcn_mfma_f32_16x16x32_bf16(Bt[n][k], At[m][k], acc[ai][bj][m][n], 0, 0, 0); __builtin_amdgcn_s_setprio(0); } while (0)
#define PG8_WAIT_V(n) asm volatile("s_waitcnt vmcnt(" #n ")" ::: "memory")
#define PG8_WAIT_L(n) asm volatile("s_waitcnt lgkmcnt(" #n ")" ::: "memory")
#define PG8_BAR __builtin_amdgcn_s_barrier()
#define PG8_SCHED __builtin_amdgcn_sched_barrier(0)
    Unit cur, nxt; int ui = 0;
    if (!S.next(0, cur)) return;
    f32x4 acc[2][2][4][2];
#pragma unroll
    for (int a = 0; a < 2; ++a)
#pragma unroll
        for (int b = 0; b < 2; ++b)
#pragma unroll
            for (int m = 0; m < 4; ++m)
#pragma unroll
                for (int n = 0; n < 2; ++n) acc[a][b][m][n] = (f32x4){0.f, 0.f, 0.f, 0.f};
    bf16x8 At[4][2], B0[2][2], B1[2][2];
    const char* cA = (const char*)g.A + (size_t)cur.pm * tstepA + (size_t)cur.pn * g.a_pn_off * 2; const char* cB = (const char*)g.Bt + (size_t)cur.pn * tstepB;
    S.a_ready(cur);
    if constexpr (SP2) {
        PG8_STAGE(PG8_SB(0, 0), cB, voffB); PG8_STAGE(PG8_SB(0, 1), cB + hstepB, voffB); PG8_STAGE(PG8_SA(0, 0), cA, voffA); PG8_STAGE(PG8_SA(0, 1), cA + hstepA, voffA);
        if (wr == 1) PG8_BAR;
        PG8_WAIT_V(2); PG8_BAR;
        PG8_STAGE(PG8_SB(1, 0), cB + kstep, voffB); PG8_STAGE(PG8_SA(1, 0), cA + kstep, voffA); PG8_STAGE(PG8_SB(1, 1), cB + hstepB + kstep, voffB);
        PG8_WAIT_V(6); PG8_BAR;
    } else {
        PG8_STAGE(PG8_SB(0, 0), cB, voffB); PG8_STAGE(PG8_SA(0, 0), cA, voffA); PG8_STAGE(PG8_SB(0, 1), cB + hstepB, voffB); PG8_STAGE(PG8_SA(0, 1), cA + hstepA, voffA);
        if (wr == 1) PG8_BAR;
        PG8_WAIT_V(4); PG8_BAR;
        PG8_STAGE(PG8_SB(1, 0), cB + kstep, voffB); PG8_STAGE(PG8_SA(1, 0), cA + kstep, voffA); PG8_STAGE(PG8_SB(1, 1), cB + hstepB + kstep, voffB);
        PG8_WAIT_V(6); PG8_BAR;
    }
    for (;;) {
        const bool has_next = S.next(ui + 1, nxt);
        const char* nA = has_next ? (const char*)g.A + (size_t)nxt.pm * tstepA + (size_t)nxt.pn * g.a_pn_off * 2 : cA; const char* nB = has_next ? (const char*)g.Bt + (size_t)nxt.pn * tstepB : cB;
        for (int t = 0; t < nt; t += 2) {
            const bool last = (t == nt - 2);
            const char* a1 = cA + (size_t)(t + 1) * kstep;
            const char* a2 = last ? nA : cA + (size_t)(t + 2) * kstep; const char* b2 = last ? nB : cB + (size_t)(t + 2) * kstep;
            const char* a3 = a2 + kstep; const char* b3 = b2 + kstep;
            if (last && has_next) S.a_ready(nxt);
            if constexpr (SP2) {
            PG8_LDB(B0, 0, 0); PG8_LDB(B1, 0, 1); PG8_SCHED; PG8_LDA(At, 0, 0); PG8_STAGE(PG8_SA(1, 1), a1 + hstepA, voffA);
            PG8_WAIT_V(8); PG8_WAIT_L(0); PG8_BAR; PG8_MMA(0, 0, At, B0); PG8_MMA(0, 1, At, B1); PG8_BAR; PG8_SCHED;
            PG8_LDA(At, 0, 1); PG8_STAGE(PG8_SB(0, 0), b2, voffB); PG8_STAGE(PG8_SB(0, 1), b2 + hstepB, voffB); PG8_STAGE(PG8_SA(0, 0), a2, voffA);
            PG8_WAIT_V(8); PG8_WAIT_L(0); PG8_BAR; PG8_MMA(1, 0, At, B0); PG8_MMA(1, 1, At, B1); PG8_BAR; PG8_SCHED;
            PG8_LDB(B0, 1, 0); PG8_LDB(B1, 1, 1); PG8_SCHED; PG8_LDA(At, 1, 0); PG8_STAGE(PG8_SA(0, 1), a2 + hstepA, voffA);
            PG8_WAIT_V(8); PG8_WAIT_L(0); PG8_BAR; PG8_MMA(0, 0, At, B0); PG8_MMA(0, 1, At, B1); PG8_BAR; PG8_SCHED;
            PG8_LDA(At, 1, 1); PG8_STAGE(PG8_SB(1, 0), b3, voffB); PG8_STAGE(PG8_SB(1, 1), b3 + hstepB, voffB); PG8_STAGE(PG8_SA(1, 0), a3, voffA);
            PG8_WAIT_V(8); PG8_WAIT_L(0); PG8_BAR; PG8_MMA(1, 0, At, B0); PG8_MMA(1, 1, At, B1); PG8_BAR; PG8_SCHED;
            } else {
            PG8_LDB(B0, 0, 0); PG8_SCHED; PG8_LDA(At, 0, 0); PG8_STAGE(PG8_SA(1, 1), a1 + hstepA, voffA);
            PG8_WAIT_L(8); PG8_BAR; PG8_WAIT_L(0); PG8_MMA(0, 0, At, B0); PG8_BAR; PG8_SCHED;
            PG8_LDB(B1, 0, 1); PG8_STAGE(PG8_SB(0, 0), b2, voffB);
            PG8_BAR; PG8_WAIT_L(0); PG8_MMA(0, 1, At, B1); PG8_BAR;
            PG8_LDA(At, 0, 1); PG8_STAGE(PG8_SA(0, 0), a2, voffA);
            PG8_BAR; PG8_WAIT_L(0); PG8_MMA(1, 0, At, B0); PG8_BAR; PG8_SCHED;
            PG8_STAGE(PG8_SB(0, 1), b2 + hstepB, voffB);
            PG8_WAIT_V(6); PG8_BAR; PG8_MMA(1, 1, At, B1); PG8_BAR;
            PG8_LDB(B0, 1, 0); PG8_SCHED; PG8_LDA(At, 1, 0); PG8_STAGE(PG8_SA(0, 1), a2 + hstepA, voffA);
            PG8_WAIT_L(8); PG8_BAR; PG8_WAIT_L(0); PG8_MMA(0, 0, At, B0); PG8_BAR; PG8_SCHED;
            PG8_LDB(B1, 1, 1); PG8_STAGE(PG8_SB(1, 0), b3, voffB);
            PG8_BAR; PG8_WAIT_L(0); PG8_MMA(0, 1, At, B1); PG8_BAR;
            PG8_LDA(At, 1, 1); PG8_STAGE(PG8_SA(1, 0), a3, voffA);
            PG8_BAR; PG8_WAIT_L(0); PG8_MMA(1, 0, At, B0); PG8_BAR; PG8_SCHED;
            PG8_STAGE(PG8_SB(1, 1), b3 + hstepB, voffB);
            PG8_WAIT_V(6); PG8_BAR; PG8_MMA(1, 1, At, B1); PG8_BAR;
            }
        }
        if constexpr (ALIGN_EPI) { if (wr == 0) PG8_BAR; }
        if constexpr (!Epi::AFTER_DRAIN) { E(acc, cur, wr, wc, fr, fq); S.done(cur); }
        if (!has_next) break;
#pragma unroll
        for (int a = 0; a < 2; ++a)
#pragma unroll
            for (int b = 0; b < 2; ++b)
#pragma unroll
                for (int m = 0; m < 4; ++m)
#pragma unroll
                    for (int n = 0; n < 2; ++n) acc[a][b][m][n] = (f32x4){0.f, 0.f, 0.f, 0.f};
        cur = nxt; cA = nA; cB = nB; ++ui;
        if constexpr (ALIGN_EPI) { if (wr == 1) PG8_BAR; }
    }
    PG8_WAIT_V(0);
    if constexpr (!ALIGN_EPI) { if (wr == 0) PG8_BAR; }
    PG8_BAR;
    if constexpr (Epi::AFTER_DRAIN) { E.fused(acc, cur, wr, wc, fr, fq, lds, wid, lane); S.done(cur); }
#undef PG8_SA
#undef PG8_SB
#undef PG8_STAGE
#undef PG8_LDA
#undef PG8_LDB
#undef PG8_MMA
#undef PG8_WAIT_V
#undef PG8_WAIT_L
#undef PG8_BAR
#undef PG8_SCHED
}
}
#include <hip/hip_bf16.h>
#include <cmath>
#define GAS __attribute__((address_space(1)))
#define LAS __attribute__((address_space(3)))
typedef unsigned short bf16;
typedef unsigned v4u __attribute__((ext_vector_type(4)));
typedef float f32x4 __attribute__((ext_vector_type(4)));
typedef short bf16x8 __attribute__((ext_vector_type(8)));
typedef float f32x16 __attribute__((ext_vector_type(16)));

constexpr int NWAVES = 8, NTHR = 512;
constexpr int BATCH = 2, SEQ = 8192, D = 1024, M = BATCH * SEQ, DFF = 2816, DEPTH = 2;
constexpr int INW = 7176;
constexpr size_t MiB = 1u << 20;
constexpr size_t WS_SS = 0, CTL_ZERO_BYTES = 1 * MiB;
constexpr size_t WS_WFL = 1 * MiB;
constexpr size_t WS_WAT = 1 * MiB + 256 * 1024, WS_WXT = 1 * MiB + 512 * 1024;
constexpr size_t WS_SUMM = 2 * MiB;
constexpr size_t WS_LOGF = 3 * MiB, WS_CTIL = 3 * MiB + 512 * 1024;
constexpr size_t WS_KPART = 7 * MiB;
constexpr size_t WS_MEMN = 4 * MiB, WS_KX = 5 * MiB, WS_VT = 6 * MiB;
constexpr size_t WS_W1IN = 8 * MiB, WS_W1OUT = 19 * MiB, WS_WIN = 25 * MiB, WS_WG = 33 * MiB, WS_UA = 39 * MiB, WS_UB = 40 * MiB, WS_UC = 42 * MiB,
                 WS_WO = 43 * MiB, WS_WXQ = 45 * MiB, WS_WXKV = 47 * MiB, WS_WXO = 51 * MiB, WS_W2IN = 53 * MiB, WS_W2OUT = 64 * MiB;
constexpr size_t WS_XB = 70 * MiB;
constexpr size_t WS_Q = 102 * MiB, WS_GG = 118 * MiB, WS_XA = 150 * MiB, WS_XL = 166 * MiB, WS_K = 198 * MiB, WS_V = 214 * MiB;
constexpr size_t WS_H = 102 * MiB;
constexpr size_t WS_YC = 150 * MiB;
constexpr size_t WS_STASH = 166 * MiB, WS_MG = 198 * MiB, WS_QX = 150 * MiB, WS_PBUF = 198 * MiB;
constexpr size_t WS_YA = 230 * MiB, WS_SSP = 246 * MiB, WS_END = 255 * MiB;
constexpr int LDS_BYTES = 147456;

__device__ __forceinline__ unsigned f2bf(float f) { unsigned u = __builtin_bit_cast(unsigned, f); return (u + 0x7fffu + ((u >> 16) & 1u)) >> 16; }
__device__ __forceinline__ unsigned pk2(float lo, float hi) { return f2bf(lo) | (f2bf(hi) << 16); }
__device__ __forceinline__ float bf2f(unsigned short v) { return __uint_as_float((unsigned)v << 16); }
__device__ __forceinline__ float bperm(float v, int srclane) { return __int_as_float(__builtin_amdgcn_ds_bpermute(srclane << 2, __float_as_int(v))); }
__device__ __forceinline__ float wave_sum(float v, int lane) {
#pragma unroll
    for (int o = 1; o < 64; o <<= 1) v += bperm(v, lane ^ o);
    return v;
}
__device__ __forceinline__ float flog1p(float e) { return e < 0.01f ? e * (1.f - e * (0.5f - e * 0.33333334f)) : __logf(1.f + e); }
#define LDS_WAIT() asm volatile("s_waitcnt lgkmcnt(0)" ::: "memory")

__device__ __forceinline__ void tr_item(const float* W, int ldn, int col0, int k0, const float* g, bf16* WT, int ldk, int drow0, LAS float* scr, int lane) {
    const int n4 = (lane & 15) * 4, kr = lane >> 4;
#pragma unroll
    for (int i = 0; i < 16; ++i) { const int kk = 4 * i + kr; f32x4 v = *(const f32x4*)(W + (size_t)(k0 + kk) * ldn + col0 + n4); if (g) v = v * g[k0 + kk];
        LAS float* d = scr + kk * 65 + n4; d[0] = v.x; d[1] = v.y; d[2] = v.z; d[3] = v.w; }
    LDS_WAIT(); asm volatile("" ::: "memory");
    const int c = lane & 7;
#pragma unroll
    for (int j = 0; j < 8; ++j) { const int n = (lane >> 3) + 8 * j; const LAS float* s = scr + (8 * c) * 65 + n;
        v4u o; o.x = pk2(s[0 * 65], s[1 * 65]); o.y = pk2(s[2 * 65], s[3 * 65]); o.z = pk2(s[4 * 65], s[5 * 65]); o.w = pk2(s[6 * 65], s[7 * 65]);
        *(v4u*)(WT + (size_t)(drow0 + n) * ldk + k0 + 8 * c) = o; }
    LDS_WAIT(); asm volatile("" ::: "memory");
}

#define RLX_AGENT __ATOMIC_RELAXED, __HIP_MEMORY_SCOPE_AGENT
#define XB_TMO      128
#define XB_XCNT(j)  (256  + 64 * (j))
#define XB_XSUB(j)  (1280 + 64 * (j))
#define XB_XGEN(j)  (2304 + 64 * (j))
#define XB_TOP      3328
#define XB_TOPGEN   3392
#define XCD_BAR_WORDS 3456
#define XB_SPIN_CAP (1u << 18)

__device__ __forceinline__ unsigned xb_ld(unsigned* p)              { return __hip_atomic_load(p, __ATOMIC_RELAXED, __HIP_MEMORY_SCOPE_AGENT); }
__device__ __forceinline__ unsigned xb_add(unsigned* p, unsigned v) { return __hip_atomic_fetch_add(p, v, __ATOMIC_RELAXED, __HIP_MEMORY_SCOPE_AGENT); }
__device__ __forceinline__ unsigned xb_xcc_id() { return (unsigned)__builtin_amdgcn_s_getreg((3 << 11) | 20) & 0xFu; }
#define XB_SPIN(cond, bar) do { unsigned _sp = 0; while (cond) { __builtin_amdgcn_s_sleep(1); \
    if ((++_sp & 255u) == 0u) { if (xb_ld(&(bar)[XB_TMO])) break; if (_sp > XB_SPIN_CAP) { atomicAdd(&(bar)[XB_TMO], 1u); break; } } } } while (0)

struct XcdBarrier {
    unsigned* bar; unsigned x;
    volatile LAS unsigned* st;
};

__device__ __forceinline__ XcdBarrier xcd_barrier_post(unsigned* bar, volatile LAS unsigned* st) {
    XcdBarrier b; b.bar = bar; b.x = xb_xcc_id(); b.st = st;
    if (threadIdx.x == 0) (void)xb_add(&bar[XB_XCNT(b.x)], 1u);
    return b;
}
__device__ __forceinline__ void xcd_barrier_complete(unsigned* bar, unsigned x, unsigned& nloc, unsigned& nx) {
    const unsigned G = gridDim.x * gridDim.y * gridDim.z;
    unsigned sum, cnt, mine, sp = 0u;
    for (;;) {
        sum = 0u; cnt = 0u; mine = 0u;
#pragma unroll
        for (unsigned j = 0; j < 16; ++j) { const unsigned c = xb_ld(&bar[XB_XCNT(j)]); sum += c; cnt += (c > 0u) ? 1u : 0u; mine = (j == x) ? c : mine; }
        if (sum == G) break;
        __builtin_amdgcn_s_sleep(1);
        if ((++sp & 255u) == 0u) { if (xb_ld(&bar[XB_TMO])) break; if (sp > XB_SPIN_CAP) { atomicAdd(&bar[XB_TMO], 1u); break; } }
    }
    nloc = mine > 0u ? mine : 1u; nx = cnt > 0u ? cnt : 1u;
}

__device__ __forceinline__ void xcd_barrier(const XcdBarrier& b) {
    asm volatile("s_waitcnt vmcnt(0)" ::: "memory");
    __syncthreads();
    if (threadIdx.x == 0) {
        unsigned* bar = b.bar;
        __builtin_amdgcn_s_waitcnt(0);
        unsigned nloc = b.st[0], nx = b.st[1];
        if (nloc == 0u) { xcd_barrier_complete(bar, b.x, nloc, nx); b.st[0] = nloc; b.st[1] = nx; }
        const unsigned old = xb_add(&bar[XB_XSUB(b.x)], 1u);
        const unsigned gen = old / nloc;
        if (old + 1u == (gen + 1u) * nloc) {
            __builtin_amdgcn_fence(__ATOMIC_RELEASE, "agent");
            asm volatile("s_waitcnt vmcnt(0)" ::: "memory");
            const unsigned og = xb_add(&bar[XB_TOP], 1u);
            const unsigned tg = og / nx;
            if (og + 1u == (tg + 1u) * nx) xb_add(&bar[XB_TOPGEN], 1u);
            else XB_SPIN(xb_ld(&bar[XB_TOPGEN]) == tg, bar);
            __builtin_amdgcn_fence(__ATOMIC_ACQUIRE, "agent");
            xb_add(&bar[XB_XGEN(b.x)], 1u);
            asm volatile("s_waitcnt vmcnt(0)" ::: "memory");
        } else {
            XB_SPIN(xb_ld(&bar[XB_XGEN(b.x)]) == gen, bar);
            __builtin_amdgcn_fence(__ATOMIC_ACQUIRE, "agent");
            asm volatile("s_waitcnt vmcnt(0)" ::: "memory");
        }
    }
    __syncthreads();
}

struct Args { const float* in[31]; float* out; unsigned char* ws; int pad[2]; };
typedef LAS unsigned long long* PtrTab;
__device__ __forceinline__ const float* tab_in(PtrTab tb, int k) { const unsigned long long v = tb[k]; const unsigned lo = __builtin_amdgcn_readfirstlane((unsigned)v), hi = __builtin_amdgcn_readfirstlane((unsigned)(v >> 32));
    return (const float*)(const GAS float*)(((unsigned long long)hi << 32) | lo); }
constexpr int TAB_OFF = 147456 - 512;
constexpr size_t WS_BAR = 768 * 1024; constexpr size_t WS_QCTR = 832 * 1024;

__device__ __forceinline__ void phase_prologue(PtrTab TB, unsigned char* ws, float* xout, int l, LAS unsigned char* lds, int gw, int NGW, int lane, int wave) {
    LAS float* scr = (LAS float*)(lds + wave * 16640);
#define g1 (tab_in(TB, 2) + l * D)
#define w1i (tab_in(TB, 3) + (size_t)l * D * 2 * DFF)
#define w1o (tab_in(TB, 4) + (size_t)l * DFF * D)
#define gm (tab_in(TB, 5) + l * D)
#define win (tab_in(TB, 6) + (size_t)l * D * INW)
#define wpool (tab_in(TB, 9) + (size_t)l * 4 * 128 * 128)
#define psc (tab_in(TB, 10) + l * 512)
#define wua (tab_in(TB, 11) + (size_t)l * 512 * D)
#define wra (tab_in(TB, 14) + (size_t)l * 8 * 128 * 128)
#define wrx (tab_in(TB, 16) + (size_t)l * 8 * 128 * 128)
#define wub (tab_in(TB, 19) + (size_t)l * D * D)
#define wuc (tab_in(TB, 20) + (size_t)l * 512 * D)
#define wo (tab_in(TB, 21) + (size_t)l * D * D)
#define gc (tab_in(TB, 22) + l * D)
#define gmem (tab_in(TB, 23) + l * D)
#define wxq (tab_in(TB, 24) + (size_t)l * D * D)
#define wxkv (tab_in(TB, 25) + (size_t)l * D * 2 * D)
#define wxo (tab_in(TB, 26) + (size_t)l * D * D)
#define g2 (tab_in(TB, 27) + l * D)
#define w2i (tab_in(TB, 28) + (size_t)l * D * 2 * DFF)
#define w2o (tab_in(TB, 29) + (size_t)l * DFF * D)
    constexpr int I_FI = 16 * 88, I_FO = 44 * 16, I_WIN = 16 * 64, I_WG = 16 * 48, I_UB = 16 * 16, I_UC = 8 * 16, I_RG = 32, I_SQ = 16 * 16, I_KV = 16 * 32;
    constexpr int S0 = 0, S1 = S0 + I_FI, S2 = S1 + I_FO, S3 = S2 + I_WIN, S4 = S3 + I_WG, S5 = S4 + I_UB, S6 = S5 + I_UC, S7 = S6 + I_RG, S8 = S7 + I_RG, S9 = S8 + I_SQ, S10 = S9 + I_SQ,
                  S11 = S10 + I_KV, S12 = S11 + I_SQ, S13 = S12 + I_FI, S14 = S13 + I_FO;
    for (int it = gw; it < S14; it += NGW) {
        if (it < S1 || (it >= S12 && it < S13)) {
            const bool second = it >= S12; const int r = second ? it - S12 : it; const int kb = r / 88, nb = r % 88; const int n = nb * 64;
            const int half = n >= DFF ? 1 : 0, nn = n - half * DFF; const int drow = (nn >> 7) * 256 + half * 128 + (nn & 127);
            tr_item(second ? w2i : w1i, 2 * DFF, n, kb * 64, second ? g2 : g1, (bf16*)(ws + (second ? WS_W2IN : WS_W1IN)), D, drow, scr, lane);
        } else if (it < S2 || it >= S13) {
            const bool second = it >= S13; const int r = second ? it - S13 : it - S1; const int kb = r / 16, nb = r % 16;
            tr_item(second ? w2o : w1o, D, nb * 64, kb * 64, nullptr, (bf16*)(ws + (second ? WS_W2OUT : WS_W1OUT)), DFF, nb * 64, scr, lane);
        } else if (it < S3) { const int r = it - S2, kb = r / 64, nb = r % 64; tr_item(win, INW, nb * 64, kb * 64, gm, (bf16*)(ws + WS_WIN), D, nb * 64, scr, lane);
        } else if (it < S4) { const int r = it - S3, kb = r / 48, nb = r % 48; tr_item(win, INW, 4104 + nb * 64, kb * 64, gm, (bf16*)(ws + WS_WG), D, nb * 64, scr, lane);
        } else if (it < S5) { const int r = it - S4, kb = r / 16, nb = r % 16; tr_item(wub, D, nb * 64, kb * 64, nullptr, (bf16*)(ws + WS_UB), D, nb * 64, scr, lane);
        } else if (it < S6) { const int r = it - S5, kb = r / 16, nb = r % 16; tr_item(wuc, D, nb * 64, kb * 64, nullptr, (bf16*)(ws + WS_UC), 512, nb * 64, scr, lane);
        } else if (it < S8) { const bool xg = it >= S7; const int r = xg ? it - S7 : it - S6; const int hh = r >> 2, kb = (r >> 1) & 1, nb = r & 1;
            tr_item((xg ? wrx : wra) + hh * 16384, 128, nb * 64, kb * 64, nullptr, (bf16*)(ws + (xg ? WS_WXT : WS_WAT)) + hh * 16384, 128, nb * 64, scr, lane);
        } else if (it < S9) { const int r = it - S8, kb = r / 16, nb = r % 16; tr_item(wo, D, nb * 64, kb * 64, nullptr, (bf16*)(ws + WS_WO), D, nb * 64, scr, lane);
        } else if (it < S10) { const int r = it - S9, kb = r / 16, nb = r % 16; tr_item(wxq, D, nb * 64, kb * 64, gc, (bf16*)(ws + WS_WXQ), D, nb * 64, scr, lane);
        } else if (it < S11) { const int r = it - S10, kb = r / 32, nb = r % 32; tr_item(wxkv, 2 * D, nb * 64, kb * 64, nullptr, (bf16*)(ws + WS_WXKV), D, nb * 64, scr, lane);
        } else { const int r = it - S11, kb = r / 16, nb = r % 16; tr_item(wxo, D, nb * 64, kb * 64, nullptr, (bf16*)(ws + WS_WXO), D, nb * 64, scr, lane); }
    }
    { bf16* UaT = (bf16*)(ws + WS_UA);
      for (int it = gw; it < 4 * 16 * 16; it += NGW) { const int g = it >> 8, nblk = (it >> 4) & 15, c0 = (it & 15) * 8, n = nblk * 64 + lane;
          const float* wp = wpool + ((size_t)g * 128 + c0) * 128; const float* sc = psc + g * 128; const float* ua = wua + (size_t)(g * 128) * D + n; float acc[8];
#pragma unroll
          for (int c = 0; c < 8; ++c) acc[c] = 0.f;
#pragma unroll 16
          for (int j = 0; j < 128; ++j) { const float u = ua[(size_t)j * D] * sc[j];
#pragma unroll
              for (int c = 0; c < 8; ++c) acc[c] += wp[c * 128 + j] * u; }
          v4u o; o.x = pk2(acc[0], acc[1]); o.y = pk2(acc[2], acc[3]); o.z = pk2(acc[4], acc[5]); o.w = pk2(acc[6], acc[7]);
          *(v4u*)(UaT + (size_t)n * 512 + g * 128 + c0) = o; } }
    { float* wfl = (float*)(ws + WS_WFL);
      for (int it = gw * 64 + lane; it < 8 * 1024; it += NGW * 64) { const int h = it >> 10, k = it & 1023; wfl[it] = gm[k] * win[(size_t)k * INW + 4096 + h]; } }
    { const float* mem = tab_in(TB, 1); bf16* mn = (bf16*)(ws + WS_MEMN);
      for (int r = gw; r < 512; r += NGW) { const f32x4* xr = (const f32x4*)(mem + (size_t)r * D) + lane; f32x4 v[4]; float s = 0.f;
#pragma unroll
          for (int j = 0; j < 4; ++j) { v[j] = xr[64 * j]; s += (v[j].x * v[j].x + v[j].y * v[j].y) + (v[j].z * v[j].z + v[j].w * v[j].w); }
          const float rs = rsqrtf(wave_sum(s, lane) * (1.f / D) + 1e-6f); unsigned long long* o8 = (unsigned long long*)(mn + (size_t)r * D) + lane;
#pragma unroll
          for (int j = 0; j < 4; ++j) { const f32x4 gv = *((const f32x4*)gmem + lane + 64 * j);
              o8[64 * j] = (unsigned long long)pk2(v[j].x * rs * gv.x, v[j].y * rs * gv.y) | ((unsigned long long)pk2(v[j].z * rs * gv.z, v[j].w * rs * gv.w) << 32); } } }
    if (l == 0) {
        const float* x = tab_in(TB, 0); float* xo = xout; bf16* xb = (bf16*)(ws + WS_XB); float* ss = (float*)(ws + WS_SSP);
        for (int r0 = gw; r0 < M; r0 += 4 * NGW) { f32x4 v[4][4]; float s[4];
#pragma unroll
            for (int q = 0; q < 4; ++q) { const int r = (r0 + q * NGW < M) ? r0 + q * NGW : r0; const f32x4* xr = (const f32x4*)(x + (size_t)r * D) + lane; s[q] = 0.f;
#pragma unroll
                for (int j = 0; j < 4; ++j) { v[q][j] = xr[64 * j]; s[q] += (v[q][j].x * v[q][j].x + v[q][j].y * v[q][j].y) + (v[q][j].z * v[q][j].z + v[q][j].w * v[q][j].w); } }
#pragma unroll
            for (int o = 1; o < 64; o <<= 1) {
#pragma unroll
                for (int q = 0; q < 4; ++q) s[q] += bperm(s[q], lane ^ o); }
#pragma unroll
            for (int q = 0; q < 4; ++q) { const int r = r0 + q * NGW; if (r < M) { f32x4* orow = (f32x4*)(xo + (size_t)r * D) + lane; unsigned long long* o8 = (unsigned long long*)(xb + (size_t)r * D) + lane;
                    if (lane < 4) ss[(size_t)r * 4 + lane] = lane == 0 ? s[q] : 0.f;
#pragma unroll
                    for (int j = 0; j < 4; ++j) { orow[64 * j] = v[q][j]; o8[64 * j] = (unsigned long long)pk2(v[q][j].x, v[q][j].y) | ((unsigned long long)pk2(v[q][j].z, v[q][j].w) << 32); } } }
        }
    }
}
#undef g1
#undef w1i
#undef w1o
#undef gm
#undef win
#undef wpool
#undef psc
#undef wua
#undef wra
#undef wrx
#undef wub
#undef wuc
#undef wo
#undef gc
#undef gmem
#undef wxq
#undef wxkv
#undef wxo
#undef g2
#undef w2i
#undef w2o
__device__ __forceinline__ void phase_fl(const bf16* xb, const float* wfl, const float* bfv, const float* ss, float* logf, int gw, int NGW, int lane) {
    for (int r0 = gw; r0 < M; r0 += 4 * NGW) {
        float acc[4][8]; v4u xv[4][2];
#pragma unroll
        for (int q = 0; q < 4; ++q) { const int r = r0 + q * NGW; const bool ok = r < M;
#pragma unroll
            for (int j = 0; j < 2; ++j) xv[q][j] = ok ? *(const v4u*)(xb + (size_t)r * D + 8 * lane + 512 * j) : (v4u){0u, 0u, 0u, 0u};
#pragma unroll
            for (int h = 0; h < 8; ++h) acc[q][h] = 0.f; }
#pragma unroll
        for (int j = 0; j < 2; ++j) { const int k0 = 8 * lane + 512 * j;
#pragma unroll
            for (int h = 0; h < 8; ++h) { const f32x4 w0 = *(const f32x4*)(wfl + h * 1024 + k0), w1 = *(const f32x4*)(wfl + h * 1024 + k0 + 4);
#pragma unroll
                for (int q = 0; q < 4; ++q) { const v4u x = xv[q][j];
                    acc[q][h] += (__uint_as_float(x.x << 16) * w0.x + __uint_as_float(x.x & 0xffff0000u) * w0.y) + (__uint_as_float(x.y << 16) * w0.z + __uint_as_float(x.y & 0xffff0000u) * w0.w)
                               + (__uint_as_float(x.z << 16) * w1.x + __uint_as_float(x.z & 0xffff0000u) * w1.y) + (__uint_as_float(x.w << 16) * w1.z + __uint_as_float(x.w & 0xffff0000u) * w1.w); } } }
        const int h = ((lane >> 5) & 1) * 4 + ((lane >> 4) & 1) * 2 + ((lane >> 3) & 1); const float bh_ = bfv[h];
#pragma unroll
        for (int q = 0; q < 4; ++q) { const int r = r0 + q * NGW;
            float v4[4], v2[2], v1;
            { const bool up = (lane & 32) != 0;
#pragma unroll
              for (int i = 0; i < 4; ++i) { const float mine = up ? acc[q][4 + i] : acc[q][i], other = up ? acc[q][i] : acc[q][4 + i]; v4[i] = mine + bperm(other, lane ^ 32); } }
            { const bool up = (lane & 16) != 0;
#pragma unroll
              for (int i = 0; i < 2; ++i) { const float mine = up ? v4[2 + i] : v4[i], other = up ? v4[i] : v4[2 + i]; v2[i] = mine + bperm(other, lane ^ 16); } }
            { const bool up = (lane & 8) != 0; const float mine = up ? v2[1] : v2[0], other = up ? v2[0] : v2[1]; v1 = mine + bperm(other, lane ^ 8); }
            v1 += bperm(v1, lane ^ 4); v1 += bperm(v1, lane ^ 2); v1 += bperm(v1, lane ^ 1);
            if (r < M) { const float z = v1 * pg8::rstd_of(ss, r) + bh_; const float ls = -(fmaxf(-z, 0.f) + flog1p(__expf(-fabsf(z)))); if ((lane & 7) == 0) logf[(size_t)r * 8 + h] = ls; } }
    }
}
__device__ __forceinline__ void cumsum_bh(const float* logf, float* ctil, int bh, LAS float* red) {
    int tid_o = threadIdx.x; asm volatile("" : "+v"(tid_o)); const int tid = tid_o, lane = tid & 63, wid = tid >> 6;
    const int b = bh >> 3, h = bh & 7; const float* src = logf + ((size_t)b * SEQ + 16 * tid) * 8 + h; float v[16]; float s = 0.f;
#pragma unroll
    for (int i = 0; i < 16; ++i) { v[i] = src[(size_t)i * 8]; s += v[i]; }
    float incl = s;
#pragma unroll
    for (int o = 1; o < 64; o <<= 1) { const float t = bperm(incl, lane - o); if (lane >= o) incl += t; }
    if (lane == 63) red[wid] = incl;
    __syncthreads();
    float base = 0.f;
#pragma unroll
    for (int w = 0; w < 8; ++w) if (w < wid) base += red[w];
    float run = base + incl - s; float* dst = ctil + (size_t)bh * SEQ + 16 * tid;
#pragma unroll
    for (int i = 0; i < 16; ++i) { run += v[i]; dst[i] = run * 1.4426950408889634f; }
    __syncthreads();
}
__device__ __forceinline__ void unpk8(const v4u xv, float (&xf)[8]) { xf[0] = __uint_as_float(xv.x << 16); xf[1] = __uint_as_float(xv.x & 0xffff0000u); xf[2] = __uint_as_float(xv.y << 16); xf[3] = __uint_as_float(xv.y & 0xffff0000u);
    xf[4] = __uint_as_float(xv.z << 16); xf[5] = __uint_as_float(xv.z & 0xffff0000u); xf[6] = __uint_as_float(xv.w << 16); xf[7] = __uint_as_float(xv.w & 0xffff0000u); }
template <int W> __device__ __forceinline__ void pool_item(const bf16* xa, bf16* ya, int m0, int cgi) {
    const int t0 = m0 & (SEQ - 1); v4u rw[W + 7];
#pragma unroll
    for (int a = 0; a < W + 7; ++a) { const int tl = a - (W - 1); rw[a] = (t0 + tl >= 0) ? *(const v4u*)(xa + (size_t)(m0 + tl) * 512 + 8 * cgi) : (v4u){0u, 0u, 0u, 0u}; }
    float s[8];
#pragma unroll
    for (int i = 0; i < 8; ++i) s[i] = 0.f;
#pragma unroll
    for (int a = 0; a < W - 1; ++a) { float xf[8]; unpk8(rw[a], xf);
#pragma unroll
        for (int i = 0; i < 8; ++i) s[i] += xf[i]; }
#pragma unroll
    for (int o = 0; o < 8; ++o) { float cur[8]; unpk8(rw[o + W - 1], cur);
#pragma unroll
        for (int i = 0; i < 8; ++i) s[i] += cur[i];
        const int t = t0 + o, cnt = (t + 1 < W) ? t + 1 : W; const float ic = 1.f / (float)cnt; v4u ov;
        ov.x = pk2(s[0] * ic - cur[0], s[1] * ic - cur[1]); ov.y = pk2(s[2] * ic - cur[2], s[3] * ic - cur[3]); ov.z = pk2(s[4] * ic - cur[4], s[5] * ic - cur[5]); ov.w = pk2(s[6] * ic - cur[6], s[7] * ic - cur[7]);
        *(v4u*)(ya + (size_t)(m0 + o) * 512 + 8 * cgi) = ov;
        float old[8]; unpk8(rw[o], old);
#pragma unroll
        for (int i = 0; i < 8; ++i) s[i] -= old[i]; }
}
__device__ __forceinline__ void phase_pool(const bf16* xa, bf16* ya, int gtid, int nthr) {
    for (int idx = gtid; idx < (M / 8) * 64; idx += nthr) { const int c16 = idx & 15, rl = (idx >> 4) & 3, g = (idx >> 6) & 3, rh = idx >> 8; const int m0 = (rh * 4 + rl) * 8, cgi = g * 16 + c16;
        if (g == 0) pool_item<2>(xa, ya, m0, cgi); else if (g == 1) pool_item<4>(xa, ya, m0, cgi); else if (g == 2) pool_item<8>(xa, ya, m0, cgi); else pool_item<16>(xa, ya, m0, cgi); }
}
__device__ __forceinline__ int crow16(int r, int hi) { return (r & 3) + 8 * (r >> 2) + 4 * hi; }
template <bool FINAL>
__device__ __forceinline__ void lru_item(LAS unsigned char* lds, int b, int hp, int ck, const bf16* xl, bf16* gg, const float* cw, const float* cb, const bf16* WaT, const bf16* WxT,
                                         const float* ba, const float* bx, const float* lam, float* summ) {
    int tid_o = threadIdx.x; asm volatile("" : "+v"(tid_o)); const int tid = tid_o, lane = tid & 63, wid = tid >> 6, r32 = lane & 31, hi = lane >> 5;
    const int t0 = ck * 128; const size_t m0 = (size_t)b * SEQ + t0; const int ch0 = hp * 256;
    constexpr int XP = 264;
    LAS bf16* xc = (LAS bf16*)lds; LAS float* h0s = (LAS float*)(lds + 128 * XP * 2);
    {
        const int cgi = tid & 31, tq = tid >> 5, c = ch0 + 8 * cgi;
        float w[4][8], bb[8];
#pragma unroll
        for (int k = 0; k < 4; ++k) { const f32x4 a = *(const f32x4*)(cw + k * 1024 + c), d = *(const f32x4*)(cw + k * 1024 + c + 4); w[k][0] = a.x; w[k][1] = a.y; w[k][2] = a.z; w[k][3] = a.w; w[k][4] = d.x; w[k][5] = d.y; w[k][6] = d.z; w[k][7] = d.w; }
        { const f32x4 a = *(const f32x4*)(cb + c), d = *(const f32x4*)(cb + c + 4); bb[0] = a.x; bb[1] = a.y; bb[2] = a.z; bb[3] = a.w; bb[4] = d.x; bb[5] = d.y; bb[6] = d.z; bb[7] = d.w; }
        v4u rw[11];
#pragma unroll
        for (int i = 0; i < 11; ++i) { const int tl = tq * 8 - 3 + i; rw[i] = (t0 + tl >= 0) ? *(const v4u*)(xl + (size_t)((long)m0 + tl) * 1024 + c) : (v4u){0u, 0u, 0u, 0u}; }
#pragma unroll
        for (int o = 0; o < 8; ++o) { float y[8];
#pragma unroll
            for (int j = 0; j < 8; ++j) y[j] = bb[j];
#pragma unroll
            for (int k = 0; k < 4; ++k) { const v4u xv = rw[o + k];
                y[0] += w[k][0] * __uint_as_float(xv.x << 16); y[1] += w[k][1] * __uint_as_float(xv.x & 0xffff0000u); y[2] += w[k][2] * __uint_as_float(xv.y << 16); y[3] += w[k][3] * __uint_as_float(xv.y & 0xffff0000u);
                y[4] += w[k][4] * __uint_as_float(xv.z << 16); y[5] += w[k][5] * __uint_as_float(xv.z & 0xffff0000u); y[6] += w[k][6] * __uint_as_float(xv.w << 16); y[7] += w[k][7] * __uint_as_float(xv.w & 0xffff0000u); }
            v4u ov; ov.x = pk2(y[0], y[1]); ov.y = pk2(y[2], y[3]); ov.z = pk2(y[4], y[5]); ov.w = pk2(y[6], y[7]);
            *(LAS v4u*)(xc + (tq * 8 + o) * XP + 8 * cgi) = ov; }
    }
    if (FINAL && tid < 256) {
        const float* sp = summ + ((size_t)b * 64 * 1024 + ch0 + tid) * 2; float h = 0.f;
        for (int c0 = 0; c0 < ck; c0 += 16) { float2 v[16];
#pragma unroll
            for (int j = 0; j < 16; ++j) v[j] = (c0 + j < ck) ? *(const float2*)(sp + (size_t)(c0 + j) * 2048) : make_float2(1.f, 0.f);
#pragma unroll
            for (int j = 0; j < 16; ++j) h = v[j].x * h + v[j].y; }
        h0s[tid] = h;
    }
    __syncthreads();
    const int hh = wid >> 2, s = wid & 3, chl = 128 * hh + 32 * s + r32, ch = ch0 + chl, head = 2 * hp + hh;
    const float bav = ba[ch], bxv = bx[ch]; const float nl = -lam[ch]; const float sp8 = 8.f * (fmaxf(nl, 0.f) + flog1p(__expf(-fabsf(nl))));
    bf16x8 fa[8], fx[8];
#pragma unroll
    for (int ks = 0; ks < 8; ++ks) { fa[ks] = *(const bf16x8*)(WaT + (size_t)head * 16384 + (32 * s + r32) * 128 + 16 * ks + 8 * hi); fx[ks] = *(const bf16x8*)(WxT + (size_t)head * 16384 + (32 * s + r32) * 128 + 16 * ks + 8 * hi); }
    float hrun = FINAL ? h0s[chl] : 0.f, Arun = 1.f;
    for (int mb = 0; mb < 4; ++mb) {
        unsigned short gv[16];
        if (FINAL) {
#pragma unroll
            for (int r = 0; r < 16; ++r) gv[r] = gg[(m0 + 32 * mb + crow16(r, hi)) * 1024 + ch]; }
        f32x16 accA = {0.f, 0.f, 0.f, 0.f, 0.f, 0.f, 0.f, 0.f, 0.f, 0.f, 0.f, 0.f, 0.f, 0.f, 0.f, 0.f}, accX = accA;
#pragma unroll
        for (int ks = 0; ks < 8; ++ks) { const bf16x8 af = *(const LAS bf16x8*)(xc + (32 * mb + r32) * XP + 128 * hh + 16 * ks + 8 * hi);
            accA = __builtin_amdgcn_mfma_f32_32x32x16_bf16(af, fa[ks], accA, 0, 0, 0); accX = __builtin_amdgcn_mfma_f32_32x32x16_bf16(af, fx[ks], accX, 0, 0, 0); }
        float a[16], u[16];
#pragma unroll
        for (int r = 0; r < 16; ++r) { const int tok = 32 * mb + crow16(r, hi); const float xcv = bf2f(xc[tok * XP + chl]);
            const float rg = pg8::fsig(accA[r] + bav), la = -rg * sp8, av = __expf(la), mult = sqrtf(fmaxf(1.f - av * av, 0.f)), ig = pg8::fsig(accX[r] + bxv);
            a[r] = av; u[r] = mult * ig * xcv; }
        float As[4], Hs[4], Ap[4], Hp[4], hin[4];
#pragma unroll
        for (int g = 0; g < 4; ++g) { float Aq = 1.f, Hq = 0.f;
#pragma unroll
            for (int i = 0; i < 4; ++i) { Hq = a[4 * g + i] * Hq + u[4 * g + i]; Aq *= a[4 * g + i]; }
            As[g] = Aq; Hs[g] = Hq; Ap[g] = bperm(Aq, lane ^ 32); Hp[g] = bperm(Hq, lane ^ 32); }
#pragma unroll
        for (int g = 0; g < 4; ++g) { const float A0 = hi ? Ap[g] : As[g], H0 = hi ? Hp[g] : Hs[g], A1 = hi ? As[g] : Ap[g], H1 = hi ? Hs[g] : Hp[g];
            const float hA = hrun, hB = A0 * hA + H0; hrun = A1 * hB + H1; Arun *= A0 * A1; hin[g] = hi ? hB : hA; }
        if (FINAL) {
#pragma unroll
            for (int g = 0; g < 4; ++g) { float hc = hin[g];
#pragma unroll
                for (int i = 0; i < 4; ++i) { const int r = 4 * g + i; hc = a[r] * hc + u[r]; gv[r] = (unsigned short)f2bf(hc * bf2f(gv[r])); } }
#pragma unroll
            for (int r = 0; r < 16; ++r) gg[(m0 + 32 * mb + crow16(r, hi)) * 1024 + ch] = gv[r];
        }
    }
    if (!FINAL && hi == 0) { float* sp = summ + (((size_t)b * 64 + ck) * 1024 + ch) * 2; sp[0] = Arun; sp[1] = hrun; }
    __syncthreads();
}
__device__ __forceinline__ void phase_final(float* x, const float* g, int gw, int NGW, int lane) {
    f32x4 gv[4];
#pragma unroll
    for (int j = 0; j < 4; ++j) gv[j] = *((const f32x4*)g + lane + 64 * j);
    for (int r0 = gw; r0 < M; r0 += 4 * NGW) { f32x4 v[4][4]; float s[4];
#pragma unroll
        for (int q = 0; q < 4; ++q) { const int r = (r0 + q * NGW < M) ? r0 + q * NGW : r0; const f32x4* xr = (const f32x4*)(x + (size_t)r * D) + lane; s[q] = 0.f;
#pragma unroll
            for (int j = 0; j < 4; ++j) { v[q][j] = xr[64 * j]; s[q] += (v[q][j].x * v[q][j].x + v[q][j].y * v[q][j].y) + (v[q][j].z * v[q][j].z + v[q][j].w * v[q][j].w); } }
#pragma unroll
        for (int o = 1; o < 64; o <<= 1) {
#pragma unroll
            for (int q = 0; q < 4; ++q) s[q] += bperm(s[q], lane ^ o); }
#pragma unroll
        for (int q = 0; q < 4; ++q) { const int r = r0 + q * NGW; if (r < M) { const float rs = rsqrtf(s[q] * (1.f / D) + 1e-6f); f32x4* xr = (f32x4*)(x + (size_t)r * D) + lane;
#pragma unroll
                for (int j = 0; j < 4; ++j) xr[64 * j] = (f32x4){v[q][j].x * rs * gv[j].x, v[q][j].y * rs * gv[j].y, v[q][j].z * rs * gv[j].z, v[q][j].w * rs * gv[j].w}; } }
    }
}
__device__ __forceinline__ void phase_kmax(const bf16* K, float* kpart, int gw, int NGW, int lane) {
    float m0 = 0.f, m1 = 0.f;
#pragma unroll 8
    for (int r = gw; r < M; r += NGW) { const v4u w = *(const v4u*)(K + (size_t)r * 512 + 8 * lane);
        const float a0 = __uint_as_float(w.x << 16), a1 = __uint_as_float(w.x & 0xffff0000u), a2 = __uint_as_float(w.y << 16), a3 = __uint_as_float(w.y & 0xffff0000u);
        const float a4 = __uint_as_float(w.z << 16), a5 = __uint_as_float(w.z & 0xffff0000u), a6 = __uint_as_float(w.w << 16), a7 = __uint_as_float(w.w & 0xffff0000u);
        float s = (a0 * a0 + a1 * a1) + (a2 * a2 + a3 * a3) + (a4 * a4 + a5 * a5) + (a6 * a6 + a7 * a7);
        s += bperm(s, lane ^ 1); s += bperm(s, lane ^ 2); s += bperm(s, lane ^ 4);
        if (r < SEQ) m0 = fmaxf(m0, s); else m1 = fmaxf(m1, s); }
    if ((lane & 7) == 0) { kpart[((size_t)gw * 2 + 0) * 8 + (lane >> 3)] = m0; kpart[((size_t)gw * 2 + 1) * 8 + (lane >> 3)] = m1; }
}
constexpr float FOX_C2 = 0.125f * 1.4426950408889634f;
constexpr float FOX_SKIP = 64.f;
constexpr int FOX_KP = 72;
constexpr int FOX_BUF = 2 * 64 * FOX_KP * 2 + 256;
__device__ __forceinline__ void fox_unit(LAS unsigned char* lds, int b, int h, int qb, const bf16* Q, const bf16* K, const bf16* V, bf16* O, const float* ct, const float* kpart, int nparts) {
    int tid_o = threadIdx.x; asm volatile("" : "+v"(tid_o)); const int tid = tid_o, lane = tid & 63, wid = tid >> 6, r32 = lane & 31, hi = lane >> 5;
    const size_t rowbase = (size_t)b * SEQ; const int q0 = qb * 256, NT = 4 * qb + 4;
    const bf16* Qw = Q + (rowbase + q0 + wid * 32 + r32) * 512 + h * 64;
    bf16x8 qr[4];
#pragma unroll
    for (int d0 = 0; d0 < 4; ++d0) qr[d0] = *(const bf16x8*)(Qw + 16 * d0 + 8 * hi);
    LAS float* red = (LAS float*)(lds + 2 * FOX_BUF); LAS int* tsl = (LAS int*)(lds + 2 * FOX_BUF + 128);
    { float qn = 0.f;
#pragma unroll
      for (int d0 = 0; d0 < 4; ++d0) { const v4u w = __builtin_bit_cast(v4u, qr[d0]);
          const float a0 = __uint_as_float(w.x << 16), a1 = __uint_as_float(w.x & 0xffff0000u), a2 = __uint_as_float(w.y << 16), a3 = __uint_as_float(w.y & 0xffff0000u);
          const float a4 = __uint_as_float(w.z << 16), a5 = __uint_as_float(w.z & 0xffff0000u), a6 = __uint_as_float(w.w << 16), a7 = __uint_as_float(w.w & 0xffff0000u);
          qn += (a0 * a0 + a1 * a1) + (a2 * a2 + a3 * a3) + (a4 * a4 + a5 * a5) + (a6 * a6 + a7 * a7); }
      qn += bperm(qn, lane ^ 32);
#pragma unroll
      for (int o = 1; o < 32; o <<= 1) qn = fmaxf(qn, bperm(qn, lane ^ o));
      __syncthreads();
      float km = 0.f;
      for (int i = tid; i < nparts; i += NTHR) km = fmaxf(km, kpart[((size_t)i * 2 + b) * 8 + h]);
#pragma unroll
      for (int o = 1; o < 64; o <<= 1) km = fmaxf(km, bperm(km, lane ^ o));
      if (lane == 0) { red[wid] = qn; red[8 + wid] = km; } if (tid == 0) tsl[0] = 4 * qb;
      __syncthreads();
      float q2 = red[0], k2 = red[8];
#pragma unroll
      for (int w = 1; w < 8; ++w) { q2 = fmaxf(q2, red[w]); k2 = fmaxf(k2, red[8 + w]); }
      const float thr = 2.f * sqrtf(q2) * sqrtf(k2) * 1.0001f + FOX_SKIP;
      const float c0 = ct[q0];
      if (tid < 4 * qb && ct[64 * tid + 63] - c0 <= thr) atomicMin((int*)tsl, tid);
      __syncthreads(); }
    const int T0 = tsl[0];
    const int skey = tid >> 3, sd = (tid & 7) * 8;
    const bf16* kp = K + (rowbase + skey) * 512 + h * 64 + sd; const bf16* vp = V + (rowbase + skey) * 512 + h * 64 + sd;
    v4u kreg = *(const v4u*)(kp + (size_t)T0 * 64 * 512), vreg = *(const v4u*)(vp + (size_t)T0 * 64 * 512); float creg = (tid < 64) ? ct[64 * T0 + tid] : 0.f;
    __syncthreads();
    { LAS unsigned char* buf0 = lds + (T0 & 1) * FOX_BUF; LAS bf16* Ks = (LAS bf16*)buf0; LAS bf16* Vt = Ks + 64 * FOX_KP; LAS float* Cs = (LAS float*)(buf0 + 2 * 64 * FOX_KP * 2);
      *(LAS v4u*)(Ks + skey * FOX_KP + sd) = kreg;
      Vt[(sd + 0) * FOX_KP + skey] = (bf16)(vreg.x & 0xffffu); Vt[(sd + 1) * FOX_KP + skey] = (bf16)(vreg.x >> 16); Vt[(sd + 2) * FOX_KP + skey] = (bf16)(vreg.y & 0xffffu); Vt[(sd + 3) * FOX_KP + skey] = (bf16)(vreg.y >> 16);
      Vt[(sd + 4) * FOX_KP + skey] = (bf16)(vreg.z & 0xffffu); Vt[(sd + 5) * FOX_KP + skey] = (bf16)(vreg.z >> 16); Vt[(sd + 6) * FOX_KP + skey] = (bf16)(vreg.w & 0xffffu); Vt[(sd + 7) * FOX_KP + skey] = (bf16)(vreg.w >> 16);
      if (tid < 64) Cs[tid] = creg; }
    if (T0 + 1 < NT) { kreg = *(const v4u*)(kp + (size_t)(T0 + 1) * 64 * 512); vreg = *(const v4u*)(vp + (size_t)(T0 + 1) * 64 * 512); if (tid < 64) creg = ct[64 * (T0 + 1) + tid]; }
    float m = -1e30f, l = 0.f; f32x16 o0, o1;
#pragma unroll
    for (int r = 0; r < 16; ++r) { o0[r] = 0.f; o1[r] = 0.f; }
    for (int t = T0; t < NT; ++t) {
        __syncthreads();
        if (t + 1 < NT) { LAS unsigned char* bufn = lds + ((t + 1) & 1) * FOX_BUF; LAS bf16* Ks = (LAS bf16*)bufn; LAS bf16* Vt = Ks + 64 * FOX_KP; LAS float* Cs = (LAS float*)(bufn + 2 * 64 * FOX_KP * 2);
            *(LAS v4u*)(Ks + skey * FOX_KP + sd) = kreg;
            Vt[(sd + 0) * FOX_KP + skey] = (bf16)(vreg.x & 0xffffu); Vt[(sd + 1) * FOX_KP + skey] = (bf16)(vreg.x >> 16); Vt[(sd + 2) * FOX_KP + skey] = (bf16)(vreg.y & 0xffffu); Vt[(sd + 3) * FOX_KP + skey] = (bf16)(vreg.y >> 16);
            Vt[(sd + 4) * FOX_KP + skey] = (bf16)(vreg.z & 0xffffu); Vt[(sd + 5) * FOX_KP + skey] = (bf16)(vreg.z >> 16); Vt[(sd + 6) * FOX_KP + skey] = (bf16)(vreg.w & 0xffffu); Vt[(sd + 7) * FOX_KP + skey] = (bf16)(vreg.w >> 16);
            if (tid < 64) Cs[tid] = creg;
            if (t + 2 < NT) { kreg = *(const v4u*)(kp + (size_t)(t + 2) * 64 * 512); vreg = *(const v4u*)(vp + (size_t)(t + 2) * 64 * 512); if (tid < 64) creg = ct[64 * (t + 2) + tid]; } }
        const int jb = t - (NT - 4);
        if (jb >= 0 && 64 * jb > 32 * wid + 31) continue;
        LAS unsigned char* buf = lds + (t & 1) * FOX_BUF; const LAS bf16* Ks = (const LAS bf16*)buf; const LAS bf16* Vt = Ks + 64 * FOX_KP; const LAS float* Cs = (const LAS float*)(buf + 2 * 64 * FOX_KP * 2);
        f32x16 p0, p1;
#pragma unroll
        for (int g = 0; g < 4; ++g) { const f32x4 a = *(const LAS f32x4*)(Cs + 8 * g + 4 * hi), c = *(const LAS f32x4*)(Cs + 32 + 8 * g + 4 * hi);
            p0[4 * g + 0] = -a[0]; p0[4 * g + 1] = -a[1]; p0[4 * g + 2] = -a[2]; p0[4 * g + 3] = -a[3]; p1[4 * g + 0] = -c[0]; p1[4 * g + 1] = -c[1]; p1[4 * g + 2] = -c[2]; p1[4 * g + 3] = -c[3]; }
#pragma unroll
        for (int d0 = 0; d0 < 4; ++d0) { const bf16x8 a0 = *(const LAS bf16x8*)(Ks + r32 * FOX_KP + 16 * d0 + 8 * hi), a1 = *(const LAS bf16x8*)(Ks + (32 + r32) * FOX_KP + 16 * d0 + 8 * hi);
            p0 = __builtin_amdgcn_mfma_f32_32x32x16_bf16(a0, qr[d0], p0, 0, 0, 0); p1 = __builtin_amdgcn_mfma_f32_32x32x16_bf16(a1, qr[d0], p1, 0, 0, 0); }
        if (jb >= 0) { const int qrel = 32 * wid + r32, kb = 64 * jb + 4 * hi;
#pragma unroll
            for (int r = 0; r < 16; ++r) { const int kv = kb + (r & 3) + 8 * (r >> 2); if (kv > qrel) p0[r] = -__builtin_inff(); if (kv + 32 > qrel) p1[r] = -__builtin_inff(); } }
        float mx = fmaxf(p0[0], p1[0]);
#pragma unroll
        for (int r = 1; r < 16; ++r) mx = fmaxf(mx, fmaxf(p0[r], p1[r]));
        mx = fmaxf(mx, bperm(mx, lane ^ 32));
        const float mn = fmaxf(m, mx), alpha = __builtin_amdgcn_exp2f(m - mn); m = mn;
        float sum = 0.f;
#pragma unroll
        for (int r = 0; r < 16; ++r) { p0[r] = __builtin_amdgcn_exp2f(p0[r] - mn); p1[r] = __builtin_amdgcn_exp2f(p1[r] - mn); sum += p0[r] + p1[r]; }
        l = l * alpha + sum;
#pragma unroll
        for (int r = 0; r < 16; ++r) { o0[r] *= alpha; o1[r] *= alpha; }
        bf16x8 pb[4];
        { v4u w;
          w.x = pg8::cvt_pk_bf16(p0[0], p0[1]); w.y = pg8::cvt_pk_bf16(p0[2], p0[3]); w.z = pg8::cvt_pk_bf16(p0[4], p0[5]); w.w = pg8::cvt_pk_bf16(p0[6], p0[7]); pb[0] = __builtin_bit_cast(bf16x8, w);
          w.x = pg8::cvt_pk_bf16(p0[8], p0[9]); w.y = pg8::cvt_pk_bf16(p0[10], p0[11]); w.z = pg8::cvt_pk_bf16(p0[12], p0[13]); w.w = pg8::cvt_pk_bf16(p0[14], p0[15]); pb[1] = __builtin_bit_cast(bf16x8, w);
          w.x = pg8::cvt_pk_bf16(p1[0], p1[1]); w.y = pg8::cvt_pk_bf16(p1[2], p1[3]); w.z = pg8::cvt_pk_bf16(p1[4], p1[5]); w.w = pg8::cvt_pk_bf16(p1[6], p1[7]); pb[2] = __builtin_bit_cast(bf16x8, w);
          w.x = pg8::cvt_pk_bf16(p1[8], p1[9]); w.y = pg8::cvt_pk_bf16(p1[10], p1[11]); w.z = pg8::cvt_pk_bf16(p1[12], p1[13]); w.w = pg8::cvt_pk_bf16(p1[14], p1[15]); pb[3] = __builtin_bit_cast(bf16x8, w); }
#pragma unroll
        for (int mm = 0; mm < 4; ++mm) {
            typedef unsigned u32x2v __attribute__((ext_vector_type(2)));
            const u32x2v a0l = *(const LAS u32x2v*)(Vt + r32 * FOX_KP + 16 * mm + 4 * hi), a0h = *(const LAS u32x2v*)(Vt + r32 * FOX_KP + 16 * mm + 8 + 4 * hi);
            const u32x2v a1l = *(const LAS u32x2v*)(Vt + (32 + r32) * FOX_KP + 16 * mm + 4 * hi), a1h = *(const LAS u32x2v*)(Vt + (32 + r32) * FOX_KP + 16 * mm + 8 + 4 * hi);
            const v4u A0 = {a0l.x, a0l.y, a0h.x, a0h.y}, A1 = {a1l.x, a1l.y, a1h.x, a1h.y};
            o0 = __builtin_amdgcn_mfma_f32_32x32x16_bf16(__builtin_bit_cast(bf16x8, A0), pb[mm], o0, 0, 0, 0);
            o1 = __builtin_amdgcn_mfma_f32_32x32x16_bf16(__builtin_bit_cast(bf16x8, A1), pb[mm], o1, 0, 0, 0); }
    }
    l += bperm(l, lane ^ 32); const float inv = 1.f / l;
    bf16* Ow = O + (rowbase + q0 + wid * 32 + r32) * 512 + h * 64;
#pragma unroll
    for (int g = 0; g < 4; ++g) { typedef unsigned u32x2v __attribute__((ext_vector_type(2)));
        u32x2v w0, w1; w0.x = pg8::cvt_pk_bf16(o0[4 * g] * inv, o0[4 * g + 1] * inv); w0.y = pg8::cvt_pk_bf16(o0[4 * g + 2] * inv, o0[4 * g + 3] * inv);
        w1.x = pg8::cvt_pk_bf16(o1[4 * g] * inv, o1[4 * g + 1] * inv); w1.y = pg8::cvt_pk_bf16(o1[4 * g + 2] * inv, o1[4 * g + 3] * inv);
        *(u32x2v*)(Ow + 8 * g + 4 * hi) = w0; *(u32x2v*)(Ow + 32 + 8 * g + 4 * hi) = w1; }
    __syncthreads();
}
__global__ void __launch_bounds__(NTHR, 2) hybrid_fwd(Args args) {
    extern __shared__ __attribute__((aligned(16))) unsigned char lds_raw[];
    cg::grid_group grid = cg::this_grid();
    LAS unsigned char* lds = (LAS unsigned char*)lds_raw;
    int tid = threadIdx.x, lane = tid & 63, wave = __builtin_amdgcn_readfirstlane(tid >> 6);
    int G = gridDim.x, bx = blockIdx.x;
    int vcu = (G % 8 == 0) ? (bx % 8) * (G / 8) + bx / 8 : bx;
    int gw = vcu * NWAVES + wave; int NGW = G * NWAVES;
    PtrTab TB = (PtrTab)(lds + TAB_OFF);
    if (tid == 0) {
#pragma unroll
        for (int i = 0; i < 31; ++i) TB[i] = (unsigned long long)args.in[i];
    }
    if (tid == 1) { TB[40] = 0ull; }
    __syncthreads();
    (void)xcd_barrier_post((unsigned*)(args.ws + WS_BAR), (volatile LAS unsigned*)(lds + TAB_OFF + 320));
    grid.sync();
    unsigned char* ws = args.ws;
    float* X = args.out;
    float* SS = (float*)(ws + WS_SSP);
    bf16* XB = (bf16*)(ws + WS_XB);
    bf16* HB = (bf16*)(ws + WS_H);
    constexpr float C2X = 0.0625f * 1.4426950408889634f;
#define GSYNC() do { asm volatile("s_waitcnt vmcnt(0) lgkmcnt(0)" ::: "memory"); { XcdBarrier xb_; xb_.bar = (unsigned*)(ws + WS_BAR); xb_.x = xb_xcc_id(); xb_.st = (volatile LAS unsigned*)(lds + TAB_OFF + 320); xcd_barrier(xb_); } tid = threadIdx.x; asm volatile("" : "+v"(tid)); lane = tid & 63; wave = __builtin_amdgcn_readfirstlane(tid >> 6); G = gridDim.x; bx = blockIdx.x; asm volatile("" : "+s"(G), "+s"(bx)); vcu = (G % 8 == 0) ? (bx % 8) * (G / 8) + bx / 8 : bx; gw = vcu * NWAVES + wave; NGW = G * NWAVES; { unsigned long long wsi_ = (unsigned long long)ws; asm volatile("" : "+s"(wsi_)); ws = (unsigned char*)(GAS unsigned char*)wsi_; } } while (0)

    for (int l = 0; l < DEPTH; ++l) {
        float* ss0 = SS + (size_t)(4 * l + 0) * M * 4; float* ss1 = SS + (size_t)(4 * l + 1) * M * 4; float* ss2 = SS + (size_t)(4 * l + 2) * M * 4; float* ss3 = SS + (size_t)(4 * l + 3) * M * 4; float* ss4 = SS + (size_t)(4 * l + 4) * M * 4;
        phase_prologue(TB, ws, X, l, lds, gw, NGW, lane, wave);
        GSYNC();
        { pg8::Gemm g{XB, (const bf16*)(ws + WS_W1IN), M, 2 * DFF, D, D, D, 0}; pg8::StaticOrder S; S.init(M, 2 * DFF, G, bx);
          pg8::EpiSwiglu E{HB, ss0, DFF};
          pg8::gemm_phase<pg8::EpiSwiglu, pg8::StaticOrder, true, true>(lds, g, S, E); }
        if (bx >= G / 2) { pg8::Gemm g{(const bf16*)(ws + WS_MEMN), (const bf16*)(ws + WS_WXKV), 512, 2 * D, D, D, D, 0}; pg8::StaticOrder S; S.init(512, 2 * D, G, bx - G / 2);
          pg8::EpiKV E{(bf16*)(ws + WS_KX), (bf16*)(ws + WS_VT)};
          pg8::gemm_phase<pg8::EpiKV, pg8::StaticOrder, true, true>(lds, g, S, E); }
        GSYNC();
        { pg8::Gemm g{HB, (const bf16*)(ws + WS_W1OUT), M, D, DFF, DFF, DFF, 0}; pg8::StaticOrder S; S.init(M, D, G, bx); pg8::Unit u_;
          pg8::EpiResid E{X, XB, ss1, 0.5f};
          for (int i_ = 0; S.next(i_, u_); ++i_) { const pg8::OneUnit O1{u_.pm, u_.pn}; pg8::gemm_phase<pg8::EpiResid, pg8::OneUnit, false, true>(lds, g, O1, E); } }
        GSYNC();
        { pg8::Gemm g{XB, (const bf16*)(ws + WS_WIN), M, 4096, D, D, D, 0}; pg8::StaticOrder S; S.init(M, 4096, G, bx);
          pg8::EpiWin E{(bf16*)(ws + WS_XA), (bf16*)(ws + WS_XL), (bf16*)(ws + WS_GG), (bf16*)(ws + WS_Q), (bf16*)(ws + WS_K), (bf16*)(ws + WS_V), ss1, FOX_C2};
          pg8::gemm_phase<pg8::EpiWin, pg8::StaticOrder, true, true>(lds, g, S, E); }
        phase_fl(XB, (const float*)(ws + WS_WFL), tab_in(TB, 7) + l * 8, ss1, (float*)(ws + WS_LOGF), gw, NGW, lane);
        GSYNC();
        if (vcu < 16) cumsum_bh((const float*)(ws + WS_LOGF), (float*)(ws + WS_CTIL), vcu, (LAS float*)lds);
        for (int it = vcu; it < 512; it += G)
            lru_item<false>(lds, it >> 8, (it >> 6) & 3, it & 63, (const bf16*)(ws + WS_XL), (bf16*)(ws + WS_GG), tab_in(TB, 12) + (size_t)l * 4 * D, tab_in(TB, 13) + l * D, (const bf16*)(ws + WS_WAT), (const bf16*)(ws + WS_WXT),
                            tab_in(TB, 15) + l * D, tab_in(TB, 17) + l * D, tab_in(TB, 18) + l * D, (float*)(ws + WS_SUMM));
        phase_pool((const bf16*)(ws + WS_XA), (bf16*)(ws + WS_YA), vcu * NTHR + tid, G * NTHR);
        phase_kmax((const bf16*)(ws + WS_K), (float*)(ws + WS_KPART), gw, NGW, lane);
        GSYNC();
        for (int it = vcu; it < 512; it += G)
            lru_item<true>(lds, it >> 8, (it >> 6) & 3, (it & 256) ? 63 - (it & 63) : (it & 63),
                            (const bf16*)(ws + WS_XL), (bf16*)(ws + WS_GG), tab_in(TB, 12) + (size_t)l * 4 * D, tab_in(TB, 13) + l * D, (const bf16*)(ws + WS_WAT), (const bf16*)(ws + WS_WXT),
                           tab_in(TB, 15) + l * D, tab_in(TB, 17) + l * D, tab_in(TB, 18) + l * D, (float*)(ws + WS_SUMM));
        for (int p = vcu; p < 256; p += G) {
            { const int bh = p & 15, qb = 31 - (p >> 4);
              fox_unit(lds, bh >> 3, bh & 7, qb, (const bf16*)(ws + WS_Q), (const bf16*)(ws + WS_K), (const bf16*)(ws + WS_V), (bf16*)(ws + WS_YC), (const float*)(ws + WS_CTIL) + (size_t)bh * SEQ, (const float*)(ws + WS_KPART), NGW); }
            { const int bh = 15 - (p & 15), qb = p >> 4;
              fox_unit(lds, bh >> 3, bh & 7, qb, (const bf16*)(ws + WS_Q), (const bf16*)(ws + WS_K), (const bf16*)(ws + WS_V), (bf16*)(ws + WS_YC), (const float*)(ws + WS_CTIL) + (size_t)bh * SEQ, (const float*)(ws + WS_KPART), NGW); } }
        GSYNC();
        { pg8::StaticOrder S; S.init(M, D, G, bx); pg8::Unit u;
          bf16* stash = (bf16*)(ws + WS_STASH) + (size_t)bx * 65536; bf16* mg = (bf16*)(ws + WS_MG);
          for (int i = 0; S.next(i, u); ++i) { const pg8::OneUnit O1{u.pm, u.pn};
#pragma unroll 1
              for (int br = 0; br < 3; ++br) {
                  { pg8::Gemm g{XB, (const bf16*)(ws + WS_WG) + (size_t)br * D * D, M, D, D, D, D, 0}; pg8::EpiGate E{stash, tab_in(TB, 8) + (size_t)l * 3 * D + br * D, ss1};
                    pg8::gemm_phase<pg8::EpiGate, pg8::OneUnit, true, true>(lds, g, O1, E); }
                  asm volatile("s_waitcnt vmcnt(0)" ::: "memory"); __syncthreads();
                  const bf16* Ab = br == 0 ? (const bf16*)(ws + WS_YA) : br == 1 ? (const bf16*)(ws + WS_GG) : (const bf16*)(ws + WS_YC);
                  const bf16* Ub = br == 0 ? (const bf16*)(ws + WS_UA) : br == 1 ? (const bf16*)(ws + WS_UB) : (const bf16*)(ws + WS_UC);
                  const int Kb = br == 1 ? 1024 : 512;
                  { pg8::Gemm g{Ab, Ub, M, D, Kb, Kb, Kb, 0}; pg8::EpiMerge E{stash, mg, br == 0 ? 1 : 0};
                    pg8::gemm_phase<pg8::EpiMerge, pg8::OneUnit, true, true>(lds, g, O1, E); }
                  asm volatile("s_waitcnt vmcnt(0)" ::: "memory"); __syncthreads();
              } } }
        GSYNC();
        { pg8::Gemm g{(const bf16*)(ws + WS_MG), (const bf16*)(ws + WS_WO), M, D, D, D, D, 0}; pg8::StaticOrder S; S.init(M, D, G, bx); pg8::Unit u_;
          pg8::EpiResid E{X, XB, ss2, 1.0f};
          for (int i_ = 0; S.next(i_, u_); ++i_) { const pg8::OneUnit O1{u_.pm, u_.pn}; pg8::gemm_phase<pg8::EpiResid, pg8::OneUnit, false, true>(lds, g, O1, E); } }
        GSYNC();
        { bf16* pb = (bf16*)(ws + WS_PBUF) + (size_t)bx * 65536; const pg8::OneUnit O1{0, 0};
          for (int uid = vcu; uid < 256; uid += G) { const int rt = uid >> 2, h = uid & 3, b = rt >> 5;
              int KX = 256; asm volatile("" : "+s"(KX));
              bf16* qo = (bf16*)(ws + WS_QX) + (size_t)rt * 256 * D + h * 256; bf16* qs = (bf16*)(ws + WS_Q) + (size_t)bx * 65536;
              { pg8::Gemm g{XB + (size_t)rt * 256 * D, (const bf16*)(ws + WS_WXQ) + (size_t)h * 256 * D, 256, 256, D, D, D, 0}; pg8::EpiRs E{qs, 256, ss2 + (size_t)rt * 256 * 4, C2X};
                pg8::gemm_phase<pg8::EpiRs, pg8::OneUnit, true, true>(lds, g, O1, E); }
              asm volatile("s_waitcnt vmcnt(0)" ::: "memory"); __syncthreads();
              { pg8::Gemm g{qs, (const bf16*)(ws + WS_KX) + (size_t)b * 256 * D + h * 256, 256, 256, KX, 256, D, 0}; pg8::EpiSoftmaxP E{pb};
                pg8::gemm_phase<pg8::EpiSoftmaxP, pg8::OneUnit, false, true>(lds, g, O1, E); }
              asm volatile("s_waitcnt vmcnt(0)" ::: "memory"); __syncthreads();
              { pg8::Gemm g{pb, (const bf16*)(ws + WS_VT) + (size_t)(b * 4 + h) * 65536, 256, 256, KX, 256, 256, 0}; pg8::EpiRs E{qo, D, nullptr, 1.0f};
                pg8::gemm_phase<pg8::EpiRs, pg8::OneUnit, true, true>(lds, g, O1, E); }
              asm volatile("s_waitcnt vmcnt(0)" ::: "memory"); if (uid + G < 256) __builtin_amdgcn_fence(__ATOMIC_ACQUIRE, "agent"); __syncthreads();
          } }
        GSYNC();
        { pg8::Gemm g{(const bf16*)(ws + WS_QX), (const bf16*)(ws + WS_WXO), M, D, D, D, D, 0}; pg8::StaticOrder S; S.init(M, D, G, bx); pg8::Unit u_;
          pg8::EpiResid E{X, XB, ss3, 1.0f};
          for (int i_ = 0; S.next(i_, u_); ++i_) { const pg8::OneUnit O1{u_.pm, u_.pn}; pg8::gemm_phase<pg8::EpiResid, pg8::OneUnit, false, true>(lds, g, O1, E); } }
        GSYNC();
        { pg8::Gemm g{XB, (const bf16*)(ws + WS_W2IN), M, 2 * DFF, D, D, D, 0}; pg8::StaticOrder S; S.init(M, 2 * DFF, G, bx);
          pg8::EpiSwiglu E{HB, ss3, DFF};
          pg8::gemm_phase<pg8::EpiSwiglu, pg8::StaticOrder, true, true>(lds, g, S, E); }
        GSYNC();
        { pg8::Gemm g{HB, (const bf16*)(ws + WS_W2OUT), M, D, DFF, DFF, DFF, 0}; pg8::StaticOrder S; S.init(M, D, G, bx); pg8::Unit u_;
          pg8::EpiResid E{X, XB, ss4, 0.5f};
          for (int i_ = 0; S.next(i_, u_); ++i_) { const pg8::OneUnit O1{u_.pm, u_.pn}; pg8::gemm_phase<pg8::EpiResid, pg8::OneUnit, false, true>(lds, g, O1, E); } }
        GSYNC();
    }
    phase_final(X, tab_in(TB, 30), gw, NGW, lane);
#undef GSYNC
}

extern "C" void kernel_launch(void* const* d_in, const int* in_sizes, int n_in, void* d_out, int out_size, void* d_ws, size_t ws_size, hipStream_t stream) {
    static int grid = 0;
    if (grid == 0) {
        if (n_in != 31 || out_size != M * D || ws_size < WS_END) { fprintf(stderr, "kernel_launch: unexpected problem (n_in %d, out %d, ws %zu)\n", n_in, out_size, ws_size); grid = -1; return; }
        int dev = 0, cus = 0, per_cu = 0;
        (void)hipGetDevice(&dev); (void)hipDeviceGetAttribute(&cus, hipDeviceAttributeMultiprocessorCount, dev);
        if (hipFuncSetAttribute((const void*)hybrid_fwd, hipFuncAttributeMaxDynamicSharedMemorySize, LDS_BYTES) != hipSuccess) { fprintf(stderr, "kernel_launch: hipFuncSetAttribute failed\n"); grid = -1; return; }
        if (hipOccupancyMaxActiveBlocksPerMultiprocessor(&per_cu, (const void*)hybrid_fwd, NTHR, LDS_BYTES) != hipSuccess || per_cu < 1) per_cu = 1;
        (void)hipGetLastError();
        grid = cus * (per_cu > 1 ? 1 : per_cu);
        if (grid > 256) grid = 256;
    }
    if (grid < 0) return;
    (void)hipMemsetAsync((char*)d_ws + WS_SS, 0, CTL_ZERO_BYTES, stream);
    Args a{};
    for (int i = 0; i < 31; ++i) a.in[i] = (const float*)d_in[i];
    a.out = (float*)d_out; a.ws = (unsigned char*)d_ws;
    void* kargs[] = {&a};
    hipError_t e = hipLaunchCooperativeKernel((const void*)hybrid_fwd, dim3(grid), dim3(NTHR), kargs, LDS_BYTES, stream);
    if (e != hipSuccess) fprintf(stderr, "cooperative launch failed: %s (grid %d)\n", hipGetErrorString(e), grid);
}
```

```cpp
#include <hip/hip_runtime.h>
#include <hip/hip_cooperative_groups.h>
#include <cstdio>
#include <cstdint>
namespace cg = cooperative_groups;
namespace pg8 {
#define PG8_LAS __attribute__((address_space(3)))
typedef unsigned short bf16_t;
typedef short bf16x8 __attribute__((ext_vector_type(8)));
typedef float f32x4 __attribute__((ext_vector_type(4)));
typedef unsigned u32x4 __attribute__((ext_vector_type(4)));
constexpr int BM = 256, BK = 64, HALF = 128, HTB = HALF * BK * 2  , STAGE_BYTES = 8 * HTB, NXCD = 8, WGM = 8;

__host__ __device__ __forceinline__ int lds_byte(int r, int c) { const int st = (r >> 4) * 2 + (c >> 5), rr = r & 15, cc = c & 31, ob = rr * 64 + cc * 2; return st * 1024 + (ob ^ (((ob >> 9) & 1) << 5)); }
__host__ __device__ __forceinline__ void stage_rc(int b, int& R, int& C) { const int st = b / 1024, sb = b % 1024, swz = sb ^ (((sb >> 9) & 1) << 5); R = (st >> 1) * 16 + swz / 64; C = (st & 1) * 32 + (swz % 64) / 2; }
__host__ __device__ __forceinline__ int perm32(int rho) { const int n = rho >> 4, i = rho & 15; return 8 * (i >> 2) + 4 * n + (i & 3); }

struct Unit { int pm, pn; };
struct Gemm { const bf16_t* A; const bf16_t* Bt; int M, N, K, lda, ldb, a_pn_off; };

struct StaticOrder {
    int nM, nN, nwg, G, c;
    __host__ __device__ __forceinline__ void init(int M, int N, int G_, int c_) { nM = M / BM; nN = N / BM; nwg = nM * nN; G = G_; c = c_; }
    __host__ __device__ __forceinline__ bool next(int i, Unit& u) const {
        const long L = (long)i * G + c; if (L >= nwg) return false;
        int wgid = (int)L; { const int q = nwg / NXCD, r = nwg % NXCD, xcd = wgid % NXCD, off = wgid / NXCD; wgid = (xcd < r ? xcd * (q + 1) : r * (q + 1) + (xcd - r) * q) + off; }
        const int nig = WGM * nN, gid = wgid / nig, fm = gid * WGM, gsz = (nM - fm) < WGM ? (nM - fm) : WGM;
        u.pm = fm + ((wgid % nig) % gsz); u.pn = (wgid % nig) / gsz; return true;
    }
    __device__ __forceinline__ void a_ready(const Unit&) const {}
    __device__ __forceinline__ void done(const Unit&) const {}
};

__device__ __forceinline__ unsigned cvt_pk_bf16(float lo, float hi) { unsigned r; asm volatile("v_cvt_pk_bf16_f32 %0, %1, %2" : "=v"(r) : "v"(lo), "v"(hi)); return r; }
__device__ __forceinline__ float bperm(float v, int srclane) { return __int_as_float(__builtin_amdgcn_ds_bpermute(srclane << 2, __float_as_int(v))); }
typedef float f32x2 __attribute__((ext_vector_type(2)));
typedef unsigned u32x2 __attribute__((ext_vector_type(2)));
__device__ __forceinline__ float fsig(float v) { return __builtin_amdgcn_rcpf(1.f + __expf(-v)); }
__device__ __forceinline__ float fsilu(float v) { return v * fsig(v); }
__device__ __forceinline__ float fgelu_tanh(float v) { return v * fsig(1.5957691216057308f * (v + 0.044715f * v * v * v)); }
__device__ __forceinline__ float bf_lo(unsigned w) { return __uint_as_float(w << 16); }
__device__ __forceinline__ float bf_hi(unsigned w) { return __uint_as_float(w & 0xffff0000u); }
__device__ __forceinline__ float rstd_of(const float* ss, int row) { const f32x4 a = *(const f32x4*)(ss + (size_t)row * 4); return rsqrtf(((a[0] + a[1]) + (a[2] + a[3])) * (1.0f / 1024.0f) + 1e-6f); }
__device__ __forceinline__ u32x4 pack8(const f32x4 v0, const f32x4 v1) { u32x4 w; w.x = cvt_pk_bf16(v0[0], v0[1]); w.y = cvt_pk_bf16(v0[2], v0[3]); w.z = cvt_pk_bf16(v1[0], v1[1]); w.w = cvt_pk_bf16(v1[2], v1[3]); return w; }

__device__ __forceinline__ void rstd8(const float* ss, int row0, float sc, float (&rs)[2][4]) {
    f32x4 pa[2][4];
#pragma unroll
    for (int ai = 0; ai < 2; ++ai)
#pragma unroll
        for (int m = 0; m < 4; ++m) pa[ai][m] = *(const f32x4*)(ss + (size_t)(row0 + ai * HALF + m * 16) * 4);
#pragma unroll
    for (int ai = 0; ai < 2; ++ai)
#pragma unroll
        for (int m = 0; m < 4; ++m) { const f32x4 a = pa[ai][m]; rs[ai][m] = rsqrtf(((a[0] + a[1]) + (a[2] + a[3])) * (1.0f / 1024.0f) + 1e-6f) * sc; }
    __builtin_amdgcn_sched_barrier(0);
}

__device__ __forceinline__ u32x4 ld16_sc1(const void* p) { u32x4 v; asm volatile("global_load_dwordx4 %0, %1, off sc1" : "=v"(v) : "v"(p) : "memory"); return v; }
#define PG8_LDWAIT(v) asm volatile("s_waitcnt vmcnt(0)" : "+v"(v))

struct OneUnit { int pm, pn;
    __device__ __forceinline__ bool next(int i, Unit& u) const { if (i) return false; u.pm = pm; u.pn = pn; return true; }
    __device__ __forceinline__ void a_ready(const Unit&) const {}
    __device__ __forceinline__ void done(const Unit&) const {} };

struct EpiSwiglu { static constexpr bool PERM = true, AFTER_DRAIN = false; bf16_t* H; const float* ss; int ldh;
    __device__ __forceinline__ void operator()(const f32x4 (&acc)[2][2][4][2], const Unit& u, int wr, int wc, int fr, int fq) const {
        const int row0 = u.pm * BM + wr * 64 + fr, col0 = u.pn * HALF + wc * 32 + 8 * fq; float rsv[2][4]; rstd8(ss, row0, 1.f, rsv);
#pragma unroll
        for (int ai = 0; ai < 2; ++ai)
#pragma unroll
            for (int m = 0; m < 4; ++m) { const int row = row0 + ai * HALF + m * 16; const float rs = rsv[ai][m];
                f32x4 o0, o1;
#pragma unroll
                for (int i = 0; i < 4; ++i) { o0[i] = fsilu(acc[ai][0][m][0][i] * rs) * (acc[ai][1][m][0][i] * rs); o1[i] = fsilu(acc[ai][0][m][1][i] * rs) * (acc[ai][1][m][1][i] * rs); }
                *(u32x4*)(H + (size_t)row * ldh + col0) = pack8(o0, o1); __builtin_amdgcn_sched_barrier(0); }
    }
};
struct EpiResid { static constexpr bool PERM = false, AFTER_DRAIN = true; float* x; bf16_t* xb; float* ss; float scale;
    __device__ __forceinline__ void fused(f32x4 (&acc)[2][2][4][2], const Unit& u, int wr, int wc, int fr, int fq, PG8_LAS unsigned char* lds, int wid, int lane) const {
        float scl = scale; asm volatile("" : "+v"(scl)); const int row0 = u.pm * BM + wr * 64 + fr, col0 = u.pn * BM + wc * 32 + 4 * fq;
        PG8_LAS float* P = (PG8_LAS float*)lds;
#pragma unroll
        for (int ai = 0; ai < 2; ++ai) { f32x4 xv[4][2][2];
#pragma unroll
            for (int m = 0; m < 4; ++m)
#pragma unroll
                for (int bj = 0; bj < 2; ++bj)
#pragma unroll
                    for (int n = 0; n < 2; ++n) xv[m][bj][n] = *(const f32x4*)(x + (size_t)(row0 + ai * HALF + m * 16) * 1024 + col0 + bj * HALF + n * 16);
            __builtin_amdgcn_sched_barrier(0);
#pragma unroll
            for (int m = 0; m < 4; ++m) { const int row = row0 + ai * HALF + m * 16; float q = 0.f;
#pragma unroll
                for (int bj = 0; bj < 2; ++bj)
#pragma unroll
                    for (int n = 0; n < 2; ++n) { const size_t off = (size_t)row * 1024 + col0 + bj * HALF + n * 16;
                        f32x4 v = xv[m][bj][n] + acc[ai][bj][m][n] * scl; *(f32x4*)(x + off) = v;
                        u32x2 w; w.x = cvt_pk_bf16(v[0], v[1]); w.y = cvt_pk_bf16(v[2], v[3]); *(u32x2*)(xb + off) = w;
                        q += (v[0] * v[0] + v[1] * v[1]) + (v[2] * v[2] + v[3] * v[3]); }
                q += bperm(q, (fr + 16 * fq) ^ 16); q += bperm(q, (fr + 16 * fq) ^ 32);
                if (fq == 0) P[(ai * HALF + wr * 64 + m * 16 + fr) * 4 + wc] = q; }
            __builtin_amdgcn_sched_barrier(0); }
        asm volatile("s_waitcnt lgkmcnt(0)" ::: "memory"); __builtin_amdgcn_s_barrier(); asm volatile("" ::: "memory");
        const int tl = wid * 64 + lane;
        if (tl < 256) { const f32x4 a = *(const PG8_LAS f32x4*)(P + tl * 4); ss[(size_t)(u.pm * BM + tl) * 4 + u.pn] = (a[0] + a[1]) + (a[2] + a[3]); }
        asm volatile("s_waitcnt lgkmcnt(0)" ::: "memory"); __builtin_amdgcn_s_barrier(); asm volatile("" ::: "memory");
    }
};
struct EpiRs { static constexpr bool PERM = true, AFTER_DRAIN = false; bf16_t* O; int ldc; const float* ss; float sc;
    __device__ __forceinline__ void operator()(const f32x4 (&acc)[2][2][4][2], const Unit& u, int wr, int wc, int fr, int fq) const {
        const int row0 = u.pm * BM + wr * 64 + fr, col0 = u.pn * BM + wc * 32 + 8 * fq; float rsv[2][4];
        if (ss) rstd8(ss, row0, sc, rsv); else {
#pragma unroll
            for (int a = 0; a < 2; ++a)
#pragma unroll
                for (int b = 0; b < 4; ++b) rsv[a][b] = sc; }
#pragma unroll
        for (int ai = 0; ai < 2; ++ai)
#pragma unroll
            for (int m = 0; m < 4; ++m) { const int row = row0 + ai * HALF + m * 16; const float rs = rsv[ai][m];
#pragma unroll
                for (int bj = 0; bj < 2; ++bj) *(u32x4*)(O + (size_t)row * ldc + col0 + bj * HALF) = pack8(acc[ai][bj][m][0] * rs, acc[ai][bj][m][1] * rs); }
    }
};
struct EpiWin { static constexpr bool PERM = true, AFTER_DRAIN = false; bf16_t *xa, *xl, *gg, *q, *k, *v; const float* ss; float qscale;
    __device__ __forceinline__ void operator()(const f32x4 (&acc)[2][2][4][2], const Unit& u, int wr, int wc, int fr, int fq) const {
        const int pn = u.pn; bf16_t* dst; int ld, ct; float sc = 1.f; bool act = false;
        if (pn < 2) { dst = xa; ld = 512; ct = pn; } else if (pn < 6) { dst = xl; ld = 1024; ct = pn - 2; } else if (pn < 10) { dst = gg; ld = 1024; ct = pn - 6; act = true; }
        else if (pn < 12) { dst = q; ld = 512; ct = pn - 10; sc = qscale; } else if (pn < 14) { dst = k; ld = 512; ct = pn - 12; } else { dst = v; ld = 512; ct = pn - 14; }
        const int row0 = u.pm * BM + wr * 64 + fr, col0 = ct * BM + wc * 32 + 8 * fq; float rsv[2][4]; rstd8(ss, row0, sc, rsv);
#pragma unroll
        for (int ai = 0; ai < 2; ++ai)
#pragma unroll
            for (int m = 0; m < 4; ++m) { const int row = row0 + ai * HALF + m * 16; const float rs = rsv[ai][m];
#pragma unroll
                for (int bj = 0; bj < 2; ++bj) { f32x4 v0 = acc[ai][bj][m][0] * rs, v1 = acc[ai][bj][m][1] * rs;
                    if (act) {
#pragma unroll
                        for (int i = 0; i < 4; ++i) { v0[i] = fgelu_tanh(v0[i]); v1[i] = fgelu_tanh(v1[i]); } }
                    *(u32x4*)(dst + (size_t)row * ld + col0 + bj * HALF) = pack8(v0, v1); __builtin_amdgcn_sched_barrier(0); } }
    }
};
struct EpiGate { static constexpr bool PERM = true, AFTER_DRAIN = false; bf16_t* stash; const float* bg; const float* ss;
    __device__ __forceinline__ void operator()(const f32x4 (&acc)[2][2][4][2], const Unit& u, int wr, int wc, int fr, int fq) const {
        const int row0 = u.pm * BM + wr * 64 + fr, col0 = u.pn * BM + wc * 32 + 8 * fq; int tid_o = threadIdx.x; asm volatile("" : "+v"(tid_o)); const int tid = tid_o;
        f32x4 bv[2][2];
#pragma unroll
        for (int bj = 0; bj < 2; ++bj)
#pragma unroll
            for (int n = 0; n < 2; ++n) bv[bj][n] = *(const f32x4*)(bg + col0 + bj * HALF + 4 * n);
        float rsv[2][4]; rstd8(ss, row0, 1.f, rsv);
#pragma unroll
        for (int ai = 0; ai < 2; ++ai)
#pragma unroll
            for (int m = 0; m < 4; ++m) { const float rs = rsv[ai][m];
#pragma unroll
                for (int bj = 0; bj < 2; ++bj) { f32x4 v0 = acc[ai][bj][m][0] * rs + bv[bj][0], v1 = acc[ai][bj][m][1] * rs + bv[bj][1];
#pragma unroll
                    for (int i = 0; i < 4; ++i) { v0[i] = fsig(v0[i]); v1[i] = fsig(v1[i]); }
                    *(u32x4*)(stash + ((size_t)((ai * 4 + m) * 2 + bj) * 512 + tid) * 8) = pack8(v0, v1); __builtin_amdgcn_sched_barrier(0); } }
    }
};
struct EpiMerge { static constexpr bool PERM = true, AFTER_DRAIN = false; const bf16_t* stash; bf16_t* mg; int first;
    __device__ __forceinline__ void operator()(const f32x4 (&acc)[2][2][4][2], const Unit& u, int wr, int wc, int fr, int fq) const {
        const int row0 = u.pm * BM + wr * 64 + fr, col0 = u.pn * BM + wc * 32 + 8 * fq; int tid_o = threadIdx.x; asm volatile("" : "+v"(tid_o)); const int tid = tid_o;
#pragma unroll
        for (int ai = 0; ai < 2; ++ai) { u32x4 gw[4][2], ow[4][2];
#pragma unroll
            for (int m = 0; m < 4; ++m)
#pragma unroll
                for (int bj = 0; bj < 2; ++bj) { gw[m][bj] = ld16_sc1(stash + ((size_t)((ai * 4 + m) * 2 + bj) * 512 + tid) * 8);
                    ow[m][bj] = first ? (u32x4){0u, 0u, 0u, 0u} : ld16_sc1(mg + (size_t)(row0 + ai * HALF + m * 16) * 1024 + col0 + bj * HALF); }
#pragma unroll
            for (int m = 0; m < 4; ++m)
#pragma unroll
                for (int bj = 0; bj < 2; ++bj) { PG8_LDWAIT(gw[m][bj]); if (!first) PG8_LDWAIT(ow[m][bj]); }
            __builtin_amdgcn_sched_barrier(0);
#pragma unroll
            for (int m = 0; m < 4; ++m)
#pragma unroll
                for (int bj = 0; bj < 2; ++bj) { const u32x4 g = gw[m][bj], o = ow[m][bj]; f32x4 v0 = acc[ai][bj][m][0], v1 = acc[ai][bj][m][1];
                    v0[0] = v0[0] * bf_lo(g.x) + bf_lo(o.x); v0[1] = v0[1] * bf_hi(g.x) + bf_hi(o.x); v0[2] = v0[2] * bf_lo(g.y) + bf_lo(o.y); v0[3] = v0[3] * bf_hi(g.y) + bf_hi(o.y);
                    v1[0] = v1[0] * bf_lo(g.z) + bf_lo(o.z); v1[1] = v1[1] * bf_hi(g.z) + bf_hi(o.z); v1[2] = v1[2] * bf_lo(g.w) + bf_lo(o.w); v1[3] = v1[3] * bf_hi(g.w) + bf_hi(o.w);
                    *(u32x4*)(mg + (size_t)(row0 + ai * HALF + m * 16) * 1024 + col0 + bj * HALF) = pack8(v0, v1); }
            __builtin_amdgcn_sched_barrier(0); }
    }
};
struct EpiKV { static constexpr bool PERM = true, AFTER_DRAIN = false; bf16_t* kx; bf16_t* vt;
    __device__ __forceinline__ void operator()(const f32x4 (&acc)[2][2][4][2], const Unit& u, int wr, int wc, int fr, int fq) const {
        if (u.pn < 4) { const int row0 = u.pm * BM + wr * 64 + fr, col0 = u.pn * BM + wc * 32 + 8 * fq;
#pragma unroll
            for (int ai = 0; ai < 2; ++ai)
#pragma unroll
                for (int m = 0; m < 4; ++m)
#pragma unroll
                    for (int bj = 0; bj < 2; ++bj) *(u32x4*)(kx + (size_t)(row0 + ai * HALF + m * 16) * 1024 + col0 + bj * HALF) = pack8(acc[ai][bj][m][0], acc[ai][bj][m][1]);
        } else { const int h = u.pn - 4, b = u.pm; bf16_t* base = vt + (size_t)(b * 4 + h) * 65536;
#pragma unroll
            for (int ai = 0; ai < 2; ++ai)
#pragma unroll
                for (int m = 0; m < 4; ++m) { const int mr = ai * HALF + wr * 64 + m * 16 + fr;
#pragma unroll
                    for (int bj = 0; bj < 2; ++bj) { bf16_t* p = base + (size_t)(bj * HALF + wc * 32 + 8 * fq) * 256 + mr; asm volatile("" : "+v"(p));
#pragma unroll
                        for (int n = 0; n < 2; ++n)
#pragma unroll
                            for (int i = 0; i < 4; ++i) p[(4 * n + i) * 256] = (bf16_t)(cvt_pk_bf16(acc[ai][bj][m][n][i], 0.f) & 0xffffu);
                        __builtin_amdgcn_sched_barrier(0); } }
        }
    }
};
struct EpiSoftmaxP { static constexpr bool PERM = true, AFTER_DRAIN = true; bf16_t* P;
    __device__ __forceinline__ void fused(f32x4 (&acc)[2][2][4][2], const Unit& u, int wr, int wc, int fr, int fq, PG8_LAS unsigned char* lds, int wid, int lane) const {
        PG8_LAS f32x2* X = (PG8_LAS f32x2*)lds;
        float mloc[2][4];
#pragma unroll
        for (int ai = 0; ai < 2; ++ai)
#pragma unroll
            for (int m = 0; m < 4; ++m) { float mx = -__builtin_inff();
#pragma unroll
                for (int bj = 0; bj < 2; ++bj)
#pragma unroll
                    for (int n = 0; n < 2; ++n) { const f32x4 v = acc[ai][bj][m][n]; mx = fmaxf(mx, fmaxf(fmaxf(v[0], v[1]), fmaxf(v[2], v[3]))); }
                mx = fmaxf(mx, bperm(mx, (fr + 16 * fq) ^ 16)); mx = fmaxf(mx, bperm(mx, (fr + 16 * fq) ^ 32)); float s = 0.f;
#pragma unroll
                for (int bj = 0; bj < 2; ++bj)
#pragma unroll
                    for (int n = 0; n < 2; ++n) { f32x4 v = acc[ai][bj][m][n];
#pragma unroll
                        for (int i = 0; i < 4; ++i) { v[i] = __builtin_amdgcn_exp2f(v[i] - mx); s += v[i]; }
                        acc[ai][bj][m][n] = v; }
                s += bperm(s, (fr + 16 * fq) ^ 16); s += bperm(s, (fr + 16 * fq) ^ 32); mloc[ai][m] = mx;
                if (fq == 0) X[(ai * HALF + wr * 64 + m * 16 + fr) * 4 + wc] = (f32x2){mx, s}; __builtin_amdgcn_sched_barrier(0); }
        asm volatile("s_waitcnt lgkmcnt(0)" ::: "memory"); __builtin_amdgcn_s_barrier(); asm volatile("" ::: "memory");
#pragma unroll
        for (int ai = 0; ai < 2; ++ai)
#pragma unroll
            for (int m = 0; m < 4; ++m) { const int rl = ai * HALF + wr * 64 + m * 16 + fr;
                const f32x2 a = X[rl * 4 + 0], b = X[rl * 4 + 1], c = X[rl * 4 + 2], d = X[rl * 4 + 3];
                const float M = fmaxf(fmaxf(a.x, b.x), fmaxf(c.x, d.x));
                const float L = a.y * __builtin_amdgcn_exp2f(a.x - M) + b.y * __builtin_amdgcn_exp2f(b.x - M) + c.y * __builtin_amdgcn_exp2f(c.x - M) + d.y * __builtin_amdgcn_exp2f(d.x - M);
                const float f = __builtin_amdgcn_exp2f(mloc[ai][m] - M) / L;
#pragma unroll
                for (int bj = 0; bj < 2; ++bj) *(u32x4*)(P + (size_t)rl * 256 + bj * HALF + wc * 32 + 8 * fq) = pack8(acc[ai][bj][m][0] * f, acc[ai][bj][m][1] * f); __builtin_amdgcn_sched_barrier(0); }
        asm volatile("s_waitcnt vmcnt(0) lgkmcnt(0)" ::: "memory"); __builtin_amdgcn_s_barrier(); asm volatile("" ::: "memory");
    }
};

template <class Epi, class Sched, bool ALIGN_EPI = false, bool SP2 = false>
__device__ __forceinline__ void gemm_phase(PG8_LAS unsigned char* lds, const Gemm g, const Sched& S, const Epi& E) {
    int tid_o = threadIdx.x; asm volatile("" : "+v"(tid_o));
    const int tid = tid_o, wid = __builtin_amdgcn_readfirstlane(tid >> 6), lane = tid & 63, wr = wid >> 2, wc = wid & 3, fr = lane & 15, fq = lane >> 4;
    const int K = g.K, nt = K / BK;
    unsigned voffA[2], voffB[2];
#pragma unroll
    for (int i = 0; i < 2; ++i) { int R, C; stage_rc(tid * 16 + i * 8192, R, C); const int Rb = Epi::PERM ? ((R & ~31) + perm32(R & 31)) : R;
        voffA[i] = (unsigned)(R * g.lda + C) * 2u; voffB[i] = (unsigned)(Rb * g.ldb + C) * 2u; }
    const size_t kstep = (size_t)(BK * 2);
    const size_t hstepA = (size_t)HALF * g.lda * 2, hstepB = (size_t)HALF * g.ldb * 2;
    const size_t tstepA = 2 * hstepA, tstepB = 2 * hstepB;
    const unsigned ldsw = (unsigned)wid * 1024u;
    const int aoff = lds_byte(wr * 64 + fr, fq * 8), boff = lds_byte(wc * 32 + fr, fq * 8);
#define PG8_SA(b, h) (((b) * 2 + (h)) * HTB)
#define PG8_SB(b, h) ((4 + (b) * 2 + (h)) * HTB)
#define PG8_STAGE(bufoff, gbase, voff) do { _Pragma("unroll") for (int _i = 0; _i < 2; ++_i) \
        __builtin_amdgcn_global_load_lds((const unsigned*)((const char*)(gbase) + (voff)[_i]), (PG8_LAS unsigned*)(lds + (bufoff) + ldsw + _i * 8192), 16, 0, 0); } while (0)
#define PG8_LDA(dst, b, h) do { _Pragma("unroll") for (int m = 0; m < 4; ++m) _Pragma("unroll") for (int k = 0; k < 2; ++k) dst[m][k] = *(const PG8_LAS bf16x8*)(lds + PG8_SA(b, h) + aoff + m * 2048 + k * 1024); } while (0)
#define PG8_LDB(dst, b, h) do { _Pragma("unroll") for (int n = 0; n < 2; ++n) _Pragma("unroll") for (int k = 0; k < 2; ++k) dst[n][k] = *(const PG8_LAS bf16x8*)(lds + PG8_SB(b, h) + boff + n * 2048 + k * 1024); } while (0)
#define PG8_MMA(ai, bj, At, Bt) do { __builtin_amdgcn_s_setprio(1); _Pragma("unroll") for (int m = 0; m < 4; ++m) _Pragma("unroll") for (int n = 0; n < 2; ++n) _Pragma("unroll") for (int k = 0; k < 2; ++k) \
        acc[ai][bj][m][n] = __builtin_amdgcn_mfma_f32_16x16x32_bf16(Bt[n][k], At[m][k], acc[ai][bj][m][n], 0, 0, 0); __builtin_amdgcn_s_setprio(0); } while (0)
#define PG8_WAIT_V(n) asm volatile("s_waitcnt vmcnt(" #n ")" ::: "memory")
#define PG8_WAIT_L(n) asm volatile("s_waitcnt lgkmcnt(" #n ")" ::: "memory")
#define PG8_BAR __builtin_amdgcn_s_barrier()
#define PG8_SCHED __builtin_amdgcn_sched_barrier(0)
    Unit cur, nxt; int ui = 0;
    if (!S.next(0, cur)) return;
    f32x4 acc[2][2][4][2];
#pragma unroll
    for (int a = 0; a < 2; ++a)
#pragma unroll
        for (int b = 0; b < 2; ++b)
#pragma unroll
            for (int m = 0; m < 4; ++m)
#pragma unroll
                for (int n = 0; n < 2; ++n) acc[a][b][m][n] = (f32x4){0.f, 0.f, 0.f, 0.f};
    bf16x8 At[4][2], B0[2][2], B1[2][2];
    const char* cA = (const char*)g.A + (size_t)cur.pm * tstepA + (size_t)cur.pn * g.a_pn_off * 2; const char* cB = (const char*)g.Bt + (size_t)cur.pn * tstepB;
    S.a_ready(cur);
    if constexpr (SP2) {
        PG8_STAGE(PG8_SB(0, 0), cB, voffB); PG8_STAGE(PG8_SB(0, 1), cB + hstepB, voffB); PG8_STAGE(PG8_SA(0, 0), cA, voffA); PG8_STAGE(PG8_SA(0, 1), cA + hstepA, voffA);
        if (wr == 1) PG8_BAR;
        PG8_WAIT_V(2); PG8_BAR;
        PG8_STAGE(PG8_SB(1, 0), cB + kstep, voffB); PG8_STAGE(PG8_SA(1, 0), cA + kstep, voffA); PG8_STAGE(PG8_SB(1, 1), cB + hstepB + kstep, voffB);
        PG8_WAIT_V(6); PG8_BAR;
    } else {
        PG8_STAGE(PG8_SB(0, 0), cB, voffB); PG8_STAGE(PG8_SA(0, 0), cA, voffA); PG8_STAGE(PG8_SB(0, 1), cB + hstepB, voffB); PG8_STAGE(PG8_SA(0, 1), cA + hstepA, voffA);
        if (wr == 1) PG8_BAR;
        PG8_WAIT_V(4); PG8_BAR;
        PG8_STAGE(PG8_SB(1, 0), cB + kstep, voffB); PG8_STAGE(PG8_SA(1, 0), cA + kstep, voffA); PG8_STAGE(PG8_SB(1, 1), cB + hstepB + kstep, voffB);
        PG8_WAIT_V(6); PG8_BAR;
    }
    for (;;) {
        const bool has_next = S.next(ui + 1, nxt);
        const char* nA = has_next ? (const char*)g.A + (size_t)nxt.pm * tstepA + (size_t)nxt.pn * g.a_pn_off * 2 : cA; const char* nB = has_next ? (const char*)g.Bt + (size_t)nxt.pn * tstepB : cB;
        for (int t = 0; t < nt; t += 2) {
            const bool last = (t == nt - 2);
            const char* a1 = cA + (size_t)(t + 1) * kstep;
            const char* a2 = last ? nA : cA + (size_t)(t + 2) * kstep; const char* b2 = last ? nB : cB + (size_t)(t + 2) * kstep;
            const char* a3 = a2 + kstep; const char* b3 = b2 + kstep;
            if (last && has_next) S.a_ready(nxt);
            if constexpr (SP2) {
            PG8_LDB(B0, 0, 0); PG8_LDB(B1, 0, 1); PG8_SCHED; PG8_LDA(At, 0, 0); PG8_STAGE(PG8_SA(1, 1), a1 + hstepA, voffA);
            PG8_WAIT_V(8); PG8_WAIT_L(0); PG8_BAR; PG8_MMA(0, 0, At, B0); PG8_MMA(0, 1, At, B1); PG8_BAR; PG8_SCHED;
            PG8_LDA(At, 0, 1); PG8_STAGE(PG8_SB(0, 0), b2, voffB); PG8_STAGE(PG8_SB(0, 1), b2 + hstepB, voffB); PG8_STAGE(PG8_SA(0, 0), a2, voffA);
            PG8_WAIT_V(8); PG8_WAIT_L(0); PG8_BAR; PG8_MMA(1, 0, At, B0); PG8_MMA(1, 1, At, B1); PG8_BAR; PG8_SCHED;
            PG8_LDB(B0, 1, 0); PG8_LDB(B1, 1, 1); PG8_SCHED; PG8_LDA(At, 1, 0); PG8_STAGE(PG8_SA(0, 1), a2 + hstepA, voffA);
            PG8_WAIT_V(8); PG8_WAIT_L(0); PG8_BAR; PG8_MMA(0, 0, At, B0); PG8_MMA(0, 1, At, B1); PG8_BAR; PG8_SCHED;
            PG8_LDA(At, 1, 1); PG8_STAGE(PG8_SB(1, 0), b3, voffB); PG8_STAGE(PG8_SB(1, 1), b3 + hstepB, voffB); PG8_STAGE(PG8_SA(1, 0), a3, voffA);
            PG8_WAIT_V(8); PG8_WAIT_L(0); PG8_BAR; PG8_MMA(1, 0, At, B0); PG8_MMA(1, 1, At, B1); PG8_BAR; PG8_SCHED;
            } else {
            PG8_LDB(B0, 0, 0); PG8_SCHED; PG8_LDA(At, 0, 0); PG8_STAGE(PG8_SA(1, 1), a1 + hstepA, voffA);
            PG8_WAIT_L(8); PG8_BAR; PG8_WAIT_L(0); PG8_MMA(0, 0, At, B0); PG8_BAR; PG8_SCHED;
            PG8_LDB(B1, 0, 1); PG8_STAGE(PG8_SB(0, 0), b2, voffB);
            PG8_BAR; PG8_WAIT_L(0); PG8_MMA(0, 1, At, B1); PG8_BAR;
            PG8_LDA(At, 0, 1); PG8_STAGE(PG8_SA(0, 0), a2, voffA);
            PG8_BAR; PG8_WAIT_L(0); PG8_MMA(1, 0, At, B0); PG8_BAR; PG8_SCHED;
            PG8_STAGE(PG8_SB(0, 1), b2 + hstepB, voffB);
            PG8_WAIT_V(6); PG8_BAR; PG8_MMA(1, 1, At, B1); PG8_BAR;
            PG8_LDB(B0, 1, 0); PG8_SCHED; PG8_LDA(At, 1, 0); PG8_STAGE(PG8_SA(0, 1), a2 + hstepA, voffA);
            PG8_WAIT_L(8); PG8_BAR; PG8_WAIT_L(0); PG8_MMA(0, 0, At, B0); PG8_BAR; PG8_SCHED;
            PG8_LDB(B1, 1, 1); PG8_STAGE(PG8_SB(1, 0), b3, voffB);
            PG8_BAR; PG8_WAIT_L(0); PG8_MMA(0, 1, At, B1); PG8_BAR;
            PG8_LDA(At, 1, 1); PG8_STAGE(PG8_SA(1, 0), a3, voffA);
            PG8_BAR; PG8_WAIT_L(0); PG8_MMA(1, 0, At, B0); PG8_BAR; PG8_SCHED;
            PG8_STAGE(PG8_SB(1, 1), b3 + hstepB, voffB);
            PG8_WAIT_V(6); PG8_BAR; PG8_MMA(1, 1, At, B1); PG8_BAR;
            }
        }
        if constexpr (ALIGN_EPI) { if (wr == 0) PG8_BAR; }
        if constexpr (!Epi::AFTER_DRAIN) { E(acc, cur, wr, wc, fr, fq); S.done(cur); }
        if (!has_next) break;
#pragma unroll
        for (int a = 0; a < 2; ++a)
#pragma unroll
            for (int b = 0; b < 2; ++b)
#pragma unroll
                for (int m = 0; m < 4; ++m)
#pragma unroll
                    for (int n = 0; n < 2; ++n) acc[a][b][m][n] = (f32x4){0.f, 0.f, 0.f, 0.f};
        cur = nxt; cA = nA; cB = nB; ++ui;
        if constexpr (ALIGN_EPI) { if (wr == 1) PG8_BAR; }
    }
    PG8_WAIT_V(0);
    if constexpr (!ALIGN_EPI) { if (wr == 0) PG8_BAR; }
    PG8_BAR;
    if constexpr (Epi::AFTER_DRAIN) { E.fused(acc, cur, wr, wc, fr, fq, lds, wid, lane); S.done(cur); }
#undef PG8_SA
#undef PG8_SB
#undef PG8_STAGE
#undef PG8_LDA
#undef PG8_LDB
#undef PG8_MMA
#undef PG8_WAIT_V
#undef PG8_WAIT_L
#undef PG8_BAR
#undef PG8_SCHED
}
}
#include <hip/hip_bf16.h>
#include <cmath>
#define GAS __attribute__((address_space(1)))
#define LAS __attribute__((address_space(3)))
typedef unsigned short bf16;
typedef unsigned v4u __attribute__((ext_vector_type(4)));
typedef float f32x4 __attribute__((ext_vector_type(4)));
typedef short bf16x8 __attribute__((ext_vector_type(8)));
typedef float f32x16 __attribute__((ext_vector_type(16)));

constexpr int NWAVES = 8, NTHR = 512;
constexpr int BATCH = 2, SEQ = 8192, D = 1024, M = BATCH * SEQ, DFF = 2816, DEPTH = 2;
constexpr int INW = 7176;
constexpr size_t MiB = 1u << 20;
constexpr size_t WS_SS = 0, CTL_ZERO_BYTES = 1 * MiB;
constexpr size_t WS_WFL = 1 * MiB;
constexpr size_t WS_WAT = 1 * MiB + 256 * 1024, WS_WXT = 1 * MiB + 512 * 1024;
constexpr size_t WS_SUMM = 2 * MiB;
constexpr size_t WS_LOGF = 3 * MiB, WS_CTIL = 3 * MiB + 512 * 1024;
constexpr size_t WS_KPART = 7 * MiB;
constexpr size_t WS_MEMN = 4 * MiB, WS_KX = 5 * MiB, WS_VT = 6 * MiB;
constexpr size_t WS_W1IN = 8 * MiB, WS_W1OUT = 19 * MiB, WS_WIN = 25 * MiB, WS_WG = 33 * MiB, WS_UA = 39 * MiB, WS_UB = 40 * MiB, WS_UC = 42 * MiB,
                 WS_WO = 43 * MiB, WS_WXQ = 45 * MiB, WS_WXKV = 47 * MiB, WS_WXO = 51 * MiB, WS_W2IN = 53 * MiB, WS_W2OUT = 64 * MiB;
constexpr size_t WS_XB = 70 * MiB;
constexpr size_t WS_Q = 102 * MiB, WS_GG = 118 * MiB, WS_XA = 150 * MiB, WS_XL = 166 * MiB, WS_K = 198 * MiB, WS_V = 214 * MiB;
constexpr size_t WS_H = 102 * MiB;
constexpr size_t WS_YC = 150 * MiB;
constexpr size_t WS_STASH = 166 * MiB, WS_MG = 198 * MiB, WS_QX = 150 * MiB, WS_PBUF = 198 * MiB;
constexpr size_t WS_YA = 230 * MiB, WS_SSP = 246 * MiB, WS_END = 255 * MiB;
constexpr int LDS_BYTES = 147456;

__device__ __forceinline__ unsigned f2bf(float f) { unsigned u = __builtin_bit_cast(unsigned, f); return (u + 0x7fffu + ((u >> 16) & 1u)) >> 16; }
__device__ __forceinline__ unsigned pk2(float lo, float hi) { return f2bf(lo) | (f2bf(hi) << 16); }
__device__ __forceinline__ float bf2f(unsigned short v) { return __uint_as_float((unsigned)v << 16); }
__device__ __forceinline__ float bperm(float v, int srclane) { return __int_as_float(__builtin_amdgcn_ds_bpermute(srclane << 2, __float_as_int(v))); }
__device__ __forceinline__ float wave_sum(float v, int lane) {
#pragma unroll
    for (int o = 1; o < 64; o <<= 1) v += bperm(v, lane ^ o);
    return v;
}
__device__ __forceinline__ float flog1p(float e) { return e < 0.01f ? e * (1.f - e * (0.5f - e * 0.33333334f)) : __logf(1.f + e); }
#define LDS_WAIT() asm volatile("s_waitcnt lgkmcnt(0)" ::: "memory")

__device__ __forceinline__ void tr_item(const float* W, int ldn, int col0, int k0, const float* g, bf16* WT, int ldk, int drow0, LAS float* scr, int lane) {
    const int n4 = (lane & 15) * 4, kr = lane >> 4;
#pragma unroll
    for (int i = 0; i < 16; ++i) { const int kk = 4 * i + kr; f32x4 v = *(const f32x4*)(W + (size_t)(k0 + kk) * ldn + col0 + n4); if (g) v = v * g[k0 + kk];
        LAS float* d = scr + kk * 65 + n4; d[0] = v.x; d[1] = v.y; d[2] = v.z; d[3] = v.w; }
    LDS_WAIT(); asm volatile("" ::: "memory");
    const int c = lane & 7;
#pragma unroll
    for (int j = 0; j < 8; ++j) { const int n = (lane >> 3) + 8 * j; const LAS float* s = scr + (8 * c) * 65 + n;
        v4u o; o.x = pk2(s[0 * 65], s[1 * 65]); o.y = pk2(s[2 * 65], s[3 * 65]); o.z = pk2(s[4 * 65], s[5 * 65]); o.w = pk2(s[6 * 65], s[7 * 65]);
        *(v4u*)(WT + (size_t)(drow0 + n) * ldk + k0 + 8 * c) = o; }
    LDS_WAIT(); asm volatile("" ::: "memory");
}

#define RLX_AGENT __ATOMIC_RELAXED, __HIP_MEMORY_SCOPE_AGENT
#define XB_TMO      128
#define XB_XCNT(j)  (256  + 64 * (j))
#define XB_XSUB(j)  (1280 + 64 * (j))
#define XB_XGEN(j)  (2304 + 64 * (j))
#define XB_TOP      3328
#define XB_TOPGEN   3392
#define XCD_BAR_WORDS 3456
#define XB_SPIN_CAP (1u << 18)

__device__ __forceinline__ unsigned xb_ld(unsigned* p)              { return __hip_atomic_load(p, __ATOMIC_RELAXED, __HIP_MEMORY_SCOPE_AGENT); }
__device__ __forceinline__ unsigned xb_add(unsigned* p, unsigned v) { return __hip_atomic_fetch_add(p, v, __ATOMIC_RELAXED, __HIP_MEMORY_SCOPE_AGENT); }
__device__ __forceinline__ unsigned xb_xcc_id() { return (unsigned)__builtin_amdgcn_s_getreg((3 << 11) | 20) & 0xFu; }
#define XB_SPIN(cond, bar) do { unsigned _sp = 0; while (cond) { __builtin_amdgcn_s_sleep(1); \
    if ((++_sp & 255u) == 0u) { if (xb_ld(&(bar)[XB_TMO])) break; if (_sp > XB_SPIN_CAP) { atomicAdd(&(bar)[XB_TMO], 1u); break; } } } } while (0)

struct XcdBarrier {
    unsigned* bar; unsigned x;
    volatile LAS unsigned* st;
};

__device__ __forceinline__ XcdBarrier xcd_barrier_post(unsigned* bar, volatile LAS unsigned* st) {
    XcdBarrier b; b.bar = bar; b.x = xb_xcc_id(); b.st = st;
    if (threadIdx.x == 0) (void)xb_add(&bar[XB_XCNT(b.x)], 1u);
    return b;
}
__device__ __forceinline__ void xcd_barrier_complete(unsigned* bar, unsigned x, unsigned& nloc, unsigned& nx) {
    const unsigned G = gridDim.x * gridDim.y * gridDim.z;
    unsigned sum, cnt, mine, sp = 0u;
    for (;;) {
        sum = 0u; cnt = 0u; mine = 0u;
#pragma unroll
        for (unsigned j = 0; j < 16; ++j) { const unsigned c = xb_ld(&bar[XB_XCNT(j)]); sum += c; cnt += (c > 0u) ? 1u : 0u; mine = (j == x) ? c : mine; }
        if (sum == G) break;
        __builtin_amdgcn_s_sleep(1);
        if ((++sp & 255u) == 0u) { if (xb_ld(&bar[XB_TMO])) break; if (sp > XB_SPIN_CAP) { atomicAdd(&bar[XB_TMO], 1u); break; } }
    }
    nloc = mine > 0u ? mine : 1u; nx = cnt > 0u ? cnt : 1u;
}

__device__ __forceinline__ void xcd_barrier(const XcdBarrier& b) {
    asm volatile("s_waitcnt vmcnt(0)" ::: "memory");
    __syncthreads();
    if (threadIdx.x == 0) {
        unsigned* bar = b.bar;
        __builtin_amdgcn_s_waitcnt(0);
        unsigned nloc = b.st[0], nx = b.st[1];
        if (nloc == 0u) { xcd_barrier_complete(bar, b.x, nloc, nx); b.st[0] = nloc; b.st[1] = nx; }
        const unsigned old = xb_add(&bar[XB_XSUB(b.x)], 1u);
        const unsigned gen = old / nloc;
        if (old + 1u == (gen + 1u) * nloc) {
            __builtin_amdgcn_fence(__ATOMIC_RELEASE, "agent");
            asm volatile("s_waitcnt vmcnt(0)" ::: "memory");
            const unsigned og = xb_add(&bar[XB_TOP], 1u);
            const unsigned tg = og / nx;
            if (og + 1u == (tg + 1u) * nx) xb_add(&bar[XB_TOPGEN], 1u);
            else XB_SPIN(xb_ld(&bar[XB_TOPGEN]) == tg, bar);
            __builtin_amdgcn_fence(__ATOMIC_ACQUIRE, "agent");
            xb_add(&bar[XB_XGEN(b.x)], 1u);
            asm volatile("s_waitcnt vmcnt(0)" ::: "memory");
        } else {
            XB_SPIN(xb_ld(&bar[XB_XGEN(b.x)]) == gen, bar);
            __builtin_amdgcn_fence(__ATOMIC_ACQUIRE, "agent");
            asm volatile("s_waitcnt vmcnt(0)" ::: "memory");
        }
    }
    __syncthreads();
}

struct Args { const float* in[31]; float* out; unsigned char* ws; int pad[2]; };
typedef LAS unsigned long long* PtrTab;
__device__ __forceinline__ const float* tab_in(PtrTab tb, int k) { const unsigned long long v = tb[k]; const unsigned lo = __builtin_amdgcn_readfirstlane((unsigned)v), hi = __builtin_amdgcn_readfirstlane((unsigned)(v >> 32));
    return (const float*)(const GAS float*)(((unsigned long long)hi << 32) | lo); }
constexpr int TAB_OFF = 147456 - 512;
constexpr size_t WS_BAR = 768 * 1024; constexpr size_t WS_QCTR = 832 * 1024;

__device__ __forceinline__ void phase_prologue(PtrTab TB, unsigned char* ws, float* xout, int l, LAS unsigned char* lds, int gw, int NGW, int lane, int wave) {
    LAS float* scr = (LAS float*)(lds + wave * 16640);
#define g1 (tab_in(TB, 2) + l * D)
#define w1i (tab_in(TB, 3) + (size_t)l * D * 2 * DFF)
#define w1o (tab_in(TB, 4) + (size_t)l * DFF * D)
#define gm (tab_in(TB, 5) + l * D)
#define win (tab_in(TB, 6) + (size_t)l * D * INW)
#define wpool (tab_in(TB, 9) + (size_t)l * 4 * 128 * 128)
#define psc (tab_in(TB, 10) + l * 512)
#define wua (tab_in(TB, 11) + (size_t)l * 512 * D)
#define wra (tab_in(TB, 14) + (size_t)l * 8 * 128 * 128)
#define wrx (tab_in(TB, 16) + (size_t)l * 8 * 128 * 128)
#define wub (tab_in(TB, 19) + (size_t)l * D * D)
#define wuc (tab_in(TB, 20) + (size_t)l * 512 * D)
#define wo (tab_in(TB, 21) + (size_t)l * D * D)
#define gc (tab_in(TB, 22) + l * D)
#define gmem (tab_in(TB, 23) + l * D)
#define wxq (tab_in(TB, 24) + (size_t)l * D * D)
#define wxkv (tab_in(TB, 25) + (size_t)l * D * 2 * D)
#define wxo (tab_in(TB, 26) + (size_t)l * D * D)
#define g2 (tab_in(TB, 27) + l * D)
#define w2i (tab_in(TB, 28) + (size_t)l * D * 2 * DFF)
#define w2o (tab_in(TB, 29) + (size_t)l * DFF * D)
    constexpr int I_FI = 16 * 88, I_FO = 44 * 16, I_WIN = 16 * 64, I_WG = 16 * 48, I_UB = 16 * 16, I_UC = 8 * 16, I_RG = 32, I_SQ = 16 * 16, I_KV = 16 * 32;
    constexpr int S0 = 0, S1 = S0 + I_FI, S2 = S1 + I_FO, S3 = S2 + I_WIN, S4 = S3 + I_WG, S5 = S4 + I_UB, S6 = S5 + I_UC, S7 = S6 + I_RG, S8 = S7 + I_RG, S9 = S8 + I_SQ, S10 = S9 + I_SQ,
                  S11 = S10 + I_KV, S12 = S11 + I_SQ, S13 = S12 + I_FI, S14 = S13 + I_FO;
    for (int it = gw; it < S14; it += NGW) {
        if (it < S1 || (it >= S12 && it < S13)) {
            const bool second = it >= S12; const int r = second ? it - S12 : it; const int kb = r / 88, nb = r % 88; const int n = nb * 64;
            const int half = n >= DFF ? 1 : 0, nn = n - half * DFF; const int drow = (nn >> 7) * 256 + half * 128 + (nn & 127);
            tr_item(second ? w2i : w1i, 2 * DFF, n, kb * 64, second ? g2 : g1, (bf16*)(ws + (second ? WS_W2IN : WS_W1IN)), D, drow, scr, lane);
        } else if (it < S2 || it >= S13) {
            const bool second = it >= S13; const int r = second ? it - S13 : it - S1; const int kb = r / 16, nb = r % 16;
            tr_item(second ? w2o : w1o, D, nb * 64, kb * 64, nullptr, (bf16*)(ws + (second ? WS_W2OUT : WS_W1OUT)), DFF, nb * 64, scr, lane);
        } else if (it < S3) { const int r = it - S2, kb = r / 64, nb = r % 64; tr_item(win, INW, nb * 64, kb * 64, gm, (bf16*)(ws + WS_WIN), D, nb * 64, scr, lane);
        } else if (it < S4) { const int r = it - S3, kb = r / 48, nb = r % 48; tr_item(win, INW, 4104 + nb * 64, kb * 64, gm, (bf16*)(ws + WS_WG), D, nb * 64, scr, lane);
        } else if (it < S5) { const int r = it - S4, kb = r / 16, nb = r % 16; tr_item(wub, D, nb * 64, kb * 64, nullptr, (bf16*)(ws + WS_UB), D, nb * 64, scr, lane);
        } else if (it < S6) { const int r = it - S5, kb = r / 16, nb = r % 16; tr_item(wuc, D, nb * 64, kb * 64, nullptr, (bf16*)(ws + WS_UC), 512, nb * 64, scr, lane);
        } else if (it < S8) { const bool xg = it >= S7; const int r = xg ? it - S7 : it - S6; const int hh = r >> 2, kb = (r >> 1) & 1, nb = r & 1;
            tr_item((xg ? wrx : wra) + hh * 16384, 128, nb * 64, kb * 64, nullptr, (bf16*)(ws + (xg ? WS_WXT : WS_WAT)) + hh * 16384, 128, nb * 64, scr, lane);
        } else if (it < S9) { const int r = it - S8, kb = r / 16, nb = r % 16; tr_item(wo, D, nb * 64, kb * 64, nullptr, (bf16*)(ws + WS_WO), D, nb * 64, scr, lane);
        } else if (it < S10) { const int r = it - S9, kb = r / 16, nb = r % 16; tr_item(wxq, D, nb * 64, kb * 64, gc, (bf16*)(ws + WS_WXQ), D, nb * 64, scr, lane);
        } else if (it < S11) { const int r = it - S10, kb = r / 32, nb = r % 32; tr_item(wxkv, 2 * D, nb * 64, kb * 64, nullptr, (bf16*)(ws + WS_WXKV), D, nb * 64, scr, lane);
        } else { const int r = it - S11, kb = r / 16, nb = r % 16; tr_item(wxo, D, nb * 64, kb * 64, nullptr, (bf16*)(ws + WS_WXO), D, nb * 64, scr, lane); }
    }
    { bf16* UaT = (bf16*)(ws + WS_UA);
      for (int it = gw; it < 4 * 16 * 16; it += NGW) { const int g = it >> 8, nblk = (it >> 4) & 15, c0 = (it & 15) * 8, n = nblk * 64 + lane;
          const float* wp = wpool + ((size_t)g * 128 + c0) * 128; const float* sc = psc + g * 128; const float* ua = wua + (size_t)(g * 128) * D + n; float acc[8];
#pragma unroll
          for (int c = 0; c < 8; ++c) acc[c] = 0.f;
#pragma unroll 16
          for (int j = 0; j < 128; ++j) { const float u = ua[(size_t)j * D] * sc[j];
#pragma unroll
              for (int c = 0; c < 8; ++c) acc[c] += wp[c * 128 + j] * u; }
          v4u o; o.x = pk2(acc[0], acc[1]); o.y = pk2(acc[2], acc[3]); o.z = pk2(acc[4], acc[5]); o.w = pk2(acc[6], acc[7]);
          *(v4u*)(UaT + (size_t)n * 512 + g * 128 + c0) = o; } }
    { float* wfl = (float*)(ws + WS_WFL);
      for (int it = gw * 64 + lane; it < 8 * 1024; it += NGW * 64) { const int h = it >> 10, k = it & 1023; wfl[it] = gm[k] * win[(size_t)k * INW + 4096 + h]; } }
    { const float* mem = tab_in(TB, 1); bf16* mn = (bf16*)(ws + WS_MEMN);
      for (int r = gw; r < 512; r += NGW) { const f32x4* xr = (const f32x4*)(mem + (size_t)r * D) + lane; f32x4 v[4]; float s = 0.f;
#pragma unroll
          for (int j = 0; j < 4; ++j) { v[j] = xr[64 * j]; s += (v[j].x * v[j].x + v[j].y * v[j].y) + (v[j].z * v[j].z + v[j].w * v[j].w); }
          const float rs = rsqrtf(wave_sum(s, lane) * (1.f / D) + 1e-6f); unsigned long long* o8 = (unsigned long long*)(mn + (size_t)r * D) + lane;
#pragma unroll
          for (int j = 0; j < 4; ++j) { const f32x4 gv = *((const f32x4*)gmem + lane + 64 * j);
              o8[64 * j] = (unsigned long long)pk2(v[j].x * rs * gv.x, v[j].y * rs * gv.y) | ((unsigned long long)pk2(v[j].z * rs * gv.z, v[j].w * rs * gv.w) << 32); } } }
    if (l == 0) {
        const float* x = tab_in(TB, 0); float* xo = xout; bf16* xb = (bf16*)(ws + WS_XB); float* ss = (float*)(ws + WS_SSP);
        for (int r0 = gw; r0 < M; r0 += 4 * NGW) { f32x4 v[4][4]; float s[4];
#pragma unroll
            for (int q = 0; q < 4; ++q) { const int r = (r0 + q * NGW < M) ? r0 + q * NGW : r0; const f32x4* xr = (const f32x4*)(x + (size_t)r * D) + lane; s[q] = 0.f;
#pragma unroll
                for (int j = 0; j < 4; ++j) { v[q][j] = xr[64 * j]; s[q] += (v[q][j].x * v[q][j].x + v[q][j].y * v[q][j].y) + (v[q][j].z * v[q][j].z + v[q][j].w * v[q][j].w); } }
#pragma unroll
            for (int o = 1; o < 64; o <<= 1) {
#pragma unroll
                for (int q = 0; q < 4; ++q) s[q] += bperm(s[q], lane ^ o); }
#pragma unroll
            for (int q = 0; q < 4; ++q) { const int r = r0 + q * NGW; if (r < M) { f32x4* orow = (f32x4*)(xo + (size_t)r * D) + lane; unsigned long long* o8 = (unsigned long long*)(xb + (size_t)r * D) + lane;
                    if (lane < 4) ss[(size_t)r * 4 + lane] = lane == 0 ? s[q] : 0.f;
#pragma unroll
                    for (int j = 0; j < 4; ++j) { orow[64 * j] = v[q][j]; o8[64 * j] = (unsigned long long)pk2(v[q][j].x, v[q][j].y) | ((unsigned long long)pk2(v[q][j].z, v[q][j].w) << 32); } } }
        }
    }
}
#undef g1
#undef w1i
#undef w1o
#undef gm
#undef win
#undef wpool
#undef psc
#undef wua
#undef wra
#undef wrx
#undef wub
#undef wuc
#undef wo
#undef gc
#undef gmem
#undef wxq
#undef wxkv
#undef wxo
#undef g2
#undef w2i
#undef w2o
__device__ __forceinline__ void phase_fl(const bf16* xb, const float* wfl, const float* bfv, const float* ss, float* logf, int gw, int NGW, int lane) {
    for (int r0 = gw; r0 < M; r0 += 4 * NGW) {
        float acc[4][8]; v4u xv[4][2];
#pragma unroll
        for (int q = 0; q < 4; ++q) { const int r = r0 + q * NGW; const bool ok = r < M;
#pragma unroll
            for (int j = 0; j < 2; ++j) xv[q][j] = ok ? *(const v4u*)(xb + (size_t)r * D + 8 * lane + 512 * j) : (v4u){0u, 0u, 0u, 0u};
#pragma unroll
            for (int h = 0; h < 8; ++h) acc[q][h] = 0.f; }
#pragma unroll
        for (int j = 0; j < 2; ++j) { const int k0 = 8 * lane + 512 * j;
#pragma unroll
            for (int h = 0; h < 8; ++h) { const f32x4 w0 = *(const f32x4*)(wfl + h * 1024 + k0), w1 = *(const f32x4*)(wfl + h * 1024 + k0 + 4);
#pragma unroll
                for (int q = 0; q < 4; ++q) { const v4u x = xv[q][j];
                    acc[q][h] += (__uint_as_float(x.x << 16) * w0.x + __uint_as_float(x.x & 0xffff0000u) * w0.y) + (__uint_as_float(x.y << 16) * w0.z + __uint_as_float(x.y & 0xffff0000u) * w0.w)
                               + (__uint_as_float(x.z << 16) * w1.x + __uint_as_float(x.z & 0xffff0000u) * w1.y) + (__uint_as_float(x.w << 16) * w1.z + __uint_as_float(x.w & 0xffff0000u) * w1.w); } } }
        const int h = ((lane >> 5) & 1) * 4 + ((lane >> 4) & 1) * 2 + ((lane >> 3) & 1); const float bh_ = bfv[h];
#pragma unroll
        for (int q = 0; q < 4; ++q) { const int r = r0 + q * NGW;
            float v4[4], v2[2], v1;
            { const bool up = (lane & 32) != 0;
#pragma unroll
              for (int i = 0; i < 4; ++i) { const float mine = up ? acc[q][4 + i] : acc[q][i], other = up ? acc[q][i] : acc[q][4 + i]; v4[i] = mine + bperm(other, lane ^ 32); } }
            { const bool up = (lane & 16) != 0;
#pragma unroll
              for (int i = 0; i < 2; ++i) { const float mine = up ? v4[2 + i] : v4[i], other = up ? v4[i] : v4[2 + i]; v2[i] = mine + bperm(other, lane ^ 16); } }
            { const bool up = (lane & 8) != 0; const float mine = up ? v2[1] : v2[0], other = up ? v2[0] : v2[1]; v1 = mine + bperm(other, lane ^ 8); }
            v1 += bperm(v1, lane ^ 4); v1 += bperm(v1, lane ^ 2); v1 += bperm(v1, lane ^ 1);
            if (r < M) { const float z = v1 * pg8::rstd_of(ss, r) + bh_; const float ls = -(fmaxf(-z, 0.f) + flog1p(__expf(-fabsf(z)))); if ((lane & 7) == 0) logf[(size_t)r * 8 + h] = ls; } }
    }
}
__device__ __forceinline__ void cumsum_bh(const float* logf, float* ctil, int bh, LAS float* red) {
    int tid_o = threadIdx.x; asm volatile("" : "+v"(tid_o)); const int tid = tid_o, lane = tid & 63, wid = tid >> 6;
    const int b = bh >> 3, h = bh & 7; const float* src = logf + ((size_t)b * SEQ + 16 * tid) * 8 + h; float v[16]; float s = 0.f;
#pragma unroll
    for (int i = 0; i < 16; ++i) { v[i] = src[(size_t)i * 8]; s += v[i]; }
    float incl = s;
#pragma unroll
    for (int o = 1; o < 64; o <<= 1) { const float t = bperm(incl, lane - o); if (lane >= o) incl += t; }
    if (lane == 63) red[wid] = incl;
    __syncthreads();
    float base = 0.f;
#pragma unroll
    for (int w = 0; w < 8; ++w) if (w < wid) base += red[w];
    float run = base + incl - s; float* dst = ctil + (size_t)bh * SEQ + 16 * tid;
#pragma unroll
    for (int i = 0; i < 16; ++i) { run += v[i]; dst[i] = run * 1.4426950408889634f; }
    __syncthreads();
}
__device__ __forceinline__ void unpk8(const v4u xv, float (&xf)[8]) { xf[0] = __uint_as_float(xv.x << 16); xf[1] = __uint_as_float(xv.x & 0xffff0000u); xf[2] = __uint_as_float(xv.y << 16); xf[3] = __uint_as_float(xv.y & 0xffff0000u);
    xf[4] = __uint_as_float(xv.z << 16); xf[5] = __uint_as_float(xv.z & 0xffff0000u); xf[6] = __uint_as_float(xv.w << 16); xf[7] = __uint_as_float(xv.w & 0xffff0000u); }
template <int W> __device__ __forceinline__ void pool_item(const bf16* xa, bf16* ya, int m0, int cgi) {
    const int t0 = m0 & (SEQ - 1); v4u rw[W + 7];
#pragma unroll
    for (int a = 0; a < W + 7; ++a) { const int tl = a - (W - 1); rw[a] = (t0 + tl >= 0) ? *(const v4u*)(xa + (size_t)(m0 + tl) * 512 + 8 * cgi) : (v4u){0u, 0u, 0u, 0u}; }
    float s[8];
#pragma unroll
    for (int i = 0; i < 8; ++i) s[i] = 0.f;
#pragma unroll
    for (int a = 0; a < W - 1; ++a) { float xf[8]; unpk8(rw[a], xf);
#pragma unroll
        for (int i = 0; i < 8; ++i) s[i] += xf[i]; }
#pragma unroll
    for (int o = 0; o < 8; ++o) { float cur[8]; unpk8(rw[o + W - 1], cur);
#pragma unroll
        for (int i = 0; i < 8; ++i) s[i] += cur[i];
        const int t = t0 + o, cnt = (t + 1 < W) ? t + 1 : W; const float ic = 1.f / (float)cnt; v4u ov;
        ov.x = pk2(s[0] * ic - cur[0], s[1] * ic - cur[1]); ov.y = pk2(s[2] * ic - cur[2], s[3] * ic - cur[3]); ov.z = pk2(s[4] * ic - cur[4], s[5] * ic - cur[5]); ov.w = pk2(s[6] * ic - cur[6], s[7] * ic - cur[7]);
        *(v4u*)(ya + (size_t)(m0 + o) * 512 + 8 * cgi) = ov;
        float old[8]; unpk8(rw[o], old);
#pragma unroll
        for (int i = 0; i < 8; ++i) s[i] -= old[i]; }
}
__device__ __forceinline__ void phase_pool(const bf16* xa, bf16* ya, int gtid, int nthr) {
    for (int idx = gtid; idx < (M / 8) * 64; idx += nthr) { const int c16 = idx & 15, rl = (idx >> 4) & 3, g = (idx >> 6) & 3, rh = idx >> 8; const int m0 = (rh * 4 + rl) * 8, cgi = g * 16 + c16;
        if (g == 0) pool_item<2>(xa, ya, m0, cgi); else if (g == 1) pool_item<4>(xa, ya, m0, cgi); else if (g == 2) pool_item<8>(xa, ya, m0, cgi); else pool_item<16>(xa, ya, m0, cgi); }
}
__device__ __forceinline__ int crow16(int r, int hi) { return (r & 3) + 8 * (r >> 2) + 4 * hi; }
template <bool FINAL>
__device__ __forceinline__ void lru_item(LAS unsigned char* lds, int b, int hp, int ck, const bf16* xl, bf16* gg, const float* cw, const float* cb, const bf16* WaT, const bf16* WxT,
                                         const float* ba, const float* bx, const float* lam, float* summ) {
    int tid_o = threadIdx.x; asm volatile("" : "+v"(tid_o)); const int tid = tid_o, lane = tid & 63, wid = tid >> 6, r32 = lane & 31, hi = lane >> 5;
    const int t0 = ck * 128; const size_t m0 = (size_t)b * SEQ + t0; const int ch0 = hp * 256;
    constexpr int XP = 264;
    LAS bf16* xc = (LAS bf16*)lds; LAS float* h0s = (LAS float*)(lds + 128 * XP * 2);
    {
        const int cgi = tid & 31, tq = tid >> 5, c = ch0 + 8 * cgi;
        float w[4][8], bb[8];
#pragma unroll
        for (int k = 0; k < 4; ++k) { const f32x4 a = *(const f32x4*)(cw + k * 1024 + c), d = *(const f32x4*)(cw + k * 1024 + c + 4); w[k][0] = a.x; w[k][1] = a.y; w[k][2] = a.z; w[k][3] = a.w; w[k][4] = d.x; w[k][5] = d.y; w[k][6] = d.z; w[k][7] = d.w; }
        { const f32x4 a = *(const f32x4*)(cb + c), d = *(const f32x4*)(cb + c + 4); bb[0] = a.x; bb[1] = a.y; bb[2] = a.z; bb[3] = a.w; bb[4] = d.x; bb[5] = d.y; bb[6] = d.z; bb[7] = d.w; }
        v4u rw[11];
#pragma unroll
        for (int i = 0; i < 11; ++i) { const int tl = tq * 8 - 3 + i; rw[i] = (t0 + tl >= 0) ? *(const v4u*)(xl + (size_t)((long)m0 + tl) * 1024 + c) : (v4u){0u, 0u, 0u, 0u}; }
#pragma unroll
        for (int o = 0; o < 8; ++o) { float y[8];
#pragma unroll
            for (int j = 0; j < 8; ++j) y[j] = bb[j];
#pragma unroll
            for (int k = 0; k < 4; ++k) { const v4u xv = rw[o + k];
                y[0] += w[k][0] * __uint_as_float(xv.x << 16); y[1] += w[k][1] * __uint_as_float(xv.x & 0xffff0000u); y[2] += w[k][2] * __uint_as_float(xv.y << 16); y[3] += w[k][3] * __uint_as_float(xv.y & 0xffff0000u);
                y[4] += w[k][4] * __uint_as_float(xv.z << 16); y[5] += w[k][5] * __uint_as_float(xv.z & 0xffff0000u); y[6] += w[k][6] * __uint_as_float(xv.w << 16); y[7] += w[k][7] * __uint_as_float(xv.w & 0xffff0000u); }
            v4u ov; ov.x = pk2(y[0], y[1]); ov.y = pk2(y[2], y[3]); ov.z = pk2(y[4], y[5]); ov.w = pk2(y[6], y[7]);
            *(LAS v4u*)(xc + (tq * 8 + o) * XP + 8 * cgi) = ov; }
    }
    if (FINAL && tid < 256) {
        const float* sp = summ + ((size_t)b * 64 * 1024 + ch0 + tid) * 2; float h = 0.f;
        for (int c0 = 0; c0 < ck; c0 += 16) { float2 v[16];
#pragma unroll
            for (int j = 0; j < 16; ++j) v[j] = (c0 + j < ck) ? *(const float2*)(sp + (size_t)(c0 + j) * 2048) : make_float2(1.f, 0.f);
#pragma unroll
            for (int j = 0; j < 16; ++j) h = v[j].x * h + v[j].y; }
        h0s[tid] = h;
    }
    __syncthreads();
    const int hh = wid >> 2, s = wid & 3, chl = 128 * hh + 32 * s + r32, ch = ch0 + chl, head = 2 * hp + hh;
    const float bav = ba[ch], bxv = bx[ch]; const float nl = -lam[ch]; const float sp8 = 8.f * (fmaxf(nl, 0.f) + flog1p(__expf(-fabsf(nl))));
    bf16x8 fa[8], fx[8];
#pragma unroll
    for (int ks = 0; ks < 8; ++ks) { fa[ks] = *(const bf16x8*)(WaT + (size_t)head * 16384 + (32 * s + r32) * 128 + 16 * ks + 8 * hi); fx[ks] = *(const bf16x8*)(WxT + (size_t)head * 16384 + (32 * s + r32) * 128 + 16 * ks + 8 * hi); }
    float hrun = FINAL ? h0s[chl] : 0.f, Arun = 1.f;
    for (int mb = 0; mb < 4; ++mb) {
        unsigned short gv[16];
        if (FINAL) {
#pragma unroll
            for (int r = 0; r < 16; ++r) gv[r] = gg[(m0 + 32 * mb + crow16(r, hi)) * 1024 + ch]; }
        f32x16 accA = {0.f, 0.f, 0.f, 0.f, 0.f, 0.f, 0.f, 0.f, 0.f, 0.f, 0.f, 0.f, 0.f, 0.f, 0.f, 0.f}, accX = accA;
#pragma unroll
        for (int ks = 0; ks < 8; ++ks) { const bf16x8 af = *(const LAS bf16x8*)(xc + (32 * mb + r32) * XP + 128 * hh + 16 * ks + 8 * hi);
            accA = __builtin_amdgcn_mfma_f32_32x32x16_bf16(af, fa[ks], accA, 0, 0, 0); accX = __builtin_amdgcn_mfma_f32_32x32x16_bf16(af, fx[ks], accX, 0, 0, 0); }
        float a[16], u[16];
#pragma unroll
        for (int r = 0; r < 16; ++r) { const int tok = 32 * mb + crow16(r, hi); const float xcv = bf2f(xc[tok * XP + chl]);
            const float rg = pg8::fsig(accA[r] + bav), la = -rg * sp8, av = __expf(la), mult = sqrtf(fmaxf(1.f - av * av, 0.f)), ig = pg8::fsig(accX[r] + bxv);
            a[r] = av; u[r] = mult * ig * xcv; }
        float As[4], Hs[4], Ap[4], Hp[4], hin[4];
#pragma unroll
        for (int g = 0; g < 4; ++g) { float Aq = 1.f, Hq = 0.f;
#pragma unroll
            for (int i = 0; i < 4; ++i) { Hq = a[4 * g + i] * Hq + u[4 * g + i]; Aq *= a[4 * g + i]; }
            As[g] = Aq; Hs[g] = Hq; Ap[g] = bperm(Aq, lane ^ 32); Hp[g] = bperm(Hq, lane ^ 32); }
#pragma unroll
        for (int g = 0; g < 4; ++g) { const float A0 = hi ? Ap[g] : As[g], H0 = hi ? Hp[g] : Hs[g], A1 = hi ? As[g] : Ap[g], H1 = hi ? Hs[g] : Hp[g];
            const float hA = hrun, hB = A0 * hA + H0; hrun = A1 * hB + H1; Arun *= A0 * A1; hin[g] = hi ? hB : hA; }
        if (FINAL) {
#pragma unroll
            for (int g = 0; g < 4; ++g) { float hc = hin[g];
#pragma unroll
                for (int i = 0; i < 4; ++i) { const int r = 4 * g + i; hc = a[r] * hc + u[r]; gv[r] = (unsigned short)f2bf(hc * bf2f(gv[r])); } }
#pragma unroll
            for (int r = 0; r < 16; ++r) gg[(m0 + 32 * mb + crow16(r, hi)) * 1024 + ch] = gv[r];
        }
    }
    if (!FINAL && hi == 0) { float* sp = summ + (((size_t)b * 64 + ck) * 1024 + ch) * 2; sp[0] = Arun; sp[1] = hrun; }
    __syncthreads();
}
__device__ __forceinline__ void phase_final(float* x, const float* g, int gw, int NGW, int lane) {
    f32x4 gv[4];
#pragma unroll
    for (int j = 0; j < 4; ++j) gv[j] = *((const f32x4*)g + lane + 64 * j);
    for (int r0 = gw; r0 < M; r0 += 4 * NGW) { f32x4 v[4][4]; float s[4];
#pragma unroll
        for (int q = 0; q < 4; ++q) { const int r = (r0 + q * NGW < M) ? r0 + q * NGW : r0; const f32x4* xr = (const f32x4*)(x + (size_t)r * D) + lane; s[q] = 0.f;
#pragma unroll
            for (int j = 0; j < 4; ++j) { v[q][j] = xr[64 * j]; s[q] += (v[q][j].x * v[q][j].x + v[q][j].y * v[q][j].y) + (v[q][j].z * v[q][j].z + v[q][j].w * v[q][j].w); } }
#pragma unroll
        for (int o = 1; o < 64; o <<= 1) {
#pragma unroll
            for (int q = 0; q < 4; ++q) s[q] += bperm(s[q], lane ^ o); }
#pragma unroll
        for (int q = 0; q < 4; ++q) { const int r = r0 + q * NGW; if (r < M) { const float rs = rsqrtf(s[q] * (1.f / D) + 1e-6f); f32x4* xr = (f32x4*)(x + (size_t)r * D) + lane;
#pragma unroll
                for (int j = 0; j < 4; ++j) xr[64 * j] = (f32x4){v[q][j].x * rs * gv[j].x, v[q][j].y * rs * gv[j].y, v[q][j].z * rs * gv[j].z, v[q][j].w * rs * gv[j].w}; } }
    }
}
__device__ __forceinline__ void phase_kmax(const bf16* K, float* kpart, int gw, int NGW, int lane) {
    float m0 = 0.f, m1 = 0.f;
#pragma unroll 8
    for (int r = gw; r < M; r += NGW) { const v4u w = *(const v4u*)(K + (size_t)r * 512 + 8 * lane);
        const float a0 = __uint_as_float(w.x << 16), a1 = __uint_as_float(w.x & 0xffff0000u), a2 = __uint_as_float(w.y << 16), a3 = __uint_as_float(w.y & 0xffff0000u);
        const float a4 = __uint_as_float(w.z << 16), a5 = __uint_as_float(w.z & 0xffff0000u), a6 = __uint_as_float(w.w << 16), a7 = __uint_as_float(w.w & 0xffff0000u);
        float s = (a0 * a0 + a1 * a1) + (a2 * a2 + a3 * a3) + (a4 * a4 + a5 * a5) + (a6 * a6 + a7 * a7);
        s += bperm(s, lane ^ 1); s += bperm(s, lane ^ 2); s += bperm(s, lane ^ 4);
        if (r < SEQ) m0 = fmaxf(m0, s); else m1 = fmaxf(m1, s); }
    if ((lane & 7) == 0) { kpart[((size_t)gw * 2 + 0) * 8 + (lane >> 3)] = m0; kpart[((size_t)gw * 2 + 1) * 8 + (lane >> 3)] = m1; }
}
constexpr float FOX_C2 = 0.125f * 1.4426950408889634f;
constexpr float FOX_SKIP = 64.f;
constexpr int FOX_KP = 72;
constexpr int FOX_BUF = 2 * 64 * FOX_KP * 2 + 256;
__device__ __forceinline__ void fox_unit(LAS unsigned char* lds, int b, int h, int qb, const bf16* Q, const bf16* K, const bf16* V, bf16* O, const float* ct, const float* kpart, int nparts) {
    int tid_o = threadIdx.x; asm volatile("" : "+v"(tid_o)); const int tid = tid_o, lane = tid & 63, wid = tid >> 6, r32 = lane & 31, hi = lane >> 5;
    const size_t rowbase = (size_t)b * SEQ; const int q0 = qb * 256, NT = 4 * qb + 4;
    const bf16* Qw = Q + (rowbase + q0 + wid * 32 + r32) * 512 + h * 64;
    bf16x8 qr[4];
#pragma unroll
    for (int d0 = 0; d0 < 4; ++d0) qr[d0] = *(const bf16x8*)(Qw + 16 * d0 + 8 * hi);
    LAS float* red = (LAS float*)(lds + 2 * FOX_BUF); LAS int* tsl = (LAS int*)(lds + 2 * FOX_BUF + 128);
    { float qn = 0.f;
#pragma unroll
      for (int d0 = 0; d0 < 4; ++d0) { const v4u w = __builtin_bit_cast(v4u, qr[d0]);
          const float a0 = __uint_as_float(w.x << 16), a1 = __uint_as_float(w.x & 0xffff0000u), a2 = __uint_as_float(w.y << 16), a3 = __uint_as_float(w.y & 0xffff0000u);
          const float a4 = __uint_as_float(w.z << 16), a5 = __uint_as_float(w.z & 0xffff0000u), a6 = __uint_as_float(w.w << 16), a7 = __uint_as_float(w.w & 0xffff0000u);
          qn += (a0 * a0 + a1 * a1) + (a2 * a2 + a3 * a3) + (a4 * a4 + a5 * a5) + (a6 * a6 + a7 * a7); }
      qn += bperm(qn, lane ^ 32);
#pragma unroll
      for (int o = 1; o < 32; o <<= 1) qn = fmaxf(qn, bperm(qn, lane ^ o));
      __syncthreads();
      float km = 0.f;
      for (int i = tid; i < nparts; i += NTHR) km = fmaxf(km, kpart[((size_t)i * 2 + b) * 8 + h]);
#pragma unroll
      for (int o = 1; o < 64; o <<= 1) km = fmaxf(km, bperm(km, lane ^ o));
      if (lane == 0) { red[wid] = qn; red[8 + wid] = km; } if (tid == 0) tsl[0] = 4 * qb;
      __syncthreads();
      float q2 = red[0], k2 = red[8];
#pragma unroll
      for (int w = 1; w < 8; ++w) { q2 = fmaxf(q2, red[w]); k2 = fmaxf(k2, red[8 + w]); }
      const float thr = 2.f * sqrtf(q2) * sqrtf(k2) * 1.0001f + FOX_SKIP;
      const float c0 = ct[q0];
      if (tid < 4 * qb && ct[64 * tid + 63] - c0 <= thr) atomicMin((int*)tsl, tid);
      __syncthreads(); }
    const int T0 = tsl[0];
    const int skey = tid >> 3, sd = (tid & 7) * 8;
    const bf16* kp = K + (rowbase + skey) * 512 + h * 64 + sd; const bf16* vp = V + (rowbase + skey) * 512 + h * 64 + sd;
    v4u kreg = *(const v4u*)(kp + (size_t)T0 * 64 * 512), vreg = *(const v4u*)(vp + (size_t)T0 * 64 * 512); float creg = (tid < 64) ? ct[64 * T0 + tid] : 0.f;
    __syncthreads();
    { LAS unsigned char* buf0 = lds + (T0 & 1) * FOX_BUF; LAS bf16* Ks = (LAS bf16*)buf0; LAS bf16* Vt = Ks + 64 * FOX_KP; LAS float* Cs = (LAS float*)(buf0 + 2 * 64 * FOX_KP * 2);
      *(LAS v4u*)(Ks + skey * FOX_KP + sd) = kreg;
      Vt[(sd + 0) * FOX_KP + skey] = (bf16)(vreg.x & 0xffffu); Vt[(sd + 1) * FOX_KP + skey] = (bf16)(vreg.x >> 16); Vt[(sd + 2) * FOX_KP + skey] = (bf16)(vreg.y & 0xffffu); Vt[(sd + 3) * FOX_KP + skey] = (bf16)(vreg.y >> 16);
      Vt[(sd + 4) * FOX_KP + skey] = (bf16)(vreg.z & 0xffffu); Vt[(sd + 5) * FOX_KP + skey] = (bf16)(vreg.z >> 16); Vt[(sd + 6) * FOX_KP + skey] = (bf16)(vreg.w & 0xffffu); Vt[(sd + 7) * FOX_KP + skey] = (bf16)(vreg.w >> 16);
      if (tid < 64) Cs[tid] = creg; }
    if (T0 + 1 < NT) { kreg = *(const v4u*)(kp + (size_t)(T0 + 1) * 64 * 512); vreg = *(const v4u*)(vp + (size_t)(T0 + 1) * 64 * 512); if (tid < 64) creg = ct[64 * (T0 + 1) + tid]; }
    float m = -1e30f, l = 0.f; f32x16 o0, o1;
#pragma unroll
    for (int r = 0; r < 16; ++r) { o0[r] = 0.f; o1[r] = 0.f; }
    for (int t = T0; t < NT; ++t) {
        __syncthreads();
        if (t + 1 < NT) { LAS unsigned char* bufn = lds + ((t + 1) & 1) * FOX_BUF; LAS bf16* Ks = (LAS bf16*)bufn; LAS bf16* Vt = Ks + 64 * FOX_KP; LAS float* Cs = (LAS float*)(bufn + 2 * 64 * FOX_KP * 2);
            *(LAS v4u*)(Ks + skey * FOX_KP + sd) = kreg;
            Vt[(sd + 0) * FOX_KP + skey] = (bf16)(vreg.x & 0xffffu); Vt[(sd + 1) * FOX_KP + skey] = (bf16)(vreg.x >> 16); Vt[(sd + 2) * FOX_KP + skey] = (bf16)(vreg.y & 0xffffu); Vt[(sd + 3) * FOX_KP + skey] = (bf16)(vreg.y >> 16);
            Vt[(sd + 4) * FOX_KP + skey] = (bf16)(vreg.z & 0xffffu); Vt[(sd + 5) * FOX_KP + skey] = (bf16)(vreg.z >> 16); Vt[(sd + 6) * FOX_KP + skey] = (bf16)(vreg.w & 0xffffu); Vt[(sd + 7) * FOX_KP + skey] = (bf16)(vreg.w >> 16);
            if (tid < 64) Cs[tid] = creg;
            if (t + 2 < NT) { kreg = *(const v4u*)(kp + (size_t)(t + 2) * 64 * 512); vreg = *(const v4u*)(vp + (size_t)(t + 2) * 64 * 512); if (tid < 64) creg = ct[64 * (t + 2) + tid]; } }
        const int jb = t - (NT - 4);
        if (jb >= 0 && 64 * jb > 32 * wid + 31) continue;
        LAS unsigned char* buf = lds + (t & 1) * FOX_BUF; const LAS bf16* Ks = (const LAS bf16*)buf; const LAS bf16* Vt = Ks + 64 * FOX_KP; const LAS float* Cs = (const LAS float*)(buf + 2 * 64 * FOX_KP * 2);
        f32x16 p0, p1;
#pragma unroll
        for (int g = 0; g < 4; ++g) { const f32x4 a = *(const LAS f32x4*)(Cs + 8 * g + 4 * hi), c = *(const LAS f32x4*)(Cs + 32 + 8 * g + 4 * hi);
            p0[4 * g + 0] = -a[0]; p0[4 * g + 1] = -a[1]; p0[4 * g + 2] = -a[2]; p0[4 * g + 3] = -a[3]; p1[4 * g + 0] = -c[0]; p1[4 * g + 1] = -c[1]; p1[4 * g + 2] = -c[2]; p1[4 * g + 3] = -c[3]; }
#pragma unroll
        for (int d0 = 0; d0 < 4; ++d0) { const bf16x8 a0 = *(const LAS bf16x8*)(Ks + r32 * FOX_KP + 16 * d0 + 8 * hi), a1 = *(const LAS bf16x8*)(Ks + (32 + r32) * FOX_KP + 16 * d0 + 8 * hi);
            p0 = __builtin_amdgcn_mfma_f32_32x32x16_bf16(a0, qr[d0], p0, 0, 0, 0); p1 = __builtin_amdgcn_mfma_f32_32x32x16_bf16(a1, qr[d0], p1, 0, 0, 0); }
        if (jb >= 0) { const int qrel = 32 * wid + r32, kb = 64 * jb + 4 * hi;
#pragma unroll
            for (int r = 0; r < 16; ++r) { const int kv = kb + (r & 3) + 8 * (r >> 2); if (kv > qrel) p0[r] = -__builtin_inff(); if (kv + 32 > qrel) p1[r] = -__builtin_inff(); } }
        float mx = fmaxf(p0[0], p1[0]);
#pragma unroll
        for (int r = 1; r < 16; ++r) mx = fmaxf(mx, fmaxf(p0[r], p1[r]));
        mx = fmaxf(mx, bperm(mx, lane ^ 32));
        const float mn = fmaxf(m, mx), alpha = __builtin_amdgcn_exp2f(m - mn); m = mn;
        float sum = 0.f;
#pragma unroll
        for (int r = 0; r < 16; ++r) { p0[r] = __builtin_amdgcn_exp2f(p0[r] - mn); p1[r] = __builtin_amdgcn_exp2f(p1[r] - mn); sum += p0[r] + p1[r]; }
        l = l * alpha + sum;
#pragma unroll
        for (int r = 0; r < 16; ++r) { o0[r] *= alpha; o1[r] *= alpha; }
        bf16x8 pb[4];
        { v4u w;
          w.x = pg8::cvt_pk_bf16(p0[0], p0[1]); w.y = pg8::cvt_pk_bf16(p0[2], p0[3]); w.z = pg8::cvt_pk_bf16(p0[4], p0[5]); w.w = pg8::cvt_pk_bf16(p0[6], p0[7]); pb[0] = __builtin_bit_cast(bf16x8, w);
          w.x = pg8::cvt_pk_bf16(p0[8], p0[9]); w.y = pg8::cvt_pk_bf16(p0[10], p0[11]); w.z = pg8::cvt_pk_bf16(p0[12], p0[13]); w.w = pg8::cvt_pk_bf16(p0[14], p0[15]); pb[1] = __builtin_bit_cast(bf16x8, w);
          w.x = pg8::cvt_pk_bf16(p1[0], p1[1]); w.y = pg8::cvt_pk_bf16(p1[2], p1[3]); w.z = pg8::cvt_pk_bf16(p1[4], p1[5]); w.w = pg8::cvt_pk_bf16(p1[6], p1[7]); pb[2] = __builtin_bit_cast(bf16x8, w);
          w.x = pg8::cvt_pk_bf16(p1[8], p1[9]); w.y = pg8::cvt_pk_bf16(p1[10], p1[11]); w.z = pg8::cvt_pk_bf16(p1[12], p1[13]); w.w = pg8::cvt_pk_bf16(p1[14], p1[15]); pb[3] = __builtin_bit_cast(bf16x8, w); }
#pragma unroll
        for (int mm = 0; mm < 4; ++mm) {
            typedef unsigned u32x2v __attribute__((ext_vector_type(2)));
            const u32x2v a0l = *(const LAS u32x2v*)(Vt + r32 * FOX_KP + 16 * mm + 4 * hi), a0h = *(const LAS u32x2v*)(Vt + r32 * FOX_KP + 16 * mm + 8 + 4 * hi);
            const u32x2v a1l = *(const LAS u32x2v*)(Vt + (32 + r32) * FOX_KP + 16 * mm + 4 * hi), a1h = *(const LAS u32x2v*)(Vt + (32 + r32) * FOX_KP + 16 * mm + 8 + 4 * hi);
            const v4u A0 = {a0l.x, a0l.y, a0h.x, a0h.y}, A1 = {a1l.x, a1l.y, a1h.x, a1h.y};
            o0 = __builtin_amdgcn_mfma_f32_32x32x16_bf16(__builtin_bit_cast(bf16x8, A0), pb[mm], o0, 0, 0, 0);
            o1 = __builtin_amdgcn_mfma_f32_32x32x16_bf16(__builtin_bit_cast(bf16x8, A1), pb[mm], o1, 0, 0, 0); }
    }
    l += bperm(l, lane ^ 32); const float inv = 1.f / l;
    bf16* Ow = O + (rowbase + q0 + wid * 32 + r32) * 512 + h * 64;
#pragma unroll
    for (int g = 0; g < 4; ++g) { typedef unsigned u32x2v __attribute__((ext_vector_type(2)));
        u32x2v w0, w1; w0.x = pg8::cvt_pk_bf16(o0[4 * g] * inv, o0[4 * g + 1] * inv); w0.y = pg8::cvt_pk_bf16(o0[4 * g + 2] * inv, o0[4 * g + 3] * inv);
        w1.x = pg8::cvt_pk_bf16(o1[4 * g] * inv, o1[4 * g + 1] * inv); w1.y = pg8::cvt_pk_bf16(o1[4 * g + 2] * inv, o1[4 * g + 3] * inv);
        *(u32x2v*)(Ow + 8 * g + 4 * hi) = w0; *(u32x2v*)(Ow + 32 + 8 * g + 4 * hi) = w1; }
    __syncthreads();
}
__global__ void __launch_bounds__(NTHR, 2) hybrid_fwd(Args args) {
    extern __shared__ __attribute__((aligned(16))) unsigned char lds_raw[];
    cg::grid_group grid = cg::this_grid();
    LAS unsigned char* lds = (LAS unsigned char*)lds_raw;
    int tid = threadIdx.x, lane = tid & 63, wave = __builtin_amdgcn_readfirstlane(tid >> 6);
    int G = gridDim.x, bx = blockIdx.x;
    int vcu = (G % 8 == 0) ? (bx % 8) * (G / 8) + bx / 8 : bx;
    int gw = vcu * NWAVES + wave; int NGW = G * NWAVES;
    PtrTab TB = (PtrTab)(lds + TAB_OFF);
    if (tid == 0) {
#pragma unroll
        for (int i = 0; i < 31; ++i) TB[i] = (unsigned long long)args.in[i];
    }
    if (tid == 1) { TB[40] = 0ull; }
    __syncthreads();
    (void)xcd_barrier_post((unsigned*)(args.ws + WS_BAR), (volatile LAS unsigned*)(lds + TAB_OFF + 320));
    grid.sync();
    unsigned char* ws = args.ws;
    float* X = args.out;
    float* SS = (float*)(ws + WS_SSP);
    bf16* XB = (bf16*)(ws + WS_XB);
    bf16* HB = (bf16*)(ws + WS_H);
    constexpr float C2X = 0.0625f * 1.4426950408889634f;
#define GSYNC() do { asm volatile("s_waitcnt vmcnt(0) lgkmcnt(0)" ::: "memory"); { XcdBarrier xb_; xb_.bar = (unsigned*)(ws + WS_BAR); xb_.x = xb_xcc_id(); xb_.st = (volatile LAS unsigned*)(lds + TAB_OFF + 320); xcd_barrier(xb_); } tid = threadIdx.x; asm volatile("" : "+v"(tid)); lane = tid & 63; wave = __builtin_amdgcn_readfirstlane(tid >> 6); G = gridDim.x; bx = blockIdx.x; asm volatile("" : "+s"(G), "+s"(bx)); vcu = (G % 8 == 0) ? (bx % 8) * (G / 8) + bx / 8 : bx; gw = vcu * NWAVES + wave; NGW = G * NWAVES; { unsigned long long wsi_ = (unsigned long long)ws; asm volatile("" : "+s"(wsi_)); ws = (unsigned char*)(GAS unsigned char*)wsi_; } } while (0)

    for (int l = 0; l < DEPTH; ++l) {
        float* ss0 = SS + (size_t)(4 * l + 0) * M * 4; float* ss1 = SS + (size_t)(4 * l + 1) * M * 4; float* ss2 = SS + (size_t)(4 * l + 2) * M * 4; float* ss3 = SS + (size_t)(4 * l + 3) * M * 4; float* ss4 = SS + (size_t)(4 * l + 4) * M * 4;
        phase_prologue(TB, ws, X, l, lds, gw, NGW, lane, wave);
        GSYNC();
        { pg8::Gemm g{XB, (const bf16*)(ws + WS_W1IN), M, 2 * DFF, D, D, D, 0}; pg8::StaticOrder S; S.init(M, 2 * DFF, G, bx);
          pg8::EpiSwiglu E{HB, ss0, DFF};
          pg8::gemm_phase<pg8::EpiSwiglu, pg8::StaticOrder, true, true>(lds, g, S, E); }
        if (bx >= G / 2) { pg8::Gemm g{(const bf16*)(ws + WS_MEMN), (const bf16*)(ws + WS_WXKV), 512, 2 * D, D, D, D, 0}; pg8::StaticOrder S; S.init(512, 2 * D, G, bx - G / 2);
          pg8::EpiKV E{(bf16*)(ws + WS_KX), (bf16*)(ws + WS_VT)};
          pg8::gemm_phase<pg8::EpiKV, pg8::StaticOrder, true, true>(lds, g, S, E); }
        GSYNC();
        { pg8::Gemm g{HB, (const bf16*)(ws + WS_W1OUT), M, D, DFF, DFF, DFF, 0}; pg8::StaticOrder S; S.init(M, D, G, bx); pg8::Unit u_;
          pg8::EpiResid E{X, XB, ss1, 0.5f};
          for (int i_ = 0; S.next(i_, u_); ++i_) { const pg8::OneUnit O1{u_.pm, u_.pn}; pg8::gemm_phase<pg8::EpiResid, pg8::OneUnit, false, true>(lds, g, O1, E); } }
        GSYNC();
        { pg8::Gemm g{XB, (const bf16*)(ws + WS_WIN), M, 4096, D, D, D, 0}; pg8::StaticOrder S; S.init(M, 4096, G, bx);
          pg8::EpiWin E{(bf16*)(ws + WS_XA), (bf16*)(ws + WS_XL), (bf16*)(ws + WS_GG), (bf16*)(ws + WS_Q), (bf16*)(ws + WS_K), (bf16*)(ws + WS_V), ss1, FOX_C2};
          pg8::gemm_phase<pg8::EpiWin, pg8::StaticOrder, true, true>(lds, g, S, E); }
        phase_fl(XB, (const float*)(ws + WS_WFL), tab_in(TB, 7) + l * 8, ss1, (float*)(ws + WS_LOGF), gw, NGW, lane);
        GSYNC();
        if (vcu < 16) cumsum_bh((const float*)(ws + WS_LOGF), (float*)(ws + WS_CTIL), vcu, (LAS float*)lds);
        for (int it = vcu; it < 512; it += G)
            lru_item<false>(lds, it >> 8, (it >> 6) & 3, it & 63, (const bf16*)(ws + WS_XL), (bf16*)(ws + WS_GG), tab_in(TB, 12) + (size_t)l * 4 * D, tab_in(TB, 13) + l * D, (const bf16*)(ws + WS_WAT), (const bf16*)(ws + WS_WXT),
                            tab_in(TB, 15) + l * D, tab_in(TB, 17) + l * D, tab_in(TB, 18) + l * D, (float*)(ws + WS_SUMM));
        phase_pool((const bf16*)(ws + WS_XA), (bf16*)(ws + WS_YA), vcu * NTHR + tid, G * NTHR);
        phase_kmax((const bf16*)(ws + WS_K), (float*)(ws + WS_KPART), gw, NGW, lane);
        GSYNC();
        for (int it = vcu; it < 512; it += G)
            lru_item<true>(lds, it >> 8, (it >> 6) & 3, (it & 256) ? 63 - (it & 63) : (it & 63),
                            (const bf16*)(ws + WS_XL), (bf16*)(ws + WS_GG), tab_in(TB, 12) + (size_t)l * 4 * D, tab_in(TB, 13) + l * D, (const bf16*)(ws + WS_WAT), (const bf16*)(ws + WS_WXT),
                           tab_in(TB, 15) + l * D, tab_in(TB, 17) + l * D, tab_in(TB, 18) + l * D, (float*)(ws + WS_SUMM));
        {
            unsigned* qc = (unsigned*)(ws + WS_QCTR) + (size_t)l * 64; LAS int* slot = (LAS int*)(lds + TAB_OFF + 384); LAS float* cl = (LAS float*)(lds + 2 * FOX_BUF + 256); LAS int* ord = (LAS int*)(lds + 2 * FOX_BUF + 384);
            __syncthreads();
            if (tid < 16) cl[tid] = ((const float*)(ws + WS_CTIL))[(size_t)tid * SEQ + SEQ - 1];
            __syncthreads();
            if (tid < 16) { const float ci = cl[tid]; int rk = 0;
#pragma unroll
                for (int j = 0; j < 16; ++j) { const float cj = cl[j]; rk += (cj > ci || (cj == ci && j < tid)) ? 1 : 0; }
                ord[rk] = tid; }
            for (;;) { __syncthreads(); if (tid == 0) slot[0] = (int)__hip_atomic_fetch_add(qc, 1u, __ATOMIC_RELAXED, __HIP_MEMORY_SCOPE_AGENT); __syncthreads();
                const int qi = slot[0]; if (qi >= 512) break; const int bh = ord[qi >> 5], qb = 31 - (qi & 31);
                fox_unit(lds, bh >> 3, bh & 7, qb, (const bf16*)(ws + WS_Q), (const bf16*)(ws + WS_K), (const bf16*)(ws + WS_V), (bf16*)(ws + WS_YC), (const float*)(ws + WS_CTIL) + (size_t)bh * SEQ, (const float*)(ws + WS_KPART), NGW); }
        }
        GSYNC();
        { pg8::StaticOrder S; S.init(M, D, G, bx); pg8::Unit u;
          bf16* stash = (bf16*)(ws + WS_STASH) + (size_t)bx * 65536; bf16* mg = (bf16*)(ws + WS_MG);
          for (int i = 0; S.next(i, u); ++i) { const pg8::OneUnit O1{u.pm, u.pn};
#pragma unroll 1
              for (int br = 0; br < 3; ++br) {
                  { pg8::Gemm g{XB, (const bf16*)(ws + WS_WG) + (size_t)br * D * D, M, D, D, D, D, 0}; pg8::EpiGate E{stash, tab_in(TB, 8) + (size_t)l * 3 * D + br * D, ss1};
                    pg8::gemm_phase<pg8::EpiGate, pg8::OneUnit, true, true>(lds, g, O1, E); }
                  asm volatile("s_waitcnt vmcnt(0)" ::: "memory"); __syncthreads();
                  const bf16* Ab = br == 0 ? (const bf16*)(ws + WS_YA) : br == 1 ? (const bf16*)(ws + WS_GG) : (const bf16*)(ws + WS_YC);
                  const bf16* Ub = br == 0 ? (const bf16*)(ws + WS_UA) : br == 1 ? (const bf16*)(ws + WS_UB) : (const bf16*)(ws + WS_UC);
                  const int Kb = br == 1 ? 1024 : 512;
                  { pg8::Gemm g{Ab, Ub, M, D, Kb, Kb, Kb, 0}; pg8::EpiMerge E{stash, mg, br == 0 ? 1 : 0};
                    pg8::gemm_phase<pg8::EpiMerge, pg8::OneUnit, true, true>(lds, g, O1, E); }
                  asm volatile("s_waitcnt vmcnt(0)" ::: "memory"); __syncthreads();
              } } }
        GSYNC();
        { pg8::Gemm g{(const bf16*)(ws + WS_MG), (const bf16*)(ws + WS_WO), M, D, D, D, D, 0}; pg8::StaticOrder S; S.init(M, D, G, bx); pg8::Unit u_;
          pg8::EpiResid E{X, XB, ss2, 1.0f};
          for (int i_ = 0; S.next(i_, u_); ++i_) { const pg8::OneUnit O1{u_.pm, u_.pn}; pg8::gemm_phase<pg8::EpiResid, pg8::OneUnit, false, true>(lds, g, O1, E); } }
        GSYNC();
        { bf16* pb = (bf16*)(ws + WS_PBUF) + (size_t)bx * 65536; const pg8::OneUnit O1{0, 0};
          for (int uid = vcu; uid < 256; uid += G) { const int rt = uid >> 2, h = uid & 3, b = rt >> 5;
              int KX = 256; asm volatile("" : "+s"(KX));
              bf16* qo = (bf16*)(ws + WS_QX) + (size_t)rt * 256 * D + h * 256; bf16* qs = (bf16*)(ws + WS_Q) + (size_t)bx * 65536;
              { pg8::Gemm g{XB + (size_t)rt * 256 * D, (const bf16*)(ws + WS_WXQ) + (size_t)h * 256 * D, 256, 256, D, D, D, 0}; pg8::EpiRs E{qs, 256, ss2 + (size_t)rt * 256 * 4, C2X};
                pg8::gemm_phase<pg8::EpiRs, pg8::OneUnit, true, true>(lds, g, O1, E); }
              asm volatile("s_waitcnt vmcnt(0)" ::: "memory"); __syncthreads();
              { pg8::Gemm g{qs, (const bf16*)(ws + WS_KX) + (size_t)b * 256 * D + h * 256, 256, 256, KX, 256, D, 0}; pg8::EpiSoftmaxP E{pb};
                pg8::gemm_phase<pg8::EpiSoftmaxP, pg8::OneUnit, false, true>(lds, g, O1, E); }
              asm volatile("s_waitcnt vmcnt(0)" ::: "memory"); __syncthreads();
              { pg8::Gemm g{pb, (const bf16*)(ws + WS_VT) + (size_t)(b * 4 + h) * 65536, 256, 256, KX, 256, 256, 0}; pg8::EpiRs E{qo, D, nullptr, 1.0f};
                pg8::gemm_phase<pg8::EpiRs, pg8::OneUnit, true, true>(lds, g, O1, E); }
              asm volatile("s_waitcnt vmcnt(0)" ::: "memory"); if (uid + G < 256) __builtin_amdgcn_fence(__ATOMIC_ACQUIRE, "agent"); __syncthreads();
          } }
        GSYNC();
        { pg8::Gemm g{(const bf16*)(ws + WS_QX), (const bf16*)(ws + WS_WXO), M, D, D, D, D, 0}; pg8::StaticOrder S; S.init(M, D, G, bx); pg8::Unit u_;
          pg8::EpiResid E{X, XB, ss3, 1.0f};
          for (int i_ = 0; S.next(i_, u_); ++i_) { const pg8::OneUnit O1{u_.pm, u_.pn}; pg8::gemm_phase<pg8::EpiResid, pg8::OneUnit, false, true>(lds, g, O1, E); } }
        GSYNC();
        { pg8::Gemm g{XB, (const bf16*)(ws + WS_W2IN), M, 2 * DFF, D, D, D, 0}; pg8::StaticOrder S; S.init(M, 2 * DFF, G, bx);
          pg8::EpiSwiglu E{HB, ss3, DFF};
          pg8::gemm_phase<pg8::EpiSwiglu, pg8::StaticOrder, true, true>(lds, g, S, E); }
        GSYNC();
        { pg8::Gemm g{HB, (const bf16*)(ws + WS_W2OUT), M, D, DFF, DFF, DFF, 0}; pg8::StaticOrder S; S.init(M, D, G, bx); pg8::Unit u_;
          pg8::EpiResid E{X, XB, ss4, 0.5f};
          for (int i_ = 0; S.next(i_, u_); ++i_) { const pg8::OneUnit O1{u_.pm, u_.pn}; pg8::gemm_phase<pg8::EpiResid, pg8::OneUnit, false, true>(lds, g, O1, E); } }
        GSYNC();
    }
    phase_final(X, tab_in(TB, 30), gw, NGW, lane);
#undef GSYNC
}

extern "C" void kernel_launch(void* const* d_in, const int* in_sizes, int n_in, void* d_out, int out_size, void* d_ws, size_t ws_size, hipStream_t stream) {
    static int grid = 0;
    if (grid == 0) {
        if (n_in != 31 || out_size != M * D || ws_size < WS_END) { fprintf(stderr, "kernel_launch: unexpected problem (n_in %d, out %d, ws %zu)\n", n_in, out_size, ws_size); grid = -1; return; }
        int dev = 0, cus = 0, per_cu = 0;
        (void)hipGetDevice(&dev); (void)hipDeviceGetAttribute(&cus, hipDeviceAttributeMultiprocessorCount, dev);
        if (hipFuncSetAttribute((const void*)hybrid_fwd, hipFuncAttributeMaxDynamicSharedMemorySize, LDS_BYTES) != hipSuccess) { fprintf(stderr, "kernel_launch: hipFuncSetAttribute failed\n"); grid = -1; return; }
        if (hipOccupancyMaxActiveBlocksPerMultiprocessor(&per_cu, (const void*)hybrid_fwd, NTHR, LDS_BYTES) != hipSuccess || per_cu < 1) per_cu = 1;
        (void)hipGetLastError();
        grid = cus * (per_cu > 1 ? 1 : per_cu);
        if (grid > 256) grid = 256;
    }
    if (grid < 0) return;
    (void)hipMemsetAsync((char*)d_ws + WS_SS, 0, CTL_ZERO_BYTES, stream);
    Args a{};
    for (int i = 0; i < 31; ++i) a.in[i] = (const float*)d_in[i];
    a.out = (float*)d_out; a.ws = (unsigned char*)d_ws;
    void* kargs[] = {&a};
    hipError_t e = hipLaunchCooperativeKernel((const void*)hybrid_fwd, dim3(grid), dim3(NTHR), kargs, LDS_BYTES, stream);
    if (e != hipSuccess) fprintf(stderr, "cooperative launch failed: %s (grid %d)\n", hipGetErrorString(e), grid);
}
```

```cpp
#include <hip/hip_runtime.h>
#include <hip/hip_cooperative_groups.h>
#include <cstdio>
#include <cstdint>
namespace cg = cooperative_groups;
namespace pg8 {
#define PG8_LAS __attribute__((address_space(3)))
typedef unsigned short bf16_t;
typedef short bf16x8 __attribute__((ext_vector_type(8)));
typedef float f32x4 __attribute__((ext_vector_type(4)));
typedef unsigned u32x4 __attribute__((ext_vector_type(4)));
constexpr int BM = 256, BK = 64, HALF = 128, HTB = HALF * BK * 2  , STAGE_BYTES = 8 * HTB, NXCD = 8, WGM = 8;

__host__ __device__ __forceinline__ int lds_byte(int r, int c) { const int st = (r >> 4) * 2 + (c >> 5), rr = r & 15, cc = c & 31, ob = rr * 64 + cc * 2; return st * 1024 + (ob ^ (((ob >> 9) & 1) << 5)); }
__host__ __device__ __forceinline__ void stage_rc(int b, int& R, int& C) { const int st = b / 1024, sb = b % 1024, swz = sb ^ (((sb >> 9) & 1) << 5); R = (st >> 1) * 16 + swz / 64; C = (st & 1) * 32 + (swz % 64) / 2; }
__host__ __device__ __forceinline__ int perm32(int rho) { const int n = rho >> 4, i = rho & 15; return 8 * (i >> 2) + 4 * n + (i & 3); }

struct Unit { int pm, pn; };
struct Gemm { const bf16_t* A; const bf16_t* Bt; int M, N, K, lda, ldb, a_pn_off; };

struct StaticOrder {
    int nM, nN, nwg, G, c;
    __host__ __device__ __forceinline__ void init(int M, int N, int G_, int c_) { nM = M / BM; nN = N / BM; nwg = nM * nN; G = G_; c = c_; }
    __host__ __device__ __forceinline__ bool next(int i, Unit& u) const {
        const long L = (long)i * G + c; if (L >= nwg) return false;
        int wgid = (int)L; { const int q = nwg / NXCD, r = nwg % NXCD, xcd = wgid % NXCD, off = wgid / NXCD; wgid = (xcd < r ? xcd * (q + 1) : r * (q + 1) + (xcd - r) * q) + off; }
        const int nig = WGM * nN, gid = wgid / nig, fm = gid * WGM, gsz = (nM - fm) < WGM ? (nM - fm) : WGM;
        u.pm = fm + ((wgid % nig) % gsz); u.pn = (wgid % nig) / gsz; return true;
    }
    __device__ __forceinline__ void a_ready(const Unit&) const {}
    __device__ __forceinline__ void done(const Unit&) const {}
};

__device__ __forceinline__ unsigned cvt_pk_bf16(float lo, float hi) { unsigned r; asm volatile("v_cvt_pk_bf16_f32 %0, %1, %2" : "=v"(r) : "v"(lo), "v"(hi)); return r; }
__device__ __forceinline__ float bperm(float v, int srclane) { return __int_as_float(__builtin_amdgcn_ds_bpermute(srclane << 2, __float_as_int(v))); }
typedef float f32x2 __attribute__((ext_vector_type(2)));
typedef unsigned u32x2 __attribute__((ext_vector_type(2)));
__device__ __forceinline__ float fsig(float v) { return __builtin_amdgcn_rcpf(1.f + __expf(-v)); }
__device__ __forceinline__ float fsilu(float v) { return v * fsig(v); }
__device__ __forceinline__ float fgelu_tanh(float v) { return v * fsig(1.5957691216057308f * (v + 0.044715f * v * v * v)); }
__device__ __forceinline__ float bf_lo(unsigned w) { return __uint_as_float(w << 16); }
__device__ __forceinline__ float bf_hi(unsigned w) { return __uint_as_float(w & 0xffff0000u); }
__device__ __forceinline__ float rstd_of(const float* ss, int row) { const f32x4 a = *(const f32x4*)(ss + (size_t)row * 4); return rsqrtf(((a[0] + a[1]) + (a[2] + a[3])) * (1.0f / 1024.0f) + 1e-6f); }
__device__ __forceinline__ u32x4 pack8(const f32x4 v0, const f32x4 v1) { u32x4 w; w.x = cvt_pk_bf16(v0[0], v0[1]); w.y = cvt_pk_bf16(v0[2], v0[3]); w.z = cvt_pk_bf16(v1[0], v1[1]); w.w = cvt_pk_bf16(v1[2], v1[3]); return w; }

__device__ __forceinline__ void rstd8(const float* ss, int row0, float sc, float (&rs)[2][4]) {
    f32x4 pa[2][4];
#pragma unroll
    for (int ai = 0; ai < 2; ++ai)
#pragma unroll
        for (int m = 0; m < 4; ++m) pa[ai][m] = *(const f32x4*)(ss + (size_t)(row0 + ai * HALF + m * 16) * 4);
#pragma unroll
    for (int ai = 0; ai < 2; ++ai)
#pragma unroll
        for (int m = 0; m < 4; ++m) { const f32x4 a = pa[ai][m]; rs[ai][m] = rsqrtf(((a[0] + a[1]) + (a[2] + a[3])) * (1.0f / 1024.0f) + 1e-6f) * sc; }
    __builtin_amdgcn_sched_barrier(0);
}

__device__ __forceinline__ u32x4 ld16_sc1(const void* p) { u32x4 v; asm volatile("global_load_dwordx4 %0, %1, off sc1" : "=v"(v) : "v"(p) : "memory"); return v; }
#define PG8_LDWAIT(v) asm volatile("s_waitcnt vmcnt(0)" : "+v"(v))

struct OneUnit { int pm, pn;
    __device__ __forceinline__ bool next(int i, Unit& u) const { if (i) return false; u.pm = pm; u.pn = pn; return true; }
    __device__ __forceinline__ void a_ready(const Unit&) const {}
    __device__ __forceinline__ void done(const Unit&) const {} };

struct EpiSwiglu { static constexpr bool PERM = true, AFTER_DRAIN = false; bf16_t* H; const float* ss; int ldh;
    __device__ __forceinline__ void operator()(const f32x4 (&acc)[2][2][4][2], const Unit& u, int wr, int wc, int fr, int fq) const {
        const int row0 = u.pm * BM + wr * 64 + fr, col0 = u.pn * HALF + wc * 32 + 8 * fq; float rsv[2][4]; rstd8(ss, row0, 1.f, rsv);
#pragma unroll
        for (int ai = 0; ai < 2; ++ai)
#pragma unroll
            for (int m = 0; m < 4; ++m) { const int row = row0 + ai * HALF + m * 16; const float rs = rsv[ai][m];
                f32x4 o0, o1;
#pragma unroll
                for (int i = 0; i < 4; ++i) { o0[i] = fsilu(acc[ai][0][m][0][i] * rs) * (acc[ai][1][m][0][i] * rs); o1[i] = fsilu(acc[ai][0][m][1][i] * rs) * (acc[ai][1][m][1][i] * rs); }
                *(u32x4*)(H + (size_t)row * ldh + col0) = pack8(o0, o1); __builtin_amdgcn_sched_barrier(0); }
    }
};
struct EpiResid { static constexpr bool PERM = false, AFTER_DRAIN = true; const float* xin; float* x; bf16_t* xb; float* ss; float scale;
    __device__ __forceinline__ void fused(f32x4 (&acc)[2][2][4][2], const Unit& u, int wr, int wc, int fr, int fq, PG8_LAS unsigned char* lds, int wid, int lane) const {
        float scl = scale; asm volatile("" : "+v"(scl)); const int row0 = u.pm * BM + wr * 64 + fr, col0 = u.pn * BM + wc * 32 + 4 * fq;
        PG8_LAS float* P = (PG8_LAS float*)lds;
#pragma unroll
        for (int ai = 0; ai < 2; ++ai) { f32x4 xv[4][2][2];
#pragma unroll
            for (int m = 0; m < 4; ++m)
#pragma unroll
                for (int bj = 0; bj < 2; ++bj)
#pragma unroll
                    for (int n = 0; n < 2; ++n) xv[m][bj][n] = *(const f32x4*)(xin + (size_t)(row0 + ai * HALF + m * 16) * 1024 + col0 + bj * HALF + n * 16);
            __builtin_amdgcn_sched_barrier(0);
#pragma unroll
            for (int m = 0; m < 4; ++m) { const int row = row0 + ai * HALF + m * 16; float q = 0.f;
#pragma unroll
                for (int bj = 0; bj < 2; ++bj)
#pragma unroll
                    for (int n = 0; n < 2; ++n) { const size_t off = (size_t)row * 1024 + col0 + bj * HALF + n * 16;
                        f32x4 v = xv[m][bj][n] + acc[ai][bj][m][n] * scl; *(f32x4*)(x + off) = v;
                        u32x2 w; w.x = cvt_pk_bf16(v[0], v[1]); w.y = cvt_pk_bf16(v[2], v[3]); *(u32x2*)(xb + off) = w;
                        q += (v[0] * v[0] + v[1] * v[1]) + (v[2] * v[2] + v[3] * v[3]); }
                q += bperm(q, (fr + 16 * fq) ^ 16); q += bperm(q, (fr + 16 * fq) ^ 32);
                if (fq == 0) P[(ai * HALF + wr * 64 + m * 16 + fr) * 4 + wc] = q; }
            __builtin_amdgcn_sched_barrier(0); }
        asm volatile("s_waitcnt lgkmcnt(0)" ::: "memory"); __builtin_amdgcn_s_barrier(); asm volatile("" ::: "memory");
        const int tl = wid * 64 + lane;
        if (tl < 256) { const f32x4 a = *(const PG8_LAS f32x4*)(P + tl * 4); ss[(size_t)(u.pm * BM + tl) * 4 + u.pn] = (a[0] + a[1]) + (a[2] + a[3]); }
        asm volatile("s_waitcnt lgkmcnt(0)" ::: "memory"); __builtin_amdgcn_s_barrier(); asm volatile("" ::: "memory");
    }
};
struct EpiRs { static constexpr bool PERM = true, AFTER_DRAIN = false; bf16_t* O; int ldc; const float* ss; float sc;
    __device__ __forceinline__ void operator()(const f32x4 (&acc)[2][2][4][2], const Unit& u, int wr, int wc, int fr, int fq) const {
        const int row0 = u.pm * BM + wr * 64 + fr, col0 = u.pn * BM + wc * 32 + 8 * fq; float rsv[2][4];
        if (ss) rstd8(ss, row0, sc, rsv); else {
#pragma unroll
            for (int a = 0; a < 2; ++a)
#pragma unroll
                for (int b = 0; b < 4; ++b) rsv[a][b] = sc; }
#pragma unroll
        for (int ai = 0; ai < 2; ++ai)
#pragma unroll
            for (int m = 0; m < 4; ++m) { const int row = row0 + ai * HALF + m * 16; const float rs = rsv[ai][m];
#pragma unroll
                for (int bj = 0; bj < 2; ++bj) *(u32x4*)(O + (size_t)row * ldc + col0 + bj * HALF) = pack8(acc[ai][bj][m][0] * rs, acc[ai][bj][m][1] * rs); }
    }
};
struct EpiWin { static constexpr bool PERM = true, AFTER_DRAIN = false; bf16_t *xa, *xl, *gg, *q, *k, *v; const float* ss; float qscale;
    __device__ __forceinline__ void operator()(const f32x4 (&acc)[2][2][4][2], const Unit& u, int wr, int wc, int fr, int fq) const {
        const int pn = u.pn; bf16_t* dst; int ld, ct; float sc = 1.f; bool act = false;
        if (pn < 2) { dst = xa; ld = 512; ct = pn; } else if (pn < 6) { dst = xl; ld = 1024; ct = pn - 2; } else if (pn < 10) { dst = gg; ld = 1024; ct = pn - 6; act = true; }
        else if (pn < 12) { dst = q; ld = 512; ct = pn - 10; sc = qscale; } else if (pn < 14) { dst = k; ld = 512; ct = pn - 12; } else { dst = v; ld = 512; ct = pn - 14; }
        const int row0 = u.pm * BM + wr * 64 + fr, col0 = ct * BM + wc * 32 + 8 * fq; float rsv[2][4]; rstd8(ss, row0, sc, rsv);
#pragma unroll
        for (int ai = 0; ai < 2; ++ai)
#pragma unroll
            for (int m = 0; m < 4; ++m) { const int row = row0 + ai * HALF + m * 16; const float rs = rsv[ai][m];
#pragma unroll
                for (int bj = 0; bj < 2; ++bj) { f32x4 v0 = acc[ai][bj][m][0] * rs, v1 = acc[ai][bj][m][1] * rs;
                    if (act) {
#pragma unroll
                        for (int i = 0; i < 4; ++i) { v0[i] = fgelu_tanh(v0[i]); v1[i] = fgelu_tanh(v1[i]); } }
                    *(u32x4*)(dst + (size_t)row * ld + col0 + bj * HALF) = pack8(v0, v1); __builtin_amdgcn_sched_barrier(0); } }
    }
};
struct EpiGate { static constexpr bool PERM = true, AFTER_DRAIN = false; bf16_t* stash; const float* bg; const float* ss;
    __device__ __forceinline__ void operator()(const f32x4 (&acc)[2][2][4][2], const Unit& u, int wr, int wc, int fr, int fq) const {
        const int row0 = u.pm * BM + wr * 64 + fr, col0 = u.pn * BM + wc * 32 + 8 * fq; int tid_o = threadIdx.x; asm volatile("" : "+v"(tid_o)); const int tid = tid_o;
        f32x4 bv[2][2];
#pragma unroll
        for (int bj = 0; bj < 2; ++bj)
#pragma unroll
            for (int n = 0; n < 2; ++n) bv[bj][n] = *(const f32x4*)(bg + col0 + bj * HALF + 4 * n);
        float rsv[2][4]; rstd8(ss, row0, 1.f, rsv);
#pragma unroll
        for (int ai = 0; ai < 2; ++ai)
#pragma unroll
            for (int m = 0; m < 4; ++m) { const float rs = rsv[ai][m];
#pragma unroll
                for (int bj = 0; bj < 2; ++bj) { f32x4 v0 = acc[ai][bj][m][0] * rs + bv[bj][0], v1 = acc[ai][bj][m][1] * rs + bv[bj][1];
#pragma unroll
                    for (int i = 0; i < 4; ++i) { v0[i] = fsig(v0[i]); v1[i] = fsig(v1[i]); }
                    *(u32x4*)(stash + ((size_t)((ai * 4 + m) * 2 + bj) * 512 + tid) * 8) = pack8(v0, v1); __builtin_amdgcn_sched_barrier(0); } }
    }
};
struct EpiMerge { static constexpr bool PERM = true, AFTER_DRAIN = false; const bf16_t* stash; bf16_t* mg; int first;
    __device__ __forceinline__ void operator()(const f32x4 (&acc)[2][2][4][2], const Unit& u, int wr, int wc, int fr, int fq) const {
        const int row0 = u.pm * BM + wr * 64 + fr, col0 = u.pn * BM + wc * 32 + 8 * fq; int tid_o = threadIdx.x; asm volatile("" : "+v"(tid_o)); const int tid = tid_o;
#pragma unroll
        for (int ai = 0; ai < 2; ++ai) { u32x4 gw[4][2], ow[4][2];
#pragma unroll
            for (int m = 0; m < 4; ++m)
#pragma unroll
                for (int bj = 0; bj < 2; ++bj) { gw[m][bj] = ld16_sc1(stash + ((size_t)((ai * 4 + m) * 2 + bj) * 512 + tid) * 8);
                    ow[m][bj] = first ? (u32x4){0u, 0u, 0u, 0u} : ld16_sc1(mg + (size_t)(row0 + ai * HALF + m * 16) * 1024 + col0 + bj * HALF); }
#pragma unroll
            for (int m = 0; m < 4; ++m)
#pragma unroll
                for (int bj = 0; bj < 2; ++bj) { PG8_LDWAIT(gw[m][bj]); if (!first) PG8_LDWAIT(ow[m][bj]); }
            __builtin_amdgcn_sched_barrier(0);
#pragma unroll
            for (int m = 0; m < 4; ++m)
#pragma unroll
                for (int bj = 0; bj < 2; ++bj) { const u32x4 g = gw[m][bj], o = ow[m][bj]; f32x4 v0 = acc[ai][bj][m][0], v1 = acc[ai][bj][m][1];
                    v0[0] = v0[0] * bf_lo(g.x) + bf_lo(o.x); v0[1] = v0[1] * bf_hi(g.x) + bf_hi(o.x); v0[2] = v0[2] * bf_lo(g.y) + bf_lo(o.y); v0[3] = v0[3] * bf_hi(g.y) + bf_hi(o.y);
                    v1[0] = v1[0] * bf_lo(g.z) + bf_lo(o.z); v1[1] = v1[1] * bf_hi(g.z) + bf_hi(o.z); v1[2] = v1[2] * bf_lo(g.w) + bf_lo(o.w); v1[3] = v1[3] * bf_hi(g.w) + bf_hi(o.w);
                    *(u32x4*)(mg + (size_t)(row0 + ai * HALF + m * 16) * 1024 + col0 + bj * HALF) = pack8(v0, v1); }
            __builtin_amdgcn_sched_barrier(0); }
    }
};
struct EpiKV { static constexpr bool PERM = true, AFTER_DRAIN = false; bf16_t* kx; bf16_t* vt;
    __device__ __forceinline__ void operator()(const f32x4 (&acc)[2][2][4][2], const Unit& u, int wr, int wc, int fr, int fq) const {
        if (u.pn < 4) { const int row0 = u.pm * BM + wr * 64 + fr, col0 = u.pn * BM + wc * 32 + 8 * fq;
#pragma unroll
            for (int ai = 0; ai < 2; ++ai)
#pragma unroll
                for (int m = 0; m < 4; ++m)
#pragma unroll
                    for (int bj = 0; bj < 2; ++bj) *(u32x4*)(kx + (size_t)(row0 + ai * HALF + m * 16) * 1024 + col0 + bj * HALF) = pack8(acc[ai][bj][m][0], acc[ai][bj][m][1]);
        } else { const int h = u.pn - 4, b = u.pm; bf16_t* base = vt + (size_t)(b * 4 + h) * 65536;
#pragma unroll
            for (int ai = 0; ai < 2; ++ai)
#pragma unroll
                for (int m = 0; m < 4; ++m) { const int mr = ai * HALF + wr * 64 + m * 16 + fr;
#pragma unroll
                    for (int bj = 0; bj < 2; ++bj) { bf16_t* p = base + (size_t)(bj * HALF + wc * 32 + 8 * fq) * 256 + mr; asm volatile("" : "+v"(p));
#pragma unroll
                        for (int n = 0; n < 2; ++n)
#pragma unroll
                            for (int i = 0; i < 4; ++i) p[(4 * n + i) * 256] = (bf16_t)(cvt_pk_bf16(acc[ai][bj][m][n][i], 0.f) & 0xffffu);
                        __builtin_amdgcn_sched_barrier(0); } }
        }
    }
};
struct EpiSoftmaxP { static constexpr bool PERM = true, AFTER_DRAIN = true; bf16_t* P;
    __device__ __forceinline__ void fused(f32x4 (&acc)[2][2][4][2], const Unit& u, int wr, int wc, int fr, int fq, PG8_LAS unsigned char* lds, int wid, int lane) const {
        PG8_LAS f32x2* X = (PG8_LAS f32x2*)lds;
        float mloc[2][4];
#pragma unroll
        for (int ai = 0; ai < 2; ++ai)
#pragma unroll
            for (int m = 0; m < 4; ++m) { float mx = -__builtin_inff();
#pragma unroll
                for (int bj = 0; bj < 2; ++bj)
#pragma unroll
                    for (int n = 0; n < 2; ++n) { const f32x4 v = acc[ai][bj][m][n]; mx = fmaxf(mx, fmaxf(fmaxf(v[0], v[1]), fmaxf(v[2], v[3]))); }
                mx = fmaxf(mx, bperm(mx, (fr + 16 * fq) ^ 16)); mx = fmaxf(mx, bperm(mx, (fr + 16 * fq) ^ 32)); float s = 0.f;
#pragma unroll
                for (int bj = 0; bj < 2; ++bj)
#pragma unroll
                    for (int n = 0; n < 2; ++n) { f32x4 v = acc[ai][bj][m][n];
#pragma unroll
                        for (int i = 0; i < 4; ++i) { v[i] = __builtin_amdgcn_exp2f(v[i] - mx); s += v[i]; }
                        acc[ai][bj][m][n] = v; }
                s += bperm(s, (fr + 16 * fq) ^ 16); s += bperm(s, (fr + 16 * fq) ^ 32); mloc[ai][m] = mx;
                if (fq == 0) X[(ai * HALF + wr * 64 + m * 16 + fr) * 4 + wc] = (f32x2){mx, s}; __builtin_amdgcn_sched_barrier(0); }
        asm volatile("s_waitcnt lgkmcnt(0)" ::: "memory"); __builtin_amdgcn_s_barrier(); asm volatile("" ::: "memory");
#pragma unroll
        for (int ai = 0; ai < 2; ++ai)
#pragma unroll
            for (int m = 0; m < 4; ++m) { const int rl = ai * HALF + wr * 64 + m * 16 + fr;
                const f32x2 a = X[rl * 4 + 0], b = X[rl * 4 + 1], c = X[rl * 4 + 2], d = X[rl * 4 + 3];
                const float M = fmaxf(fmaxf(a.x, b.x), fmaxf(c.x, d.x));
                const float L = a.y * __builtin_amdgcn_exp2f(a.x - M) + b.y * __builtin_amdgcn_exp2f(b.x - M) + c.y * __builtin_amdgcn_exp2f(c.x - M) + d.y * __builtin_amdgcn_exp2f(d.x - M);
                const float f = __builtin_amdgcn_exp2f(mloc[ai][m] - M) / L;
#pragma unroll
                for (int bj = 0; bj < 2; ++bj) *(u32x4*)(P + (size_t)rl * 256 + bj * HALF + wc * 32 + 8 * fq) = pack8(acc[ai][bj][m][0] * f, acc[ai][bj][m][1] * f); __builtin_amdgcn_sched_barrier(0); }
        asm volatile("s_waitcnt vmcnt(0) lgkmcnt(0)" ::: "memory"); __builtin_amdgcn_s_barrier(); asm volatile("" ::: "memory");
    }
};

template <class Epi, class Sched, bool ALIGN_EPI = false, bool SP2 = false>
__device__ __forceinline__ void gemm_phase(PG8_LAS unsigned char* lds, const Gemm g, const Sched& S, const Epi& E) {
    int tid_o = threadIdx.x; asm volatile("" : "+v"(tid_o));
    const int tid = tid_o, wid = __builtin_amdgcn_readfirstlane(tid >> 6), lane = tid & 63, wr = wid >> 2, wc = wid & 3, fr = lane & 15, fq = lane >> 4;
    const int K = g.K, nt = K / BK;
    unsigned voffA[2], voffB[2];
#pragma unroll
    for (int i = 0; i < 2; ++i) { int R, C; stage_rc(tid * 16 + i * 8192, R, C); const int Rb = Epi::PERM ? ((R & ~31) + perm32(R & 31)) : R;
        voffA[i] = (unsigned)(R * g.lda + C) * 2u; voffB[i] = (unsigned)(Rb * g.ldb + C) * 2u; }
    const size_t kstep = (size_t)(BK * 2);
    const size_t hstepA = (size_t)HALF * g.lda * 2, hstepB = (size_t)HALF * g.ldb * 2;
    const size_t tstepA = 2 * hstepA, tstepB = 2 * hstepB;
    const unsigned ldsw = (unsigned)wid * 1024u;
    const int aoff = lds_byte(wr * 64 + fr, fq * 8), boff = lds_byte(wc * 32 + fr, fq * 8);
#define PG8_SA(b, h) (((b) * 2 + (h)) * HTB)
#define PG8_SB(b, h) ((4 + (b) * 2 + (h)) * HTB)
#define PG8_STAGE(bufoff, gbase, voff) do { _Pragma("unroll") for (int _i = 0; _i < 2; ++_i) \
        __builtin_amdgcn_global_load_lds((const unsigned*)((const char*)(gbase) + (voff)[_i]), (PG8_LAS unsigned*)(lds + (bufoff) + ldsw + _i * 8192), 16, 0, 0); } while (0)
#define PG8_LDA(dst, b, h) do { _Pragma("unroll") for (int m = 0; m < 4; ++m) _Pragma("unroll") for (int k = 0; k < 2; ++k) dst[m][k] = *(const PG8_LAS bf16x8*)(lds + PG8_SA(b, h) + aoff + m * 2048 + k * 1024); } while (0)
#define PG8_LDB(dst, b, h) do { _Pragma("unroll") for (int n = 0; n < 2; ++n) _Pragma("unroll") for (int k = 0; k < 2; ++k) dst[n][k] = *(const PG8_LAS bf16x8*)(lds + PG8_SB(b, h) + boff + n * 2048 + k * 1024); } while (0)
#define PG8_MMA(ai, bj, At, Bt) do { __builtin_amdgcn_s_setprio(1); _Pragma("unroll") for (int m = 0; m < 4; ++m) _Pragma("unroll") for (int n = 0; n < 2; ++n) _Pragma("unroll") for (int k = 0; k < 2; ++k) \
        acc[ai][bj][m][n] = __builtin_amdgcn_mfma_f32_16x16x32_bf16(Bt[n][k], At[m][k], acc[ai][bj][m][n], 0, 0, 0); __builtin_amdgcn_s_setprio(0); } while (0)
#define PG8_WAIT_V(n) asm volatile("s_waitcnt vmcnt(" #n ")" ::: "memory")
#define PG8_WAIT_L(n) asm volatile("s_waitcnt lgkmcnt(" #n ")" ::: "memory")
#define PG8_BAR __builtin_amdgcn_s_barrier()
#define PG8_SCHED __builtin_amdgcn_sched_barrier(0)
    Unit cur, nxt; int ui = 0;
    if (!S.next(0, cur)) return;
    f32x4 acc[2][2][4][2];
#pragma unroll
    for (int a = 0; a < 2; ++a)
#pragma unroll
        for (int b = 0; b < 2; ++b)
#pragma unroll
            for (int m = 0; m < 4; ++m)
#pragma unroll
                for (int n = 0; n < 2; ++n) acc[a][b][m][n] = (f32x4){0.f, 0.f, 0.f, 0.f};
    bf16x8 At[4][2], B0[2][2], B1[2][2];
    const char* cA = (const char*)g.A + (size_t)cur.pm * tstepA + (size_t)cur.pn * g.a_pn_off * 2; const char* cB = (const char*)g.Bt + (size_t)cur.pn * tstepB;
    S.a_ready(cur);
    if constexpr (SP2) {
        PG8_STAGE(PG8_SB(0, 0), cB, voffB); PG8_STAGE(PG8_SB(0, 1), cB + hstepB, voffB); PG8_STAGE(PG8_SA(0, 0), cA, voffA); PG8_STAGE(PG8_SA(0, 1), cA + hstepA, voffA);
        if (wr == 1) PG8_BAR;
        PG8_WAIT_V(2); PG8_BAR;
        PG8_STAGE(PG8_SB(1, 0), cB + kstep, voffB); PG8_STAGE(PG8_SA(1, 0), cA + kstep, voffA); PG8_STAGE(PG8_SB(1, 1), cB + hstepB + kstep, voffB);
        PG8_WAIT_V(6); PG8_BAR;
    } else {
        PG8_STAGE(PG8_SB(0, 0), cB, voffB); PG8_STAGE(PG8_SA(0, 0), cA, voffA); PG8_STAGE(PG8_SB(0, 1), cB + hstepB, voffB); PG8_STAGE(PG8_SA(0, 1), cA + hstepA, voffA);
        if (wr == 1) PG8_BAR;
        PG8_WAIT_V(4); PG8_BAR;
        PG8_STAGE(PG8_SB(1, 0), cB + kstep, voffB); PG8_STAGE(PG8_SA(1, 0), cA + kstep, voffA); PG8_STAGE(PG8_SB(1, 1), cB + hstepB + kstep, voffB);
        PG8_WAIT_V(6); PG8_BAR;
    }
    for (;;) {
        const bool has_next = S.next(ui + 1, nxt);
        const char* nA = has_next ? (const char*)g.A + (size_t)nxt.pm * tstepA + (size_t)nxt.pn * g.a_pn_off * 2 : cA; const char* nB = has_next ? (const char*)g.Bt + (size_t)nxt.pn * tstepB : cB;
        for (int t = 0; t < nt; t += 2) {
            const bool last = (t == nt - 2);
            const char* a1 = cA + (size_t)(t + 1) * kstep;
            const char* a2 = last ? nA : cA + (size_t)(t + 2) * kstep; const char* b2 = last ? nB : cB + (size_t)(t + 2) * kstep;
            const char* a3 = a2 + kstep; const char* b3 = b2 + kstep;
            if (last && has_next) S.a_ready(nxt);
            if constexpr (SP2) {
            PG8_LDB(B0, 0, 0); PG8_LDB(B1, 0, 1); PG8_SCHED; PG8_LDA(At, 0, 0); PG8_STAGE(PG8_SA(1, 1), a1 + hstepA, voffA);
            PG8_WAIT_V(8); PG8_WAIT_L(0); PG8_BAR; PG8_MMA(0, 0, At, B0); PG8_MMA(0, 1, At, B1); PG8_BAR; PG8_SCHED;
            PG8_LDA(At, 0, 1); PG8_STAGE(PG8_SB(0, 0), b2, voffB); PG8_STAGE(PG8_SB(0, 1), b2 + hstepB, voffB); PG8_STAGE(PG8_SA(0, 0), a2, voffA);
            PG8_WAIT_V(8); PG8_WAIT_L(0); PG8_BAR; PG8_MMA(1, 0, At, B0); PG8_MMA(1, 1, At, B1); PG8_BAR; PG8_SCHED;
            PG8_LDB(B0, 1, 0); PG8_LDB(B1, 1, 1); PG8_SCHED; PG8_LDA(At, 1, 0); PG8_STAGE(PG8_SA(0, 1), a2 + hstepA, voffA);
            PG8_WAIT_V(8); PG8_WAIT_L(0); PG8_BAR; PG8_MMA(0, 0, At, B0); PG8_MMA(0, 1, At, B1); PG8_BAR; PG8_SCHED;
            PG8_LDA(At, 1, 1); PG8_STAGE(PG8_SB(1, 0), b3, voffB); PG8_STAGE(PG8_SB(1, 1), b3 + hstepB, voffB); PG8_STAGE(PG8_SA(1, 0), a3, voffA);
            PG8_WAIT_V(8); PG8_WAIT_L(0); PG8_BAR; PG8_MMA(1, 0, At, B0); PG8_MMA(1, 1, At, B1); PG8_BAR; PG8_SCHED;
            } else {
            PG8_LDB(B0, 0, 0); PG8_SCHED; PG8_LDA(At, 0, 0); PG8_STAGE(PG8_SA(1, 1), a1 + hstepA, voffA);
            PG8_WAIT_L(8); PG8_BAR; PG8_WAIT_L(0); PG8_MMA(0, 0, At, B0); PG8_BAR; PG8_SCHED;
            PG8_LDB(B1, 0, 1); PG8_STAGE(PG8_SB(0, 0), b2, voffB);
            PG8_BAR; PG8_WAIT_L(0); PG8_MMA(0, 1, At, B1); PG8_BAR;
            PG8_LDA(At, 0, 1); PG8_STAGE(PG8_SA(0, 0), a2, voffA);
            PG8_BAR; PG8_WAIT_L(0); PG8_MMA(1, 0, At, B0); PG8_BAR; PG8_SCHED;
            PG8_STAGE(PG8_SB(0, 1), b2 + hstepB, voffB);
            PG8_WAIT_V(6); PG8_BAR; PG8_MMA(1, 1, At, B1); PG8_BAR;
            PG8_LDB(B0, 1, 0); PG8_SCHED; PG8_LDA(At, 1, 0); PG8_STAGE(PG8_SA(0, 1), a2 + hstepA, voffA);
            PG8_WAIT_L(8); PG8_BAR; PG8_WAIT_L(0); PG8_MMA(0, 0, At, B0); PG8_BAR; PG8_SCHED;
            PG8_LDB(B1, 1, 1); PG8_STAGE(PG8_SB(1, 0), b3, voffB);
            PG8_BAR; PG8_WAIT_L(0); PG8_MMA(0, 1, At, B1); PG8_BAR;
            PG8_LDA(At, 1, 1); PG8_STAGE(PG8_SA(1, 0), a3, voffA);
            PG8_BAR; PG8_WAIT_L(0); PG8_MMA(1, 0, At, B0); PG8_BAR; PG8_SCHED;
            PG8_STAGE(PG8_SB(1, 1), b3 + hstepB, voffB);
            PG8_WAIT_V(6); PG8_BAR; PG8_MMA(1, 1, At, B1); PG8_BAR;
            }
        }
        if constexpr (ALIGN_EPI) { if (wr == 0) PG8_BAR; }
        if constexpr (!Epi::AFTER_DRAIN) { E(acc, cur, wr, wc, fr, fq); S.done(cur); }
        if (!has_next) break;
#pragma unroll
        for (int a = 0; a < 2; ++a)
#pragma unroll
            for (int b = 0; b < 2; ++b)
#pragma unroll
                for (int m = 0; m < 4; ++m)
#pragma unroll
                    for (int n = 0; n < 2; ++n) acc[a][b][m][n] = (f32x4){0.f, 0.f, 0.f, 0.f};
        cur = nxt; cA = nA; cB = nB; ++ui;
        if constexpr (ALIGN_EPI) { if (wr == 1) PG8_BAR; }
    }
    PG8_WAIT_V(0);
    if constexpr (!ALIGN_EPI) { if (wr == 0) PG8_BAR; }
    PG8_BAR;
    if constexpr (Epi::AFTER_DRAIN) { E.fused(acc, cur, wr, wc, fr, fq, lds, wid, lane); S.done(cur); }
#undef PG8_SA
#undef PG8_SB
#undef PG8_STAGE
#undef PG8_LDA
#undef PG8_LDB
#undef PG8_MMA
#undef PG8_WAIT_V
#undef PG8_WAIT_L
#undef PG8_BAR
#undef PG8_SCHED
}
}
#include <hip/hip_bf16.h>
#include <cmath>
#define GAS __attribute__((address_space(1)))
#define LAS __attribute__((address_space(3)))
typedef unsigned short bf16;
typedef unsigned v4u __attribute__((ext_vector_type(4)));
typedef float f32x4 __attribute__((ext_vector_type(4)));
typedef short bf16x8 __attribute__((ext_vector_type(8)));
typedef float f32x16 __attribute__((ext_vector_type(16)));

constexpr int NWAVES = 8, NTHR = 512;
constexpr int BATCH = 2, SEQ = 8192, D = 1024, M = BATCH * SEQ, DFF = 2816, DEPTH = 2;
constexpr int INW = 7176;
constexpr size_t MiB = 1u << 20;
constexpr size_t WS_SS = 0, CTL_ZERO_BYTES = 1 * MiB;
constexpr size_t WS_WFL = 1 * MiB;
constexpr size_t WS_WAT = 1 * MiB + 256 * 1024, WS_WXT = 1 * MiB + 512 * 1024;
constexpr size_t WS_SUMM = 2 * MiB;
constexpr size_t WS_LOGF = 3 * MiB, WS_CTIL = 3 * MiB + 512 * 1024;
constexpr size_t WS_KPART = 7 * MiB;
constexpr size_t WS_MEMN = 4 * MiB, WS_KX = 5 * MiB, WS_VT = 6 * MiB;
constexpr size_t WS_W1IN = 8 * MiB, WS_W1OUT = 19 * MiB, WS_WIN = 25 * MiB, WS_WG = 33 * MiB, WS_UA = 39 * MiB, WS_UB = 40 * MiB, WS_UC = 42 * MiB,
                 WS_WO = 43 * MiB, WS_WXQ = 45 * MiB, WS_WXKV = 47 * MiB, WS_WXO = 51 * MiB, WS_W2IN = 53 * MiB, WS_W2OUT = 64 * MiB;
constexpr size_t WS_XB = 70 * MiB;
constexpr size_t WS_Q = 102 * MiB, WS_GG = 118 * MiB, WS_XA = 150 * MiB, WS_XL = 166 * MiB, WS_K = 198 * MiB, WS_V = 214 * MiB;
constexpr size_t WS_H = 102 * MiB;
constexpr size_t WS_YC = 150 * MiB;
constexpr size_t WS_STASH = 166 * MiB, WS_MG = 198 * MiB, WS_QX = 150 * MiB, WS_PBUF = 198 * MiB;
constexpr size_t WS_YA = 230 * MiB, WS_SSP = 246 * MiB, WS_END = 255 * MiB;
constexpr int LDS_BYTES = 147456;

__device__ __forceinline__ unsigned f2bf(float f) { unsigned u = __builtin_bit_cast(unsigned, f); return (u + 0x7fffu + ((u >> 16) & 1u)) >> 16; }
__device__ __forceinline__ unsigned pk2(float lo, float hi) { return f2bf(lo) | (f2bf(hi) << 16); }
__device__ __forceinline__ float bf2f(unsigned short v) { return __uint_as_float((unsigned)v << 16); }
__device__ __forceinline__ float bperm(float v, int srclane) { return __int_as_float(__builtin_amdgcn_ds_bpermute(srclane << 2, __float_as_int(v))); }
__device__ __forceinline__ float wave_sum(float v, int lane) {
#pragma unroll
    for (int o = 1; o < 64; o <<= 1) v += bperm(v, lane ^ o);
    return v;
}
__device__ __forceinline__ float flog1p(float e) { return e < 0.01f ? e * (1.f - e * (0.5f - e * 0.33333334f)) : __logf(1.f + e); }
#define LDS_WAIT() asm volatile("s_waitcnt lgkmcnt(0)" ::: "memory")

__device__ __forceinline__ void tr_item(const float* W, int ldn, int col0, int k0, const float* g, bf16* WT, int ldk, int drow0, LAS float* scr, int lane) {
    const int n4 = (lane & 15) * 4, kr = lane >> 4;
#pragma unroll
    for (int i = 0; i < 16; ++i) { const int kk = 4 * i + kr; f32x4 v = *(const f32x4*)(W + (size_t)(k0 + kk) * ldn + col0 + n4); if (g) v = v * g[k0 + kk];
        LAS float* d = scr + kk * 65 + n4; d[0] = v.x; d[1] = v.y; d[2] = v.z; d[3] = v.w; }
    LDS_WAIT(); asm volatile("" ::: "memory");
    const int c = lane & 7;
#pragma unroll
    for (int j = 0; j < 8; ++j) { const int n = (lane >> 3) + 8 * j; const LAS float* s = scr + (8 * c) * 65 + n;
        v4u o; o.x = pk2(s[0 * 65], s[1 * 65]); o.y = pk2(s[2 * 65], s[3 * 65]); o.z = pk2(s[4 * 65], s[5 * 65]); o.w = pk2(s[6 * 65], s[7 * 65]);
        *(v4u*)(WT + (size_t)(drow0 + n) * ldk + k0 + 8 * c) = o; }
    LDS_WAIT(); asm volatile("" ::: "memory");
}

#define RLX_AGENT __ATOMIC_RELAXED, __HIP_MEMORY_SCOPE_AGENT
#define XB_TMO      128
#define XB_XCNT(j)  (256  + 64 * (j))
#define XB_XSUB(j)  (1280 + 64 * (j))
#define XB_XGEN(j)  (2304 + 64 * (j))
#define XB_TOP      3328
#define XB_TOPGEN   3392
#define XCD_BAR_WORDS 3456
#define XB_SPIN_CAP (1u << 18)

__device__ __forceinline__ unsigned xb_ld(unsigned* p)              { return __hip_atomic_load(p, __ATOMIC_RELAXED, __HIP_MEMORY_SCOPE_AGENT); }
__device__ __forceinline__ unsigned xb_add(unsigned* p, unsigned v) { return __hip_atomic_fetch_add(p, v, __ATOMIC_RELAXED, __HIP_MEMORY_SCOPE_AGENT); }
__device__ __forceinline__ unsigned xb_xcc_id() { return (unsigned)__builtin_amdgcn_s_getreg((3 << 11) | 20) & 0xFu; }
#define XB_SPIN(cond, bar) do { unsigned _sp = 0; while (cond) { __builtin_amdgcn_s_sleep(1); \
    if ((++_sp & 255u) == 0u) { if (xb_ld(&(bar)[XB_TMO])) break; if (_sp > XB_SPIN_CAP) { atomicAdd(&(bar)[XB_TMO], 1u); break; } } } } while (0)

struct XcdBarrier {
    unsigned* bar; unsigned x;
    volatile LAS unsigned* st;
};

__device__ __forceinline__ XcdBarrier xcd_barrier_post(unsigned* bar, volatile LAS unsigned* st) {
    XcdBarrier b; b.bar = bar; b.x = xb_xcc_id(); b.st = st;
    if (threadIdx.x == 0) (void)xb_add(&bar[XB_XCNT(b.x)], 1u);
    return b;
}
__device__ __forceinline__ void xcd_barrier_complete(unsigned* bar, unsigned x, unsigned& nloc, unsigned& nx) {
    const unsigned G = gridDim.x * gridDim.y * gridDim.z;
    unsigned sum, cnt, mine, sp = 0u;
    for (;;) {
        sum = 0u; cnt = 0u; mine = 0u;
#pragma unroll
        for (unsigned j = 0; j < 16; ++j) { const unsigned c = xb_ld(&bar[XB_XCNT(j)]); sum += c; cnt += (c > 0u) ? 1u : 0u; mine = (j == x) ? c : mine; }
        if (sum == G) break;
        __builtin_amdgcn_s_sleep(1);
        if ((++sp & 255u) == 0u) { if (xb_ld(&bar[XB_TMO])) break; if (sp > XB_SPIN_CAP) { atomicAdd(&bar[XB_TMO], 1u); break; } }
    }
    nloc = mine > 0u ? mine : 1u; nx = cnt > 0u ? cnt : 1u;
}

__device__ __forceinline__ void xcd_barrier(const XcdBarrier& b) {
    asm volatile("s_waitcnt vmcnt(0)" ::: "memory");
    __syncthreads();
    if (threadIdx.x == 0) {
        unsigned* bar = b.bar;
        __builtin_amdgcn_s_waitcnt(0);
        unsigned nloc = b.st[0], nx = b.st[1];
        if (nloc == 0u) { xcd_barrier_complete(bar, b.x, nloc, nx); b.st[0] = nloc; b.st[1] = nx; }
        const unsigned old = xb_add(&bar[XB_XSUB(b.x)], 1u);
        const unsigned gen = old / nloc;
        if (old + 1u == (gen + 1u) * nloc) {
            __builtin_amdgcn_fence(__ATOMIC_RELEASE, "agent");
            asm volatile("s_waitcnt vmcnt(0)" ::: "memory");
            const unsigned og = xb_add(&bar[XB_TOP], 1u);
            const unsigned tg = og / nx;
            if (og + 1u == (tg + 1u) * nx) xb_add(&bar[XB_TOPGEN], 1u);
            else XB_SPIN(xb_ld(&bar[XB_TOPGEN]) == tg, bar);
            __builtin_amdgcn_fence(__ATOMIC_ACQUIRE, "agent");
            xb_add(&bar[XB_XGEN(b.x)], 1u);
            asm volatile("s_waitcnt vmcnt(0)" ::: "memory");
        } else {
            XB_SPIN(xb_ld(&bar[XB_XGEN(b.x)]) == gen, bar);
            __builtin_amdgcn_fence(__ATOMIC_ACQUIRE, "agent");
            asm volatile("s_waitcnt vmcnt(0)" ::: "memory");
        }
    }
    __syncthreads();
}

struct Args { const float* in[31]; float* out; unsigned char* ws; int pad[2]; };
typedef LAS unsigned long long* PtrTab;
__device__ __forceinline__ const float* tab_in(PtrTab tb, int k) { const unsigned long long v = tb[k]; const unsigned lo = __builtin_amdgcn_readfirstlane((unsigned)v), hi = __builtin_amdgcn_readfirstlane((unsigned)(v >> 32));
    return (const float*)(const GAS float*)(((unsigned long long)hi << 32) | lo); }
constexpr int TAB_OFF = 147456 - 512;
constexpr size_t WS_BAR = 768 * 1024; constexpr size_t WS_QCTR = 832 * 1024;

__device__ __forceinline__ void phase_prologue(PtrTab TB, unsigned char* ws, float* xout, int l, LAS unsigned char* lds, int gw, int NGW, int lane, int wave) {
    LAS float* scr = (LAS float*)(lds + wave * 16640);
#define g1 (tab_in(TB, 2) + l * D)
#define w1i (tab_in(TB, 3) + (size_t)l * D * 2 * DFF)
#define w1o (tab_in(TB, 4) + (size_t)l * DFF * D)
#define gm (tab_in(TB, 5) + l * D)
#define win (tab_in(TB, 6) + (size_t)l * D * INW)
#define wpool (tab_in(TB, 9) + (size_t)l * 4 * 128 * 128)
#define psc (tab_in(TB, 10) + l * 512)
#define wua (tab_in(TB, 11) + (size_t)l * 512 * D)
#define wra (tab_in(TB, 14) + (size_t)l * 8 * 128 * 128)
#define wrx (tab_in(TB, 16) + (size_t)l * 8 * 128 * 128)
#define wub (tab_in(TB, 19) + (size_t)l * D * D)
#define wuc (tab_in(TB, 20) + (size_t)l * 512 * D)
#define wo (tab_in(TB, 21) + (size_t)l * D * D)
#define gc (tab_in(TB, 22) + l * D)
#define gmem (tab_in(TB, 23) + l * D)
#define wxq (tab_in(TB, 24) + (size_t)l * D * D)
#define wxkv (tab_in(TB, 25) + (size_t)l * D * 2 * D)
#define wxo (tab_in(TB, 26) + (size_t)l * D * D)
#define g2 (tab_in(TB, 27) + l * D)
#define w2i (tab_in(TB, 28) + (size_t)l * D * 2 * DFF)
#define w2o (tab_in(TB, 29) + (size_t)l * DFF * D)
    constexpr int I_FI = 16 * 88, I_FO = 44 * 16, I_WIN = 16 * 64, I_WG = 16 * 48, I_UB = 16 * 16, I_UC = 8 * 16, I_RG = 32, I_SQ = 16 * 16, I_KV = 16 * 32;
    constexpr int S0 = 0, S1 = S0 + I_FI, S2 = S1 + I_FO, S3 = S2 + I_WIN, S4 = S3 + I_WG, S5 = S4 + I_UB, S6 = S5 + I_UC, S7 = S6 + I_RG, S8 = S7 + I_RG, S9 = S8 + I_SQ, S10 = S9 + I_SQ,
                  S11 = S10 + I_KV, S12 = S11 + I_SQ, S13 = S12 + I_FI, S14 = S13 + I_FO;
    for (int it = gw; it < S14; it += NGW) {
        if (it < S1 || (it >= S12 && it < S13)) {
            const bool second = it >= S12; const int r = second ? it - S12 : it; const int kb = r / 88, nb = r % 88; const int n = nb * 64;
            const int half = n >= DFF ? 1 : 0, nn = n - half * DFF; const int drow = (nn >> 7) * 256 + half * 128 + (nn & 127);
            tr_item(second ? w2i : w1i, 2 * DFF, n, kb * 64, second ? g2 : g1, (bf16*)(ws + (second ? WS_W2IN : WS_W1IN)), D, drow, scr, lane);
        } else if (it < S2 || it >= S13) {
            const bool second = it >= S13; const int r = second ? it - S13 : it - S1; const int kb = r / 16, nb = r % 16;
            tr_item(second ? w2o : w1o, D, nb * 64, kb * 64, nullptr, (bf16*)(ws + (second ? WS_W2OUT : WS_W1OUT)), DFF, nb * 64, scr, lane);
        } else if (it < S3) { const int r = it - S2, kb = r / 64, nb = r % 64; tr_item(win, INW, nb * 64, kb * 64, gm, (bf16*)(ws + WS_WIN), D, nb * 64, scr, lane);
        } else if (it < S4) { const int r = it - S3, kb = r / 48, nb = r % 48; tr_item(win, INW, 4104 + nb * 64, kb * 64, gm, (bf16*)(ws + WS_WG), D, nb * 64, scr, lane);
        } else if (it < S5) { const int r = it - S4, kb = r / 16, nb = r % 16; tr_item(wub, D, nb * 64, kb * 64, nullptr, (bf16*)(ws + WS_UB), D, nb * 64, scr, lane);
        } else if (it < S6) { const int r = it - S5, kb = r / 16, nb = r % 16; tr_item(wuc, D, nb * 64, kb * 64, nullptr, (bf16*)(ws + WS_UC), 512, nb * 64, scr, lane);
        } else if (it < S8) { const bool xg = it >= S7; const int r = xg ? it - S7 : it - S6; const int hh = r >> 2, kb = (r >> 1) & 1, nb = r & 1;
            tr_item((xg ? wrx : wra) + hh * 16384, 128, nb * 64, kb * 64, nullptr, (bf16*)(ws + (xg ? WS_WXT : WS_WAT)) + hh * 16384, 128, nb * 64, scr, lane);
        } else if (it < S9) { const int r = it - S8, kb = r / 16, nb = r % 16; tr_item(wo, D, nb * 64, kb * 64, nullptr, (bf16*)(ws + WS_WO), D, nb * 64, scr, lane);
        } else if (it < S10) { const int r = it - S9, kb = r / 16, nb = r % 16; tr_item(wxq, D, nb * 64, kb * 64, gc, (bf16*)(ws + WS_WXQ), D, nb * 64, scr, lane);
        } else if (it < S11) { const int r = it - S10, kb = r / 32, nb = r % 32; tr_item(wxkv, 2 * D, nb * 64, kb * 64, nullptr, (bf16*)(ws + WS_WXKV), D, nb * 64, scr, lane);
        } else { const int r = it - S11, kb = r / 16, nb = r % 16; tr_item(wxo, D, nb * 64, kb * 64, nullptr, (bf16*)(ws + WS_WXO), D, nb * 64, scr, lane); }
    }
    { bf16* UaT = (bf16*)(ws + WS_UA);
      for (int it = gw; it < 4 * 16 * 16; it += NGW) { const int g = it >> 8, nblk = (it >> 4) & 15, c0 = (it & 15) * 8, n = nblk * 64 + lane;
          const float* wp = wpool + ((size_t)g * 128 + c0) * 128; const float* sc = psc + g * 128; const float* ua = wua + (size_t)(g * 128) * D + n; float acc[8];
#pragma unroll
          for (int c = 0; c < 8; ++c) acc[c] = 0.f;
#pragma unroll 16
          for (int j = 0; j < 128; ++j) { const float u = ua[(size_t)j * D] * sc[j];
#pragma unroll
              for (int c = 0; c < 8; ++c) acc[c] += wp[c * 128 + j] * u; }
          v4u o; o.x = pk2(acc[0], acc[1]); o.y = pk2(acc[2], acc[3]); o.z = pk2(acc[4], acc[5]); o.w = pk2(acc[6], acc[7]);
          *(v4u*)(UaT + (size_t)n * 512 + g * 128 + c0) = o; } }
    { float* wfl = (float*)(ws + WS_WFL);
      for (int it = gw * 64 + lane; it < 8 * 1024; it += NGW * 64) { const int h = it >> 10, k = it & 1023; wfl[it] = gm[k] * win[(size_t)k * INW + 4096 + h]; } }
    { const float* mem = tab_in(TB, 1); bf16* mn = (bf16*)(ws + WS_MEMN);
      for (int r = gw; r < 512; r += NGW) { const f32x4* xr = (const f32x4*)(mem + (size_t)r * D) + lane; f32x4 v[4]; float s = 0.f;
#pragma unroll
          for (int j = 0; j < 4; ++j) { v[j] = xr[64 * j]; s += (v[j].x * v[j].x + v[j].y * v[j].y) + (v[j].z * v[j].z + v[j].w * v[j].w); }
          const float rs = rsqrtf(wave_sum(s, lane) * (1.f / D) + 1e-6f); unsigned long long* o8 = (unsigned long long*)(mn + (size_t)r * D) + lane;
#pragma unroll
          for (int j = 0; j < 4; ++j) { const f32x4 gv = *((const f32x4*)gmem + lane + 64 * j);
              o8[64 * j] = (unsigned long long)pk2(v[j].x * rs * gv.x, v[j].y * rs * gv.y) | ((unsigned long long)pk2(v[j].z * rs * gv.z, v[j].w * rs * gv.w) << 32); } } }
    if (l == 0) {
        const float* x = tab_in(TB, 0); (void)xout; bf16* xb = (bf16*)(ws + WS_XB); float* ss = (float*)(ws + WS_SSP);
        for (int r0 = gw; r0 < M; r0 += 4 * NGW) { f32x4 v[4][4]; float s[4];
#pragma unroll
            for (int q = 0; q < 4; ++q) { const int r = (r0 + q * NGW < M) ? r0 + q * NGW : r0; const f32x4* xr = (const f32x4*)(x + (size_t)r * D) + lane; s[q] = 0.f;
#pragma unroll
                for (int j = 0; j < 4; ++j) { v[q][j] = xr[64 * j]; s[q] += (v[q][j].x * v[q][j].x + v[q][j].y * v[q][j].y) + (v[q][j].z * v[q][j].z + v[q][j].w * v[q][j].w); } }
#pragma unroll
            for (int o = 1; o < 64; o <<= 1) {
#pragma unroll
                for (int q = 0; q < 4; ++q) s[q] += bperm(s[q], lane ^ o); }
#pragma unroll
            for (int q = 0; q < 4; ++q) { const int r = r0 + q * NGW; if (r < M) { unsigned long long* o8 = (unsigned long long*)(xb + (size_t)r * D) + lane;
                    if (lane < 4) ss[(size_t)r * 4 + lane] = lane == 0 ? s[q] : 0.f;
#pragma unroll
                    for (int j = 0; j < 4; ++j) { o8[64 * j] = (unsigned long long)pk2(v[q][j].x, v[q][j].y) | ((unsigned long long)pk2(v[q][j].z, v[q][j].w) << 32); } } }
        }
    }
}
#undef g1
#undef w1i
#undef w1o
#undef gm
#undef win
#undef wpool
#undef psc
#undef wua
#undef wra
#undef wrx
#undef wub
#undef wuc
#undef wo
#undef gc
#undef gmem
#undef wxq
#undef wxkv
#undef wxo
#undef g2
#undef w2i
#undef w2o
__device__ __forceinline__ void phase_fl(const bf16* xb, const float* wfl, const float* bfv, const float* ss, float* logf, int gw, int NGW, int lane) {
    for (int r0 = gw; r0 < M; r0 += 4 * NGW) {
        float acc[4][8]; v4u xv[4][2];
#pragma unroll
        for (int q = 0; q < 4; ++q) { const int r = r0 + q * NGW; const bool ok = r < M;
#pragma unroll
            for (int j = 0; j < 2; ++j) xv[q][j] = ok ? *(const v4u*)(xb + (size_t)r * D + 8 * lane + 512 * j) : (v4u){0u, 0u, 0u, 0u};
#pragma unroll
            for (int h = 0; h < 8; ++h) acc[q][h] = 0.f; }
#pragma unroll
        for (int j = 0; j < 2; ++j) { const int k0 = 8 * lane + 512 * j;
#pragma unroll
            for (int h = 0; h < 8; ++h) { const f32x4 w0 = *(const f32x4*)(wfl + h * 1024 + k0), w1 = *(const f32x4*)(wfl + h * 1024 + k0 + 4);
#pragma unroll
                for (int q = 0; q < 4; ++q) { const v4u x = xv[q][j];
                    acc[q][h] += (__uint_as_float(x.x << 16) * w0.x + __uint_as_float(x.x & 0xffff0000u) * w0.y) + (__uint_as_float(x.y << 16) * w0.z + __uint_as_float(x.y & 0xffff0000u) * w0.w)
                               + (__uint_as_float(x.z << 16) * w1.x + __uint_as_float(x.z & 0xffff0000u) * w1.y) + (__uint_as_float(x.w << 16) * w1.z + __uint_as_float(x.w & 0xffff0000u) * w1.w); } } }
        const int h = ((lane >> 5) & 1) * 4 + ((lane >> 4) & 1) * 2 + ((lane >> 3) & 1); const float bh_ = bfv[h];
#pragma unroll
        for (int q = 0; q < 4; ++q) { const int r = r0 + q * NGW;
            float v4[4], v2[2], v1;
            { const bool up = (lane & 32) != 0;
#pragma unroll
              for (int i = 0; i < 4; ++i) { const float mine = up ? acc[q][4 + i] : acc[q][i], other = up ? acc[q][i] : acc[q][4 + i]; v4[i] = mine + bperm(other, lane ^ 32); } }
            { const bool up = (lane & 16) != 0;
#pragma unroll
              for (int i = 0; i < 2; ++i) { const float mine = up ? v4[2 + i] : v4[i], other = up ? v4[i] : v4[2 + i]; v2[i] = mine + bperm(other, lane ^ 16); } }
            { const bool up = (lane & 8) != 0; const float mine = up ? v2[1] : v2[0], other = up ? v2[0] : v2[1]; v1 = mine + bperm(other, lane ^ 8); }
            v1 += bperm(v1, lane ^ 4); v1 += bperm(v1, lane ^ 2); v1 += bperm(v1, lane ^ 1);
            if (r < M) { const float z = v1 * pg8::rstd_of(ss, r) + bh_; const float ls = -(fmaxf(-z, 0.f) + flog1p(__expf(-fabsf(z)))); if ((lane & 7) == 0) logf[(size_t)r * 8 + h] = ls; } }
    }
}
__device__ __forceinline__ void cumsum_bh(const float* logf, float* ctil, int bh, LAS float* red) {
    int tid_o = threadIdx.x; asm volatile("" : "+v"(tid_o)); const int tid = tid_o, lane = tid & 63, wid = tid >> 6;
    const int b = bh >> 3, h = bh & 7; const float* src = logf + ((size_t)b * SEQ + 16 * tid) * 8 + h; float v[16]; float s = 0.f;
#pragma unroll
    for (int i = 0; i < 16; ++i) { v[i] = src[(size_t)i * 8]; s += v[i]; }
    float incl = s;
#pragma unroll
    for (int o = 1; o < 64; o <<= 1) { const float t = bperm(incl, lane - o); if (lane >= o) incl += t; }
    if (lane == 63) red[wid] = incl;
    __syncthreads();
    float base = 0.f;
#pragma unroll
    for (int w = 0; w < 8; ++w) if (w < wid) base += red[w];
    float run = base + incl - s; float* dst = ctil + (size_t)bh * SEQ + 16 * tid;
#pragma unroll
    for (int i = 0; i < 16; ++i) { run += v[i]; dst[i] = run * 1.4426950408889634f; }
    __syncthreads();
}
__device__ __forceinline__ void unpk8(const v4u xv, float (&xf)[8]) { xf[0] = __uint_as_float(xv.x << 16); xf[1] = __uint_as_float(xv.x & 0xffff0000u); xf[2] = __uint_as_float(xv.y << 16); xf[3] = __uint_as_float(xv.y & 0xffff0000u);
    xf[4] = __uint_as_float(xv.z << 16); xf[5] = __uint_as_float(xv.z & 0xffff0000u); xf[6] = __uint_as_float(xv.w << 16); xf[7] = __uint_as_float(xv.w & 0xffff0000u); }
template <int W> __device__ __forceinline__ void pool_item(const bf16* xa, bf16* ya, int m0, int cgi) {
    const int t0 = m0 & (SEQ - 1); v4u rw[W + 7];
#pragma unroll
    for (int a = 0; a < W + 7; ++a) { const int tl = a - (W - 1); rw[a] = (t0 + tl >= 0) ? *(const v4u*)(xa + (size_t)(m0 + tl) * 512 + 8 * cgi) : (v4u){0u, 0u, 0u, 0u}; }
    float s[8];
#pragma unroll
    for (int i = 0; i < 8; ++i) s[i] = 0.f;
#pragma unroll
    for (int a = 0; a < W - 1; ++a) { float xf[8]; unpk8(rw[a], xf);
#pragma unroll
        for (int i = 0; i < 8; ++i) s[i] += xf[i]; }
#pragma unroll
    for (int o = 0; o < 8; ++o) { float cur[8]; unpk8(rw[o + W - 1], cur);
#pragma unroll
        for (int i = 0; i < 8; ++i) s[i] += cur[i];
        const int t = t0 + o, cnt = (t + 1 < W) ? t + 1 : W; const float ic = 1.f / (float)cnt; v4u ov;
        ov.x = pk2(s[0] * ic - cur[0], s[1] * ic - cur[1]); ov.y = pk2(s[2] * ic - cur[2], s[3] * ic - cur[3]); ov.z = pk2(s[4] * ic - cur[4], s[5] * ic - cur[5]); ov.w = pk2(s[6] * ic - cur[6], s[7] * ic - cur[7]);
        *(v4u*)(ya + (size_t)(m0 + o) * 512 + 8 * cgi) = ov;
        float old[8]; unpk8(rw[o], old);
#pragma unroll
        for (int i = 0; i < 8; ++i) s[i] -= old[i]; }
}
__device__ __forceinline__ void phase_pool(const bf16* xa, bf16* ya, int gtid, int nthr) {
    for (int idx = gtid; idx < (M / 8) * 64; idx += nthr) { const int c16 = idx & 15, rl = (idx >> 4) & 3, g = (idx >> 6) & 3, rh = idx >> 8; const int m0 = (rh * 4 + rl) * 8, cgi = g * 16 + c16;
        if (g == 0) pool_item<2>(xa, ya, m0, cgi); else if (g == 1) pool_item<4>(xa, ya, m0, cgi); else if (g == 2) pool_item<8>(xa, ya, m0, cgi); else pool_item<16>(xa, ya, m0, cgi); }
}
__device__ __forceinline__ int crow16(int r, int hi) { return (r & 3) + 8 * (r >> 2) + 4 * hi; }
template <bool FINAL>
__device__ __forceinline__ void lru_item(LAS unsigned char* lds, int b, int hp, int ck, const bf16* xl, bf16* gg, const float* cw, const float* cb, const bf16* WaT, const bf16* WxT,
                                         const float* ba, const float* bx, const float* lam, float* summ) {
    int tid_o = threadIdx.x; asm volatile("" : "+v"(tid_o)); const int tid = tid_o, lane = tid & 63, wid = tid >> 6, r32 = lane & 31, hi = lane >> 5;
    const int t0 = ck * 128; const size_t m0 = (size_t)b * SEQ + t0; const int ch0 = hp * 256;
    constexpr int XP = 264;
    LAS bf16* xc = (LAS bf16*)lds; LAS float* h0s = (LAS float*)(lds + 128 * XP * 2);
    {
        const int cgi = tid & 31, tq = tid >> 5, c = ch0 + 8 * cgi;
        float w[4][8], bb[8];
#pragma unroll
        for (int k = 0; k < 4; ++k) { const f32x4 a = *(const f32x4*)(cw + k * 1024 + c), d = *(const f32x4*)(cw + k * 1024 + c + 4); w[k][0] = a.x; w[k][1] = a.y; w[k][2] = a.z; w[k][3] = a.w; w[k][4] = d.x; w[k][5] = d.y; w[k][6] = d.z; w[k][7] = d.w; }
        { const f32x4 a = *(const f32x4*)(cb + c), d = *(const f32x4*)(cb + c + 4); bb[0] = a.x; bb[1] = a.y; bb[2] = a.z; bb[3] = a.w; bb[4] = d.x; bb[5] = d.y; bb[6] = d.z; bb[7] = d.w; }
        v4u rw[11];
#pragma unroll
        for (int i = 0; i < 11; ++i) { const int tl = tq * 8 - 3 + i; rw[i] = (t0 + tl >= 0) ? *(const v4u*)(xl + (size_t)((long)m0 + tl) * 1024 + c) : (v4u){0u, 0u, 0u, 0u}; }
#pragma unroll
        for (int o = 0; o < 8; ++o) { float y[8];
#pragma unroll
            for (int j = 0; j < 8; ++j) y[j] = bb[j];
#pragma unroll
            for (int k = 0; k < 4; ++k) { const v4u xv = rw[o + k];
                y[0] += w[k][0] * __uint_as_float(xv.x << 16); y[1] += w[k][1] * __uint_as_float(xv.x & 0xffff0000u); y[2] += w[k][2] * __uint_as_float(xv.y << 16); y[3] += w[k][3] * __uint_as_float(xv.y & 0xffff0000u);
                y[4] += w[k][4] * __uint_as_float(xv.z << 16); y[5] += w[k][5] * __uint_as_float(xv.z & 0xffff0000u); y[6] += w[k][6] * __uint_as_float(xv.w << 16); y[7] += w[k][7] * __uint_as_float(xv.w & 0xffff0000u); }
            v4u ov; ov.x = pk2(y[0], y[1]); ov.y = pk2(y[2], y[3]); ov.z = pk2(y[4], y[5]); ov.w = pk2(y[6], y[7]);
            *(LAS v4u*)(xc + (tq * 8 + o) * XP + 8 * cgi) = ov; }
    }
    if (FINAL && tid < 256) {
        const float* sp = summ + ((size_t)b * 64 * 1024 + ch0 + tid) * 2; float h = 0.f;
        for (int c0 = 0; c0 < ck; c0 += 16) { float2 v[16];
#pragma unroll
            for (int j = 0; j < 16; ++j) v[j] = (c0 + j < ck) ? *(const float2*)(sp + (size_t)(c0 + j) * 2048) : make_float2(1.f, 0.f);
#pragma unroll
            for (int j = 0; j < 16; ++j) h = v[j].x * h + v[j].y; }
        h0s[tid] = h;
    }
    __syncthreads();
    const int hh = wid >> 2, s = wid & 3, chl = 128 * hh + 32 * s + r32, ch = ch0 + chl, head = 2 * hp + hh;
    const float bav = ba[ch], bxv = bx[ch]; const float nl = -lam[ch]; const float sp8 = 8.f * (fmaxf(nl, 0.f) + flog1p(__expf(-fabsf(nl))));
    bf16x8 fa[8], fx[8];
#pragma unroll
    for (int ks = 0; ks < 8; ++ks) { fa[ks] = *(const bf16x8*)(WaT + (size_t)head * 16384 + (32 * s + r32) * 128 + 16 * ks + 8 * hi); fx[ks] = *(const bf16x8*)(WxT + (size_t)head * 16384 + (32 * s + r32) * 128 + 16 * ks + 8 * hi); }
    float hrun = FINAL ? h0s[chl] : 0.f, Arun = 1.f;
    for (int mb = 0; mb < 4; ++mb) {
        unsigned short gv[16];
        if (FINAL) {
#pragma unroll
            for (int r = 0; r < 16; ++r) gv[r] = gg[(m0 + 32 * mb + crow16(r, hi)) * 1024 + ch]; }
        f32x16 accA = {0.f, 0.f, 0.f, 0.f, 0.f, 0.f, 0.f, 0.f, 0.f, 0.f, 0.f, 0.f, 0.f, 0.f, 0.f, 0.f}, accX = accA;
#pragma unroll
        for (int ks = 0; ks < 8; ++ks) { const bf16x8 af = *(const LAS bf16x8*)(xc + (32 * mb + r32) * XP + 128 * hh + 16 * ks + 8 * hi);
            accA = __builtin_amdgcn_mfma_f32_32x32x16_bf16(af, fa[ks], accA, 0, 0, 0); accX = __builtin_amdgcn_mfma_f32_32x32x16_bf16(af, fx[ks], accX, 0, 0, 0); }
        float a[16], u[16];
#pragma unroll
        for (int r = 0; r < 16; ++r) { const int tok = 32 * mb + crow16(r, hi); const float xcv = bf2f(xc[tok * XP + chl]);
            const float rg = pg8::fsig(accA[r] + bav), la = -rg * sp8, av = __expf(la), mult = sqrtf(fmaxf(1.f - av * av, 0.f)), ig = pg8::fsig(accX[r] + bxv);
            a[r] = av; u[r] = mult * ig * xcv; }
        float As[4], Hs[4], Ap[4], Hp[4], hin[4];
#pragma unroll
        for (int g = 0; g < 4; ++g) { float Aq = 1.f, Hq = 0.f;
#pragma unroll
            for (int i = 0; i < 4; ++i) { Hq = a[4 * g + i] * Hq + u[4 * g + i]; Aq *= a[4 * g + i]; }
            As[g] = Aq; Hs[g] = Hq; Ap[g] = bperm(Aq, lane ^ 32); Hp[g] = bperm(Hq, lane ^ 32); }
#pragma unroll
        for (int g = 0; g < 4; ++g) { const float A0 = hi ? Ap[g] : As[g], H0 = hi ? Hp[g] : Hs[g], A1 = hi ? As[g] : Ap[g], H1 = hi ? Hs[g] : Hp[g];
            const float hA = hrun, hB = A0 * hA + H0; hrun = A1 * hB + H1; Arun *= A0 * A1; hin[g] = hi ? hB : hA; }
        if (FINAL) {
#pragma unroll
            for (int g = 0; g < 4; ++g) { float hc = hin[g];
#pragma unroll
                for (int i = 0; i < 4; ++i) { const int r = 4 * g + i; hc = a[r] * hc + u[r]; gv[r] = (unsigned short)f2bf(hc * bf2f(gv[r])); } }
#pragma unroll
            for (int r = 0; r < 16; ++r) gg[(m0 + 32 * mb + crow16(r, hi)) * 1024 + ch] = gv[r];
        }
    }
    if (!FINAL && hi == 0) { float* sp = summ + (((size_t)b * 64 + ck) * 1024 + ch) * 2; sp[0] = Arun; sp[1] = hrun; }
    __syncthreads();
}
__device__ __forceinline__ void phase_final(float* x, const float* g, int gw, int NGW, int lane) {
    f32x4 gv[4];
#pragma unroll
    for (int j = 0; j < 4; ++j) gv[j] = *((const f32x4*)g + lane + 64 * j);
    for (int r0 = gw; r0 < M; r0 += 4 * NGW) { f32x4 v[4][4]; float s[4];
#pragma unroll
        for (int q = 0; q < 4; ++q) { const int r = (r0 + q * NGW < M) ? r0 + q * NGW : r0; const f32x4* xr = (const f32x4*)(x + (size_t)r * D) + lane; s[q] = 0.f;
#pragma unroll
            for (int j = 0; j < 4; ++j) { v[q][j] = xr[64 * j]; s[q] += (v[q][j].x * v[q][j].x + v[q][j].y * v[q][j].y) + (v[q][j].z * v[q][j].z + v[q][j].w * v[q][j].w); } }
#pragma unroll
        for (int o = 1; o < 64; o <<= 1) {
#pragma unroll
            for (int q = 0; q < 4; ++q) s[q] += bperm(s[q], lane ^ o); }
#pragma unroll
        for (int q = 0; q < 4; ++q) { const int r = r0 + q * NGW; if (r < M) { const float rs = rsqrtf(s[q] * (1.f / D) + 1e-6f); f32x4* xr = (f32x4*)(x + (size_t)r * D) + lane;
#pragma unroll
                for (int j = 0; j < 4; ++j) xr[64 * j] = (f32x4){v[q][j].x * rs * gv[j].x, v[q][j].y * rs * gv[j].y, v[q][j].z * rs * gv[j].z, v[q][j].w * rs * gv[j].w}; } }
    }
}
__device__ __forceinline__ void phase_kmax(const bf16* K, float* kpart, int gw, int NGW, int lane) {
    float m0 = 0.f, m1 = 0.f;
#pragma unroll 8
    for (int r = gw; r < M; r += NGW) { const v4u w = *(const v4u*)(K + (size_t)r * 512 + 8 * lane);
        const float a0 = __uint_as_float(w.x << 16), a1 = __uint_as_float(w.x & 0xffff0000u), a2 = __uint_as_float(w.y << 16), a3 = __uint_as_float(w.y & 0xffff0000u);
        const float a4 = __uint_as_float(w.z << 16), a5 = __uint_as_float(w.z & 0xffff0000u), a6 = __uint_as_float(w.w << 16), a7 = __uint_as_float(w.w & 0xffff0000u);
        float s = (a0 * a0 + a1 * a1) + (a2 * a2 + a3 * a3) + (a4 * a4 + a5 * a5) + (a6 * a6 + a7 * a7);
        s += bperm(s, lane ^ 1); s += bperm(s, lane ^ 2); s += bperm(s, lane ^ 4);
        if (r < SEQ) m0 = fmaxf(m0, s); else m1 = fmaxf(m1, s); }
    if ((lane & 7) == 0) { kpart[((size_t)gw * 2 + 0) * 8 + (lane >> 3)] = m0; kpart[((size_t)gw * 2 + 1) * 8 + (lane >> 3)] = m1; }
}
constexpr float FOX_C2 = 0.125f * 1.4426950408889634f;
constexpr float FOX_SKIP = 64.f;
constexpr int FOX_KP = 72;
constexpr int FOX_BUF = 2 * 64 * FOX_KP * 2 + 256;
__device__ __forceinline__ void fox_unit(LAS unsigned char* lds, int b, int h, int qb, const bf16* Q, const bf16* K, const bf16* V, bf16* O, const float* ct, const float* kpart, int nparts) {
    int tid_o = threadIdx.x; asm volatile("" : "+v"(tid_o)); const int tid = tid_o, lane = tid & 63, wid = tid >> 6, r32 = lane & 31, hi = lane >> 5;
    const size_t rowbase = (size_t)b * SEQ; const int q0 = qb * 256, NT = 4 * qb + 4;
    const bf16* Qw = Q + (rowbase + q0 + wid * 32 + r32) * 512 + h * 64;
    bf16x8 qr[4];
#pragma unroll
    for (int d0 = 0; d0 < 4; ++d0) qr[d0] = *(const bf16x8*)(Qw + 16 * d0 + 8 * hi);
    LAS float* red = (LAS float*)(lds + 2 * FOX_BUF); LAS int* tsl = (LAS int*)(lds + 2 * FOX_BUF + 128);
    { float qn = 0.f;
#pragma unroll
      for (int d0 = 0; d0 < 4; ++d0) { const v4u w = __builtin_bit_cast(v4u, qr[d0]);
          const float a0 = __uint_as_float(w.x << 16), a1 = __uint_as_float(w.x & 0xffff0000u), a2 = __uint_as_float(w.y << 16), a3 = __uint_as_float(w.y & 0xffff0000u);
          const float a4 = __uint_as_float(w.z << 16), a5 = __uint_as_float(w.z & 0xffff0000u), a6 = __uint_as_float(w.w << 16), a7 = __uint_as_float(w.w & 0xffff0000u);
          qn += (a0 * a0 + a1 * a1) + (a2 * a2 + a3 * a3) + (a4 * a4 + a5 * a5) + (a6 * a6 + a7 * a7); }
      qn += bperm(qn, lane ^ 32);
#pragma unroll
      for (int o = 1; o < 32; o <<= 1) qn = fmaxf(qn, bperm(qn, lane ^ o));
      __syncthreads();
      float km = 0.f;
      for (int i = tid; i < nparts; i += NTHR) km = fmaxf(km, kpart[((size_t)i * 2 + b) * 8 + h]);
#pragma unroll
      for (int o = 1; o < 64; o <<= 1) km = fmaxf(km, bperm(km, lane ^ o));
      if (lane == 0) { red[wid] = qn; red[8 + wid] = km; } if (tid == 0) tsl[0] = 4 * qb;
      __syncthreads();
      float q2 = red[0], k2 = red[8];
#pragma unroll
      for (int w = 1; w < 8; ++w) { q2 = fmaxf(q2, red[w]); k2 = fmaxf(k2, red[8 + w]); }
      const float thr = 2.f * sqrtf(q2) * sqrtf(k2) * 1.0001f + FOX_SKIP;
      const float c0 = ct[q0];
      if (tid < 4 * qb && ct[64 * tid + 63] - c0 <= thr) atomicMin((int*)tsl, tid);
      __syncthreads(); }
    const int T0 = tsl[0];
    const int skey = tid >> 3, sd = (tid & 7) * 8;
    const bf16* kp = K + (rowbase + skey) * 512 + h * 64 + sd; const bf16* vp = V + (rowbase + skey) * 512 + h * 64 + sd;
    v4u kreg = *(const v4u*)(kp + (size_t)T0 * 64 * 512), vreg = *(const v4u*)(vp + (size_t)T0 * 64 * 512); float creg = (tid < 64) ? ct[64 * T0 + tid] : 0.f;
    __syncthreads();
    { LAS unsigned char* buf0 = lds + (T0 & 1) * FOX_BUF; LAS bf16* Ks = (LAS bf16*)buf0; LAS bf16* Vt = Ks + 64 * FOX_KP; LAS float* Cs = (LAS float*)(buf0 + 2 * 64 * FOX_KP * 2);
      *(LAS v4u*)(Ks + skey * FOX_KP + sd) = kreg;
      Vt[(sd + 0) * FOX_KP + skey] = (bf16)(vreg.x & 0xffffu); Vt[(sd + 1) * FOX_KP + skey] = (bf16)(vreg.x >> 16); Vt[(sd + 2) * FOX_KP + skey] = (bf16)(vreg.y & 0xffffu); Vt[(sd + 3) * FOX_KP + skey] = (bf16)(vreg.y >> 16);
      Vt[(sd + 4) * FOX_KP + skey] = (bf16)(vreg.z & 0xffffu); Vt[(sd + 5) * FOX_KP + skey] = (bf16)(vreg.z >> 16); Vt[(sd + 6) * FOX_KP + skey] = (bf16)(vreg.w & 0xffffu); Vt[(sd + 7) * FOX_KP + skey] = (bf16)(vreg.w >> 16);
      if (tid < 64) Cs[tid] = creg; }
    if (T0 + 1 < NT) { kreg = *(const v4u*)(kp + (size_t)(T0 + 1) * 64 * 512); vreg = *(const v4u*)(vp + (size_t)(T0 + 1) * 64 * 512); if (tid < 64) creg = ct[64 * (T0 + 1) + tid]; }
    float m = -1e30f, l = 0.f; f32x16 o0, o1;
#pragma unroll
    for (int r = 0; r < 16; ++r) { o0[r] = 0.f; o1[r] = 0.f; }
    for (int t = T0; t < NT; ++t) {
        __syncthreads();
        if (t + 1 < NT) { LAS unsigned char* bufn = lds + ((t + 1) & 1) * FOX_BUF; LAS bf16* Ks = (LAS bf16*)bufn; LAS bf16* Vt = Ks + 64 * FOX_KP; LAS float* Cs = (LAS float*)(bufn + 2 * 64 * FOX_KP * 2);
            *(LAS v4u*)(Ks + skey * FOX_KP + sd) = kreg;
            Vt[(sd + 0) * FOX_KP + skey] = (bf16)(vreg.x & 0xffffu); Vt[(sd + 1) * FOX_KP + skey] = (bf16)(vreg.x >> 16); Vt[(sd + 2) * FOX_KP + skey] = (bf16)(vreg.y & 0xffffu); Vt[(sd + 3) * FOX_KP + skey] = (bf16)(vreg.y >> 16);
            Vt[(sd + 4) * FOX_KP + skey] = (bf16)(vreg.z & 0xffffu); Vt[(sd + 5) * FOX_KP + skey] = (bf16)(vreg.z >> 16); Vt[(sd + 6) * FOX_KP + skey] = (bf16)(vreg.w & 0xffffu); Vt[(sd + 7) * FOX_KP + skey] = (bf16)(vreg.w >> 16);
            if (tid < 64) Cs[tid] = creg;
            if (t + 2 < NT) { kreg = *(const v4u*)(kp + (size_t)(t + 2) * 64 * 512); vreg = *(const v4u*)(vp + (size_t)(t + 2) * 64 * 512); if (tid < 64) creg = ct[64 * (t + 2) + tid]; } }
        const int jb = t - (NT - 4);
        if (jb >= 0 && 64 * jb > 32 * wid + 31) continue;
        LAS unsigned char* buf = lds + (t & 1) * FOX_BUF; const LAS bf16* Ks = (const LAS bf16*)buf; const LAS bf16* Vt = Ks + 64 * FOX_KP; const LAS float* Cs = (const LAS float*)(buf + 2 * 64 * FOX_KP * 2);
        f32x16 p0, p1;
#pragma unroll
        for (int g = 0; g < 4; ++g) { const f32x4 a = *(const LAS f32x4*)(Cs + 8 * g + 4 * hi), c = *(const LAS f32x4*)(Cs + 32 + 8 * g + 4 * hi);
            p0[4 * g + 0] = -a[0]; p0[4 * g + 1] = -a[1]; p0[4 * g + 2] = -a[2]; p0[4 * g + 3] = -a[3]; p1[4 * g + 0] = -c[0]; p1[4 * g + 1] = -c[1]; p1[4 * g + 2] = -c[2]; p1[4 * g + 3] = -c[3]; }
#pragma unroll
        for (int d0 = 0; d0 < 4; ++d0) { const bf16x8 a0 = *(const LAS bf16x8*)(Ks + r32 * FOX_KP + 16 * d0 + 8 * hi), a1 = *(const LAS bf16x8*)(Ks + (32 + r32) * FOX_KP + 16 * d0 + 8 * hi);
            p0 = __builtin_amdgcn_mfma_f32_32x32x16_bf16(a0, qr[d0], p0, 0, 0, 0); p1 = __builtin_amdgcn_mfma_f32_32x32x16_bf16(a1, qr[d0], p1, 0, 0, 0); }
        if (jb >= 0) { const int qrel = 32 * wid + r32, kb = 64 * jb + 4 * hi;
#pragma unroll
            for (int r = 0; r < 16; ++r) { const int kv = kb + (r & 3) + 8 * (r >> 2); if (kv > qrel) p0[r] = -__builtin_inff(); if (kv + 32 > qrel) p1[r] = -__builtin_inff(); } }
        float mx = fmaxf(p0[0], p1[0]);
#pragma unroll
        for (int r = 1; r < 16; ++r) mx = fmaxf(mx, fmaxf(p0[r], p1[r]));
        mx = fmaxf(mx, bperm(mx, lane ^ 32));
        const float mn = fmaxf(m, mx), alpha = __builtin_amdgcn_exp2f(m - mn); m = mn;
        float sum = 0.f;
#pragma unroll
        for (int r = 0; r < 16; ++r) { p0[r] = __builtin_amdgcn_exp2f(p0[r] - mn); p1[r] = __builtin_amdgcn_exp2f(p1[r] - mn); sum += p0[r] + p1[r]; }
        l = l * alpha + sum;
#pragma unroll
        for (int r = 0; r < 16; ++r) { o0[r] *= alpha; o1[r] *= alpha; }
        bf16x8 pb[4];
        { v4u w;
          w.x = pg8::cvt_pk_bf16(p0[0], p0[1]); w.y = pg8::cvt_pk_bf16(p0[2], p0[3]); w.z = pg8::cvt_pk_bf16(p0[4], p0[5]); w.w = pg8::cvt_pk_bf16(p0[6], p0[7]); pb[0] = __builtin_bit_cast(bf16x8, w);
          w.x = pg8::cvt_pk_bf16(p0[8], p0[9]); w.y = pg8::cvt_pk_bf16(p0[10], p0[11]); w.z = pg8::cvt_pk_bf16(p0[12], p0[13]); w.w = pg8::cvt_pk_bf16(p0[14], p0[15]); pb[1] = __builtin_bit_cast(bf16x8, w);
          w.x = pg8::cvt_pk_bf16(p1[0], p1[1]); w.y = pg8::cvt_pk_bf16(p1[2], p1[3]); w.z = pg8::cvt_pk_bf16(p1[4], p1[5]); w.w = pg8::cvt_pk_bf16(p1[6], p1[7]); pb[2] = __builtin_bit_cast(bf16x8, w);
          w.x = pg8::cvt_pk_bf16(p1[8], p1[9]); w.y = pg8::cvt_pk_bf16(p1[10], p1[11]); w.z = pg8::cvt_pk_bf16(p1[12], p1[13]); w.w = pg8::cvt_pk_bf16(p1[14], p1[15]); pb[3] = __builtin_bit_cast(bf16x8, w); }
#pragma unroll
        for (int mm = 0; mm < 4; ++mm) {
            typedef unsigned u32x2v __attribute__((ext_vector_type(2)));
            const u32x2v a0l = *(const LAS u32x2v*)(Vt + r32 * FOX_KP + 16 * mm + 4 * hi), a0h = *(const LAS u32x2v*)(Vt + r32 * FOX_KP + 16 * mm + 8 + 4 * hi);
            const u32x2v a1l = *(const LAS u32x2v*)(Vt + (32 + r32) * FOX_KP + 16 * mm + 4 * hi), a1h = *(const LAS u32x2v*)(Vt + (32 + r32) * FOX_KP + 16 * mm + 8 + 4 * hi);
            const v4u A0 = {a0l.x, a0l.y, a0h.x, a0h.y}, A1 = {a1l.x, a1l.y, a1h.x, a1h.y};
            o0 = __builtin_amdgcn_mfma_f32_32x32x16_bf16(__builtin_bit_cast(bf16x8, A0), pb[mm], o0, 0, 0, 0);
            o1 = __builtin_amdgcn_mfma_f32_32x32x16_bf16(__builtin_bit_cast(bf16x8, A1), pb[mm], o1, 0, 0, 0); }
    }
    l += bperm(l, lane ^ 32); const float inv = 1.f / l;
    bf16* Ow = O + (rowbase + q0 + wid * 32 + r32) * 512 + h * 64;
#pragma unroll
    for (int g = 0; g < 4; ++g) { typedef unsigned u32x2v __attribute__((ext_vector_type(2)));
        u32x2v w0, w1; w0.x = pg8::cvt_pk_bf16(o0[4 * g] * inv, o0[4 * g + 1] * inv); w0.y = pg8::cvt_pk_bf16(o0[4 * g + 2] * inv, o0[4 * g + 3] * inv);
        w1.x = pg8::cvt_pk_bf16(o1[4 * g] * inv, o1[4 * g + 1] * inv); w1.y = pg8::cvt_pk_bf16(o1[4 * g + 2] * inv, o1[4 * g + 3] * inv);
        *(u32x2v*)(Ow + 8 * g + 4 * hi) = w0; *(u32x2v*)(Ow + 32 + 8 * g + 4 * hi) = w1; }
    __syncthreads();
}
__global__ void __launch_bounds__(NTHR, 2) hybrid_fwd(Args args) {
    extern __shared__ __attribute__((aligned(16))) unsigned char lds_raw[];
    cg::grid_group grid = cg::this_grid();
    LAS unsigned char* lds = (LAS unsigned char*)lds_raw;
    int tid = threadIdx.x, lane = tid & 63, wave = __builtin_amdgcn_readfirstlane(tid >> 6);
    int G = gridDim.x, bx = blockIdx.x;
    int vcu = (G % 8 == 0) ? (bx % 8) * (G / 8) + bx / 8 : bx;
    int gw = vcu * NWAVES + wave; int NGW = G * NWAVES;
    PtrTab TB = (PtrTab)(lds + TAB_OFF);
    if (tid == 0) {
#pragma unroll
        for (int i = 0; i < 31; ++i) TB[i] = (unsigned long long)args.in[i];
    }
    if (tid == 1) { TB[40] = 0ull; }
    __syncthreads();
    (void)xcd_barrier_post((unsigned*)(args.ws + WS_BAR), (volatile LAS unsigned*)(lds + TAB_OFF + 320));
    grid.sync();
    unsigned char* ws = args.ws;
    float* X = args.out;
    float* SS = (float*)(ws + WS_SSP);
    bf16* XB = (bf16*)(ws + WS_XB);
    bf16* HB = (bf16*)(ws + WS_H);
    constexpr float C2X = 0.0625f * 1.4426950408889634f;
#define GSYNC() do { asm volatile("s_waitcnt vmcnt(0) lgkmcnt(0)" ::: "memory"); { XcdBarrier xb_; xb_.bar = (unsigned*)(ws + WS_BAR); xb_.x = xb_xcc_id(); xb_.st = (volatile LAS unsigned*)(lds + TAB_OFF + 320); xcd_barrier(xb_); } tid = threadIdx.x; asm volatile("" : "+v"(tid)); lane = tid & 63; wave = __builtin_amdgcn_readfirstlane(tid >> 6); G = gridDim.x; bx = blockIdx.x; asm volatile("" : "+s"(G), "+s"(bx)); vcu = (G % 8 == 0) ? (bx % 8) * (G / 8) + bx / 8 : bx; gw = vcu * NWAVES + wave; NGW = G * NWAVES; { unsigned long long wsi_ = (unsigned long long)ws; asm volatile("" : "+s"(wsi_)); ws = (unsigned char*)(GAS unsigned char*)wsi_; } } while (0)

    for (int l = 0; l < DEPTH; ++l) {
        float* ss0 = SS + (size_t)(4 * l + 0) * M * 4; float* ss1 = SS + (size_t)(4 * l + 1) * M * 4; float* ss2 = SS + (size_t)(4 * l + 2) * M * 4; float* ss3 = SS + (size_t)(4 * l + 3) * M * 4; float* ss4 = SS + (size_t)(4 * l + 4) * M * 4;
        phase_prologue(TB, ws, X, l, lds, gw, NGW, lane, wave);
        GSYNC();
        { pg8::Gemm g{XB, (const bf16*)(ws + WS_W1IN), M, 2 * DFF, D, D, D, 0}; pg8::StaticOrder S; S.init(M, 2 * DFF, G, bx);
          pg8::EpiSwiglu E{HB, ss0, DFF};
          pg8::gemm_phase<pg8::EpiSwiglu, pg8::StaticOrder, true, true>(lds, g, S, E); }
        if (bx >= G / 2) { pg8::Gemm g{(const bf16*)(ws + WS_MEMN), (const bf16*)(ws + WS_WXKV), 512, 2 * D, D, D, D, 0}; pg8::StaticOrder S; S.init(512, 2 * D, G, bx - G / 2);
          pg8::EpiKV E{(bf16*)(ws + WS_KX), (bf16*)(ws + WS_VT)};
          pg8::gemm_phase<pg8::EpiKV, pg8::StaticOrder, true, true>(lds, g, S, E); }
        GSYNC();
        { pg8::Gemm g{HB, (const bf16*)(ws + WS_W1OUT), M, D, DFF, DFF, DFF, 0}; pg8::StaticOrder S; S.init(M, D, G, bx); pg8::Unit u_;
          pg8::EpiResid E{l == 0 ? tab_in(TB, 0) : (const float*)X, X, XB, ss1, 0.5f};
          for (int i_ = 0; S.next(i_, u_); ++i_) { const pg8::OneUnit O1{u_.pm, u_.pn}; pg8::gemm_phase<pg8::EpiResid, pg8::OneUnit, false, true>(lds, g, O1, E); } }
        GSYNC();
        { pg8::Gemm g{XB, (const bf16*)(ws + WS_WIN), M, 4096, D, D, D, 0}; pg8::StaticOrder S; S.init(M, 4096, G, bx);
          pg8::EpiWin E{(bf16*)(ws + WS_XA), (bf16*)(ws + WS_XL), (bf16*)(ws + WS_GG), (bf16*)(ws + WS_Q), (bf16*)(ws + WS_K), (bf16*)(ws + WS_V), ss1, FOX_C2};
          pg8::gemm_phase<pg8::EpiWin, pg8::StaticOrder, true, true>(lds, g, S, E); }
        phase_fl(XB, (const float*)(ws + WS_WFL), tab_in(TB, 7) + l * 8, ss1, (float*)(ws + WS_LOGF), gw, NGW, lane);
        GSYNC();
        if (vcu < 16) cumsum_bh((const float*)(ws + WS_LOGF), (float*)(ws + WS_CTIL), vcu, (LAS float*)lds);
        for (int it = vcu; it < 512; it += G)
            lru_item<false>(lds, it >> 8, (it >> 6) & 3, it & 63, (const bf16*)(ws + WS_XL), (bf16*)(ws + WS_GG), tab_in(TB, 12) + (size_t)l * 4 * D, tab_in(TB, 13) + l * D, (const bf16*)(ws + WS_WAT), (const bf16*)(ws + WS_WXT),
                            tab_in(TB, 15) + l * D, tab_in(TB, 17) + l * D, tab_in(TB, 18) + l * D, (float*)(ws + WS_SUMM));
        phase_pool((const bf16*)(ws + WS_XA), (bf16*)(ws + WS_YA), vcu * NTHR + tid, G * NTHR);
        phase_kmax((const bf16*)(ws + WS_K), (float*)(ws + WS_KPART), gw, NGW, lane);
        GSYNC();
        for (int it = vcu; it < 512; it += G)
            lru_item<true>(lds, it >> 8, (it >> 6) & 3, (it & 256) ? 63 - (it & 63) : (it & 63),
                            (const bf16*)(ws + WS_XL), (bf16*)(ws + WS_GG), tab_in(TB, 12) + (size_t)l * 4 * D, tab_in(TB, 13) + l * D, (const bf16*)(ws + WS_WAT), (const bf16*)(ws + WS_WXT),
                           tab_in(TB, 15) + l * D, tab_in(TB, 17) + l * D, tab_in(TB, 18) + l * D, (float*)(ws + WS_SUMM));
        {
            unsigned* qc = (unsigned*)(ws + WS_QCTR) + (size_t)l * 64; LAS int* slot = (LAS int*)(lds + TAB_OFF + 384); LAS float* cl = (LAS float*)(lds + 2 * FOX_BUF + 256); LAS int* ord = (LAS int*)(lds + 2 * FOX_BUF + 384);
            __syncthreads();
            if (tid < 16) cl[tid] = ((const float*)(ws + WS_CTIL))[(size_t)tid * SEQ + SEQ - 1];
            __syncthreads();
            if (tid < 16) { const float ci = cl[tid]; int rk = 0;
#pragma unroll
                for (int j = 0; j < 16; ++j) { const float cj = cl[j]; rk += (cj > ci || (cj == ci && j < tid)) ? 1 : 0; }
                ord[rk] = tid; }
            for (;;) { __syncthreads(); if (tid == 0) slot[0] = (int)__hip_atomic_fetch_add(qc, 1u, __ATOMIC_RELAXED, __HIP_MEMORY_SCOPE_AGENT); __syncthreads();
                const int qi = slot[0]; if (qi >= 512) break; const int bh = ord[qi >> 5], qb = 31 - (qi & 31);
                fox_unit(lds, bh >> 3, bh & 7, qb, (const bf16*)(ws + WS_Q), (const bf16*)(ws + WS_K), (const bf16*)(ws + WS_V), (bf16*)(ws + WS_YC), (const float*)(ws + WS_CTIL) + (size_t)bh * SEQ, (const float*)(ws + WS_KPART), NGW); }
        }
        GSYNC();
        { pg8::StaticOrder S; S.init(M, D, G, bx); pg8::Unit u;
          bf16* stash = (bf16*)(ws + WS_STASH) + (size_t)bx * 65536; bf16* mg = (bf16*)(ws + WS_MG);
          for (int i = 0; S.next(i, u); ++i) { const pg8::OneUnit O1{u.pm, u.pn};
#pragma unroll 1
              for (int br = 0; br < 3; ++br) {
                  { pg8::Gemm g{XB, (const bf16*)(ws + WS_WG) + (size_t)br * D * D, M, D, D, D, D, 0}; pg8::EpiGate E{stash, tab_in(TB, 8) + (size_t)l * 3 * D + br * D, ss1};
                    pg8::gemm_phase<pg8::EpiGate, pg8::OneUnit, true, true>(lds, g, O1, E); }
                  asm volatile("s_waitcnt vmcnt(0)" ::: "memory"); __syncthreads();
                  const bf16* Ab = br == 0 ? (const bf16*)(ws + WS_YA) : br == 1 ? (const bf16*)(ws + WS_GG) : (const bf16*)(ws + WS_YC);
                  const bf16* Ub = br == 0 ? (const bf16*)(ws + WS_UA) : br == 1 ? (const bf16*)(ws + WS_UB) : (const bf16*)(ws + WS_UC);
                  const int Kb = br == 1 ? 1024 : 512;
                  { pg8::Gemm g{Ab, Ub, M, D, Kb, Kb, Kb, 0}; pg8::EpiMerge E{stash, mg, br == 0 ? 1 : 0};
                    pg8::gemm_phase<pg8::EpiMerge, pg8::OneUnit, true, true>(lds, g, O1, E); }
                  asm volatile("s_waitcnt vmcnt(0)" ::: "memory"); __syncthreads();
              } } }
        GSYNC();
        { pg8::Gemm g{(const bf16*)(ws + WS_MG), (const bf16*)(ws + WS_WO), M, D, D, D, D, 0}; pg8::StaticOrder S; S.init(M, D, G, bx); pg8::Unit u_;
          pg8::EpiResid E{X, X, XB, ss2, 1.0f};
          for (int i_ = 0; S.next(i_, u_); ++i_) { const pg8::OneUnit O1{u_.pm, u_.pn}; pg8::gemm_phase<pg8::EpiResid, pg8::OneUnit, false, true>(lds, g, O1, E); } }
        GSYNC();
        { bf16* pb = (bf16*)(ws + WS_PBUF) + (size_t)bx * 65536; const pg8::OneUnit O1{0, 0};
          for (int uid = vcu; uid < 256; uid += G) { const int rt = uid >> 2, h = uid & 3, b = rt >> 5;
              int KX = 256; asm volatile("" : "+s"(KX));
              bf16* qo = (bf16*)(ws + WS_QX) + (size_t)rt * 256 * D + h * 256; bf16* qs = (bf16*)(ws + WS_Q) + (size_t)bx * 65536;
              { pg8::Gemm g{XB + (size_t)rt * 256 * D, (const bf16*)(ws + WS_WXQ) + (size_t)h * 256 * D, 256, 256, D, D, D, 0}; pg8::EpiRs E{qs, 256, ss2 + (size_t)rt * 256 * 4, C2X};
                pg8::gemm_phase<pg8::EpiRs, pg8::OneUnit, true, true>(lds, g, O1, E); }
              asm volatile("s_waitcnt vmcnt(0)" ::: "memory"); __syncthreads();
              { pg8::Gemm g{qs, (const bf16*)(ws + WS_KX) + (size_t)b * 256 * D + h * 256, 256, 256, KX, 256, D, 0}; pg8::EpiSoftmaxP E{pb};
                pg8::gemm_phase<pg8::EpiSoftmaxP, pg8::OneUnit, false, true>(lds, g, O1, E); }
              asm volatile("s_waitcnt vmcnt(0)" ::: "memory"); __syncthreads();
              { pg8::Gemm g{pb, (const bf16*)(ws + WS_VT) + (size_t)(b * 4 + h) * 65536, 256, 256, KX, 256, 256, 0}; pg8::EpiRs E{qo, D, nullptr, 1.0f};
                pg8::gemm_phase<pg8::EpiRs, pg8::OneUnit, true, true>(lds, g, O1, E); }
              asm volatile("s_waitcnt vmcnt(0)" ::: "memory"); if (uid + G < 256) __builtin_amdgcn_fence(__ATOMIC_ACQUIRE, "agent"); __syncthreads();
          } }
        GSYNC();
        { pg8::Gemm g{(const bf16*)(ws + WS_QX), (const bf16*)(ws + WS_WXO), M, D, D, D, D, 0}; pg8::StaticOrder S; S.init(M, D, G, bx); pg8::Unit u_;
          pg8::EpiResid E{X, X, XB, ss3, 1.0f};
          for (int i_ = 0; S.next(i_, u_); ++i_) { const pg8::OneUnit O1{u_.pm, u_.pn}; pg8::gemm_phase<pg8::EpiResid, pg8::OneUnit, false, true>(lds, g, O1, E); } }
        GSYNC();
        { pg8::Gemm g{XB, (const bf16*)(ws + WS_W2IN), M, 2 * DFF, D, D, D, 0}; pg8::StaticOrder S; S.init(M, 2 * DFF, G, bx);
          pg8::EpiSwiglu E{HB, ss3, DFF};
          pg8::gemm_phase<pg8::EpiSwiglu, pg8::StaticOrder, true, true>(lds, g, S, E); }
        GSYNC();
        { pg8::Gemm g{HB, (const bf16*)(ws + WS_W2OUT), M, D, DFF, DFF, DFF, 0}; pg8::StaticOrder S; S.init(M, D, G, bx); pg8::Unit u_;
          pg8::EpiResid E{X, X, XB, ss4, 0.5f};
          for (int i_ = 0; S.next(i_, u_); ++i_) { const pg8::OneUnit O1{u_.pm, u_.pn}; pg8::gemm_phase<pg8::EpiResid, pg8::OneUnit, false, true>(lds, g, O1, E); } }
        GSYNC();
    }
    phase_final(X, tab_in(TB, 30), gw, NGW, lane);
#undef GSYNC
}

extern "C" void kernel_launch(void* const* d_in, const int* in_sizes, int n_in, void* d_out, int out_size, void* d_ws, size_t ws_size, hipStream_t stream) {
    static int grid = 0;
    if (grid == 0) {
        if (n_in != 31 || out_size != M * D || ws_size < WS_END) { fprintf(stderr, "kernel_launch: unexpected problem (n_in %d, out %d, ws %zu)\n", n_in, out_size, ws_size); grid = -1; return; }
        int dev = 0, cus = 0, per_cu = 0;
        (void)hipGetDevice(&dev); (void)hipDeviceGetAttribute(&cus, hipDeviceAttributeMultiprocessorCount, dev);
        if (hipFuncSetAttribute((const void*)hybrid_fwd, hipFuncAttributeMaxDynamicSharedMemorySize, LDS_BYTES) != hipSuccess) { fprintf(stderr, "kernel_launch: hipFuncSetAttribute failed\n"); grid = -1; return; }
        if (hipOccupancyMaxActiveBlocksPerMultiprocessor(&per_cu, (const void*)hybrid_fwd, NTHR, LDS_BYTES) != hipSuccess || per_cu < 1) per_cu = 1;
        (void)hipGetLastError();
        grid = cus * (per_cu > 1 ? 1 : per_cu);
        if (grid > 256) grid = 256;
    }
    if (grid < 0) return;
    (void)hipMemsetAsync((char*)d_ws + WS_SS, 0, CTL_ZERO_BYTES, stream);
    Args a{};
    for (int i = 0; i < 31; ++i) a.in[i] = (const float*)d_in[i];
    a.out = (float*)d_out; a.ws = (unsigned char*)d_ws;
    void* kargs[] = {&a};
    hipError_t e = hipLaunchCooperativeKernel((const void*)hybrid_fwd, dim3(grid), dim3(NTHR), kargs, LDS_BYTES, stream);
    if (e != hipSuccess) fprintf(stderr, "cooperative launch failed: %s (grid %d)\n", hipGetErrorString(e), grid);
}
```

```cpp
#include <hip/hip_runtime.h>
#include <hip/hip_cooperative_groups.h>
#include <cstdio>
#include <cstdint>
namespace cg = cooperative_groups;
namespace pg8 {
#define PG8_LAS __attribute__((address_space(3)))
typedef unsigned short bf16_t;
typedef short bf16x8 __attribute__((ext_vector_type(8)));
typedef float f32x4 __attribute__((ext_vector_type(4)));
typedef unsigned u32x4 __attribute__((ext_vector_type(4)));
constexpr int BM = 256, BK = 64, HALF = 128, HTB = HALF * BK * 2  , STAGE_BYTES = 8 * HTB, NXCD = 8, WGM = 8;

__host__ __device__ __forceinline__ int lds_byte(int r, int c) { const int st = (r >> 4) * 2 + (c >> 5), rr = r & 15, cc = c & 31, ob = rr * 64 + cc * 2; return st * 1024 + (ob ^ (((ob >> 9) & 1) << 5)); }
__host__ __device__ __forceinline__ void stage_rc(int b, int& R, int& C) { const int st = b / 1024, sb = b % 1024, swz = sb ^ (((sb >> 9) & 1) << 5); R = (st >> 1) * 16 + swz / 64; C = (st & 1) * 32 + (swz % 64) / 2; }
__host__ __device__ __forceinline__ int perm32(int rho) { const int n = rho >> 4, i = rho & 15; return 8 * (i >> 2) + 4 * n + (i & 3); }

struct Unit { int pm, pn; };
struct Gemm { const bf16_t* A; const bf16_t* Bt; int M, N, K, lda, ldb, a_pn_off; };

struct StaticOrder {
    int nM, nN, nwg, G, c;
    __host__ __device__ __forceinline__ void init(int M, int N, int G_, int c_) { nM = M / BM; nN = N / BM; nwg = nM * nN; G = G_; c = c_; }
    __host__ __device__ __forceinline__ bool next(int i, Unit& u) const {
        const long L = (long)i * G + c; if (L >= nwg) return false;
        int wgid = (int)L; { const int q = nwg / NXCD, r = nwg % NXCD, xcd = wgid % NXCD, off = wgid / NXCD; wgid = (xcd < r ? xcd * (q + 1) : r * (q + 1) + (xcd - r) * q) + off; }
        const int nig = WGM * nN, gid = wgid / nig, fm = gid * WGM, gsz = (nM - fm) < WGM ? (nM - fm) : WGM;
        u.pm = fm + ((wgid % nig) % gsz); u.pn = (wgid % nig) / gsz; return true;
    }
    __device__ __forceinline__ void a_ready(const Unit&) const {}
    __device__ __forceinline__ void done(const Unit&) const {}
};

__device__ __forceinline__ unsigned cvt_pk_bf16(float lo, float hi) { unsigned r; asm volatile("v_cvt_pk_bf16_f32 %0, %1, %2" : "=v"(r) : "v"(lo), "v"(hi)); return r; }
__device__ __forceinline__ float bperm(float v, int srclane) { return __int_as_float(__builtin_amdgcn_ds_bpermute(srclane << 2, __float_as_int(v))); }
typedef float f32x2 __attribute__((ext_vector_type(2)));
typedef unsigned u32x2 __attribute__((ext_vector_type(2)));
__device__ __forceinline__ float fsig(float v) { return __builtin_amdgcn_rcpf(1.f + __expf(-v)); }
__device__ __forceinline__ float fsilu(float v) { return v * fsig(v); }
__device__ __forceinline__ float fgelu_tanh(float v) { return v * fsig(1.5957691216057308f * (v + 0.044715f * v * v * v)); }
__device__ __forceinline__ float bf_lo(unsigned w) { return __uint_as_float(w << 16); }
__device__ __forceinline__ float bf_hi(unsigned w) { return __uint_as_float(w & 0xffff0000u); }
__device__ __forceinline__ float rstd_of(const float* ss, int row) { const f32x4 a = *(const f32x4*)(ss + (size_t)row * 4); return rsqrtf(((a[0] + a[1]) + (a[2] + a[3])) * (1.0f / 1024.0f) + 1e-6f); }
__device__ __forceinline__ u32x4 pack8(const f32x4 v0, const f32x4 v1) { u32x4 w; w.x = cvt_pk_bf16(v0[0], v0[1]); w.y = cvt_pk_bf16(v0[2], v0[3]); w.z = cvt_pk_bf16(v1[0], v1[1]); w.w = cvt_pk_bf16(v1[2], v1[3]); return w; }

__device__ __forceinline__ void rstd8(const float* ss, int row0, float sc, float (&rs)[2][4]) {
    f32x4 pa[2][4];
#pragma unroll
    for (int ai = 0; ai < 2; ++ai)
#pragma unroll
        for (int m = 0; m < 4; ++m) pa[ai][m] = *(const f32x4*)(ss + (size_t)(row0 + ai * HALF + m * 16) * 4);
#pragma unroll
    for (int ai = 0; ai < 2; ++ai)
#pragma unroll
        for (int m = 0; m < 4; ++m) { const f32x4 a = pa[ai][m]; rs[ai][m] = rsqrtf(((a[0] + a[1]) + (a[2] + a[3])) * (1.0f / 1024.0f) + 1e-6f) * sc; }
    __builtin_amdgcn_sched_barrier(0);
}

__device__ __forceinline__ u32x4 ld16_sc1(const void* p) { u32x4 v; asm volatile("global_load_dwordx4 %0, %1, off sc1" : "=v"(v) : "v"(p) : "memory"); return v; }
#define PG8_LDWAIT(v) asm volatile("s_waitcnt vmcnt(0)" : "+v"(v))

struct OneUnit { int pm, pn;
    __device__ __forceinline__ bool next(int i, Unit& u) const { if (i) return false; u.pm = pm; u.pn = pn; return true; }
    __device__ __forceinline__ void a_ready(const Unit&) const {}
    __device__ __forceinline__ void done(const Unit&) const {} };

struct EpiSwiglu { static constexpr bool PERM = true, AFTER_DRAIN = false; bf16_t* H; const float* ss; int ldh;
    __device__ __forceinline__ void operator()(const f32x4 (&acc)[2][2][4][2], const Unit& u, int wr, int wc, int fr, int fq) const {
        const int row0 = u.pm * BM + wr * 64 + fr, col0 = u.pn * HALF + wc * 32 + 8 * fq; float rsv[2][4]; rstd8(ss, row0, 1.f, rsv);
#pragma unroll
        for (int ai = 0; ai < 2; ++ai)
#pragma unroll
            for (int m = 0; m < 4; ++m) { const int row = row0 + ai * HALF + m * 16; const float rs = rsv[ai][m];
                f32x4 o0, o1;
#pragma unroll
                for (int i = 0; i < 4; ++i) { o0[i] = fsilu(acc[ai][0][m][0][i] * rs) * (acc[ai][1][m][0][i] * rs); o1[i] = fsilu(acc[ai][0][m][1][i] * rs) * (acc[ai][1][m][1][i] * rs); }
                *(u32x4*)(H + (size_t)row * ldh + col0) = pack8(o0, o1); __builtin_amdgcn_sched_barrier(0); }
    }
};
struct EpiResid { static constexpr bool PERM = false, AFTER_DRAIN = true; const float* xin; float* x; bf16_t* xb; float* ss; float scale;
    __device__ __forceinline__ void fused(f32x4 (&acc)[2][2][4][2], const Unit& u, int wr, int wc, int fr, int fq, PG8_LAS unsigned char* lds, int wid, int lane) const {
        float scl = scale; asm volatile("" : "+v"(scl)); const int row0 = u.pm * BM + wr * 64 + fr, col0 = u.pn * BM + wc * 32 + 4 * fq;
        PG8_LAS float* P = (PG8_LAS float*)lds;
#pragma unroll
        for (int ai = 0; ai < 2; ++ai) { f32x4 xv[4][2][2];
#pragma unroll
            for (int m = 0; m < 4; ++m)
#pragma unroll
                for (int bj = 0; bj < 2; ++bj)
#pragma unroll
                    for (int n = 0; n < 2; ++n) xv[m][bj][n] = *(const f32x4*)(xin + (size_t)(row0 + ai * HALF + m * 16) * 1024 + col0 + bj * HALF + n * 16);
            __builtin_amdgcn_sched_barrier(0);
#pragma unroll
            for (int m = 0; m < 4; ++m) { const int row = row0 + ai * HALF + m * 16; float q = 0.f;
#pragma unroll
                for (int bj = 0; bj < 2; ++bj)
#pragma unroll
                    for (int n = 0; n < 2; ++n) { const size_t off = (size_t)row * 1024 + col0 + bj * HALF + n * 16;
                        f32x4 v = xv[m][bj][n] + acc[ai][bj][m][n] * scl; *(f32x4*)(x + off) = v;
                        u32x2 w; w.x = cvt_pk_bf16(v[0], v[1]); w.y = cvt_pk_bf16(v[2], v[3]); *(u32x2*)(xb + off) = w;
                        q += (v[0] * v[0] + v[1] * v[1]) + (v[2] * v[2] + v[3] * v[3]); }
                q += bperm(q, (fr + 16 * fq) ^ 16); q += bperm(q, (fr + 16 * fq) ^ 32);
                if (fq == 0) P[(ai * HALF + wr * 64 + m * 16 + fr) * 4 + wc] = q; }
            __builtin_amdgcn_sched_barrier(0); }
        asm volatile("s_waitcnt lgkmcnt(0)" ::: "memory"); __builtin_amdgcn_s_barrier(); asm volatile("" ::: "memory");
        const int tl = wid * 64 + lane;
        if (tl < 256) { const f32x4 a = *(const PG8_LAS f32x4*)(P + tl * 4); ss[(size_t)(u.pm * BM + tl) * 4 + u.pn] = (a[0] + a[1]) + (a[2] + a[3]); }
        asm volatile("s_waitcnt lgkmcnt(0)" ::: "memory"); __builtin_amdgcn_s_barrier(); asm volatile("" ::: "memory");
    }
};
struct EpiRs { static constexpr bool PERM = true, AFTER_DRAIN = false; bf16_t* O; int ldc; const float* ss; float sc;
    __device__ __forceinline__ void operator()(const f32x4 (&acc)[2][2][4][2], const Unit& u, int wr, int wc, int fr, int fq) const {
        const int row0 = u.pm * BM + wr * 64 + fr, col0 = u.pn * BM + wc * 32 + 8 * fq; float rsv[2][4];
        if (ss) rstd8(ss, row0, sc, rsv); else {
#pragma unroll
            for (int a = 0; a < 2; ++a)
#pragma unroll
                for (int b = 0; b < 4; ++b) rsv[a][b] = sc; }
#pragma unroll
        for (int ai = 0; ai < 2; ++ai)
#pragma unroll
            for (int m = 0; m < 4; ++m) { const int row = row0 + ai * HALF + m * 16; const float rs = rsv[ai][m];
#pragma unroll
                for (int bj = 0; bj < 2; ++bj) *(u32x4*)(O + (size_t)row * ldc + col0 + bj * HALF) = pack8(acc[ai][bj][m][0] * rs, acc[ai][bj][m][1] * rs); }
    }
};
struct EpiWin { static constexpr bool PERM = true, AFTER_DRAIN = false; bf16_t *xa, *xl, *gg, *q, *k, *v; const float* ss; float qscale;
    __device__ __forceinline__ void operator()(const f32x4 (&acc)[2][2][4][2], const Unit& u, int wr, int wc, int fr, int fq) const {
        const int pn = u.pn; bf16_t* dst; int ld, ct; float sc = 1.f; bool act = false;
        if (pn < 2) { dst = xa; ld = 512; ct = pn; } else if (pn < 6) { dst = xl; ld = 1024; ct = pn - 2; } else if (pn < 10) { dst = gg; ld = 1024; ct = pn - 6; act = true; }
        else if (pn < 12) { dst = q; ld = 512; ct = pn - 10; sc = qscale; } else if (pn < 14) { dst = k; ld = 512; ct = pn - 12; } else { dst = v; ld = 512; ct = pn - 14; }
        const int row0 = u.pm * BM + wr * 64 + fr, col0 = ct * BM + wc * 32 + 8 * fq; float rsv[2][4]; rstd8(ss, row0, sc, rsv);
#pragma unroll
        for (int ai = 0; ai < 2; ++ai)
#pragma unroll
            for (int m = 0; m < 4; ++m) { const int row = row0 + ai * HALF + m * 16; const float rs = rsv[ai][m];
#pragma unroll
                for (int bj = 0; bj < 2; ++bj) { f32x4 v0 = acc[ai][bj][m][0] * rs, v1 = acc[ai][bj][m][1] * rs;
                    if (act) {
#pragma unroll
                        for (int i = 0; i < 4; ++i) { v0[i] = fgelu_tanh(v0[i]); v1[i] = fgelu_tanh(v1[i]); } }
                    *(u32x4*)(dst + (size_t)row * ld + col0 + bj * HALF) = pack8(v0, v1); __builtin_amdgcn_sched_barrier(0); } }
    }
};
struct EpiGate { static constexpr bool PERM = true, AFTER_DRAIN = false; bf16_t* stash; const float* bg; const float* ss;
    __device__ __forceinline__ void operator()(const f32x4 (&acc)[2][2][4][2], const Unit& u, int wr, int wc, int fr, int fq) const {
        const int row0 = u.pm * BM + wr * 64 + fr, col0 = u.pn * BM + wc * 32 + 8 * fq; int tid_o = threadIdx.x; asm volatile("" : "+v"(tid_o)); const int tid = tid_o;
        f32x4 bv[2][2];
#pragma unroll
        for (int bj = 0; bj < 2; ++bj)
#pragma unroll
            for (int n = 0; n < 2; ++n) bv[bj][n] = *(const f32x4*)(bg + col0 + bj * HALF + 4 * n);
        float rsv[2][4]; rstd8(ss, row0, 1.f, rsv);
#pragma unroll
        for (int ai = 0; ai < 2; ++ai)
#pragma unroll
            for (int m = 0; m < 4; ++m) { const float rs = rsv[ai][m];
#pragma unroll
                for (int bj = 0; bj < 2; ++bj) { f32x4 v0 = acc[ai][bj][m][0] * rs + bv[bj][0], v1 = acc[ai][bj][m][1] * rs + bv[bj][1];
#pragma unroll
                    for (int i = 0; i < 4; ++i) { v0[i] = fsig(v0[i]); v1[i] = fsig(v1[i]); }
                    *(u32x4*)(stash + ((size_t)((ai * 4 + m) * 2 + bj) * 512 + tid) * 8) = pack8(v0, v1); __builtin_amdgcn_sched_barrier(0); } }
    }
};
struct EpiMerge { static constexpr bool PERM = true, AFTER_DRAIN = false; const bf16_t* stash; bf16_t* mg; int first;
    __device__ __forceinline__ void operator()(const f32x4 (&acc)[2][2][4][2], const Unit& u, int wr, int wc, int fr, int fq) const {
        const int row0 = u.pm * BM + wr * 64 + fr, col0 = u.pn * BM + wc * 32 + 8 * fq; int tid_o = threadIdx.x; asm volatile("" : "+v"(tid_o)); const int tid = tid_o;
#pragma unroll
        for (int ai = 0; ai < 2; ++ai) { u32x4 gw[4][2], ow[4][2];
#pragma unroll
            for (int m = 0; m < 4; ++m)
#pragma unroll
                for (int bj = 0; bj < 2; ++bj) { gw[m][bj] = ld16_sc1(stash + ((size_t)((ai * 4 + m) * 2 + bj) * 512 + tid) * 8);
                    ow[m][bj] = first ? (u32x4){0u, 0u, 0u, 0u} : ld16_sc1(mg + (size_t)(row0 + ai * HALF + m * 16) * 1024 + col0 + bj * HALF); }
#pragma unroll
            for (int m = 0; m < 4; ++m)
#pragma unroll
                for (int bj = 0; bj < 2; ++bj) { PG8_LDWAIT(gw[m][bj]); if (!first) PG8_LDWAIT(ow[m][bj]); }
            __builtin_amdgcn_sched_barrier(0);
#pragma unroll
            for (int m = 0; m < 4; ++m)
#pragma unroll
                for (int bj = 0; bj < 2; ++bj) { const u32x4 g = gw[m][bj], o = ow[m][bj]; f32x4 v0 = acc[ai][bj][m][0], v1 = acc[ai][bj][m][1];
                    v0[0] = v0[0] * bf_lo(g.x) + bf_lo(o.x); v0[1] = v0[1] * bf_hi(g.x) + bf_hi(o.x); v0[2] = v0[2] * bf_lo(g.y) + bf_lo(o.y); v0[3] = v0[3] * bf_hi(g.y) + bf_hi(o.y);
                    v1[0] = v1[0] * bf_lo(g.z) + bf_lo(o.z); v1[1] = v1[1] * bf_hi(g.z) + bf_hi(o.z); v1[2] = v1[2] * bf_lo(g.w) + bf_lo(o.w); v1[3] = v1[3] * bf_hi(g.w) + bf_hi(o.w);
                    *(u32x4*)(mg + (size_t)(row0 + ai * HALF + m * 16) * 1024 + col0 + bj * HALF) = pack8(v0, v1); }
            __builtin_amdgcn_sched_barrier(0); }
    }
};
struct EpiKV { static constexpr bool PERM = true, AFTER_DRAIN = false; bf16_t* kx; bf16_t* vt;
    __device__ __forceinline__ void operator()(const f32x4 (&acc)[2][2][4][2], const Unit& u, int wr, int wc, int fr, int fq) const {
        if (u.pn < 4) { const int row0 = u.pm * BM + wr * 64 + fr, col0 = u.pn * BM + wc * 32 + 8 * fq;
#pragma unroll
            for (int ai = 0; ai < 2; ++ai)
#pragma unroll
                for (int m = 0; m < 4; ++m)
#pragma unroll
                    for (int bj = 0; bj < 2; ++bj) *(u32x4*)(kx + (size_t)(row0 + ai * HALF + m * 16) * 1024 + col0 + bj * HALF) = pack8(acc[ai][bj][m][0], acc[ai][bj][m][1]);
        } else { const int h = u.pn - 4, b = u.pm; bf16_t* base = vt + (size_t)(b * 4 + h) * 65536;
#pragma unroll
            for (int ai = 0; ai < 2; ++ai)
#pragma unroll
                for (int m = 0; m < 4; ++m) { const int mr = ai * HALF + wr * 64 + m * 16 + fr;
#pragma unroll
                    for (int bj = 0; bj < 2; ++bj) { bf16_t* p = base + (size_t)(bj * HALF + wc * 32 + 8 * fq) * 256 + mr; asm volatile("" : "+v"(p));
#pragma unroll
                        for (int n = 0; n < 2; ++n)
#pragma unroll
                            for (int i = 0; i < 4; ++i) p[(4 * n + i) * 256] = (bf16_t)(cvt_pk_bf16(acc[ai][bj][m][n][i], 0.f) & 0xffffu);
                        __builtin_amdgcn_sched_barrier(0); } }
        }
    }
};
struct EpiSoftmaxP { static constexpr bool PERM = true, AFTER_DRAIN = true; bf16_t* P;
    __device__ __forceinline__ void fused(f32x4 (&acc)[2][2][4][2], const Unit& u, int wr, int wc, int fr, int fq, PG8_LAS unsigned char* lds, int wid, int lane) const {
        PG8_LAS f32x2* X = (PG8_LAS f32x2*)lds;
        float mloc[2][4];
#pragma unroll
        for (int ai = 0; ai < 2; ++ai)
#pragma unroll
            for (int m = 0; m < 4; ++m) { float mx = -__builtin_inff();
#pragma unroll
                for (int bj = 0; bj < 2; ++bj)
#pragma unroll
                    for (int n = 0; n < 2; ++n) { const f32x4 v = acc[ai][bj][m][n]; mx = fmaxf(mx, fmaxf(fmaxf(v[0], v[1]), fmaxf(v[2], v[3]))); }
                mx = fmaxf(mx, bperm(mx, (fr + 16 * fq) ^ 16)); mx = fmaxf(mx, bperm(mx, (fr + 16 * fq) ^ 32)); float s = 0.f;
#pragma unroll
                for (int bj = 0; bj < 2; ++bj)
#pragma unroll
                    for (int n = 0; n < 2; ++n) { f32x4 v = acc[ai][bj][m][n];
#pragma unroll
                        for (int i = 0; i < 4; ++i) { v[i] = __builtin_amdgcn_exp2f(v[i] - mx); s += v[i]; }
                        acc[ai][bj][m][n] = v; }
                s += bperm(s, (fr + 16 * fq) ^ 16); s += bperm(s, (fr + 16 * fq) ^ 32); mloc[ai][m] = mx;
                if (fq == 0) X[(ai * HALF + wr * 64 + m * 16 + fr) * 4 + wc] = (f32x2){mx, s}; __builtin_amdgcn_sched_barrier(0); }
        asm volatile("s_waitcnt lgkmcnt(0)" ::: "memory"); __builtin_amdgcn_s_barrier(); asm volatile("" ::: "memory");
#pragma unroll
        for (int ai = 0; ai < 2; ++ai)
#pragma unroll
            for (int m = 0; m < 4; ++m) { const int rl = ai * HALF + wr * 64 + m * 16 + fr;
                const f32x2 a = X[rl * 4 + 0], b = X[rl * 4 + 1], c = X[rl * 4 + 2], d = X[rl * 4 + 3];
                const float M = fmaxf(fmaxf(a.x, b.x), fmaxf(c.x, d.x));
                const float L = a.y * __builtin_amdgcn_exp2f(a.x - M) + b.y * __builtin_amdgcn_exp2f(b.x - M) + c.y * __builtin_amdgcn_exp2f(c.x - M) + d.y * __builtin_amdgcn_exp2f(d.x - M);
                const float f = __builtin_amdgcn_exp2f(mloc[ai][m] - M) / L;
#pragma unroll
                for (int bj = 0; bj < 2; ++bj) *(u32x4*)(P + (size_t)rl * 256 + bj * HALF + wc * 32 + 8 * fq) = pack8(acc[ai][bj][m][0] * f, acc[ai][bj][m][1] * f); __builtin_amdgcn_sched_barrier(0); }
        asm volatile("s_waitcnt vmcnt(0) lgkmcnt(0)" ::: "memory"); __builtin_amdgcn_s_barrier(); asm volatile("" ::: "memory");
    }
};

template <class Epi, class Sched, bool ALIGN_EPI = false, bool SP2 = false>
__device__ __forceinline__ void gemm_phase(PG8_LAS unsigned char* lds, const Gemm g, const Sched& S, const Epi& E) {
    int tid_o = threadIdx.x; asm volatile("" : "+v"(tid_o));
    const int tid = tid_o, wid = __builtin_amdgcn_readfirstlane(tid >> 6), lane = tid & 63, wr = wid >> 2, wc = wid & 3, fr = lane & 15, fq = lane >> 4;
    const int K = g.K, nt = K / BK;
    unsigned voffA[2], voffB[2];
#pragma unroll
    for (int i = 0; i < 2; ++i) { int R, C; stage_rc(tid * 16 + i * 8192, R, C); const int Rb = Epi::PERM ? ((R & ~31) + perm32(R & 31)) : R;
        voffA[i] = (unsigned)(R * g.lda + C) * 2u; voffB[i] = (unsigned)(Rb * g.ldb + C) * 2u; }
    const size_t kstep = (size_t)(BK * 2);
    const size_t hstepA = (size_t)HALF * g.lda * 2, hstepB = (size_t)HALF * g.ldb * 2;
    const size_t tstepA = 2 * hstepA, tstepB = 2 * hstepB;
    const unsigned ldsw = (unsigned)wid * 1024u;
    const int aoff = lds_byte(wr * 64 + fr, fq * 8), boff = lds_byte(wc * 32 + fr, fq * 8);
#define PG8_SA(b, h) (((b) * 2 + (h)) * HTB)
#define PG8_SB(b, h) ((4 + (b) * 2 + (h)) * HTB)
#define PG8_STAGE(bufoff, gbase, voff) do { _Pragma("unroll") for (int _i = 0; _i < 2; ++_i) \
        __builtin_amdgcn_global_load_lds((const unsigned*)((const char*)(gbase) + (voff)[_i]), (PG8_LAS unsigned*)(lds + (bufoff) + ldsw + _i * 8192), 16, 0, 0); } while (0)
#define PG8_LDA(dst, b, h) do { _Pragma("unroll") for (int m = 0; m < 4; ++m) _Pragma("unroll") for (int k = 0; k < 2; ++k) dst[m][k] = *(const PG8_LAS bf16x8*)(lds + PG8_SA(b, h) + aoff + m * 2048 + k * 1024); } while (0)
#define PG8_LDB(dst, b, h) do { _Pragma("unroll") for (int n = 0; n < 2; ++n) _Pragma("unroll") for (int k = 0; k < 2; ++k) dst[n][k] = *(const PG8_LAS bf16x8*)(lds + PG8_SB(b, h) + boff + n * 2048 + k * 1024); } while (0)
#define PG8_MMA(ai, bj, At, Bt) do { __builtin_amdgcn_s_setprio(1); _Pragma("unroll") for (int m = 0; m < 4; ++m) _Pragma("unroll") for (int n = 0; n < 2; ++n) _Pragma("unroll") for (int k = 0; k < 2; ++k) \
        acc[ai][bj][m][n] = __builtin_amdgcn_mfma_f32_16x16x32_bf16(Bt[n][k], At[m][k], acc[ai][bj][m][n], 0, 0, 0); __builtin_amdgcn_s_setprio(0); } while (0)
#define PG8_WAIT_V(n) asm volatile("s_waitcnt vmcnt(" #n ")" ::: "memory")
#define PG8_WAIT_L(n) asm volatile("s_waitcnt lgkmcnt(" #n ")" ::: "memory")
#define PG8_BAR __builtin_amdgcn_s_barrier()
#define PG8_SCHED __builtin_amdgcn_sched_barrier(0)
    Unit cur, nxt; int ui = 0;
    if (!S.next(0, cur)) return;
    f32x4 acc[2][2][4][2];
#pragma unroll
    for (int a = 0; a < 2; ++a)
#pragma unroll
        for (int b = 0; b < 2; ++b)
#pragma unroll
            for (int m = 0; m < 4; ++m)
#pragma unroll
                for (int n = 0; n < 2; ++n) acc[a][b][m][n] = (f32x4){0.f, 0.f, 0.f, 0.f};
    bf16x8 At[4][2], B0[2][2], B1[2][2];
    const char* cA = (const char*)g.A + (size_t)cur.pm * tstepA + (size_t)cur.pn * g.a_pn_off * 2; const char* cB = (const char*)g.Bt + (size_t)cur.pn * tstepB;
    S.a_ready(cur);
    if constexpr (SP2) {
        PG8_STAGE(PG8_SB(0, 0), cB, voffB); PG8_STAGE(PG8_SB(0, 1), cB + hstepB, voffB); PG8_STAGE(PG8_SA(0, 0), cA, voffA); PG8_STAGE(PG8_SA(0, 1), cA + hstepA, voffA);
        if (wr == 1) PG8_BAR;
        PG8_WAIT_V(2); PG8_BAR;
        PG8_STAGE(PG8_SB(1, 0), cB + kstep, voffB); PG8_STAGE(PG8_SA(1, 0), cA + kstep, voffA); PG8_STAGE(PG8_SB(1, 1), cB + hstepB + kstep, voffB);
        PG8_WAIT_V(6); PG8_BAR;
    } else {
        PG8_STAGE(PG8_SB(0, 0), cB, voffB); PG8_STAGE(PG8_SA(0, 0), cA, voffA); PG8_STAGE(PG8_SB(0, 1), cB + hstepB, voffB); PG8_STAGE(PG8_SA(0, 1), cA + hstepA, voffA);
        if (wr == 1) PG8_BAR;
        PG8_WAIT_V(4); PG8_BAR;
        PG8_STAGE(PG8_SB(1, 0), cB + kstep, voffB); PG8_STAGE(PG8_SA(1, 0), cA + kstep, voffA); PG8_STAGE(PG8_SB(1, 1), cB + hstepB + kstep, voffB);
        PG8_WAIT_V(6); PG8_BAR;
    }
    for (;;) {
        const bool has_next = S.next(ui + 1, nxt);
        const char* nA = has_next ? (const char*)g.A + (size_t)nxt.pm * tstepA + (size_t)nxt.pn * g.a_pn_off * 2 : cA; const char* nB = has_next ? (const char*)g.Bt + (size_t)nxt.pn * tstepB : cB;
        for (int t = 0; t < nt; t += 2) {
            const bool last = (t == nt - 2);
            const char* a1 = cA + (size_t)(t + 1) * kstep;
            const char* a2 = last ? nA : cA + (size_t)(t + 2) * kstep; const char* b2 = last ? nB : cB + (size_t)(t + 2) * kstep;
            const char* a3 = a2 + kstep; const char* b3 = b2 + kstep;
            if (last && has_next) S.a_ready(nxt);
            if constexpr (SP2) {
            PG8_LDB(B0, 0, 0); PG8_LDB(B1, 0, 1); PG8_SCHED; PG8_LDA(At, 0, 0); PG8_STAGE(PG8_SA(1, 1), a1 + hstepA, voffA);
            PG8_WAIT_V(8); PG8_WAIT_L(0); PG8_BAR; PG8_MMA(0, 0, At, B0); PG8_MMA(0, 1, At, B1); PG8_BAR; PG8_SCHED;
            PG8_LDA(At, 0, 1); PG8_STAGE(PG8_SB(0, 0), b2, voffB); PG8_STAGE(PG8_SB(0, 1), b2 + hstepB, voffB); PG8_STAGE(PG8_SA(0, 0), a2, voffA);
            PG8_WAIT_V(8); PG8_WAIT_L(0); PG8_BAR; PG8_MMA(1, 0, At, B0); PG8_MMA(1, 1, At, B1); PG8_BAR; PG8_SCHED;
            PG8_LDB(B0, 1, 0); PG8_LDB(B1, 1, 1); PG8_SCHED; PG8_LDA(At, 1, 0); PG8_STAGE(PG8_SA(0, 1), a2 + hstepA, voffA);
            PG8_WAIT_V(8); PG8_WAIT_L(0); PG8_BAR; PG8_MMA(0, 0, At, B0); PG8_MMA(0, 1, At, B1); PG8_BAR; PG8_SCHED;
            PG8_LDA(At, 1, 1); PG8_STAGE(PG8_SB(1, 0), b3, voffB); PG8_STAGE(PG8_SB(1, 1), b3 + hstepB, voffB); PG8_STAGE(PG8_SA(1, 0), a3, voffA);
            PG8_WAIT_V(8); PG8_WAIT_L(0); PG8_BAR; PG8_MMA(1, 0, At, B0); PG8_MMA(1, 1, At, B1); PG8_BAR; PG8_SCHED;
            } else {
            PG8_LDB(B0, 0, 0); PG8_SCHED; PG8_LDA(At, 0, 0); PG8_STAGE(PG8_SA(1, 1), a1 + hstepA, voffA);
            PG8_WAIT_L(8); PG8_BAR; PG8_WAIT_L(0); PG8_MMA(0, 0, At, B0); PG8_BAR; PG8_SCHED;
            PG8_LDB(B1, 0, 1); PG8_STAGE(PG8_SB(0, 0), b2, voffB);
            PG8_BAR; PG8_WAIT_L(0); PG8_MMA(0, 1, At, B1); PG8_BAR;
            PG8_LDA(At, 0, 1); PG8_STAGE(PG8_SA(0, 0), a2, voffA);
            PG8_BAR; PG8_WAIT_L(0); PG8_MMA(1, 0, At, B0); PG8_BAR; PG8_SCHED;
            PG8_STAGE(PG8_SB(0, 1), b2 + hstepB, voffB);
            PG8_WAIT_V(6); PG8_BAR; PG8_MMA(1, 1, At, B1); PG8_BAR;
            PG8_LDB(B0, 1, 0); PG8_SCHED; PG8_LDA(At, 1, 0); PG8_STAGE(PG8_SA(0, 1), a2 + hstepA, voffA);
            PG8_WAIT_L(8); PG8_BAR; PG8_WAIT_L(0); PG8_MMA(0, 0, At, B0); PG8_BAR; PG8_SCHED;
            PG8_LDB(B1, 1, 1); PG8_STAGE(PG8_SB(1, 0), b3, voffB);
            PG8_BAR; PG8_WAIT_L(0); PG8_MMA(0, 1, At, B1); PG8_BAR;
            PG8_LDA(At, 1, 1); PG8_STAGE(PG8_SA(1, 0), a3, voffA);
            PG8_BAR; PG8_WAIT_L(0); PG8_MMA(1, 0, At, B0); PG8_BAR; PG8_SCHED;
            PG8_STAGE(PG8_SB(1, 1), b3 + hstepB, voffB);
            PG8_WAIT_V(6); PG8_BAR; PG8_MMA(1, 1, At, B1); PG8_BAR;
            }
        }
        if constexpr (ALIGN_EPI) { if (wr == 0) PG8_BAR; }
        if constexpr (!Epi::AFTER_DRAIN) { E(acc, cur, wr, wc, fr, fq); S.done(cur); }
        if (!has_next) break;
#pragma unroll
        for (int a = 0; a < 2; ++a)
#pragma unroll
            for (int b = 0; b < 2; ++b)
#pragma unroll
                for (int m = 0; m < 4; ++m)
#pragma unroll
                    for (int n = 0; n < 2; ++n) acc[a][b][m][n] = (f32x4){0.f, 0.f, 0.f, 0.f};
        cur = nxt; cA = nA; cB = nB; ++ui;
        if constexpr (ALIGN_EPI) { if (wr == 1) PG8_BAR; }
    }
    PG8_WAIT_V(0);
    if constexpr (!ALIGN_EPI) { if (wr == 0) PG8_BAR; }
    PG8_BAR;
    if constexpr (Epi::AFTER_DRAIN) { E.fused(acc, cur, wr, wc, fr, fq, lds, wid, lane); S.done(cur); }
#undef PG8_SA
#undef PG8_SB
#undef PG8_STAGE
#undef PG8_LDA
#undef PG8_LDB
#undef PG8_MMA
#undef PG8_WAIT_V
#undef PG8_WAIT_L
#undef PG8_BAR
#undef PG8_SCHED
}
}
#include <hip/hip_bf16.h>
#include <cmath>
#define GAS __attribute__((address_space(1)))
#define LAS __attribute__((address_space(3)))
typedef unsigned short bf16;
typedef unsigned v4u __attribute__((ext_vector_type(4)));
typedef float f32x4 __attribute__((ext_vector_type(4)));
typedef short bf16x8 __attribute__((ext_vector_type(8)));
typedef float f32x16 __attribute__((ext_vector_type(16)));

constexpr int NWAVES = 8, NTHR = 512;
constexpr int BATCH = 2, SEQ = 8192, D = 1024, M = BATCH * SEQ, DFF = 2816, DEPTH = 2;
constexpr int INW = 7176;
constexpr size_t MiB = 1u << 20;
constexpr size_t WS_SS = 0, CTL_ZERO_BYTES = 1 * MiB;
constexpr size_t WS_WFL = 1 * MiB;
constexpr size_t WS_WAT = 1 * MiB + 256 * 1024, WS_WXT = 1 * MiB + 512 * 1024;
constexpr size_t WS_SUMM = 2 * MiB;
constexpr size_t WS_LOGF = 3 * MiB, WS_CTIL = 3 * MiB + 512 * 1024;
constexpr size_t WS_KPART = 7 * MiB;
constexpr size_t WS_MEMN = 4 * MiB, WS_KX = 5 * MiB, WS_VT = 6 * MiB;
constexpr size_t WS_W1IN = 8 * MiB, WS_W1OUT = 19 * MiB, WS_WIN = 25 * MiB, WS_WG = 33 * MiB, WS_UA = 39 * MiB, WS_UB = 40 * MiB, WS_UC = 42 * MiB,
                 WS_WO = 43 * MiB, WS_WXQ = 45 * MiB, WS_WXKV = 47 * MiB, WS_WXO = 51 * MiB, WS_W2IN = 53 * MiB, WS_W2OUT = 64 * MiB;
constexpr size_t WS_XB = 70 * MiB;
constexpr size_t WS_Q = 102 * MiB, WS_GG = 118 * MiB, WS_XA = 150 * MiB, WS_XL = 166 * MiB, WS_K = 198 * MiB, WS_V = 214 * MiB;
constexpr size_t WS_H = 102 * MiB;
constexpr size_t WS_YC = 150 * MiB;
constexpr size_t WS_STASH = 166 * MiB, WS_MG = 198 * MiB, WS_QX = 150 * MiB, WS_PBUF = 198 * MiB;
constexpr size_t WS_YA = 230 * MiB, WS_SSP = 246 * MiB, WS_END = 255 * MiB;
constexpr int LDS_BYTES = 147456;

__device__ __forceinline__ unsigned f2bf(float f) { unsigned u = __builtin_bit_cast(unsigned, f); return (u + 0x7fffu + ((u >> 16) & 1u)) >> 16; }
__device__ __forceinline__ unsigned pk2(float lo, float hi) { return f2bf(lo) | (f2bf(hi) << 16); }
__device__ __forceinline__ float bf2f(unsigned short v) { return __uint_as_float((unsigned)v << 16); }
__device__ __forceinline__ float bperm(float v, int srclane) { return __int_as_float(__builtin_amdgcn_ds_bpermute(srclane << 2, __float_as_int(v))); }
__device__ __forceinline__ float wave_sum(float v, int lane) {
#pragma unroll
    for (int o = 1; o < 64; o <<= 1) v += bperm(v, lane ^ o);
    return v;
}
__device__ __forceinline__ float flog1p(float e) { return e < 0.01f ? e * (1.f - e * (0.5f - e * 0.33333334f)) : __logf(1.f + e); }
#define LDS_WAIT() asm volatile("s_waitcnt lgkmcnt(0)" ::: "memory")

__device__ __forceinline__ void tr_item(const float* W, int ldn, int col0, int k0, const float* g, bf16* WT, int ldk, int drow0, LAS float* scr, int lane) {
    const int n4 = (lane & 15) * 4, kr = lane >> 4;
#pragma unroll
    for (int i = 0; i < 16; ++i) { const int kk = 4 * i + kr; f32x4 v = *(const f32x4*)(W + (size_t)(k0 + kk) * ldn + col0 + n4); if (g) v = v * g[k0 + kk];
        LAS float* d = scr + kk * 65 + n4; d[0] = v.x; d[1] = v.y; d[2] = v.z; d[3] = v.w; }
    LDS_WAIT(); asm volatile("" ::: "memory");
    const int c = lane & 7;
#pragma unroll
    for (int j = 0; j < 8; ++j) { const int n = (lane >> 3) + 8 * j; const LAS float* s = scr + (8 * c) * 65 + n;
        v4u o; o.x = pk2(s[0 * 65], s[1 * 65]); o.y = pk2(s[2 * 65], s[3 * 65]); o.z = pk2(s[4 * 65], s[5 * 65]); o.w = pk2(s[6 * 65], s[7 * 65]);
        *(v4u*)(WT + (size_t)(drow0 + n) * ldk + k0 + 8 * c) = o; }
    LDS_WAIT(); asm volatile("" ::: "memory");
}

#define RLX_AGENT __ATOMIC_RELAXED, __HIP_MEMORY_SCOPE_AGENT
#define XB_TMO      128
#define XB_XCNT(j)  (256  + 64 * (j))
#define XB_XSUB(j)  (1280 + 64 * (j))
#define XB_XGEN(j)  (2304 + 64 * (j))
#define XB_TOP      3328
#define XB_TOPGEN   3392
#define XCD_BAR_WORDS 3456
#define XB_SPIN_CAP (1u << 18)

__device__ __forceinline__ unsigned xb_ld(unsigned* p)              { return __hip_atomic_load(p, __ATOMIC_RELAXED, __HIP_MEMORY_SCOPE_AGENT); }
__device__ __forceinline__ unsigned xb_add(unsigned* p, unsigned v) { return __hip_atomic_fetch_add(p, v, __ATOMIC_RELAXED, __HIP_MEMORY_SCOPE_AGENT); }
__device__ __forceinline__ unsigned xb_xcc_id() { return (unsigned)__builtin_amdgcn_s_getreg((3 << 11) | 20) & 0xFu; }
#define XB_SPIN(cond, bar) do { unsigned _sp = 0; while (cond) { __builtin_amdgcn_s_sleep(1); \
    if ((++_sp & 255u) == 0u) { if (xb_ld(&(bar)[XB_TMO])) break; if (_sp > XB_SPIN_CAP) { atomicAdd(&(bar)[XB_TMO], 1u); break; } } } } while (0)

struct XcdBarrier {
    unsigned* bar; unsigned x;
    volatile LAS unsigned* st;
};

__device__ __forceinline__ XcdBarrier xcd_barrier_post(unsigned* bar, volatile LAS unsigned* st) {
    XcdBarrier b; b.bar = bar; b.x = xb_xcc_id(); b.st = st;
    if (threadIdx.x == 0) (void)xb_add(&bar[XB_XCNT(b.x)], 1u);
    return b;
}
__device__ __forceinline__ void xcd_barrier_complete(unsigned* bar, unsigned x, unsigned& nloc, unsigned& nx) {
    const unsigned G = gridDim.x * gridDim.y * gridDim.z;
    unsigned sum, cnt, mine, sp = 0u;
    for (;;) {
        sum = 0u; cnt = 0u; mine = 0u;
#pragma unroll
        for (unsigned j = 0; j < 16; ++j) { const unsigned c = xb_ld(&bar[XB_XCNT(j)]); sum += c; cnt += (c > 0u) ? 1u : 0u; mine = (j == x) ? c : mine; }
        if (sum == G) break;
        __builtin_amdgcn_s_sleep(1);
        if ((++sp & 255u) == 0u) { if (xb_ld(&bar[XB_TMO])) break; if (sp > XB_SPIN_CAP) { atomicAdd(&bar[XB_TMO], 1u); break; } }
    }
    nloc = mine > 0u ? mine : 1u; nx = cnt > 0u ? cnt : 1u;
}

__device__ __forceinline__ void xcd_barrier(const XcdBarrier& b) {
    asm volatile("s_waitcnt vmcnt(0)" ::: "memory");
    __syncthreads();
    if (threadIdx.x == 0) {
        unsigned* bar = b.bar;
        __builtin_amdgcn_s_waitcnt(0);
        unsigned nloc = b.st[0], nx = b.st[1];
        if (nloc == 0u) { xcd_barrier_complete(bar, b.x, nloc, nx); b.st[0] = nloc; b.st[1] = nx; }
        const unsigned old = xb_add(&bar[XB_XSUB(b.x)], 1u);
        const unsigned gen = old / nloc;
        if (old + 1u == (gen + 1u) * nloc) {
            __builtin_amdgcn_fence(__ATOMIC_RELEASE, "agent");
            asm volatile("s_waitcnt vmcnt(0)" ::: "memory");
            const unsigned og = xb_add(&bar[XB_TOP], 1u);
            const unsigned tg = og / nx;
            if (og + 1u == (tg + 1u) * nx) xb_add(&bar[XB_TOPGEN], 1u);
            else XB_SPIN(xb_ld(&bar[XB_TOPGEN]) == tg, bar);
            __builtin_amdgcn_fence(__ATOMIC_ACQUIRE, "agent");
            xb_add(&bar[XB_XGEN(b.x)], 1u);
            asm volatile("s_waitcnt vmcnt(0)" ::: "memory");
        } else {
            XB_SPIN(xb_ld(&bar[XB_XGEN(b.x)]) == gen, bar);
            __builtin_amdgcn_fence(__ATOMIC_ACQUIRE, "agent");
            asm volatile("s_waitcnt vmcnt(0)" ::: "memory");
        }
    }
    __syncthreads();
}

struct Args { const float* in[31]; float* out; unsigned char* ws; int pad[2]; };
typedef LAS unsigned long long* PtrTab;
__device__ __forceinline__ const float* tab_in(PtrTab tb, int k) { const unsigned long long v = tb[k]; const unsigned lo = __builtin_amdgcn_readfirstlane((unsigned)v), hi = __builtin_amdgcn_readfirstlane((unsigned)(v >> 32));
    return (const float*)(const GAS float*)(((unsigned long long)hi << 32) | lo); }
constexpr int TAB_OFF = 147456 - 512;
constexpr size_t WS_BAR = 768 * 1024; constexpr size_t WS_QCTR = 832 * 1024;

__device__ __forceinline__ void phase_prologue(PtrTab TB, unsigned char* ws, float* xout, int l, LAS unsigned char* lds, int gw, int NGW, int lane, int wave) {
    LAS float* scr = (LAS float*)(lds + wave * 16640);
#define g1 (tab_in(TB, 2) + l * D)
#define w1i (tab_in(TB, 3) + (size_t)l * D * 2 * DFF)
#define w1o (tab_in(TB, 4) + (size_t)l * DFF * D)
#define gm (tab_in(TB, 5) + l * D)
#define win (tab_in(TB, 6) + (size_t)l * D * INW)
#define wpool (tab_in(TB, 9) + (size_t)l * 4 * 128 * 128)
#define psc (tab_in(TB, 10) + l * 512)
#define wua (tab_in(TB, 11) + (size_t)l * 512 * D)
#define wra (tab_in(TB, 14) + (size_t)l * 8 * 128 * 128)
#define wrx (tab_in(TB, 16) + (size_t)l * 8 * 128 * 128)
#define wub (tab_in(TB, 19) + (size_t)l * D * D)
#define wuc (tab_in(TB, 20) + (size_t)l * 512 * D)
#define wo (tab_in(TB, 21) + (size_t)l * D * D)
#define gc (tab_in(TB, 22) + l * D)
#define gmem (tab_in(TB, 23) + l * D)
#define wxq (tab_in(TB, 24) + (size_t)l * D * D)
#define wxkv (tab_in(TB, 25) + (size_t)l * D * 2 * D)
#define wxo (tab_in(TB, 26) + (size_t)l * D * D)
#define g2 (tab_in(TB, 27) + l * D)
#define w2i (tab_in(TB, 28) + (size_t)l * D * 2 * DFF)
#define w2o (tab_in(TB, 29) + (size_t)l * DFF * D)
    constexpr int I_FI = 16 * 88, I_FO = 44 * 16, I_WIN = 16 * 64, I_WG = 16 * 48, I_UB = 16 * 16, I_UC = 8 * 16, I_RG = 32, I_SQ = 16 * 16, I_KV = 16 * 32;
    constexpr int S0 = 0, S1 = S0 + I_FI, S2 = S1 + I_FO, S3 = S2 + I_WIN, S4 = S3 + I_WG, S5 = S4 + I_UB, S6 = S5 + I_UC, S7 = S6 + I_RG, S8 = S7 + I_RG, S9 = S8 + I_SQ, S10 = S9 + I_SQ,
                  S11 = S10 + I_KV, S12 = S11 + I_SQ, S13 = S12 + I_FI, S14 = S13 + I_FO;
    for (int it = gw; it < S14; it += NGW) {
        if (it < S1 || (it >= S12 && it < S13)) {
            const bool second = it >= S12; const int r = second ? it - S12 : it; const int kb = r / 88, nb = r % 88; const int n = nb * 64;
            const int half = n >= DFF ? 1 : 0, nn = n - half * DFF; const int drow = (nn >> 7) * 256 + half * 128 + (nn & 127);
            tr_item(second ? w2i : w1i, 2 * DFF, n, kb * 64, second ? g2 : g1, (bf16*)(ws + (second ? WS_W2IN : WS_W1IN)), D, drow, scr, lane);
        } else if (it < S2 || it >= S13) {
            const bool second = it >= S13; const int r = second ? it - S13 : it - S1; const int kb = r / 16, nb = r % 16;
            tr_item(second ? w2o : w1o, D, nb * 64, kb * 64, nullptr, (bf16*)(ws + (second ? WS_W2OUT : WS_W1OUT)), DFF, nb * 64, scr, lane);
        } else if (it < S3) { const int r = it - S2, kb = r / 64, nb = r % 64; tr_item(win, INW, nb * 64, kb * 64, gm, (bf16*)(ws + WS_WIN), D, nb * 64, scr, lane);
        } else if (it < S4) { const int r = it - S3, kb = r / 48, nb = r % 48; tr_item(win, INW, 4104 + nb * 64, kb * 64, gm, (bf16*)(ws + WS_WG), D, nb * 64, scr, lane);
        } else if (it < S5) { const int r = it - S4, kb = r / 16, nb = r % 16; tr_item(wub, D, nb * 64, kb * 64, nullptr, (bf16*)(ws + WS_UB), D, nb * 64, scr, lane);
        } else if (it < S6) { const int r = it - S5, kb = r / 16, nb = r % 16; tr_item(wuc, D, nb * 64, kb * 64, nullptr, (bf16*)(ws + WS_UC), 512, nb * 64, scr, lane);
        } else if (it < S8) { const bool xg = it >= S7; const int r = xg ? it - S7 : it - S6; const int hh = r >> 2, kb = (r >> 1) & 1, nb = r & 1;
            tr_item((xg ? wrx : wra) + hh * 16384, 128, nb * 64, kb * 64, nullptr, (bf16*)(ws + (xg ? WS_WXT : WS_WAT)) + hh * 16384, 128, nb * 64, scr, lane);
        } else if (it < S9) { const int r = it - S8, kb = r / 16, nb = r % 16; tr_item(wo, D, nb * 64, kb * 64, nullptr, (bf16*)(ws + WS_WO), D, nb * 64, scr, lane);
        } else if (it < S10) { const int r = it - S9, kb = r / 16, nb = r % 16; tr_item(wxq, D, nb * 64, kb * 64, gc, (bf16*)(ws + WS_WXQ), D, nb * 64, scr, lane);
        } else if (it < S11) { const int r = it - S10, kb = r / 32, nb = r % 32; tr_item(wxkv, 2 * D, nb * 64, kb * 64, nullptr, (bf16*)(ws + WS_WXKV), D, nb * 64, scr, lane);
        } else { const int r = it - S11, kb = r / 16, nb = r % 16; tr_item(wxo, D, nb * 64, kb * 64, nullptr, (bf16*)(ws + WS_WXO), D, nb * 64, scr, lane); }
    }
    { bf16* UaT = (bf16*)(ws + WS_UA);
      for (int it = gw; it < 4 * 16 * 16; it += NGW) { const int g = it >> 8, nblk = (it >> 4) & 15, c0 = (it & 15) * 8, n = nblk * 64 + lane;
          const float* wp = wpool + ((size_t)g * 128 + c0) * 128; const float* sc = psc + g * 128; const float* ua = wua + (size_t)(g * 128) * D + n; float acc[8];
#pragma unroll
          for (int c = 0; c < 8; ++c) acc[c] = 0.f;
#pragma unroll 16
          for (int j = 0; j < 128; ++j) { const float u = ua[(size_t)j * D] * sc[j];
#pragma unroll
              for (int c = 0; c < 8; ++c) acc[c] += wp[c * 128 + j] * u; }
          v4u o; o.x = pk2(acc[0], acc[1]); o.y = pk2(acc[2], acc[3]); o.z = pk2(acc[4], acc[5]); o.w = pk2(acc[6], acc[7]);
          *(v4u*)(UaT + (size_t)n * 512 + g * 128 + c0) = o; } }
    { float* wfl = (float*)(ws + WS_WFL);
      for (int it = gw * 64 + lane; it < 8 * 1024; it += NGW * 64) { const int h = it >> 10, k = it & 1023; wfl[it] = gm[k] * win[(size_t)k * INW + 4096 + h]; } }
    { const float* mem = tab_in(TB, 1); bf16* mn = (bf16*)(ws + WS_MEMN);
      for (int r = gw; r < 512; r += NGW) { const f32x4* xr = (const f32x4*)(mem + (size_t)r * D) + lane; f32x4 v[4]; float s = 0.f;
#pragma unroll
          for (int j = 0; j < 4; ++j) { v[j] = xr[64 * j]; s += (v[j].x * v[j].x + v[j].y * v[j].y) + (v[j].z * v[j].z + v[j].w * v[j].w); }
          const float rs = rsqrtf(wave_sum(s, lane) * (1.f / D) + 1e-6f); unsigned long long* o8 = (unsigned long long*)(mn + (size_t)r * D) + lane;
#pragma unroll
          for (int j = 0; j < 4; ++j) { const f32x4 gv = *((const f32x4*)gmem + lane + 64 * j);
              o8[64 * j] = (unsigned long long)pk2(v[j].x * rs * gv.x, v[j].y * rs * gv.y) | ((unsigned long long)pk2(v[j].z * rs * gv.z, v[j].w * rs * gv.w) << 32); } } }
    if (l == 0) {
        const float* x = tab_in(TB, 0); (void)xout; bf16* xb = (bf16*)(ws + WS_XB); float* ss = (float*)(ws + WS_SSP);
        for (int r0 = gw; r0 < M; r0 += 4 * NGW) { f32x4 v[4][4]; float s[4];
#pragma unroll
            for (int q = 0; q < 4; ++q) { const int r = (r0 + q * NGW < M) ? r0 + q * NGW : r0; const f32x4* xr = (const f32x4*)(x + (size_t)r * D) + lane; s[q] = 0.f;
#pragma unroll
                for (int j = 0; j < 4; ++j) { v[q][j] = xr[64 * j]; s[q] += (v[q][j].x * v[q][j].x + v[q][j].y * v[q][j].y) + (v[q][j].z * v[q][j].z + v[q][j].w * v[q][j].w); } }
#pragma unroll
            for (int o = 1; o < 64; o <<= 1) {
#pragma unroll
                for (int q = 0; q < 4; ++q) s[q] += bperm(s[q], lane ^ o); }
#pragma unroll
            for (int q = 0; q < 4; ++q) { const int r = r0 + q * NGW; if (r < M) { unsigned long long* o8 = (unsigned long long*)(xb + (size_t)r * D) + lane;
                    if (lane < 4) ss[(size_t)r * 4 + lane] = lane == 0 ? s[q] : 0.f;
#pragma unroll
                    for (int j = 0; j < 4; ++j) { o8[64 * j] = (unsigned long long)pk2(v[q][j].x, v[q][j].y) | ((unsigned long long)pk2(v[q][j].z, v[q][j].w) << 32); } } }
        }
    }
}
#undef g1
#undef w1i
#undef w1o
#undef gm
#undef win
#undef wpool
#undef psc
#undef wua
#undef wra
#undef wrx
#undef wub
#undef wuc
#undef wo
#undef gc
#undef gmem
#undef wxq
#undef wxkv
#undef wxo
#undef g2
#undef w2i
#undef w2o
__device__ __forceinline__ void phase_fl(const bf16* xb, const float* wfl, const float* bfv, const float* ss, float* logf, int gw, int NGW, int lane) {
    for (int r0 = gw; r0 < M; r0 += 4 * NGW) {
        float acc[4][8]; v4u xv[4][2];
#pragma unroll
        for (int q = 0; q < 4; ++q) { const int r = r0 + q * NGW; const bool ok = r < M;
#pragma unroll
            for (int j = 0; j < 2; ++j) xv[q][j] = ok ? *(const v4u*)(xb + (size_t)r * D + 8 * lane + 512 * j) : (v4u){0u, 0u, 0u, 0u};
#pragma unroll
            for (int h = 0; h < 8; ++h) acc[q][h] = 0.f; }
#pragma unroll
        for (int j = 0; j < 2; ++j) { const int k0 = 8 * lane + 512 * j;
#pragma unroll
            for (int h = 0; h < 8; ++h) { const f32x4 w0 = *(const f32x4*)(wfl + h * 1024 + k0), w1 = *(const f32x4*)(wfl + h * 1024 + k0 + 4);
#pragma unroll
                for (int q = 0; q < 4; ++q) { const v4u x = xv[q][j];
                    acc[q][h] += (__uint_as_float(x.x << 16) * w0.x + __uint_as_float(x.x & 0xffff0000u) * w0.y) + (__uint_as_float(x.y << 16) * w0.z + __uint_as_float(x.y & 0xffff0000u) * w0.w)
                               + (__uint_as_float(x.z << 16) * w1.x + __uint_as_float(x.z & 0xffff0000u) * w1.y) + (__uint_as_float(x.w << 16) * w1.z + __uint_as_float(x.w & 0xffff0000u) * w1.w); } } }
        const int h = ((lane >> 5) & 1) * 4 + ((lane >> 4) & 1) * 2 + ((lane >> 3) & 1); const float bh_ = bfv[h];
#pragma unroll
        for (int q = 0; q < 4; ++q) { const int r = r0 + q * NGW;
            float v4[4], v2[2], v1;
            { const bool up = (lane & 32) != 0;
#pragma unroll
              for (int i = 0; i < 4; ++i) { const float mine = up ? acc[q][4 + i] : acc[q][i], other = up ? acc[q][i] : acc[q][4 + i]; v4[i] = mine + bperm(other, lane ^ 32); } }
            { const bool up = (lane & 16) != 0;
#pragma unroll
              for (int i = 0; i < 2; ++i) { const float mine = up ? v4[2 + i] : v4[i], other = up ? v4[i] : v4[2 + i]; v2[i] = mine + bperm(other, lane ^ 16); } }
            { const bool up = (lane & 8) != 0; const float mine = up ? v2[1] : v2[0], other = up ? v2[0] : v2[1]; v1 = mine + bperm(other, lane ^ 8); }
            v1 += bperm(v1, lane ^ 4); v1 += bperm(v1, lane ^ 2); v1 += bperm(v1, lane ^ 1);
            if (r < M) { const float z = v1 * pg8::rstd_of(ss, r) + bh_; const float ls = -(fmaxf(-z, 0.f) + flog1p(__expf(-fabsf(z)))); if ((lane & 7) == 0) logf[(size_t)r * 8 + h] = ls; } }
    }
}
__device__ __forceinline__ void cumsum_bh(const float* logf, float* ctil, int bh, LAS float* red) {
    int tid_o = threadIdx.x; asm volatile("" : "+v"(tid_o)); const int tid = tid_o, lane = tid & 63, wid = tid >> 6;
    const int b = bh >> 3, h = bh & 7; const float* src = logf + ((size_t)b * SEQ + 16 * tid) * 8 + h; float v[16]; float s = 0.f;
#pragma unroll
    for (int i = 0; i < 16; ++i) { v[i] = src[(size_t)i * 8]; s += v[i]; }
    float incl = s;
#pragma unroll
    for (int o = 1; o < 64; o <<= 1) { const float t = bperm(incl, lane - o); if (lane >= o) incl += t; }
    if (lane == 63) red[wid] = incl;
    __syncthreads();
    float base = 0.f;
#pragma unroll
    for (int w = 0; w < 8; ++w) if (w < wid) base += red[w];
    float run = base + incl - s; float* dst = ctil + (size_t)bh * SEQ + 16 * tid;
#pragma unroll
    for (int i = 0; i < 16; ++i) { run += v[i]; dst[i] = run * 1.4426950408889634f; }
    __syncthreads();
}
__device__ __forceinline__ void unpk8(const v4u xv, float (&xf)[8]) { xf[0] = __uint_as_float(xv.x << 16); xf[1] = __uint_as_float(xv.x & 0xffff0000u); xf[2] = __uint_as_float(xv.y << 16); xf[3] = __uint_as_float(xv.y & 0xffff0000u);
    xf[4] = __uint_as_float(xv.z << 16); xf[5] = __uint_as_float(xv.z & 0xffff0000u); xf[6] = __uint_as_float(xv.w << 16); xf[7] = __uint_as_float(xv.w & 0xffff0000u); }
template <int W> __device__ __forceinline__ void pool_item(const bf16* xa, bf16* ya, int m0, int cgi) {
    const int t0 = m0 & (SEQ - 1); v4u rw[W + 7];
#pragma unroll
    for (int a = 0; a < W + 7; ++a) { const int tl = a - (W - 1); rw[a] = (t0 + tl >= 0) ? *(const v4u*)(xa + (size_t)(m0 + tl) * 512 + 8 * cgi) : (v4u){0u, 0u, 0u, 0u}; }
    float s[8];
#pragma unroll
    for (int i = 0; i < 8; ++i) s[i] = 0.f;
#pragma unroll
    for (int a = 0; a < W - 1; ++a) { float xf[8]; unpk8(rw[a], xf);
#pragma unroll
        for (int i = 0; i < 8; ++i) s[i] += xf[i]; }
#pragma unroll
    for (int o = 0; o < 8; ++o) { float cur[8]; unpk8(rw[o + W - 1], cur);
#pragma unroll
        for (int i = 0; i < 8; ++i) s[i] += cur[i];
        const int t = t0 + o, cnt = (t + 1 < W) ? t + 1 : W; const float ic = 1.f / (float)cnt; v4u ov;
        ov.x = pk2(s[0] * ic - cur[0], s[1] * ic - cur[1]); ov.y = pk2(s[2] * ic - cur[2], s[3] * ic - cur[3]); ov.z = pk2(s[4] * ic - cur[4], s[5] * ic - cur[5]); ov.w = pk2(s[6] * ic - cur[6], s[7] * ic - cur[7]);
        *(v4u*)(ya + (size_t)(m0 + o) * 512 + 8 * cgi) = ov;
        float old[8]; unpk8(rw[o], old);
#pragma unroll
        for (int i = 0; i < 8; ++i) s[i] -= old[i]; }
}
__device__ __forceinline__ void phase_pool(const bf16* xa, bf16* ya, int gtid, int nthr) {
    for (int idx = gtid; idx < (M / 8) * 64; idx += nthr) { const int c16 = idx & 15, rl = (idx >> 4) & 3, g = (idx >> 6) & 3, rh = idx >> 8; const int m0 = (rh * 4 + rl) * 8, cgi = g * 16 + c16;
        if (g == 0) pool_item<2>(xa, ya, m0, cgi); else if (g == 1) pool_item<4>(xa, ya, m0, cgi); else if (g == 2) pool_item<8>(xa, ya, m0, cgi); else pool_item<16>(xa, ya, m0, cgi); }
}
__device__ __forceinline__ int crow16(int r, int hi) { return (r & 3) + 8 * (r >> 2) + 4 * hi; }
template <bool FINAL>
__device__ __forceinline__ void lru_item(LAS unsigned char* lds, int b, int hp, int ck, const bf16* xl, bf16* gg, const float* cw, const float* cb, const bf16* WaT, const bf16* WxT,
                                         const float* ba, const float* bx, const float* lam, float* summ) {
    int tid_o = threadIdx.x; asm volatile("" : "+v"(tid_o)); const int tid = tid_o, lane = tid & 63, wid = tid >> 6, r32 = lane & 31, hi = lane >> 5;
    const int t0 = ck * 128; const size_t m0 = (size_t)b * SEQ + t0; const int ch0 = hp * 256;
    constexpr int XP = 264;
    LAS bf16* xc = (LAS bf16*)lds; LAS float* h0s = (LAS float*)(lds + 128 * XP * 2);
    {
        const int cgi = tid & 31, tq = tid >> 5, c = ch0 + 8 * cgi;
        float w[4][8], bb[8];
#pragma unroll
        for (int k = 0; k < 4; ++k) { const f32x4 a = *(const f32x4*)(cw + k * 1024 + c), d = *(const f32x4*)(cw + k * 1024 + c + 4); w[k][0] = a.x; w[k][1] = a.y; w[k][2] = a.z; w[k][3] = a.w; w[k][4] = d.x; w[k][5] = d.y; w[k][6] = d.z; w[k][7] = d.w; }
        { const f32x4 a = *(const f32x4*)(cb + c), d = *(const f32x4*)(cb + c + 4); bb[0] = a.x; bb[1] = a.y; bb[2] = a.z; bb[3] = a.w; bb[4] = d.x; bb[5] = d.y; bb[6] = d.z; bb[7] = d.w; }
        v4u rw[11];
#pragma unroll
        for (int i = 0; i < 11; ++i) { const int tl = tq * 8 - 3 + i; rw[i] = (t0 + tl >= 0) ? *(const v4u*)(xl + (size_t)((long)m0 + tl) * 1024 + c) : (v4u){0u, 0u, 0u, 0u}; }
#pragma unroll
        for (int o = 0; o < 8; ++o) { float y[8];
#pragma unroll
            for (int j = 0; j < 8; ++j) y[j] = bb[j];
#pragma unroll
            for (int k = 0; k < 4; ++k) { const v4u xv = rw[o + k];
                y[0] += w[k][0] * __uint_as_float(xv.x << 16); y[1] += w[k][1] * __uint_as_float(xv.x & 0xffff0000u); y[2] += w[k][2] * __uint_as_float(xv.y << 16); y[3] += w[k][3] * __uint_as_float(xv.y & 0xffff0000u);
                y[4] += w[k][4] * __uint_as_float(xv.z << 16); y[5] += w[k][5] * __uint_as_float(xv.z & 0xffff0000u); y[6] += w[k][6] * __uint_as_float(xv.w << 16); y[7] += w[k][7] * __uint_as_float(xv.w & 0xffff0000u); }
            v4u ov; ov.x = pk2(y[0], y[1]); ov.y = pk2(y[2], y[3]); ov.z = pk2(y[4], y[5]); ov.w = pk2(y[6], y[7]);
            *(LAS v4u*)(xc + (tq * 8 + o) * XP + 8 * cgi) = ov; }
    }
    if (FINAL && tid < 256) {
        const float* sp = summ + ((size_t)b * 64 * 1024 + ch0 + tid) * 2; float h = 0.f;
        for (int c0 = 0; c0 < ck; c0 += 16) { float2 v[16];
#pragma unroll
            for (int j = 0; j < 16; ++j) v[j] = (c0 + j < ck) ? *(const float2*)(sp + (size_t)(c0 + j) * 2048) : make_float2(1.f, 0.f);
#pragma unroll
            for (int j = 0; j < 16; ++j) h = v[j].x * h + v[j].y; }
        h0s[tid] = h;
    }
    __syncthreads();
    const int hh = wid >> 2, s = wid & 3, chl = 128 * hh + 32 * s + r32, ch = ch0 + chl, head = 2 * hp + hh;
    const float bav = ba[ch], bxv = bx[ch]; const float nl = -lam[ch]; const float sp8 = 8.f * (fmaxf(nl, 0.f) + flog1p(__expf(-fabsf(nl))));
    bf16x8 fa[8], fx[8];
#pragma unroll
    for (int ks = 0; ks < 8; ++ks) { fa[ks] = *(const bf16x8*)(WaT + (size_t)head * 16384 + (32 * s + r32) * 128 + 16 * ks + 8 * hi); fx[ks] = *(const bf16x8*)(WxT + (size_t)head * 16384 + (32 * s + r32) * 128 + 16 * ks + 8 * hi); }
    float hrun = FINAL ? h0s[chl] : 0.f, Arun = 1.f;
    for (int mb = 0; mb < 4; ++mb) {
        unsigned short gv[16];
        if (FINAL) {
#pragma unroll
            for (int r = 0; r < 16; ++r) gv[r] = gg[(m0 + 32 * mb + crow16(r, hi)) * 1024 + ch]; }
        f32x16 accA = {0.f, 0.f, 0.f, 0.f, 0.f, 0.f, 0.f, 0.f, 0.f, 0.f, 0.f, 0.f, 0.f, 0.f, 0.f, 0.f}, accX = accA;
#pragma unroll
        for (int ks = 0; ks < 8; ++ks) { const bf16x8 af = *(const LAS bf16x8*)(xc + (32 * mb + r32) * XP + 128 * hh + 16 * ks + 8 * hi);
            accA = __builtin_amdgcn_mfma_f32_32x32x16_bf16(af, fa[ks], accA, 0, 0, 0); accX = __builtin_amdgcn_mfma_f32_32x32x16_bf16(af, fx[ks], accX, 0, 0, 0); }
        float a[16], u[16];
#pragma unroll
        for (int r = 0; r < 16; ++r) { const int tok = 32 * mb + crow16(r, hi); const float xcv = bf2f(xc[tok * XP + chl]);
            const float rg = pg8::fsig(accA[r] + bav), la = -rg * sp8, av = __expf(la), mult = __builtin_amdgcn_sqrtf(fmaxf(1.f - av * av, 0.f)), ig = pg8::fsig(accX[r] + bxv);
            a[r] = av; u[r] = mult * ig * xcv; }
        float As[4], Hs[4], Ap[4], Hp[4], hin[4];
#pragma unroll
        for (int g = 0; g < 4; ++g) { float Aq = 1.f, Hq = 0.f;
#pragma unroll
            for (int i = 0; i < 4; ++i) { Hq = a[4 * g + i] * Hq + u[4 * g + i]; Aq *= a[4 * g + i]; }
            As[g] = Aq; Hs[g] = Hq; Ap[g] = bperm(Aq, lane ^ 32); Hp[g] = bperm(Hq, lane ^ 32); }
#pragma unroll
        for (int g = 0; g < 4; ++g) { const float A0 = hi ? Ap[g] : As[g], H0 = hi ? Hp[g] : Hs[g], A1 = hi ? As[g] : Ap[g], H1 = hi ? Hs[g] : Hp[g];
            const float hA = hrun, hB = A0 * hA + H0; hrun = A1 * hB + H1; Arun *= A0 * A1; hin[g] = hi ? hB : hA; }
        if (FINAL) {
#pragma unroll
            for (int g = 0; g < 4; ++g) { float hc = hin[g];
#pragma unroll
                for (int i = 0; i < 4; ++i) { const int r = 4 * g + i; hc = a[r] * hc + u[r]; gv[r] = (unsigned short)f2bf(hc * bf2f(gv[r])); } }
#pragma unroll
            for (int r = 0; r < 16; ++r) gg[(m0 + 32 * mb + crow16(r, hi)) * 1024 + ch] = gv[r];
        }
    }
    if (!FINAL && hi == 0) { float* sp = summ + (((size_t)b * 64 + ck) * 1024 + ch) * 2; sp[0] = Arun; sp[1] = hrun; }
    __syncthreads();
}
__device__ __forceinline__ void phase_final(float* x, const float* g, int gw, int NGW, int lane) {
    f32x4 gv[4];
#pragma unroll
    for (int j = 0; j < 4; ++j) gv[j] = *((const f32x4*)g + lane + 64 * j);
    for (int r0 = gw; r0 < M; r0 += 4 * NGW) { f32x4 v[4][4]; float s[4];
#pragma unroll
        for (int q = 0; q < 4; ++q) { const int r = (r0 + q * NGW < M) ? r0 + q * NGW : r0; const f32x4* xr = (const f32x4*)(x + (size_t)r * D) + lane; s[q] = 0.f;
#pragma unroll
            for (int j = 0; j < 4; ++j) { v[q][j] = xr[64 * j]; s[q] += (v[q][j].x * v[q][j].x + v[q][j].y * v[q][j].y) + (v[q][j].z * v[q][j].z + v[q][j].w * v[q][j].w); } }
#pragma unroll
        for (int o = 1; o < 64; o <<= 1) {
#pragma unroll
            for (int q = 0; q < 4; ++q) s[q] += bperm(s[q], lane ^ o); }
#pragma unroll
        for (int q = 0; q < 4; ++q) { const int r = r0 + q * NGW; if (r < M) { const float rs = rsqrtf(s[q] * (1.f / D) + 1e-6f); f32x4* xr = (f32x4*)(x + (size_t)r * D) + lane;
#pragma unroll
                for (int j = 0; j < 4; ++j) xr[64 * j] = (f32x4){v[q][j].x * rs * gv[j].x, v[q][j].y * rs * gv[j].y, v[q][j].z * rs * gv[j].z, v[q][j].w * rs * gv[j].w}; } }
    }
}
__device__ __forceinline__ void phase_kmax(const bf16* K, float* kpart, int gw, int NGW, int lane) {
    float m0 = 0.f, m1 = 0.f;
#pragma unroll 8
    for (int r = gw; r < M; r += NGW) { const v4u w = *(const v4u*)(K + (size_t)r * 512 + 8 * lane);
        const float a0 = __uint_as_float(w.x << 16), a1 = __uint_as_float(w.x & 0xffff0000u), a2 = __uint_as_float(w.y << 16), a3 = __uint_as_float(w.y & 0xffff0000u);
        const float a4 = __uint_as_float(w.z << 16), a5 = __uint_as_float(w.z & 0xffff0000u), a6 = __uint_as_float(w.w << 16), a7 = __uint_as_float(w.w & 0xffff0000u);
        float s = (a0 * a0 + a1 * a1) + (a2 * a2 + a3 * a3) + (a4 * a4 + a5 * a5) + (a6 * a6 + a7 * a7);
        s += bperm(s, lane ^ 1); s += bperm(s, lane ^ 2); s += bperm(s, lane ^ 4);
        if (r < SEQ) m0 = fmaxf(m0, s); else m1 = fmaxf(m1, s); }
    if ((lane & 7) == 0) { kpart[((size_t)gw * 2 + 0) * 8 + (lane >> 3)] = m0; kpart[((size_t)gw * 2 + 1) * 8 + (lane >> 3)] = m1; }
}
constexpr float FOX_C2 = 0.125f * 1.4426950408889634f;
constexpr float FOX_SKIP = 64.f;
constexpr int FOX_KP = 72;
constexpr int FOX_BUF = 2 * 64 * FOX_KP * 2 + 256;
__device__ __forceinline__ void fox_unit(LAS unsigned char* lds, int b, int h, int qb, const bf16* Q, const bf16* K, const bf16* V, bf16* O, const float* ct, const float* kpart, int nparts) {
    int tid_o = threadIdx.x; asm volatile("" : "+v"(tid_o)); const int tid = tid_o, lane = tid & 63, wid = tid >> 6, r32 = lane & 31, hi = lane >> 5;
    const size_t rowbase = (size_t)b * SEQ; const int q0 = qb * 256, NT = 4 * qb + 4;
    const bf16* Qw = Q + (rowbase + q0 + wid * 32 + r32) * 512 + h * 64;
    bf16x8 qr[4];
#pragma unroll
    for (int d0 = 0; d0 < 4; ++d0) qr[d0] = *(const bf16x8*)(Qw + 16 * d0 + 8 * hi);
    LAS float* red = (LAS float*)(lds + 2 * FOX_BUF); LAS int* tsl = (LAS int*)(lds + 2 * FOX_BUF + 128);
    { float qn = 0.f;
#pragma unroll
      for (int d0 = 0; d0 < 4; ++d0) { const v4u w = __builtin_bit_cast(v4u, qr[d0]);
          const float a0 = __uint_as_float(w.x << 16), a1 = __uint_as_float(w.x & 0xffff0000u), a2 = __uint_as_float(w.y << 16), a3 = __uint_as_float(w.y & 0xffff0000u);
          const float a4 = __uint_as_float(w.z << 16), a5 = __uint_as_float(w.z & 0xffff0000u), a6 = __uint_as_float(w.w << 16), a7 = __uint_as_float(w.w & 0xffff0000u);
          qn += (a0 * a0 + a1 * a1) + (a2 * a2 + a3 * a3) + (a4 * a4 + a5 * a5) + (a6 * a6 + a7 * a7); }
      qn += bperm(qn, lane ^ 32);
#pragma unroll
      for (int o = 1; o < 32; o <<= 1) qn = fmaxf(qn, bperm(qn, lane ^ o));
      __syncthreads();
      float km = 0.f;
      for (int i = tid; i < nparts; i += NTHR) km = fmaxf(km, kpart[((size_t)i * 2 + b) * 8 + h]);
#pragma unroll
      for (int o = 1; o < 64; o <<= 1) km = fmaxf(km, bperm(km, lane ^ o));
      if (lane == 0) { red[wid] = qn; red[8 + wid] = km; } if (tid == 0) tsl[0] = 4 * qb;
      __syncthreads();
      float q2 = red[0], k2 = red[8];
#pragma unroll
      for (int w = 1; w < 8; ++w) { q2 = fmaxf(q2, red[w]); k2 = fmaxf(k2, red[8 + w]); }
      const float thr = 2.f * sqrtf(q2) * sqrtf(k2) * 1.0001f + FOX_SKIP;
      const float c0 = ct[q0];
      if (tid < 4 * qb && ct[64 * tid + 63] - c0 <= thr) atomicMin((int*)tsl, tid);
      __syncthreads(); }
    const int T0 = tsl[0];
    const int skey = tid >> 3, sd = (tid & 7) * 8;
    const bf16* kp = K + (rowbase + skey) * 512 + h * 64 + sd; const bf16* vp = V + (rowbase + skey) * 512 + h * 64 + sd;
    v4u kreg = *(const v4u*)(kp + (size_t)T0 * 64 * 512), vreg = *(const v4u*)(vp + (size_t)T0 * 64 * 512); float creg = (tid < 64) ? ct[64 * T0 + tid] : 0.f;
    __syncthreads();
    { LAS unsigned char* buf0 = lds + (T0 & 1) * FOX_BUF; LAS bf16* Ks = (LAS bf16*)buf0; LAS bf16* Vt = Ks + 64 * FOX_KP; LAS float* Cs = (LAS float*)(buf0 + 2 * 64 * FOX_KP * 2);
      *(LAS v4u*)(Ks + skey * FOX_KP + sd) = kreg;
      Vt[(sd + 0) * FOX_KP + skey] = (bf16)(vreg.x & 0xffffu); Vt[(sd + 1) * FOX_KP + skey] = (bf16)(vreg.x >> 16); Vt[(sd + 2) * FOX_KP + skey] = (bf16)(vreg.y & 0xffffu); Vt[(sd + 3) * FOX_KP + skey] = (bf16)(vreg.y >> 16);
      Vt[(sd + 4) * FOX_KP + skey] = (bf16)(vreg.z & 0xffffu); Vt[(sd + 5) * FOX_KP + skey] = (bf16)(vreg.z >> 16); Vt[(sd + 6) * FOX_KP + skey] = (bf16)(vreg.w & 0xffffu); Vt[(sd + 7) * FOX_KP + skey] = (bf16)(vreg.w >> 16);
      if (tid < 64) Cs[tid] = creg; }
    if (T0 + 1 < NT) { kreg = *(const v4u*)(kp + (size_t)(T0 + 1) * 64 * 512); vreg = *(const v4u*)(vp + (size_t)(T0 + 1) * 64 * 512); if (tid < 64) creg = ct[64 * (T0 + 1) + tid]; }
    float m = -1e30f, l = 0.f; f32x16 o0, o1;
#pragma unroll
    for (int r = 0; r < 16; ++r) { o0[r] = 0.f; o1[r] = 0.f; }
    for (int t = T0; t < NT; ++t) {
        __syncthreads();
        if (t + 1 < NT) { LAS unsigned char* bufn = lds + ((t + 1) & 1) * FOX_BUF; LAS bf16* Ks = (LAS bf16*)bufn; LAS bf16* Vt = Ks + 64 * FOX_KP; LAS float* Cs = (LAS float*)(bufn + 2 * 64 * FOX_KP * 2);
            *(LAS v4u*)(Ks + skey * FOX_KP + sd) = kreg;
            Vt[(sd + 0) * FOX_KP + skey] = (bf16)(vreg.x & 0xffffu); Vt[(sd + 1) * FOX_KP + skey] = (bf16)(vreg.x >> 16); Vt[(sd + 2) * FOX_KP + skey] = (bf16)(vreg.y & 0xffffu); Vt[(sd + 3) * FOX_KP + skey] = (bf16)(vreg.y >> 16);
            Vt[(sd + 4) * FOX_KP + skey] = (bf16)(vreg.z & 0xffffu); Vt[(sd + 5) * FOX_KP + skey] = (bf16)(vreg.z >> 16); Vt[(sd + 6) * FOX_KP + skey] = (bf16)(vreg.w & 0xffffu); Vt[(sd + 7) * FOX_KP + skey] = (bf16)(vreg.w >> 16);
            if (tid < 64) Cs[tid] = creg;
            if (t + 2 < NT) { kreg = *(const v4u*)(kp + (size_t)(t + 2) * 64 * 512); vreg = *(const v4u*)(vp + (size_t)(t + 2) * 64 * 512); if (tid < 64) creg = ct[64 * (t + 2) + tid]; } }
        const int jb = t - (NT - 4);
        if (jb >= 0 && 64 * jb > 32 * wid + 31) continue;
        LAS unsigned char* buf = lds + (t & 1) * FOX_BUF; const LAS bf16* Ks = (const LAS bf16*)buf; const LAS bf16* Vt = Ks + 64 * FOX_KP; const LAS float* Cs = (const LAS float*)(buf + 2 * 64 * FOX_KP * 2);
        f32x16 p0, p1;
#pragma unroll
        for (int g = 0; g < 4; ++g) { const f32x4 a = *(const LAS f32x4*)(Cs + 8 * g + 4 * hi), c = *(const LAS f32x4*)(Cs + 32 + 8 * g + 4 * hi);
            p0[4 * g + 0] = -a[0]; p0[4 * g + 1] = -a[1]; p0[4 * g + 2] = -a[2]; p0[4 * g + 3] = -a[3]; p1[4 * g + 0] = -c[0]; p1[4 * g + 1] = -c[1]; p1[4 * g + 2] = -c[2]; p1[4 * g + 3] = -c[3]; }
#pragma unroll
        for (int d0 = 0; d0 < 4; ++d0) { const bf16x8 a0 = *(const LAS bf16x8*)(Ks + r32 * FOX_KP + 16 * d0 + 8 * hi), a1 = *(const LAS bf16x8*)(Ks + (32 + r32) * FOX_KP + 16 * d0 + 8 * hi);
            p0 = __builtin_amdgcn_mfma_f32_32x32x16_bf16(a0, qr[d0], p0, 0, 0, 0); p1 = __builtin_amdgcn_mfma_f32_32x32x16_bf16(a1, qr[d0], p1, 0, 0, 0); }
        if (jb >= 0) { const int qrel = 32 * wid + r32, kb = 64 * jb + 4 * hi;
#pragma unroll
            for (int r = 0; r < 16; ++r) { const int kv = kb + (r & 3) + 8 * (r >> 2); if (kv > qrel) p0[r] = -__builtin_inff(); if (kv + 32 > qrel) p1[r] = -__builtin_inff(); } }
        float mx = fmaxf(p0[0], p1[0]);
#pragma unroll
        for (int r = 1; r < 16; ++r) mx = fmaxf(mx, fmaxf(p0[r], p1[r]));
        mx = fmaxf(mx, bperm(mx, lane ^ 32));
        const float mn = fmaxf(m, mx), alpha = __builtin_amdgcn_exp2f(m - mn); m = mn;
        float sum = 0.f;
#pragma unroll
        for (int r = 0; r < 16; ++r) { p0[r] = __builtin_amdgcn_exp2f(p0[r] - mn); p1[r] = __builtin_amdgcn_exp2f(p1[r] - mn); sum += p0[r] + p1[r]; }
        l = l * alpha + sum;
#pragma unroll
        for (int r = 0; r < 16; ++r) { o0[r] *= alpha; o1[r] *= alpha; }
        bf16x8 pb[4];
        { v4u w;
          w.x = pg8::cvt_pk_bf16(p0[0], p0[1]); w.y = pg8::cvt_pk_bf16(p0[2], p0[3]); w.z = pg8::cvt_pk_bf16(p0[4], p0[5]); w.w = pg8::cvt_pk_bf16(p0[6], p0[7]); pb[0] = __builtin_bit_cast(bf16x8, w);
          w.x = pg8::cvt_pk_bf16(p0[8], p0[9]); w.y = pg8::cvt_pk_bf16(p0[10], p0[11]); w.z = pg8::cvt_pk_bf16(p0[12], p0[13]); w.w = pg8::cvt_pk_bf16(p0[14], p0[15]); pb[1] = __builtin_bit_cast(bf16x8, w);
          w.x = pg8::cvt_pk_bf16(p1[0], p1[1]); w.y = pg8::cvt_pk_bf16(p1[2], p1[3]); w.z = pg8::cvt_pk_bf16(p1[4], p1[5]); w.w = pg8::cvt_pk_bf16(p1[6], p1[7]); pb[2] = __builtin_bit_cast(bf16x8, w);
          w.x = pg8::cvt_pk_bf16(p1[8], p1[9]); w.y = pg8::cvt_pk_bf16(p1[10], p1[11]); w.z = pg8::cvt_pk_bf16(p1[12], p1[13]); w.w = pg8::cvt_pk_bf16(p1[14], p1[15]); pb[3] = __builtin_bit_cast(bf16x8, w); }
#pragma unroll
        for (int mm = 0; mm < 4; ++mm) {
            typedef unsigned u32x2v __attribute__((ext_vector_type(2)));
            const u32x2v a0l = *(const LAS u32x2v*)(Vt + r32 * FOX_KP + 16 * mm + 4 * hi), a0h = *(const LAS u32x2v*)(Vt + r32 * FOX_KP + 16 * mm + 8 + 4 * hi);
            const u32x2v a1l = *(const LAS u32x2v*)(Vt + (32 + r32) * FOX_KP + 16 * mm + 4 * hi), a1h = *(const LAS u32x2v*)(Vt + (32 + r32) * FOX_KP + 16 * mm + 8 + 4 * hi);
            const v4u A0 = {a0l.x, a0l.y, a0h.x, a0h.y}, A1 = {a1l.x, a1l.y, a1h.x, a1h.y};
            o0 = __builtin_amdgcn_mfma_f32_32x32x16_bf16(__builtin_bit_cast(bf16x8, A0), pb[mm], o0, 0, 0, 0);
            o1 = __builtin_amdgcn_mfma_f32_32x32x16_bf16(__builtin_bit_cast(bf16x8, A1), pb[mm], o1, 0, 0, 0); }
    }
    l += bperm(l, lane ^ 32); const float inv = 1.f / l;
    bf16* Ow = O + (rowbase + q0 + wid * 32 + r32) * 512 + h * 64;
#pragma unroll
    for (int g = 0; g < 4; ++g) { typedef unsigned u32x2v __attribute__((ext_vector_type(2)));
        u32x2v w0, w1; w0.x = pg8::cvt_pk_bf16(o0[4 * g] * inv, o0[4 * g + 1] * inv); w0.y = pg8::cvt_pk_bf16(o0[4 * g + 2] * inv, o0[4 * g + 3] * inv);
        w1.x = pg8::cvt_pk_bf16(o1[4 * g] * inv, o1[4 * g + 1] * inv); w1.y = pg8::cvt_pk_bf16(o1[4 * g + 2] * inv, o1[4 * g + 3] * inv);
        *(u32x2v*)(Ow + 8 * g + 4 * hi) = w0; *(u32x2v*)(Ow + 32 + 8 * g + 4 * hi) = w1; }
    __syncthreads();
}
__global__ void __launch_bounds__(NTHR, 2) hybrid_fwd(Args args) {
    extern __shared__ __attribute__((aligned(16))) unsigned char lds_raw[];
    cg::grid_group grid = cg::this_grid();
    LAS unsigned char* lds = (LAS unsigned char*)lds_raw;
    int tid = threadIdx.x, lane = tid & 63, wave = __builtin_amdgcn_readfirstlane(tid >> 6);
    int G = gridDim.x, bx = blockIdx.x;
    int vcu = (G % 8 == 0) ? (bx % 8) * (G / 8) + bx / 8 : bx;
    int gw = vcu * NWAVES + wave; int NGW = G * NWAVES;
    PtrTab TB = (PtrTab)(lds + TAB_OFF);
    if (tid == 0) {
#pragma unroll
        for (int i = 0; i < 31; ++i) TB[i] = (unsigned long long)args.in[i];
    }
    if (tid == 1) { TB[40] = 0ull; }
    __syncthreads();
    (void)xcd_barrier_post((unsigned*)(args.ws + WS_BAR), (volatile LAS unsigned*)(lds + TAB_OFF + 320));
    grid.sync();
    unsigned char* ws = args.ws;
    float* X = args.out;
    float* SS = (float*)(ws + WS_SSP);
    bf16* XB = (bf16*)(ws + WS_XB);
    bf16* HB = (bf16*)(ws + WS_H);
    constexpr float C2X = 0.0625f * 1.4426950408889634f;
#define GSYNC() do { asm volatile("s_waitcnt vmcnt(0) lgkmcnt(0)" ::: "memory"); { XcdBarrier xb_; xb_.bar = (unsigned*)(ws + WS_BAR); xb_.x = xb_xcc_id(); xb_.st = (volatile LAS unsigned*)(lds + TAB_OFF + 320); xcd_barrier(xb_); } tid = threadIdx.x; asm volatile("" : "+v"(tid)); lane = tid & 63; wave = __builtin_amdgcn_readfirstlane(tid >> 6); G = gridDim.x; bx = blockIdx.x; asm volatile("" : "+s"(G), "+s"(bx)); vcu = (G % 8 == 0) ? (bx % 8) * (G / 8) + bx / 8 : bx; gw = vcu * NWAVES + wave; NGW = G * NWAVES; { unsigned long long wsi_ = (unsigned long long)ws; asm volatile("" : "+s"(wsi_)); ws = (unsigned char*)(GAS unsigned char*)wsi_; } } while (0)

    for (int l = 0; l < DEPTH; ++l) {
        float* ss0 = SS + (size_t)(4 * l + 0) * M * 4; float* ss1 = SS + (size_t)(4 * l + 1) * M * 4; float* ss2 = SS + (size_t)(4 * l + 2) * M * 4; float* ss3 = SS + (size_t)(4 * l + 3) * M * 4; float* ss4 = SS + (size_t)(4 * l + 4) * M * 4;
        phase_prologue(TB, ws, X, l, lds, gw, NGW, lane, wave);
        GSYNC();
        { pg8::Gemm g{XB, (const bf16*)(ws + WS_W1IN), M, 2 * DFF, D, D, D, 0}; pg8::StaticOrder S; S.init(M, 2 * DFF, G, bx);
          pg8::EpiSwiglu E{HB, ss0, DFF};
          pg8::gemm_phase<pg8::EpiSwiglu, pg8::StaticOrder, true, true>(lds, g, S, E); }
        if (bx >= G / 2) { pg8::Gemm g{(const bf16*)(ws + WS_MEMN), (const bf16*)(ws + WS_WXKV), 512, 2 * D, D, D, D, 0}; pg8::StaticOrder S; S.init(512, 2 * D, G, bx - G / 2);
          pg8::EpiKV E{(bf16*)(ws + WS_KX), (bf16*)(ws + WS_VT)};
          pg8::gemm_phase<pg8::EpiKV, pg8::StaticOrder, true, true>(lds, g, S, E); }
        GSYNC();
        { pg8::Gemm g{HB, (const bf16*)(ws + WS_W1OUT), M, D, DFF, DFF, DFF, 0}; pg8::StaticOrder S; S.init(M, D, G, bx); pg8::Unit u_;
          pg8::EpiResid E{l == 0 ? tab_in(TB, 0) : (const float*)X, X, XB, ss1, 0.5f};
          for (int i_ = 0; S.next(i_, u_); ++i_) { const pg8::OneUnit O1{u_.pm, u_.pn}; pg8::gemm_phase<pg8::EpiResid, pg8::OneUnit, false, true>(lds, g, O1, E); } }
        GSYNC();
        { pg8::Gemm g{XB, (const bf16*)(ws + WS_WIN), M, 4096, D, D, D, 0}; pg8::StaticOrder S; S.init(M, 4096, G, bx);
          pg8::EpiWin E{(bf16*)(ws + WS_XA), (bf16*)(ws + WS_XL), (bf16*)(ws + WS_GG), (bf16*)(ws + WS_Q), (bf16*)(ws + WS_K), (bf16*)(ws + WS_V), ss1, FOX_C2};
          pg8::gemm_phase<pg8::EpiWin, pg8::StaticOrder, true, true>(lds, g, S, E); }
        phase_fl(XB, (const float*)(ws + WS_WFL), tab_in(TB, 7) + l * 8, ss1, (float*)(ws + WS_LOGF), gw, NGW, lane);
        GSYNC();
        if (vcu < 16) cumsum_bh((const float*)(ws + WS_LOGF), (float*)(ws + WS_CTIL), vcu, (LAS float*)lds);
        for (int it = vcu; it < 512; it += G)
            lru_item<false>(lds, it >> 8, (it >> 6) & 3, it & 63, (const bf16*)(ws + WS_XL), (bf16*)(ws + WS_GG), tab_in(TB, 12) + (size_t)l * 4 * D, tab_in(TB, 13) + l * D, (const bf16*)(ws + WS_WAT), (const bf16*)(ws + WS_WXT),
                            tab_in(TB, 15) + l * D, tab_in(TB, 17) + l * D, tab_in(TB, 18) + l * D, (float*)(ws + WS_SUMM));
        phase_pool((const bf16*)(ws + WS_XA), (bf16*)(ws + WS_YA), vcu * NTHR + tid, G * NTHR);
        phase_kmax((const bf16*)(ws + WS_K), (float*)(ws + WS_KPART), gw, NGW, lane);
        GSYNC();
        for (int it = vcu; it < 512; it += G)
            lru_item<true>(lds, it >> 8, (it >> 6) & 3, (it & 256) ? 63 - (it & 63) : (it & 63),
                            (const bf16*)(ws + WS_XL), (bf16*)(ws + WS_GG), tab_in(TB, 12) + (size_t)l * 4 * D, tab_in(TB, 13) + l * D, (const bf16*)(ws + WS_WAT), (const bf16*)(ws + WS_WXT),
                           tab_in(TB, 15) + l * D, tab_in(TB, 17) + l * D, tab_in(TB, 18) + l * D, (float*)(ws + WS_SUMM));
        {
            unsigned* qc = (unsigned*)(ws + WS_QCTR) + (size_t)l * 64; LAS int* slot = (LAS int*)(lds + TAB_OFF + 384); LAS float* cl = (LAS float*)(lds + 2 * FOX_BUF + 256); LAS int* ord = (LAS int*)(lds + 2 * FOX_BUF + 384);
            __syncthreads();
            if (tid < 16) cl[tid] = ((const float*)(ws + WS_CTIL))[(size_t)tid * SEQ + SEQ - 1];
            __syncthreads();
            if (tid < 16) { const float ci = cl[tid]; int rk = 0;
#pragma unroll
                for (int j = 0; j < 16; ++j) { const float cj = cl[j]; rk += (cj > ci || (cj == ci && j < tid)) ? 1 : 0; }
                ord[rk] = tid; }
            for (;;) { __syncthreads(); if (tid == 0) slot[0] = (int)__hip_atomic_fetch_add(qc, 1u, __ATOMIC_RELAXED, __HIP_MEMORY_SCOPE_AGENT); __syncthreads();
                const int qi = slot[0]; if (qi >= 512) break; const int bh = ord[qi >> 5], qb = 31 - (qi & 31);
                fox_unit(lds, bh >> 3, bh & 7, qb, (const bf16*)(ws + WS_Q), (const bf16*)(ws + WS_K), (const bf16*)(ws + WS_V), (bf16*)(ws + WS_YC), (const float*)(ws + WS_CTIL) + (size_t)bh * SEQ, (const float*)(ws + WS_KPART), NGW); }
        }
        GSYNC();
        { pg8::StaticOrder S; S.init(M, D, G, bx); pg8::Unit u;
          bf16* stash = (bf16*)(ws + WS_STASH) + (size_t)bx * 65536; bf16* mg = (bf16*)(ws + WS_MG);
          for (int i = 0; S.next(i, u); ++i) { const pg8::OneUnit O1{u.pm, u.pn};
#pragma unroll 1
              for (int br = 0; br < 3; ++br) {
                  { pg8::Gemm g{XB, (const bf16*)(ws + WS_WG) + (size_t)br * D * D, M, D, D, D, D, 0}; pg8::EpiGate E{stash, tab_in(TB, 8) + (size_t)l * 3 * D + br * D, ss1};
                    pg8::gemm_phase<pg8::EpiGate, pg8::OneUnit, true, true>(lds, g, O1, E); }
                  asm volatile("s_waitcnt vmcnt(0)" ::: "memory"); __syncthreads();
                  const bf16* Ab = br == 0 ? (const bf16*)(ws + WS_YA) : br == 1 ? (const bf16*)(ws + WS_GG) : (const bf16*)(ws + WS_YC);
                  const bf16* Ub = br == 0 ? (const bf16*)(ws + WS_UA) : br == 1 ? (const bf16*)(ws + WS_UB) : (const bf16*)(ws + WS_UC);
                  const int Kb = br == 1 ? 1024 : 512;
                  { pg8::Gemm g{Ab, Ub, M, D, Kb, Kb, Kb, 0}; pg8::EpiMerge E{stash, mg, br == 0 ? 1 : 0};
                    pg8::gemm_phase<pg8::EpiMerge, pg8::OneUnit, true, true>(lds, g, O1, E); }
                  asm volatile("s_waitcnt vmcnt(0)" ::: "memory"); __syncthreads();
              } } }
        GSYNC();
        { pg8::Gemm g{(const bf16*)(ws + WS_MG), (const bf16*)(ws + WS_WO), M, D, D, D, D, 0}; pg8::StaticOrder S; S.init(M, D, G, bx); pg8::Unit u_;
          pg8::EpiResid E{X, X, XB, ss2, 1.0f};
          for (int i_ = 0; S.next(i_, u_); ++i_) { const pg8::OneUnit O1{u_.pm, u_.pn}; pg8::gemm_phase<pg8::EpiResid, pg8::OneUnit, false, true>(lds, g, O1, E); } }
        GSYNC();
        { bf16* pb = (bf16*)(ws + WS_PBUF) + (size_t)bx * 65536; const pg8::OneUnit O1{0, 0};
          for (int uid = vcu; uid < 256; uid += G) { const int rt = uid >> 2, h = uid & 3, b = rt >> 5;
              int KX = 256; asm volatile("" : "+s"(KX));
              bf16* qo = (bf16*)(ws + WS_QX) + (size_t)rt * 256 * D + h * 256; bf16* qs = (bf16*)(ws + WS_Q) + (size_t)bx * 65536;
              { pg8::Gemm g{XB + (size_t)rt * 256 * D, (const bf16*)(ws + WS_WXQ) + (size_t)h * 256 * D, 256, 256, D, D, D, 0}; pg8::EpiRs E{qs, 256, ss2 + (size_t)rt * 256 * 4, C2X};
                pg8::gemm_phase<pg8::EpiRs, pg8::OneUnit, true, true>(lds, g, O1, E); }
              asm volatile("s_waitcnt vmcnt(0)" ::: "memory"); __syncthreads();
              { pg8::Gemm g{qs, (const bf16*)(ws + WS_KX) + (size_t)b * 256 * D + h * 256, 256, 256, KX, 256, D, 0}; pg8::EpiSoftmaxP E{pb};
                pg8::gemm_phase<pg8::EpiSoftmaxP, pg8::OneUnit, false, true>(lds, g, O1, E); }
              asm volatile("s_waitcnt vmcnt(0)" ::: "memory"); __syncthreads();
              { pg8::Gemm g{pb, (const bf16*)(ws + WS_VT) + (size_t)(b * 4 + h) * 65536, 256, 256, KX, 256, 256, 0}; pg8::EpiRs E{qo, D, nullptr, 1.0f};
                pg8::gemm_phase<pg8::EpiRs, pg8::OneUnit, true, true>(lds, g, O1, E); }
              asm volatile("s_waitcnt vmcnt(0)" ::: "memory"); if (uid + G < 256) __builtin_amdgcn_fence(__ATOMIC_ACQUIRE, "agent"); __syncthreads();
          } }
        GSYNC();
        { pg8::Gemm g{(const bf16*)(ws + WS_QX), (const bf16*)(ws + WS_WXO), M, D, D, D, D, 0}; pg8::StaticOrder S; S.init(M, D, G, bx); pg8::Unit u_;
          pg8::EpiResid E{X, X, XB, ss3, 1.0f};
          for (int i_ = 0; S.next(i_, u_); ++i_) { const pg8::OneUnit O1{u_.pm, u_.pn}; pg8::gemm_phase<pg8::EpiResid, pg8::OneUnit, false, true>(lds, g, O1, E); } }
        GSYNC();
        { pg8::Gemm g{XB, (const bf16*)(ws + WS_W2IN), M, 2 * DFF, D, D, D, 0}; pg8::StaticOrder S; S.init(M, 2 * DFF, G, bx);
          pg8::EpiSwiglu E{HB, ss3, DFF};
          pg8::gemm_phase<pg8::EpiSwiglu, pg8::StaticOrder, true, true>(lds, g, S, E); }
        GSYNC();
        { pg8::Gemm g{HB, (const bf16*)(ws + WS_W2OUT), M, D, DFF, DFF, DFF, 0}; pg8::StaticOrder S; S.init(M, D, G, bx); pg8::Unit u_;
          pg8::EpiResid E{X, X, XB, ss4, 0.5f};
          for (int i_ = 0; S.next(i_, u_); ++i_) { const pg8::OneUnit O1{u_.pm, u_.pn}; pg8::gemm_phase<pg8::EpiResid, pg8::OneUnit, false, true>(lds, g, O1, E); } }
        GSYNC();
    }
    phase_final(X, tab_in(TB, 30), gw, NGW, lane);
#undef GSYNC
}

extern "C" void kernel_launch(void* const* d_in, const int* in_sizes, int n_in, void* d_out, int out_size, void* d_ws, size_t ws_size, hipStream_t stream) {
    static int grid = 0;
    if (grid == 0) {
        if (n_in != 31 || out_size != M * D || ws_size < WS_END) { fprintf(stderr, "kernel_launch: unexpected problem (n_in %d, out %d, ws %zu)\n", n_in, out_size, ws_size); grid = -1; return; }
        int dev = 0, cus = 0, per_cu = 0;
        (void)hipGetDevice(&dev); (void)hipDeviceGetAttribute(&cus, hipDeviceAttributeMultiprocessorCount, dev);
        if (hipFuncSetAttribute((const void*)hybrid_fwd, hipFuncAttributeMaxDynamicSharedMemorySize, LDS_BYTES) != hipSuccess) { fprintf(stderr, "kernel_launch: hipFuncSetAttribute failed\n"); grid = -1; return; }
        if (hipOccupancyMaxActiveBlocksPerMultiprocessor(&per_cu, (const void*)hybrid_fwd, NTHR, LDS_BYTES) != hipSuccess || per_cu < 1) per_cu = 1;
        (void)hipGetLastError();
        grid = cus * (per_cu > 1 ? 1 : per_cu);
        if (grid > 256) grid = 256;
    }
    if (grid < 0) return;
    (void)hipMemsetAsync((char*)d_ws + WS_SS, 0, CTL_ZERO_BYTES, stream);
    Args a{};
    for (int i = 0; i < 31; ++i) a.in[i] = (const float*)d_in[i];
    a.out = (float*)d_out; a.ws = (unsigned char*)d_ws;
    void* kargs[] = {&a};
    hipError_t e = hipLaunchCooperativeKernel((const void*)hybrid_fwd, dim3(grid), dim3(NTHR), kargs, LDS_BYTES, stream);
    if (e != hipSuccess) fprintf(stderr, "cooperative launch failed: %s (grid %d)\n", hipGetErrorString(e), grid);
}
```

```cpp
#include <hip/hip_runtime.h>
#include <hip/hip_cooperative_groups.h>
#include <cstdio>
#include <cstdint>
namespace cg = cooperative_groups;
namespace pg8 {
#define PG8_LAS __attribute__((address_space(3)))
typedef unsigned short bf16_t;
typedef short bf16x8 __attribute__((ext_vector_type(8)));
typedef float f32x4 __attribute__((ext_vector_type(4)));
typedef unsigned u32x4 __attribute__((ext_vector_type(4)));
constexpr int BM = 256, BK = 64, HALF = 128, HTB = HALF * BK * 2  , STAGE_BYTES = 8 * HTB, NXCD = 8, WGM = 8;

__host__ __device__ __forceinline__ int lds_byte(int r, int c) { const int st = (r >> 4) * 2 + (c >> 5), rr = r & 15, cc = c & 31, ob = rr * 64 + cc * 2; return st * 1024 + (ob ^ (((ob >> 9) & 1) << 5)); }
__host__ __device__ __forceinline__ void stage_rc(int b, int& R, int& C) { const int st = b / 1024, sb = b % 1024, swz = sb ^ (((sb >> 9) & 1) << 5); R = (st >> 1) * 16 + swz / 64; C = (st & 1) * 32 + (swz % 64) / 2; }
__host__ __device__ __forceinline__ int perm32(int rho) { const int n = rho >> 4, i = rho & 15; return 8 * (i >> 2) + 4 * n + (i & 3); }

struct Unit { int pm, pn; };
struct Gemm { const bf16_t* A; const bf16_t* Bt; int M, N, K, lda, ldb, a_pn_off; };

struct StaticOrder {
    int nM, nN, nwg, G, c;
    __host__ __device__ __forceinline__ void init(int M, int N, int G_, int c_) { nM = M / BM; nN = N / BM; nwg = nM * nN; G = G_; c = c_; }
    __host__ __device__ __forceinline__ bool next(int i, Unit& u) const {
        const long L = (long)i * G + c; if (L >= nwg) return false;
        int wgid = (int)L; { const int q = nwg / NXCD, r = nwg % NXCD, xcd = wgid % NXCD, off = wgid / NXCD; wgid = (xcd < r ? xcd * (q + 1) : r * (q + 1) + (xcd - r) * q) + off; }
        const int nig = WGM * nN, gid = wgid / nig, fm = gid * WGM, gsz = (nM - fm) < WGM ? (nM - fm) : WGM;
        u.pm = fm + ((wgid % nig) % gsz); u.pn = (wgid % nig) / gsz; return true;
    }
    __device__ __forceinline__ void a_ready(const Unit&) const {}
    __device__ __forceinline__ void done(const Unit&) const {}
};

__device__ __forceinline__ unsigned cvt_pk_bf16(float lo, float hi) { unsigned r; asm volatile("v_cvt_pk_bf16_f32 %0, %1, %2" : "=v"(r) : "v"(lo), "v"(hi)); return r; }
__device__ __forceinline__ float bperm(float v, int srclane) { return __int_as_float(__builtin_amdgcn_ds_bpermute(srclane << 2, __float_as_int(v))); }
typedef float f32x2 __attribute__((ext_vector_type(2)));
typedef unsigned u32x2 __attribute__((ext_vector_type(2)));
__device__ __forceinline__ float fsig(float v) { return __builtin_amdgcn_rcpf(1.f + __expf(-v)); }
__device__ __forceinline__ float fsilu(float v) { return v * fsig(v); }
__device__ __forceinline__ float fgelu_tanh(float v) { return v * fsig(1.5957691216057308f * (v + 0.044715f * v * v * v)); }
__device__ __forceinline__ float bf_lo(unsigned w) { return __uint_as_float(w << 16); }
__device__ __forceinline__ float bf_hi(unsigned w) { return __uint_as_float(w & 0xffff0000u); }
__device__ __forceinline__ float rstd_of(const float* ss, int row) { const f32x4 a = *(const f32x4*)(ss + (size_t)row * 4); return rsqrtf(((a[0] + a[1]) + (a[2] + a[3])) * (1.0f / 1024.0f) + 1e-6f); }
__device__ __forceinline__ u32x4 pack8(const f32x4 v0, const f32x4 v1) { u32x4 w; w.x = cvt_pk_bf16(v0[0], v0[1]); w.y = cvt_pk_bf16(v0[2], v0[3]); w.z = cvt_pk_bf16(v1[0], v1[1]); w.w = cvt_pk_bf16(v1[2], v1[3]); return w; }

__device__ __forceinline__ void rstd8(const float* ss, int row0, float sc, float (&rs)[2][4]) {
    f32x4 pa[2][4];
#pragma unroll
    for (int ai = 0; ai < 2; ++ai)
#pragma unroll
        for (int m = 0; m < 4; ++m) pa[ai][m] = *(const f32x4*)(ss + (size_t)(row0 + ai * HALF + m * 16) * 4);
#pragma unroll
    for (int ai = 0; ai < 2; ++ai)
#pragma unroll
        for (int m = 0; m < 4; ++m) { const f32x4 a = pa[ai][m]; rs[ai][m] = rsqrtf(((a[0] + a[1]) + (a[2] + a[3])) * (1.0f / 1024.0f) + 1e-6f) * sc; }
    __builtin_amdgcn_sched_barrier(0);
}

__device__ __forceinline__ u32x4 ld16_sc1(const void* p) { u32x4 v; asm volatile("global_load_dwordx4 %0, %1, off sc1" : "=v"(v) : "v"(p) : "memory"); return v; }
#define PG8_LDWAIT(v) asm volatile("s_waitcnt vmcnt(0)" : "+v"(v))

struct OneUnit { int pm, pn;
    __device__ __forceinline__ bool next(int i, Unit& u) const { if (i) return false; u.pm = pm; u.pn = pn; return true; }
    __device__ __forceinline__ void a_ready(const Unit&) const {}
    __device__ __forceinline__ void done(const Unit&) const {} };

struct EpiSwiglu { static constexpr bool PERM = true, AFTER_DRAIN = false; bf16_t* H; const float* ss; int ldh;
    __device__ __forceinline__ void operator()(const f32x4 (&acc)[2][2][4][2], const Unit& u, int wr, int wc, int fr, int fq) const {
        const int row0 = u.pm * BM + wr * 64 + fr, col0 = u.pn * HALF + wc * 32 + 8 * fq; float rsv[2][4]; rstd8(ss, row0, 1.f, rsv);
#pragma unroll
        for (int ai = 0; ai < 2; ++ai)
#pragma unroll
            for (int m = 0; m < 4; ++m) { const int row = row0 + ai * HALF + m * 16; const float rs = rsv[ai][m];
                f32x4 o0, o1;
#pragma unroll
                for (int i = 0; i < 4; ++i) { o0[i] = fsilu(acc[ai][0][m][0][i] * rs) * (acc[ai][1][m][0][i] * rs); o1[i] = fsilu(acc[ai][0][m][1][i] * rs) * (acc[ai][1][m][1][i] * rs); }
                *(u32x4*)(H + (size_t)row * ldh + col0) = pack8(o0, o1); __builtin_amdgcn_sched_barrier(0); }
    }
};
struct EpiResid { static constexpr bool PERM = false, AFTER_DRAIN = true; const float* xin; float* x; bf16_t* xb; float* ss; float scale;
    __device__ __forceinline__ void fused(f32x4 (&acc)[2][2][4][2], const Unit& u, int wr, int wc, int fr, int fq, PG8_LAS unsigned char* lds, int wid, int lane) const {
        float scl = scale; asm volatile("" : "+v"(scl)); const int row0 = u.pm * BM + wr * 64 + fr, col0 = u.pn * BM + wc * 32 + 4 * fq;
        PG8_LAS float* P = (PG8_LAS float*)lds;
#pragma unroll
        for (int ai = 0; ai < 2; ++ai) { f32x4 xv[4][2][2];
#pragma unroll
            for (int m = 0; m < 4; ++m)
#pragma unroll
                for (int bj = 0; bj < 2; ++bj)
#pragma unroll
                    for (int n = 0; n < 2; ++n) xv[m][bj][n] = *(const f32x4*)(xin + (size_t)(row0 + ai * HALF + m * 16) * 1024 + col0 + bj * HALF + n * 16);
            __builtin_amdgcn_sched_barrier(0);
#pragma unroll
            for (int m = 0; m < 4; ++m) { const int row = row0 + ai * HALF + m * 16; float q = 0.f;
#pragma unroll
                for (int bj = 0; bj < 2; ++bj)
#pragma unroll
                    for (int n = 0; n < 2; ++n) { const size_t off = (size_t)row * 1024 + col0 + bj * HALF + n * 16;
                        f32x4 v = xv[m][bj][n] + acc[ai][bj][m][n] * scl; *(f32x4*)(x + off) = v;
                        u32x2 w; w.x = cvt_pk_bf16(v[0], v[1]); w.y = cvt_pk_bf16(v[2], v[3]); *(u32x2*)(xb + off) = w;
                        q += (v[0] * v[0] + v[1] * v[1]) + (v[2] * v[2] + v[3] * v[3]); }
                q += bperm(q, (fr + 16 * fq) ^ 16); q += bperm(q, (fr + 16 * fq) ^ 32);
                if (fq == 0) P[(ai * HALF + wr * 64 + m * 16 + fr) * 4 + wc] = q; }
            __builtin_amdgcn_sched_barrier(0); }
        asm volatile("s_waitcnt lgkmcnt(0)" ::: "memory"); __builtin_amdgcn_s_barrier(); asm volatile("" ::: "memory");
        const int tl = wid * 64 + lane;
        if (tl < 256) { const f32x4 a = *(const PG8_LAS f32x4*)(P + tl * 4); ss[(size_t)(u.pm * BM + tl) * 4 + u.pn] = (a[0] + a[1]) + (a[2] + a[3]); }
        asm volatile("s_waitcnt lgkmcnt(0)" ::: "memory"); __builtin_amdgcn_s_barrier(); asm volatile("" ::: "memory");
    }
};
struct EpiRs { static constexpr bool PERM = true, AFTER_DRAIN = false; bf16_t* O; int ldc; const float* ss; float sc;
    __device__ __forceinline__ void operator()(const f32x4 (&acc)[2][2][4][2], const Unit& u, int wr, int wc, int fr, int fq) const {
        const int row0 = u.pm * BM + wr * 64 + fr, col0 = u.pn * BM + wc * 32 + 8 * fq; float rsv[2][4];
        if (ss) rstd8(ss, row0, sc, rsv); else {
#pragma unroll
            for (int a = 0; a < 2; ++a)
#pragma unroll
                for (int b = 0; b < 4; ++b) rsv[a][b] = sc; }
#pragma unroll
        for (int ai = 0; ai < 2; ++ai)
#pragma unroll
            for (int m = 0; m < 4; ++m) { const int row = row0 + ai * HALF + m * 16; const float rs = rsv[ai][m];
#pragma unroll
                for (int bj = 0; bj < 2; ++bj) *(u32x4*)(O + (size_t)row * ldc + col0 + bj * HALF) = pack8(acc[ai][bj][m][0] * rs, acc[ai][bj][m][1] * rs); }
    }
};
struct EpiWin { static constexpr bool PERM = true, AFTER_DRAIN = false; bf16_t *xa, *xl, *gg, *q, *k, *v; const float* ss; float qscale;
    __device__ __forceinline__ void operator()(const f32x4 (&acc)[2][2][4][2], const Unit& u, int wr, int wc, int fr, int fq) const {
        const int pn = u.pn; bf16_t* dst; int ld, ct; float sc = 1.f; bool act = false;
        if (pn < 2) { dst = xa; ld = 512; ct = pn; } else if (pn < 6) { dst = xl; ld = 1024; ct = pn - 2; } else if (pn < 10) { dst = gg; ld = 1024; ct = pn - 6; act = true; }
        else if (pn < 12) { dst = q; ld = 512; ct = pn - 10; sc = qscale; } else if (pn < 14) { dst = k; ld = 512; ct = pn - 12; } else { dst = v; ld = 512; ct = pn - 14; }
        const int row0 = u.pm * BM + wr * 64 + fr, col0 = ct * BM + wc * 32 + 8 * fq; float rsv[2][4]; rstd8(ss, row0, sc, rsv);
#pragma unroll
        for (int ai = 0; ai < 2; ++ai)
#pragma unroll
            for (int m = 0; m < 4; ++m) { const int row = row0 + ai * HALF + m * 16; const float rs = rsv[ai][m];
#pragma unroll
                for (int bj = 0; bj < 2; ++bj) { f32x4 v0 = acc[ai][bj][m][0] * rs, v1 = acc[ai][bj][m][1] * rs;
                    if (act) {
#pragma unroll
                        for (int i = 0; i < 4; ++i) { v0[i] = fgelu_tanh(v0[i]); v1[i] = fgelu_tanh(v1[i]); } }
                    *(u32x4*)(dst + (size_t)row * ld + col0 + bj * HALF) = pack8(v0, v1); __builtin_amdgcn_sched_barrier(0); } }
    }
};
struct EpiGate { static constexpr bool PERM = true, AFTER_DRAIN = false; bf16_t* stash; const float* bg; const float* ss;
    __device__ __forceinline__ void operator()(const f32x4 (&acc)[2][2][4][2], const Unit& u, int wr, int wc, int fr, int fq) const {
        const int row0 = u.pm * BM + wr * 64 + fr, col0 = u.pn * BM + wc * 32 + 8 * fq; int tid_o = threadIdx.x; asm volatile("" : "+v"(tid_o)); const int tid = tid_o;
        f32x4 bv[2][2];
#pragma unroll
        for (int bj = 0; bj < 2; ++bj)
#pragma unroll
            for (int n = 0; n < 2; ++n) bv[bj][n] = *(const f32x4*)(bg + col0 + bj * HALF + 4 * n);
        float rsv[2][4]; rstd8(ss, row0, 1.f, rsv);
#pragma unroll
        for (int ai = 0; ai < 2; ++ai)
#pragma unroll
            for (int m = 0; m < 4; ++m) { const float rs = rsv[ai][m];
#pragma unroll
                for (int bj = 0; bj < 2; ++bj) { f32x4 v0 = acc[ai][bj][m][0] * rs + bv[bj][0], v1 = acc[ai][bj][m][1] * rs + bv[bj][1];
#pragma unroll
                    for (int i = 0; i < 4; ++i) { v0[i] = fsig(v0[i]); v1[i] = fsig(v1[i]); }
                    *(u32x4*)(stash + ((size_t)((ai * 4 + m) * 2 + bj) * 512 + tid) * 8) = pack8(v0, v1); __builtin_amdgcn_sched_barrier(0); } }
    }
};
struct EpiMerge { static constexpr bool PERM = true, AFTER_DRAIN = false; const bf16_t* stash; bf16_t* mg; int first;
    __device__ __forceinline__ void operator()(const f32x4 (&acc)[2][2][4][2], const Unit& u, int wr, int wc, int fr, int fq) const {
        const int row0 = u.pm * BM + wr * 64 + fr, col0 = u.pn * BM + wc * 32 + 8 * fq; int tid_o = threadIdx.x; asm volatile("" : "+v"(tid_o)); const int tid = tid_o;
#pragma unroll
        for (int ai = 0; ai < 2; ++ai) { u32x4 gw[4][2], ow[4][2];
#pragma unroll
            for (int m = 0; m < 4; ++m)
#pragma unroll
                for (int bj = 0; bj < 2; ++bj) { gw[m][bj] = ld16_sc1(stash + ((size_t)((ai * 4 + m) * 2 + bj) * 512 + tid) * 8);
                    ow[m][bj] = first ? (u32x4){0u, 0u, 0u, 0u} : ld16_sc1(mg + (size_t)(row0 + ai * HALF + m * 16) * 1024 + col0 + bj * HALF); }
#pragma unroll
            for (int m = 0; m < 4; ++m)
#pragma unroll
                for (int bj = 0; bj < 2; ++bj) { PG8_LDWAIT(gw[m][bj]); if (!first) PG8_LDWAIT(ow[m][bj]); }
            __builtin_amdgcn_sched_barrier(0);
#pragma unroll
            for (int m = 0; m < 4; ++m)
#pragma unroll
                for (int bj = 0; bj < 2; ++bj) { const u32x4 g = gw[m][bj], o = ow[m][bj]; f32x4 v0 = acc[ai][bj][m][0], v1 = acc[ai][bj][m][1];
                    v0[0] = v0[0] * bf_lo(g.x) + bf_lo(o.x); v0[1] = v0[1] * bf_hi(g.x) + bf_hi(o.x); v0[2] = v0[2] * bf_lo(g.y) + bf_lo(o.y); v0[3] = v0[3] * bf_hi(g.y) + bf_hi(o.y);
                    v1[0] = v1[0] * bf_lo(g.z) + bf_lo(o.z); v1[1] = v1[1] * bf_hi(g.z) + bf_hi(o.z); v1[2] = v1[2] * bf_lo(g.w) + bf_lo(o.w); v1[3] = v1[3] * bf_hi(g.w) + bf_hi(o.w);
                    *(u32x4*)(mg + (size_t)(row0 + ai * HALF + m * 16) * 1024 + col0 + bj * HALF) = pack8(v0, v1); }
            __builtin_amdgcn_sched_barrier(0); }
    }
};
struct EpiKV { static constexpr bool PERM = true, AFTER_DRAIN = false; bf16_t* kx; bf16_t* vt;
    __device__ __forceinline__ void operator()(const f32x4 (&acc)[2][2][4][2], const Unit& u, int wr, int wc, int fr, int fq) const {
        if (u.pn < 4) { const int row0 = u.pm * BM + wr * 64 + fr, col0 = u.pn * BM + wc * 32 + 8 * fq;
#pragma unroll
            for (int ai = 0; ai < 2; ++ai)
#pragma unroll
                for (int m = 0; m < 4; ++m)
#pragma unroll
                    for (int bj = 0; bj < 2; ++bj) *(u32x4*)(kx + (size_t)(row0 + ai * HALF + m * 16) * 1024 + col0 + bj * HALF) = pack8(acc[ai][bj][m][0], acc[ai][bj][m][1]);
        } else { const int h = u.pn - 4, b = u.pm; bf16_t* base = vt + (size_t)(b * 4 + h) * 65536;
#pragma unroll
            for (int ai = 0; ai < 2; ++ai)
#pragma unroll
                for (int m = 0; m < 4; ++m) { const int mr = ai * HALF + wr * 64 + m * 16 + fr;
#pragma unroll
                    for (int bj = 0; bj < 2; ++bj) { bf16_t* p = base + (size_t)(bj * HALF + wc * 32 + 8 * fq) * 256 + mr; asm volatile("" : "+v"(p));
#pragma unroll
                        for (int n = 0; n < 2; ++n)
#pragma unroll
                            for (int i = 0; i < 4; ++i) p[(4 * n + i) * 256] = (bf16_t)(cvt_pk_bf16(acc[ai][bj][m][n][i], 0.f) & 0xffffu);
                        __builtin_amdgcn_sched_barrier(0); } }
        }
    }
};
struct EpiSoftmaxP { static constexpr bool PERM = true, AFTER_DRAIN = true; bf16_t* P;
    __device__ __forceinline__ void fused(f32x4 (&acc)[2][2][4][2], const Unit& u, int wr, int wc, int fr, int fq, PG8_LAS unsigned char* lds, int wid, int lane) const {
        PG8_LAS f32x2* X = (PG8_LAS f32x2*)lds;
        float mloc[2][4];
#pragma unroll
        for (int ai = 0; ai < 2; ++ai)
#pragma unroll
            for (int m = 0; m < 4; ++m) { float mx = -__builtin_inff();
#pragma unroll
                for (int bj = 0; bj < 2; ++bj)
#pragma unroll
                    for (int n = 0; n < 2; ++n) { const f32x4 v = acc[ai][bj][m][n]; mx = fmaxf(mx, fmaxf(fmaxf(v[0], v[1]), fmaxf(v[2], v[3]))); }
                mx = fmaxf(mx, bperm(mx, (fr + 16 * fq) ^ 16)); mx = fmaxf(mx, bperm(mx, (fr + 16 * fq) ^ 32)); float s = 0.f;
#pragma unroll
                for (int bj = 0; bj < 2; ++bj)
#pragma unroll
                    for (int n = 0; n < 2; ++n) { f32x4 v = acc[ai][bj][m][n];
#pragma unroll
                        for (int i = 0; i < 4; ++i) { v[i] = __builtin_amdgcn_exp2f(v[i] - mx); s += v[i]; }
                        acc[ai][bj][m][n] = v; }
                s += bperm(s, (fr + 16 * fq) ^ 16); s += bperm(s, (fr + 16 * fq) ^ 32); mloc[ai][m] = mx;
                if (fq == 0) X[(ai * HALF + wr * 64 + m * 16 + fr) * 4 + wc] = (f32x2){mx, s}; __builtin_amdgcn_sched_barrier(0); }
        asm volatile("s_waitcnt lgkmcnt(0)" ::: "memory"); __builtin_amdgcn_s_barrier(); asm volatile("" ::: "memory");
#pragma unroll
        for (int ai = 0; ai < 2; ++ai)
#pragma unroll
            for (int m = 0; m < 4; ++m) { const int rl = ai * HALF + wr * 64 + m * 16 + fr;
                const f32x2 a = X[rl * 4 + 0], b = X[rl * 4 + 1], c = X[rl * 4 + 2], d = X[rl * 4 + 3];
                const float M = fmaxf(fmaxf(a.x, b.x), fmaxf(c.x, d.x));
                const float L = a.y * __builtin_amdgcn_exp2f(a.x - M) + b.y * __builtin_amdgcn_exp2f(b.x - M) + c.y * __builtin_amdgcn_exp2f(c.x - M) + d.y * __builtin_amdgcn_exp2f(d.x - M);
                const float f = __builtin_amdgcn_exp2f(mloc[ai][m] - M) / L;
#pragma unroll
                for (int bj = 0; bj < 2; ++bj) *(u32x4*)(P + (size_t)rl * 256 + bj * HALF + wc * 32 + 8 * fq) = pack8(acc[ai][bj][m][0] * f, acc[ai][bj][m][1] * f); __builtin_amdgcn_sched_barrier(0); }
        asm volatile("s_waitcnt vmcnt(0) lgkmcnt(0)" ::: "memory"); __builtin_amdgcn_s_barrier(); asm volatile("" ::: "memory");
    }
};

template <class Epi, class Sched, bool ALIGN_EPI = false, bool SP2 = false>
__device__ __forceinline__ void gemm_phase(PG8_LAS unsigned char* lds, const Gemm g, const Sched& S, const Epi& E) {
    int tid_o = threadIdx.x; asm volatile("" : "+v"(tid_o));
    const int tid = tid_o, wid = __builtin_amdgcn_readfirstlane(tid >> 6), lane = tid & 63, wr = wid >> 2, wc = wid & 3, fr = lane & 15, fq = lane >> 4;
    const int K = g.K, nt = K / BK;
    unsigned voffA[2], voffB[2];
#pragma unroll
    for (int i = 0; i < 2; ++i) { int R, C; stage_rc(tid * 16 + i * 8192, R, C); const int Rb = Epi::PERM ? ((R & ~31) + perm32(R & 31)) : R;
        voffA[i] = (unsigned)(R * g.lda + C) * 2u; voffB[i] = (unsigned)(Rb * g.ldb + C) * 2u; }
    const size_t kstep = (size_t)(BK * 2);
    const size_t hstepA = (size_t)HALF * g.lda * 2, hstepB = (size_t)HALF * g.ldb * 2;
    const size_t tstepA = 2 * hstepA, tstepB = 2 * hstepB;
    const unsigned ldsw = (unsigned)wid * 1024u;
    const int aoff = lds_byte(wr * 64 + fr, fq * 8), boff = lds_byte(wc * 32 + fr, fq * 8);
#define PG8_SA(b, h) (((b) * 2 + (h)) * HTB)
#define PG8_SB(b, h) ((4 + (b) * 2 + (h)) * HTB)
#define PG8_STAGE(bufoff, gbase, voff) do { _Pragma("unroll") for (int _i = 0; _i < 2; ++_i) \
        __builtin_amdgcn_global_load_lds((const unsigned*)((const char*)(gbase) + (voff)[_i]), (PG8_LAS unsigned*)(lds + (bufoff) + ldsw + _i * 8192), 16, 0, 0); } while (0)
#define PG8_LDA(dst, b, h) do { _Pragma("unroll") for (int m = 0; m < 4; ++m) _Pragma("unroll") for (int k = 0; k < 2; ++k) dst[m][k] = *(const PG8_LAS bf16x8*)(lds + PG8_SA(b, h) + aoff + m * 2048 + k * 1024); } while (0)
#define PG8_LDB(dst, b, h) do { _Pragma("unroll") for (int n = 0; n < 2; ++n) _Pragma("unroll") for (int k = 0; k < 2; ++k) dst[n][k] = *(const PG8_LAS bf16x8*)(lds + PG8_SB(b, h) + boff + n * 2048 + k * 1024); } while (0)
#define PG8_MMA(ai, bj, At, Bt) do { __builtin_amdgcn_s_setprio(1); _Pragma("unroll") for (int m = 0; m < 4; ++m) _Pragma("unroll") for (int n = 0; n < 2; ++n) _Pragma("unroll") for (int k = 0; k < 2; ++k) \
        acc[ai][bj][m][n] = __builtin_amdgcn_mfma_f32_16x16x32_bf16(Bt[n][k], At[m][k], acc[ai][bj][m][n], 0, 0, 0); __builtin_amdgcn_s_setprio(0); } while (0)
#define PG8_WAIT_V(n) asm volatile("s_waitcnt vmcnt(" #n ")" ::: "memory")
#define PG8_WAIT_L(n) asm volatile("s_waitcnt lgkmcnt(" #n ")" ::: "memory")
#define PG8_BAR __builtin_amdgcn_s_barrier()
#define PG8_SCHED __builtin_amdgcn_sched_barrier(0)
    Unit cur, nxt; int ui = 0;
    if (!S.next(0, cur)) return;
    f32x4 acc[2][2][4][2];
#pragma unroll
    for (int a = 0; a < 2; ++a)
#pragma unroll
        for (int b = 0; b < 2; ++b)
#pragma unroll
            for (int m = 0; m < 4; ++m)
#pragma unroll
                for (int n = 0; n < 2; ++n) acc[a][b][m][n] = (f32x4){0.f, 0.f, 0.f, 0.f};
    bf16x8 At[4][2], B0[2][2], B1[2][2];
    const char* cA = (const char*)g.A + (size_t)cur.pm * tstepA + (size_t)cur.pn * g.a_pn_off * 2; const char* cB = (const char*)g.Bt + (size_t)cur.pn * tstepB;
    S.a_ready(cur);
    if constexpr (SP2) {
        PG8_STAGE(PG8_SB(0, 0), cB, voffB); PG8_STAGE(PG8_SB(0, 1), cB + hstepB, voffB); PG8_STAGE(PG8_SA(0, 0), cA, voffA); PG8_STAGE(PG8_SA(0, 1), cA + hstepA, voffA);
        if (wr == 1) PG8_BAR;
        PG8_WAIT_V(2); PG8_BAR;
        PG8_STAGE(PG8_SB(1, 0), cB + kstep, voffB); PG8_STAGE(PG8_SA(1, 0), cA + kstep, voffA); PG8_STAGE(PG8_SB(1, 1), cB + hstepB + kstep, voffB);
        PG8_WAIT_V(6); PG8_BAR;
    } else {
        PG8_STAGE(PG8_SB(0, 0), cB, voffB); PG8_STAGE(PG8_SA(0, 0), cA, voffA); PG8_STAGE(PG8_SB(0, 1), cB + hstepB, voffB); PG8_STAGE(PG8_SA(0, 1), cA + hstepA, voffA);
        if (wr == 1) PG8_BAR;
        PG8_WAIT_V(4); PG8_BAR;
        PG8_STAGE(PG8_SB(1, 0), cB + kstep, voffB); PG8_STAGE(PG8_SA(1, 0), cA + kstep, voffA); PG8_STAGE(PG8_SB(1, 1), cB + hstepB + kstep, voffB);
        PG8_WAIT_V(6); PG8_BAR;
    }
    for (;;) {
        const bool has_next = S.next(ui + 1, nxt);
        const char* nA = has_next ? (const char*)g.A + (size_t)nxt.pm * tstepA + (size_t)nxt.pn * g.a_pn_off * 2 : cA; const char* nB = has_next ? (const char*)g.Bt + (size_t)nxt.pn * tstepB : cB;
        for (int t = 0; t < nt; t += 2) {
            const bool last = (t == nt - 2);
            const char* a1 = cA + (size_t)(t + 1) * kstep;
            const char* a2 = last ? nA : cA + (size_t)(t + 2) * kstep; const char* b2 = last ? nB : cB + (size_t)(t + 2) * kstep;
            const char* a3 = a2 + kstep; const char* b3 = b2 + kstep;
            if (last && has_next) S.a_ready(nxt);
            if constexpr (SP2) {
            PG8_LDB(B0, 0, 0); PG8_LDB(B1, 0, 1); PG8_SCHED; PG8_LDA(At, 0, 0); PG8_STAGE(PG8_SA(1, 1), a1 + hstepA, voffA);
            PG8_WAIT_V(8); PG8_WAIT_L(0); PG8_BAR; PG8_MMA(0, 0, At, B0); PG8_MMA(0, 1, At, B1); PG8_BAR; PG8_SCHED;
            PG8_LDA(At, 0, 1); PG8_STAGE(PG8_SB(0, 0), b2, voffB); PG8_STAGE(PG8_SB(0, 1), b2 + hstepB, voffB); PG8_STAGE(PG8_SA(0, 0), a2, voffA);
            PG8_WAIT_V(8); PG8_WAIT_L(0); PG8_BAR; PG8_MMA(1, 0, At, B0); PG8_MMA(1, 1, At, B1); PG8_BAR; PG8_SCHED;
            PG8_LDB(B0, 1, 0); PG8_LDB(B1, 1, 1); PG8_SCHED; PG8_LDA(At, 1, 0); PG8_STAGE(PG8_SA(0, 1), a2 + hstepA, voffA);
            PG8_WAIT_V(8); PG8_WAIT_L(0); PG8_BAR; PG8_MMA(0, 0, At, B0); PG8_MMA(0, 1, At, B1); PG8_BAR; PG8_SCHED;
            PG8_LDA(At, 1, 1); PG8_STAGE(PG8_SB(1, 0), b3, voffB); PG8_STAGE(PG8_SB(1, 1), b3 + hstepB, voffB); PG8_STAGE(PG8_SA(1, 0), a3, voffA);
            PG8_WAIT_V(8); PG8_WAIT_L(0); PG8_BAR; PG8_MMA(1, 0, At, B0); PG8_MMA(1, 1, At, B1); PG8_BAR; PG8_SCHED;
            } else {
            PG8_LDB(B0, 0, 0); PG8_SCHED; PG8_LDA(At, 0, 0); PG8_STAGE(PG8_SA(1, 1), a1 + hstepA, voffA);
            PG8_WAIT_L(8); PG8_BAR; PG8_WAIT_L(0); PG8_MMA(0, 0, At, B0); PG8_BAR; PG8_SCHED;
            PG8_LDB(B1, 0, 1); PG8_STAGE(PG8_SB(0, 0), b2, voffB);
            PG8_BAR; PG8_WAIT_L(0); PG8_MMA(0, 1, At, B1); PG8_BAR;
            PG8_LDA(At, 0, 1); PG8_STAGE(PG8_SA(0, 0), a2, voffA);
            PG8_BAR; PG8_WAIT_L(0); PG8_MMA(1, 0, At, B0); PG8_BAR; PG8_SCHED;
            PG8_STAGE(PG8_SB(0, 1), b2 + hstepB, voffB);
            PG8_WAIT_V(6); PG8_BAR; PG8_MMA(1, 1, At, B1); PG8_BAR;
            PG8_LDB(B0, 1, 0); PG8_SCHED; PG8_LDA(At, 1, 0); PG8_STAGE(PG8_SA(0, 1), a2 + hstepA, voffA);
            PG8_WAIT_L(8); PG8_BAR; PG8_WAIT_L(0); PG8_MMA(0, 0, At, B0); PG8_BAR; PG8_SCHED;
            PG8_LDB(B1, 1, 1); PG8_STAGE(PG8_SB(1, 0), b3, voffB);
            PG8_BAR; PG8_WAIT_L(0); PG8_MMA(0, 1, At, B1); PG8_BAR;
            PG8_LDA(At, 1, 1); PG8_STAGE(PG8_SA(1, 0), a3, voffA);
            PG8_BAR; PG8_WAIT_L(0); PG8_MMA(1, 0, At, B0); PG8_BAR; PG8_SCHED;
            PG8_STAGE(PG8_SB(1, 1), b3 + hstepB, voffB);
            PG8_WAIT_V(6); PG8_BAR; PG8_MMA(1, 1, At, B1); PG8_BAR;
            }
        }
        if constexpr (ALIGN_EPI) { if (wr == 0) PG8_BAR; }
        if constexpr (!Epi::AFTER_DRAIN) { E(acc, cur, wr, wc, fr, fq); S.done(cur); }
        if (!has_next) break;
#pragma unroll
        for (int a = 0; a < 2; ++a)
#pragma unroll
            for (int b = 0; b < 2; ++b)
#pragma unroll
                for (int m = 0; m < 4; ++m)
#pragma unroll
                    for (int n = 0; n < 2; ++n) acc[a][b][m][n] = (f32x4){0.f, 0.f, 0.f, 0.f};
        cur = nxt; cA = nA; cB = nB; ++ui;
        if constexpr (ALIGN_EPI) { if (wr == 1) PG8_BAR; }
    }
    PG8_WAIT_V(0);
    if constexpr (!ALIGN_EPI) { if (wr == 0) PG8_BAR; }
    PG8_BAR;
    if constexpr (Epi::AFTER_DRAIN) { E.fused(acc, cur, wr, wc, fr, fq, lds, wid, lane); S.done(cur); }
#undef PG8_SA
#undef PG8_SB
#undef PG8_STAGE
#undef PG8_LDA
#undef PG8_LDB
#undef PG8_MMA
#undef PG8_WAIT_V
#undef PG8_WAIT_L
#undef PG8_BAR
#undef PG8_SCHED
}
}
#include <hip/hip_bf16.h>
#include <cmath>
#define GAS __attribute__((address_space(1)))
#define LAS __attribute__((address_space(3)))
typedef unsigned short bf16;
typedef unsigned v4u __attribute__((ext_vector_type(4)));
typedef float f32x4 __attribute__((ext_vector_type(4)));
typedef short bf16x8 __attribute__((ext_vector_type(8)));
typedef float f32x16 __attribute__((ext_vector_type(16)));

constexpr int NWAVES = 8, NTHR = 512;
constexpr int BATCH = 2, SEQ = 8192, D = 1024, M = BATCH * SEQ, DFF = 2816, DEPTH = 2;
constexpr int INW = 7176;
constexpr size_t MiB = 1u << 20;
constexpr size_t WS_SS = 0, CTL_ZERO_BYTES = 1 * MiB;
constexpr size_t WS_WFL = 1 * MiB;
constexpr size_t WS_WAT = 1 * MiB + 256 * 1024, WS_WXT = 1 * MiB + 512 * 1024;
constexpr size_t WS_SUMM = 2 * MiB;
constexpr size_t WS_LOGF = 3 * MiB, WS_CTIL = 3 * MiB + 512 * 1024;
constexpr size_t WS_KPART = 7 * MiB;
constexpr size_t WS_MEMN = 4 * MiB, WS_KX = 5 * MiB, WS_VT = 6 * MiB;
constexpr size_t WS_W1IN = 8 * MiB, WS_W1OUT = 19 * MiB, WS_WIN = 25 * MiB, WS_WG = 33 * MiB, WS_UA = 39 * MiB, WS_UB = 40 * MiB, WS_UC = 42 * MiB,
                 WS_WO = 43 * MiB, WS_WXQ = 45 * MiB, WS_WXKV = 47 * MiB, WS_WXO = 51 * MiB, WS_W2IN = 53 * MiB, WS_W2OUT = 64 * MiB;
constexpr size_t WS_XB = 70 * MiB;
constexpr size_t WS_Q = 102 * MiB, WS_GG = 118 * MiB, WS_XA = 150 * MiB, WS_XL = 166 * MiB, WS_K = 198 * MiB, WS_V = 214 * MiB;
constexpr size_t WS_H = 102 * MiB;
constexpr size_t WS_YC = 150 * MiB;
constexpr size_t WS_STASH = 166 * MiB, WS_MG = 198 * MiB, WS_QX = 150 * MiB, WS_PBUF = 198 * MiB;
constexpr size_t WS_YA = 230 * MiB, WS_SSP = 246 * MiB, WS_END = 255 * MiB;
constexpr int LDS_BYTES = 147456;

__device__ __forceinline__ unsigned f2bf(float f) { unsigned u = __builtin_bit_cast(unsigned, f); return (u + 0x7fffu + ((u >> 16) & 1u)) >> 16; }
__device__ __forceinline__ unsigned pk2(float lo, float hi) { return f2bf(lo) | (f2bf(hi) << 16); }
__device__ __forceinline__ float bf2f(unsigned short v) { return __uint_as_float((unsigned)v << 16); }
__device__ __forceinline__ float bperm(float v, int srclane) { return __int_as_float(__builtin_amdgcn_ds_bpermute(srclane << 2, __float_as_int(v))); }
__device__ __forceinline__ float wave_sum(float v, int lane) {
#pragma unroll
    for (int o = 1; o < 64; o <<= 1) v += bperm(v, lane ^ o);
    return v;
}
__device__ __forceinline__ float flog1p(float e) { return e < 0.01f ? e * (1.f - e * (0.5f - e * 0.33333334f)) : __logf(1.f + e); }
#define LDS_WAIT() asm volatile("s_waitcnt lgkmcnt(0)" ::: "memory")

__device__ __forceinline__ void tr_item(const float* W, int ldn, int col0, int k0, const float* g, bf16* WT, int ldk, int drow0, LAS float* scr, int lane) {
    const int n4 = (lane & 15) * 4, kr = lane >> 4;
#pragma unroll
    for (int i = 0; i < 16; ++i) { const int kk = 4 * i + kr; f32x4 v = *(const f32x4*)(W + (size_t)(k0 + kk) * ldn + col0 + n4); if (g) v = v * g[k0 + kk];
        LAS float* d = scr + kk * 65 + n4; d[0] = v.x; d[1] = v.y; d[2] = v.z; d[3] = v.w; }
    LDS_WAIT(); asm volatile("" ::: "memory");
    const int c = lane & 7;
#pragma unroll
    for (int j = 0; j < 8; ++j) { const int n = (lane >> 3) + 8 * j; const LAS float* s = scr + (8 * c) * 65 + n;
        v4u o; o.x = pk2(s[0 * 65], s[1 * 65]); o.y = pk2(s[2 * 65], s[3 * 65]); o.z = pk2(s[4 * 65], s[5 * 65]); o.w = pk2(s[6 * 65], s[7 * 65]);
        *(v4u*)(WT + (size_t)(drow0 + n) * ldk + k0 + 8 * c) = o; }
    LDS_WAIT(); asm volatile("" ::: "memory");
}

#define RLX_AGENT __ATOMIC_RELAXED, __HIP_MEMORY_SCOPE_AGENT
#define XB_TMO      128
#define XB_XCNT(j)  (256  + 64 * (j))
#define XB_XSUB(j)  (1280 + 64 * (j))
#define XB_XGEN(j)  (2304 + 64 * (j))
#define XB_TOP      3328
#define XB_TOPGEN   3392
#define XCD_BAR_WORDS 3456
#define XB_SPIN_CAP (1u << 18)

__device__ __forceinline__ unsigned xb_ld(unsigned* p)              { return __hip_atomic_load(p, __ATOMIC_RELAXED, __HIP_MEMORY_SCOPE_AGENT); }
__device__ __forceinline__ unsigned xb_add(unsigned* p, unsigned v) { return __hip_atomic_fetch_add(p, v, __ATOMIC_RELAXED, __HIP_MEMORY_SCOPE_AGENT); }
__device__ __forceinline__ unsigned xb_xcc_id() { return (unsigned)__builtin_amdgcn_s_getreg((3 << 11) | 20) & 0xFu; }
#define XB_SPIN(cond, bar) do { unsigned _sp = 0; while (cond) { __builtin_amdgcn_s_sleep(1); \
    if ((++_sp & 255u) == 0u) { if (xb_ld(&(bar)[XB_TMO])) break; if (_sp > XB_SPIN_CAP) { atomicAdd(&(bar)[XB_TMO], 1u); break; } } } } while (0)

struct XcdBarrier {
    unsigned* bar; unsigned x;
    volatile LAS unsigned* st;
};

__device__ __forceinline__ XcdBarrier xcd_barrier_post(unsigned* bar, volatile LAS unsigned* st) {
    XcdBarrier b; b.bar = bar; b.x = xb_xcc_id(); b.st = st;
    if (threadIdx.x == 0) (void)xb_add(&bar[XB_XCNT(b.x)], 1u);
    return b;
}
__device__ __forceinline__ void xcd_barrier_complete(unsigned* bar, unsigned x, unsigned& nloc, unsigned& nx) {
    const unsigned G = gridDim.x * gridDim.y * gridDim.z;
    unsigned sum, cnt, mine, sp = 0u;
    for (;;) {
        sum = 0u; cnt = 0u; mine = 0u;
#pragma unroll
        for (unsigned j = 0; j < 16; ++j) { const unsigned c = xb_ld(&bar[XB_XCNT(j)]); sum += c; cnt += (c > 0u) ? 1u : 0u; mine = (j == x) ? c : mine; }
        if (sum == G) break;
        __builtin_amdgcn_s_sleep(1);
        if ((++sp & 255u) == 0u) { if (xb_ld(&bar[XB_TMO])) break; if (sp > XB_SPIN_CAP) { atomicAdd(&bar[XB_TMO], 1u); break; } }
    }
    nloc = mine > 0u ? mine : 1u; nx = cnt > 0u ? cnt : 1u;
}

__device__ __forceinline__ void xcd_barrier(const XcdBarrier& b) {
    asm volatile("s_waitcnt vmcnt(0)" ::: "memory");
    __syncthreads();
    if (threadIdx.x == 0) {
        unsigned* bar = b.bar;
        __builtin_amdgcn_s_waitcnt(0);
        unsigned nloc = b.st[0], nx = b.st[1];
        if (nloc == 0u) { xcd_barrier_complete(bar, b.x, nloc, nx); b.st[0] = nloc; b.st[1] = nx; }
        const unsigned old = xb_add(&bar[XB_XSUB(b.x)], 1u);
        const unsigned gen = old / nloc;
        if (old + 1u == (gen + 1u) * nloc) {
            __builtin_amdgcn_fence(__ATOMIC_RELEASE, "agent");
            asm volatile("s_waitcnt vmcnt(0)" ::: "memory");
            const unsigned og = xb_add(&bar[XB_TOP], 1u);
            const unsigned tg = og / nx;
            if (og + 1u == (tg + 1u) * nx) xb_add(&bar[XB_TOPGEN], 1u);
            else XB_SPIN(xb_ld(&bar[XB_TOPGEN]) == tg, bar);
            __builtin_amdgcn_fence(__ATOMIC_ACQUIRE, "agent");
            xb_add(&bar[XB_XGEN(b.x)], 1u);
            asm volatile("s_waitcnt vmcnt(0)" ::: "memory");
        } else {
            XB_SPIN(xb_ld(&bar[XB_XGEN(b.x)]) == gen, bar);
            __builtin_amdgcn_fence(__ATOMIC_ACQUIRE, "agent");
            asm volatile("s_waitcnt vmcnt(0)" ::: "memory");
        }
    }
    __syncthreads();
}

struct Args { const float* in[31]; float* out; unsigned char* ws; int pad[2]; };
typedef LAS unsigned long long* PtrTab;
__device__ __forceinline__ const float* tab_in(PtrTab tb, int k) { const unsigned long long v = tb[k]; const unsigned lo = __builtin_amdgcn_readfirstlane((unsigned)v), hi = __builtin_amdgcn_readfirstlane((unsigned)(v >> 32));
    return (const float*)(const GAS float*)(((unsigned long long)hi << 32) | lo); }
constexpr int TAB_OFF = 147456 - 512;
constexpr size_t WS_BAR = 768 * 1024; constexpr size_t WS_QCTR = 832 * 1024;

__device__ __forceinline__ void phase_prologue(PtrTab TB, unsigned char* ws, float* xout, int l, LAS unsigned char* lds, int gw, int NGW, int lane, int wave) {
    LAS float* scr = (LAS float*)(lds + wave * 16640);
#define g1 (tab_in(TB, 2) + l * D)
#define w1i (tab_in(TB, 3) + (size_t)l * D * 2 * DFF)
#define w1o (tab_in(TB, 4) + (size_t)l * DFF * D)
#define gm (tab_in(TB, 5) + l * D)
#define win (tab_in(TB, 6) + (size_t)l * D * INW)
#define wpool (tab_in(TB, 9) + (size_t)l * 4 * 128 * 128)
#define psc (tab_in(TB, 10) + l * 512)
#define wua (tab_in(TB, 11) + (size_t)l * 512 * D)
#define wra (tab_in(TB, 14) + (size_t)l * 8 * 128 * 128)
#define wrx (tab_in(TB, 16) + (size_t)l * 8 * 128 * 128)
#define wub (tab_in(TB, 19) + (size_t)l * D * D)
#define wuc (tab_in(TB, 20) + (size_t)l * 512 * D)
#define wo (tab_in(TB, 21) + (size_t)l * D * D)
#define gc (tab_in(TB, 22) + l * D)
#define gmem (tab_in(TB, 23) + l * D)
#define wxq (tab_in(TB, 24) + (size_t)l * D * D)
#define wxkv (tab_in(TB, 25) + (size_t)l * D * 2 * D)
#define wxo (tab_in(TB, 26) + (size_t)l * D * D)
#define g2 (tab_in(TB, 27) + l * D)
#define w2i (tab_in(TB, 28) + (size_t)l * D * 2 * DFF)
#define w2o (tab_in(TB, 29) + (size_t)l * DFF * D)
    constexpr int I_FI = 16 * 88, I_FO = 44 * 16, I_WIN = 16 * 64, I_WG = 16 * 48, I_UB = 16 * 16, I_UC = 8 * 16, I_RG = 32, I_SQ = 16 * 16, I_KV = 16 * 32;
    constexpr int S0 = 0, S1 = S0 + I_FI, S2 = S1 + I_FO, S3 = S2 + I_WIN, S4 = S3 + I_WG, S5 = S4 + I_UB, S6 = S5 + I_UC, S7 = S6 + I_RG, S8 = S7 + I_RG, S9 = S8 + I_SQ, S10 = S9 + I_SQ,
                  S11 = S10 + I_KV, S12 = S11 + I_SQ, S13 = S12 + I_FI, S14 = S13 + I_FO;
    for (int it = gw; it < S14; it += NGW) {
        if (it < S1 || (it >= S12 && it < S13)) {
            const bool second = it >= S12; const int r = second ? it - S12 : it; const int kb = r / 88, nb = r % 88; const int n = nb * 64;
            const int half = n >= DFF ? 1 : 0, nn = n - half * DFF; const int drow = (nn >> 7) * 256 + half * 128 + (nn & 127);
            tr_item(second ? w2i : w1i, 2 * DFF, n, kb * 64, second ? g2 : g1, (bf16*)(ws + (second ? WS_W2IN : WS_W1IN)), D, drow, scr, lane);
        } else if (it < S2 || it >= S13) {
            const bool second = it >= S13; const int r = second ? it - S13 : it - S1; const int kb = r / 16, nb = r % 16;
            tr_item(second ? w2o : w1o, D, nb * 64, kb * 64, nullptr, (bf16*)(ws + (second ? WS_W2OUT : WS_W1OUT)), DFF, nb * 64, scr, lane);
        } else if (it < S3) { const int r = it - S2, kb = r / 64, nb = r % 64; tr_item(win, INW, nb * 64, kb * 64, gm, (bf16*)(ws + WS_WIN), D, nb * 64, scr, lane);
        } else if (it < S4) { const int r = it - S3, kb = r / 48, nb = r % 48; tr_item(win, INW, 4104 + nb * 64, kb * 64, gm, (bf16*)(ws + WS_WG), D, nb * 64, scr, lane);
        } else if (it < S5) { const int r = it - S4, kb = r / 16, nb = r % 16; tr_item(wub, D, nb * 64, kb * 64, nullptr, (bf16*)(ws + WS_UB), D, nb * 64, scr, lane);
        } else if (it < S6) { const int r = it - S5, kb = r / 16, nb = r % 16; tr_item(wuc, D, nb * 64, kb * 64, nullptr, (bf16*)(ws + WS_UC), 512, nb * 64, scr, lane);
        } else if (it < S8) { const bool xg = it >= S7; const int r = xg ? it - S7 : it - S6; const int hh = r >> 2, kb = (r >> 1) & 1, nb = r & 1;
            tr_item((xg ? wrx : wra) + hh * 16384, 128, nb * 64, kb * 64, nullptr, (bf16*)(ws + (xg ? WS_WXT : WS_WAT)) + hh * 16384, 128, nb * 64, scr, lane);
        } else if (it < S9) { const int r = it - S8, kb = r / 16, nb = r % 16; tr_item(wo, D, nb * 64, kb * 64, nullptr, (bf16*)(ws + WS_WO), D, nb * 64, scr, lane);
        } else if (it < S10) { const int r = it - S9, kb = r / 16, nb = r % 16; tr_item(wxq, D, nb * 64, kb * 64, gc, (bf16*)(ws + WS_WXQ), D, nb * 64, scr, lane);
        } else if (it < S11) { const int r = it - S10, kb = r / 32, nb = r % 32; tr_item(wxkv, 2 * D, nb * 64, kb * 64, nullptr, (bf16*)(ws + WS_WXKV), D, nb * 64, scr, lane);
        } else { const int r = it - S11, kb = r / 16, nb = r % 16; tr_item(wxo, D, nb * 64, kb * 64, nullptr, (bf16*)(ws + WS_WXO), D, nb * 64, scr, lane); }
    }
    { bf16* UaT = (bf16*)(ws + WS_UA);
      for (int it = gw; it < 4 * 16 * 16; it += NGW) { const int g = it >> 8, nblk = (it >> 4) & 15, c0 = (it & 15) * 8, n = nblk * 64 + lane;
          const float* wp = wpool + ((size_t)g * 128 + c0) * 128; const float* sc = psc + g * 128; const float* ua = wua + (size_t)(g * 128) * D + n; float acc[8];
#pragma unroll
          for (int c = 0; c < 8; ++c) acc[c] = 0.f;
#pragma unroll 16
          for (int j = 0; j < 128; ++j) { const float u = ua[(size_t)j * D] * sc[j];
#pragma unroll
              for (int c = 0; c < 8; ++c) acc[c] += wp[c * 128 + j] * u; }
          v4u o; o.x = pk2(acc[0], acc[1]); o.y = pk2(acc[2], acc[3]); o.z = pk2(acc[4], acc[5]); o.w = pk2(acc[6], acc[7]);
          *(v4u*)(UaT + (size_t)n * 512 + g * 128 + c0) = o; } }
    { float* wfl = (float*)(ws + WS_WFL);
      for (int it = gw * 64 + lane; it < 8 * 1024; it += NGW * 64) { const int h = it >> 10, k = it & 1023; wfl[it] = gm[k] * win[(size_t)k * INW + 4096 + h]; } }
    { const float* mem = tab_in(TB, 1); bf16* mn = (bf16*)(ws + WS_MEMN);
      for (int r = gw; r < 512; r += NGW) { const f32x4* xr = (const f32x4*)(mem + (size_t)r * D) + lane; f32x4 v[4]; float s = 0.f;
#pragma unroll
          for (int j = 0; j < 4; ++j) { v[j] = xr[64 * j]; s += (v[j].x * v[j].x + v[j].y * v[j].y) + (v[j].z * v[j].z + v[j].w * v[j].w); }
          const float rs = rsqrtf(wave_sum(s, lane) * (1.f / D) + 1e-6f); unsigned long long* o8 = (unsigned long long*)(mn + (size_t)r * D) + lane;
#pragma unroll
          for (int j = 0; j < 4; ++j) { const f32x4 gv = *((const f32x4*)gmem + lane + 64 * j);
              o8[64 * j] = (unsigned long long)pk2(v[j].x * rs * gv.x, v[j].y * rs * gv.y) | ((unsigned long long)pk2(v[j].z * rs * gv.z, v[j].w * rs * gv.w) << 32); } } }
    if (l == 0) {
        const float* x = tab_in(TB, 0); (void)xout; bf16* xb = (bf16*)(ws + WS_XB); float* ss = (float*)(ws + WS_SSP);
        for (int r0 = gw; r0 < M; r0 += 4 * NGW) { f32x4 v[4][4]; float s[4];
#pragma unroll
            for (int q = 0; q < 4; ++q) { const int r = (r0 + q * NGW < M) ? r0 + q * NGW : r0; const f32x4* xr = (const f32x4*)(x + (size_t)r * D) + lane; s[q] = 0.f;
#pragma unroll
                for (int j = 0; j < 4; ++j) { v[q][j] = xr[64 * j]; s[q] += (v[q][j].x * v[q][j].x + v[q][j].y * v[q][j].y) + (v[q][j].z * v[q][j].z + v[q][j].w * v[q][j].w); } }
#pragma unroll
            for (int o = 1; o < 64; o <<= 1) {
#pragma unroll
                for (int q = 0; q < 4; ++q) s[q] += bperm(s[q], lane ^ o); }
#pragma unroll
            for (int q = 0; q < 4; ++q) { const int r = r0 + q * NGW; if (r < M) { unsigned long long* o8 = (unsigned long long*)(xb + (size_t)r * D) + lane;
                    if (lane < 4) ss[(size_t)r * 4 + lane] = lane == 0 ? s[q] : 0.f;
#pragma unroll
                    for (int j = 0; j < 4; ++j) { o8[64 * j] = (unsigned long long)pk2(v[q][j].x, v[q][j].y) | ((unsigned long long)pk2(v[q][j].z, v[q][j].w) << 32); } } }
        }
    }
}
#undef g1
#undef w1i
#undef w1o
#undef gm
#undef win
#undef wpool
#undef psc
#undef wua
#undef wra
#undef wrx
#undef wub
#undef wuc
#undef wo
#undef gc
#undef gmem
#undef wxq
#undef wxkv
#undef wxo
#undef g2
#undef w2i
#undef w2o
__device__ __forceinline__ void phase_fl(const bf16* xb, const float* wfl, const float* bfv, const float* ss, float* logf, int gw, int NGW, int lane) {
    for (int r0 = gw; r0 < M; r0 += 4 * NGW) {
        float acc[4][8]; v4u xv[4][2];
#pragma unroll
        for (int q = 0; q < 4; ++q) { const int r = r0 + q * NGW; const bool ok = r < M;
#pragma unroll
            for (int j = 0; j < 2; ++j) xv[q][j] = ok ? *(const v4u*)(xb + (size_t)r * D + 8 * lane + 512 * j) : (v4u){0u, 0u, 0u, 0u};
#pragma unroll
            for (int h = 0; h < 8; ++h) acc[q][h] = 0.f; }
#pragma unroll
        for (int j = 0; j < 2; ++j) { const int k0 = 8 * lane + 512 * j;
#pragma unroll
            for (int h = 0; h < 8; ++h) { const f32x4 w0 = *(const f32x4*)(wfl + h * 1024 + k0), w1 = *(const f32x4*)(wfl + h * 1024 + k0 + 4);
#pragma unroll
                for (int q = 0; q < 4; ++q) { const v4u x = xv[q][j];
                    acc[q][h] += (__uint_as_float(x.x << 16) * w0.x + __uint_as_float(x.x & 0xffff0000u) * w0.y) + (__uint_as_float(x.y << 16) * w0.z + __uint_as_float(x.y & 0xffff0000u) * w0.w)
                               + (__uint_as_float(x.z << 16) * w1.x + __uint_as_float(x.z & 0xffff0000u) * w1.y) + (__uint_as_float(x.w << 16) * w1.z + __uint_as_float(x.w & 0xffff0000u) * w1.w); } } }
        const int h = ((lane >> 5) & 1) * 4 + ((lane >> 4) & 1) * 2 + ((lane >> 3) & 1); const float bh_ = bfv[h];
#pragma unroll
        for (int q = 0; q < 4; ++q) { const int r = r0 + q * NGW;
            float v4[4], v2[2], v1;
            { const bool up = (lane & 32) != 0;
#pragma unroll
              for (int i = 0; i < 4; ++i) { const float mine = up ? acc[q][4 + i] : acc[q][i], other = up ? acc[q][i] : acc[q][4 + i]; v4[i] = mine + bperm(other, lane ^ 32); } }
            { const bool up = (lane & 16) != 0;
#pragma unroll
              for (int i = 0; i < 2; ++i) { const float mine = up ? v4[2 + i] : v4[i], other = up ? v4[i] : v4[2 + i]; v2[i] = mine + bperm(other, lane ^ 16); } }
            { const bool up = (lane & 8) != 0; const float mine = up ? v2[1] : v2[0], other = up ? v2[0] : v2[1]; v1 = mine + bperm(other, lane ^ 8); }
            v1 += bperm(v1, lane ^ 4); v1 += bperm(v1, lane ^ 2); v1 += bperm(v1, lane ^ 1);
            if (r < M) { const float z = v1 * pg8::rstd_of(ss, r) + bh_; const float ls = -(fmaxf(-z, 0.f) + flog1p(__expf(-fabsf(z)))); if ((lane & 7) == 0) logf[(size_t)r * 8 + h] = ls; } }
    }
}
__device__ __forceinline__ void cumsum_bh(const float* logf, float* ctil, int bh, LAS float* red) {
    int tid_o = threadIdx.x; asm volatile("" : "+v"(tid_o)); const int tid = tid_o, lane = tid & 63, wid = tid >> 6;
    const int b = bh >> 3, h = bh & 7; const float* src = logf + ((size_t)b * SEQ + 16 * tid) * 8 + h; float v[16]; float s = 0.f;
#pragma unroll
    for (int i = 0; i < 16; ++i) { v[i] = src[(size_t)i * 8]; s += v[i]; }
    float incl = s;
#pragma unroll
    for (int o = 1; o < 64; o <<= 1) { const float t = bperm(incl, lane - o); if (lane >= o) incl += t; }
    if (lane == 63) red[wid] = incl;
    __syncthreads();
    float base = 0.f;
#pragma unroll
    for (int w = 0; w < 8; ++w) if (w < wid) base += red[w];
    float run = base + incl - s; float* dst = ctil + (size_t)bh * SEQ + 16 * tid;
#pragma unroll
    for (int i = 0; i < 16; ++i) { run += v[i]; dst[i] = run * 1.4426950408889634f; }
    __syncthreads();
}
__device__ __forceinline__ void unpk8(const v4u xv, float (&xf)[8]) { xf[0] = __uint_as_float(xv.x << 16); xf[1] = __uint_as_float(xv.x & 0xffff0000u); xf[2] = __uint_as_float(xv.y << 16); xf[3] = __uint_as_float(xv.y & 0xffff0000u);
    xf[4] = __uint_as_float(xv.z << 16); xf[5] = __uint_as_float(xv.z & 0xffff0000u); xf[6] = __uint_as_float(xv.w << 16); xf[7] = __uint_as_float(xv.w & 0xffff0000u); }
template <int W> __device__ __forceinline__ void pool_item(const bf16* xa, bf16* ya, int m0, int cgi) {
    const int t0 = m0 & (SEQ - 1); v4u rw[W + 7];
#pragma unroll
    for (int a = 0; a < W + 7; ++a) { const int tl = a - (W - 1); rw[a] = (t0 + tl >= 0) ? *(const v4u*)(xa + (size_t)(m0 + tl) * 512 + 8 * cgi) : (v4u){0u, 0u, 0u, 0u}; }
    float s[8];
#pragma unroll
    for (int i = 0; i < 8; ++i) s[i] = 0.f;
#pragma unroll
    for (int a = 0; a < W - 1; ++a) { float xf[8]; unpk8(rw[a], xf);
#pragma unroll
        for (int i = 0; i < 8; ++i) s[i] += xf[i]; }
#pragma unroll
    for (int o = 0; o < 8; ++o) { float cur[8]; unpk8(rw[o + W - 1], cur);
#pragma unroll
        for (int i = 0; i < 8; ++i) s[i] += cur[i];
        const int t = t0 + o, cnt = (t + 1 < W) ? t + 1 : W; const float ic = 1.f / (float)cnt; v4u ov;
        ov.x = pk2(s[0] * ic - cur[0], s[1] * ic - cur[1]); ov.y = pk2(s[2] * ic - cur[2], s[3] * ic - cur[3]); ov.z = pk2(s[4] * ic - cur[4], s[5] * ic - cur[5]); ov.w = pk2(s[6] * ic - cur[6], s[7] * ic - cur[7]);
        *(v4u*)(ya + (size_t)(m0 + o) * 512 + 8 * cgi) = ov;
        float old[8]; unpk8(rw[o], old);
#pragma unroll
        for (int i = 0; i < 8; ++i) s[i] -= old[i]; }
}
__device__ __forceinline__ void phase_pool(const bf16* xa, bf16* ya, int gtid, int nthr) {
    for (int idx = gtid; idx < (M / 8) * 64; idx += nthr) { const int c16 = idx & 15, rl = (idx >> 4) & 3, g = (idx >> 6) & 3, rh = idx >> 8; const int m0 = (rh * 4 + rl) * 8, cgi = g * 16 + c16;
        if (g == 0) pool_item<2>(xa, ya, m0, cgi); else if (g == 1) pool_item<4>(xa, ya, m0, cgi); else if (g == 2) pool_item<8>(xa, ya, m0, cgi); else pool_item<16>(xa, ya, m0, cgi); }
}
__device__ __forceinline__ int crow16(int r, int hi) { return (r & 3) + 8 * (r >> 2) + 4 * hi; }
template <bool FINAL>
__device__ __forceinline__ void lru_item(LAS unsigned char* lds, int b, int hp, int ck, const bf16* xl, bf16* gg, const float* cw, const float* cb, const bf16* WaT, const bf16* WxT,
                                         const float* ba, const float* bx, const float* lam, float* summ) {
    int tid_o = threadIdx.x; asm volatile("" : "+v"(tid_o)); const int tid = tid_o, lane = tid & 63, wid = tid >> 6, r32 = lane & 31, hi = lane >> 5;
    const int t0 = ck * 128; const size_t m0 = (size_t)b * SEQ + t0; const int ch0 = hp * 256;
    constexpr int XP = 264;
    LAS bf16* xc = (LAS bf16*)lds; LAS float* h0s = (LAS float*)(lds + 128 * XP * 2);
    {
        const int cgi = tid & 31, tq = tid >> 5, c = ch0 + 8 * cgi;
        float w[4][8], bb[8];
#pragma unroll
        for (int k = 0; k < 4; ++k) { const f32x4 a = *(const f32x4*)(cw + k * 1024 + c), d = *(const f32x4*)(cw + k * 1024 + c + 4); w[k][0] = a.x; w[k][1] = a.y; w[k][2] = a.z; w[k][3] = a.w; w[k][4] = d.x; w[k][5] = d.y; w[k][6] = d.z; w[k][7] = d.w; }
        { const f32x4 a = *(const f32x4*)(cb + c), d = *(const f32x4*)(cb + c + 4); bb[0] = a.x; bb[1] = a.y; bb[2] = a.z; bb[3] = a.w; bb[4] = d.x; bb[5] = d.y; bb[6] = d.z; bb[7] = d.w; }
        v4u rw[11];
#pragma unroll
        for (int i = 0; i < 11; ++i) { const int tl = tq * 8 - 3 + i; rw[i] = (t0 + tl >= 0) ? *(const v4u*)(xl + (size_t)((long)m0 + tl) * 1024 + c) : (v4u){0u, 0u, 0u, 0u}; }
#pragma unroll
        for (int o = 0; o < 8; ++o) { float y[8];
#pragma unroll
            for (int j = 0; j < 8; ++j) y[j] = bb[j];
#pragma unroll
            for (int k = 0; k < 4; ++k) { const v4u xv = rw[o + k];
                y[0] += w[k][0] * __uint_as_float(xv.x << 16); y[1] += w[k][1] * __uint_as_float(xv.x & 0xffff0000u); y[2] += w[k][2] * __uint_as_float(xv.y << 16); y[3] += w[k][3] * __uint_as_float(xv.y & 0xffff0000u);
                y[4] += w[k][4] * __uint_as_float(xv.z << 16); y[5] += w[k][5] * __uint_as_float(xv.z & 0xffff0000u); y[6] += w[k][6] * __uint_as_float(xv.w << 16); y[7] += w[k][7] * __uint_as_float(xv.w & 0xffff0000u); }
            v4u ov; ov.x = pk2(y[0], y[1]); ov.y = pk2(y[2], y[3]); ov.z = pk2(y[4], y[5]); ov.w = pk2(y[6], y[7]);
            *(LAS v4u*)(xc + (tq * 8 + o) * XP + 8 * cgi) = ov; }
    }
    if (FINAL && tid < 256) {
        const float* sp = summ + ((size_t)b * 64 * 1024 + ch0 + tid) * 2; float h = 0.f;
        for (int c0 = 0; c0 < ck; c0 += 16) { float2 v[16];
#pragma unroll
            for (int j = 0; j < 16; ++j) v[j] = (c0 + j < ck) ? *(const float2*)(sp + (size_t)(c0 + j) * 2048) : make_float2(1.f, 0.f);
#pragma unroll
            for (int j = 0; j < 16; ++j) h = v[j].x * h + v[j].y; }
        h0s[tid] = h;
    }
    __syncthreads();
    const int hh = wid >> 2, s = wid & 3, chl = 128 * hh + 32 * s + r32, ch = ch0 + chl, head = 2 * hp + hh;
    const float bav = ba[ch], bxv = bx[ch]; const float nl = -lam[ch]; const float sp8 = 8.f * (fmaxf(nl, 0.f) + flog1p(__expf(-fabsf(nl))));
    bf16x8 fa[8], fx[8];
#pragma unroll
    for (int ks = 0; ks < 8; ++ks) { fa[ks] = *(const bf16x8*)(WaT + (size_t)head * 16384 + (32 * s + r32) * 128 + 16 * ks + 8 * hi); fx[ks] = *(const bf16x8*)(WxT + (size_t)head * 16384 + (32 * s + r32) * 128 + 16 * ks + 8 * hi); }
    float hrun = FINAL ? h0s[chl] : 0.f, Arun = 1.f;
    for (int mb = 0; mb < 4; ++mb) {
        unsigned short gv[16];
        if (FINAL) {
#pragma unroll
            for (int r = 0; r < 16; ++r) gv[r] = gg[(m0 + 32 * mb + crow16(r, hi)) * 1024 + ch]; }
        f32x16 accA = {0.f, 0.f, 0.f, 0.f, 0.f, 0.f, 0.f, 0.f, 0.f, 0.f, 0.f, 0.f, 0.f, 0.f, 0.f, 0.f}, accX = accA;
#pragma unroll
        for (int ks = 0; ks < 8; ++ks) { const bf16x8 af = *(const LAS bf16x8*)(xc + (32 * mb + r32) * XP + 128 * hh + 16 * ks + 8 * hi);
            accA = __builtin_amdgcn_mfma_f32_32x32x16_bf16(af, fa[ks], accA, 0, 0, 0); accX = __builtin_amdgcn_mfma_f32_32x32x16_bf16(af, fx[ks], accX, 0, 0, 0); }
        float a[16], u[16];
#pragma unroll
        for (int r = 0; r < 16; ++r) { const int tok = 32 * mb + crow16(r, hi); const float xcv = bf2f(xc[tok * XP + chl]);
            const float rg = pg8::fsig(accA[r] + bav), la = -rg * sp8, av = __expf(la), mult = __builtin_amdgcn_sqrtf(fmaxf(1.f - av * av, 0.f)), ig = pg8::fsig(accX[r] + bxv);
            a[r] = av; u[r] = mult * ig * xcv; }
        float As[4], Hs[4], Ap[4], Hp[4], hin[4];
#pragma unroll
        for (int g = 0; g < 4; ++g) { float Aq = 1.f, Hq = 0.f;
#pragma unroll
            for (int i = 0; i < 4; ++i) { Hq = a[4 * g + i] * Hq + u[4 * g + i]; Aq *= a[4 * g + i]; }
            As[g] = Aq; Hs[g] = Hq; Ap[g] = bperm(Aq, lane ^ 32); Hp[g] = bperm(Hq, lane ^ 32); }
#pragma unroll
        for (int g = 0; g < 4; ++g) { const float A0 = hi ? Ap[g] : As[g], H0 = hi ? Hp[g] : Hs[g], A1 = hi ? As[g] : Ap[g], H1 = hi ? Hs[g] : Hp[g];
            const float hA = hrun, hB = A0 * hA + H0; hrun = A1 * hB + H1; Arun *= A0 * A1; hin[g] = hi ? hB : hA; }
        if (FINAL) {
#pragma unroll
            for (int g = 0; g < 4; ++g) { float hc = hin[g];
#pragma unroll
                for (int i = 0; i < 4; ++i) { const int r = 4 * g + i; hc = a[r] * hc + u[r]; gv[r] = (unsigned short)f2bf(hc * bf2f(gv[r])); } }
#pragma unroll
            for (int r = 0; r < 16; ++r) gg[(m0 + 32 * mb + crow16(r, hi)) * 1024 + ch] = gv[r];
        }
    }
    if (!FINAL && hi == 0) { float* sp = summ + (((size_t)b * 64 + ck) * 1024 + ch) * 2; sp[0] = Arun; sp[1] = hrun; }
    __syncthreads();
}
__device__ __forceinline__ void phase_final(float* x, const float* g, int gw, int NGW, int lane) {
    f32x4 gv[4];
#pragma unroll
    for (int j = 0; j < 4; ++j) gv[j] = *((const f32x4*)g + lane + 64 * j);
    for (int r0 = gw; r0 < M; r0 += 4 * NGW) { f32x4 v[4][4]; float s[4];
#pragma unroll
        for (int q = 0; q < 4; ++q) { const int r = (r0 + q * NGW < M) ? r0 + q * NGW : r0; const f32x4* xr = (const f32x4*)(x + (size_t)r * D) + lane; s[q] = 0.f;
#pragma unroll
            for (int j = 0; j < 4; ++j) { v[q][j] = xr[64 * j]; s[q] += (v[q][j].x * v[q][j].x + v[q][j].y * v[q][j].y) + (v[q][j].z * v[q][j].z + v[q][j].w * v[q][j].w); } }
#pragma unroll
        for (int o = 1; o < 64; o <<= 1) {
#pragma unroll
            for (int q = 0; q < 4; ++q) s[q] += bperm(s[q], lane ^ o); }
#pragma unroll
        for (int q = 0; q < 4; ++q) { const int r = r0 + q * NGW; if (r < M) { const float rs = rsqrtf(s[q] * (1.f / D) + 1e-6f); f32x4* xr = (f32x4*)(x + (size_t)r * D) + lane;
#pragma unroll
                for (int j = 0; j < 4; ++j) xr[64 * j] = (f32x4){v[q][j].x * rs * gv[j].x, v[q][j].y * rs * gv[j].y, v[q][j].z * rs * gv[j].z, v[q][j].w * rs * gv[j].w}; } }
    }
}
__device__ __forceinline__ void phase_kmax(const bf16* K, float* kpart, int gw, int NGW, int lane) {
    float m0 = 0.f, m1 = 0.f;
#pragma unroll 8
    for (int r = gw; r < M; r += NGW) { const v4u w = *(const v4u*)(K + (size_t)r * 512 + 8 * lane);
        const float a0 = __uint_as_float(w.x << 16), a1 = __uint_as_float(w.x & 0xffff0000u), a2 = __uint_as_float(w.y << 16), a3 = __uint_as_float(w.y & 0xffff0000u);
        const float a4 = __uint_as_float(w.z << 16), a5 = __uint_as_float(w.z & 0xffff0000u), a6 = __uint_as_float(w.w << 16), a7 = __uint_as_float(w.w & 0xffff0000u);
        float s = (a0 * a0 + a1 * a1) + (a2 * a2 + a3 * a3) + (a4 * a4 + a5 * a5) + (a6 * a6 + a7 * a7);
        s += bperm(s, lane ^ 1); s += bperm(s, lane ^ 2); s += bperm(s, lane ^ 4);
        if (r < SEQ) m0 = fmaxf(m0, s); else m1 = fmaxf(m1, s); }
    if ((lane & 7) == 0) { kpart[((size_t)gw * 2 + 0) * 8 + (lane >> 3)] = m0; kpart[((size_t)gw * 2 + 1) * 8 + (lane >> 3)] = m1; }
}
constexpr float FOX_C2 = 0.125f * 1.4426950408889634f;
constexpr float FOX_SKIP = 64.f;
constexpr int FOX_KP = 72;
constexpr int FOX_BUF = 2 * 64 * FOX_KP * 2 + 256;
__device__ __forceinline__ void fox_unit(LAS unsigned char* lds, int b, int h, int qb, const bf16* Q, const bf16* K, const bf16* V, bf16* O, const float* ct, const float* kpart, int nparts) {
    int tid_o = threadIdx.x; asm volatile("" : "+v"(tid_o)); const int tid = tid_o, lane = tid & 63, wid = tid >> 6, r32 = lane & 31, hi = lane >> 5;
    const size_t rowbase = (size_t)b * SEQ; const int q0 = qb * 256, NT = 4 * qb + 4;
    const bf16* Qw = Q + (rowbase + q0 + wid * 32 + r32) * 512 + h * 64;
    bf16x8 qr[4];
#pragma unroll
    for (int d0 = 0; d0 < 4; ++d0) qr[d0] = *(const bf16x8*)(Qw + 16 * d0 + 8 * hi);
    LAS float* red = (LAS float*)(lds + 2 * FOX_BUF); LAS int* tsl = (LAS int*)(lds + 2 * FOX_BUF + 128);
    { float qn = 0.f;
#pragma unroll
      for (int d0 = 0; d0 < 4; ++d0) { const v4u w = __builtin_bit_cast(v4u, qr[d0]);
          const float a0 = __uint_as_float(w.x << 16), a1 = __uint_as_float(w.x & 0xffff0000u), a2 = __uint_as_float(w.y << 16), a3 = __uint_as_float(w.y & 0xffff0000u);
          const float a4 = __uint_as_float(w.z << 16), a5 = __uint_as_float(w.z & 0xffff0000u), a6 = __uint_as_float(w.w << 16), a7 = __uint_as_float(w.w & 0xffff0000u);
          qn += (a0 * a0 + a1 * a1) + (a2 * a2 + a3 * a3) + (a4 * a4 + a5 * a5) + (a6 * a6 + a7 * a7); }
      qn += bperm(qn, lane ^ 32);
#pragma unroll
      for (int o = 1; o < 32; o <<= 1) qn = fmaxf(qn, bperm(qn, lane ^ o));
      __syncthreads();
      float km = 0.f;
      for (int i = tid; i < nparts; i += NTHR) km = fmaxf(km, kpart[((size_t)i * 2 + b) * 8 + h]);
#pragma unroll
      for (int o = 1; o < 64; o <<= 1) km = fmaxf(km, bperm(km, lane ^ o));
      if (lane == 0) { red[wid] = qn; red[8 + wid] = km; } if (tid == 0) tsl[0] = 4 * qb;
      __syncthreads();
      float q2 = red[0], k2 = red[8];
#pragma unroll
      for (int w = 1; w < 8; ++w) { q2 = fmaxf(q2, red[w]); k2 = fmaxf(k2, red[8 + w]); }
      const float thr = 2.f * sqrtf(q2) * sqrtf(k2) * 1.0001f + FOX_SKIP;
      const float c0 = ct[q0];
      if (tid < 4 * qb && ct[64 * tid + 63] - c0 <= thr) atomicMin((int*)tsl, tid);
      __syncthreads(); }
    const int T0 = tsl[0];
    const int skey = tid >> 3, sd = (tid & 7) * 8;
    const bf16* kp = K + (rowbase + skey) * 512 + h * 64 + sd; const bf16* vp = V + (rowbase + skey) * 512 + h * 64 + sd;
    v4u kreg = *(const v4u*)(kp + (size_t)T0 * 64 * 512), vreg = *(const v4u*)(vp + (size_t)T0 * 64 * 512); float creg = (tid < 64) ? ct[64 * T0 + tid] : 0.f;
    __syncthreads();
    { LAS unsigned char* buf0 = lds + (T0 & 1) * FOX_BUF; LAS bf16* Ks = (LAS bf16*)buf0; LAS bf16* Vt = Ks + 64 * FOX_KP; LAS float* Cs = (LAS float*)(buf0 + 2 * 64 * FOX_KP * 2);
      *(LAS v4u*)(Ks + skey * FOX_KP + sd) = kreg;
      Vt[(sd + 0) * FOX_KP + skey] = (bf16)(vreg.x & 0xffffu); Vt[(sd + 1) * FOX_KP + skey] = (bf16)(vreg.x >> 16); Vt[(sd + 2) * FOX_KP + skey] = (bf16)(vreg.y & 0xffffu); Vt[(sd + 3) * FOX_KP + skey] = (bf16)(vreg.y >> 16);
      Vt[(sd + 4) * FOX_KP + skey] = (bf16)(vreg.z & 0xffffu); Vt[(sd + 5) * FOX_KP + skey] = (bf16)(vreg.z >> 16); Vt[(sd + 6) * FOX_KP + skey] = (bf16)(vreg.w & 0xffffu); Vt[(sd + 7) * FOX_KP + skey] = (bf16)(vreg.w >> 16);
      if (tid < 64) Cs[tid] = creg; }
    if (T0 + 1 < NT) { kreg = *(const v4u*)(kp + (size_t)(T0 + 1) * 64 * 512); vreg = *(const v4u*)(vp + (size_t)(T0 + 1) * 64 * 512); if (tid < 64) creg = ct[64 * (T0 + 1) + tid]; }
    float m = -1e30f, l = 0.f; f32x16 o0, o1;
#pragma unroll
    for (int r = 0; r < 16; ++r) { o0[r] = 0.f; o1[r] = 0.f; }
    for (int t = T0; t < NT; ++t) {
        __syncthreads();
        if (t + 1 < NT) { LAS unsigned char* bufn = lds + ((t + 1) & 1) * FOX_BUF; LAS bf16* Ks = (LAS bf16*)bufn; LAS bf16* Vt = Ks + 64 * FOX_KP; LAS float* Cs = (LAS float*)(bufn + 2 * 64 * FOX_KP * 2);
            *(LAS v4u*)(Ks + skey * FOX_KP + sd) = kreg;
            Vt[(sd + 0) * FOX_KP + skey] = (bf16)(vreg.x & 0xffffu); Vt[(sd + 1) * FOX_KP + skey] = (bf16)(vreg.x >> 16); Vt[(sd + 2) * FOX_KP + skey] = (bf16)(vreg.y & 0xffffu); Vt[(sd + 3) * FOX_KP + skey] = (bf16)(vreg.y >> 16);
            Vt[(sd + 4) * FOX_KP + skey] = (bf16)(vreg.z & 0xffffu); Vt[(sd + 5) * FOX_KP + skey] = (bf16)(vreg.z >> 16); Vt[(sd + 6) * FOX_KP + skey] = (bf16)(vreg.w & 0xffffu); Vt[(sd + 7) * FOX_KP + skey] = (bf16)(vreg.w >> 16);
            if (tid < 64) Cs[tid] = creg;
            if (t + 2 < NT) { kreg = *(const v4u*)(kp + (size_t)(t + 2) * 64 * 512); vreg = *(const v4u*)(vp + (size_t)(t + 2) * 64 * 512); if (tid < 64) creg = ct[64 * (t + 2) + tid]; } }
        const int jb = t - (NT - 4);
        if (jb >= 0 && 64 * jb > 32 * wid + 31) continue;
        LAS unsigned char* buf = lds + (t & 1) * FOX_BUF; const LAS bf16* Ks = (const LAS bf16*)buf; const LAS bf16* Vt = Ks + 64 * FOX_KP; const LAS float* Cs = (const LAS float*)(buf + 2 * 64 * FOX_KP * 2);
        f32x16 p0, p1;
#pragma unroll
        for (int g = 0; g < 4; ++g) { const f32x4 a = *(const LAS f32x4*)(Cs + 8 * g + 4 * hi), c = *(const LAS f32x4*)(Cs + 32 + 8 * g + 4 * hi);
            p0[4 * g + 0] = -a[0]; p0[4 * g + 1] = -a[1]; p0[4 * g + 2] = -a[2]; p0[4 * g + 3] = -a[3]; p1[4 * g + 0] = -c[0]; p1[4 * g + 1] = -c[1]; p1[4 * g + 2] = -c[2]; p1[4 * g + 3] = -c[3]; }
#pragma unroll
        for (int d0 = 0; d0 < 4; ++d0) { const bf16x8 a0 = *(const LAS bf16x8*)(Ks + r32 * FOX_KP + 16 * d0 + 8 * hi), a1 = *(const LAS bf16x8*)(Ks + (32 + r32) * FOX_KP + 16 * d0 + 8 * hi);
            p0 = __builtin_amdgcn_mfma_f32_32x32x16_bf16(a0, qr[d0], p0, 0, 0, 0); p1 = __builtin_amdgcn_mfma_f32_32x32x16_bf16(a1, qr[d0], p1, 0, 0, 0); }
        if (jb >= 0) { const int qrel = 32 * wid + r32, kb = 64 * jb + 4 * hi;
#pragma unroll
            for (int r = 0; r < 16; ++r) { const int kv = kb + (r & 3) + 8 * (r >> 2); if (kv > qrel) p0[r] = -__builtin_inff(); if (kv + 32 > qrel) p1[r] = -__builtin_inff(); } }
        float mx = fmaxf(p0[0], p1[0]);
#pragma unroll
        for (int r = 1; r < 16; ++r) mx = fmaxf(mx, fmaxf(p0[r], p1[r]));
        mx = fmaxf(mx, bperm(mx, lane ^ 32));
        const float mn = fmaxf(m, mx), alpha = __builtin_amdgcn_exp2f(m - mn); m = mn;
        float sum = 0.f;
#pragma unroll
        for (int r = 0; r < 16; ++r) { p0[r] = __builtin_amdgcn_exp2f(p0[r] - mn); p1[r] = __builtin_amdgcn_exp2f(p1[r] - mn); sum += p0[r] + p1[r]; }
        l = l * alpha + sum;
#pragma unroll
        for (int r = 0; r < 16; ++r) { o0[r] *= alpha; o1[r] *= alpha; }
        bf16x8 pb[4];
        { v4u w;
          w.x = pg8::cvt_pk_bf16(p0[0], p0[1]); w.y = pg8::cvt_pk_bf16(p0[2], p0[3]); w.z = pg8::cvt_pk_bf16(p0[4], p0[5]); w.w = pg8::cvt_pk_bf16(p0[6], p0[7]); pb[0] = __builtin_bit_cast(bf16x8, w);
          w.x = pg8::cvt_pk_bf16(p0[8], p0[9]); w.y = pg8::cvt_pk_bf16(p0[10], p0[11]); w.z = pg8::cvt_pk_bf16(p0[12], p0[13]); w.w = pg8::cvt_pk_bf16(p0[14], p0[15]); pb[1] = __builtin_bit_cast(bf16x8, w);
          w.x = pg8::cvt_pk_bf16(p1[0], p1[1]); w.y = pg8::cvt_pk_bf16(p1[2], p1[3]); w.z = pg8::cvt_pk_bf16(p1[4], p1[5]); w.w = pg8::cvt_pk_bf16(p1[6], p1[7]); pb[2] = __builtin_bit_cast(bf16x8, w);
          w.x = pg8::cvt_pk_bf16(p1[8], p1[9]); w.y = pg8::cvt_pk_bf16(p1[10], p1[11]); w.z = pg8::cvt_pk_bf16(p1[12], p1[13]); w.w = pg8::cvt_pk_bf16(p1[14], p1[15]); pb[3] = __builtin_bit_cast(bf16x8, w); }
#pragma unroll
        for (int mm = 0; mm < 4; ++mm) {
            typedef unsigned u32x2v __attribute__((ext_vector_type(2)));
            const u32x2v a0l = *(const LAS u32x2v*)(Vt + r32 * FOX_KP + 16 * mm + 4 * hi), a0h = *(const LAS u32x2v*)(Vt + r32 * FOX_KP + 16 * mm + 8 + 4 * hi);
            const u32x2v a1l = *(const LAS u32x2v*)(Vt + (32 + r32) * FOX_KP + 16 * mm + 4 * hi), a1h = *(const LAS u32x2v*)(Vt + (32 + r32) * FOX_KP + 16 * mm + 8 + 4 * hi);
            const v4u A0 = {a0l.x, a0l.y, a0h.x, a0h.y}, A1 = {a1l.x, a1l.y, a1h.x, a1h.y};
            o0 = __builtin_amdgcn_mfma_f32_32x32x16_bf16(__builtin_bit_cast(bf16x8, A0), pb[mm], o0, 0, 0, 0);
            o1 = __builtin_amdgcn_mfma_f32_32x32x16_bf16(__builtin_bit_cast(bf16x8, A1), pb[mm], o1, 0, 0, 0); }
    }
    l += bperm(l, lane ^ 32); const float inv = 1.f / l;
    bf16* Ow = O + (rowbase + q0 + wid * 32 + r32) * 512 + h * 64;
#pragma unroll
    for (int g = 0; g < 4; ++g) { typedef unsigned u32x2v __attribute__((ext_vector_type(2)));
        u32x2v w0, w1; w0.x = pg8::cvt_pk_bf16(o0[4 * g] * inv, o0[4 * g + 1] * inv); w0.y = pg8::cvt_pk_bf16(o0[4 * g + 2] * inv, o0[4 * g + 3] * inv);
        w1.x = pg8::cvt_pk_bf16(o1[4 * g] * inv, o1[4 * g + 1] * inv); w1.y = pg8::cvt_pk_bf16(o1[4 * g + 2] * inv, o1[4 * g + 3] * inv);
        *(u32x2v*)(Ow + 8 * g + 4 * hi) = w0; *(u32x2v*)(Ow + 32 + 8 * g + 4 * hi) = w1; }
    __syncthreads();
}
__global__ void __launch_bounds__(NTHR, 2) hybrid_fwd(Args args) {
    extern __shared__ __attribute__((aligned(16))) unsigned char lds_raw[];
    cg::grid_group grid = cg::this_grid();
    LAS unsigned char* lds = (LAS unsigned char*)lds_raw;
    int tid = threadIdx.x, lane = tid & 63, wave = __builtin_amdgcn_readfirstlane(tid >> 6);
    int G = gridDim.x, bx = blockIdx.x;
    int vcu = (G % 8 == 0) ? (bx % 8) * (G / 8) + bx / 8 : bx;
    int gw = vcu * NWAVES + wave; int NGW = G * NWAVES;
    PtrTab TB = (PtrTab)(lds + TAB_OFF);
    if (tid == 0) {
#pragma unroll
        for (int i = 0; i < 31; ++i) TB[i] = (unsigned long long)args.in[i];
    }
    if (tid == 1) { TB[40] = 0ull; }
    __syncthreads();
    (void)xcd_barrier_post((unsigned*)(args.ws + WS_BAR), (volatile LAS unsigned*)(lds + TAB_OFF + 320));
    if (args.pad[0] != 0) grid.sync();
    unsigned char* ws = args.ws;
    float* X = args.out;
    float* SS = (float*)(ws + WS_SSP);
    bf16* XB = (bf16*)(ws + WS_XB);
    bf16* HB = (bf16*)(ws + WS_H);
    constexpr float C2X = 0.0625f * 1.4426950408889634f;
#define GSYNC() do { asm volatile("s_waitcnt vmcnt(0) lgkmcnt(0)" ::: "memory"); { XcdBarrier xb_; xb_.bar = (unsigned*)(ws + WS_BAR); xb_.x = xb_xcc_id(); xb_.st = (volatile LAS unsigned*)(lds + TAB_OFF + 320); xcd_barrier(xb_); } tid = threadIdx.x; asm volatile("" : "+v"(tid)); lane = tid & 63; wave = __builtin_amdgcn_readfirstlane(tid >> 6); G = gridDim.x; bx = blockIdx.x; asm volatile("" : "+s"(G), "+s"(bx)); vcu = (G % 8 == 0) ? (bx % 8) * (G / 8) + bx / 8 : bx; gw = vcu * NWAVES + wave; NGW = G * NWAVES; { unsigned long long wsi_ = (unsigned long long)ws; asm volatile("" : "+s"(wsi_)); ws = (unsigned char*)(GAS unsigned char*)wsi_; } } while (0)

    for (int l = 0; l < DEPTH; ++l) {
        float* ss0 = SS + (size_t)(4 * l + 0) * M * 4; float* ss1 = SS + (size_t)(4 * l + 1) * M * 4; float* ss2 = SS + (size_t)(4 * l + 2) * M * 4; float* ss3 = SS + (size_t)(4 * l + 3) * M * 4; float* ss4 = SS + (size_t)(4 * l + 4) * M * 4;
        phase_prologue(TB, ws, X, l, lds, gw, NGW, lane, wave);
        GSYNC();
        { pg8::Gemm g{XB, (const bf16*)(ws + WS_W1IN), M, 2 * DFF, D, D, D, 0}; pg8::StaticOrder S; S.init(M, 2 * DFF, G, bx);
          pg8::EpiSwiglu E{HB, ss0, DFF};
          pg8::gemm_phase<pg8::EpiSwiglu, pg8::StaticOrder, true, true>(lds, g, S, E); }
        if (bx >= G / 2) { pg8::Gemm g{(const bf16*)(ws + WS_MEMN), (const bf16*)(ws + WS_WXKV), 512, 2 * D, D, D, D, 0}; pg8::StaticOrder S; S.init(512, 2 * D, G, bx - G / 2);
          pg8::EpiKV E{(bf16*)(ws + WS_KX), (bf16*)(ws + WS_VT)};
          pg8::gemm_phase<pg8::EpiKV, pg8::StaticOrder, true, true>(lds, g, S, E); }
        GSYNC();
        { pg8::Gemm g{HB, (const bf16*)(ws + WS_W1OUT), M, D, DFF, DFF, DFF, 0}; pg8::StaticOrder S; S.init(M, D, G, bx); pg8::Unit u_;
          pg8::EpiResid E{l == 0 ? tab_in(TB, 0) : (const float*)X, X, XB, ss1, 0.5f};
          for (int i_ = 0; S.next(i_, u_); ++i_) { const pg8::OneUnit O1{u_.pm, u_.pn}; pg8::gemm_phase<pg8::EpiResid, pg8::OneUnit, false, true>(lds, g, O1, E); } }
        GSYNC();
        { pg8::Gemm g{XB, (const bf16*)(ws + WS_WIN), M, 4096, D, D, D, 0}; pg8::StaticOrder S; S.init(M, 4096, G, bx);
          pg8::EpiWin E{(bf16*)(ws + WS_XA), (bf16*)(ws + WS_XL), (bf16*)(ws + WS_GG), (bf16*)(ws + WS_Q), (bf16*)(ws + WS_K), (bf16*)(ws + WS_V), ss1, FOX_C2};
          pg8::gemm_phase<pg8::EpiWin, pg8::StaticOrder, true, true>(lds, g, S, E); }
        phase_fl(XB, (const float*)(ws + WS_WFL), tab_in(TB, 7) + l * 8, ss1, (float*)(ws + WS_LOGF), gw, NGW, lane);
        GSYNC();
        if (vcu < 16) cumsum_bh((const float*)(ws + WS_LOGF), (float*)(ws + WS_CTIL), vcu, (LAS float*)lds);
        for (int it = vcu; it < 512; it += G)
            lru_item<false>(lds, it >> 8, (it >> 6) & 3, it & 63, (const bf16*)(ws + WS_XL), (bf16*)(ws + WS_GG), tab_in(TB, 12) + (size_t)l * 4 * D, tab_in(TB, 13) + l * D, (const bf16*)(ws + WS_WAT), (const bf16*)(ws + WS_WXT),
                            tab_in(TB, 15) + l * D, tab_in(TB, 17) + l * D, tab_in(TB, 18) + l * D, (float*)(ws + WS_SUMM));
        phase_pool((const bf16*)(ws + WS_XA), (bf16*)(ws + WS_YA), vcu * NTHR + tid, G * NTHR);
        phase_kmax((const bf16*)(ws + WS_K), (float*)(ws + WS_KPART), gw, NGW, lane);
        GSYNC();
        for (int it = vcu; it < 512; it += G)
            lru_item<true>(lds, it >> 8, (it >> 6) & 3, (it & 256) ? 63 - (it & 63) : (it & 63),
                            (const bf16*)(ws + WS_XL), (bf16*)(ws + WS_GG), tab_in(TB, 12) + (size_t)l * 4 * D, tab_in(TB, 13) + l * D, (const bf16*)(ws + WS_WAT), (const bf16*)(ws + WS_WXT),
                           tab_in(TB, 15) + l * D, tab_in(TB, 17) + l * D, tab_in(TB, 18) + l * D, (float*)(ws + WS_SUMM));
        {
            unsigned* qc = (unsigned*)(ws + WS_QCTR) + (size_t)l * 64; LAS int* slot = (LAS int*)(lds + TAB_OFF + 384); LAS float* cl = (LAS float*)(lds + 2 * FOX_BUF + 256); LAS int* ord = (LAS int*)(lds + 2 * FOX_BUF + 384);
            __syncthreads();
            if (tid < 16) cl[tid] = ((const float*)(ws + WS_CTIL))[(size_t)tid * SEQ + SEQ - 1];
            __syncthreads();
            if (tid < 16) { const float ci = cl[tid]; int rk = 0;
#pragma unroll
                for (int j = 0; j < 16; ++j) { const float cj = cl[j]; rk += (cj > ci || (cj == ci && j < tid)) ? 1 : 0; }
                ord[rk] = tid; }
            for (;;) { __syncthreads(); if (tid == 0) slot[0] = (int)__hip_atomic_fetch_add(qc, 1u, __ATOMIC_RELAXED, __HIP_MEMORY_SCOPE_AGENT); __syncthreads();
                const int qi = slot[0]; if (qi >= 512) break; const int bh = ord[qi >> 5], qb = 31 - (qi & 31);
                fox_unit(lds, bh >> 3, bh & 7, qb, (const bf16*)(ws + WS_Q), (const bf16*)(ws + WS_K), (const bf16*)(ws + WS_V), (bf16*)(ws + WS_YC), (const float*)(ws + WS_CTIL) + (size_t)bh * SEQ, (const float*)(ws + WS_KPART), NGW); }
        }
        GSYNC();
        { pg8::StaticOrder S; S.init(M, D, G, bx); pg8::Unit u;
          bf16* stash = (bf16*)(ws + WS_STASH) + (size_t)bx * 65536; bf16* mg = (bf16*)(ws + WS_MG);
          for (int i = 0; S.next(i, u); ++i) { const pg8::OneUnit O1{u.pm, u.pn};
#pragma unroll 1
              for (int br = 0; br < 3; ++br) {
                  { pg8::Gemm g{XB, (const bf16*)(ws + WS_WG) + (size_t)br * D * D, M, D, D, D, D, 0}; pg8::EpiGate E{stash, tab_in(TB, 8) + (size_t)l * 3 * D + br * D, ss1};
                    pg8::gemm_phase<pg8::EpiGate, pg8::OneUnit, true, true>(lds, g, O1, E); }
                  asm volatile("s_waitcnt vmcnt(0)" ::: "memory"); __syncthreads();
                  const bf16* Ab = br == 0 ? (const bf16*)(ws + WS_YA) : br == 1 ? (const bf16*)(ws + WS_GG) : (const bf16*)(ws + WS_YC);
                  const bf16* Ub = br == 0 ? (const bf16*)(ws + WS_UA) : br == 1 ? (const bf16*)(ws + WS_UB) : (const bf16*)(ws + WS_UC);
                  const int Kb = br == 1 ? 1024 : 512;
                  { pg8::Gemm g{Ab, Ub, M, D, Kb, Kb, Kb, 0}; pg8::EpiMerge E{stash, mg, br == 0 ? 1 : 0};
                    pg8::gemm_phase<pg8::EpiMerge, pg8::OneUnit, true, true>(lds, g, O1, E); }
                  asm volatile("s_waitcnt vmcnt(0)" ::: "memory"); __syncthreads();
              } } }
        GSYNC();
        { pg8::Gemm g{(const bf16*)(ws + WS_MG), (const bf16*)(ws + WS_WO), M, D, D, D, D, 0}; pg8::StaticOrder S; S.init(M, D, G, bx); pg8::Unit u_;
          pg8::EpiResid E{X, X, XB, ss2, 1.0f};
          for (int i_ = 0; S.next(i_, u_); ++i_) { const pg8::OneUnit O1{u_.pm, u_.pn}; pg8::gemm_phase<pg8::EpiResid, pg8::OneUnit, false, true>(lds, g, O1, E); } }
        GSYNC();
        { bf16* pb = (bf16*)(ws + WS_PBUF) + (size_t)bx * 65536; const pg8::OneUnit O1{0, 0};
          for (int uid = vcu; uid < 256; uid += G) { const int rt = uid >> 2, h = uid & 3, b = rt >> 5;
              int KX = 256; asm volatile("" : "+s"(KX));
              bf16* qo = (bf16*)(ws + WS_QX) + (size_t)rt * 256 * D + h * 256; bf16* qs = (bf16*)(ws + WS_Q) + (size_t)bx * 65536;
              { pg8::Gemm g{XB + (size_t)rt * 256 * D, (const bf16*)(ws + WS_WXQ) + (size_t)h * 256 * D, 256, 256, D, D, D, 0}; pg8::EpiRs E{qs, 256, ss2 + (size_t)rt * 256 * 4, C2X};
                pg8::gemm_phase<pg8::EpiRs, pg8::OneUnit, true, true>(lds, g, O1, E); }
              asm volatile("s_waitcnt vmcnt(0)" ::: "memory"); __syncthreads();
              { pg8::Gemm g{qs, (const bf16*)(ws + WS_KX) + (size_t)b * 256 * D + h * 256, 256, 256, KX, 256, D, 0}; pg8::EpiSoftmaxP E{pb};
                pg8::gemm_phase<pg8::EpiSoftmaxP, pg8::OneUnit, false, true>(lds, g, O1, E); }
              asm volatile("s_waitcnt vmcnt(0)" ::: "memory"); __syncthreads();
              { pg8::Gemm g{pb, (const bf16*)(ws + WS_VT) + (size_t)(b * 4 + h) * 65536, 256, 256, KX, 256, 256, 0}; pg8::EpiRs E{qo, D, nullptr, 1.0f};
                pg8::gemm_phase<pg8::EpiRs, pg8::OneUnit, true, true>(lds, g, O1, E); }
              asm volatile("s_waitcnt vmcnt(0)" ::: "memory"); if (uid + G < 256) __builtin_amdgcn_fence(__ATOMIC_ACQUIRE, "agent"); __syncthreads();
          } }
        GSYNC();
        { pg8::Gemm g{(const bf16*)(ws + WS_QX), (const bf16*)(ws + WS_WXO), M, D, D, D, D, 0}; pg8::StaticOrder S; S.init(M, D, G, bx); pg8::Unit u_;
          pg8::EpiResid E{X, X, XB, ss3, 1.0f};
          for (int i_ = 0; S.next(i_, u_); ++i_) { const pg8::OneUnit O1{u_.pm, u_.pn}; pg8::gemm_phase<pg8::EpiResid, pg8::OneUnit, false, true>(lds, g, O1, E); } }
        GSYNC();
        { pg8::Gemm g{XB, (const bf16*)(ws + WS_W2IN), M, 2 * DFF, D, D, D, 0}; pg8::StaticOrder S; S.init(M, 2 * DFF, G, bx);
          pg8::EpiSwiglu E{HB, ss3, DFF};
          pg8::gemm_phase<pg8::EpiSwiglu, pg8::StaticOrder, true, true>(lds, g, S, E); }
        GSYNC();
        { pg8::Gemm g{HB, (const bf16*)(ws + WS_W2OUT), M, D, DFF, DFF, DFF, 0}; pg8::StaticOrder S; S.init(M, D, G, bx); pg8::Unit u_;
          pg8::EpiResid E{X, X, XB, ss4, 0.5f};
          for (int i_ = 0; S.next(i_, u_); ++i_) { const pg8::OneUnit O1{u_.pm, u_.pn}; pg8::gemm_phase<pg8::EpiResid, pg8::OneUnit, false, true>(lds, g, O1, E); } }
        GSYNC();
    }
    phase_final(X, tab_in(TB, 30), gw, NGW, lane);
#undef GSYNC
}

extern "C" void kernel_launch(void* const* d_in, const int* in_sizes, int n_in, void* d_out, int out_size, void* d_ws, size_t ws_size, hipStream_t stream) {
    static int grid = 0;
    if (grid == 0) {
        if (n_in != 31 || out_size != M * D || ws_size < WS_END) { fprintf(stderr, "kernel_launch: unexpected problem (n_in %d, out %d, ws %zu)\n", n_in, out_size, ws_size); grid = -1; return; }
        int dev = 0, cus = 0, per_cu = 0;
        (void)hipGetDevice(&dev); (void)hipDeviceGetAttribute(&cus, hipDeviceAttributeMultiprocessorCount, dev);
        if (hipFuncSetAttribute((const void*)hybrid_fwd, hipFuncAttributeMaxDynamicSharedMemorySize, LDS_BYTES) != hipSuccess) { fprintf(stderr, "kernel_launch: hipFuncSetAttribute failed\n"); grid = -1; return; }
        if (hipOccupancyMaxActiveBlocksPerMultiprocessor(&per_cu, (const void*)hybrid_fwd, NTHR, LDS_BYTES) != hipSuccess || per_cu < 1) per_cu = 1;
        (void)hipGetLastError();
        grid = cus * (per_cu > 1 ? 1 : per_cu);
        if (grid > 256) grid = 256;
    }
    if (grid < 0) return;
    (void)hipMemsetAsync((char*)d_ws + WS_SS, 0, CTL_ZERO_BYTES, stream);
    Args a{};
    for (int i = 0; i < 31; ++i) a.in[i] = (const float*)d_in[i];
    a.out = (float*)d_out; a.ws = (unsigned char*)d_ws;
    void* kargs[] = {&a};
    hipError_t e = hipLaunchCooperativeKernel((const void*)hybrid_fwd, dim3(grid), dim3(NTHR), kargs, LDS_BYTES, stream);
    if (e != hipSuccess) fprintf(stderr, "cooperative launch failed: %s (grid %d)\n", hipGetErrorString(e), grid);
}
```
